# Optimizing an MI355X kernel written in HIP

```python
import jax, jax.numpy as jnp
from jax import lax
import numpy as np

D_MODEL = 1024
BATCH = 32
SEQ = 2048
DEPTH = 2

HEAD_DIM = 64
N_BRANCHES = 4
BRANCH_WIDTH = D_MODEL // 4
ROPE_THETA = 500000.0
ROPE_DIM = HEAD_DIM // 4
NORM_EPS = 1e-6
NEG_INF = -1e30
QBLK = 128

NSA_HEADS = BRANCH_WIDTH // HEAD_DIM
NSA_GROUPS = 2
NSA_REP = NSA_HEADS // NSA_GROUPS
NSA_KV = NSA_GROUPS * HEAD_DIM
CMP_LEN = 32
CMP_STRIDE = 16
CMP_HIDDEN = 128
SEL_BLOCK = 64
SEL_TOPN = 8
SEL_QBLK = 32
SEL_FORCE = 1e30
WINDOW = 512

POOL_WINDOWS = (2, 4, 8, 16)
POOL_GROUPS = len(POOL_WINDOWS)
POOL_GROUP_DIM = BRANCH_WIDTH // POOL_GROUPS

RWKV_HEADS = BRANCH_WIDTH // HEAD_DIM
RWKV_DECAY_RANK = 32
RWKV_A_RANK = 32
RWKV_V_RANK = 32
RWKV_G_RANK = 64
RWKV_GN_EPS = 64e-5

GLA_HEADS = 4
GLA_DV = BRANCH_WIDTH // GLA_HEADS
GLA_DK = GLA_DV // 2
GLA_GATE_RANK = 16
GLA_TAU = 16.0
GLA_CHUNK = 16

NSA_IN = NSA_HEADS * HEAD_DIM + 6 * NSA_KV + 3 * NSA_HEADS
POOL_IN = BRANCH_WIDTH
RWKV_IN = 3 * BRANCH_WIDTH + RWKV_DECAY_RANK + RWKV_A_RANK + RWKV_G_RANK
GLA_IN = 2 * GLA_HEADS * GLA_DK + 2 * BRANCH_WIDTH + GLA_GATE_RANK
IN_WIDTH = NSA_IN + POOL_IN + RWKV_IN + GLA_IN

MEM_LEN = 256
CA_HEADS = 4
CA_WIDTH = CA_HEADS * HEAD_DIM

D_FF = 2816
N_EXPERTS = 8
TOP_K = 2
N_DENSE = (DEPTH + 1) // 2
N_MOE = DEPTH // 2

kernel_name = 'hybrid_nsa_pool_rwkv7_gla_moe_block'


def _split(t, sizes):
    return jnp.split(t, np.cumsum(sizes)[:-1].tolist(), axis=-1)


def rms_norm(x, g, eps=NORM_EPS):
    xf = x.astype(jnp.float32)
    y = xf * lax.rsqrt(jnp.mean(xf * xf, axis=-1, keepdims=True) + eps)
    return (y * g.astype(jnp.float32)).astype(x.dtype)


def rope_tables(positions):
    inv_freq = ROPE_THETA ** (-jnp.arange(0, ROPE_DIM, 2, dtype=jnp.float32) / ROPE_DIM)
    ang = positions.astype(jnp.float32)[..., None] * inv_freq
    return jnp.cos(ang), jnp.sin(ang)


def apply_partial_rope(t, cos, sin):
    half = ROPE_DIM // 2
    c = cos[:, :, None, :].astype(t.dtype)
    s = sin[:, :, None, :].astype(t.dtype)
    t1, t2, rest = t[..., :half], t[..., half:ROPE_DIM], t[..., ROPE_DIM:]
    return jnp.concatenate([t1 * c - t2 * s, t2 * c + t1 * s, rest], axis=-1)


def masked_softmax(scores, mask):
    s = jnp.where(mask, scores.astype(jnp.float32), NEG_INF)
    return jnp.where(mask, jax.nn.softmax(s, axis=-1), 0.0)


def nsa_mixer(p, cos, sin, cmp_pe, cmp_w1, cmp_w2):
    B, S, _ = p.shape
    G, R, hd = NSA_GROUPS, NSA_REP, HEAD_DIM
    q, kc, vc, ks, vs, kw, vw, gates = _split(p, (NSA_HEADS * hd,) + (NSA_KV,) * 6 + (3 * NSA_HEADS,))
    q = apply_partial_rope(q.reshape(B, S, NSA_HEADS, hd), cos, sin) * (hd ** -0.5)
    q = q.reshape(B, S, G, R, hd)
    kvs = lambda t: t.reshape(B, S, G, hd)
    t_idx = np.arange(S)

    n_cmp = (S - CMP_LEN) // CMP_STRIDE + 1
    cmp_start = np.arange(n_cmp) * CMP_STRIDE
    cmp_idx = cmp_start[:, None] + np.arange(CMP_LEN)[None, :]
    cmp_end = cmp_start + CMP_LEN - 1

    def compress(t, j):
        blocks = t[:, cmp_idx] + cmp_pe[j][:, None, :]
        hid = jax.nn.gelu(jnp.einsum('bnlgd,ldf->bngf', blocks, cmp_w1[j]))
        return jnp.einsum('bngf,fd->bngd', hid, cmp_w2[j])

    k_cmp = apply_partial_rope(compress(kvs(kc), 0), cos[:, cmp_end], sin[:, cmp_end])
    v_cmp = compress(kvs(vc), 1)
    cmp_mask = cmp_end[None, :] <= t_idx[:, None]
    p_cmp = masked_softmax(jnp.einsum('bsgrd,bngd->bgrsn', q, k_cmp), cmp_mask)
    o_cmp = jnp.einsum('bgrsn,bngd->bsgrd', p_cmp.astype(v_cmp.dtype), v_cmp)

    n_slc = S // SEL_BLOCK
    slc_start = np.arange(n_slc) * SEL_BLOCK
    cover = np.clip(np.minimum(cmp_start[:, None] + CMP_LEN, slc_start[None, :] + SEL_BLOCK)
                    - np.maximum(cmp_start[:, None], slc_start[None, :]), 0, None) / CMP_LEN
    imp = jnp.einsum('bgrsn,nj->bgsj', p_cmp, jnp.asarray(cover, jnp.float32))
    cur = t_idx[:, None] // SEL_BLOCK
    blk = np.arange(n_slc)[None, :]
    forced = (blk == 0) | (blk == cur) | (blk == cur - 1)
    causal_blk = slc_start[None, :] <= t_idx[:, None]
    imp = jnp.where(forced, SEL_FORCE, jnp.where(causal_blk, imp, -SEL_FORCE))
    n_top = min(SEL_TOPN, n_slc)
    _, sel = lax.top_k(imp, n_top)

    k_sel = apply_partial_rope(kvs(ks), cos, sin).transpose(0, 2, 1, 3)
    v_sel = kvs(vs).transpose(0, 2, 1, 3)
    n_sq = S // SEL_QBLK
    n_keys = n_top * SEL_BLOCK
    gather_rows = jax.vmap(jax.vmap(lambda src, idx: src[idx]))

    def sel_block(args):
        i, qb, sb = args
        tok = (sb[..., None] * SEL_BLOCK + np.arange(SEL_BLOCK)).reshape(B, G, SEL_QBLK * n_keys)
        kg = gather_rows(k_sel, tok).reshape(B, G, SEL_QBLK, n_keys, hd)
        vg = gather_rows(v_sel, tok).reshape(B, G, SEL_QBLK, n_keys, hd)
        qpos = i * SEL_QBLK + jnp.arange(SEL_QBLK)
        mask = tok.reshape(B, G, 1, SEL_QBLK, n_keys) <= qpos[:, None]
        pr = masked_softmax(jnp.einsum('bqgrd,bgqkd->bgrqk', qb, kg), mask)
        return jnp.einsum('bgrqk,bgqkd->bqgrd', pr.astype(vg.dtype), vg)

    q_sb = jnp.moveaxis(q.reshape(B, n_sq, SEL_QBLK, G, R, hd), 1, 0)
    sel_b = jnp.moveaxis(sel.reshape(B, G, n_sq, SEL_QBLK, n_top), 2, 0)
    o_sel = lax.map(sel_block, (jnp.arange(n_sq), q_sb, sel_b))
    o_sel = jnp.moveaxis(o_sel, 0, 1).reshape(B, S, G, R, hd)

    pad = ((0, 0), (WINDOW, 0), (0, 0), (0, 0))
    k_win = jnp.pad(apply_partial_rope(kvs(kw), cos, sin), pad)
    v_win = jnp.pad(kvs(vw), pad)
    span = WINDOW + QBLK
    rel = jnp.arange(span) - WINDOW

    def win_block(args):
        i, qb = args
        start = i * QBLK
        kb = lax.dynamic_slice_in_dim(k_win, start, span, axis=1)
        vb = lax.dynamic_slice_in_dim(v_win, start, span, axis=1)
        qpos = start + jnp.arange(QBLK)
        kpos = start + rel
        dist = qpos[:, None] - kpos[None, :]
        mask = (dist >= 0) & (dist < WINDOW) & (kpos[None, :] >= 0)
        pr = masked_softmax(jnp.einsum('bqgrd,bkgd->bgrqk', qb, kb), mask)
        return jnp.einsum('bgrqk,bkgd->bqgrd', pr.astype(vb.dtype), vb)

    n_wb = S // QBLK
    q_wb = jnp.moveaxis(q.reshape(B, n_wb, QBLK, G, R, hd), 1, 0)
    o_win = jnp.moveaxis(lax.map(win_block, (jnp.arange(n_wb), q_wb)), 0, 1).reshape(B, S, G, R, hd)

    g = jax.nn.sigmoid(gates.reshape(B, S, G, R, 3))
    o = g[..., 0:1] * o_cmp + g[..., 1:2] * o_sel + g[..., 2:3] * o_win
    return o.reshape(B, S, NSA_HEADS * hd)


def pool_mixer(u, w, scale):
    B, S, _ = u.shape
    uf = u.astype(jnp.float32)
    c = jnp.cumsum(uf, axis=1)
    count = jnp.arange(1, S + 1, dtype=jnp.float32)[None, :, None]
    outs = []
    for gi, win in enumerate(POOL_WINDOWS):
        sl = slice(gi * POOL_GROUP_DIM, (gi + 1) * POOL_GROUP_DIM)
        cg = c[..., sl]
        prev = jnp.pad(cg, ((0, 0), (win, 0), (0, 0)))[:, :S]
        outs.append((cg - prev) / jnp.minimum(count, win) - uf[..., sl])
    d = jnp.stack(outs, axis=2).astype(u.dtype)
    y = jnp.einsum('bsgc,gcd->bsgd', d, w).reshape(B, S, BRANCH_WIDTH)
    return y * scale


def token_shift(t):
    return jnp.pad(t, ((0, 0), (1, 0), (0, 0)))[:, :-1]


def rwkv7_mixer(p, mu, w0, w2, a0, a2, g2, k_k, k_a, r_k, ln_g, v_first, v_res_logit):
    B, S, _ = p.shape
    H, hd, W = RWKV_HEADS, HEAD_DIM, BRANCH_WIDTH
    f32 = jnp.float32
    dtype = p.dtype
    p = p.astype(f32)
    p = p + (token_shift(p) - p) * mu
    r, k, v, wd, ad, gd = _split(p, (W, W, W, RWKV_DECAY_RANK, RWKV_A_RANK, RWKV_G_RANK))
    w_log = -jax.nn.softplus(-(w0 + jnp.tanh(wd) @ w2)) - 0.5
    decay = jnp.exp(-jnp.exp(w_log))
    a = jax.nn.sigmoid(a0 + ad @ a2)
    g = jax.nn.sigmoid(gd) @ g2
    if v_first is not None:
        v = v + (v_first - v) * jax.nn.sigmoid(v_res_logit)
    heads = lambda t: t.reshape(B, S, H, hd)
    kk = heads(k * k_k)
    kk = kk / jnp.maximum(jnp.linalg.norm(kk, axis=-1, keepdims=True), 1e-12)
    k = k * (1.0 + (a - 1.0) * k_a)
    b = kk * heads(a)
    xs = tuple(jnp.moveaxis(t, 1, 0) for t in (heads(r), heads(decay), heads(k), heads(v), kk, b))

    def step(state, inp):
        r_t, w_t, k_t, v_t, kk_t, b_t = inp
        s_kk = jnp.einsum('bhvk,bhk->bhv', state, kk_t)
        state = (state * w_t[:, :, None, :] - s_kk[..., None] * b_t[:, :, None, :]
                 + v_t[..., None] * k_t[:, :, None, :])
        return state, jnp.einsum('bhvk,bhk->bhv', state, r_t)

    _, y = lax.scan(step, jnp.zeros((B, H, hd, hd), f32), xs)
    y = jnp.moveaxis(y, 0, 1)
    mean = jnp.mean(y, axis=-1, keepdims=True)
    var = jnp.mean(jnp.square(y - mean), axis=-1, keepdims=True)
    y = (y - mean) * lax.rsqrt(var + RWKV_GN_EPS) * ln_g.reshape(H, hd)
    y = y + jnp.sum(heads(r) * heads(k) * r_k, axis=-1, keepdims=True) * heads(v)
    return (y.reshape(B, S, W) * g).astype(dtype), v


def gla_mixer(p, a2, ab, norm_g):
    B, S, _ = p.shape
    H, dk, dv, C = GLA_HEADS, GLA_DK, GLA_DV, GLA_CHUNK
    f32 = jnp.float32
    dtype = p.dtype
    q, k, v, ad, og = _split(p, (H * dk, H * dk, BRANCH_WIDTH, GLA_GATE_RANK, BRANCH_WIDTH))
    log_a = jax.nn.log_sigmoid((ad @ a2 + ab).astype(f32)) / GLA_TAU
    nc = S // C
    chunks = lambda t, d: t.astype(f32).reshape(B, nc, C, H, d)
    q = chunks(q, dk) * (dk ** -0.5)
    k = chunks(k, dk)
    v = chunks(v, dv)
    bcum = jnp.cumsum(chunks(log_a, dk), axis=2)
    blast = bcum[:, :, -1]
    q_t = q * jnp.exp(bcum)
    k_t = k * jnp.exp(-bcum)
    k_end = k * jnp.exp(blast[:, :, None] - bcum)
    causal = np.tril(np.ones((C, C), dtype=bool))
    att = jnp.where(causal, jnp.einsum('bnthk,bnshk->bnhts', q_t, k_t), 0.0)
    o_intra = jnp.einsum('bnhts,bnshv->bnthv', att, v)

    def step(state, inp):
        kc, vc, dl = inp
        new = state * dl[..., None] + jnp.einsum('bchk,bchv->bhkv', kc, vc)
        return new, state

    xs = (jnp.moveaxis(k_end, 1, 0), jnp.moveaxis(v, 1, 0), jnp.moveaxis(jnp.exp(blast), 1, 0))
    _, s_prev = lax.scan(step, jnp.zeros((B, H, dk, dv), f32), xs)
    o_inter = jnp.einsum('bnthk,nbhkv->bnthv', q_t, s_prev)
    o = (o_intra + o_inter).reshape(B, S, H, dv)
    o = o * lax.rsqrt(jnp.mean(o * o, axis=-1, keepdims=True) + NORM_EPS) * norm_g
    return (o.reshape(B, S, BRANCH_WIDTH) * jax.nn.silu(og.astype(f32))).astype(dtype)


def cross_attention(hc, mem_n, wq, wkv, wo):
    B, S, _ = hc.shape
    M = mem_n.shape[1]
    q = (hc @ wq).reshape(B, S, CA_HEADS, HEAD_DIM) * (HEAD_DIM ** -0.5)
    k, v = _split(mem_n @ wkv, (CA_WIDTH, CA_WIDTH))
    k = k.reshape(B, M, CA_HEADS, HEAD_DIM)
    v = v.reshape(B, M, CA_HEADS, HEAD_DIM)
    pr = jax.nn.softmax(jnp.einsum('bshd,bmhd->bhsm', q, k).astype(jnp.float32), axis=-1)
    o = jnp.einsum('bhsm,bmhd->bshd', pr.astype(v.dtype), v).reshape(B, S, CA_WIDTH)
    return o @ wo


def swiglu(x, wg, wu, wd):
    return (jax.nn.silu(x @ wg) * (x @ wu)) @ wd


def moe_swiglu(x, router, wg, wu, wd):
    logits = (x @ router).astype(jnp.float32)
    top_val, top_idx = lax.top_k(logits, TOP_K)
    weights = jax.nn.softmax(top_val, axis=-1)
    combine = jnp.sum(jax.nn.one_hot(top_idx, N_EXPERTS, dtype=jnp.float32) * weights[..., None], axis=-2)
    out = jnp.zeros_like(x)
    for e in range(N_EXPERTS):
        out = out + combine[..., e:e + 1].astype(x.dtype) * swiglu(x, wg[e], wu[e], wd[e])
    return out


def setup_inputs(seed: int = 0) -> dict:
    key = jax.random.key(seed)
    keys = iter(jax.random.split(key, 64))
    f32 = jnp.float32

    def normal(shape, scale):
        return jax.random.normal(next(keys), shape, f32) * scale

    def gain(shape):
        return 1.0 + normal(shape, 0.05)

    def uniform(shape, lo, hi):
        return jax.random.uniform(next(keys), shape, f32, lo, hi)

    L, D, W = DEPTH, D_MODEL, BRANCH_WIDTH
    x = normal((BATCH, SEQ, D), 1.0)
    mem = normal((BATCH, MEM_LEN, D), 1.0)
    start = jax.random.randint(next(keys), (BATCH, 1), 0, 4096, dtype=jnp.int32)
    positions = start + jnp.arange(SEQ, dtype=jnp.int32)[None, :]
    return {
        'x': x,
        'mem': mem,
        'positions': positions,
        'norm_mix': gain((L, D)),
        'w_in': normal((L, D, IN_WIDTH), D ** -0.5),
        'nsa_cmp_pe': normal((L, 2, CMP_LEN, HEAD_DIM), 0.1),
        'nsa_cmp_w1': normal((L, 2, CMP_LEN, HEAD_DIM, CMP_HIDDEN), (CMP_LEN * HEAD_DIM) ** -0.5),
        'nsa_cmp_w2': normal((L, 2, CMP_HIDDEN, HEAD_DIM), CMP_HIDDEN ** -0.5),
        'pool_w': normal((L, POOL_GROUPS, POOL_GROUP_DIM, POOL_GROUP_DIM), POOL_GROUP_DIM ** -0.5),
        'pool_scale': gain((L, W)),
        'rwkv_mu': uniform((L, RWKV_IN), 0.0, 1.0),
        'rwkv_w0': uniform((L, W), -6.0, 1.0),
        'rwkv_w2': normal((L, RWKV_DECAY_RANK, W), 0.5 * RWKV_DECAY_RANK ** -0.5),
        'rwkv_a0': normal((L, W), 0.1),
        'rwkv_a2': normal((L, RWKV_A_RANK, W), RWKV_A_RANK ** -0.5),
        'rwkv_g2': normal((L, RWKV_G_RANK, W), RWKV_G_RANK ** -0.5),
        'rwkv_v0': normal((L - 1, W), 0.1),
        'rwkv_v1': normal((L - 1, D, RWKV_V_RANK), D ** -0.5),
        'rwkv_v2': normal((L - 1, RWKV_V_RANK, W), RWKV_V_RANK ** -0.5),
        'rwkv_k_k': 0.85 + normal((L, W), 0.05),
        'rwkv_k_a': gain((L, W)),
        'rwkv_r_k': normal((L, RWKV_HEADS, HEAD_DIM), 0.1),
        'rwkv_ln': gain((L, W)),
        'gla_a2': normal((L, GLA_GATE_RANK, GLA_HEADS * GLA_DK), GLA_GATE_RANK ** -0.5),
        'gla_ab': uniform((L, GLA_HEADS * GLA_DK), 0.0, 4.0),
        'gla_norm': gain((L, GLA_DV)),
        'w_gate': normal((L, N_BRANCHES, D, D), D ** -0.5),
        'b_gate': normal((L, N_BRANCHES, D), 0.1),
        'w_branch': normal((L, N_BRANCHES, W, D), W ** -0.5),
        'w_out': normal((L, D, D), D ** -0.5),
        'norm_ca': gain((L, D)),
        'mem_norm': gain((D,)),
        'w_ca_q': normal((L, D, CA_WIDTH), D ** -0.5),
        'w_ca_kv': normal((L, D, 2 * CA_WIDTH), D ** -0.5),
        'w_ca_o': normal((L, CA_WIDTH, D), CA_WIDTH ** -0.5),
        'norm_ffn': gain((L, D)),
        'ffn_w_gate': normal((N_DENSE, D, D_FF), D ** -0.5),
        'ffn_w_up': normal((N_DENSE, D, D_FF), D ** -0.5),
        'ffn_w_down': normal((N_DENSE, D_FF, D), D_FF ** -0.5),
        'moe_router': normal((N_MOE, D, N_EXPERTS), D ** -0.5),
        'moe_w_gate': normal((N_MOE, N_EXPERTS, D, D_FF), D ** -0.5),
        'moe_w_up': normal((N_MOE, N_EXPERTS, D, D_FF), D ** -0.5),
        'moe_w_down': normal((N_MOE, N_EXPERTS, D_FF, D), D_FF ** -0.5),
        'norm_final': gain((D,)),
    }


def reference(x, mem, positions, norm_mix, w_in, nsa_cmp_pe, nsa_cmp_w1, nsa_cmp_w2, pool_w, pool_scale,
              rwkv_mu, rwkv_w0, rwkv_w2, rwkv_a0, rwkv_a2, rwkv_g2, rwkv_v0, rwkv_v1, rwkv_v2,
              rwkv_k_k, rwkv_k_a, rwkv_r_k, rwkv_ln, gla_a2, gla_ab, gla_norm,
              w_gate, b_gate, w_branch, w_out, norm_ca, mem_norm, w_ca_q, w_ca_kv, w_ca_o,
              norm_ffn, ffn_w_gate, ffn_w_up, ffn_w_down,
              moe_router, moe_w_gate, moe_w_up, moe_w_down, norm_final):
    cos, sin = rope_tables(positions)
    mem_n = rms_norm(mem, mem_norm)
    v_first = None
    for l in range(DEPTH):
        h = rms_norm(x, norm_mix[l])
        p_nsa, p_pool, p_rwkv, p_gla = _split(h @ w_in[l], (NSA_IN, POOL_IN, RWKV_IN, GLA_IN))
        o_nsa = nsa_mixer(p_nsa, cos, sin, nsa_cmp_pe[l], nsa_cmp_w1[l], nsa_cmp_w2[l])
        o_pool = pool_mixer(p_pool, pool_w[l], pool_scale[l])
        v_res_logit = None if l == 0 else rwkv_v0[l - 1] + (h @ rwkv_v1[l - 1]) @ rwkv_v2[l - 1]
        o_rwkv, v_l = rwkv7_mixer(p_rwkv, rwkv_mu[l], rwkv_w0[l], rwkv_w2[l], rwkv_a0[l], rwkv_a2[l],
                                  rwkv_g2[l], rwkv_k_k[l], rwkv_k_a[l], rwkv_r_k[l], rwkv_ln[l],
                                  v_first, v_res_logit)
        if l == 0:
            v_first = v_l
        o_gla = gla_mixer(p_gla, gla_a2[l], gla_ab[l], gla_norm[l])
        merged = jnp.zeros_like(x)
        for i, o in enumerate((o_nsa, o_pool, o_rwkv, o_gla)):
            gate = jax.nn.sigmoid(h @ w_gate[l, i] + b_gate[l, i])
            merged = merged + gate * (o @ w_branch[l, i])
        x = x + merged @ w_out[l]
        x = x + cross_attention(rms_norm(x, norm_ca[l]), mem_n, w_ca_q[l], w_ca_kv[l], w_ca_o[l])
        hf = rms_norm(x, norm_ffn[l])
        j = l // 2
        if l % 2 == 0:
            x = x + swiglu(hf, ffn_w_gate[j], ffn_w_up[j], ffn_w_down[j])
        else:
            x = x + moe_swiglu(hf, moe_router[j], moe_w_gate[j], moe_w_up[j], moe_w_down[j])
    return rms_norm(x, norm_final)
```

```cpp
#ifndef CPU_EMU
#include <hip/hip_runtime.h>
#include <cstdio>
#include <cstdint>
#include <cstring>
#define DEVI __device__ __forceinline__
#define DEVM __device__ __forceinline__
#else
#include <cmath>
#include <cstdio>
#include <cstdint>
#include <cstring>
#include <cstdlib>
#define DEVI static inline
#define DEVM inline
struct uint4 { unsigned x, y, z, w; };
#endif

typedef unsigned short bf16_t;
#ifdef CPU_EMU
static inline float u2f(unsigned u) { float f; memcpy(&f, &u, 4); return f; }
static inline unsigned f2u(float f) { unsigned u; memcpy(&u, &f, 4); return u; }
#else
DEVI float u2f(unsigned u) { return __uint_as_float(u); }
DEVI unsigned f2u(float f) { return __float_as_uint(f); }
#endif
DEVI float bf2f(bf16_t b) { return u2f(((unsigned)b) << 16); }
DEVI bf16_t f2bf(float f) { unsigned u = f2u(f); u += 0x7FFFu + ((u >> 16) & 1u); return (bf16_t)(u >> 16); }
DEVI float sigmoidf_(float x) { return 1.0f / (1.0f + expf(-x)); }
DEVI float siluf_(float x) { return x / (1.0f + expf(-x)); }
DEVI float softplusf_(float x) { return x > 20.f ? x : log1pf(expf(x)); }
DEVI float gelu_tanhf_(float x) { return 0.5f * x * (1.0f + tanhf(0.7978845608028654f * (x + 0.044715f * x * x * x))); }

constexpr int DM = 1024;
constexpr int PW = 3072;
constexpr int INW = 2972;
constexpr int C_Q = 0, C_KC = 256, C_VC = 384, C_KS = 512, C_VS = 640, C_KW = 768, C_VW = 896, C_NG = 1024;
constexpr int C_POOL = 1036;
constexpr int C_RW = 1292;
constexpr int C_GLA = 2188;
constexpr int C_VRES = 2972;
constexpr int NCMPH = 128;

enum { I_X = 0, I_MEM, I_POS, I_NORM_MIX, I_W_IN, I_CMP_PE, I_CMP_W1, I_CMP_W2, I_POOL_W, I_POOL_SCALE, I_RW_MU, I_RW_W0, I_RW_W2, I_RW_A0, I_RW_A2, I_RW_G2,
       I_RW_V0, I_RW_V1, I_RW_V2, I_RW_KK, I_RW_KA, I_RW_RK, I_RW_LN, I_GLA_A2, I_GLA_AB, I_GLA_NORM, I_W_GATE, I_B_GATE, I_W_BRANCH, I_W_OUT, I_NORM_CA, I_MEM_NORM,
       I_CA_Q, I_CA_KV, I_CA_O, I_NORM_FFN, I_FFN_G, I_FFN_U, I_FFN_D, I_MOE_R, I_MOE_G, I_MOE_U, I_MOE_D, I_NORM_FINAL, N_INPUTS };

struct Params {
    const float* in[N_INPUTS];
    float* out;
    unsigned char* ws;
    long long B, S, T, DFF, NC, NR;
    float inv_freq[8];
    long long oBAR, oMOEC, oROPE, oKCMP, oVCMP, oHID, oSELM, oKV, oRK, oTOKE, oTOKW, oTOKS, oR2T, oROWW, oCCNT, oCOFF;
    long long oWL[2], oWKV, oWFFN, oVF, oH, oP, oO, oBO, oMG, oRWW, oRWX, oGA, oCQ, oCAO, oMEMN, oACT, oY, oHS, oMOEW, oACTC, wsNeed;
};
constexpr long long W_IN = 0, W_G = W_IN + 3072LL * 1024, W_B = W_G + 4096LL * 1024, W_O = W_B + 4LL * 1024 * 256, W_CQ = W_O + 1024LL * 1024, W_CKV = W_CQ + 256LL * 1024,
                    W_CO = W_CKV + 512LL * 1024, W_LAYER = W_CO + 1024LL * 256;

static inline long long al256(long long x) { return (x + 255) & ~255LL; }
static inline void make_layout(Params& p, long long B, long long S, long long DFF) {
    p.B = B; p.S = S; p.T = B * S; p.DFF = DFF; p.NC = (S - 32) / 16 + 1; p.NR = 2 * p.T + 2048;
    const long long T = p.T;
    long long o = 0;
    auto take = [&](long long bytes) { long long r = o; o = al256(o + bytes); return r; };
    p.oBAR = take(16384); p.oMOEC = take(4096);
    p.oROPE = take(T * 16 * 4);
    p.oKCMP = take(B * p.NC * 128 * 4); p.oVCMP = take(B * p.NC * 128 * 4); p.oHID = take(B * p.NC * 4 * 128 * 4);
    p.oSELM = take(T * 2 * 4);
    p.oKV = take(2 * B * 256 * 512 * 2);
    p.oRK = take(T * 4 * 4);
    p.oTOKE = take(T * 2 * 4); p.oTOKW = take(T * 2 * 4); p.oTOKS = take(T * 2 * 4); p.oR2T = take(p.NR * 4); p.oROWW = take(p.NR * 4);
    p.oCCNT = take((T / 64) * 8 * 4); p.oCOFF = take((T / 64) * 8 * 4);
    p.oWL[0] = take(W_LAYER * 2); p.oWL[1] = take(W_LAYER * 2); p.oWKV = take(2LL * 512 * 1024 * 2); p.oWFFN = take(3 * 1024 * DFF * 2);
    p.oVF = take(T * 256 * 2);
    p.oH = take(T * 1024 * 2);
    p.oP = take(T * 3072 * 2);
    p.oO = take(T * 1024 * 2);
    p.oBO = take(T * 2048);
    p.oMG = take(T * 2048);
    long long end_main = o;
    p.oRWW = p.oBO;
    p.oRWX = p.oRWW + T * 1024;
    p.oGA = p.oRWX + T * 2560;
    p.oCQ = p.oP; p.oCAO = p.oP + T * 512;
    p.oMEMN = p.oBO;
    p.oACT = p.oP;
    p.oY = p.oVF; long long q = al256(p.oY + p.NR * 2048);
    p.oHS = q; q = al256(q + p.NR * 2048);
    p.oMOEW = q; q = al256(q + 8LL * 3 * 1024 * DFF * 2);
    const long long ntmax = p.NR / 256, ct = (ntmax + 3) / 4;
    p.oACTC = q; q = al256(q + ct * 256 * DFF * 2);
    p.wsNeed = q > end_main ? q : end_main;
}
#define WSP(T_, off) ((T_*)(p.ws + (off)))

DEVI void cvt_T(bf16_t* dst, const float* src, long long K, long long N, long long Npad, long long ld, long long gtid, long long gsz) {
    for (long long i = gtid; i < Npad * K; i += gsz) { const long long n = i / K, k = i % K; dst[i] = n < N ? f2bf(src[k * ld + n]) : (bf16_t)0; }
}
DEVI void cvt_GU(bf16_t* dst, const float* wg, const float* wu, long long DFF, long long gtid, long long gsz) {
    for (long long i = gtid; i < 2 * DFF * 1024; i += gsz) { const long long rr = i / 1024, k = i % 1024, t = rr >> 8, w = rr & 255;
        dst[i] = f2bf((w < 128 ? wg : wu)[k * DFF + t * 128 + (w & 127)]); }
}
DEVI void ph_convert_layer(const Params& p, int l, long long gtid, long long gsz) {
    bf16_t* W = WSP(bf16_t, p.oWL[l]);
    for (long long i = gtid; i < 3072LL * 1024; i += gsz) { const long long n = i >> 10, k = i & 1023; float v = 0.f;
        if (n < INW) v = p.in[I_W_IN][((long long)l * 1024 + k) * INW + n];
        else if (n < INW + 32 && l == 1) v = p.in[I_RW_V1][k * 32 + (n - INW)];
        W[W_IN + i] = f2bf(v); }
    for (int i = 0; i < 4; ++i) cvt_T(W + W_G + (long long)i * 1024 * 1024, p.in[I_W_GATE] + ((long long)l * 4 + i) * 1024 * 1024, 1024, 1024, 1024, 1024, gtid, gsz);
    for (int i = 0; i < 4; ++i) cvt_T(W + W_B + (long long)i * 1024 * 256, p.in[I_W_BRANCH] + ((long long)l * 4 + i) * 256 * 1024, 256, 1024, 1024, 1024, gtid, gsz);
    cvt_T(W + W_O, p.in[I_W_OUT] + (long long)l * 1024 * 1024, 1024, 1024, 1024, 1024, gtid, gsz);
    cvt_T(W + W_CQ, p.in[I_CA_Q] + (long long)l * 1024 * 256, 1024, 256, 256, 256, gtid, gsz);
    cvt_T(WSP(bf16_t, p.oWKV) + (long long)l * 512 * 1024, p.in[I_CA_KV] + (long long)l * 1024 * 512, 1024, 512, 512, 512, gtid, gsz);
    cvt_T(W + W_CO, p.in[I_CA_O] + (long long)l * 256 * 1024, 256, 1024, 1024, 1024, gtid, gsz);
}
DEVI void ph_convert_ffn(const Params& p, long long gtid, long long gsz) {
    bf16_t* W = WSP(bf16_t, p.oWFFN);
    cvt_GU(W, p.in[I_FFN_G], p.in[I_FFN_U], p.DFF, gtid, gsz);
    cvt_T(W + 2 * p.DFF * 1024, p.in[I_FFN_D], p.DFF, 1024, 1024, 1024, gtid, gsz);
}
DEVI void ph_convert_moe(const Params& p, long long gtid, long long gsz) {
    const long long DFF = p.DFF, per = 3 * 1024 * DFF;
    for (int e = 0; e < 8; ++e) { bf16_t* W = WSP(bf16_t, p.oMOEW) + e * per;
        cvt_GU(W, p.in[I_MOE_G] + (long long)e * 1024 * DFF, p.in[I_MOE_U] + (long long)e * 1024 * DFF, DFF, gtid, gsz);
        cvt_T(W + 2 * DFF * 1024, p.in[I_MOE_D] + (long long)e * DFF * 1024, DFF, 1024, 1024, 1024, gtid, gsz); }
}
DEVI void ph_rope(const Params& p, long long gtid, long long gsz) {
    const int* pos = (const int*)p.in[I_POS]; float* R = WSP(float, p.oROPE);
    for (long long i = gtid; i < p.T * 8; i += gsz) { const long long t = i >> 3; const int j = (int)(i & 7);
        const float ang = (float)pos[t] * p.inv_freq[j];
        double a = (double)ang; a -= 6.283185307179586476925 * floor(a * 0.15915494309189533577 + 0.5);
        const float ar = (float)a; R[t * 16 + j] = cosf(ar); R[t * 16 + 8 + j] = sinf(ar); }
}
DEVI void ph_rope_apply(const Params& p, long long gtid, long long gsz) {
    bf16_t* P = WSP(bf16_t, p.oP); const float* R = WSP(float, p.oROPE);
    for (long long i = gtid; i < p.T * 8; i += gsz) { const long long t = i >> 3; const int w = (int)(i & 7);
        const int col = w < 4 ? C_Q + w * 64 : (w < 6 ? C_KS + (w - 4) * 64 : C_KW + (w - 6) * 64);
        bf16_t* x = P + t * PW + col; const float* r = R + t * 16; const float sc = w < 4 ? 0.125f : 1.0f;
        for (int j = 0; j < 8; ++j) { const float a = bf2f(x[j]), b = bf2f(x[j + 8]), c = r[j], s = r[8 + j]; x[j] = f2bf((a * c - b * s) * sc); x[j + 8] = f2bf((b * c + a * s) * sc); }
        if (w < 4) for (int j = 16; j < 64; ++j) x[j] = f2bf(bf2f(x[j]) * 0.125f); }
}
DEVI void ph_compress1(const Params& p, int l, long long gtid, long long gsz) {
    const bf16_t* P = WSP(bf16_t, p.oP); float* HID = WSP(float, p.oHID);
    const float* pe = p.in[I_CMP_PE] + (long long)l * 2 * 32 * 64; const float* w1 = p.in[I_CMP_W1] + (long long)l * 2 * 32 * 64 * 128;
    const long long n_items = p.B * p.NC * 4 * 128;
    for (long long i = gtid; i < n_items; i += gsz) { const int f = (int)(i & 127); const int j = (int)((i >> 7) & 1), g = (int)((i >> 8) & 1); const long long bn = i >> 9, n = bn % p.NC, b = bn / p.NC;
        const int col = (j == 0 ? C_KC : C_VC) + g * 64; float acc = 0.f;
        for (int ll = 0; ll < 32; ++ll) { const bf16_t* x = P + (b * p.S + n * 16 + ll) * PW + col; const float* pp = pe + (j * 32 + ll) * 64; const float* ww = w1 + ((long long)(j * 32 + ll) * 64) * 128 + f;
            for (int d = 0; d < 64; ++d) acc += (bf2f(x[d]) + pp[d]) * ww[d * 128]; }
        HID[i] = gelu_tanhf_(acc); }
}
DEVI void ph_compress2(const Params& p, int l, long long gtid, long long gsz) {
    const float* HID = WSP(float, p.oHID); const float* w2 = p.in[I_CMP_W2] + (long long)l * 2 * 128 * 64; const float* R = WSP(float, p.oROPE);
    float* KC = WSP(float, p.oKCMP); float* VC = WSP(float, p.oVCMP);
    const long long n_items = p.B * p.NC * 2 * 2 * 8;
    for (long long i = gtid; i < n_items; i += gsz) { const int d8 = (int)(i & 7), j = (int)((i >> 3) & 1), g = (int)((i >> 4) & 1); const long long bn = i >> 5, n = bn % p.NC, b = bn / p.NC;
        const float* h = HID + ((bn * 2 + g) * 2 + j) * 128; const float* w = w2 + (long long)j * 128 * 64;
        float a[8];
#pragma unroll
        for (int m = 0; m < 8; ++m) a[m] = 0.f;
        for (int f = 0; f < 128; ++f) { const float hv = h[f];
#pragma unroll
            for (int m = 0; m < 8; ++m) a[m] += hv * w[f * 64 + d8 + 8 * m]; }
        if (j == 0) { const float* r = R + (b * p.S + n * 16 + 31) * 16; const float x0 = a[0], x1 = a[1], cs = r[d8], sn = r[8 + d8]; a[0] = x0 * cs - x1 * sn; a[1] = x1 * cs + x0 * sn; }
        float* dst = (j == 0 ? KC : VC) + (bn * 2 + g) * 64;
#pragma unroll
        for (int m = 0; m < 8; ++m) dst[d8 + 8 * m] = a[m]; }
}
DEVI void ph_pool(const Params& p, int l, long long gtid, long long gsz) {
    const bf16_t* P = WSP(bf16_t, p.oP); bf16_t* O = WSP(bf16_t, p.oO);
    const float* pw = p.in[I_POOL_W] + (long long)l * 4 * 64 * 64; const float* ps = p.in[I_POOL_SCALE] + (long long)l * 256;
    for (long long i = gtid; i < p.T * 4; i += gsz) { const long long t = i >> 2; const int g = (int)(i & 3); const long long s = t % p.S; const int win = 2 << g;
        const int cnt = (int)(s + 1 < win ? s + 1 : win); const float inv = 1.0f / (float)cnt;
        float dv[64];
#pragma unroll
        for (int c = 0; c < 64; ++c) dv[c] = 0.f;
        for (int k = 0; k < cnt; ++k) { const bf16_t* x = P + (t - k) * PW + C_POOL + g * 64;
#pragma unroll
            for (int c = 0; c < 64; ++c) dv[c] += bf2f(x[c]); }
        { const bf16_t* x = P + t * PW + C_POOL + g * 64;
#pragma unroll
            for (int c = 0; c < 64; ++c) dv[c] = dv[c] * inv - bf2f(x[c]); }
        const float* w = pw + g * 64 * 64;
        for (int d = 0; d < 64; ++d) { float a = 0.f;
#pragma unroll
            for (int c = 0; c < 64; ++c) a += dv[c] * w[c * 64 + d];
            O[t * 1024 + 256 + g * 64 + d] = f2bf(a * ps[g * 64 + d]); } }
}
DEVI void ph_rwkv_prep(const Params& p, int l, long long gtid, long long gsz) {
    const bf16_t* P = WSP(bf16_t, p.oP); float* RWW = WSP(float, p.oRWW); bf16_t* RWX = WSP(bf16_t, p.oRWX); float* RK = WSP(float, p.oRK); bf16_t* O = WSP(bf16_t, p.oO); bf16_t* VF = WSP(bf16_t, p.oVF);
    const float* mu = p.in[I_RW_MU] + l * 896; const float* w0 = p.in[I_RW_W0] + l * 256; const float* w2 = p.in[I_RW_W2] + l * 32 * 256; const float* a0 = p.in[I_RW_A0] + l * 256;
    const float* a2 = p.in[I_RW_A2] + l * 32 * 256; const float* g2 = p.in[I_RW_G2] + l * 64 * 256; const float* kkw = p.in[I_RW_KK] + l * 256; const float* kaw = p.in[I_RW_KA] + l * 256;
    const float* rkw = p.in[I_RW_RK] + l * 256; const float* v0 = p.in[I_RW_V0]; const float* v2 = p.in[I_RW_V2];
    for (long long i = gtid; i < p.T * 4; i += gsz) { const long long t = i >> 2; const int h = (int)(i & 3); const bool first = (t % p.S) == 0;
        const bf16_t* x = P + t * PW + C_RW; const bf16_t* xp = x - PW;
#define LERP(c) (first ? bf2f(x[c]) * (1.0f - mu[c]) : (bf2f(x[c]) + (bf2f(xp[c]) - bf2f(x[c])) * mu[c]))
        float nn = 0.f;
        for (int c = h * 64; c < h * 64 + 64; ++c) { const float kq = LERP(256 + c) * kkw[c]; nn += kq * kq; }
        const float rn = 1.0f / fmaxf(sqrtf(nn), 1e-12f);
        float rks = 0.f;
        for (int cc = 0; cc < 4; ++cc) { const int c0 = h * 64 + cc * 16;
            float zw[16], za[16], zg[16], zv[16];
#pragma unroll
            for (int u = 0; u < 16; ++u) { zw[u] = w0[c0 + u]; za[u] = a0[c0 + u]; zg[u] = 0.f; zv[u] = (l == 1) ? v0[c0 + u] : 0.f; }
            for (int j = 0; j < 32; ++j) { const float tw = tanhf(LERP(768 + j)), ad = LERP(800 + j), hv = (l == 1) ? bf2f(P[t * PW + C_VRES + j]) : 0.f;
#pragma unroll
                for (int u = 0; u < 16; ++u) { zw[u] += tw * w2[j * 256 + c0 + u]; za[u] += ad * a2[j * 256 + c0 + u]; if (l == 1) zv[u] += hv * v2[j * 256 + c0 + u]; } }
            for (int j = 0; j < 64; ++j) { const float sg = sigmoidf_(LERP(832 + j));
#pragma unroll
                for (int u = 0; u < 16; ++u) zg[u] += sg * g2[j * 256 + c0 + u]; }
#pragma unroll
            for (int u = 0; u < 16; ++u) { const int c = c0 + u;
                const float wlog = -softplusf_(-zw[u]) - 0.5f, dec = expf(-expf(wlog)), a = sigmoidf_(za[u]);
                const float r = LERP(c), k = LERP(256 + c); float v = LERP(512 + c);
                if (l == 0) VF[t * 256 + c] = f2bf(v); else { const float vf = bf2f(VF[t * 256 + c]); v = v + (vf - v) * sigmoidf_(zv[u]); }
                const float kk = k * kkw[c] * rn, k2 = k * (1.0f + (a - 1.0f) * kaw[c]), bb = kk * a;
                RWW[t * 256 + c] = dec; bf16_t* rx = RWX + t * 1280 + c;
                rx[0] = f2bf(r); rx[256] = f2bf(k2); rx[512] = f2bf(v); rx[768] = f2bf(kk); rx[1024] = f2bf(bb);
                rks += bf2f(f2bf(r)) * bf2f(f2bf(k2)) * rkw[c];
                O[t * 1024 + 512 + c] = f2bf(zg[u]); } }
        RK[t * 4 + h] = rks; }
#undef LERP
}
DEVI float rwkv_row_step(float (&st)[64], const float* w, const bf16_t* r, const bf16_t* k, const bf16_t* kk, const bf16_t* b, float v) {
    float skk = 0.f;
#pragma unroll
    for (int c = 0; c < 64; ++c) skk += st[c] * bf2f(kk[c]);
    float y = 0.f;
#pragma unroll
    for (int c = 0; c < 64; ++c) { st[c] = st[c] * w[c] - skk * bf2f(b[c]) + v * bf2f(k[c]); y += st[c] * bf2f(r[c]); }
    return y;
}
DEVI void ph_gla_prep(const Params& p, int l, long long gtid, long long gsz) {
    const bf16_t* P = WSP(bf16_t, p.oP); float* GA = WSP(float, p.oGA); bf16_t* O = WSP(bf16_t, p.oO);
    const float* a2 = p.in[I_GLA_A2] + l * 16 * 128; const float* ab = p.in[I_GLA_AB] + l * 128;
    for (long long i = gtid; i < p.T * 128; i += gsz) { const long long t = i >> 7; const int c = (int)(i & 127); const bf16_t* ad = P + t * PW + C_GLA + 512;
        float z = ab[c];
        for (int j = 0; j < 16; ++j) z += bf2f(ad[j]) * a2[j * 128 + c];
        GA[i] = expf(-softplusf_(-z) * 0.0625f);
        const bf16_t* og = P + t * PW + C_GLA + 528; O[t * 1024 + 768 + c] = f2bf(siluf_(bf2f(og[c]))); O[t * 1024 + 768 + 128 + c] = f2bf(siluf_(bf2f(og[128 + c]))); }
}
DEVI float gla_col_step(float (&st)[32], const float* a, const bf16_t* q, const bf16_t* k, float v) {
    float o = 0.f;
#pragma unroll
    for (int c = 0; c < 32; ++c) { st[c] = st[c] * a[c] + bf2f(k[c]) * v; o += st[c] * bf2f(q[c]); }
    return o * 0.17677669529663687f;
}
DEVI void ph_cmp_attn(const Params& p, long long gtid, long long gsz) {
    const bf16_t* P = WSP(bf16_t, p.oP); const float* KC = WSP(float, p.oKCMP); const float* VC = WSP(float, p.oVCMP); unsigned* SELM = WSP(unsigned, p.oSELM); bf16_t* O = WSP(bf16_t, p.oO);
    for (long long i = gtid; i < p.T * 2; i += gsz) { const long long t = i >> 1, b = t / p.S, s = t % p.S; const int g = (int)(i & 1);
        const int nv = s >= 31 ? (int)((s - 31) / 16 + 1) : 0;
        const int cur = (int)(s >> 6);
        const float* kc = KC + (b * p.NC * 2 + g) * 64; const float* vc = VC + (b * p.NC * 2 + g) * 64;
        float q0[64], q1[64];
        { const bf16_t* q = P + t * PW + C_Q + (2 * g) * 64;
#pragma unroll
          for (int d = 0; d < 64; ++d) { q0[d] = bf2f(q[d]); q1[d] = bf2f(q[64 + d]); } }
        float m0 = -3e38f, m1 = -3e38f;
        for (int n = 0; n < nv; ++n) { const float* k = kc + n * 128; float s0 = 0.f, s1 = 0.f;
#pragma unroll
            for (int d = 0; d < 64; ++d) { s0 += q0[d] * k[d]; s1 += q1[d] * k[d]; }
            m0 = fmaxf(m0, s0); m1 = fmaxf(m1, s1); }
        float z0 = 0.f, z1 = 0.f;
        for (int n = 0; n < nv; ++n) { const float* k = kc + n * 128; float s0 = 0.f, s1 = 0.f;
#pragma unroll
            for (int d = 0; d < 64; ++d) { s0 += q0[d] * k[d]; s1 += q1[d] * k[d]; }
            z0 += expf(s0 - m0); z1 += expf(s1 - m1); }
        const float iz0 = nv ? 1.0f / z0 : 0.f, iz1 = nv ? 1.0f / z1 : 0.f;
        unsigned mask;
        if (cur < 8) mask = (2u << cur) - 1u;
        else {
            float tv0 = -3e38f, tv1 = -3e38f, tv2 = -3e38f, tv3 = -3e38f, tv4 = -3e38f; int ti0 = 0, ti1 = 0, ti2 = 0, ti3 = 0, ti4 = 0;
            float carry = 0.f;
            for (int j = 0; j <= cur - 2; ++j) { float imp = carry;
                for (int mm = 0; mm < 4; ++mm) { const int n = 4 * j + mm; float pn = 0.f;
                    if (n < nv) { const float* k = kc + n * 128; float s0 = 0.f, s1 = 0.f;
#pragma unroll
                        for (int d = 0; d < 64; ++d) { s0 += q0[d] * k[d]; s1 += q1[d] * k[d]; }
                        pn = expf(s0 - m0) * iz0 + expf(s1 - m1) * iz1; }
                    if (mm < 3) imp += pn; else { imp += 0.5f * pn; carry = 0.5f * pn; } }
                if (j >= 1) {
                    float v = imp; int id = j;
                    if (v > tv0) { float tf = tv0; tv0 = v; v = tf; int tt = ti0; ti0 = id; id = tt; }
                    if (v > tv1) { float tf = tv1; tv1 = v; v = tf; int tt = ti1; ti1 = id; id = tt; }
                    if (v > tv2) { float tf = tv2; tv2 = v; v = tf; int tt = ti2; ti2 = id; id = tt; }
                    if (v > tv3) { float tf = tv3; tv3 = v; v = tf; int tt = ti3; ti3 = id; id = tt; }
                    if (v > tv4) { tv4 = v; ti4 = id; } } }
            mask = 1u | (1u << cur) | (1u << (cur - 1)) | (1u << ti0) | (1u << ti1) | (1u << ti2) | (1u << ti3) | (1u << ti4);
        }
        SELM[i] = mask;
        for (int r = 0; r < 2; ++r) { const int hd = 2 * g + r; const float mr = r ? m1 : m0, izr = r ? iz1 : iz0;
            float o[64], qq[64];
            { const bf16_t* q = P + t * PW + C_Q + hd * 64;
#pragma unroll
              for (int d = 0; d < 64; ++d) { o[d] = 0.f; qq[d] = bf2f(q[d]); } }
            for (int n = 0; n < nv; ++n) { const float* k = kc + n * 128; const float* v = vc + n * 128; float sc = 0.f;
#pragma unroll
                for (int d = 0; d < 64; ++d) sc += qq[d] * k[d];
                const float pr = expf(sc - mr) * izr;
#pragma unroll
                for (int d = 0; d < 64; ++d) o[d] += pr * v[d]; }
            const float g0 = sigmoidf_(bf2f(P[t * PW + C_NG + hd * 3 + 0]));
#pragma unroll
            for (int d = 0; d < 64; ++d) O[t * 1024 + hd * 64 + d] = f2bf(g0 * o[d]); } }
}
DEVI void ph_selwin(const Params& p, long long gtid, long long gsz) {
    const bf16_t* P = WSP(bf16_t, p.oP); const unsigned* SELM = WSP(unsigned, p.oSELM); bf16_t* O = WSP(bf16_t, p.oO);
    for (long long i = gtid; i < p.T * 8; i += gsz) { const long long t = i >> 3, b = t / p.S, s = t % p.S; const int hd = (int)((i >> 1) & 3), g = hd >> 1, d0 = (int)(i & 1) * 32;
        unsigned qp[32]; float o[32];
        { const bf16_t* qq = P + t * PW + C_Q + hd * 64;
#pragma unroll
          for (int d = 0; d < 32; ++d) qp[d] = (unsigned)qq[2 * d] | ((unsigned)qq[2 * d + 1] << 16); }
        for (int pass = 0; pass < 2; ++pass) {
            const int ck = pass ? C_KW : C_KS, cv = pass ? C_VW : C_VS; const unsigned mask = SELM[t * 2 + g];
            float m = -3e38f, z = 0.f;
#pragma unroll
            for (int d = 0; d < 32; ++d) o[d] = 0.f;
            const long long lo = pass ? (s - 511 > 0 ? s - 511 : 0) : 0;
            for (long long kp = lo; kp <= s; ++kp) {
                if (!pass && !((mask >> (kp >> 6)) & 1u)) { kp |= 63; continue; }
                const bf16_t* k = P + (b * p.S + kp) * PW + ck + g * 64; const bf16_t* v = P + (b * p.S + kp) * PW + cv + g * 64 + d0; float sc = 0.f;
#pragma unroll
                for (int d = 0; d < 32; ++d) sc += u2f(qp[d] << 16) * bf2f(k[2 * d]) + u2f(qp[d] & 0xffff0000u) * bf2f(k[2 * d + 1]);
                if (sc > m) { const float f = expf(m - sc); z *= f;
#pragma unroll
                    for (int d = 0; d < 32; ++d) o[d] *= f;
                    m = sc; }
                const float pr = expf(sc - m); z += pr;
#pragma unroll
                for (int d = 0; d < 32; ++d) o[d] += pr * bf2f(v[d]); }
            const float gt = sigmoidf_(bf2f(P[t * PW + C_NG + hd * 3 + 1 + pass])) / z;
#pragma unroll
            for (int d = 0; d < 32; ++d) { bf16_t* od = O + t * 1024 + hd * 64 + d0 + d; *od = f2bf(bf2f(*od) + gt * o[d]); } } }
}
DEVI void ph_ca_attn(const Params& p, int l, long long gtid, long long gsz) {
    const bf16_t* CQ = WSP(bf16_t, p.oCQ); const bf16_t* KV = WSP(bf16_t, p.oKV) + (long long)l * 512; bf16_t* AO = WSP(bf16_t, p.oCAO);
    for (long long i = gtid; i < p.T * 4; i += gsz) { const long long t = i >> 2, b = t / p.S; const int hd = (int)(i & 3);
        float q[64], o[64];
#pragma unroll
        for (int d = 0; d < 64; ++d) { q[d] = bf2f(CQ[t * 256 + hd * 64 + d]); o[d] = 0.f; }
        float m = -3e38f, z = 0.f;
        for (int kp = 0; kp < 256; ++kp) { const bf16_t* k = KV + (b * 256 + kp) * 1024 + hd * 64; const bf16_t* v = k + 256; float sc = 0.f;
#pragma unroll
            for (int d = 0; d < 64; ++d) sc += q[d] * bf2f(k[d]);
            if (sc > m) { const float f = expf(m - sc); z *= f;
#pragma unroll
                for (int d = 0; d < 64; ++d) o[d] *= f;
                m = sc; }
            const float pr = expf(sc - m); z += pr;
#pragma unroll
            for (int d = 0; d < 64; ++d) o[d] += pr * bf2f(v[d]); }
        const float iz = 1.0f / z;
#pragma unroll
        for (int d = 0; d < 64; ++d) AO[t * 256 + hd * 64 + d] = f2bf(o[d] * iz); }
}
DEVI void ph_moe_count(const Params& p, long long gtid, long long gsz) {
    const int* TE = WSP(int, p.oTOKE); int* CC = WSP(int, p.oCCNT); int* R2T = WSP(int, p.oR2T);
    for (long long c = gtid; c < p.T / 64; c += gsz) { int cnt[8] = {0, 0, 0, 0, 0, 0, 0, 0};
        for (int j = 0; j < 128; ++j) { const int e = TE[c * 128 + j];
#pragma unroll
            for (int q = 0; q < 8; ++q) cnt[q] += (e == q); }
#pragma unroll
        for (int q = 0; q < 8; ++q) CC[c * 8 + q] = cnt[q]; }
    for (long long i = gtid; i < p.NR; i += gsz) R2T[i] = -1;
}
DEVI void ph_moe_offsets(const Params& p, long long gtid, long long gsz) {
    const int* CC = WSP(int, p.oCCNT); int* CO = WSP(int, p.oCOFF); int* MC = WSP(int, p.oMOEC);
    for (long long ee = gtid; ee < 8; ee += gsz) { const int e = (int)ee; int run = 0; for (long long c = 0; c < p.T / 64; ++c) { CO[c * 8 + e] = run; run += CC[c * 8 + e]; } MC[e] = run; }
}
DEVI void moe_bases(const Params& p, int (&base)[9]) { const int* MC = WSP(int, p.oMOEC); int run = 0;
#pragma unroll
    for (int e = 0; e < 8; ++e) { base[e] = run; run += (MC[e] + 255) & ~255; } base[8] = run; }
DEVI void ph_moe_assign(const Params& p, long long gtid, long long gsz) {
    const int* TE = WSP(int, p.oTOKE); const float* TW = WSP(float, p.oTOKW); const int* CO = WSP(int, p.oCOFF); int* TS = WSP(int, p.oTOKS); int* R2T = WSP(int, p.oR2T); float* RW = WSP(float, p.oROWW);
    int base[9]; moe_bases(p, base);
    if (gtid == 0) { int* MC = WSP(int, p.oMOEC);
#pragma unroll
        for (int e = 0; e < 9; ++e) MC[16 + e] = base[e]; }
    for (long long c = gtid; c < p.T / 64; c += gsz) { int run[8];
#pragma unroll
        for (int q = 0; q < 8; ++q) run[q] = base[q] + CO[c * 8 + q];
        for (int j = 0; j < 128; ++j) { const int e = TE[c * 128 + j]; int slot = 0;
#pragma unroll
            for (int q = 0; q < 8; ++q) if (e == q) { slot = run[q]; run[q] += 1; }
            TS[c * 128 + j] = slot; R2T[slot] = (int)(c * 64 + (j >> 1)); RW[slot] = TW[c * 128 + j]; } }
}
DEVI void ph_moe_gather(const Params& p, long long gtid, long long gsz) {
    const int* R2T = WSP(int, p.oR2T); const int* MC = WSP(int, p.oMOEC); const uint4* H = WSP(uint4, p.oH); uint4* HS = WSP(uint4, p.oHS);
    const long long rows = MC[16 + 8];
    for (long long i = gtid; i < rows * 128; i += gsz) { const long long r = i >> 7; const int j = (int)(i & 127); const int t = R2T[r];
        uint4 v; v.x = v.y = v.z = v.w = 0u; if (t >= 0) v = H[(long long)t * 128 + j]; HS[i] = v; }
}
struct Unit { int pm, pn, aux, pad; long long aoff, boff; };
constexpr int NXCD = 8, WGM = 8;
DEVI void tile_order(long long L, int nM, int nN, int& pm, int& pn) {
    const int nwg = nM * nN; int wgid = (int)L; { const int q = nwg / NXCD, r = nwg % NXCD, xcd = wgid % NXCD, off = wgid / NXCD; wgid = (xcd < r ? xcd * (q + 1) : r * (q + 1) + (xcd - r) * q) + off; }
    const int nig = WGM * nN, gid = wgid / nig, fm = gid * WGM, gsz = (nM - fm) < WGM ? (nM - fm) : WGM;
    pm = fm + ((wgid % nig) % gsz); pn = (wgid % nig) / gsz;
}
struct SchedPlain {
    int nM, nN, G, c; long long lda, ldb;
    DEVM void init(long long M, long long N, long long lda_, long long ldb_, int G_, int c_) { nM = (int)(M / 256); nN = (int)(N / 256); lda = lda_; ldb = ldb_; G = G_; c = c_; }
    DEVM bool next(int i, Unit& u) const { const long long L = (long long)i * G + c; if (L >= (long long)nM * nN) return false; tile_order(L, nM, nN, u.pm, u.pn); u.aux = 0; u.pad = 0;
        u.aoff = (long long)u.pm * 256 * lda * 2; u.boff = (long long)u.pn * 256 * ldb * 2; return true; }
    DEVM void a_ready(const Unit&) const {}
    DEVM void done(const Unit&) const {}
};
struct SchedBranch {
    int nM, G, c;
    DEVM void init(long long M, int G_, int c_) { nM = (int)(M / 256); G = G_; c = c_; }
    DEVM bool next(int i, Unit& u) const { const long long L = (long long)i * G + c; if (L >= (long long)nM * 16) return false; tile_order(L, nM, 16, u.pm, u.pn); u.aux = u.pn >> 2; u.pad = 0;
        u.aoff = (long long)u.pm * 256 * 1024 * 2 + (long long)u.aux * 256 * 2; u.boff = (long long)u.pn * 256 * 256 * 2; return true; }
    DEVM void a_ready(const Unit&) const {}
    DEVM void done(const Unit&) const {}
};
struct SchedGate {
    int nM, G, c;
    DEVM void init(long long M, int G_, int c_) { nM = (int)(M / 256); G = G_; c = c_; }
    DEVM bool next(int i, Unit& u) const { const long long tile = (long long)(i >> 2) * G + c; if (tile >= (long long)nM * 4) return false; tile_order(tile, nM, 4, u.pm, u.pn); u.aux = i & 3; u.pad = 0;
        u.aoff = (long long)u.pm * 256 * 1024 * 2; u.boff = (long long)(u.aux * 4 + u.pn) * 256 * 1024 * 2; return true; }
    DEVM void a_ready(const Unit&) const {}
    DEVM void done(const Unit&) const {}
};
struct SchedMoe {
    int t0, t1, nN, G, c; long long lda, ldb, per_e; int base[9];
    DEVM bool next(int i, Unit& u) const { const long long L = (long long)i * G + c; if (L >= (long long)(t1 - t0) * nN) return false; u.pm = t0 + (int)(L / nN); u.pn = (int)(L % nN); u.pad = 0;
        int e = 0;
#pragma unroll
        for (int q = 1; q < 8; ++q) e += (u.pm * 256 >= base[q]) ? 1 : 0;
        u.aux = e; u.aoff = (long long)u.pm * 256 * lda * 2; u.boff = (long long)e * per_e + (long long)u.pn * 256 * ldb * 2; return true; }
    DEVM void a_ready(const Unit&) const {}
    DEVM void done(const Unit&) const {}
};
DEVI void st8(bf16_t* dst, const float* v) {
#ifndef CPU_EMU
    uint4 w; w.x = (unsigned)f2bf(v[0]) | ((unsigned)f2bf(v[1]) << 16); w.y = (unsigned)f2bf(v[2]) | ((unsigned)f2bf(v[3]) << 16); w.z = (unsigned)f2bf(v[4]) | ((unsigned)f2bf(v[5]) << 16); w.w = (unsigned)f2bf(v[6]) | ((unsigned)f2bf(v[7]) << 16);
    *(uint4*)dst = w;
#else
    for (int j = 0; j < 8; ++j) dst[j] = f2bf(v[j]);
#endif
}
DEVI void ld8(const bf16_t* src, float* v) {
#ifndef CPU_EMU
    const uint4 w = *(const uint4*)src; v[0] = u2f(w.x << 16); v[1] = u2f(w.x & 0xffff0000u); v[2] = u2f(w.y << 16); v[3] = u2f(w.y & 0xffff0000u); v[4] = u2f(w.z << 16); v[5] = u2f(w.z & 0xffff0000u); v[6] = u2f(w.w << 16); v[7] = u2f(w.w & 0xffff0000u);
#else
    for (int j = 0; j < 8; ++j) v[j] = bf2f(src[j]);
#endif
}
struct EpStore {
    bf16_t* O; long long ldo; float scale;
    DEVM void apply(const Unit& u, long long row, int c8, const float* lo, const float* hi) const { float a[8], b[8];
#pragma unroll
        for (int j = 0; j < 8; ++j) { a[j] = lo[j] * scale; b[j] = hi[j] * scale; }
        bf16_t* d = O + row * ldo + u.pn * 256 + c8; st8(d, a); st8(d + 128, b); }
};
struct EpGate {
    const bf16_t* BO; const float* bias; bf16_t* MG; long long row0;
    DEVM void apply(const Unit& u, long long row, int c8, const float* lo, const float* hi) const {
#pragma unroll
        for (int hh = 0; hh < 2; ++hh) { const float* v = hh ? hi : lo; const int c = u.pn * 256 + hh * 128 + c8, n = u.aux * 1024 + c; float bo[8], mg[8], r[8]; ld8(BO + row * 4096 + n, bo);
            bf16_t* m = MG + (row0 + row) * 1024 + c;
            if (u.aux) ld8(m, mg);
#pragma unroll
            for (int j = 0; j < 8; ++j) { r[j] = sigmoidf_(v[j] + bias[n + j]) * bo[j]; if (u.aux) r[j] += mg[j]; }
            st8(m, r); } }
};
struct EpResid {
    float* X;
    DEVM void apply(const Unit& u, long long row, int c8, const float* lo, const float* hi) const { float* x = X + row * 1024 + u.pn * 256 + c8;
#ifndef CPU_EMU
        float4 a = *(float4*)x, b = *(float4*)(x + 4), c = *(float4*)(x + 128), d = *(float4*)(x + 132);
        a.x += lo[0]; a.y += lo[1]; a.z += lo[2]; a.w += lo[3]; b.x += lo[4]; b.y += lo[5]; b.z += lo[6]; b.w += lo[7];
        c.x += hi[0]; c.y += hi[1]; c.z += hi[2]; c.w += hi[3]; d.x += hi[4]; d.y += hi[5]; d.z += hi[6]; d.w += hi[7];
        *(float4*)x = a; *(float4*)(x + 4) = b; *(float4*)(x + 128) = c; *(float4*)(x + 132) = d;
#else
        for (int j = 0; j < 8; ++j) { x[j] += lo[j]; x[128 + j] += hi[j]; }
#endif
    }
};
struct EpSwiglu {
    bf16_t* ACT; long long ldo; long long row0;
    DEVM void apply(const Unit& u, long long row, int c8, const float* lo, const float* hi) const { float r[8];
#pragma unroll
        for (int j = 0; j < 8; ++j) r[j] = siluf_(lo[j]) * hi[j];
        st8(ACT + (row - row0) * ldo + u.pn * 128 + c8, r); }
};
struct EpMoeDown {
    bf16_t* Y; const float* roww;
    DEVM void apply(const Unit& u, long long row, int c8, const float* lo, const float* hi) const { const float w = roww[row]; float a[8], b[8];
#pragma unroll
        for (int j = 0; j < 8; ++j) { a[j] = lo[j] * w; b[j] = hi[j] * w; }
        bf16_t* d = Y + row * 1024 + u.pn * 256 + c8; st8(d, a); st8(d + 128, b); }
};

#ifdef CPU_EMU
template <class Sched, class Epi> static void gemm_cpu(const bf16_t* A, long long lda, const bf16_t* Bt, long long ldb, long long K, const Sched& S, const Epi& E) {
    Unit u;
    for (int i = 0; S.next(i, u); ++i) {
        const bf16_t* a0 = (const bf16_t*)((const char*)A + u.aoff); const bf16_t* b0 = (const bf16_t*)((const char*)Bt + u.boff);
#pragma omp parallel for
        for (int r = 0; r < 256; ++r) { float arow[4096]; for (long long k = 0; k < K; ++k) arow[k] = bf2f(a0[r * lda + k]);
            for (int c8 = 0; c8 < 128; c8 += 8) { float lo[8], hi[8];
                for (int j = 0; j < 8; ++j) { const bf16_t* bl = b0 + (c8 + j) * ldb; const bf16_t* bh = b0 + (128 + c8 + j) * ldb; float s0 = 0.f, s1 = 0.f;
                    for (long long k = 0; k < K; ++k) { s0 += arow[k] * bf2f(bl[k]); s1 += arow[k] * bf2f(bh[k]); } lo[j] = s0; hi[j] = s1; }
                E.apply(u, (long long)u.pm * 256 + r, c8, lo, hi); } } }
}
#endif

#ifndef CPU_EMU
DEVI float wave_sum(float v) {
#pragma unroll
    for (int o = 32; o > 0; o >>= 1) v += __shfl_xor(v, o);
    return v; }
DEVI void row_load(const float* src, float (&v)[16], int lane) {
#pragma unroll
    for (int j = 0; j < 4; ++j) { const float4 f = *(const float4*)(src + j * 256 + lane * 4); v[4 * j] = f.x; v[4 * j + 1] = f.y; v[4 * j + 2] = f.z; v[4 * j + 3] = f.w; } }
DEVI void row_store_bf16(bf16_t* dst, const float (&v)[16], int lane) {
#pragma unroll
    for (int j = 0; j < 4; ++j) { uint2 w; w.x = (unsigned)f2bf(v[4 * j]) | ((unsigned)f2bf(v[4 * j + 1]) << 16); w.y = (unsigned)f2bf(v[4 * j + 2]) | ((unsigned)f2bf(v[4 * j + 3]) << 16); *(uint2*)(dst + j * 256 + lane * 4) = w; } }
#endif
DEVI void ph_rmsnorm(const Params& p, const float* src, long long rows, const float* gain, bf16_t* dst, int mode, float* xcopy, long long gw, long long nw, int lane) {
    const float* router = p.in[I_MOE_R]; int* TE = WSP(int, p.oTOKE); float* TW = WSP(float, p.oTOKW);
#ifndef CPU_EMU
    for (long long r = gw; r < rows; r += nw) { float v[16], g[16]; row_load(src + r * 1024, v, lane); row_load(gain, g, lane);
        float ss = 0.f;
#pragma unroll
        for (int j = 0; j < 16; ++j) ss += v[j] * v[j];
        ss = wave_sum(ss); const float rs = rsqrtf(ss * (1.0f / 1024.0f) + 1e-6f);
        if (mode == 1) {
#pragma unroll
            for (int j = 0; j < 4; ++j) *(float4*)(xcopy + r * 1024 + j * 256 + lane * 4) = make_float4(v[4 * j], v[4 * j + 1], v[4 * j + 2], v[4 * j + 3]); }
#pragma unroll
        for (int j = 0; j < 16; ++j) v[j] = v[j] * rs * g[j];
        row_store_bf16(dst + r * 1024, v, lane);
        if (mode == 2) { float lg[8];
#pragma unroll
            for (int e = 0; e < 8; ++e) { float a = 0.f;
#pragma unroll
                for (int j = 0; j < 16; ++j) a += v[j] * router[(long long)((j >> 2) * 256 + lane * 4 + (j & 3)) * 8 + e];
                lg[e] = wave_sum(a); }
            int i0 = 0; float v0 = lg[0];
#pragma unroll
            for (int e = 1; e < 8; ++e) if (lg[e] > v0) { v0 = lg[e]; i0 = e; }
            int i1 = -1; float v1 = -3e38f;
#pragma unroll
            for (int e = 0; e < 8; ++e) if (e != i0 && lg[e] > v1) { v1 = lg[e]; i1 = e; }
            const float w0 = 1.0f / (1.0f + expf(v1 - v0));
            if (lane == 0) { TE[r * 2] = i0; TE[r * 2 + 1] = i1; TW[r * 2] = w0; TW[r * 2 + 1] = 1.0f - w0; } } }
#else
    (void)lane;
    for (long long r = gw; r < rows; r += nw) { const float* x = src + r * 1024; float ss = 0.f; for (int c = 0; c < 1024; ++c) ss += x[c] * x[c];
        const float rs = 1.0f / sqrtf(ss / 1024.0f + 1e-6f); float hv[1024];
        for (int c = 0; c < 1024; ++c) { hv[c] = x[c] * rs * gain[c]; dst[r * 1024 + c] = f2bf(hv[c]); if (mode == 1) xcopy[r * 1024 + c] = x[c]; }
        if (mode == 2) { float lg[8]; for (int e = 0; e < 8; ++e) { float a = 0.f; for (int c = 0; c < 1024; ++c) a += hv[c] * router[c * 8 + e]; lg[e] = a; }
            int i0 = 0; float v0 = lg[0]; for (int e = 1; e < 8; ++e) if (lg[e] > v0) { v0 = lg[e]; i0 = e; }
            int i1 = -1; float v1 = -3e38f; for (int e = 0; e < 8; ++e) if (e != i0 && lg[e] > v1) { v1 = lg[e]; i1 = e; }
            const float w0 = 1.0f / (1.0f + expf(v1 - v0)); TE[r * 2] = i0; TE[r * 2 + 1] = i1; TW[r * 2] = w0; TW[r * 2 + 1] = 1.0f - w0; } }
#endif
}
DEVI void ph_final(const Params& p, long long gw, long long nw, int lane) {
    const int* TS = WSP(int, p.oTOKS); const bf16_t* Y = WSP(bf16_t, p.oY); const float* gain = p.in[I_NORM_FINAL]; float* X = p.out;
#ifndef CPU_EMU
    for (long long r = gw; r < p.T; r += nw) { float v[16], g[16]; row_load(X + r * 1024, v, lane); row_load(gain, g, lane);
        const bf16_t* y0 = Y + (long long)TS[r * 2] * 1024; const bf16_t* y1 = Y + (long long)TS[r * 2 + 1] * 1024;
#pragma unroll
        for (int j = 0; j < 4; ++j) { const uint2 a = *(const uint2*)(y0 + j * 256 + lane * 4), b = *(const uint2*)(y1 + j * 256 + lane * 4);
            v[4 * j] += u2f(a.x << 16) + u2f(b.x << 16); v[4 * j + 1] += u2f(a.x & 0xffff0000u) + u2f(b.x & 0xffff0000u); v[4 * j + 2] += u2f(a.y << 16) + u2f(b.y << 16); v[4 * j + 3] += u2f(a.y & 0xffff0000u) + u2f(b.y & 0xffff0000u); }
        float ss = 0.f;
#pragma unroll
        for (int j = 0; j < 16; ++j) ss += v[j] * v[j];
        ss = wave_sum(ss); const float rs = rsqrtf(ss * (1.0f / 1024.0f) + 1e-6f);
#pragma unroll
        for (int j = 0; j < 4; ++j) *(float4*)(X + r * 1024 + j * 256 + lane * 4) = make_float4(v[4 * j] * rs * g[4 * j], v[4 * j + 1] * rs * g[4 * j + 1], v[4 * j + 2] * rs * g[4 * j + 2], v[4 * j + 3] * rs * g[4 * j + 3]); }
#else
    (void)lane;
    for (long long r = gw; r < p.T; r += nw) { float v[1024]; float ss = 0.f; const bf16_t* y0 = Y + (long long)TS[r * 2] * 1024; const bf16_t* y1 = Y + (long long)TS[r * 2 + 1] * 1024;
        for (int c = 0; c < 1024; ++c) { v[c] = X[r * 1024 + c] + bf2f(y0[c]) + bf2f(y1[c]); ss += v[c] * v[c]; }
        const float rs = 1.0f / sqrtf(ss / 1024.0f + 1e-6f); for (int c = 0; c < 1024; ++c) X[r * 1024 + c] = v[c] * rs * gain[c]; }
#endif
}
DEVI void ph_rwkv_scan(const Params& p, int l, long long gw, long long nw, int lane) {
    const float* RWW = WSP(float, p.oRWW); const bf16_t* RWX = WSP(bf16_t, p.oRWX); const float* RK = WSP(float, p.oRK); bf16_t* O = WSP(bf16_t, p.oO); const float* lng = p.in[I_RW_LN] + l * 256;
    for (long long ch = gw; ch < p.B * 4; ch += nw) { const long long b = ch >> 2; const int h = (int)(ch & 3);
#ifndef CPU_EMU
        float st[64];
#pragma unroll
        for (int c = 0; c < 64; ++c) st[c] = 0.f;
        for (long long s = 0; s < p.S; ++s) { const long long t = b * p.S + s; const bf16_t* rx = RWX + t * 1280 + h * 64; const float v = bf2f(rx[512 + lane]);
            const float y = rwkv_row_step(st, RWW + t * 256 + h * 64, rx, rx + 256, rx + 768, rx + 1024, v);
            const float mean = wave_sum(y) * (1.0f / 64.0f), dy = y - mean, var = wave_sum(dy * dy) * (1.0f / 64.0f);
            const float yn = dy * rsqrtf(var + 64e-5f) * lng[h * 64 + lane] + RK[t * 4 + h] * v;
            bf16_t* o = O + t * 1024 + 512 + h * 64 + lane; *o = f2bf(yn * bf2f(*o)); }
#else
        (void)lane;
        static float st[64][64]; for (int v = 0; v < 64; ++v) for (int c = 0; c < 64; ++c) st[v][c] = 0.f;
        for (long long s = 0; s < p.S; ++s) { const long long t = b * p.S + s; const bf16_t* rx = RWX + t * 1280 + h * 64; float y[64], mean = 0.f, var = 0.f;
            for (int v = 0; v < 64; ++v) { y[v] = rwkv_row_step(st[v], RWW + t * 256 + h * 64, rx, rx + 256, rx + 768, rx + 1024, bf2f(rx[512 + v])); mean += y[v]; }
            mean /= 64.f; for (int v = 0; v < 64; ++v) var += (y[v] - mean) * (y[v] - mean); var /= 64.f;
            for (int v = 0; v < 64; ++v) { const float yn = (y[v] - mean) / sqrtf(var + 64e-5f) * lng[h * 64 + v] + RK[t * 4 + h] * bf2f(rx[512 + v]);
                bf16_t* o = O + t * 1024 + 512 + h * 64 + v; *o = f2bf(yn * bf2f(*o)); } }
#endif
    }
}
DEVI void ph_gla_scan(const Params& p, int l, long long gw, long long nw, int lane) {
    const bf16_t* P = WSP(bf16_t, p.oP); const float* GA = WSP(float, p.oGA); bf16_t* O = WSP(bf16_t, p.oO); const float* ng = p.in[I_GLA_NORM] + l * 64;
    for (long long ch = gw; ch < p.B * 4; ch += nw) { const long long b = ch >> 2; const int h = (int)(ch & 3);
#ifndef CPU_EMU
        float st[32];
#pragma unroll
        for (int c = 0; c < 32; ++c) st[c] = 0.f;
        for (long long s = 0; s < p.S; ++s) { const long long t = b * p.S + s; const bf16_t* x = P + t * PW + C_GLA;
            const float o = gla_col_step(st, GA + t * 128 + h * 32, x + h * 32, x + 128 + h * 32, bf2f(x[256 + h * 64 + lane]));
            const float ms = wave_sum(o * o) * (1.0f / 64.0f), on = o * rsqrtf(ms + 1e-6f) * ng[lane];
            bf16_t* d = O + t * 1024 + 768 + h * 64 + lane; *d = f2bf(on * bf2f(*d)); }
#else
        (void)lane;
        static float st[64][32]; for (int v = 0; v < 64; ++v) for (int c = 0; c < 32; ++c) st[v][c] = 0.f;
        for (long long s = 0; s < p.S; ++s) { const long long t = b * p.S + s; const bf16_t* x = P + t * PW + C_GLA; float o[64], ms = 0.f;
            for (int v = 0; v < 64; ++v) { o[v] = gla_col_step(st[v], GA + t * 128 + h * 32, x + h * 32, x + 128 + h * 32, bf2f(x[256 + h * 64 + v])); ms += o[v] * o[v]; }
            ms /= 64.f;
            for (int v = 0; v < 64; ++v) { bf16_t* d = O + t * 1024 + 768 + h * 64 + v; *d = f2bf(o[v] / sqrtf(ms + 1e-6f) * ng[v] * bf2f(*d)); } }
#endif
    }
}
#ifndef CPU_EMU
#define LAS __attribute__((address_space(3)))
typedef short bf16x8 __attribute__((ext_vector_type(8)));
typedef float f32x4 __attribute__((ext_vector_type(4)));
constexpr int HALF = 128, BK = 64, HTB = HALF * BK * 2, STAGE_BYTES = 8 * HTB;
__device__ __forceinline__ int lds_byte(int r, int c) { const int st = (r >> 4) * 2 + (c >> 5), rr = r & 15, cc = c & 31, ob = rr * 64 + cc * 2; return st * 1024 + (ob ^ (((ob >> 9) & 1) << 5)); }
__device__ __forceinline__ void stage_rc(int b, int& R, int& C) { const int st = b / 1024, sb = b % 1024, swz = sb ^ (((sb >> 9) & 1) << 5); R = (st >> 1) * 16 + swz / 64; C = (st & 1) * 32 + (swz % 64) / 2; }
__device__ __forceinline__ int perm32(int rho) { const int n = rho >> 4, i = rho & 15; return 8 * (i >> 2) + 4 * n + (i & 3); }

template <class Epi, class Sched>
__device__ __forceinline__ void gemm_phase(LAS unsigned char* lds, const bf16_t* A, long long lda, const bf16_t* Bt, long long ldb, long long K, const Sched& S, const Epi& E) {
    int tid = threadIdx.x; asm volatile("" : "+v"(tid));
    const int wid = __builtin_amdgcn_readfirstlane(tid >> 6), lane = tid & 63, wr = wid >> 2, wc = wid & 3, fr = lane & 15, fq = lane >> 4;
    { unsigned long long a_ = (unsigned long long)A, b_ = (unsigned long long)Bt; unsigned alo = __builtin_amdgcn_readfirstlane((unsigned)a_), ahi = __builtin_amdgcn_readfirstlane((unsigned)(a_ >> 32)),
        blo = __builtin_amdgcn_readfirstlane((unsigned)b_), bhi = __builtin_amdgcn_readfirstlane((unsigned)(b_ >> 32));
      int lda_ = __builtin_amdgcn_readfirstlane((int)lda), ldb_ = __builtin_amdgcn_readfirstlane((int)ldb), k_ = __builtin_amdgcn_readfirstlane((int)K);
      asm volatile("" : "+s"(alo), "+s"(ahi), "+s"(blo), "+s"(bhi), "+s"(lda_), "+s"(ldb_), "+s"(k_));
      A = (const bf16_t*)(((unsigned long long)ahi << 32) | alo); Bt = (const bf16_t*)(((unsigned long long)bhi << 32) | blo); lda = lda_; ldb = ldb_; K = k_; }
    const int nt = (int)(K / BK);
    unsigned voffA[2], voffB[2];
#pragma unroll
    for (int i = 0; i < 2; ++i) { int R, C; stage_rc(tid * 16 + i * 8192, R, C); const int Rb = (R & ~31) + perm32(R & 31);
        voffA[i] = (unsigned)(R * (int)lda + C) * 2u; voffB[i] = (unsigned)(Rb * (int)ldb + C) * 2u; }
    const size_t kstep = (size_t)(BK * 2);
    const size_t hstepA = (size_t)HALF * lda * 2, hstepB = (size_t)HALF * ldb * 2;
    const unsigned ldsw = (unsigned)wid * 1024u;
    const int aoff = lds_byte(wr * 64 + fr, fq * 8), boff = lds_byte(wc * 32 + fr, fq * 8);
#define PG8_SA(b, h) (((b) * 2 + (h)) * HTB)
#define PG8_SB(b, h) ((4 + (b) * 2 + (h)) * HTB)
#define PG8_STAGE(bufoff, gbase, voff) do { _Pragma("unroll") for (int _i = 0; _i < 2; ++_i) \
        __builtin_amdgcn_global_load_lds((const unsigned*)((const char*)(gbase) + (voff)[_i]), (LAS unsigned*)(lds + (bufoff) + ldsw + _i * 8192), 16, 0, 0); } while (0)
#define PG8_LDA(dst, b, h) do { _Pragma("unroll") for (int m = 0; m < 4; ++m) _Pragma("unroll") for (int k = 0; k < 2; ++k) dst[m][k] = *(const LAS bf16x8*)(lds + PG8_SA(b, h) + aoff + m * 2048 + k * 1024); } while (0)
#define PG8_LDB(dst, b, h) do { _Pragma("unroll") for (int n = 0; n < 2; ++n) _Pragma("unroll") for (int k = 0; k < 2; ++k) dst[n][k] = *(const LAS bf16x8*)(lds + PG8_SB(b, h) + boff + n * 2048 + k * 1024); } while (0)
#define PG8_MMA(ai, bj, At, Bt_) do { __builtin_amdgcn_s_setprio(1); _Pragma("unroll") for (int m = 0; m < 4; ++m) _Pragma("unroll") for (int n = 0; n < 2; ++n) _Pragma("unroll") for (int k = 0; k < 2; ++k) \
        acc[ai][bj][m][n] = __builtin_amdgcn_mfma_f32_16x16x32_bf16(Bt_[n][k], At[m][k], acc[ai][bj][m][n], 0, 0, 0); __builtin_amdgcn_s_setprio(0); } while (0)
#define PG8_WAIT_V(n) asm volatile("s_waitcnt vmcnt(" #n ")" ::: "memory")
#define PG8_WAIT_L(n) asm volatile("s_waitcnt lgkmcnt(" #n ")" ::: "memory")
#define PG8_BAR __builtin_amdgcn_s_barrier()
#define PG8_SCHED __builtin_amdgcn_sched_barrier(0)
    Unit cur, nxt; int ui = 0;
    if (!S.next(0, cur)) return;
    f32x4 acc[2][2][4][2];
#pragma unroll
    for (int a = 0; a < 2; ++a)
#pragma unroll
        for (int b = 0; b < 2; ++b)
#pragma unroll
            for (int m = 0; m < 4; ++m)
#pragma unroll
                for (int n = 0; n < 2; ++n) acc[a][b][m][n] = (f32x4){0.f, 0.f, 0.f, 0.f};
    bf16x8 At[4][2], B0[2][2], B1[2][2];
    const char* cA = (const char*)A + cur.aoff; const char* cB = (const char*)Bt + cur.boff;
    S.a_ready(cur);
    PG8_STAGE(PG8_SB(0, 0), cB, voffB); PG8_STAGE(PG8_SA(0, 0), cA, voffA); PG8_STAGE(PG8_SB(0, 1), cB + hstepB, voffB); PG8_STAGE(PG8_SA(0, 1), cA + hstepA, voffA);
    if (wr == 1) PG8_BAR;
    PG8_WAIT_V(4); PG8_BAR;
    PG8_STAGE(PG8_SB(1, 0), cB + kstep, voffB); PG8_STAGE(PG8_SA(1, 0), cA + kstep, voffA); PG8_STAGE(PG8_SB(1, 1), cB + hstepB + kstep, voffB);
    PG8_WAIT_V(6); PG8_BAR;
    for (;;) {
        const bool has_next = S.next(ui + 1, nxt);
        const char* nA = has_next ? (const char*)A + nxt.aoff : cA; const char* nB = has_next ? (const char*)Bt + nxt.boff : cB;
#pragma nounroll
        for (int t = 0; t < nt; t += 2) {
            const bool last = (t == nt - 2);
            const char* a1 = cA + (size_t)(t + 1) * kstep;
            const char* a2 = last ? nA : cA + (size_t)(t + 2) * kstep; const char* b2 = last ? nB : cB + (size_t)(t + 2) * kstep;
            const char* a3 = a2 + kstep; const char* b3 = b2 + kstep;
            if (last && has_next) S.a_ready(nxt);
            PG8_LDB(B0, 0, 0); PG8_SCHED; PG8_LDA(At, 0, 0); PG8_STAGE(PG8_SA(1, 1), a1 + hstepA, voffA);
            PG8_WAIT_L(8); PG8_BAR; PG8_WAIT_L(0); PG8_MMA(0, 0, At, B0); PG8_BAR; PG8_SCHED;
            PG8_LDB(B1, 0, 1); PG8_STAGE(PG8_SB(0, 0), b2, voffB);
            PG8_BAR; PG8_WAIT_L(0); PG8_MMA(0, 1, At, B1); PG8_BAR;
            PG8_LDA(At, 0, 1); PG8_STAGE(PG8_SA(0, 0), a2, voffA);
            PG8_BAR; PG8_WAIT_L(0); PG8_MMA(1, 0, At, B0); PG8_BAR; PG8_SCHED;
            PG8_STAGE(PG8_SB(0, 1), b2 + hstepB, voffB);
            PG8_WAIT_V(6); PG8_BAR; PG8_MMA(1, 1, At, B1); PG8_BAR;
            PG8_LDB(B0, 1, 0); PG8_SCHED; PG8_LDA(At, 1, 0); PG8_STAGE(PG8_SA(0, 1), a2 + hstepA, voffA);
            PG8_WAIT_L(8); PG8_BAR; PG8_WAIT_L(0); PG8_MMA(0, 0, At, B0); PG8_BAR; PG8_SCHED;
            PG8_LDB(B1, 1, 1); PG8_STAGE(PG8_SB(1, 0), b3, voffB);
            PG8_BAR; PG8_WAIT_L(0); PG8_MMA(0, 1, At, B1); PG8_BAR;
            PG8_LDA(At, 1, 1); PG8_STAGE(PG8_SA(1, 0), a3, voffA);
            PG8_BAR; PG8_WAIT_L(0); PG8_MMA(1, 0, At, B0); PG8_BAR; PG8_SCHED;
            PG8_STAGE(PG8_SB(1, 1), b3 + hstepB, voffB);
            PG8_WAIT_V(6); PG8_BAR; PG8_MMA(1, 1, At, B1); PG8_BAR;
        }
#pragma unroll
        for (int ai = 0; ai < 2; ++ai)
#pragma unroll
            for (int m = 0; m < 4; ++m) { float lo[8], hi[8];
#pragma unroll
                for (int j = 0; j < 8; ++j) { lo[j] = acc[ai][0][m][j >> 2][j & 3]; hi[j] = acc[ai][1][m][j >> 2][j & 3]; }
                E.apply(cur, (long long)cur.pm * 256 + ai * HALF + wr * 64 + m * 16 + fr, wc * 32 + 8 * fq, lo, hi); PG8_SCHED; }
        S.done(cur);
        if (!has_next) break;
#pragma unroll
        for (int a = 0; a < 2; ++a)
#pragma unroll
            for (int b = 0; b < 2; ++b)
#pragma unroll
                for (int m = 0; m < 4; ++m)
#pragma unroll
                    for (int n = 0; n < 2; ++n) acc[a][b][m][n] = (f32x4){0.f, 0.f, 0.f, 0.f};
        cur = nxt; cA = nA; cB = nB; ++ui;
    }
    PG8_WAIT_V(0);
    if (wr == 0) PG8_BAR;
    PG8_BAR;
#undef PG8_SA
#undef PG8_SB
#undef PG8_STAGE
#undef PG8_LDA
#undef PG8_LDB
#undef PG8_MMA
#undef PG8_WAIT_V
#undef PG8_WAIT_L
#undef PG8_BAR
#undef PG8_SCHED
}

#define XB_TMO      128
#define XB_XCNT(j)  (256  + 64 * (j))
#define XB_XSUB(j)  (1280 + 64 * (j))
#define XB_XGEN(j)  (2304 + 64 * (j))
#define XB_TOP      3328
#define XB_TOPGEN   3392
#define XCD_BAR_WORDS 3456
#define XB_SPIN_CAP (1u << 18)
__device__ __forceinline__ unsigned xb_ld(unsigned* p)              { return __hip_atomic_load(p, __ATOMIC_RELAXED, __HIP_MEMORY_SCOPE_AGENT); }
__device__ __forceinline__ unsigned xb_add(unsigned* p, unsigned v) { return __hip_atomic_fetch_add(p, v, __ATOMIC_RELAXED, __HIP_MEMORY_SCOPE_AGENT); }
__device__ __forceinline__ unsigned xb_xcc_id() { return (unsigned)__builtin_amdgcn_s_getreg((3 << 11) | 20) & 0xFu; }
#define XB_SPIN(cond, bar) do { unsigned _sp = 0; while (cond) { __builtin_amdgcn_s_sleep(1); \
    if ((++_sp & 255u) == 0u) { if (xb_ld(&(bar)[XB_TMO])) break; if (_sp > XB_SPIN_CAP) { atomicAdd(&(bar)[XB_TMO], 1u); break; } } } } while (0)
struct XcdBarrier { unsigned* bar; unsigned x; volatile LAS unsigned* st; };
__device__ __forceinline__ XcdBarrier xcd_barrier_post(unsigned* bar, volatile LAS unsigned* st) {
    XcdBarrier b; b.bar = bar; b.x = xb_xcc_id(); b.st = st;
    if (threadIdx.x == 0) (void)xb_add(&bar[XB_XCNT(b.x)], 1u);
    return b;
}
__device__ __forceinline__ void xcd_barrier_complete(unsigned* bar, unsigned x, unsigned& nloc, unsigned& nx) {
    const unsigned G = gridDim.x * gridDim.y * gridDim.z;
    unsigned sum, cnt, mine, sp = 0u;
    for (;;) {
        sum = 0u; cnt = 0u; mine = 0u;
#pragma unroll
        for (unsigned j = 0; j < 16; ++j) { const unsigned c = xb_ld(&bar[XB_XCNT(j)]); sum += c; cnt += (c > 0u) ? 1u : 0u; mine = (j == x) ? c : mine; }
        if (sum == G) break;
        __builtin_amdgcn_s_sleep(1);
        if ((++sp & 255u) == 0u) { if (xb_ld(&bar[XB_TMO])) break; if (sp > XB_SPIN_CAP) { atomicAdd(&bar[XB_TMO], 1u); break; } }
    }
    nloc = mine > 0u ? mine : 1u; nx = cnt > 0u ? cnt : 1u;
}
__device__ __forceinline__ void xcd_barrier(const XcdBarrier& b) {
    asm volatile("s_waitcnt vmcnt(0)" ::: "memory");
    __syncthreads();
    if (threadIdx.x == 0) {
        unsigned* bar = b.bar;
        __builtin_amdgcn_s_waitcnt(0);
        unsigned nloc = b.st[0], nx = b.st[1];
        if (nloc == 0u) { xcd_barrier_complete(bar, b.x, nloc, nx); b.st[0] = nloc; b.st[1] = nx; }
        const unsigned old = xb_add(&bar[XB_XSUB(b.x)], 1u);
        const unsigned gen = old / nloc;
        if (old + 1u == (gen + 1u) * nloc) {
            __builtin_amdgcn_fence(__ATOMIC_RELEASE, "agent");
            asm volatile("s_waitcnt vmcnt(0)" ::: "memory");
            const unsigned og = xb_add(&bar[XB_TOP], 1u);
            const unsigned tg = og / nx;
            if (og + 1u == (tg + 1u) * nx) xb_add(&bar[XB_TOPGEN], 1u);
            else XB_SPIN(xb_ld(&bar[XB_TOPGEN]) == tg, bar);
            __builtin_amdgcn_fence(__ATOMIC_ACQUIRE, "agent");
            xb_add(&bar[XB_XGEN(b.x)], 1u);
            asm volatile("s_waitcnt vmcnt(0)" ::: "memory");
        } else {
            XB_SPIN(xb_ld(&bar[XB_XGEN(b.x)]) == gen, bar);
            __builtin_amdgcn_fence(__ATOMIC_ACQUIRE, "agent");
            asm volatile("s_waitcnt vmcnt(0)" ::: "memory");
        }
    }
    __syncthreads();
}
#endif
#ifdef CPU_EMU
struct Ctx { long long gtid, gsz, gw, nw; int lane, G, c; };
#define GEMM(A, lda, Bt, ldb, K, S, E) gemm_cpu(A, lda, Bt, ldb, K, S, E)
#define GRID_BARRIER() do { } while (0)
#else
struct Ctx { LAS unsigned char* lds; XcdBarrier bar; };
#define GEMM(A, lda, Bt, ldb, K, S, E) gemm_phase(cx.lds, A, lda, Bt, ldb, K, S, E)
#define GRID_BARRIER() xcd_barrier(cx.bar)
#endif
constexpr int N_PHASES = 56;

template <int KIND> DEVI void run_program(const Params& p, const Ctx& cx, int pb, int pe) {
    int ph = 0;
#define T p.T
#define DFF p.DFF
#ifdef CPU_EMU
    const long long gsz = cx.gsz, nw = cx.nw; const int gG = cx.G, gC = cx.c;
#else
#define gsz ((long long)gridDim.x * 512)
#define nw ((long long)gridDim.x * 8)
#define gG ((int)gridDim.x)
#define gC ((int)blockIdx.x)
#endif
#define H WSP(bf16_t, p.oH)
#define P WSP(bf16_t, p.oP)
#define O WSP(bf16_t, p.oO)
#define BO WSP(bf16_t, p.oBO)
#define MG WSP(bf16_t, p.oMG)
#define CQ WSP(bf16_t, p.oCQ)
#define CAO WSP(bf16_t, p.oCAO)
#define MEMN WSP(bf16_t, p.oMEMN)
#define ACT WSP(bf16_t, p.oACT)
#define WFFN WSP(bf16_t, p.oWFFN)
#ifdef CPU_EMU
#define OPAQUE_V(x) do { } while (0)
#define PH_IDX long long gtid = cx.gtid, gw = cx.gw; int lane = cx.lane
#else
#define OPAQUE_V(x) asm volatile("" : "+v"(x))
#define PH_IDX unsigned tx_ = threadIdx.x; OPAQUE_V(tx_); long long gtid = (long long)blockIdx.x * 512 + tx_, gw = (long long)(tx_ >> 6) * gridDim.x + blockIdx.x; int lane = tx_ & 63
#endif
#define PH_BEGIN(k) if (ph >= pb && ph < pe) { if constexpr (KIND < 0 || KIND == (k)) { PH_IDX; OPAQUE_V(gtid); OPAQUE_V(gw); OPAQUE_V(lane); (void)gtid; (void)gw; (void)lane;
#define PH_END   } if (ph + 1 < pe) GRID_BARRIER(); } ++ph;
    PH_BEGIN(0)
        ph_convert_layer(p, 0, gtid, gsz); ph_convert_layer(p, 1, gtid, gsz); ph_convert_ffn(p, gtid, gsz); ph_rope(p, gtid, gsz);
        ph_rmsnorm(p, p.in[I_MEM], p.B * 256, p.in[I_MEM_NORM], MEMN, 0, nullptr, gw, nw, lane);
        ph_rmsnorm(p, p.in[I_X], T, p.in[I_NORM_MIX], H, 1, p.out, gw, nw, lane);
    PH_END
    PH_BEGIN(1)
        { SchedPlain S; S.init(p.B * 256, 1024, 1024, 1024, gG, gC); EpStore E{WSP(bf16_t, p.oKV), 1024, 1.0f}; GEMM(MEMN, 1024, WSP(bf16_t, p.oWKV), 1024, 1024, S, E); }
    PH_END
    for (int l = 0; l < 2; ++l) {
#define W WSP(bf16_t, p.oWL[l])
        PH_BEGIN(1) { SchedPlain S; S.init(T, 3072, 1024, 1024, gG, gC); EpStore E{P, 3072, 1.0f}; GEMM(H, 1024, W + W_IN, 1024, 1024, S, E); } PH_END
        PH_BEGIN(2) ph_rope_apply(p, gtid, gsz); ph_compress1(p, l, gtid, gsz); ph_pool(p, l, gtid, gsz); ph_rwkv_prep(p, l, gtid, gsz); ph_gla_prep(p, l, gtid, gsz); PH_END
        PH_BEGIN(3) ph_compress2(p, l, gtid, gsz); PH_END
        PH_BEGIN(4) ph_rwkv_scan(p, l, gw, nw, lane); ph_gla_scan(p, l, (gw + nw - (p.B * 4) % nw) % nw, nw, lane); ph_cmp_attn(p, gtid, gsz); PH_END
        PH_BEGIN(5) ph_selwin(p, gtid, gsz); PH_END
        for (int q = 0; q < 4; ++q) { const long long r0 = q * (T / 4);
            PH_BEGIN(6) { SchedBranch S; S.init(T / 4, gG, gC); EpStore E{BO, 4096, 1.0f}; GEMM(O + r0 * 1024, 1024, W + W_B, 256, 256, S, E); } PH_END
            PH_BEGIN(7) { SchedGate S; S.init(T / 4, gG, gC); EpGate E{BO, p.in[I_B_GATE] + l * 4096, MG, r0}; GEMM(H + r0 * 1024, 1024, W + W_G, 1024, 1024, S, E); } PH_END }
        PH_BEGIN(8) { SchedPlain S; S.init(T, 1024, 1024, 1024, gG, gC); EpResid E{p.out}; GEMM(MG, 1024, W + W_O, 1024, 1024, S, E); } PH_END
        PH_BEGIN(9) ph_rmsnorm(p, p.out, T, p.in[I_NORM_CA] + l * 1024, H, 0, nullptr, gw, nw, lane); PH_END
        PH_BEGIN(1) { SchedPlain S; S.init(T, 256, 1024, 1024, gG, gC); EpStore E{CQ, 256, 0.125f}; GEMM(H, 1024, W + W_CQ, 1024, 1024, S, E); } PH_END
        PH_BEGIN(10) ph_ca_attn(p, l, gtid, gsz); PH_END
        PH_BEGIN(8) { SchedPlain S; S.init(T, 1024, 256, 256, gG, gC); EpResid E{p.out}; GEMM(CAO, 256, W + W_CO, 256, 256, S, E); } PH_END
        PH_BEGIN(9) ph_rmsnorm(p, p.out, T, p.in[I_NORM_FFN] + l * 1024, H, l == 1 ? 2 : 0, nullptr, gw, nw, lane); if (l == 1) ph_convert_moe(p, gtid, gsz); PH_END
        if (l == 0) {
            PH_BEGIN(11) { SchedPlain S; S.init(T, 2 * DFF, 1024, 1024, gG, gC); EpSwiglu E{ACT, DFF, 0}; GEMM(H, 1024, WFFN, 1024, 1024, S, E); } PH_END
            PH_BEGIN(8) { SchedPlain S; S.init(T, 1024, DFF, DFF, gG, gC); EpResid E{p.out}; GEMM(ACT, DFF, WFFN + 2 * DFF * 1024, DFF, DFF, S, E); } PH_END
            PH_BEGIN(9) ph_rmsnorm(p, p.out, T, p.in[I_NORM_MIX] + 1024, H, 0, nullptr, gw, nw, lane); PH_END
        } else {
            PH_BEGIN(12) ph_moe_count(p, gtid, gsz); PH_END
            PH_BEGIN(12) ph_moe_offsets(p, gtid, gsz); PH_END
            PH_BEGIN(12) ph_moe_assign(p, gtid, gsz); PH_END
            PH_BEGIN(12) ph_moe_gather(p, gtid, gsz); PH_END
#define HS WSP(bf16_t, p.oHS)
#define ACTC WSP(bf16_t, p.oACTC)
#define MW WSP(bf16_t, p.oMOEW)
#define MC WSP(int, p.oMOEC)
            const int ct = (int)((p.NR / 256 + 3) / 4);
            for (int q = 0; q < 4; ++q) {
                PH_BEGIN(13) { SchedMoe S; const int nt_ = MC[16 + 8] / 256; S.t0 = q * ct; S.t1 = (q + 1) * ct < nt_ ? (q + 1) * ct : nt_; if (S.t1 < S.t0) S.t1 = S.t0; S.nN = (int)(2 * DFF / 256); S.G = gG; S.c = gC; S.lda = 1024; S.ldb = 1024; S.per_e = 3 * 1024 * DFF * 2;
#pragma unroll
                    for (int e = 0; e < 9; ++e) S.base[e] = MC[16 + e];
                    EpSwiglu E{ACTC, DFF, (long long)S.t0 * 256}; GEMM(HS, 1024, MW, 1024, 1024, S, E); } PH_END
                PH_BEGIN(14) { SchedMoe S; const int nt_ = MC[16 + 8] / 256; S.t0 = q * ct; S.t1 = (q + 1) * ct < nt_ ? (q + 1) * ct : nt_; if (S.t1 < S.t0) S.t1 = S.t0; S.nN = 4; S.G = gG; S.c = gC; S.lda = DFF; S.ldb = DFF; S.per_e = 3 * 1024 * DFF * 2;
#pragma unroll
                    for (int e = 0; e < 9; ++e) S.base[e] = MC[16 + e];
                    EpMoeDown E{WSP(bf16_t, p.oY), WSP(float, p.oROWW)}; GEMM(ACTC - (long long)S.t0 * 256 * DFF, DFF, MW + 2 * DFF * 1024, DFF, DFF, S, E); } PH_END }
            PH_BEGIN(15) ph_final(p, gw, nw, lane); PH_END
        }
    }
#undef PH_BEGIN
#undef PH_END
#undef H
#undef P
#undef O
#undef BO
#undef MG
#undef CQ
#undef CAO
#undef MEMN
#undef ACT
#undef WFFN
#undef T
#undef DFF
#undef W
#undef HS
#undef ACTC
#undef MW
#undef MC
#ifndef CPU_EMU
#undef gsz
#undef nw
#undef gG
#undef gC
#endif
}

#ifndef CPU_EMU
template <int KIND> __global__ __launch_bounds__(512, 2) void mk_fwd(Params p, int pb, int pe) {
    extern __shared__ __attribute__((aligned(16))) unsigned char shm[];
    Ctx cx; cx.lds = (LAS unsigned char*)shm;
    volatile LAS unsigned* xbw = (volatile LAS unsigned*)(cx.lds + STAGE_BYTES);
    if (threadIdx.x == 0) { xbw[0] = 0u; xbw[1] = 0u; xbw[2] = 0u; xbw[3] = 0u; }
    __syncthreads();
    cx.bar = xcd_barrier_post((unsigned*)(p.ws + p.oBAR), xbw);
    run_program<KIND>(p, cx, pb, pe);
}
#ifndef MK_ONE
#define MK_ONE 1
#endif
#if !MK_ONE
static const int kPhaseKind[N_PHASES] = { 0, 1,
    1, 2, 3, 4, 5, 6, 7, 6, 7, 6, 7, 6, 7, 8, 9, 1, 10, 8, 9, 11, 8, 9,
    1, 2, 3, 4, 5, 6, 7, 6, 7, 6, 7, 6, 7, 8, 9, 1, 10, 8, 9, 12, 12, 12, 12, 13, 14, 13, 14, 13, 14, 13, 14, 15 };
#endif
typedef void (*mk_fn)(Params, int, int);
extern "C" void kernel_launch(void* const* d_in, const int* in_sizes, int n_in, void* d_out, int out_size, void* d_ws, size_t ws_size, hipStream_t stream) {
    (void)in_sizes; (void)n_in; (void)out_size;
    Params p; memset(&p, 0, sizeof(p));
    for (int i = 0; i < N_INPUTS; ++i) p.in[i] = (const float*)d_in[i];
    p.out = (float*)d_out; p.ws = (unsigned char*)d_ws;
    make_layout(p, 32, 2048, 2816);
    for (int j = 0; j < 8; ++j) p.inv_freq[j] = (float)pow(500000.0, -(double)(2 * j) / 16.0);
    if ((size_t)p.wsNeed > ws_size) { fprintf(stderr, "workspace too small: need %lld have %zu\n", p.wsNeed, ws_size); return; }
    const size_t lds_bytes = STAGE_BYTES + 16;
#if MK_ONE
    static const mk_fn fns[1] = { mk_fwd<-1> }; const int nf = 1;
#else
    static const mk_fn fns[16] = { mk_fwd<0>, mk_fwd<1>, mk_fwd<2>, mk_fwd<3>, mk_fwd<4>, mk_fwd<5>, mk_fwd<6>, mk_fwd<7>, mk_fwd<8>, mk_fwd<9>, mk_fwd<10>, mk_fwd<11>, mk_fwd<12>, mk_fwd<13>, mk_fwd<14>, mk_fwd<15> }; const int nf = 16;
#endif
    static int grid = 0;
    if (!grid) { int dev = 0, cus = 0; (void)hipGetDevice(&dev); (void)hipDeviceGetAttribute(&cus, hipDeviceAttributeMultiprocessorCount, dev);
        for (int k = 0; k < nf; ++k) (void)hipFuncSetAttribute((const void*)fns[k], hipFuncAttributeMaxDynamicSharedMemorySize, (int)lds_bytes);
        int per_cu = 0; (void)hipOccupancyMaxActiveBlocksPerMultiprocessor(&per_cu, (const void*)fns[0], 512, lds_bytes); (void)hipGetLastError();
        grid = cus > 0 ? cus : 256; }
    (void)hipMemsetAsync(p.ws + p.oBAR, 0, 16384 + 4096, stream);
#if MK_ONE
    hipLaunchKernelGGL(fns[0], dim3(grid), dim3(512), lds_bytes, stream, p, 0, N_PHASES);
#else
    for (int ph = 0; ph < N_PHASES; ++ph) hipLaunchKernelGGL(fns[kPhaseKind[ph]], dim3(grid), dim3(512), lds_bytes, stream, p, ph, ph + 1);
#endif
}
#endif
```

```cpp
#ifndef CPU_EMU
#include <hip/hip_runtime.h>
#include <cstdio>
#include <cstdint>
#include <cstring>
#define DEVI __device__ __forceinline__
#define DEVM __device__ __forceinline__
#else
#include <cmath>
#include <cstdio>
#include <cstdint>
#include <cstring>
#include <cstdlib>
#define DEVI static inline
#define DEVM inline
struct uint4 { unsigned x, y, z, w; };
#endif

typedef unsigned short bf16_t;
#ifdef CPU_EMU
static inline float u2f(unsigned u) { float f; memcpy(&f, &u, 4); return f; }
static inline unsigned f2u(float f) { unsigned u; memcpy(&u, &f, 4); return u; }
#else
DEVI float u2f(unsigned u) { return __uint_as_float(u); }
DEVI unsigned f2u(float f) { return __float_as_uint(f); }
#endif
DEVI float bf2f(bf16_t b) { return u2f(((unsigned)b) << 16); }
DEVI bf16_t f2bf(float f) { unsigned u = f2u(f); u += 0x7FFFu + ((u >> 16) & 1u); return (bf16_t)(u >> 16); }
DEVI float sigmoidf_(float x) { return 1.0f / (1.0f + expf(-x)); }
DEVI float siluf_(float x) { return x / (1.0f + expf(-x)); }
DEVI float softplusf_(float x) { return x > 20.f ? x : log1pf(expf(x)); }
DEVI float gelu_tanhf_(float x) { return 0.5f * x * (1.0f + tanhf(0.7978845608028654f * (x + 0.044715f * x * x * x))); }

constexpr int DM = 1024;
constexpr int PW = 3072;
constexpr int INW = 2972;
constexpr int C_Q = 0, C_KC = 256, C_VC = 384, C_KS = 512, C_VS = 640, C_KW = 768, C_VW = 896, C_NG = 1024;
constexpr int C_POOL = 1036;
constexpr int C_RW = 1292;
constexpr int C_GLA = 2188;
constexpr int C_VRES = 2972;
constexpr int NCMPH = 128;

enum { I_X = 0, I_MEM, I_POS, I_NORM_MIX, I_W_IN, I_CMP_PE, I_CMP_W1, I_CMP_W2, I_POOL_W, I_POOL_SCALE, I_RW_MU, I_RW_W0, I_RW_W2, I_RW_A0, I_RW_A2, I_RW_G2,
       I_RW_V0, I_RW_V1, I_RW_V2, I_RW_KK, I_RW_KA, I_RW_RK, I_RW_LN, I_GLA_A2, I_GLA_AB, I_GLA_NORM, I_W_GATE, I_B_GATE, I_W_BRANCH, I_W_OUT, I_NORM_CA, I_MEM_NORM,
       I_CA_Q, I_CA_KV, I_CA_O, I_NORM_FFN, I_FFN_G, I_FFN_U, I_FFN_D, I_MOE_R, I_MOE_G, I_MOE_U, I_MOE_D, I_NORM_FINAL, N_INPUTS };

struct Params {
    const float* in[N_INPUTS];
    float* out;
    unsigned char* ws;
    long long B, S, T, DFF, NC, NR;
    float inv_freq[8];
    long long oBAR, oMOEC, oROPE, oKCMP, oVCMP, oHID, oSELM, oKV, oRK, oTOKE, oTOKW, oTOKS, oR2T, oROWW, oCCNT, oCOFF;
    long long oWL[2], oWKV, oWFFN, oVF, oH, oP, oO, oBO, oMG, oRWW, oRWX, oGA, oCQ, oCAO, oMEMN, oACT, oY, oHS, oMOEW, oACTC, wsNeed;
};
constexpr long long W_IN = 0, W_G = W_IN + 3072LL * 1024, W_B = W_G + 4096LL * 1024, W_O = W_B + 4LL * 1024 * 256, W_CQ = W_O + 1024LL * 1024, W_CKV = W_CQ + 256LL * 1024,
                    W_CO = W_CKV + 512LL * 1024, W_LAYER = W_CO + 1024LL * 256;

static inline long long al256(long long x) { return (x + 255) & ~255LL; }
static inline void make_layout(Params& p, long long B, long long S, long long DFF) {
    p.B = B; p.S = S; p.T = B * S; p.DFF = DFF; p.NC = (S - 32) / 16 + 1; p.NR = 2 * p.T + 2048;
    const long long T = p.T;
    long long o = 0;
    auto take = [&](long long bytes) { long long r = o; o = al256(o + bytes); return r; };
    p.oBAR = take(16384); p.oMOEC = take(4096);
    p.oROPE = take(T * 16 * 4);
    p.oKCMP = take(B * p.NC * 128 * 4); p.oVCMP = take(B * p.NC * 128 * 4); p.oHID = take(B * p.NC * 4 * 128 * 4);
    p.oSELM = take(T * 2 * 4);
    p.oKV = take(2 * B * 256 * 512 * 2);
    p.oRK = take(T * 4 * 4);
    p.oTOKE = take(T * 2 * 4); p.oTOKW = take(T * 2 * 4); p.oTOKS = take(T * 2 * 4); p.oR2T = take(p.NR * 4); p.oROWW = take(p.NR * 4);
    p.oCCNT = take((T / 64) * 8 * 4); p.oCOFF = take((T / 64) * 8 * 4);
    p.oWL[0] = take(W_LAYER * 2); p.oWL[1] = take(W_LAYER * 2); p.oWKV = take(2LL * 512 * 1024 * 2); p.oWFFN = take(3 * 1024 * DFF * 2);
    p.oVF = take(T * 256 * 2);
    p.oH = take(T * 1024 * 2);
    p.oP = take(T * 3072 * 2);
    p.oO = take(T * 1024 * 2);
    p.oBO = take(T * 2048);
    p.oMG = take(T * 2048);
    long long end_main = o;
    p.oRWW = p.oBO;
    p.oRWX = p.oRWW + T * 1024;
    p.oGA = p.oRWX + T * 2560;
    p.oCQ = p.oP; p.oCAO = p.oP + T * 512;
    p.oMEMN = p.oBO;
    p.oACT = p.oP;
    p.oY = p.oVF; long long q = al256(p.oY + p.NR * 2048);
    p.oHS = q; q = al256(q + p.NR * 2048);
    p.oMOEW = q; q = al256(q + 8LL * 3 * 1024 * DFF * 2);
    const long long ntmax = p.NR / 256, ct = (ntmax + 3) / 4;
    p.oACTC = q; q = al256(q + ct * 256 * DFF * 2);
    p.wsNeed = q > end_main ? q : end_main;
}
#define WSP(T_, off) ((T_*)(p.ws + (off)))

DEVI void cvt_T(bf16_t* dst, const float* src, long long K, long long N, long long Npad, long long ld, long long gtid, long long gsz) {
    for (long long i = gtid; i < Npad * K; i += gsz) { const long long n = i / K, k = i % K; dst[i] = n < N ? f2bf(src[k * ld + n]) : (bf16_t)0; }
}
DEVI void cvt_GU(bf16_t* dst, const float* wg, const float* wu, long long DFF, long long gtid, long long gsz) {
    for (long long i = gtid; i < 2 * DFF * 1024; i += gsz) { const long long rr = i / 1024, k = i % 1024, t = rr >> 8, w = rr & 255;
        dst[i] = f2bf((w < 128 ? wg : wu)[k * DFF + t * 128 + (w & 127)]); }
}
DEVI void ph_convert_layer(const Params& p, int l, long long gtid, long long gsz) {
    bf16_t* W = WSP(bf16_t, p.oWL[l]);
    for (long long i = gtid; i < 3072LL * 1024; i += gsz) { const long long n = i >> 10, k = i & 1023; float v = 0.f;
        if (n < INW) v = p.in[I_W_IN][((long long)l * 1024 + k) * INW + n];
        else if (n < INW + 32 && l == 1) v = p.in[I_RW_V1][k * 32 + (n - INW)];
        W[W_IN + i] = f2bf(v); }
    for (int i = 0; i < 4; ++i) cvt_T(W + W_G + (long long)i * 1024 * 1024, p.in[I_W_GATE] + ((long long)l * 4 + i) * 1024 * 1024, 1024, 1024, 1024, 1024, gtid, gsz);
    for (int i = 0; i < 4; ++i) cvt_T(W + W_B + (long long)i * 1024 * 256, p.in[I_W_BRANCH] + ((long long)l * 4 + i) * 256 * 1024, 256, 1024, 1024, 1024, gtid, gsz);
    cvt_T(W + W_O, p.in[I_W_OUT] + (long long)l * 1024 * 1024, 1024, 1024, 1024, 1024, gtid, gsz);
    cvt_T(W + W_CQ, p.in[I_CA_Q] + (long long)l * 1024 * 256, 1024, 256, 256, 256, gtid, gsz);
    cvt_T(WSP(bf16_t, p.oWKV) + (long long)l * 512 * 1024, p.in[I_CA_KV] + (long long)l * 1024 * 512, 1024, 512, 512, 512, gtid, gsz);
    cvt_T(W + W_CO, p.in[I_CA_O] + (long long)l * 256 * 1024, 256, 1024, 1024, 1024, gtid, gsz);
}
DEVI void ph_convert_ffn(const Params& p, long long gtid, long long gsz) {
    bf16_t* W = WSP(bf16_t, p.oWFFN);
    cvt_GU(W, p.in[I_FFN_G], p.in[I_FFN_U], p.DFF, gtid, gsz);
    cvt_T(W + 2 * p.DFF * 1024, p.in[I_FFN_D], p.DFF, 1024, 1024, 1024, gtid, gsz);
}
DEVI void ph_convert_moe(const Params& p, long long gtid, long long gsz) {
    const long long DFF = p.DFF, per = 3 * 1024 * DFF;
    for (int e = 0; e < 8; ++e) { bf16_t* W = WSP(bf16_t, p.oMOEW) + e * per;
        cvt_GU(W, p.in[I_MOE_G] + (long long)e * 1024 * DFF, p.in[I_MOE_U] + (long long)e * 1024 * DFF, DFF, gtid, gsz);
        cvt_T(W + 2 * DFF * 1024, p.in[I_MOE_D] + (long long)e * DFF * 1024, DFF, 1024, 1024, 1024, gtid, gsz); }
}
DEVI void ph_rope(const Params& p, long long gtid, long long gsz) {
    const int* pos = (const int*)p.in[I_POS]; float* R = WSP(float, p.oROPE);
    for (long long i = gtid; i < p.T * 8; i += gsz) { const long long t = i >> 3; const int j = (int)(i & 7);
        const float ang = (float)pos[t] * p.inv_freq[j];
        double a = (double)ang; a -= 6.283185307179586476925 * floor(a * 0.15915494309189533577 + 0.5);
        const float ar = (float)a; R[t * 16 + j] = cosf(ar); R[t * 16 + 8 + j] = sinf(ar); }
}
DEVI void ph_rope_apply(const Params& p, long long gtid, long long gsz) {
    bf16_t* P = WSP(bf16_t, p.oP); const float* R = WSP(float, p.oROPE);
    for (long long i = gtid; i < p.T * 8; i += gsz) { const long long t = i >> 3; const int w = (int)(i & 7);
        const int col = w < 4 ? C_Q + w * 64 : (w < 6 ? C_KS + (w - 4) * 64 : C_KW + (w - 6) * 64);
        bf16_t* x = P + t * PW + col; const float* r = R + t * 16; const float sc = w < 4 ? 0.125f : 1.0f;
        for (int j = 0; j < 8; ++j) { const float a = bf2f(x[j]), b = bf2f(x[j + 8]), c = r[j], s = r[8 + j]; x[j] = f2bf((a * c - b * s) * sc); x[j + 8] = f2bf((b * c + a * s) * sc); }
        if (w < 4) for (int j = 16; j < 64; ++j) x[j] = f2bf(bf2f(x[j]) * 0.125f); }
}
DEVI void ph_compress1(const Params& p, int l, long long gtid, long long gsz) {
    const bf16_t* P = WSP(bf16_t, p.oP); float* HID = WSP(float, p.oHID);
    const float* pe = p.in[I_CMP_PE] + (long long)l * 2 * 32 * 64; const float* w1 = p.in[I_CMP_W1] + (long long)l * 2 * 32 * 64 * 128;
    const long long n_items = p.B * p.NC * 4 * 128;
    for (long long i = gtid; i < n_items; i += gsz) { const int f = (int)(i & 127); const int j = (int)((i >> 7) & 1), g = (int)((i >> 8) & 1); const long long bn = i >> 9, n = bn % p.NC, b = bn / p.NC;
        const int col = (j == 0 ? C_KC : C_VC) + g * 64; float acc = 0.f;
        for (int ll = 0; ll < 32; ++ll) { const bf16_t* x = P + (b * p.S + n * 16 + ll) * PW + col; const float* pp = pe + (j * 32 + ll) * 64; const float* ww = w1 + ((long long)(j * 32 + ll) * 64) * 128 + f;
            for (int d = 0; d < 64; ++d) acc += (bf2f(x[d]) + pp[d]) * ww[d * 128]; }
        HID[i] = gelu_tanhf_(acc); }
}
DEVI void ph_compress2(const Params& p, int l, long long gtid, long long gsz) {
    const float* HID = WSP(float, p.oHID); const float* w2 = p.in[I_CMP_W2] + (long long)l * 2 * 128 * 64; const float* R = WSP(float, p.oROPE);
    float* KC = WSP(float, p.oKCMP); float* VC = WSP(float, p.oVCMP);
    const long long n_items = p.B * p.NC * 2 * 2 * 8;
    for (long long i = gtid; i < n_items; i += gsz) { const int d8 = (int)(i & 7), j = (int)((i >> 3) & 1), g = (int)((i >> 4) & 1); const long long bn = i >> 5, n = bn % p.NC, b = bn / p.NC;
        const float* h = HID + ((bn * 2 + g) * 2 + j) * 128; const float* w = w2 + (long long)j * 128 * 64;
        float a[8];
#pragma unroll
        for (int m = 0; m < 8; ++m) a[m] = 0.f;
        for (int f = 0; f < 128; ++f) { const float hv = h[f];
#pragma unroll
            for (int m = 0; m < 8; ++m) a[m] += hv * w[f * 64 + d8 + 8 * m]; }
        if (j == 0) { const float* r = R + (b * p.S + n * 16 + 31) * 16; const float x0 = a[0], x1 = a[1], cs = r[d8], sn = r[8 + d8]; a[0] = x0 * cs - x1 * sn; a[1] = x1 * cs + x0 * sn; }
        float* dst = (j == 0 ? KC : VC) + (bn * 2 + g) * 64;
#pragma unroll
        for (int m = 0; m < 8; ++m) dst[d8 + 8 * m] = a[m]; }
}
DEVI void ph_pool(const Params& p, int l, long long gtid, long long gsz) {
    const bf16_t* P = WSP(bf16_t, p.oP); bf16_t* O = WSP(bf16_t, p.oO);
    const float* pw = p.in[I_POOL_W] + (long long)l * 4 * 64 * 64; const float* ps = p.in[I_POOL_SCALE] + (long long)l * 256;
    for (long long i = gtid; i < p.T * 4; i += gsz) { const long long t = i >> 2; const int g = (int)(i & 3); const long long s = t % p.S; const int win = 2 << g;
        const int cnt = (int)(s + 1 < win ? s + 1 : win); const float inv = 1.0f / (float)cnt;
        float dv[64];
#pragma unroll
        for (int c = 0; c < 64; ++c) dv[c] = 0.f;
        for (int k = 0; k < cnt; ++k) { const bf16_t* x = P + (t - k) * PW + C_POOL + g * 64;
#pragma unroll
            for (int c = 0; c < 64; ++c) dv[c] += bf2f(x[c]); }
        { const bf16_t* x = P + t * PW + C_POOL + g * 64;
#pragma unroll
            for (int c = 0; c < 64; ++c) dv[c] = dv[c] * inv - bf2f(x[c]); }
        const float* w = pw + g * 64 * 64;
        for (int d = 0; d < 64; ++d) { float a = 0.f;
#pragma unroll
            for (int c = 0; c < 64; ++c) a += dv[c] * w[c * 64 + d];
            O[t * 1024 + 256 + g * 64 + d] = f2bf(a * ps[g * 64 + d]); } }
}
DEVI void ph_rwkv_prep(const Params& p, int l, long long gtid, long long gsz) {
    const bf16_t* P = WSP(bf16_t, p.oP); float* RWW = WSP(float, p.oRWW); bf16_t* RWX = WSP(bf16_t, p.oRWX); float* RK = WSP(float, p.oRK); bf16_t* O = WSP(bf16_t, p.oO); bf16_t* VF = WSP(bf16_t, p.oVF);
    const float* mu = p.in[I_RW_MU] + l * 896; const float* w0 = p.in[I_RW_W0] + l * 256; const float* w2 = p.in[I_RW_W2] + l * 32 * 256; const float* a0 = p.in[I_RW_A0] + l * 256;
    const float* a2 = p.in[I_RW_A2] + l * 32 * 256; const float* g2 = p.in[I_RW_G2] + l * 64 * 256; const float* kkw = p.in[I_RW_KK] + l * 256; const float* kaw = p.in[I_RW_KA] + l * 256;
    const float* rkw = p.in[I_RW_RK] + l * 256; const float* v0 = p.in[I_RW_V0]; const float* v2 = p.in[I_RW_V2];
    for (long long i = gtid; i < p.T * 4; i += gsz) { const long long t = i >> 2; const int h = (int)(i & 3); const bool first = (t % p.S) == 0;
        const bf16_t* x = P + t * PW + C_RW; const bf16_t* xp = x - PW;
#define LERP(c) (first ? bf2f(x[c]) * (1.0f - mu[c]) : (bf2f(x[c]) + (bf2f(xp[c]) - bf2f(x[c])) * mu[c]))
        float nn = 0.f;
        for (int c = h * 64; c < h * 64 + 64; ++c) { const float kq = LERP(256 + c) * kkw[c]; nn += kq * kq; }
        const float rn = 1.0f / fmaxf(sqrtf(nn), 1e-12f);
        float rks = 0.f;
        for (int cc = 0; cc < 4; ++cc) { const int c0 = h * 64 + cc * 16;
            float zw[16], za[16], zg[16], zv[16];
#pragma unroll
            for (int u = 0; u < 16; ++u) { zw[u] = w0[c0 + u]; za[u] = a0[c0 + u]; zg[u] = 0.f; zv[u] = (l == 1) ? v0[c0 + u] : 0.f; }
            for (int j = 0; j < 32; ++j) { const float tw = tanhf(LERP(768 + j)), ad = LERP(800 + j), hv = (l == 1) ? bf2f(P[t * PW + C_VRES + j]) : 0.f;
#pragma unroll
                for (int u = 0; u < 16; ++u) { zw[u] += tw * w2[j * 256 + c0 + u]; za[u] += ad * a2[j * 256 + c0 + u]; if (l == 1) zv[u] += hv * v2[j * 256 + c0 + u]; } }
            for (int j = 0; j < 64; ++j) { const float sg = sigmoidf_(LERP(832 + j));
#pragma unroll
                for (int u = 0; u < 16; ++u) zg[u] += sg * g2[j * 256 + c0 + u]; }
#pragma unroll
            for (int u = 0; u < 16; ++u) { const int c = c0 + u;
                const float wlog = -softplusf_(-zw[u]) - 0.5f, dec = expf(-expf(wlog)), a = sigmoidf_(za[u]);
                const float r = LERP(c), k = LERP(256 + c); float v = LERP(512 + c);
                if (l == 0) VF[t * 256 + c] = f2bf(v); else { const float vf = bf2f(VF[t * 256 + c]); v = v + (vf - v) * sigmoidf_(zv[u]); }
                const float kk = k * kkw[c] * rn, k2 = k * (1.0f + (a - 1.0f) * kaw[c]), bb = kk * a;
                RWW[t * 256 + c] = dec; bf16_t* rx = RWX + t * 1280 + c;
                rx[0] = f2bf(r); rx[256] = f2bf(k2); rx[512] = f2bf(v); rx[768] = f2bf(kk); rx[1024] = f2bf(bb);
                rks += bf2f(f2bf(r)) * bf2f(f2bf(k2)) * rkw[c];
                O[t * 1024 + 512 + c] = f2bf(zg[u]); } }
        RK[t * 4 + h] = rks; }
#undef LERP
}
DEVI float rwkv_row_step(float (&st)[64], const float* w, const bf16_t* r, const bf16_t* k, const bf16_t* kk, const bf16_t* b, float v) {
    float skk = 0.f;
#pragma unroll
    for (int c = 0; c < 64; ++c) skk += st[c] * bf2f(kk[c]);
    float y = 0.f;
#pragma unroll
    for (int c = 0; c < 64; ++c) { st[c] = st[c] * w[c] - skk * bf2f(b[c]) + v * bf2f(k[c]); y += st[c] * bf2f(r[c]); }
    return y;
}
DEVI void ph_gla_prep(const Params& p, int l, long long gtid, long long gsz) {
    const bf16_t* P = WSP(bf16_t, p.oP); float* GA = WSP(float, p.oGA); bf16_t* O = WSP(bf16_t, p.oO);
    const float* a2 = p.in[I_GLA_A2] + l * 16 * 128; const float* ab = p.in[I_GLA_AB] + l * 128;
    for (long long i = gtid; i < p.T * 128; i += gsz) { const long long t = i >> 7; const int c = (int)(i & 127); const bf16_t* ad = P + t * PW + C_GLA + 512;
        float z = ab[c];
        for (int j = 0; j < 16; ++j) z += bf2f(ad[j]) * a2[j * 128 + c];
        GA[i] = expf(-softplusf_(-z) * 0.0625f);
        const bf16_t* og = P + t * PW + C_GLA + 528; O[t * 1024 + 768 + c] = f2bf(siluf_(bf2f(og[c]))); O[t * 1024 + 768 + 128 + c] = f2bf(siluf_(bf2f(og[128 + c]))); }
}
DEVI float gla_col_step(float (&st)[32], const float* a, const bf16_t* q, const bf16_t* k, float v) {
    float o = 0.f;
#pragma unroll
    for (int c = 0; c < 32; ++c) { st[c] = st[c] * a[c] + bf2f(k[c]) * v; o += st[c] * bf2f(q[c]); }
    return o * 0.17677669529663687f;
}
DEVI void ph_cmp_attn(const Params& p, long long gtid, long long gsz) {
    const bf16_t* P = WSP(bf16_t, p.oP); const float* KC = WSP(float, p.oKCMP); const float* VC = WSP(float, p.oVCMP); unsigned* SELM = WSP(unsigned, p.oSELM); bf16_t* O = WSP(bf16_t, p.oO);
    for (long long i = gtid; i < p.T * 2; i += gsz) { const long long t = i >> 1, b = t / p.S, s = t % p.S; const int g = (int)(i & 1);
        const int nv = s >= 31 ? (int)((s - 31) / 16 + 1) : 0;
        const int cur = (int)(s >> 6);
        const float* kc = KC + (b * p.NC * 2 + g) * 64; const float* vc = VC + (b * p.NC * 2 + g) * 64;
        float q0[64], q1[64];
        { const bf16_t* q = P + t * PW + C_Q + (2 * g) * 64;
#pragma unroll
          for (int d = 0; d < 64; ++d) { q0[d] = bf2f(q[d]); q1[d] = bf2f(q[64 + d]); } }
        float m0 = -3e38f, m1 = -3e38f;
        for (int n = 0; n < nv; ++n) { const float* k = kc + n * 128; float s0 = 0.f, s1 = 0.f;
#pragma unroll
            for (int d = 0; d < 64; ++d) { s0 += q0[d] * k[d]; s1 += q1[d] * k[d]; }
            m0 = fmaxf(m0, s0); m1 = fmaxf(m1, s1); }
        float z0 = 0.f, z1 = 0.f;
        for (int n = 0; n < nv; ++n) { const float* k = kc + n * 128; float s0 = 0.f, s1 = 0.f;
#pragma unroll
            for (int d = 0; d < 64; ++d) { s0 += q0[d] * k[d]; s1 += q1[d] * k[d]; }
            z0 += expf(s0 - m0); z1 += expf(s1 - m1); }
        const float iz0 = nv ? 1.0f / z0 : 0.f, iz1 = nv ? 1.0f / z1 : 0.f;
        unsigned mask;
        if (cur < 8) mask = (2u << cur) - 1u;
        else {
            float tv0 = -3e38f, tv1 = -3e38f, tv2 = -3e38f, tv3 = -3e38f, tv4 = -3e38f; int ti0 = 0, ti1 = 0, ti2 = 0, ti3 = 0, ti4 = 0;
            float carry = 0.f;
            for (int j = 0; j <= cur - 2; ++j) { float imp = carry;
                for (int mm = 0; mm < 4; ++mm) { const int n = 4 * j + mm; float pn = 0.f;
                    if (n < nv) { const float* k = kc + n * 128; float s0 = 0.f, s1 = 0.f;
#pragma unroll
                        for (int d = 0; d < 64; ++d) { s0 += q0[d] * k[d]; s1 += q1[d] * k[d]; }
                        pn = expf(s0 - m0) * iz0 + expf(s1 - m1) * iz1; }
                    if (mm < 3) imp += pn; else { imp += 0.5f * pn; carry = 0.5f * pn; } }
                if (j >= 1) {
                    float v = imp; int id = j;
                    if (v > tv0) { float tf = tv0; tv0 = v; v = tf; int tt = ti0; ti0 = id; id = tt; }
                    if (v > tv1) { float tf = tv1; tv1 = v; v = tf; int tt = ti1; ti1 = id; id = tt; }
                    if (v > tv2) { float tf = tv2; tv2 = v; v = tf; int tt = ti2; ti2 = id; id = tt; }
                    if (v > tv3) { float tf = tv3; tv3 = v; v = tf; int tt = ti3; ti3 = id; id = tt; }
                    if (v > tv4) { tv4 = v; ti4 = id; } } }
            mask = 1u | (1u << cur) | (1u << (cur - 1)) | (1u << ti0) | (1u << ti1) | (1u << ti2) | (1u << ti3) | (1u << ti4);
        }
        SELM[i] = mask;
        for (int r = 0; r < 2; ++r) { const int hd = 2 * g + r; const float mr = r ? m1 : m0, izr = r ? iz1 : iz0;
            float o[64], qq[64];
            { const bf16_t* q = P + t * PW + C_Q + hd * 64;
#pragma unroll
              for (int d = 0; d < 64; ++d) { o[d] = 0.f; qq[d] = bf2f(q[d]); } }
            for (int n = 0; n < nv; ++n) { const float* k = kc + n * 128; const float* v = vc + n * 128; float sc = 0.f;
#pragma unroll
                for (int d = 0; d < 64; ++d) sc += qq[d] * k[d];
                const float pr = expf(sc - mr) * izr;
#pragma unroll
                for (int d = 0; d < 64; ++d) o[d] += pr * v[d]; }
            const float g0 = sigmoidf_(bf2f(P[t * PW + C_NG + hd * 3 + 0]));
#pragma unroll
            for (int d = 0; d < 64; ++d) O[t * 1024 + hd * 64 + d] = f2bf(g0 * o[d]); } }
}
DEVI void ph_selwin(const Params& p, long long gtid, long long gsz) {
    const bf16_t* P = WSP(bf16_t, p.oP); const unsigned* SELM = WSP(unsigned, p.oSELM); bf16_t* O = WSP(bf16_t, p.oO);
    for (long long i = gtid; i < p.T * 8; i += gsz) { const long long t = i >> 3, b = t / p.S, s = t % p.S; const int hd = (int)((i >> 1) & 3), g = hd >> 1, d0 = (int)(i & 1) * 32;
        unsigned qp[32]; float o[32];
        { const bf16_t* qq = P + t * PW + C_Q + hd * 64;
#pragma unroll
          for (int d = 0; d < 32; ++d) qp[d] = (unsigned)qq[2 * d] | ((unsigned)qq[2 * d + 1] << 16); }
        for (int pass = 0; pass < 2; ++pass) {
            const int ck = pass ? C_KW : C_KS, cv = pass ? C_VW : C_VS; const unsigned mask = SELM[t * 2 + g];
            float m = -3e38f, z = 0.f;
#pragma unroll
            for (int d = 0; d < 32; ++d) o[d] = 0.f;
            const long long lo = pass ? (s - 511 > 0 ? s - 511 : 0) : 0;
            for (long long kp = lo; kp <= s; ++kp) {
                if (!pass && !((mask >> (kp >> 6)) & 1u)) { kp |= 63; continue; }
                const bf16_t* k = P + (b * p.S + kp) * PW + ck + g * 64; const bf16_t* v = P + (b * p.S + kp) * PW + cv + g * 64 + d0; float sc = 0.f;
#pragma unroll
                for (int d = 0; d < 32; ++d) sc += u2f(qp[d] << 16) * bf2f(k[2 * d]) + u2f(qp[d] & 0xffff0000u) * bf2f(k[2 * d + 1]);
                if (sc > m) { const float f = expf(m - sc); z *= f;
#pragma unroll
                    for (int d = 0; d < 32; ++d) o[d] *= f;
                    m = sc; }
                const float pr = expf(sc - m); z += pr;
#pragma unroll
                for (int d = 0; d < 32; ++d) o[d] += pr * bf2f(v[d]); }
            const float gt = sigmoidf_(bf2f(P[t * PW + C_NG + hd * 3 + 1 + pass])) / z;
#pragma unroll
            for (int d = 0; d < 32; ++d) { bf16_t* od = O + t * 1024 + hd * 64 + d0 + d; *od = f2bf(bf2f(*od) + gt * o[d]); } } }
}
DEVI void ph_ca_attn(const Params& p, int l, long long gtid, long long gsz) {
    const bf16_t* CQ = WSP(bf16_t, p.oCQ); const bf16_t* KV = WSP(bf16_t, p.oKV) + (long long)l * 512; bf16_t* AO = WSP(bf16_t, p.oCAO);
    for (long long i = gtid; i < p.T * 4; i += gsz) { const long long t = i >> 2, b = t / p.S; const int hd = (int)(i & 3);
        float q[64], o[64];
#pragma unroll
        for (int d = 0; d < 64; ++d) { q[d] = bf2f(CQ[t * 256 + hd * 64 + d]); o[d] = 0.f; }
        float m = -3e38f, z = 0.f;
        for (int kp = 0; kp < 256; ++kp) { const bf16_t* k = KV + (b * 256 + kp) * 1024 + hd * 64; const bf16_t* v = k + 256; float sc = 0.f;
#pragma unroll
            for (int d = 0; d < 64; ++d) sc += q[d] * bf2f(k[d]);
            if (sc > m) { const float f = expf(m - sc); z *= f;
#pragma unroll
                for (int d = 0; d < 64; ++d) o[d] *= f;
                m = sc; }
            const float pr = expf(sc - m); z += pr;
#pragma unroll
            for (int d = 0; d < 64; ++d) o[d] += pr * bf2f(v[d]); }
        const float iz = 1.0f / z;
#pragma unroll
        for (int d = 0; d < 64; ++d) AO[t * 256 + hd * 64 + d] = f2bf(o[d] * iz); }
}
DEVI void ph_moe_count(const Params& p, long long gtid, long long gsz) {
    const int* TE = WSP(int, p.oTOKE); int* CC = WSP(int, p.oCCNT); int* R2T = WSP(int, p.oR2T);
    for (long long c = gtid; c < p.T / 64; c += gsz) { int cnt[8] = {0, 0, 0, 0, 0, 0, 0, 0};
        for (int j = 0; j < 128; ++j) { const int e = TE[c * 128 + j];
#pragma unroll
            for (int q = 0; q < 8; ++q) cnt[q] += (e == q); }
#pragma unroll
        for (int q = 0; q < 8; ++q) CC[c * 8 + q] = cnt[q]; }
    for (long long i = gtid; i < p.NR; i += gsz) R2T[i] = -1;
}
DEVI void ph_moe_offsets(const Params& p, long long gtid, long long gsz) {
    const int* CC = WSP(int, p.oCCNT); int* CO = WSP(int, p.oCOFF); int* MC = WSP(int, p.oMOEC);
    for (long long ee = gtid; ee < 8; ee += gsz) { const int e = (int)ee; int run = 0; for (long long c = 0; c < p.T / 64; ++c) { CO[c * 8 + e] = run; run += CC[c * 8 + e]; } MC[e] = run; }
}
DEVI void moe_bases(const Params& p, int (&base)[9]) { const int* MC = WSP(int, p.oMOEC); int run = 0;
#pragma unroll
    for (int e = 0; e < 8; ++e) { base[e] = run; run += (MC[e] + 255) & ~255; } base[8] = run; }
DEVI void ph_moe_assign(const Params& p, long long gtid, long long gsz) {
    const int* TE = WSP(int, p.oTOKE); const float* TW = WSP(float, p.oTOKW); const int* CO = WSP(int, p.oCOFF); int* TS = WSP(int, p.oTOKS); int* R2T = WSP(int, p.oR2T); float* RW = WSP(float, p.oROWW);
    int base[9]; moe_bases(p, base);
    if (gtid == 0) { int* MC = WSP(int, p.oMOEC);
#pragma unroll
        for (int e = 0; e < 9; ++e) MC[16 + e] = base[e]; }
    for (long long c = gtid; c < p.T / 64; c += gsz) { int run[8];
#pragma unroll
        for (int q = 0; q < 8; ++q) run[q] = base[q] + CO[c * 8 + q];
        for (int j = 0; j < 128; ++j) { const int e = TE[c * 128 + j]; int slot = 0;
#pragma unroll
            for (int q = 0; q < 8; ++q) if (e == q) { slot = run[q]; run[q] += 1; }
            TS[c * 128 + j] = slot; R2T[slot] = (int)(c * 64 + (j >> 1)); RW[slot] = TW[c * 128 + j]; } }
}
DEVI void ph_moe_gather(const Params& p, long long gtid, long long gsz) {
    const int* R2T = WSP(int, p.oR2T); const int* MC = WSP(int, p.oMOEC); const uint4* H = WSP(uint4, p.oH); uint4* HS = WSP(uint4, p.oHS);
    const long long rows = MC[16 + 8];
    for (long long i = gtid; i < rows * 128; i += gsz) { const long long r = i >> 7; const int j = (int)(i & 127); const int t = R2T[r];
        uint4 v; v.x = v.y = v.z = v.w = 0u; if (t >= 0) v = H[(long long)t * 128 + j]; HS[i] = v; }
}
struct Unit { int pm, pn, aux, pad; long long aoff, boff; };
constexpr int NXCD = 8, WGM = 8;
DEVI void tile_order(long long L, int nM, int nN, int& pm, int& pn) {
    const int nwg = nM * nN; int wgid = (int)L; { const int q = nwg / NXCD, r = nwg % NXCD, xcd = wgid % NXCD, off = wgid / NXCD; wgid = (xcd < r ? xcd * (q + 1) : r * (q + 1) + (xcd - r) * q) + off; }
    const int nig = WGM * nN, gid = wgid / nig, fm = gid * WGM, gsz = (nM - fm) < WGM ? (nM - fm) : WGM;
    pm = fm + ((wgid % nig) % gsz); pn = (wgid % nig) / gsz;
}
struct SchedPlain {
    int nM, nN, G, c; long long lda, ldb;
    DEVM void init(long long M, long long N, long long lda_, long long ldb_, int G_, int c_) { nM = (int)(M / 256); nN = (int)(N / 256); lda = lda_; ldb = ldb_; G = G_; c = c_; }
    DEVM bool next(int i, Unit& u) const { const long long L = (long long)i * G + c; if (L >= (long long)nM * nN) return false; tile_order(L, nM, nN, u.pm, u.pn); u.aux = 0; u.pad = 0;
        u.aoff = (long long)u.pm * 256 * lda * 2; u.boff = (long long)u.pn * 256 * ldb * 2; return true; }
    DEVM void a_ready(const Unit&) const {}
    DEVM void done(const Unit&) const {}
};
struct SchedBranch {
    int nM, G, c;
    DEVM void init(long long M, int G_, int c_) { nM = (int)(M / 256); G = G_; c = c_; }
    DEVM bool next(int i, Unit& u) const { const long long L = (long long)i * G + c; if (L >= (long long)nM * 16) return false; tile_order(L, nM, 16, u.pm, u.pn); u.aux = u.pn >> 2; u.pad = 0;
        u.aoff = (long long)u.pm * 256 * 1024 * 2 + (long long)u.aux * 256 * 2; u.boff = (long long)u.pn * 256 * 256 * 2; return true; }
    DEVM void a_ready(const Unit&) const {}
    DEVM void done(const Unit&) const {}
};
struct SchedGate {
    int nM, G, c;
    DEVM void init(long long M, int G_, int c_) { nM = (int)(M / 256); G = G_; c = c_; }
    DEVM bool next(int i, Unit& u) const { const long long tile = (long long)(i >> 2) * G + c; if (tile >= (long long)nM * 4) return false; tile_order(tile, nM, 4, u.pm, u.pn); u.aux = i & 3; u.pad = 0;
        u.aoff = (long long)u.pm * 256 * 1024 * 2; u.boff = (long long)(u.aux * 4 + u.pn) * 256 * 1024 * 2; return true; }
    DEVM void a_ready(const Unit&) const {}
    DEVM void done(const Unit&) const {}
};
struct SchedMoe {
    int t0, t1, nN, G, c; long long lda, ldb, per_e; int base[9];
    DEVM bool next(int i, Unit& u) const { const long long L = (long long)i * G + c; if (L >= (long long)(t1 - t0) * nN) return false; u.pm = t0 + (int)(L / nN); u.pn = (int)(L % nN); u.pad = 0;
        int e = 0;
#pragma unroll
        for (int q = 1; q < 8; ++q) e += (u.pm * 256 >= base[q]) ? 1 : 0;
        u.aux = e; u.aoff = (long long)u.pm * 256 * lda * 2; u.boff = (long long)e * per_e + (long long)u.pn * 256 * ldb * 2; return true; }
    DEVM void a_ready(const Unit&) const {}
    DEVM void done(const Unit&) const {}
};
DEVI void st8(bf16_t* dst, const float* v) {
#ifndef CPU_EMU
    uint4 w; w.x = (unsigned)f2bf(v[0]) | ((unsigned)f2bf(v[1]) << 16); w.y = (unsigned)f2bf(v[2]) | ((unsigned)f2bf(v[3]) << 16); w.z = (unsigned)f2bf(v[4]) | ((unsigned)f2bf(v[5]) << 16); w.w = (unsigned)f2bf(v[6]) | ((unsigned)f2bf(v[7]) << 16);
    *(uint4*)dst = w;
#else
    for (int j = 0; j < 8; ++j) dst[j] = f2bf(v[j]);
#endif
}
DEVI void ld8(const bf16_t* src, float* v) {
#ifndef CPU_EMU
    const uint4 w = *(const uint4*)src; v[0] = u2f(w.x << 16); v[1] = u2f(w.x & 0xffff0000u); v[2] = u2f(w.y << 16); v[3] = u2f(w.y & 0xffff0000u); v[4] = u2f(w.z << 16); v[5] = u2f(w.z & 0xffff0000u); v[6] = u2f(w.w << 16); v[7] = u2f(w.w & 0xffff0000u);
#else
    for (int j = 0; j < 8; ++j) v[j] = bf2f(src[j]);
#endif
}
struct EpStore {
    bf16_t* O; long long ldo; float scale;
    DEVM void apply(const Unit& u, long long row, int c8, const float* lo, const float* hi) const { float a[8], b[8];
#pragma unroll
        for (int j = 0; j < 8; ++j) { a[j] = lo[j] * scale; b[j] = hi[j] * scale; }
        bf16_t* d = O + row * ldo + u.pn * 256 + c8; st8(d, a); st8(d + 128, b); }
};
struct EpGate {
    const bf16_t* BO; const float* bias; bf16_t* MG; long long row0;
    DEVM void apply(const Unit& u, long long row, int c8, const float* lo, const float* hi) const {
#pragma unroll
        for (int hh = 0; hh < 2; ++hh) { const float* v = hh ? hi : lo; const int c = u.pn * 256 + hh * 128 + c8, n = u.aux * 1024 + c; float bo[8], mg[8], r[8]; ld8(BO + row * 4096 + n, bo);
            bf16_t* m = MG + (row0 + row) * 1024 + c;
            if (u.aux) ld8(m, mg);
#pragma unroll
            for (int j = 0; j < 8; ++j) { r[j] = sigmoidf_(v[j] + bias[n + j]) * bo[j]; if (u.aux) r[j] += mg[j]; }
            st8(m, r); } }
};
struct EpResid {
    float* X;
    DEVM void apply(const Unit& u, long long row, int c8, const float* lo, const float* hi) const { float* x = X + row * 1024 + u.pn * 256 + c8;
#ifndef CPU_EMU
        float4 a = *(float4*)x, b = *(float4*)(x + 4), c = *(float4*)(x + 128), d = *(float4*)(x + 132);
        a.x += lo[0]; a.y += lo[1]; a.z += lo[2]; a.w += lo[3]; b.x += lo[4]; b.y += lo[5]; b.z += lo[6]; b.w += lo[7];
        c.x += hi[0]; c.y += hi[1]; c.z += hi[2]; c.w += hi[3]; d.x += hi[4]; d.y += hi[5]; d.z += hi[6]; d.w += hi[7];
        *(float4*)x = a; *(float4*)(x + 4) = b; *(float4*)(x + 128) = c; *(float4*)(x + 132) = d;
#else
        for (int j = 0; j < 8; ++j) { x[j] += lo[j]; x[128 + j] += hi[j]; }
#endif
    }
};
struct EpSwiglu {
    bf16_t* ACT; long long ldo; long long row0;
    DEVM void apply(const Unit& u, long long row, int c8, const float* lo, const float* hi) const { float r[8];
#pragma unroll
        for (int j = 0; j < 8; ++j) r[j] = siluf_(lo[j]) * hi[j];
        st8(ACT + (row - row0) * ldo + u.pn * 128 + c8, r); }
};
struct EpMoeDown {
    bf16_t* Y; const float* roww;
    DEVM void apply(const Unit& u, long long row, int c8, const float* lo, const float* hi) const { const float w = roww[row]; float a[8], b[8];
#pragma unroll
        for (int j = 0; j < 8; ++j) { a[j] = lo[j] * w; b[j] = hi[j] * w; }
        bf16_t* d = Y + row * 1024 + u.pn * 256 + c8; st8(d, a); st8(d + 128, b); }
};

#ifdef CPU_EMU
template <class Sched, class Epi> static void gemm_cpu(const bf16_t* A, long long lda, const bf16_t* Bt, long long ldb, long long K, const Sched& S, const Epi& E) {
    Unit u;
    for (int i = 0; S.next(i, u); ++i) {
        const bf16_t* a0 = (const bf16_t*)((const char*)A + u.aoff); const bf16_t* b0 = (const bf16_t*)((const char*)Bt + u.boff);
#pragma omp parallel for
        for (int r = 0; r < 256; ++r) { float arow[4096]; for (long long k = 0; k < K; ++k) arow[k] = bf2f(a0[r * lda + k]);
            for (int c8 = 0; c8 < 128; c8 += 8) { float lo[8], hi[8];
                for (int j = 0; j < 8; ++j) { const bf16_t* bl = b0 + (c8 + j) * ldb; const bf16_t* bh = b0 + (128 + c8 + j) * ldb; float s0 = 0.f, s1 = 0.f;
                    for (long long k = 0; k < K; ++k) { s0 += arow[k] * bf2f(bl[k]); s1 += arow[k] * bf2f(bh[k]); } lo[j] = s0; hi[j] = s1; }
                E.apply(u, (long long)u.pm * 256 + r, c8, lo, hi); } } }
}
#endif

#ifndef CPU_EMU
DEVI float wave_sum(float v) {
#pragma unroll
    for (int o = 32; o > 0; o >>= 1) v += __shfl_xor(v, o);
    return v; }
DEVI void row_load(const float* src, float (&v)[16], int lane) {
#pragma unroll
    for (int j = 0; j < 4; ++j) { const float4 f = *(const float4*)(src + j * 256 + lane * 4); v[4 * j] = f.x; v[4 * j + 1] = f.y; v[4 * j + 2] = f.z; v[4 * j + 3] = f.w; } }
DEVI void row_store_bf16(bf16_t* dst, const float (&v)[16], int lane) {
#pragma unroll
    for (int j = 0; j < 4; ++j) { uint2 w; w.x = (unsigned)f2bf(v[4 * j]) | ((unsigned)f2bf(v[4 * j + 1]) << 16); w.y = (unsigned)f2bf(v[4 * j + 2]) | ((unsigned)f2bf(v[4 * j + 3]) << 16); *(uint2*)(dst + j * 256 + lane * 4) = w; } }
#endif
DEVI void ph_rmsnorm(const Params& p, const float* src, long long rows, const float* gain, bf16_t* dst, int mode, float* xcopy, long long gw, long long nw, int lane) {
    const float* router = p.in[I_MOE_R]; int* TE = WSP(int, p.oTOKE); float* TW = WSP(float, p.oTOKW);
#ifndef CPU_EMU
    for (long long r = gw; r < rows; r += nw) { float v[16], g[16]; row_load(src + r * 1024, v, lane); row_load(gain, g, lane);
        float ss = 0.f;
#pragma unroll
        for (int j = 0; j < 16; ++j) ss += v[j] * v[j];
        ss = wave_sum(ss); const float rs = rsqrtf(ss * (1.0f / 1024.0f) + 1e-6f);
        if (mode == 1) {
#pragma unroll
            for (int j = 0; j < 4; ++j) *(float4*)(xcopy + r * 1024 + j * 256 + lane * 4) = make_float4(v[4 * j], v[4 * j + 1], v[4 * j + 2], v[4 * j + 3]); }
#pragma unroll
        for (int j = 0; j < 16; ++j) v[j] = v[j] * rs * g[j];
        row_store_bf16(dst + r * 1024, v, lane);
        if (mode == 2) { float lg[8];
#pragma unroll
            for (int e = 0; e < 8; ++e) { float a = 0.f;
#pragma unroll
                for (int j = 0; j < 16; ++j) a += v[j] * router[(long long)((j >> 2) * 256 + lane * 4 + (j & 3)) * 8 + e];
                lg[e] = wave_sum(a); }
            int i0 = 0; float v0 = lg[0];
#pragma unroll
            for (int e = 1; e < 8; ++e) if (lg[e] > v0) { v0 = lg[e]; i0 = e; }
            int i1 = -1; float v1 = -3e38f;
#pragma unroll
            for (int e = 0; e < 8; ++e) if (e != i0 && lg[e] > v1) { v1 = lg[e]; i1 = e; }
            const float w0 = 1.0f / (1.0f + expf(v1 - v0));
            if (lane == 0) { TE[r * 2] = i0; TE[r * 2 + 1] = i1; TW[r * 2] = w0; TW[r * 2 + 1] = 1.0f - w0; } } }
#else
    (void)lane;
    for (long long r = gw; r < rows; r += nw) { const float* x = src + r * 1024; float ss = 0.f; for (int c = 0; c < 1024; ++c) ss += x[c] * x[c];
        const float rs = 1.0f / sqrtf(ss / 1024.0f + 1e-6f); float hv[1024];
        for (int c = 0; c < 1024; ++c) { hv[c] = x[c] * rs * gain[c]; dst[r * 1024 + c] = f2bf(hv[c]); if (mode == 1) xcopy[r * 1024 + c] = x[c]; }
        if (mode == 2) { float lg[8]; for (int e = 0; e < 8; ++e) { float a = 0.f; for (int c = 0; c < 1024; ++c) a += hv[c] * router[c * 8 + e]; lg[e] = a; }
            int i0 = 0; float v0 = lg[0]; for (int e = 1; e < 8; ++e) if (lg[e] > v0) { v0 = lg[e]; i0 = e; }
            int i1 = -1; float v1 = -3e38f; for (int e = 0; e < 8; ++e) if (e != i0 && lg[e] > v1) { v1 = lg[e]; i1 = e; }
            const float w0 = 1.0f / (1.0f + expf(v1 - v0)); TE[r * 2] = i0; TE[r * 2 + 1] = i1; TW[r * 2] = w0; TW[r * 2 + 1] = 1.0f - w0; } }
#endif
}
DEVI void ph_final(const Params& p, long long gw, long long nw, int lane) {
    const int* TS = WSP(int, p.oTOKS); const bf16_t* Y = WSP(bf16_t, p.oY); const float* gain = p.in[I_NORM_FINAL]; float* X = p.out;
#ifndef CPU_EMU
    for (long long r = gw; r < p.T; r += nw) { float v[16], g[16]; row_load(X + r * 1024, v, lane); row_load(gain, g, lane);
        const bf16_t* y0 = Y + (long long)TS[r * 2] * 1024; const bf16_t* y1 = Y + (long long)TS[r * 2 + 1] * 1024;
#pragma unroll
        for (int j = 0; j < 4; ++j) { const uint2 a = *(const uint2*)(y0 + j * 256 + lane * 4), b = *(const uint2*)(y1 + j * 256 + lane * 4);
            v[4 * j] += u2f(a.x << 16) + u2f(b.x << 16); v[4 * j + 1] += u2f(a.x & 0xffff0000u) + u2f(b.x & 0xffff0000u); v[4 * j + 2] += u2f(a.y << 16) + u2f(b.y << 16); v[4 * j + 3] += u2f(a.y & 0xffff0000u) + u2f(b.y & 0xffff0000u); }
        float ss = 0.f;
#pragma unroll
        for (int j = 0; j < 16; ++j) ss += v[j] * v[j];
        ss = wave_sum(ss); const float rs = rsqrtf(ss * (1.0f / 1024.0f) + 1e-6f);
#pragma unroll
        for (int j = 0; j < 4; ++j) *(float4*)(X + r * 1024 + j * 256 + lane * 4) = make_float4(v[4 * j] * rs * g[4 * j], v[4 * j + 1] * rs * g[4 * j + 1], v[4 * j + 2] * rs * g[4 * j + 2], v[4 * j + 3] * rs * g[4 * j + 3]); }
#else
    (void)lane;
    for (long long r = gw; r < p.T; r += nw) { float v[1024]; float ss = 0.f; const bf16_t* y0 = Y + (long long)TS[r * 2] * 1024; const bf16_t* y1 = Y + (long long)TS[r * 2 + 1] * 1024;
        for (int c = 0; c < 1024; ++c) { v[c] = X[r * 1024 + c] + bf2f(y0[c]) + bf2f(y1[c]); ss += v[c] * v[c]; }
        const float rs = 1.0f / sqrtf(ss / 1024.0f + 1e-6f); for (int c = 0; c < 1024; ++c) X[r * 1024 + c] = v[c] * rs * gain[c]; }
#endif
}
DEVI void ph_rwkv_scan(const Params& p, int l, long long gw, long long nw, int lane) {
    const float* RWW = WSP(float, p.oRWW); const bf16_t* RWX = WSP(bf16_t, p.oRWX); const float* RK = WSP(float, p.oRK); bf16_t* O = WSP(bf16_t, p.oO); const float* lng = p.in[I_RW_LN] + l * 256;
    for (long long ch = gw; ch < p.B * 4; ch += nw) { const long long b = ch >> 2; const int h = (int)(ch & 3);
#ifndef CPU_EMU
        float st[64];
#pragma unroll
        for (int c = 0; c < 64; ++c) st[c] = 0.f;
        for (long long s = 0; s < p.S; ++s) { const long long t = b * p.S + s; const bf16_t* rx = RWX + t * 1280 + h * 64; const float v = bf2f(rx[512 + lane]);
            const float y = rwkv_row_step(st, RWW + t * 256 + h * 64, rx, rx + 256, rx + 768, rx + 1024, v);
            const float mean = wave_sum(y) * (1.0f / 64.0f), dy = y - mean, var = wave_sum(dy * dy) * (1.0f / 64.0f);
            const float yn = dy * rsqrtf(var + 64e-5f) * lng[h * 64 + lane] + RK[t * 4 + h] * v;
            bf16_t* o = O + t * 1024 + 512 + h * 64 + lane; *o = f2bf(yn * bf2f(*o)); }
#else
        (void)lane;
        static float st[64][64]; for (int v = 0; v < 64; ++v) for (int c = 0; c < 64; ++c) st[v][c] = 0.f;
        for (long long s = 0; s < p.S; ++s) { const long long t = b * p.S + s; const bf16_t* rx = RWX + t * 1280 + h * 64; float y[64], mean = 0.f, var = 0.f;
            for (int v = 0; v < 64; ++v) { y[v] = rwkv_row_step(st[v], RWW + t * 256 + h * 64, rx, rx + 256, rx + 768, rx + 1024, bf2f(rx[512 + v])); mean += y[v]; }
            mean /= 64.f; for (int v = 0; v < 64; ++v) var += (y[v] - mean) * (y[v] - mean); var /= 64.f;
            for (int v = 0; v < 64; ++v) { const float yn = (y[v] - mean) / sqrtf(var + 64e-5f) * lng[h * 64 + v] + RK[t * 4 + h] * bf2f(rx[512 + v]);
                bf16_t* o = O + t * 1024 + 512 + h * 64 + v; *o = f2bf(yn * bf2f(*o)); } }
#endif
    }
}
DEVI void ph_gla_scan(const Params& p, int l, long long gw, long long nw, int lane) {
    const bf16_t* P = WSP(bf16_t, p.oP); const float* GA = WSP(float, p.oGA); bf16_t* O = WSP(bf16_t, p.oO); const float* ng = p.in[I_GLA_NORM] + l * 64;
    for (long long ch = gw; ch < p.B * 4; ch += nw) { const long long b = ch >> 2; const int h = (int)(ch & 3);
#ifndef CPU_EMU
        float st[32];
#pragma unroll
        for (int c = 0; c < 32; ++c) st[c] = 0.f;
        for (long long s = 0; s < p.S; ++s) { const long long t = b * p.S + s; const bf16_t* x = P + t * PW + C_GLA;
            const float o = gla_col_step(st, GA + t * 128 + h * 32, x + h * 32, x + 128 + h * 32, bf2f(x[256 + h * 64 + lane]));
            const float ms = wave_sum(o * o) * (1.0f / 64.0f), on = o * rsqrtf(ms + 1e-6f) * ng[lane];
            bf16_t* d = O + t * 1024 + 768 + h * 64 + lane; *d = f2bf(on * bf2f(*d)); }
#else
        (void)lane;
        static float st[64][32]; for (int v = 0; v < 64; ++v) for (int c = 0; c < 32; ++c) st[v][c] = 0.f;
        for (long long s = 0; s < p.S; ++s) { const long long t = b * p.S + s; const bf16_t* x = P + t * PW + C_GLA; float o[64], ms = 0.f;
            for (int v = 0; v < 64; ++v) { o[v] = gla_col_step(st[v], GA + t * 128 + h * 32, x + h * 32, x + 128 + h * 32, bf2f(x[256 + h * 64 + v])); ms += o[v] * o[v]; }
            ms /= 64.f;
            for (int v = 0; v < 64; ++v) { bf16_t* d = O + t * 1024 + 768 + h * 64 + v; *d = f2bf(o[v] / sqrtf(ms + 1e-6f) * ng[v] * bf2f(*d)); } }
#endif
    }
}
#ifndef CPU_EMU
#define LAS __attribute__((address_space(3)))
typedef short bf16x8 __attribute__((ext_vector_type(8)));
typedef float f32x4 __attribute__((ext_vector_type(4)));
constexpr int HALF = 128, BK = 64, HTB = HALF * BK * 2, STAGE_BYTES = 8 * HTB;
__device__ __forceinline__ int lds_byte(int r, int c) { const int st = (r >> 4) * 2 + (c >> 5), rr = r & 15, cc = c & 31, ob = rr * 64 + cc * 2; return st * 1024 + (ob ^ (((ob >> 9) & 1) << 5)); }
__device__ __forceinline__ void stage_rc(int b, int& R, int& C) { const int st = b / 1024, sb = b % 1024, swz = sb ^ (((sb >> 9) & 1) << 5); R = (st >> 1) * 16 + swz / 64; C = (st & 1) * 32 + (swz % 64) / 2; }
__device__ __forceinline__ int perm32(int rho) { const int n = rho >> 4, i = rho & 15; return 8 * (i >> 2) + 4 * n + (i & 3); }

template <class Epi, class Sched>
__device__ __forceinline__ void gemm_phase(LAS unsigned char* lds, const bf16_t* A, long long lda, const bf16_t* Bt, long long ldb, long long K, const Sched& S, const Epi& E) {
    int tid = threadIdx.x; asm volatile("" : "+v"(tid));
    const int wid = __builtin_amdgcn_readfirstlane(tid >> 6), lane = tid & 63, wr = wid >> 2, wc = wid & 3, fr = lane & 15, fq = lane >> 4;
    { unsigned long long a_ = (unsigned long long)A, b_ = (unsigned long long)Bt; unsigned alo = __builtin_amdgcn_readfirstlane((unsigned)a_), ahi = __builtin_amdgcn_readfirstlane((unsigned)(a_ >> 32)),
        blo = __builtin_amdgcn_readfirstlane((unsigned)b_), bhi = __builtin_amdgcn_readfirstlane((unsigned)(b_ >> 32));
      int lda_ = __builtin_amdgcn_readfirstlane((int)lda), ldb_ = __builtin_amdgcn_readfirstlane((int)ldb), k_ = __builtin_amdgcn_readfirstlane((int)K);
      asm volatile("" : "+s"(alo), "+s"(ahi), "+s"(blo), "+s"(bhi), "+s"(lda_), "+s"(ldb_), "+s"(k_));
      A = (const bf16_t*)(((unsigned long long)ahi << 32) | alo); Bt = (const bf16_t*)(((unsigned long long)bhi << 32) | blo); lda = lda_; ldb = ldb_; K = k_; }
    const int nt = (int)(K / BK);
    unsigned voffA[2], voffB[2];
#pragma unroll
    for (int i = 0; i < 2; ++i) { int R, C; stage_rc(tid * 16 + i * 8192, R, C); const int Rb = (R & ~31) + perm32(R & 31);
        voffA[i] = (unsigned)(R * (int)lda + C) * 2u; voffB[i] = (unsigned)(Rb * (int)ldb + C) * 2u; }
    const size_t kstep = (size_t)(BK * 2);
    const size_t hstepA = (size_t)HALF * lda * 2, hstepB = (size_t)HALF * ldb * 2;
    const unsigned ldsw = (unsigned)wid * 1024u;
    const int aoff = lds_byte(wr * 64 + fr, fq * 8), boff = lds_byte(wc * 32 + fr, fq * 8);
#define PG8_SA(b, h) (((b) * 2 + (h)) * HTB)
#define PG8_SB(b, h) ((4 + (b) * 2 + (h)) * HTB)
#define PG8_STAGE(bufoff, gbase, voff) do { _Pragma("unroll") for (int _i = 0; _i < 2; ++_i) \
        __builtin_amdgcn_global_load_lds((const unsigned*)((const char*)(gbase) + (voff)[_i]), (LAS unsigned*)(lds + (bufoff) + ldsw + _i * 8192), 16, 0, 0); } while (0)
#define PG8_LDA(dst, b, h) do { _Pragma("unroll") for (int m = 0; m < 4; ++m) _Pragma("unroll") for (int k = 0; k < 2; ++k) dst[m][k] = *(const LAS bf16x8*)(lds + PG8_SA(b, h) + aoff + m * 2048 + k * 1024); } while (0)
#define PG8_LDB(dst, b, h) do { _Pragma("unroll") for (int n = 0; n < 2; ++n) _Pragma("unroll") for (int k = 0; k < 2; ++k) dst[n][k] = *(const LAS bf16x8*)(lds + PG8_SB(b, h) + boff + n * 2048 + k * 1024); } while (0)
#define PG8_MMA(ai, bj, At, Bt_) do { __builtin_amdgcn_s_setprio(1); _Pragma("unroll") for (int m = 0; m < 4; ++m) _Pragma("unroll") for (int n = 0; n < 2; ++n) _Pragma("unroll") for (int k = 0; k < 2; ++k) \
        acc[ai][bj][m][n] = __builtin_amdgcn_mfma_f32_16x16x32_bf16(Bt_[n][k], At[m][k], acc[ai][bj][m][n], 0, 0, 0); __builtin_amdgcn_s_setprio(0); } while (0)
#define PG8_WAIT_V(n) asm volatile("s_waitcnt vmcnt(" #n ")" ::: "memory")
#define PG8_WAIT_L(n) asm volatile("s_waitcnt lgkmcnt(" #n ")" ::: "memory")
#define PG8_BAR __builtin_amdgcn_s_barrier()
#define PG8_SCHED __builtin_amdgcn_sched_barrier(0)
    Unit cur, nxt; int ui = 0;
    if (!S.next(0, cur)) return;
    f32x4 acc[2][2][4][2];
#pragma unroll
    for (int a = 0; a < 2; ++a)
#pragma unroll
        for (int b = 0; b < 2; ++b)
#pragma unroll
            for (int m = 0; m < 4; ++m)
#pragma unroll
                for (int n = 0; n < 2; ++n) acc[a][b][m][n] = (f32x4){0.f, 0.f, 0.f, 0.f};
    bf16x8 At[4][2], B0[2][2], B1[2][2];
    const char* cA = (const char*)A + cur.aoff; const char* cB = (const char*)Bt + cur.boff;
    S.a_ready(cur);
    PG8_STAGE(PG8_SB(0, 0), cB, voffB); PG8_STAGE(PG8_SA(0, 0), cA, voffA); PG8_STAGE(PG8_SB(0, 1), cB + hstepB, voffB); PG8_STAGE(PG8_SA(0, 1), cA + hstepA, voffA);
    if (wr == 1) PG8_BAR;
    PG8_WAIT_V(4); PG8_BAR;
    PG8_STAGE(PG8_SB(1, 0), cB + kstep, voffB); PG8_STAGE(PG8_SA(1, 0), cA + kstep, voffA); PG8_STAGE(PG8_SB(1, 1), cB + hstepB + kstep, voffB);
    PG8_WAIT_V(6); PG8_BAR;
    for (;;) {
        const bool has_next = S.next(ui + 1, nxt);
        const char* nA = has_next ? (const char*)A + nxt.aoff : cA; const char* nB = has_next ? (const char*)Bt + nxt.boff : cB;
#pragma nounroll
        for (int t = 0; t < nt; t += 2) {
            const bool last = (t == nt - 2);
            const char* a1 = cA + (size_t)(t + 1) * kstep;
            const char* a2 = last ? nA : cA + (size_t)(t + 2) * kstep; const char* b2 = last ? nB : cB + (size_t)(t + 2) * kstep;
            const char* a3 = a2 + kstep; const char* b3 = b2 + kstep;
            if (last && has_next) S.a_ready(nxt);
            PG8_LDB(B0, 0, 0); PG8_SCHED; PG8_LDA(At, 0, 0); PG8_STAGE(PG8_SA(1, 1), a1 + hstepA, voffA);
            PG8_WAIT_L(8); PG8_BAR; PG8_WAIT_L(0); PG8_MMA(0, 0, At, B0); PG8_BAR; PG8_SCHED;
            PG8_LDB(B1, 0, 1); PG8_STAGE(PG8_SB(0, 0), b2, voffB);
            PG8_BAR; PG8_WAIT_L(0); PG8_MMA(0, 1, At, B1); PG8_BAR;
            PG8_LDA(At, 0, 1); PG8_STAGE(PG8_SA(0, 0), a2, voffA);
            PG8_BAR; PG8_WAIT_L(0); PG8_MMA(1, 0, At, B0); PG8_BAR; PG8_SCHED;
            PG8_STAGE(PG8_SB(0, 1), b2 + hstepB, voffB);
            PG8_WAIT_V(6); PG8_BAR; PG8_MMA(1, 1, At, B1); PG8_BAR;
            PG8_LDB(B0, 1, 0); PG8_SCHED; PG8_LDA(At, 1, 0); PG8_STAGE(PG8_SA(0, 1), a2 + hstepA, voffA);
            PG8_WAIT_L(8); PG8_BAR; PG8_WAIT_L(0); PG8_MMA(0, 0, At, B0); PG8_BAR; PG8_SCHED;
            PG8_LDB(B1, 1, 1); PG8_STAGE(PG8_SB(1, 0), b3, voffB);
            PG8_BAR; PG8_WAIT_L(0); PG8_MMA(0, 1, At, B1); PG8_BAR;
            PG8_LDA(At, 1, 1); PG8_STAGE(PG8_SA(1, 0), a3, voffA);
            PG8_BAR; PG8_WAIT_L(0); PG8_MMA(1, 0, At, B0); PG8_BAR; PG8_SCHED;
            PG8_STAGE(PG8_SB(1, 1), b3 + hstepB, voffB);
            PG8_WAIT_V(6); PG8_BAR; PG8_MMA(1, 1, At, B1); PG8_BAR;
        }
#pragma unroll
        for (int ai = 0; ai < 2; ++ai)
#pragma unroll
            for (int m = 0; m < 4; ++m) { float lo[8], hi[8];
#pragma unroll
                for (int j = 0; j < 8; ++j) { lo[j] = acc[ai][0][m][j >> 2][j & 3]; hi[j] = acc[ai][1][m][j >> 2][j & 3]; }
                E.apply(cur, (long long)cur.pm * 256 + ai * HALF + wr * 64 + m * 16 + fr, wc * 32 + 8 * fq, lo, hi); PG8_SCHED; }
        S.done(cur);
        if (!has_next) break;
#pragma unroll
        for (int a = 0; a < 2; ++a)
#pragma unroll
            for (int b = 0; b < 2; ++b)
#pragma unroll
                for (int m = 0; m < 4; ++m)
#pragma unroll
                    for (int n = 0; n < 2; ++n) acc[a][b][m][n] = (f32x4){0.f, 0.f, 0.f, 0.f};
        cur = nxt; cA = nA; cB = nB; ++ui;
    }
    PG8_WAIT_V(0);
    if (wr == 0) PG8_BAR;
    PG8_BAR;
#undef PG8_SA
#undef PG8_SB
#undef PG8_STAGE
#undef PG8_LDA
#undef PG8_LDB
#undef PG8_MMA
#undef PG8_WAIT_V
#undef PG8_WAIT_L
#undef PG8_BAR
#undef PG8_SCHED
}

#define XB_TMO      128
#define XB_XCNT(j)  (256  + 64 * (j))
#define XB_XSUB(j)  (1280 + 64 * (j))
#define XB_XGEN(j)  (2304 + 64 * (j))
#define XB_TOP      3328
#define XB_TOPGEN   3392
#define XCD_BAR_WORDS 3456
#define XB_SPIN_CAP (1u << 18)
__device__ __forceinline__ unsigned xb_ld(unsigned* p)              { return __hip_atomic_load(p, __ATOMIC_RELAXED, __HIP_MEMORY_SCOPE_AGENT); }
__device__ __forceinline__ unsigned xb_add(unsigned* p, unsigned v) { return __hip_atomic_fetch_add(p, v, __ATOMIC_RELAXED, __HIP_MEMORY_SCOPE_AGENT); }
__device__ __forceinline__ unsigned xb_xcc_id() { return (unsigned)__builtin_amdgcn_s_getreg((3 << 11) | 20) & 0xFu; }
#define XB_SPIN(cond, bar) do { unsigned _sp = 0; while (cond) { __builtin_amdgcn_s_sleep(1); \
    if ((++_sp & 255u) == 0u) { if (xb_ld(&(bar)[XB_TMO])) break; if (_sp > XB_SPIN_CAP) { atomicAdd(&(bar)[XB_TMO], 1u); break; } } } } while (0)
struct XcdBarrier { unsigned* bar; unsigned x; volatile LAS unsigned* st; };
__device__ __forceinline__ XcdBarrier xcd_barrier_post(unsigned* bar, volatile LAS unsigned* st) {
    XcdBarrier b; b.bar = bar; b.x = xb_xcc_id(); b.st = st;
    if (threadIdx.x == 0) (void)xb_add(&bar[XB_XCNT(b.x)], 1u);
    return b;
}
__device__ __forceinline__ void xcd_barrier_complete(unsigned* bar, unsigned x, unsigned& nloc, unsigned& nx) {
    const unsigned G = gridDim.x * gridDim.y * gridDim.z;
    unsigned sum, cnt, mine, sp = 0u;
    for (;;) {
        sum = 0u; cnt = 0u; mine = 0u;
#pragma unroll
        for (unsigned j = 0; j < 16; ++j) { const unsigned c = xb_ld(&bar[XB_XCNT(j)]); sum += c; cnt += (c > 0u) ? 1u : 0u; mine = (j == x) ? c : mine; }
        if (sum == G) break;
        __builtin_amdgcn_s_sleep(1);
        if ((++sp & 255u) == 0u) { if (xb_ld(&bar[XB_TMO])) break; if (sp > XB_SPIN_CAP) { atomicAdd(&bar[XB_TMO], 1u); break; } }
    }
    nloc = mine > 0u ? mine : 1u; nx = cnt > 0u ? cnt : 1u;
}
__device__ __forceinline__ void xcd_barrier(const XcdBarrier& b) {
    asm volatile("s_waitcnt vmcnt(0)" ::: "memory");
    __syncthreads();
    if (threadIdx.x == 0) {
        unsigned* bar = b.bar;
        __builtin_amdgcn_s_waitcnt(0);
        unsigned nloc = b.st[0], nx = b.st[1];
        if (nloc == 0u) { xcd_barrier_complete(bar, b.x, nloc, nx); b.st[0] = nloc; b.st[1] = nx; }
        const unsigned old = xb_add(&bar[XB_XSUB(b.x)], 1u);
        const unsigned gen = old / nloc;
        if (old + 1u == (gen + 1u) * nloc) {
            __builtin_amdgcn_fence(__ATOMIC_RELEASE, "agent");
            asm volatile("s_waitcnt vmcnt(0)" ::: "memory");
            const unsigned og = xb_add(&bar[XB_TOP], 1u);
            const unsigned tg = og / nx;
            if (og + 1u == (tg + 1u) * nx) xb_add(&bar[XB_TOPGEN], 1u);
            else XB_SPIN(xb_ld(&bar[XB_TOPGEN]) == tg, bar);
            __builtin_amdgcn_fence(__ATOMIC_ACQUIRE, "agent");
            xb_add(&bar[XB_XGEN(b.x)], 1u);
            asm volatile("s_waitcnt vmcnt(0)" ::: "memory");
        } else {
            XB_SPIN(xb_ld(&bar[XB_XGEN(b.x)]) == gen, bar);
            __builtin_amdgcn_fence(__ATOMIC_ACQUIRE, "agent");
            asm volatile("s_waitcnt vmcnt(0)" ::: "memory");
        }
    }
    __syncthreads();
}
#endif
#ifndef CPU_EMU
typedef short bf16x8_t __attribute__((ext_vector_type(8)));
typedef short bf16x4_t __attribute__((ext_vector_type(4)));
typedef float f32x4_t __attribute__((ext_vector_type(4)));
typedef unsigned u32x4_t __attribute__((ext_vector_type(4)));
constexpr int AT_KS = 144, AT_VS = 136;
constexpr int AT_KBYTES = 64 * AT_KS, AT_VBYTES = 64 * AT_VS, AT_BUF = AT_KBYTES + AT_VBYTES;
struct AttnState { float m, l; f32x4_t o[4]; };
__device__ __forceinline__ void attn_init(AttnState& s) { s.m = -1e30f; s.l = 0.f;
#pragma unroll
    for (int d = 0; d < 4; ++d) s.o[d] = (f32x4_t){0.f, 0.f, 0.f, 0.f}; }
__device__ __forceinline__ unsigned pack2bf(float lo, float hi) { return (unsigned)f2bf(lo) | ((unsigned)f2bf(hi) << 16); }
template <class Valid> __device__ __forceinline__ void attn_tile(const LAS unsigned char* kt, const LAS unsigned char* vt, const bf16x8_t (&bq)[2], AttnState& st, int lane, const Valid& valid) {
    const int r = lane & 15, q = lane >> 4;
    f32x4_t s[4];
#pragma unroll
    for (int kb = 0; kb < 4; ++kb) { s[kb] = (f32x4_t){0.f, 0.f, 0.f, 0.f};
#pragma unroll
        for (int ks = 0; ks < 2; ++ks) { const bf16x8_t a = *(const LAS bf16x8_t*)(kt + (16 * kb + r) * AT_KS + (32 * ks + 8 * q) * 2); s[kb] = __builtin_amdgcn_mfma_f32_16x16x32_bf16(a, bq[ks], s[kb], 0, 0, 0); } }
    float mx = -1e30f;
#pragma unroll
    for (int kb = 0; kb < 4; ++kb)
#pragma unroll
        for (int j = 0; j < 4; ++j) { const float v = valid(kb, j) ? s[kb][j] * 1.44269504f : -1e30f; s[kb][j] = v; mx = fmaxf(mx, v); }
    mx = fmaxf(mx, __shfl_xor(mx, 16)); mx = fmaxf(mx, __shfl_xor(mx, 32));
    const float mn = fmaxf(st.m, mx), alpha = __builtin_amdgcn_exp2f(st.m - mn);
    float rs = 0.f;
#pragma unroll
    for (int kb = 0; kb < 4; ++kb)
#pragma unroll
        for (int j = 0; j < 4; ++j) { const float pv = s[kb][j] > -1e29f ? __builtin_amdgcn_exp2f(s[kb][j] - mn) : 0.f; s[kb][j] = pv; rs += pv; }
    rs += __shfl_xor(rs, 16); rs += __shfl_xor(rs, 32);
    st.l = st.l * alpha + rs; st.m = mn;
    bf16x8_t pb[2];
#pragma unroll
    for (int kk = 0; kk < 2; ++kk) { uint4 w; w.x = pack2bf(s[2 * kk][0], s[2 * kk][1]); w.y = pack2bf(s[2 * kk][2], s[2 * kk][3]); w.z = pack2bf(s[2 * kk + 1][0], s[2 * kk + 1][1]); w.w = pack2bf(s[2 * kk + 1][2], s[2 * kk + 1][3]);
        pb[kk] = __builtin_bit_cast(bf16x8_t, w); }
#pragma unroll
    for (int db = 0; db < 4; ++db) { st.o[db] = st.o[db] * alpha;
#pragma unroll
        for (int kk = 0; kk < 2; ++kk) { const LAS unsigned char* vp = vt + (16 * db + r) * AT_VS + (32 * kk + 4 * q) * 2;
            const bf16x4_t lo = *(const LAS bf16x4_t*)vp, hi = *(const LAS bf16x4_t*)(vp + 32);
            const bf16x8_t a = __builtin_shufflevector(lo, hi, 0, 1, 2, 3, 4, 5, 6, 7);
            st.o[db] = __builtin_amdgcn_mfma_f32_16x16x32_bf16(a, pb[kk], st.o[db], 0, 0, 0); } }
}
__device__ __forceinline__ void attn_stage_store(LAS unsigned char* buf, int tid, const uint4& kc, const uint4& vc) {
    const int key = tid >> 3, c = tid & 7;
    *(LAS u32x4_t*)(buf + key * AT_KS + c * 16) = (u32x4_t){kc.x, kc.y, kc.z, kc.w};
    LAS unsigned short* vt = (LAS unsigned short*)(buf + AT_KBYTES);
    const unsigned w[4] = {vc.x, vc.y, vc.z, vc.w};
#pragma unroll
    for (int i = 0; i < 4; ++i) { vt[((8 * c + 2 * i) * AT_VS) / 2 + key] = (unsigned short)(w[i] & 0xffffu); vt[((8 * c + 2 * i + 1) * AT_VS) / 2 + key] = (unsigned short)(w[i] >> 16); }
}
__device__ __forceinline__ void ph_selwin_mfma(const Params& p, LAS unsigned char* lds, int gC, int gG) {
    int tid = threadIdx.x; asm volatile("" : "+v"(tid));
    const int wid = tid >> 6, lane = tid & 63, r = lane & 15, q = lane >> 4;
    const bf16_t* P = WSP(bf16_t, p.oP); const unsigned* SELM = WSP(unsigned, p.oSELM); bf16_t* O = WSP(bf16_t, p.oO);
    const int nqb = (int)(p.S >> 6), units = (int)(p.B * 2) * nqb;
    for (int u = gC; u < units; u += gG) {
        const int cur = nqb - 1 - (u % nqb), bg = u / nqb, b = bg >> 1, g = bg & 1;
        const long long t0 = (long long)b * p.S + (long long)cur * 64;
        const int hd = 2 * g + (wid >> 2); const int tq = (wid & 3) * 16 + r; const long long tok = t0 + tq; const int sq = cur * 64 + tq;
        bf16x8_t bq[2];
#pragma unroll
        for (int ks = 0; ks < 2; ++ks) bq[ks] = *(const bf16x8_t*)(P + tok * PW + C_Q + hd * 64 + 32 * ks + 8 * q);
        unsigned un = SELM[(t0 + lane) * 2 + g];
#pragma unroll
        for (int o = 32; o > 0; o >>= 1) un |= __shfl_xor(un, o);
        un = __builtin_amdgcn_readfirstlane(un);
        const unsigned mymask = SELM[tok * 2 + g];
        const int wlo = cur - 8 > 0 ? cur - 8 : 0, nwin = cur - wlo + 1, nsel = __builtin_popcount(un), ntile = nwin + nsel;
        AttnState sw, ss; attn_init(sw); attn_init(ss);
        unsigned rem = un; int blk = wlo;
        uint4 kc, vc;
        { const long long kr = ((long long)b * p.S + (long long)blk * 64 + (tid >> 3)) * PW + g * 64 + (tid & 7) * 8; kc = *(const uint4*)(P + kr + C_KW); vc = *(const uint4*)(P + kr + C_VW); }
        attn_stage_store(lds, tid, kc, vc);
        __syncthreads();
        for (int i = 0; i < ntile; ++i) {
            const bool win = i < nwin; const int cb = blk;
            int nb = 0; bool nwinf = false; const bool has = i + 1 < ntile;
            if (has) { if (i + 1 < nwin) { nb = wlo + i + 1; nwinf = true; } else { nb = __builtin_ctz(rem); rem &= rem - 1; }
                const long long kr = ((long long)b * p.S + (long long)nb * 64 + (tid >> 3)) * PW + g * 64 + (tid & 7) * 8;
                kc = *(const uint4*)(P + kr + (nwinf ? C_KW : C_KS)); vc = *(const uint4*)(P + kr + (nwinf ? C_VW : C_VS)); }
            const LAS unsigned char* buf = lds + (i & 1) * AT_BUF;
            const int kbase = cb * 64 + 4 * q;
            if (win) attn_tile(buf, buf + AT_KBYTES, bq, sw, lane, [&](int kb, int j) { const int key = kbase + 16 * kb + j; return key <= sq && key > sq - 512; });
            else { const bool on = (mymask >> cb) & 1u; attn_tile(buf, buf + AT_KBYTES, bq, ss, lane, [&](int kb, int j) { const int key = kbase + 16 * kb + j; return on && key <= sq; }); }
            if (has) attn_stage_store(lds + ((i + 1) & 1) * AT_BUF, tid, kc, vc);
            blk = nb;
            __syncthreads();
        }
        const float g1 = sigmoidf_(bf2f(P[tok * PW + C_NG + hd * 3 + 1])) / ss.l, g2 = sigmoidf_(bf2f(P[tok * PW + C_NG + hd * 3 + 2])) / sw.l;
#pragma unroll
        for (int db = 0; db < 4; ++db) { bf16_t* od = O + tok * 1024 + hd * 64 + 16 * db + 4 * q; const uint2 pv = *(const uint2*)od;
            const float r0 = u2f(pv.x << 16) + g1 * ss.o[db][0] + g2 * sw.o[db][0], r1 = u2f(pv.x & 0xffff0000u) + g1 * ss.o[db][1] + g2 * sw.o[db][1];
            const float r2 = u2f(pv.y << 16) + g1 * ss.o[db][2] + g2 * sw.o[db][2], r3 = u2f(pv.y & 0xffff0000u) + g1 * ss.o[db][3] + g2 * sw.o[db][3];
            uint2 w; w.x = pack2bf(r0, r1); w.y = pack2bf(r2, r3); *(uint2*)od = w; }
    }
}
__device__ __forceinline__ void ph_ca_attn_mfma(const Params& p, int l, LAS unsigned char* lds, int gC, int gG) {
    int tid = threadIdx.x; asm volatile("" : "+v"(tid));
    const int wid = tid >> 6, lane = tid & 63, r = lane & 15, q = lane >> 4;
    const bf16_t* CQ = WSP(bf16_t, p.oCQ); const bf16_t* KV = WSP(bf16_t, p.oKV) + (long long)l * 512; bf16_t* AO = WSP(bf16_t, p.oCAO);
    const int nqb = (int)(p.S >> 7), units = (int)(p.B * 4) * nqb;
    for (int u = gC; u < units; u += gG) {
        const int qb = u % nqb, bh = u / nqb, b = bh >> 2, hd = bh & 3;
        const long long tok = (long long)b * p.S + (long long)qb * 128 + wid * 16 + r;
        bf16x8_t bq[2];
#pragma unroll
        for (int ks = 0; ks < 2; ++ks) bq[ks] = *(const bf16x8_t*)(CQ + tok * 256 + hd * 64 + 32 * ks + 8 * q);
        AttnState st; attn_init(st);
        uint4 kc, vc;
        { const long long kr = ((long long)b * 256 + (tid >> 3)) * 1024 + hd * 64 + (tid & 7) * 8; kc = *(const uint4*)(KV + kr); vc = *(const uint4*)(KV + kr + 256); }
        attn_stage_store(lds, tid, kc, vc);
        __syncthreads();
        for (int i = 0; i < 4; ++i) {
            if (i < 3) { const long long kr = ((long long)b * 256 + (i + 1) * 64 + (tid >> 3)) * 1024 + hd * 64 + (tid & 7) * 8; kc = *(const uint4*)(KV + kr); vc = *(const uint4*)(KV + kr + 256); }
            const LAS unsigned char* buf = lds + (i & 1) * AT_BUF;
            attn_tile(buf, buf + AT_KBYTES, bq, st, lane, [](int, int) { return true; });
            if (i < 3) attn_stage_store(lds + ((i + 1) & 1) * AT_BUF, tid, kc, vc);
            __syncthreads();
        }
        const float il = 1.0f / st.l;
#pragma unroll
        for (int db = 0; db < 4; ++db) { uint2 w; w.x = pack2bf(st.o[db][0] * il, st.o[db][1] * il); w.y = pack2bf(st.o[db][2] * il, st.o[db][3] * il); *(uint2*)(AO + tok * 256 + hd * 64 + 16 * db + 4 * q) = w; }
    }
}
#endif
#ifdef CPU_EMU
struct Ctx { long long gtid, gsz, gw, nw; int lane, G, c; };
#define GEMM(A, lda, Bt, ldb, K, S, E) gemm_cpu(A, lda, Bt, ldb, K, S, E)
#define GRID_BARRIER() do { } while (0)
#else
struct Ctx { LAS unsigned char* lds; XcdBarrier bar; };
#define GEMM(A, lda, Bt, ldb, K, S, E) gemm_phase(cx.lds, A, lda, Bt, ldb, K, S, E)
#define GRID_BARRIER() xcd_barrier(cx.bar)
#endif
constexpr int N_PHASES = 56;

template <int KIND> DEVI void run_program(const Params& p, const Ctx& cx, int pb, int pe) {
    int ph = 0;
#define T p.T
#define DFF p.DFF
#ifdef CPU_EMU
    const long long gsz = cx.gsz, nw = cx.nw; const int gG = cx.G, gC = cx.c;
#else
#define gsz ((long long)gridDim.x * 512)
#define nw ((long long)gridDim.x * 8)
#define gG ((int)gridDim.x)
#define gC ((int)blockIdx.x)
#endif
#define H WSP(bf16_t, p.oH)
#define P WSP(bf16_t, p.oP)
#define O WSP(bf16_t, p.oO)
#define BO WSP(bf16_t, p.oBO)
#define MG WSP(bf16_t, p.oMG)
#define CQ WSP(bf16_t, p.oCQ)
#define CAO WSP(bf16_t, p.oCAO)
#define MEMN WSP(bf16_t, p.oMEMN)
#define ACT WSP(bf16_t, p.oACT)
#define WFFN WSP(bf16_t, p.oWFFN)
#ifdef CPU_EMU
#define OPAQUE_V(x) do { } while (0)
#define PH_IDX long long gtid = cx.gtid, gw = cx.gw; int lane = cx.lane
#else
#define OPAQUE_V(x) asm volatile("" : "+v"(x))
#define PH_IDX unsigned tx_ = threadIdx.x; OPAQUE_V(tx_); long long gtid = (long long)blockIdx.x * 512 + tx_, gw = (long long)(tx_ >> 6) * gridDim.x + blockIdx.x; int lane = tx_ & 63
#endif
#define PH_BEGIN(k) if (ph >= pb && ph < pe) { if constexpr (KIND < 0 || KIND == (k)) { PH_IDX; OPAQUE_V(gtid); OPAQUE_V(gw); OPAQUE_V(lane); (void)gtid; (void)gw; (void)lane;
#define PH_END   } if (ph + 1 < pe) GRID_BARRIER(); } ++ph;
    PH_BEGIN(0)
        ph_convert_layer(p, 0, gtid, gsz); ph_convert_layer(p, 1, gtid, gsz); ph_convert_ffn(p, gtid, gsz); ph_rope(p, gtid, gsz);
        ph_rmsnorm(p, p.in[I_MEM], p.B * 256, p.in[I_MEM_NORM], MEMN, 0, nullptr, gw, nw, lane);
        ph_rmsnorm(p, p.in[I_X], T, p.in[I_NORM_MIX], H, 1, p.out, gw, nw, lane);
    PH_END
    PH_BEGIN(1)
        { SchedPlain S; S.init(p.B * 256, 1024, 1024, 1024, gG, gC); EpStore E{WSP(bf16_t, p.oKV), 1024, 1.0f}; GEMM(MEMN, 1024, WSP(bf16_t, p.oWKV), 1024, 1024, S, E); }
    PH_END
    for (int l = 0; l < 2; ++l) {
#define W WSP(bf16_t, p.oWL[l])
        PH_BEGIN(1) { SchedPlain S; S.init(T, 3072, 1024, 1024, gG, gC); EpStore E{P, 3072, 1.0f}; GEMM(H, 1024, W + W_IN, 1024, 1024, S, E); } PH_END
        PH_BEGIN(2) ph_rope_apply(p, gtid, gsz); ph_compress1(p, l, gtid, gsz); ph_pool(p, l, gtid, gsz); ph_rwkv_prep(p, l, gtid, gsz); ph_gla_prep(p, l, gtid, gsz); PH_END
        PH_BEGIN(3) ph_compress2(p, l, gtid, gsz); PH_END
        PH_BEGIN(4) ph_rwkv_scan(p, l, gw, nw, lane); ph_gla_scan(p, l, (gw + nw - (p.B * 4) % nw) % nw, nw, lane); ph_cmp_attn(p, gtid, gsz); PH_END
#ifdef CPU_EMU
        PH_BEGIN(5) ph_selwin(p, gtid, gsz); PH_END
#else
        PH_BEGIN(5) ph_selwin_mfma(p, cx.lds, gC, gG); PH_END
#endif
        for (int q = 0; q < 4; ++q) { const long long r0 = q * (T / 4);
            PH_BEGIN(6) { SchedBranch S; S.init(T / 4, gG, gC); EpStore E{BO, 4096, 1.0f}; GEMM(O + r0 * 1024, 1024, W + W_B, 256, 256, S, E); } PH_END
            PH_BEGIN(7) { SchedGate S; S.init(T / 4, gG, gC); EpGate E{BO, p.in[I_B_GATE] + l * 4096, MG, r0}; GEMM(H + r0 * 1024, 1024, W + W_G, 1024, 1024, S, E); } PH_END }
        PH_BEGIN(8) { SchedPlain S; S.init(T, 1024, 1024, 1024, gG, gC); EpResid E{p.out}; GEMM(MG, 1024, W + W_O, 1024, 1024, S, E); } PH_END
        PH_BEGIN(9) ph_rmsnorm(p, p.out, T, p.in[I_NORM_CA] + l * 1024, H, 0, nullptr, gw, nw, lane); PH_END
        PH_BEGIN(1) { SchedPlain S; S.init(T, 256, 1024, 1024, gG, gC); EpStore E{CQ, 256, 0.125f}; GEMM(H, 1024, W + W_CQ, 1024, 1024, S, E); } PH_END
#ifdef CPU_EMU
        PH_BEGIN(10) ph_ca_attn(p, l, gtid, gsz); PH_END
#else
        PH_BEGIN(10) ph_ca_attn_mfma(p, l, cx.lds, gC, gG); PH_END
#endif
        PH_BEGIN(8) { SchedPlain S; S.init(T, 1024, 256, 256, gG, gC); EpResid E{p.out}; GEMM(CAO, 256, W + W_CO, 256, 256, S, E); } PH_END
        PH_BEGIN(9) ph_rmsnorm(p, p.out, T, p.in[I_NORM_FFN] + l * 1024, H, l == 1 ? 2 : 0, nullptr, gw, nw, lane); if (l == 1) ph_convert_moe(p, gtid, gsz); PH_END
        if (l == 0) {
            PH_BEGIN(11) { SchedPlain S; S.init(T, 2 * DFF, 1024, 1024, gG, gC); EpSwiglu E{ACT, DFF, 0}; GEMM(H, 1024, WFFN, 1024, 1024, S, E); } PH_END
            PH_BEGIN(8) { SchedPlain S; S.init(T, 1024, DFF, DFF, gG, gC); EpResid E{p.out}; GEMM(ACT, DFF, WFFN + 2 * DFF * 1024, DFF, DFF, S, E); } PH_END
            PH_BEGIN(9) ph_rmsnorm(p, p.out, T, p.in[I_NORM_MIX] + 1024, H, 0, nullptr, gw, nw, lane); PH_END
        } else {
            PH_BEGIN(12) ph_moe_count(p, gtid, gsz); PH_END
            PH_BEGIN(12) ph_moe_offsets(p, gtid, gsz); PH_END
            PH_BEGIN(12) ph_moe_assign(p, gtid, gsz); PH_END
            PH_BEGIN(12) ph_moe_gather(p, gtid, gsz); PH_END
#define HS WSP(bf16_t, p.oHS)
#define ACTC WSP(bf16_t, p.oACTC)
#define MW WSP(bf16_t, p.oMOEW)
#define MC WSP(int, p.oMOEC)
            const int ct = (int)((p.NR / 256 + 3) / 4);
            for (int q = 0; q < 4; ++q) {
                PH_BEGIN(13) { SchedMoe S; const int nt_ = MC[16 + 8] / 256; S.t0 = q * ct; S.t1 = (q + 1) * ct < nt_ ? (q + 1) * ct : nt_; if (S.t1 < S.t0) S.t1 = S.t0; S.nN = (int)(2 * DFF / 256); S.G = gG; S.c = gC; S.lda = 1024; S.ldb = 1024; S.per_e = 3 * 1024 * DFF * 2;
#pragma unroll
                    for (int e = 0; e < 9; ++e) S.base[e] = MC[16 + e];
                    EpSwiglu E{ACTC, DFF, (long long)S.t0 * 256}; GEMM(HS, 1024, MW, 1024, 1024, S, E); } PH_END
                PH_BEGIN(14) { SchedMoe S; const int nt_ = MC[16 + 8] / 256; S.t0 = q * ct; S.t1 = (q + 1) * ct < nt_ ? (q + 1) * ct : nt_; if (S.t1 < S.t0) S.t1 = S.t0; S.nN = 4; S.G = gG; S.c = gC; S.lda = DFF; S.ldb = DFF; S.per_e = 3 * 1024 * DFF * 2;
#pragma unroll
                    for (int e = 0; e < 9; ++e) S.base[e] = MC[16 + e];
                    EpMoeDown E{WSP(bf16_t, p.oY), WSP(float, p.oROWW)}; GEMM(ACTC - (long long)S.t0 * 256 * DFF, DFF, MW + 2 * DFF * 1024, DFF, DFF, S, E); } PH_END }
            PH_BEGIN(15) ph_final(p, gw, nw, lane); PH_END
        }
    }
#undef PH_BEGIN
#undef PH_END
#undef H
#undef P
#undef O
#undef BO
#undef MG
#undef CQ
#undef CAO
#undef MEMN
#undef ACT
#undef WFFN
#undef T
#undef DFF
#undef W
#undef HS
#undef ACTC
#undef MW
#undef MC
#ifndef CPU_EMU
#undef gsz
#undef nw
#undef gG
#undef gC
#endif
}

#ifndef CPU_EMU
template <int KIND> __global__ __launch_bounds__(512, 2) void mk_fwd(Params p, int pb, int pe) {
    extern __shared__ __attribute__((aligned(16))) unsigned char shm[];
    Ctx cx; cx.lds = (LAS unsigned char*)shm;
    volatile LAS unsigned* xbw = (volatile LAS unsigned*)(cx.lds + STAGE_BYTES);
    if (threadIdx.x == 0) { xbw[0] = 0u; xbw[1] = 0u; xbw[2] = 0u; xbw[3] = 0u; }
    __syncthreads();
    cx.bar = xcd_barrier_post((unsigned*)(p.ws + p.oBAR), xbw);
    run_program<KIND>(p, cx, pb, pe);
}
#ifndef MK_ONE
#define MK_ONE 1
#endif
#if !MK_ONE
static const int kPhaseKind[N_PHASES] = { 0, 1,
    1, 2, 3, 4, 5, 6, 7, 6, 7, 6, 7, 6, 7, 8, 9, 1, 10, 8, 9, 11, 8, 9,
    1, 2, 3, 4, 5, 6, 7, 6, 7, 6, 7, 6, 7, 8, 9, 1, 10, 8, 9, 12, 12, 12, 12, 13, 14, 13, 14, 13, 14, 13, 14, 15 };
#endif
typedef void (*mk_fn)(Params, int, int);
extern "C" void kernel_launch(void* const* d_in, const int* in_sizes, int n_in, void* d_out, int out_size, void* d_ws, size_t ws_size, hipStream_t stream) {
    (void)in_sizes; (void)n_in; (void)out_size;
    Params p; memset(&p, 0, sizeof(p));
    for (int i = 0; i < N_INPUTS; ++i) p.in[i] = (const float*)d_in[i];
    p.out = (float*)d_out; p.ws = (unsigned char*)d_ws;
    make_layout(p, 32, 2048, 2816);
    for (int j = 0; j < 8; ++j) p.inv_freq[j] = (float)pow(500000.0, -(double)(2 * j) / 16.0);
    if ((size_t)p.wsNeed > ws_size) { fprintf(stderr, "workspace too small: need %lld have %zu\n", p.wsNeed, ws_size); return; }
    const size_t lds_bytes = STAGE_BYTES + 16;
#if MK_ONE
    static const mk_fn fns[1] = { mk_fwd<-1> }; const int nf = 1;
#else
    static const mk_fn fns[16] = { mk_fwd<0>, mk_fwd<1>, mk_fwd<2>, mk_fwd<3>, mk_fwd<4>, mk_fwd<5>, mk_fwd<6>, mk_fwd<7>, mk_fwd<8>, mk_fwd<9>, mk_fwd<10>, mk_fwd<11>, mk_fwd<12>, mk_fwd<13>, mk_fwd<14>, mk_fwd<15> }; const int nf = 16;
#endif
    static int grid = 0;
    if (!grid) { int dev = 0, cus = 0; (void)hipGetDevice(&dev); (void)hipDeviceGetAttribute(&cus, hipDeviceAttributeMultiprocessorCount, dev);
        for (int k = 0; k < nf; ++k) (void)hipFuncSetAttribute((const void*)fns[k], hipFuncAttributeMaxDynamicSharedMemorySize, (int)lds_bytes);
        int per_cu = 0; (void)hipOccupancyMaxActiveBlocksPerMultiprocessor(&per_cu, (const void*)fns[0], 512, lds_bytes); (void)hipGetLastError();
        grid = cus > 0 ? cus : 256; }
    (void)hipMemsetAsync(p.ws + p.oBAR, 0, 16384 + 4096, stream);
#if MK_ONE
    hipLaunchKernelGGL(fns[0], dim3(grid), dim3(512), lds_bytes, stream, p, 0, N_PHASES);
#else
    for (int ph = 0; ph < N_PHASES; ++ph) hipLaunchKernelGGL(fns[kPhaseKind[ph]], dim3(grid), dim3(512), lds_bytes, stream, p, ph, ph + 1);
#endif
}
#endif
```

```cpp
#ifndef CPU_EMU
#include <hip/hip_runtime.h>
#include <cstdio>
#include <cstdint>
#include <cstring>
#define DEVI __device__ __forceinline__
#define DEVM __device__ __forceinline__
#else
#include <cmath>
#include <cstdio>
#include <cstdint>
#include <cstring>
#include <cstdlib>
#define DEVI static inline
#define DEVM inline
struct uint4 { unsigned x, y, z, w; };
#endif

typedef unsigned short bf16_t;
#ifdef CPU_EMU
static inline float u2f(unsigned u) { float f; memcpy(&f, &u, 4); return f; }
static inline unsigned f2u(float f) { unsigned u; memcpy(&u, &f, 4); return u; }
#else
DEVI float u2f(unsigned u) { return __uint_as_float(u); }
DEVI unsigned f2u(float f) { return __float_as_uint(f); }
#endif
DEVI float bf2f(bf16_t b) { return u2f(((unsigned)b) << 16); }
DEVI bf16_t f2bf(float f) { unsigned u = f2u(f); u += 0x7FFFu + ((u >> 16) & 1u); return (bf16_t)(u >> 16); }
DEVI float sigmoidf_(float x) { return 1.0f / (1.0f + expf(-x)); }
DEVI float siluf_(float x) { return x / (1.0f + expf(-x)); }
DEVI float softplusf_(float x) { return x > 20.f ? x : log1pf(expf(x)); }
DEVI float gelu_tanhf_(float x) { return 0.5f * x * (1.0f + tanhf(0.7978845608028654f * (x + 0.044715f * x * x * x))); }

constexpr int DM = 1024;
constexpr int PW = 3072;
constexpr int INW = 2972;
constexpr int C_Q = 0, C_KC = 256, C_VC = 384, C_KS = 512, C_VS = 640, C_KW = 768, C_VW = 896, C_NG = 1024;
constexpr int C_POOL = 1040;
constexpr int C_RW = 1296;
constexpr int C_GLA = 2192;
constexpr int C_VRES = 2976;
constexpr int NCMPH = 128;

enum { I_X = 0, I_MEM, I_POS, I_NORM_MIX, I_W_IN, I_CMP_PE, I_CMP_W1, I_CMP_W2, I_POOL_W, I_POOL_SCALE, I_RW_MU, I_RW_W0, I_RW_W2, I_RW_A0, I_RW_A2, I_RW_G2,
       I_RW_V0, I_RW_V1, I_RW_V2, I_RW_KK, I_RW_KA, I_RW_RK, I_RW_LN, I_GLA_A2, I_GLA_AB, I_GLA_NORM, I_W_GATE, I_B_GATE, I_W_BRANCH, I_W_OUT, I_NORM_CA, I_MEM_NORM,
       I_CA_Q, I_CA_KV, I_CA_O, I_NORM_FFN, I_FFN_G, I_FFN_U, I_FFN_D, I_MOE_R, I_MOE_G, I_MOE_U, I_MOE_D, I_NORM_FINAL, N_INPUTS };

struct Params {
    const float* in[N_INPUTS];
    float* out;
    unsigned char* ws;
    long long B, S, T, DFF, NC, NR;
    float inv_freq[8];
    long long oBAR, oMOEC, oROPE, oKCMP, oVCMP, oHID, oSELM, oKV, oRK, oTOKE, oTOKW, oTOKS, oR2T, oROWW, oCCNT, oCOFF;
    long long oWL[2], oWKV, oWFFN, oVF, oH, oP, oO, oBO, oMG, oRWW, oRWX, oGA, oCQ, oCAO, oMEMN, oACT, oY, oHS, oMOEW, oACTC, wsNeed;
};
constexpr long long W_IN = 0, W_G = W_IN + 3072LL * 1024, W_B = W_G + 4096LL * 1024, W_O = W_B + 4LL * 1024 * 256, W_CQ = W_O + 1024LL * 1024, W_CKV = W_CQ + 256LL * 1024,
                    W_CO = W_CKV + 512LL * 1024, W_LAYER = W_CO + 1024LL * 256;

static inline long long al256(long long x) { return (x + 255) & ~255LL; }
static inline void make_layout(Params& p, long long B, long long S, long long DFF) {
    p.B = B; p.S = S; p.T = B * S; p.DFF = DFF; p.NC = (S - 32) / 16 + 1; p.NR = 2 * p.T + 2048;
    const long long T = p.T;
    long long o = 0;
    auto take = [&](long long bytes) { long long r = o; o = al256(o + bytes); return r; };
    p.oBAR = take(16384); p.oMOEC = take(4096);
    p.oROPE = take(T * 16 * 4);
    p.oKCMP = take(B * p.NC * 128 * 4); p.oVCMP = take(B * p.NC * 128 * 4); p.oHID = take(B * p.NC * 4 * 128 * 4);
    p.oSELM = take(T * 2 * 4);
    p.oKV = take(2 * B * 256 * 512 * 2);
    p.oRK = take(T * 4 * 4);
    p.oTOKE = take(T * 2 * 4); p.oTOKW = take(T * 2 * 4); p.oTOKS = take(T * 2 * 4); p.oR2T = take(p.NR * 4); p.oROWW = take(p.NR * 4);
    p.oCCNT = take((T / 64) * 8 * 4); p.oCOFF = take((T / 64) * 8 * 4);
    p.oWL[0] = take(W_LAYER * 2); p.oWL[1] = take(W_LAYER * 2); p.oWKV = take(2LL * 512 * 1024 * 2); p.oWFFN = take(3 * 1024 * DFF * 2);
    p.oVF = take(T * 256 * 2);
    p.oH = take(T * 1024 * 2);
    p.oP = take(T * 3072 * 2);
    p.oO = take(T * 1024 * 2);
    p.oBO = take(T * 2048);
    p.oMG = take(T * 2048);
    long long end_main = o;
    p.oRWW = p.oBO;
    p.oRWX = p.oRWW + T * 1024;
    p.oGA = p.oRWX + T * 2560;
    p.oCQ = p.oP; p.oCAO = p.oP + T * 512;
    p.oMEMN = p.oBO;
    p.oACT = p.oP;
    p.oY = p.oVF; long long q = al256(p.oY + p.NR * 2048);
    p.oHS = q; q = al256(q + p.NR * 2048);
    p.oMOEW = q; q = al256(q + 8LL * 3 * 1024 * DFF * 2);
    const long long ntmax = p.NR / 256, ct = (ntmax + 3) / 4;
    p.oACTC = q; q = al256(q + ct * 256 * DFF * 2);
    p.wsNeed = q > end_main ? q : end_main;
}
#define WSP(T_, off) ((T_*)(p.ws + (off)))

DEVI void cvt_T(bf16_t* dst, const float* src, long long K, long long N, long long Npad, long long ld, long long gtid, long long gsz) {
    for (long long i = gtid; i < Npad * K; i += gsz) { const long long n = i / K, k = i % K; dst[i] = n < N ? f2bf(src[k * ld + n]) : (bf16_t)0; }
}
DEVI void cvt_GU(bf16_t* dst, const float* wg, const float* wu, long long DFF, long long gtid, long long gsz) {
    for (long long i = gtid; i < 2 * DFF * 1024; i += gsz) { const long long rr = i / 1024, k = i % 1024, t = rr >> 8, w = rr & 255;
        dst[i] = f2bf((w < 128 ? wg : wu)[k * DFF + t * 128 + (w & 127)]); }
}
DEVI void ph_convert_layer(const Params& p, int l, long long gtid, long long gsz) {
    bf16_t* W = WSP(bf16_t, p.oWL[l]);
    for (long long i = gtid; i < 3072LL * 1024; i += gsz) { const long long n = i >> 10, k = i & 1023; float v = 0.f;
        if (n < 1036) v = p.in[I_W_IN][((long long)l * 1024 + k) * INW + n];
        else if (n >= C_POOL && n < C_VRES) v = p.in[I_W_IN][((long long)l * 1024 + k) * INW + n - 4];
        else if (n >= C_VRES && n < C_VRES + 32 && l == 1) v = p.in[I_RW_V1][k * 32 + (n - C_VRES)];
        W[W_IN + i] = f2bf(v); }
    for (int i = 0; i < 4; ++i) cvt_T(W + W_G + (long long)i * 1024 * 1024, p.in[I_W_GATE] + ((long long)l * 4 + i) * 1024 * 1024, 1024, 1024, 1024, 1024, gtid, gsz);
    for (int i = 0; i < 4; ++i) cvt_T(W + W_B + (long long)i * 1024 * 256, p.in[I_W_BRANCH] + ((long long)l * 4 + i) * 256 * 1024, 256, 1024, 1024, 1024, gtid, gsz);
    cvt_T(W + W_O, p.in[I_W_OUT] + (long long)l * 1024 * 1024, 1024, 1024, 1024, 1024, gtid, gsz);
    cvt_T(W + W_CQ, p.in[I_CA_Q] + (long long)l * 1024 * 256, 1024, 256, 256, 256, gtid, gsz);
    cvt_T(WSP(bf16_t, p.oWKV) + (long long)l * 512 * 1024, p.in[I_CA_KV] + (long long)l * 1024 * 512, 1024, 512, 512, 512, gtid, gsz);
    cvt_T(W + W_CO, p.in[I_CA_O] + (long long)l * 256 * 1024, 256, 1024, 1024, 1024, gtid, gsz);
}
DEVI void ph_convert_ffn(const Params& p, long long gtid, long long gsz) {
    bf16_t* W = WSP(bf16_t, p.oWFFN);
    cvt_GU(W, p.in[I_FFN_G], p.in[I_FFN_U], p.DFF, gtid, gsz);
    cvt_T(W + 2 * p.DFF * 1024, p.in[I_FFN_D], p.DFF, 1024, 1024, 1024, gtid, gsz);
}
DEVI void ph_convert_moe(const Params& p, long long gtid, long long gsz) {
    const long long DFF = p.DFF, per = 3 * 1024 * DFF;
    for (int e = 0; e < 8; ++e) { bf16_t* W = WSP(bf16_t, p.oMOEW) + e * per;
        cvt_GU(W, p.in[I_MOE_G] + (long long)e * 1024 * DFF, p.in[I_MOE_U] + (long long)e * 1024 * DFF, DFF, gtid, gsz);
        cvt_T(W + 2 * DFF * 1024, p.in[I_MOE_D] + (long long)e * DFF * 1024, DFF, 1024, 1024, 1024, gtid, gsz); }
}
DEVI void ph_rope(const Params& p, long long gtid, long long gsz) {
    const int* pos = (const int*)p.in[I_POS]; float* R = WSP(float, p.oROPE);
    for (long long i = gtid; i < p.T * 8; i += gsz) { const long long t = i >> 3; const int j = (int)(i & 7);
        const float ang = (float)pos[t] * p.inv_freq[j];
        double a = (double)ang; a -= 6.283185307179586476925 * floor(a * 0.15915494309189533577 + 0.5);
        const float ar = (float)a; R[t * 16 + j] = cosf(ar); R[t * 16 + 8 + j] = sinf(ar); }
}
DEVI void ph_rope_apply(const Params& p, long long gtid, long long gsz) {
    bf16_t* P = WSP(bf16_t, p.oP); const float* R = WSP(float, p.oROPE);
    for (long long i = gtid; i < p.T * 8; i += gsz) { const long long t = i >> 3; const int w = (int)(i & 7);
        const int col = w < 4 ? C_Q + w * 64 : (w < 6 ? C_KS + (w - 4) * 64 : C_KW + (w - 6) * 64);
        bf16_t* x = P + t * PW + col; const float* r = R + t * 16; const float sc = w < 4 ? 0.125f : 1.0f;
        for (int j = 0; j < 8; ++j) { const float a = bf2f(x[j]), b = bf2f(x[j + 8]), c = r[j], s = r[8 + j]; x[j] = f2bf((a * c - b * s) * sc); x[j + 8] = f2bf((b * c + a * s) * sc); }
        if (w < 4) for (int j = 16; j < 64; ++j) x[j] = f2bf(bf2f(x[j]) * 0.125f); }
}
DEVI void ph_compress1(const Params& p, int l, long long gtid, long long gsz) {
    const bf16_t* P = WSP(bf16_t, p.oP); float* HID = WSP(float, p.oHID);
    const float* pe = p.in[I_CMP_PE] + (long long)l * 2 * 32 * 64; const float* w1 = p.in[I_CMP_W1] + (long long)l * 2 * 32 * 64 * 128;
    const long long n_items = p.B * p.NC * 4 * 128;
    for (long long i = gtid; i < n_items; i += gsz) { const int f = (int)(i & 127); const int j = (int)((i >> 7) & 1), g = (int)((i >> 8) & 1); const long long bn = i >> 9, n = bn % p.NC, b = bn / p.NC;
        const int col = (j == 0 ? C_KC : C_VC) + g * 64; float acc = 0.f;
        for (int ll = 0; ll < 32; ++ll) { const bf16_t* x = P + (b * p.S + n * 16 + ll) * PW + col; const float* pp = pe + (j * 32 + ll) * 64; const float* ww = w1 + ((long long)(j * 32 + ll) * 64) * 128 + f;
            for (int d = 0; d < 64; ++d) acc += (bf2f(x[d]) + pp[d]) * ww[d * 128]; }
        HID[i] = gelu_tanhf_(acc); }
}
DEVI void ph_compress2(const Params& p, int l, long long gtid, long long gsz) {
    const float* HID = WSP(float, p.oHID); const float* w2 = p.in[I_CMP_W2] + (long long)l * 2 * 128 * 64; const float* R = WSP(float, p.oROPE);
    float* KC = WSP(float, p.oKCMP); float* VC = WSP(float, p.oVCMP);
    const long long n_items = p.B * p.NC * 2 * 2 * 8;
    for (long long i = gtid; i < n_items; i += gsz) { const int d8 = (int)(i & 7), j = (int)((i >> 3) & 1), g = (int)((i >> 4) & 1); const long long bn = i >> 5, n = bn % p.NC, b = bn / p.NC;
        const float* h = HID + ((bn * 2 + g) * 2 + j) * 128; const float* w = w2 + (long long)j * 128 * 64;
        float a[8];
#pragma unroll
        for (int m = 0; m < 8; ++m) a[m] = 0.f;
        for (int f = 0; f < 128; ++f) { const float hv = h[f];
#pragma unroll
            for (int m = 0; m < 8; ++m) a[m] += hv * w[f * 64 + d8 + 8 * m]; }
        if (j == 0) { const float* r = R + (b * p.S + n * 16 + 31) * 16; const float x0 = a[0], x1 = a[1], cs = r[d8], sn = r[8 + d8]; a[0] = x0 * cs - x1 * sn; a[1] = x1 * cs + x0 * sn; }
        float* dst = (j == 0 ? KC : VC) + (bn * 2 + g) * 64;
#pragma unroll
        for (int m = 0; m < 8; ++m) dst[d8 + 8 * m] = a[m]; }
}
DEVI void ph_pool(const Params& p, int l, long long gtid, long long gsz) {
    const bf16_t* P = WSP(bf16_t, p.oP); bf16_t* O = WSP(bf16_t, p.oO);
    const float* pw = p.in[I_POOL_W] + (long long)l * 4 * 64 * 64; const float* ps = p.in[I_POOL_SCALE] + (long long)l * 256;
    for (long long i = gtid; i < p.T * 4; i += gsz) { const long long t = i >> 2; const int g = (int)(i & 3); const long long s = t % p.S; const int win = 2 << g;
        const int cnt = (int)(s + 1 < win ? s + 1 : win); const float inv = 1.0f / (float)cnt;
        float dv[64];
#pragma unroll
        for (int c = 0; c < 64; ++c) dv[c] = 0.f;
        for (int k = 0; k < cnt; ++k) { const bf16_t* x = P + (t - k) * PW + C_POOL + g * 64;
#pragma unroll
            for (int c = 0; c < 64; ++c) dv[c] += bf2f(x[c]); }
        { const bf16_t* x = P + t * PW + C_POOL + g * 64;
#pragma unroll
            for (int c = 0; c < 64; ++c) dv[c] = dv[c] * inv - bf2f(x[c]); }
        const float* w = pw + g * 64 * 64;
        for (int d = 0; d < 64; ++d) { float a = 0.f;
#pragma unroll
            for (int c = 0; c < 64; ++c) a += dv[c] * w[c * 64 + d];
            O[t * 1024 + 256 + g * 64 + d] = f2bf(a * ps[g * 64 + d]); } }
}
DEVI void ph_rwkv_prep(const Params& p, int l, long long gtid, long long gsz) {
    const bf16_t* P = WSP(bf16_t, p.oP); float* RWW = WSP(float, p.oRWW); bf16_t* RWX = WSP(bf16_t, p.oRWX); float* RK = WSP(float, p.oRK); bf16_t* O = WSP(bf16_t, p.oO); bf16_t* VF = WSP(bf16_t, p.oVF);
    const float* mu = p.in[I_RW_MU] + l * 896; const float* w0 = p.in[I_RW_W0] + l * 256; const float* w2 = p.in[I_RW_W2] + l * 32 * 256; const float* a0 = p.in[I_RW_A0] + l * 256;
    const float* a2 = p.in[I_RW_A2] + l * 32 * 256; const float* g2 = p.in[I_RW_G2] + l * 64 * 256; const float* kkw = p.in[I_RW_KK] + l * 256; const float* kaw = p.in[I_RW_KA] + l * 256;
    const float* rkw = p.in[I_RW_RK] + l * 256; const float* v0 = p.in[I_RW_V0]; const float* v2 = p.in[I_RW_V2];
    for (long long i = gtid; i < p.T * 4; i += gsz) { const long long t = i >> 2; const int h = (int)(i & 3); const bool first = (t % p.S) == 0;
        const bf16_t* x = P + t * PW + C_RW; const bf16_t* xp = x - PW;
#define LERP(c) (first ? bf2f(x[c]) * (1.0f - mu[c]) : (bf2f(x[c]) + (bf2f(xp[c]) - bf2f(x[c])) * mu[c]))
        float nn = 0.f;
        for (int c = h * 64; c < h * 64 + 64; ++c) { const float kq = LERP(256 + c) * kkw[c]; nn += kq * kq; }
        const float rn = 1.0f / fmaxf(sqrtf(nn), 1e-12f);
        float rks = 0.f;
        for (int cc = 0; cc < 4; ++cc) { const int c0 = h * 64 + cc * 16;
            float zw[16], za[16], zg[16], zv[16];
#pragma unroll
            for (int u = 0; u < 16; ++u) { zw[u] = w0[c0 + u]; za[u] = a0[c0 + u]; zg[u] = 0.f; zv[u] = (l == 1) ? v0[c0 + u] : 0.f; }
            for (int j = 0; j < 32; ++j) { const float tw = tanhf(LERP(768 + j)), ad = LERP(800 + j), hv = (l == 1) ? bf2f(P[t * PW + C_VRES + j]) : 0.f;
#pragma unroll
                for (int u = 0; u < 16; ++u) { zw[u] += tw * w2[j * 256 + c0 + u]; za[u] += ad * a2[j * 256 + c0 + u]; if (l == 1) zv[u] += hv * v2[j * 256 + c0 + u]; } }
            for (int j = 0; j < 64; ++j) { const float sg = sigmoidf_(LERP(832 + j));
#pragma unroll
                for (int u = 0; u < 16; ++u) zg[u] += sg * g2[j * 256 + c0 + u]; }
#pragma unroll
            for (int u = 0; u < 16; ++u) { const int c = c0 + u;
                const float wlog = -softplusf_(-zw[u]) - 0.5f, dec = expf(-expf(wlog)), a = sigmoidf_(za[u]);
                const float r = LERP(c), k = LERP(256 + c); float v = LERP(512 + c);
                if (l == 0) VF[t * 256 + c] = f2bf(v); else { const float vf = bf2f(VF[t * 256 + c]); v = v + (vf - v) * sigmoidf_(zv[u]); }
                const float kk = k * kkw[c] * rn, k2 = k * (1.0f + (a - 1.0f) * kaw[c]), bb = kk * a;
                RWW[t * 256 + c] = dec; bf16_t* rx = RWX + t * 1280 + c;
                rx[0] = f2bf(r); rx[256] = f2bf(k2); rx[512] = f2bf(v); rx[768] = f2bf(kk); rx[1024] = f2bf(bb);
                rks += bf2f(f2bf(r)) * bf2f(f2bf(k2)) * rkw[c];
                O[t * 1024 + 512 + c] = f2bf(zg[u]); } }
        RK[t * 4 + h] = rks; }
#undef LERP
}
DEVI float rwkv_row_step(float (&st)[64], const float* w, const bf16_t* r, const bf16_t* k, const bf16_t* kk, const bf16_t* b, float v) {
    float skk = 0.f;
#pragma unroll
    for (int c = 0; c < 64; ++c) skk += st[c] * bf2f(kk[c]);
    float y = 0.f;
#pragma unroll
    for (int c = 0; c < 64; ++c) { st[c] = st[c] * w[c] - skk * bf2f(b[c]) + v * bf2f(k[c]); y += st[c] * bf2f(r[c]); }
    return y;
}
DEVI void ph_gla_prep(const Params& p, int l, long long gtid, long long gsz) {
    const bf16_t* P = WSP(bf16_t, p.oP); float* GA = WSP(float, p.oGA); bf16_t* O = WSP(bf16_t, p.oO);
    const float* a2 = p.in[I_GLA_A2] + l * 16 * 128; const float* ab = p.in[I_GLA_AB] + l * 128;
    for (long long i = gtid; i < p.T * 128; i += gsz) { const long long t = i >> 7; const int c = (int)(i & 127); const bf16_t* ad = P + t * PW + C_GLA + 512;
        float z = ab[c];
        for (int j = 0; j < 16; ++j) z += bf2f(ad[j]) * a2[j * 128 + c];
        GA[i] = expf(-softplusf_(-z) * 0.0625f);
        const bf16_t* og = P + t * PW + C_GLA + 528; O[t * 1024 + 768 + c] = f2bf(siluf_(bf2f(og[c]))); O[t * 1024 + 768 + 128 + c] = f2bf(siluf_(bf2f(og[128 + c]))); }
}
DEVI float gla_col_step(float (&st)[32], const float* a, const bf16_t* q, const bf16_t* k, float v) {
    float o = 0.f;
#pragma unroll
    for (int c = 0; c < 32; ++c) { st[c] = st[c] * a[c] + bf2f(k[c]) * v; o += st[c] * bf2f(q[c]); }
    return o * 0.17677669529663687f;
}
DEVI void ph_cmp_attn(const Params& p, long long gtid, long long gsz) {
    const bf16_t* P = WSP(bf16_t, p.oP); const float* KC = WSP(float, p.oKCMP); const float* VC = WSP(float, p.oVCMP); unsigned* SELM = WSP(unsigned, p.oSELM); bf16_t* O = WSP(bf16_t, p.oO);
    for (long long i = gtid; i < p.T * 2; i += gsz) { const long long t = i >> 1, b = t / p.S, s = t % p.S; const int g = (int)(i & 1);
        const int nv = s >= 31 ? (int)((s - 31) / 16 + 1) : 0;
        const int cur = (int)(s >> 6);
        const float* kc = KC + (b * p.NC * 2 + g) * 64; const float* vc = VC + (b * p.NC * 2 + g) * 64;
        float q0[64], q1[64];
        { const bf16_t* q = P + t * PW + C_Q + (2 * g) * 64;
#pragma unroll
          for (int d = 0; d < 64; ++d) { q0[d] = bf2f(q[d]); q1[d] = bf2f(q[64 + d]); } }
        float m0 = -3e38f, m1 = -3e38f;
        for (int n = 0; n < nv; ++n) { const float* k = kc + n * 128; float s0 = 0.f, s1 = 0.f;
#pragma unroll
            for (int d = 0; d < 64; ++d) { s0 += q0[d] * k[d]; s1 += q1[d] * k[d]; }
            m0 = fmaxf(m0, s0); m1 = fmaxf(m1, s1); }
        float z0 = 0.f, z1 = 0.f;
        for (int n = 0; n < nv; ++n) { const float* k = kc + n * 128; float s0 = 0.f, s1 = 0.f;
#pragma unroll
            for (int d = 0; d < 64; ++d) { s0 += q0[d] * k[d]; s1 += q1[d] * k[d]; }
            z0 += expf(s0 - m0); z1 += expf(s1 - m1); }
        const float iz0 = nv ? 1.0f / z0 : 0.f, iz1 = nv ? 1.0f / z1 : 0.f;
        unsigned mask;
        if (cur < 8) mask = (2u << cur) - 1u;
        else {
            float tv0 = -3e38f, tv1 = -3e38f, tv2 = -3e38f, tv3 = -3e38f, tv4 = -3e38f; int ti0 = 0, ti1 = 0, ti2 = 0, ti3 = 0, ti4 = 0;
            float carry = 0.f;
            for (int j = 0; j <= cur - 2; ++j) { float imp = carry;
                for (int mm = 0; mm < 4; ++mm) { const int n = 4 * j + mm; float pn = 0.f;
                    if (n < nv) { const float* k = kc + n * 128; float s0 = 0.f, s1 = 0.f;
#pragma unroll
                        for (int d = 0; d < 64; ++d) { s0 += q0[d] * k[d]; s1 += q1[d] * k[d]; }
                        pn = expf(s0 - m0) * iz0 + expf(s1 - m1) * iz1; }
                    if (mm < 3) imp += pn; else { imp += 0.5f * pn; carry = 0.5f * pn; } }
                if (j >= 1) {
                    float v = imp; int id = j;
                    if (v > tv0) { float tf = tv0; tv0 = v; v = tf; int tt = ti0; ti0 = id; id = tt; }
                    if (v > tv1) { float tf = tv1; tv1 = v; v = tf; int tt = ti1; ti1 = id; id = tt; }
                    if (v > tv2) { float tf = tv2; tv2 = v; v = tf; int tt = ti2; ti2 = id; id = tt; }
                    if (v > tv3) { float tf = tv3; tv3 = v; v = tf; int tt = ti3; ti3 = id; id = tt; }
                    if (v > tv4) { tv4 = v; ti4 = id; } } }
            mask = 1u | (1u << cur) | (1u << (cur - 1)) | (1u << ti0) | (1u << ti1) | (1u << ti2) | (1u << ti3) | (1u << ti4);
        }
        SELM[i] = mask;
        for (int r = 0; r < 2; ++r) { const int hd = 2 * g + r; const float mr = r ? m1 : m0, izr = r ? iz1 : iz0;
            float o[64], qq[64];
            { const bf16_t* q = P + t * PW + C_Q + hd * 64;
#pragma unroll
              for (int d = 0; d < 64; ++d) { o[d] = 0.f; qq[d] = bf2f(q[d]); } }
            for (int n = 0; n < nv; ++n) { const float* k = kc + n * 128; const float* v = vc + n * 128; float sc = 0.f;
#pragma unroll
                for (int d = 0; d < 64; ++d) sc += qq[d] * k[d];
                const float pr = expf(sc - mr) * izr;
#pragma unroll
                for (int d = 0; d < 64; ++d) o[d] += pr * v[d]; }
            const float g0 = sigmoidf_(bf2f(P[t * PW + C_NG + hd * 3 + 0]));
#pragma unroll
            for (int d = 0; d < 64; ++d) O[t * 1024 + hd * 64 + d] = f2bf(g0 * o[d]); } }
}
DEVI void ph_selwin(const Params& p, long long gtid, long long gsz) {
    const bf16_t* P = WSP(bf16_t, p.oP); const unsigned* SELM = WSP(unsigned, p.oSELM); bf16_t* O = WSP(bf16_t, p.oO);
    for (long long i = gtid; i < p.T * 8; i += gsz) { const long long t = i >> 3, b = t / p.S, s = t % p.S; const int hd = (int)((i >> 1) & 3), g = hd >> 1, d0 = (int)(i & 1) * 32;
        unsigned qp[32]; float o[32];
        { const bf16_t* qq = P + t * PW + C_Q + hd * 64;
#pragma unroll
          for (int d = 0; d < 32; ++d) qp[d] = (unsigned)qq[2 * d] | ((unsigned)qq[2 * d + 1] << 16); }
        for (int pass = 0; pass < 2; ++pass) {
            const int ck = pass ? C_KW : C_KS, cv = pass ? C_VW : C_VS; const unsigned mask = SELM[t * 2 + g];
            float m = -3e38f, z = 0.f;
#pragma unroll
            for (int d = 0; d < 32; ++d) o[d] = 0.f;
            const long long lo = pass ? (s - 511 > 0 ? s - 511 : 0) : 0;
            for (long long kp = lo; kp <= s; ++kp) {
                if (!pass && !((mask >> (kp >> 6)) & 1u)) { kp |= 63; continue; }
                const bf16_t* k = P + (b * p.S + kp) * PW + ck + g * 64; const bf16_t* v = P + (b * p.S + kp) * PW + cv + g * 64 + d0; float sc = 0.f;
#pragma unroll
                for (int d = 0; d < 32; ++d) sc += u2f(qp[d] << 16) * bf2f(k[2 * d]) + u2f(qp[d] & 0xffff0000u) * bf2f(k[2 * d + 1]);
                if (sc > m) { const float f = expf(m - sc); z *= f;
#pragma unroll
                    for (int d = 0; d < 32; ++d) o[d] *= f;
                    m = sc; }
                const float pr = expf(sc - m); z += pr;
#pragma unroll
                for (int d = 0; d < 32; ++d) o[d] += pr * bf2f(v[d]); }
            const float gt = sigmoidf_(bf2f(P[t * PW + C_NG + hd * 3 + 1 + pass])) / z;
#pragma unroll
            for (int d = 0; d < 32; ++d) { bf16_t* od = O + t * 1024 + hd * 64 + d0 + d; *od = f2bf(bf2f(*od) + gt * o[d]); } } }
}
DEVI void ph_ca_attn(const Params& p, int l, long long gtid, long long gsz) {
    const bf16_t* CQ = WSP(bf16_t, p.oCQ); const bf16_t* KV = WSP(bf16_t, p.oKV) + (long long)l * 512; bf16_t* AO = WSP(bf16_t, p.oCAO);
    for (long long i = gtid; i < p.T * 4; i += gsz) { const long long t = i >> 2, b = t / p.S; const int hd = (int)(i & 3);
        float q[64], o[64];
#pragma unroll
        for (int d = 0; d < 64; ++d) { q[d] = bf2f(CQ[t * 256 + hd * 64 + d]); o[d] = 0.f; }
        float m = -3e38f, z = 0.f;
        for (int kp = 0; kp < 256; ++kp) { const bf16_t* k = KV + (b * 256 + kp) * 1024 + hd * 64; const bf16_t* v = k + 256; float sc = 0.f;
#pragma unroll
            for (int d = 0; d < 64; ++d) sc += q[d] * bf2f(k[d]);
            if (sc > m) { const float f = expf(m - sc); z *= f;
#pragma unroll
                for (int d = 0; d < 64; ++d) o[d] *= f;
                m = sc; }
            const float pr = expf(sc - m); z += pr;
#pragma unroll
            for (int d = 0; d < 64; ++d) o[d] += pr * bf2f(v[d]); }
        const float iz = 1.0f / z;
#pragma unroll
        for (int d = 0; d < 64; ++d) AO[t * 256 + hd * 64 + d] = f2bf(o[d] * iz); }
}
DEVI void ph_moe_count(const Params& p, long long gtid, long long gsz) {
    const int* TE = WSP(int, p.oTOKE); int* CC = WSP(int, p.oCCNT); int* R2T = WSP(int, p.oR2T);
    for (long long c = gtid; c < p.T / 64; c += gsz) { int cnt[8] = {0, 0, 0, 0, 0, 0, 0, 0};
        for (int j = 0; j < 128; ++j) { const int e = TE[c * 128 + j];
#pragma unroll
            for (int q = 0; q < 8; ++q) cnt[q] += (e == q); }
#pragma unroll
        for (int q = 0; q < 8; ++q) CC[c * 8 + q] = cnt[q]; }
    for (long long i = gtid; i < p.NR; i += gsz) R2T[i] = -1;
}
DEVI void ph_moe_offsets(const Params& p, long long gtid, long long gsz) {
    const int* CC = WSP(int, p.oCCNT); int* CO = WSP(int, p.oCOFF); int* MC = WSP(int, p.oMOEC);
    for (long long ee = gtid; ee < 8; ee += gsz) { const int e = (int)ee; int run = 0; for (long long c = 0; c < p.T / 64; ++c) { CO[c * 8 + e] = run; run += CC[c * 8 + e]; } MC[e] = run; }
}
DEVI void moe_bases(const Params& p, int (&base)[9]) { const int* MC = WSP(int, p.oMOEC); int run = 0;
#pragma unroll
    for (int e = 0; e < 8; ++e) { base[e] = run; run += (MC[e] + 255) & ~255; } base[8] = run; }
DEVI void ph_moe_assign(const Params& p, long long gtid, long long gsz) {
    const int* TE = WSP(int, p.oTOKE); const float* TW = WSP(float, p.oTOKW); const int* CO = WSP(int, p.oCOFF); int* TS = WSP(int, p.oTOKS); int* R2T = WSP(int, p.oR2T); float* RW = WSP(float, p.oROWW);
    int base[9]; moe_bases(p, base);
    if (gtid == 0) { int* MC = WSP(int, p.oMOEC);
#pragma unroll
        for (int e = 0; e < 9; ++e) MC[16 + e] = base[e]; }
    for (long long c = gtid; c < p.T / 64; c += gsz) { int run[8];
#pragma unroll
        for (int q = 0; q < 8; ++q) run[q] = base[q] + CO[c * 8 + q];
        for (int j = 0; j < 128; ++j) { const int e = TE[c * 128 + j]; int slot = 0;
#pragma unroll
            for (int q = 0; q < 8; ++q) if (e == q) { slot = run[q]; run[q] += 1; }
            TS[c * 128 + j] = slot; R2T[slot] = (int)(c * 64 + (j >> 1)); RW[slot] = TW[c * 128 + j]; } }
}
DEVI void ph_moe_gather(const Params& p, long long gtid, long long gsz) {
    const int* R2T = WSP(int, p.oR2T); const int* MC = WSP(int, p.oMOEC); const uint4* H = WSP(uint4, p.oH); uint4* HS = WSP(uint4, p.oHS);
    const long long rows = MC[16 + 8];
    for (long long i = gtid; i < rows * 128; i += gsz) { const long long r = i >> 7; const int j = (int)(i & 127); const int t = R2T[r];
        uint4 v; v.x = v.y = v.z = v.w = 0u; if (t >= 0) v = H[(long long)t * 128 + j]; HS[i] = v; }
}
struct Unit { int pm, pn, aux, pad; long long aoff, boff; };
constexpr int NXCD = 8, WGM = 8;
DEVI void tile_order(long long L, int nM, int nN, int& pm, int& pn) {
    const int nwg = nM * nN; int wgid = (int)L; { const int q = nwg / NXCD, r = nwg % NXCD, xcd = wgid % NXCD, off = wgid / NXCD; wgid = (xcd < r ? xcd * (q + 1) : r * (q + 1) + (xcd - r) * q) + off; }
    const int nig = WGM * nN, gid = wgid / nig, fm = gid * WGM, gsz = (nM - fm) < WGM ? (nM - fm) : WGM;
    pm = fm + ((wgid % nig) % gsz); pn = (wgid % nig) / gsz;
}
struct SchedPlain {
    int nM, nN, G, c; long long lda, ldb;
    DEVM void init(long long M, long long N, long long lda_, long long ldb_, int G_, int c_) { nM = (int)(M / 256); nN = (int)(N / 256); lda = lda_; ldb = ldb_; G = G_; c = c_; }
    DEVM bool next(int i, Unit& u) const { const long long L = (long long)i * G + c; if (L >= (long long)nM * nN) return false; tile_order(L, nM, nN, u.pm, u.pn); u.aux = 0; u.pad = 0;
        u.aoff = (long long)u.pm * 256 * lda * 2; u.boff = (long long)u.pn * 256 * ldb * 2; return true; }
    DEVM void a_ready(const Unit&) const {}
    DEVM void done(const Unit&) const {}
};
struct SchedBranch {
    int nM, G, c;
    DEVM void init(long long M, int G_, int c_) { nM = (int)(M / 256); G = G_; c = c_; }
    DEVM bool next(int i, Unit& u) const { const long long L = (long long)i * G + c; if (L >= (long long)nM * 16) return false; tile_order(L, nM, 16, u.pm, u.pn); u.aux = u.pn >> 2; u.pad = 0;
        u.aoff = (long long)u.pm * 256 * 1024 * 2 + (long long)u.aux * 256 * 2; u.boff = (long long)u.pn * 256 * 256 * 2; return true; }
    DEVM void a_ready(const Unit&) const {}
    DEVM void done(const Unit&) const {}
};
struct SchedGate {
    int nM, G, c;
    DEVM void init(long long M, int G_, int c_) { nM = (int)(M / 256); G = G_; c = c_; }
    DEVM bool next(int i, Unit& u) const { const long long tile = (long long)(i >> 2) * G + c; if (tile >= (long long)nM * 4) return false; tile_order(tile, nM, 4, u.pm, u.pn); u.aux = i & 3; u.pad = 0;
        u.aoff = (long long)u.pm * 256 * 1024 * 2; u.boff = (long long)(u.aux * 4 + u.pn) * 256 * 1024 * 2; return true; }
    DEVM void a_ready(const Unit&) const {}
    DEVM void done(const Unit&) const {}
};
struct SchedMoe {
    int t0, t1, nN, G, c; long long lda, ldb, per_e; int base[9];
    DEVM bool next(int i, Unit& u) const { const long long L = (long long)i * G + c; if (L >= (long long)(t1 - t0) * nN) return false; u.pm = t0 + (int)(L / nN); u.pn = (int)(L % nN); u.pad = 0;
        int e = 0;
#pragma unroll
        for (int q = 1; q < 8; ++q) e += (u.pm * 256 >= base[q]) ? 1 : 0;
        u.aux = e; u.aoff = (long long)u.pm * 256 * lda * 2; u.boff = (long long)e * per_e + (long long)u.pn * 256 * ldb * 2; return true; }
    DEVM void a_ready(const Unit&) const {}
    DEVM void done(const Unit&) const {}
};
DEVI void st8(bf16_t* dst, const float* v) {
#ifndef CPU_EMU
    uint4 w; w.x = (unsigned)f2bf(v[0]) | ((unsigned)f2bf(v[1]) << 16); w.y = (unsigned)f2bf(v[2]) | ((unsigned)f2bf(v[3]) << 16); w.z = (unsigned)f2bf(v[4]) | ((unsigned)f2bf(v[5]) << 16); w.w = (unsigned)f2bf(v[6]) | ((unsigned)f2bf(v[7]) << 16);
    *(uint4*)dst = w;
#else
    for (int j = 0; j < 8; ++j) dst[j] = f2bf(v[j]);
#endif
}
DEVI void ld8(const bf16_t* src, float* v) {
#ifndef CPU_EMU
    const uint4 w = *(const uint4*)src; v[0] = u2f(w.x << 16); v[1] = u2f(w.x & 0xffff0000u); v[2] = u2f(w.y << 16); v[3] = u2f(w.y & 0xffff0000u); v[4] = u2f(w.z << 16); v[5] = u2f(w.z & 0xffff0000u); v[6] = u2f(w.w << 16); v[7] = u2f(w.w & 0xffff0000u);
#else
    for (int j = 0; j < 8; ++j) v[j] = bf2f(src[j]);
#endif
}
struct EpStore {
    bf16_t* O; long long ldo; float scale;
    DEVM void apply(const Unit& u, long long row, int c8, const float* lo, const float* hi) const { float a[8], b[8];
#pragma unroll
        for (int j = 0; j < 8; ++j) { a[j] = lo[j] * scale; b[j] = hi[j] * scale; }
        bf16_t* d = O + row * ldo + u.pn * 256 + c8; st8(d, a); st8(d + 128, b); }
};
struct EpGate {
    const bf16_t* BO; const float* bias; bf16_t* MG; long long row0;
    DEVM void apply(const Unit& u, long long row, int c8, const float* lo, const float* hi) const {
#pragma unroll
        for (int hh = 0; hh < 2; ++hh) { const float* v = hh ? hi : lo; const int c = u.pn * 256 + hh * 128 + c8, n = u.aux * 1024 + c; float bo[8], mg[8], r[8]; ld8(BO + row * 4096 + n, bo);
            bf16_t* m = MG + (row0 + row) * 1024 + c;
            if (u.aux) ld8(m, mg);
#pragma unroll
            for (int j = 0; j < 8; ++j) { r[j] = sigmoidf_(v[j] + bias[n + j]) * bo[j]; if (u.aux) r[j] += mg[j]; }
            st8(m, r); } }
};
struct EpResid {
    float* X;
    DEVM void apply(const Unit& u, long long row, int c8, const float* lo, const float* hi) const { float* x = X + row * 1024 + u.pn * 256 + c8;
#ifndef CPU_EMU
        float4 a = *(float4*)x, b = *(float4*)(x + 4), c = *(float4*)(x + 128), d = *(float4*)(x + 132);
        a.x += lo[0]; a.y += lo[1]; a.z += lo[2]; a.w += lo[3]; b.x += lo[4]; b.y += lo[5]; b.z += lo[6]; b.w += lo[7];
        c.x += hi[0]; c.y += hi[1]; c.z += hi[2]; c.w += hi[3]; d.x += hi[4]; d.y += hi[5]; d.z += hi[6]; d.w += hi[7];
        *(float4*)x = a; *(float4*)(x + 4) = b; *(float4*)(x + 128) = c; *(float4*)(x + 132) = d;
#else
        for (int j = 0; j < 8; ++j) { x[j] += lo[j]; x[128 + j] += hi[j]; }
#endif
    }
};
struct EpSwiglu {
    bf16_t* ACT; long long ldo; long long row0;
    DEVM void apply(const Unit& u, long long row, int c8, const float* lo, const float* hi) const { float r[8];
#pragma unroll
        for (int j = 0; j < 8; ++j) r[j] = siluf_(lo[j]) * hi[j];
        st8(ACT + (row - row0) * ldo + u.pn * 128 + c8, r); }
};
struct EpMoeDown {
    bf16_t* Y; const float* roww;
    DEVM void apply(const Unit& u, long long row, int c8, const float* lo, const float* hi) const { const float w = roww[row]; float a[8], b[8];
#pragma unroll
        for (int j = 0; j < 8; ++j) { a[j] = lo[j] * w; b[j] = hi[j] * w; }
        bf16_t* d = Y + row * 1024 + u.pn * 256 + c8; st8(d, a); st8(d + 128, b); }
};

#ifdef CPU_EMU
template <class Sched, class Epi> static void gemm_cpu(const bf16_t* A, long long lda, const bf16_t* Bt, long long ldb, long long K, const Sched& S, const Epi& E) {
    Unit u;
    for (int i = 0; S.next(i, u); ++i) {
        const bf16_t* a0 = (const bf16_t*)((const char*)A + u.aoff); const bf16_t* b0 = (const bf16_t*)((const char*)Bt + u.boff);
#pragma omp parallel for
        for (int r = 0; r < 256; ++r) { float arow[4096]; for (long long k = 0; k < K; ++k) arow[k] = bf2f(a0[r * lda + k]);
            for (int c8 = 0; c8 < 128; c8 += 8) { float lo[8], hi[8];
                for (int j = 0; j < 8; ++j) { const bf16_t* bl = b0 + (c8 + j) * ldb; const bf16_t* bh = b0 + (128 + c8 + j) * ldb; float s0 = 0.f, s1 = 0.f;
                    for (long long k = 0; k < K; ++k) { s0 += arow[k] * bf2f(bl[k]); s1 += arow[k] * bf2f(bh[k]); } lo[j] = s0; hi[j] = s1; }
                E.apply(u, (long long)u.pm * 256 + r, c8, lo, hi); } } }
}
#endif

#ifndef CPU_EMU
DEVI float wave_sum(float v) {
#pragma unroll
    for (int o = 32; o > 0; o >>= 1) v += __shfl_xor(v, o);
    return v; }
DEVI void row_load(const float* src, float (&v)[16], int lane) {
#pragma unroll
    for (int j = 0; j < 4; ++j) { const float4 f = *(const float4*)(src + j * 256 + lane * 4); v[4 * j] = f.x; v[4 * j + 1] = f.y; v[4 * j + 2] = f.z; v[4 * j + 3] = f.w; } }
DEVI void row_store_bf16(bf16_t* dst, const float (&v)[16], int lane) {
#pragma unroll
    for (int j = 0; j < 4; ++j) { uint2 w; w.x = (unsigned)f2bf(v[4 * j]) | ((unsigned)f2bf(v[4 * j + 1]) << 16); w.y = (unsigned)f2bf(v[4 * j + 2]) | ((unsigned)f2bf(v[4 * j + 3]) << 16); *(uint2*)(dst + j * 256 + lane * 4) = w; } }
#endif
DEVI void ph_rmsnorm(const Params& p, const float* src, long long rows, const float* gain, bf16_t* dst, int mode, float* xcopy, long long gw, long long nw, int lane) {
    const float* router = p.in[I_MOE_R]; int* TE = WSP(int, p.oTOKE); float* TW = WSP(float, p.oTOKW);
#ifndef CPU_EMU
    for (long long r = gw; r < rows; r += nw) { float v[16], g[16]; row_load(src + r * 1024, v, lane); row_load(gain, g, lane);
        float ss = 0.f;
#pragma unroll
        for (int j = 0; j < 16; ++j) ss += v[j] * v[j];
        ss = wave_sum(ss); const float rs = rsqrtf(ss * (1.0f / 1024.0f) + 1e-6f);
        if (mode == 1) {
#pragma unroll
            for (int j = 0; j < 4; ++j) *(float4*)(xcopy + r * 1024 + j * 256 + lane * 4) = make_float4(v[4 * j], v[4 * j + 1], v[4 * j + 2], v[4 * j + 3]); }
#pragma unroll
        for (int j = 0; j < 16; ++j) v[j] = v[j] * rs * g[j];
        row_store_bf16(dst + r * 1024, v, lane);
        if (mode == 2) { float lg[8];
#pragma unroll
            for (int e = 0; e < 8; ++e) { float a = 0.f;
#pragma unroll
                for (int j = 0; j < 16; ++j) a += v[j] * router[(long long)((j >> 2) * 256 + lane * 4 + (j & 3)) * 8 + e];
                lg[e] = wave_sum(a); }
            int i0 = 0; float v0 = lg[0];
#pragma unroll
            for (int e = 1; e < 8; ++e) if (lg[e] > v0) { v0 = lg[e]; i0 = e; }
            int i1 = -1; float v1 = -3e38f;
#pragma unroll
            for (int e = 0; e < 8; ++e) if (e != i0 && lg[e] > v1) { v1 = lg[e]; i1 = e; }
            const float w0 = 1.0f / (1.0f + expf(v1 - v0));
            if (lane == 0) { TE[r * 2] = i0; TE[r * 2 + 1] = i1; TW[r * 2] = w0; TW[r * 2 + 1] = 1.0f - w0; } } }
#else
    (void)lane;
    for (long long r = gw; r < rows; r += nw) { const float* x = src + r * 1024; float ss = 0.f; for (int c = 0; c < 1024; ++c) ss += x[c] * x[c];
        const float rs = 1.0f / sqrtf(ss / 1024.0f + 1e-6f); float hv[1024];
        for (int c = 0; c < 1024; ++c) { hv[c] = x[c] * rs * gain[c]; dst[r * 1024 + c] = f2bf(hv[c]); if (mode == 1) xcopy[r * 1024 + c] = x[c]; }
        if (mode == 2) { float lg[8]; for (int e = 0; e < 8; ++e) { float a = 0.f; for (int c = 0; c < 1024; ++c) a += hv[c] * router[c * 8 + e]; lg[e] = a; }
            int i0 = 0; float v0 = lg[0]; for (int e = 1; e < 8; ++e) if (lg[e] > v0) { v0 = lg[e]; i0 = e; }
            int i1 = -1; float v1 = -3e38f; for (int e = 0; e < 8; ++e) if (e != i0 && lg[e] > v1) { v1 = lg[e]; i1 = e; }
            const float w0 = 1.0f / (1.0f + expf(v1 - v0)); TE[r * 2] = i0; TE[r * 2 + 1] = i1; TW[r * 2] = w0; TW[r * 2 + 1] = 1.0f - w0; } }
#endif
}
DEVI void ph_final(const Params& p, long long gw, long long nw, int lane) {
    const int* TS = WSP(int, p.oTOKS); const bf16_t* Y = WSP(bf16_t, p.oY); const float* gain = p.in[I_NORM_FINAL]; float* X = p.out;
#ifndef CPU_EMU
    for (long long r = gw; r < p.T; r += nw) { float v[16], g[16]; row_load(X + r * 1024, v, lane); row_load(gain, g, lane);
        const bf16_t* y0 = Y + (long long)TS[r * 2] * 1024; const bf16_t* y1 = Y + (long long)TS[r * 2 + 1] * 1024;
#pragma unroll
        for (int j = 0; j < 4; ++j) { const uint2 a = *(const uint2*)(y0 + j * 256 + lane * 4), b = *(const uint2*)(y1 + j * 256 + lane * 4);
            v[4 * j] += u2f(a.x << 16) + u2f(b.x << 16); v[4 * j + 1] += u2f(a.x & 0xffff0000u) + u2f(b.x & 0xffff0000u); v[4 * j + 2] += u2f(a.y << 16) + u2f(b.y << 16); v[4 * j + 3] += u2f(a.y & 0xffff0000u) + u2f(b.y & 0xffff0000u); }
        float ss = 0.f;
#pragma unroll
        for (int j = 0; j < 16; ++j) ss += v[j] * v[j];
        ss = wave_sum(ss); const float rs = rsqrtf(ss * (1.0f / 1024.0f) + 1e-6f);
#pragma unroll
        for (int j = 0; j < 4; ++j) *(float4*)(X + r * 1024 + j * 256 + lane * 4) = make_float4(v[4 * j] * rs * g[4 * j], v[4 * j + 1] * rs * g[4 * j + 1], v[4 * j + 2] * rs * g[4 * j + 2], v[4 * j + 3] * rs * g[4 * j + 3]); }
#else
    (void)lane;
    for (long long r = gw; r < p.T; r += nw) { float v[1024]; float ss = 0.f; const bf16_t* y0 = Y + (long long)TS[r * 2] * 1024; const bf16_t* y1 = Y + (long long)TS[r * 2 + 1] * 1024;
        for (int c = 0; c < 1024; ++c) { v[c] = X[r * 1024 + c] + bf2f(y0[c]) + bf2f(y1[c]); ss += v[c] * v[c]; }
        const float rs = 1.0f / sqrtf(ss / 1024.0f + 1e-6f); for (int c = 0; c < 1024; ++c) X[r * 1024 + c] = v[c] * rs * gain[c]; }
#endif
}
DEVI void ph_rwkv_scan(const Params& p, int l, long long gw, long long nw, int lane) {
    const float* RWW = WSP(float, p.oRWW); const bf16_t* RWX = WSP(bf16_t, p.oRWX); const float* RK = WSP(float, p.oRK); bf16_t* O = WSP(bf16_t, p.oO); const float* lng = p.in[I_RW_LN] + l * 256;
    for (long long ch = gw; ch < p.B * 4; ch += nw) { const long long b = ch >> 2; const int h = (int)(ch & 3);
#ifndef CPU_EMU
        float st[64];
#pragma unroll
        for (int c = 0; c < 64; ++c) st[c] = 0.f;
        for (long long s = 0; s < p.S; ++s) { const long long t = b * p.S + s; const bf16_t* rx = RWX + t * 1280 + h * 64; const float v = bf2f(rx[512 + lane]);
            const float y = rwkv_row_step(st, RWW + t * 256 + h * 64, rx, rx + 256, rx + 768, rx + 1024, v);
            const float mean = wave_sum(y) * (1.0f / 64.0f), dy = y - mean, var = wave_sum(dy * dy) * (1.0f / 64.0f);
            const float yn = dy * rsqrtf(var + 64e-5f) * lng[h * 64 + lane] + RK[t * 4 + h] * v;
            bf16_t* o = O + t * 1024 + 512 + h * 64 + lane; *o = f2bf(yn * bf2f(*o)); }
#else
        (void)lane;
        static float st[64][64]; for (int v = 0; v < 64; ++v) for (int c = 0; c < 64; ++c) st[v][c] = 0.f;
        for (long long s = 0; s < p.S; ++s) { const long long t = b * p.S + s; const bf16_t* rx = RWX + t * 1280 + h * 64; float y[64], mean = 0.f, var = 0.f;
            for (int v = 0; v < 64; ++v) { y[v] = rwkv_row_step(st[v], RWW + t * 256 + h * 64, rx, rx + 256, rx + 768, rx + 1024, bf2f(rx[512 + v])); mean += y[v]; }
            mean /= 64.f; for (int v = 0; v < 64; ++v) var += (y[v] - mean) * (y[v] - mean); var /= 64.f;
            for (int v = 0; v < 64; ++v) { const float yn = (y[v] - mean) / sqrtf(var + 64e-5f) * lng[h * 64 + v] + RK[t * 4 + h] * bf2f(rx[512 + v]);
                bf16_t* o = O + t * 1024 + 512 + h * 64 + v; *o = f2bf(yn * bf2f(*o)); } }
#endif
    }
}
DEVI void ph_gla_scan(const Params& p, int l, long long gw, long long nw, int lane) {
    const bf16_t* P = WSP(bf16_t, p.oP); const float* GA = WSP(float, p.oGA); bf16_t* O = WSP(bf16_t, p.oO); const float* ng = p.in[I_GLA_NORM] + l * 64;
    for (long long ch = gw; ch < p.B * 4; ch += nw) { const long long b = ch >> 2; const int h = (int)(ch & 3);
#ifndef CPU_EMU
        float st[32];
#pragma unroll
        for (int c = 0; c < 32; ++c) st[c] = 0.f;
        for (long long s = 0; s < p.S; ++s) { const long long t = b * p.S + s; const bf16_t* x = P + t * PW + C_GLA;
            const float o = gla_col_step(st, GA + t * 128 + h * 32, x + h * 32, x + 128 + h * 32, bf2f(x[256 + h * 64 + lane]));
            const float ms = wave_sum(o * o) * (1.0f / 64.0f), on = o * rsqrtf(ms + 1e-6f) * ng[lane];
            bf16_t* d = O + t * 1024 + 768 + h * 64 + lane; *d = f2bf(on * bf2f(*d)); }
#else
        (void)lane;
        static float st[64][32]; for (int v = 0; v < 64; ++v) for (int c = 0; c < 32; ++c) st[v][c] = 0.f;
        for (long long s = 0; s < p.S; ++s) { const long long t = b * p.S + s; const bf16_t* x = P + t * PW + C_GLA; float o[64], ms = 0.f;
            for (int v = 0; v < 64; ++v) { o[v] = gla_col_step(st[v], GA + t * 128 + h * 32, x + h * 32, x + 128 + h * 32, bf2f(x[256 + h * 64 + v])); ms += o[v] * o[v]; }
            ms /= 64.f;
            for (int v = 0; v < 64; ++v) { bf16_t* d = O + t * 1024 + 768 + h * 64 + v; *d = f2bf(o[v] / sqrtf(ms + 1e-6f) * ng[v] * bf2f(*d)); } }
#endif
    }
}
#ifndef CPU_EMU
#define LAS __attribute__((address_space(3)))
typedef short bf16x8 __attribute__((ext_vector_type(8)));
typedef float f32x4 __attribute__((ext_vector_type(4)));
constexpr int HALF = 128, BK = 64, HTB = HALF * BK * 2, STAGE_BYTES = 8 * HTB;
__device__ __forceinline__ int lds_byte(int r, int c) { const int st = (r >> 4) * 2 + (c >> 5), rr = r & 15, cc = c & 31, ob = rr * 64 + cc * 2; return st * 1024 + (ob ^ (((ob >> 9) & 1) << 5)); }
__device__ __forceinline__ void stage_rc(int b, int& R, int& C) { const int st = b / 1024, sb = b % 1024, swz = sb ^ (((sb >> 9) & 1) << 5); R = (st >> 1) * 16 + swz / 64; C = (st & 1) * 32 + (swz % 64) / 2; }
__device__ __forceinline__ int perm32(int rho) { const int n = rho >> 4, i = rho & 15; return 8 * (i >> 2) + 4 * n + (i & 3); }

template <class Epi, class Sched>
__device__ __forceinline__ void gemm_phase(LAS unsigned char* lds, const bf16_t* A, long long lda, const bf16_t* Bt, long long ldb, long long K, const Sched& S, const Epi& E) {
    int tid = threadIdx.x; asm volatile("" : "+v"(tid));
    const int wid = __builtin_amdgcn_readfirstlane(tid >> 6), lane = tid & 63, wr = wid >> 2, wc = wid & 3, fr = lane & 15, fq = lane >> 4;
    { unsigned long long a_ = (unsigned long long)A, b_ = (unsigned long long)Bt; unsigned alo = __builtin_amdgcn_readfirstlane((unsigned)a_), ahi = __builtin_amdgcn_readfirstlane((unsigned)(a_ >> 32)),
        blo = __builtin_amdgcn_readfirstlane((unsigned)b_), bhi = __builtin_amdgcn_readfirstlane((unsigned)(b_ >> 32));
      int lda_ = __builtin_amdgcn_readfirstlane((int)lda), ldb_ = __builtin_amdgcn_readfirstlane((int)ldb), k_ = __builtin_amdgcn_readfirstlane((int)K);
      asm volatile("" : "+s"(alo), "+s"(ahi), "+s"(blo), "+s"(bhi), "+s"(lda_), "+s"(ldb_), "+s"(k_));
      A = (const bf16_t*)(((unsigned long long)ahi << 32) | alo); Bt = (const bf16_t*)(((unsigned long long)bhi << 32) | blo); lda = lda_; ldb = ldb_; K = k_; }
    const int nt = (int)(K / BK);
    unsigned voffA[2], voffB[2];
#pragma unroll
    for (int i = 0; i < 2; ++i) { int R, C; stage_rc(tid * 16 + i * 8192, R, C); const int Rb = (R & ~31) + perm32(R & 31);
        voffA[i] = (unsigned)(R * (int)lda + C) * 2u; voffB[i] = (unsigned)(Rb * (int)ldb + C) * 2u; }
    const size_t kstep = (size_t)(BK * 2);
    const size_t hstepA = (size_t)HALF * lda * 2, hstepB = (size_t)HALF * ldb * 2;
    const unsigned ldsw = (unsigned)wid * 1024u;
    const int aoff = lds_byte(wr * 64 + fr, fq * 8), boff = lds_byte(wc * 32 + fr, fq * 8);
#define PG8_SA(b, h) (((b) * 2 + (h)) * HTB)
#define PG8_SB(b, h) ((4 + (b) * 2 + (h)) * HTB)
#define PG8_STAGE(bufoff, gbase, voff) do { _Pragma("unroll") for (int _i = 0; _i < 2; ++_i) \
        __builtin_amdgcn_global_load_lds((const unsigned*)((const char*)(gbase) + (voff)[_i]), (LAS unsigned*)(lds + (bufoff) + ldsw + _i * 8192), 16, 0, 0); } while (0)
#define PG8_LDA(dst, b, h) do { _Pragma("unroll") for (int m = 0; m < 4; ++m) _Pragma("unroll") for (int k = 0; k < 2; ++k) dst[m][k] = *(const LAS bf16x8*)(lds + PG8_SA(b, h) + aoff + m * 2048 + k * 1024); } while (0)
#define PG8_LDB(dst, b, h) do { _Pragma("unroll") for (int n = 0; n < 2; ++n) _Pragma("unroll") for (int k = 0; k < 2; ++k) dst[n][k] = *(const LAS bf16x8*)(lds + PG8_SB(b, h) + boff + n * 2048 + k * 1024); } while (0)
#define PG8_MMA(ai, bj, At, Bt_) do { __builtin_amdgcn_s_setprio(1); _Pragma("unroll") for (int m = 0; m < 4; ++m) _Pragma("unroll") for (int n = 0; n < 2; ++n) _Pragma("unroll") for (int k = 0; k < 2; ++k) \
        acc[ai][bj][m][n] = __builtin_amdgcn_mfma_f32_16x16x32_bf16(Bt_[n][k], At[m][k], acc[ai][bj][m][n], 0, 0, 0); __builtin_amdgcn_s_setprio(0); } while (0)
#define PG8_WAIT_V(n) asm volatile("s_waitcnt vmcnt(" #n ")" ::: "memory")
#define PG8_WAIT_L(n) asm volatile("s_waitcnt lgkmcnt(" #n ")" ::: "memory")
#define PG8_BAR __builtin_amdgcn_s_barrier()
#define PG8_SCHED __builtin_amdgcn_sched_barrier(0)
    Unit cur, nxt; int ui = 0;
    if (!S.next(0, cur)) return;
    f32x4 acc[2][2][4][2];
#pragma unroll
    for (int a = 0; a < 2; ++a)
#pragma unroll
        for (int b = 0; b < 2; ++b)
#pragma unroll
            for (int m = 0; m < 4; ++m)
#pragma unroll
                for (int n = 0; n < 2; ++n) acc[a][b][m][n] = (f32x4){0.f, 0.f, 0.f, 0.f};
    bf16x8 At[4][2], B0[2][2], B1[2][2];
    const char* cA = (const char*)A + cur.aoff; const char* cB = (const char*)Bt + cur.boff;
    S.a_ready(cur);
    PG8_STAGE(PG8_SB(0, 0), cB, voffB); PG8_STAGE(PG8_SA(0, 0), cA, voffA); PG8_STAGE(PG8_SB(0, 1), cB + hstepB, voffB); PG8_STAGE(PG8_SA(0, 1), cA + hstepA, voffA);
    if (wr == 1) PG8_BAR;
    PG8_WAIT_V(4); PG8_BAR;
    PG8_STAGE(PG8_SB(1, 0), cB + kstep, voffB); PG8_STAGE(PG8_SA(1, 0), cA + kstep, voffA); PG8_STAGE(PG8_SB(1, 1), cB + hstepB + kstep, voffB);
    PG8_WAIT_V(6); PG8_BAR;
    for (;;) {
        const bool has_next = S.next(ui + 1, nxt);
        const char* nA = has_next ? (const char*)A + nxt.aoff : cA; const char* nB = has_next ? (const char*)Bt + nxt.boff : cB;
#pragma nounroll
        for (int t = 0; t < nt; t += 2) {
            const bool last = (t == nt - 2);
            const char* a1 = cA + (size_t)(t + 1) * kstep;
            const char* a2 = last ? nA : cA + (size_t)(t + 2) * kstep; const char* b2 = last ? nB : cB + (size_t)(t + 2) * kstep;
            const char* a3 = a2 + kstep; const char* b3 = b2 + kstep;
            if (last && has_next) S.a_ready(nxt);
            PG8_LDB(B0, 0, 0); PG8_SCHED; PG8_LDA(At, 0, 0); PG8_STAGE(PG8_SA(1, 1), a1 + hstepA, voffA);
            PG8_WAIT_L(8); PG8_BAR; PG8_WAIT_L(0); PG8_MMA(0, 0, At, B0); PG8_BAR; PG8_SCHED;
            PG8_LDB(B1, 0, 1); PG8_STAGE(PG8_SB(0, 0), b2, voffB);
            PG8_BAR; PG8_WAIT_L(0); PG8_MMA(0, 1, At, B1); PG8_BAR;
            PG8_LDA(At, 0, 1); PG8_STAGE(PG8_SA(0, 0), a2, voffA);
            PG8_BAR; PG8_WAIT_L(0); PG8_MMA(1, 0, At, B0); PG8_BAR; PG8_SCHED;
            PG8_STAGE(PG8_SB(0, 1), b2 + hstepB, voffB);
            PG8_WAIT_V(6); PG8_BAR; PG8_MMA(1, 1, At, B1); PG8_BAR;
            PG8_LDB(B0, 1, 0); PG8_SCHED; PG8_LDA(At, 1, 0); PG8_STAGE(PG8_SA(0, 1), a2 + hstepA, voffA);
            PG8_WAIT_L(8); PG8_BAR; PG8_WAIT_L(0); PG8_MMA(0, 0, At, B0); PG8_BAR; PG8_SCHED;
            PG8_LDB(B1, 1, 1); PG8_STAGE(PG8_SB(1, 0), b3, voffB);
            PG8_BAR; PG8_WAIT_L(0); PG8_MMA(0, 1, At, B1); PG8_BAR;
            PG8_LDA(At, 1, 1); PG8_STAGE(PG8_SA(1, 0), a3, voffA);
            PG8_BAR; PG8_WAIT_L(0); PG8_MMA(1, 0, At, B0); PG8_BAR; PG8_SCHED;
            PG8_STAGE(PG8_SB(1, 1), b3 + hstepB, voffB);
            PG8_WAIT_V(6); PG8_BAR; PG8_MMA(1, 1, At, B1); PG8_BAR;
        }
#pragma unroll
        for (int ai = 0; ai < 2; ++ai)
#pragma unroll
            for (int m = 0; m < 4; ++m) { float lo[8], hi[8];
#pragma unroll
                for (int j = 0; j < 8; ++j) { lo[j] = acc[ai][0][m][j >> 2][j & 3]; hi[j] = acc[ai][1][m][j >> 2][j & 3]; }
                E.apply(cur, (long long)cur.pm * 256 + ai * HALF + wr * 64 + m * 16 + fr, wc * 32 + 8 * fq, lo, hi); PG8_SCHED; }
        S.done(cur);
        if (!has_next) break;
#pragma unroll
        for (int a = 0; a < 2; ++a)
#pragma unroll
            for (int b = 0; b < 2; ++b)
#pragma unroll
                for (int m = 0; m < 4; ++m)
#pragma unroll
                    for (int n = 0; n < 2; ++n) acc[a][b][m][n] = (f32x4){0.f, 0.f, 0.f, 0.f};
        cur = nxt; cA = nA; cB = nB; ++ui;
    }
    PG8_WAIT_V(0);
    if (wr == 0) PG8_BAR;
    PG8_BAR;
#undef PG8_SA
#undef PG8_SB
#undef PG8_STAGE
#undef PG8_LDA
#undef PG8_LDB
#undef PG8_MMA
#undef PG8_WAIT_V
#undef PG8_WAIT_L
#undef PG8_BAR
#undef PG8_SCHED
}

#define XB_TMO      128
#define XB_XCNT(j)  (256  + 64 * (j))
#define XB_XSUB(j)  (1280 + 64 * (j))
#define XB_XGEN(j)  (2304 + 64 * (j))
#define XB_TOP      3328
#define XB_TOPGEN   3392
#define XCD_BAR_WORDS 3456
#define XB_SPIN_CAP (1u << 18)
__device__ __forceinline__ unsigned xb_ld(unsigned* p)              { return __hip_atomic_load(p, __ATOMIC_RELAXED, __HIP_MEMORY_SCOPE_AGENT); }
__device__ __forceinline__ unsigned xb_add(unsigned* p, unsigned v) { return __hip_atomic_fetch_add(p, v, __ATOMIC_RELAXED, __HIP_MEMORY_SCOPE_AGENT); }
__device__ __forceinline__ unsigned xb_xcc_id() { return (unsigned)__builtin_amdgcn_s_getreg((3 << 11) | 20) & 0xFu; }
#define XB_SPIN(cond, bar) do { unsigned _sp = 0; while (cond) { __builtin_amdgcn_s_sleep(1); \
    if ((++_sp & 255u) == 0u) { if (xb_ld(&(bar)[XB_TMO])) break; if (_sp > XB_SPIN_CAP) { atomicAdd(&(bar)[XB_TMO], 1u); break; } } } } while (0)
struct XcdBarrier { unsigned* bar; unsigned x; volatile LAS unsigned* st; };
__device__ __forceinline__ XcdBarrier xcd_barrier_post(unsigned* bar, volatile LAS unsigned* st) {
    XcdBarrier b; b.bar = bar; b.x = xb_xcc_id(); b.st = st;
    if (threadIdx.x == 0) (void)xb_add(&bar[XB_XCNT(b.x)], 1u);
    return b;
}
__device__ __forceinline__ void xcd_barrier_complete(unsigned* bar, unsigned x, unsigned& nloc, unsigned& nx) {
    const unsigned G = gridDim.x * gridDim.y * gridDim.z;
    unsigned sum, cnt, mine, sp = 0u;
    for (;;) {
        sum = 0u; cnt = 0u; mine = 0u;
#pragma unroll
        for (unsigned j = 0; j < 16; ++j) { const unsigned c = xb_ld(&bar[XB_XCNT(j)]); sum += c; cnt += (c > 0u) ? 1u : 0u; mine = (j == x) ? c : mine; }
        if (sum == G) break;
        __builtin_amdgcn_s_sleep(1);
        if ((++sp & 255u) == 0u) { if (xb_ld(&bar[XB_TMO])) break; if (sp > XB_SPIN_CAP) { atomicAdd(&bar[XB_TMO], 1u); break; } }
    }
    nloc = mine > 0u ? mine : 1u; nx = cnt > 0u ? cnt : 1u;
}
__device__ __forceinline__ void xcd_barrier(const XcdBarrier& b) {
    asm volatile("s_waitcnt vmcnt(0)" ::: "memory");
    __syncthreads();
    if (threadIdx.x == 0) {
        unsigned* bar = b.bar;
        __builtin_amdgcn_s_waitcnt(0);
        unsigned nloc = b.st[0], nx = b.st[1];
        if (nloc == 0u) { xcd_barrier_complete(bar, b.x, nloc, nx); b.st[0] = nloc; b.st[1] = nx; }
        const unsigned old = xb_add(&bar[XB_XSUB(b.x)], 1u);
        const unsigned gen = old / nloc;
        if (old + 1u == (gen + 1u) * nloc) {
            __builtin_amdgcn_fence(__ATOMIC_RELEASE, "agent");
            asm volatile("s_waitcnt vmcnt(0)" ::: "memory");
            const unsigned og = xb_add(&bar[XB_TOP], 1u);
            const unsigned tg = og / nx;
            if (og + 1u == (tg + 1u) * nx) xb_add(&bar[XB_TOPGEN], 1u);
            else XB_SPIN(xb_ld(&bar[XB_TOPGEN]) == tg, bar);
            __builtin_amdgcn_fence(__ATOMIC_ACQUIRE, "agent");
            xb_add(&bar[XB_XGEN(b.x)], 1u);
            asm volatile("s_waitcnt vmcnt(0)" ::: "memory");
        } else {
            XB_SPIN(xb_ld(&bar[XB_XGEN(b.x)]) == gen, bar);
            __builtin_amdgcn_fence(__ATOMIC_ACQUIRE, "agent");
            asm volatile("s_waitcnt vmcnt(0)" ::: "memory");
        }
    }
    __syncthreads();
}
#endif
#ifndef CPU_EMU
typedef short bf16x8_t __attribute__((ext_vector_type(8)));
typedef short bf16x4_t __attribute__((ext_vector_type(4)));
typedef float f32x4_t __attribute__((ext_vector_type(4)));
typedef unsigned u32x4_t __attribute__((ext_vector_type(4)));
constexpr int AT_KS = 144, AT_VS = 136;
constexpr int AT_KBYTES = 64 * AT_KS, AT_VBYTES = 64 * AT_VS, AT_BUF = AT_KBYTES + AT_VBYTES;
struct AttnState { float m, l; f32x4_t o[4]; };
__device__ __forceinline__ void attn_init(AttnState& s) { s.m = -1e30f; s.l = 0.f;
#pragma unroll
    for (int d = 0; d < 4; ++d) s.o[d] = (f32x4_t){0.f, 0.f, 0.f, 0.f}; }
__device__ __forceinline__ unsigned pack2bf(float lo, float hi) { return (unsigned)f2bf(lo) | ((unsigned)f2bf(hi) << 16); }
template <class Valid> __device__ __forceinline__ void attn_tile(const LAS unsigned char* kt, const LAS unsigned char* vt, const bf16x8_t (&bq)[2], AttnState& st, int lane, const Valid& valid) {
    const int r = lane & 15, q = lane >> 4;
    f32x4_t s[4];
#pragma unroll
    for (int kb = 0; kb < 4; ++kb) { s[kb] = (f32x4_t){0.f, 0.f, 0.f, 0.f};
#pragma unroll
        for (int ks = 0; ks < 2; ++ks) { const bf16x8_t a = *(const LAS bf16x8_t*)(kt + (16 * kb + r) * AT_KS + (32 * ks + 8 * q) * 2); s[kb] = __builtin_amdgcn_mfma_f32_16x16x32_bf16(a, bq[ks], s[kb], 0, 0, 0); } }
    float mx = -1e30f;
#pragma unroll
    for (int kb = 0; kb < 4; ++kb)
#pragma unroll
        for (int j = 0; j < 4; ++j) { const float v = valid(kb, j) ? s[kb][j] * 1.44269504f : -1e30f; s[kb][j] = v; mx = fmaxf(mx, v); }
    mx = fmaxf(mx, __shfl_xor(mx, 16)); mx = fmaxf(mx, __shfl_xor(mx, 32));
    const float mn = fmaxf(st.m, mx), alpha = __builtin_amdgcn_exp2f(st.m - mn);
    float rs = 0.f;
#pragma unroll
    for (int kb = 0; kb < 4; ++kb)
#pragma unroll
        for (int j = 0; j < 4; ++j) { const float pv = s[kb][j] > -1e29f ? __builtin_amdgcn_exp2f(s[kb][j] - mn) : 0.f; s[kb][j] = pv; rs += pv; }
    rs += __shfl_xor(rs, 16); rs += __shfl_xor(rs, 32);
    st.l = st.l * alpha + rs; st.m = mn;
    bf16x8_t pb[2];
#pragma unroll
    for (int kk = 0; kk < 2; ++kk) { uint4 w; w.x = pack2bf(s[2 * kk][0], s[2 * kk][1]); w.y = pack2bf(s[2 * kk][2], s[2 * kk][3]); w.z = pack2bf(s[2 * kk + 1][0], s[2 * kk + 1][1]); w.w = pack2bf(s[2 * kk + 1][2], s[2 * kk + 1][3]);
        pb[kk] = __builtin_bit_cast(bf16x8_t, w); }
#pragma unroll
    for (int db = 0; db < 4; ++db) { st.o[db] = st.o[db] * alpha;
#pragma unroll
        for (int kk = 0; kk < 2; ++kk) { const LAS unsigned char* vp = vt + (16 * db + r) * AT_VS + (32 * kk + 4 * q) * 2;
            const bf16x4_t lo = *(const LAS bf16x4_t*)vp, hi = *(const LAS bf16x4_t*)(vp + 32);
            const bf16x8_t a = __builtin_shufflevector(lo, hi, 0, 1, 2, 3, 4, 5, 6, 7);
            st.o[db] = __builtin_amdgcn_mfma_f32_16x16x32_bf16(a, pb[kk], st.o[db], 0, 0, 0); } }
}
__device__ __forceinline__ void attn_stage_store(LAS unsigned char* buf, int tid, const uint4& kc, const uint4& vc) {
    const int key = tid >> 3, c = tid & 7;
    *(LAS u32x4_t*)(buf + key * AT_KS + c * 16) = (u32x4_t){kc.x, kc.y, kc.z, kc.w};
    LAS unsigned short* vt = (LAS unsigned short*)(buf + AT_KBYTES);
    const unsigned w[4] = {vc.x, vc.y, vc.z, vc.w};
#pragma unroll
    for (int i = 0; i < 4; ++i) { vt[((8 * c + 2 * i) * AT_VS) / 2 + key] = (unsigned short)(w[i] & 0xffffu); vt[((8 * c + 2 * i + 1) * AT_VS) / 2 + key] = (unsigned short)(w[i] >> 16); }
}
__device__ __forceinline__ void ph_selwin_mfma(const Params& p, LAS unsigned char* lds, int gC, int gG) {
    int tid = threadIdx.x; asm volatile("" : "+v"(tid));
    const int wid = tid >> 6, lane = tid & 63, r = lane & 15, q = lane >> 4;
    const bf16_t* P = WSP(bf16_t, p.oP); const unsigned* SELM = WSP(unsigned, p.oSELM); bf16_t* O = WSP(bf16_t, p.oO);
    const int nqb = (int)(p.S >> 6), units = (int)(p.B * 2) * nqb;
    for (int u = gC; u < units; u += gG) {
        const int cur = nqb - 1 - (u % nqb), bg = u / nqb, b = bg >> 1, g = bg & 1;
        const long long t0 = (long long)b * p.S + (long long)cur * 64;
        const int hd = 2 * g + (wid >> 2); const int tq = (wid & 3) * 16 + r; const long long tok = t0 + tq; const int sq = cur * 64 + tq;
        bf16x8_t bq[2];
#pragma unroll
        for (int ks = 0; ks < 2; ++ks) bq[ks] = *(const bf16x8_t*)(P + tok * PW + C_Q + hd * 64 + 32 * ks + 8 * q);
        unsigned un = SELM[(t0 + lane) * 2 + g];
#pragma unroll
        for (int o = 32; o > 0; o >>= 1) un |= __shfl_xor(un, o);
        un = __builtin_amdgcn_readfirstlane(un);
        const unsigned mymask = SELM[tok * 2 + g];
        const int wlo = cur - 8 > 0 ? cur - 8 : 0, nwin = cur - wlo + 1, nsel = __builtin_popcount(un), ntile = nwin + nsel;
        AttnState sw, ss; attn_init(sw); attn_init(ss);
        unsigned rem = un; int blk = wlo;
        uint4 kc, vc;
        { const long long kr = ((long long)b * p.S + (long long)blk * 64 + (tid >> 3)) * PW + g * 64 + (tid & 7) * 8; kc = *(const uint4*)(P + kr + C_KW); vc = *(const uint4*)(P + kr + C_VW); }
        attn_stage_store(lds, tid, kc, vc);
        __syncthreads();
        for (int i = 0; i < ntile; ++i) {
            const bool win = i < nwin; const int cb = blk;
            int nb = 0; bool nwinf = false; const bool has = i + 1 < ntile;
            if (has) { if (i + 1 < nwin) { nb = wlo + i + 1; nwinf = true; } else { nb = __builtin_ctz(rem); rem &= rem - 1; }
                const long long kr = ((long long)b * p.S + (long long)nb * 64 + (tid >> 3)) * PW + g * 64 + (tid & 7) * 8;
                kc = *(const uint4*)(P + kr + (nwinf ? C_KW : C_KS)); vc = *(const uint4*)(P + kr + (nwinf ? C_VW : C_VS)); }
            const LAS unsigned char* buf = lds + (i & 1) * AT_BUF;
            const int kbase = cb * 64 + 4 * q;
            if (win) attn_tile(buf, buf + AT_KBYTES, bq, sw, lane, [&](int kb, int j) { const int key = kbase + 16 * kb + j; return key <= sq && key > sq - 512; });
            else { const bool on = (mymask >> cb) & 1u; attn_tile(buf, buf + AT_KBYTES, bq, ss, lane, [&](int kb, int j) { const int key = kbase + 16 * kb + j; return on && key <= sq; }); }
            if (has) attn_stage_store(lds + ((i + 1) & 1) * AT_BUF, tid, kc, vc);
            blk = nb;
            __syncthreads();
        }
        const float g1 = sigmoidf_(bf2f(P[tok * PW + C_NG + hd * 3 + 1])) / ss.l, g2 = sigmoidf_(bf2f(P[tok * PW + C_NG + hd * 3 + 2])) / sw.l;
#pragma unroll
        for (int db = 0; db < 4; ++db) { bf16_t* od = O + tok * 1024 + hd * 64 + 16 * db + 4 * q; const uint2 pv = *(const uint2*)od;
            const float r0 = u2f(pv.x << 16) + g1 * ss.o[db][0] + g2 * sw.o[db][0], r1 = u2f(pv.x & 0xffff0000u) + g1 * ss.o[db][1] + g2 * sw.o[db][1];
            const float r2 = u2f(pv.y << 16) + g1 * ss.o[db][2] + g2 * sw.o[db][2], r3 = u2f(pv.y & 0xffff0000u) + g1 * ss.o[db][3] + g2 * sw.o[db][3];
            uint2 w; w.x = pack2bf(r0, r1); w.y = pack2bf(r2, r3); *(uint2*)od = w; }
    }
}
__device__ __forceinline__ void ph_ca_attn_mfma(const Params& p, int l, LAS unsigned char* lds, int gC, int gG) {
    int tid = threadIdx.x; asm volatile("" : "+v"(tid));
    const int wid = tid >> 6, lane = tid & 63, r = lane & 15, q = lane >> 4;
    const bf16_t* CQ = WSP(bf16_t, p.oCQ); const bf16_t* KV = WSP(bf16_t, p.oKV) + (long long)l * 512; bf16_t* AO = WSP(bf16_t, p.oCAO);
    const int nqb = (int)(p.S >> 7), units = (int)(p.B * 4) * nqb;
    for (int u = gC; u < units; u += gG) {
        const int qb = u % nqb, bh = u / nqb, b = bh >> 2, hd = bh & 3;
        const long long tok = (long long)b * p.S + (long long)qb * 128 + wid * 16 + r;
        bf16x8_t bq[2];
#pragma unroll
        for (int ks = 0; ks < 2; ++ks) bq[ks] = *(const bf16x8_t*)(CQ + tok * 256 + hd * 64 + 32 * ks + 8 * q);
        AttnState st; attn_init(st);
        uint4 kc, vc;
        { const long long kr = ((long long)b * 256 + (tid >> 3)) * 1024 + hd * 64 + (tid & 7) * 8; kc = *(const uint4*)(KV + kr); vc = *(const uint4*)(KV + kr + 256); }
        attn_stage_store(lds, tid, kc, vc);
        __syncthreads();
        for (int i = 0; i < 4; ++i) {
            if (i < 3) { const long long kr = ((long long)b * 256 + (i + 1) * 64 + (tid >> 3)) * 1024 + hd * 64 + (tid & 7) * 8; kc = *(const uint4*)(KV + kr); vc = *(const uint4*)(KV + kr + 256); }
            const LAS unsigned char* buf = lds + (i & 1) * AT_BUF;
            attn_tile(buf, buf + AT_KBYTES, bq, st, lane, [](int, int) { return true; });
            if (i < 3) attn_stage_store(lds + ((i + 1) & 1) * AT_BUF, tid, kc, vc);
            __syncthreads();
        }
        const float il = 1.0f / st.l;
#pragma unroll
        for (int db = 0; db < 4; ++db) { uint2 w; w.x = pack2bf(st.o[db][0] * il, st.o[db][1] * il); w.y = pack2bf(st.o[db][2] * il, st.o[db][3] * il); *(uint2*)(AO + tok * 256 + hd * 64 + 16 * db + 4 * q) = w; }
    }
}
#endif
#ifndef CPU_EMU
typedef float f32x2_t __attribute__((ext_vector_type(2)));
template <int CTRL> __device__ __forceinline__ float dpp_mov(float x) { return __builtin_bit_cast(float, __builtin_amdgcn_update_dpp(0, __builtin_bit_cast(int, x), CTRL, 0xF, 0xF, true)); }
__device__ __forceinline__ float sum8(float x) { x += dpp_mov<0xB1>(x); x += dpp_mov<0x4E>(x); x += dpp_mov<0x141>(x); return x; }
__device__ __forceinline__ float sum16s(float x) { x += __shfl_xor(x, 1); x += __shfl_xor(x, 2); x += __shfl_xor(x, 4); x += __shfl_xor(x, 8); return x; }
constexpr int SC_CH = 32;
constexpr int RW_STEP = 384, RW_BUF = SC_CH * RW_STEP * 4;
constexpr int GL_STEP = 160, GL_BUF = SC_CH * GL_STEP * 4;
__device__ __forceinline__ void cvt8(const uint4& w, float (&f)[8]) { f[0] = u2f(w.x << 16); f[1] = u2f(w.x & 0xffff0000u); f[2] = u2f(w.y << 16); f[3] = u2f(w.y & 0xffff0000u); f[4] = u2f(w.z << 16); f[5] = u2f(w.z & 0xffff0000u); f[6] = u2f(w.w << 16); f[7] = u2f(w.w & 0xffff0000u); }

__device__ __forceinline__ void rwkv_chain(const Params& p, int l, int ch, LAS unsigned char* lds) {
    int tid = threadIdx.x; asm volatile("" : "+v"(tid));
    const int row = tid >> 3, cg = tid & 7; const long long b = ch >> 2; const int h = ch & 3;
    const float* RWW = WSP(float, p.oRWW); const bf16_t* RWX = WSP(bf16_t, p.oRWX); const float* RK = WSP(float, p.oRK); bf16_t* O = WSP(bf16_t, p.oO); const float* lng = p.in[I_RW_LN] + l * 256 + h * 64;
    LAS float* YB = (LAS float*)(lds + 2 * RW_BUF);
    const long long tb = b * p.S; const int nch = (int)(p.S / SC_CH);
    float4 gw;
    uint4 gx0, gx1, gx2;
#define RW_GLOAD1(idx_, dst_) do { const int idx = (idx_); if (idx < 1280) { const int step = idx / 40, rem = idx % 40, vec = rem >> 3, c8 = rem & 7; dst_ = *(const uint4*)(RWX + (t0_ + step) * 1280 + vec * 256 + h * 64 + 8 * c8); } } while (0)
#define RW_GLOAD(c_) do { const long long t0_ = tb + (long long)(c_) * SC_CH; gw = *(const float4*)(RWW + (t0_ + (tid >> 4)) * 256 + h * 64 + 4 * (tid & 15)); RW_GLOAD1(tid, gx0); RW_GLOAD1(tid + 512, gx1); RW_GLOAD1(tid + 1024, gx2); } while (0)
#define RW_SSTORE1(idx_, src_) do { const int idx = (idx_); if (idx < 1280) { const int step = idx / 40, rem = idx % 40, vec = rem >> 3, c8 = rem & 7; \
        const int slot = vec == 0 ? 4 : (vec == 1 ? 3 : (vec == 2 ? 5 : (vec == 3 ? 1 : 2))); float f[8]; cvt8(src_, f); LAS float* d = B_ + step * RW_STEP + slot * 64 + 8 * c8; \
        *(LAS f32x4_t*)d = (f32x4_t){f[0], f[1], f[2], f[3]}; *(LAS f32x4_t*)(d + 4) = (f32x4_t){f[4], f[5], f[6], f[7]}; } } while (0)
#define RW_SSTORE(buf_) do { LAS float* B_ = (LAS float*)(lds + (buf_) * RW_BUF); *(LAS f32x4_t*)(B_ + (tid >> 4) * RW_STEP + 4 * (tid & 15)) = (f32x4_t){gw.x, gw.y, gw.z, gw.w}; \
        RW_SSTORE1(tid, gx0); RW_SSTORE1(tid + 512, gx1); RW_SSTORE1(tid + 1024, gx2); } while (0)
    f32x2_t st[4];
#pragma unroll
    for (int i = 0; i < 4; ++i) st[i] = (f32x2_t){0.f, 0.f};
    RW_GLOAD(0); RW_SSTORE(0); __syncthreads();
    for (int c = 0; c < nch; ++c) {
        if (c + 1 < nch) RW_GLOAD(c + 1);
        const LAS float* B = (const LAS float*)(lds + (c & 1) * RW_BUF);
        for (int s = 0; s < SC_CH; ++s) { const LAS float* x = B + s * RW_STEP + 8 * cg;
            f32x2_t w[4], kk[4], bb[4], k[4], r[4];
#pragma unroll
            for (int i = 0; i < 2; ++i) { const f32x4_t a0 = *(const LAS f32x4_t*)(x + 4 * i), a1 = *(const LAS f32x4_t*)(x + 64 + 4 * i), a2 = *(const LAS f32x4_t*)(x + 128 + 4 * i), a3 = *(const LAS f32x4_t*)(x + 192 + 4 * i), a4 = *(const LAS f32x4_t*)(x + 256 + 4 * i);
                w[2 * i] = (f32x2_t){a0[0], a0[1]}; w[2 * i + 1] = (f32x2_t){a0[2], a0[3]}; kk[2 * i] = (f32x2_t){a1[0], a1[1]}; kk[2 * i + 1] = (f32x2_t){a1[2], a1[3]};
                bb[2 * i] = (f32x2_t){a2[0], a2[1]}; bb[2 * i + 1] = (f32x2_t){a2[2], a2[3]}; k[2 * i] = (f32x2_t){a3[0], a3[1]}; k[2 * i + 1] = (f32x2_t){a3[2], a3[3]};
                r[2 * i] = (f32x2_t){a4[0], a4[1]}; r[2 * i + 1] = (f32x2_t){a4[2], a4[3]}; }
            const float v = B[s * RW_STEP + 320 + row];
            f32x2_t a = st[0] * kk[0] + st[1] * kk[1]; a += st[2] * kk[2] + st[3] * kk[3];
            const float skk = sum8(a[0] + a[1]);
            f32x2_t y2 = (f32x2_t){0.f, 0.f};
#pragma unroll
            for (int i = 0; i < 4; ++i) { st[i] = st[i] * w[i] - bb[i] * skk + k[i] * v; y2 += st[i] * r[i]; }
            const float y = sum8(y2[0] + y2[1]);
            if (cg == 0) YB[s * 64 + row] = y; }
        __syncthreads();
        {
            const int s = tid >> 4, v0 = 4 * (tid & 15); const long long t = tb + (long long)c * SC_CH + s;
            const f32x4_t y = *(const LAS f32x4_t*)(YB + s * 64 + v0); const f32x4_t vv = *(const LAS f32x4_t*)(B + s * RW_STEP + 320 + v0);
            const float mean = sum16s(y[0] + y[1] + y[2] + y[3]) * (1.0f / 64.0f);
            const float d0 = y[0] - mean, d1 = y[1] - mean, d2 = y[2] - mean, d3 = y[3] - mean;
            const float var = sum16s(d0 * d0 + d1 * d1 + d2 * d2 + d3 * d3) * (1.0f / 64.0f), rstd = rsqrtf(var + 64e-5f), rk = RK[t * 4 + h];
            bf16_t* o = O + t * 1024 + 512 + h * 64 + v0; const uint2 g = *(const uint2*)o; const float4 ln = *(const float4*)(lng + v0);
            const float r0 = (d0 * rstd * ln.x + rk * vv[0]) * u2f(g.x << 16), r1 = (d1 * rstd * ln.y + rk * vv[1]) * u2f(g.x & 0xffff0000u);
            const float r2 = (d2 * rstd * ln.z + rk * vv[2]) * u2f(g.y << 16), r3 = (d3 * rstd * ln.w + rk * vv[3]) * u2f(g.y & 0xffff0000u);
            uint2 w; w.x = pack2bf(r0, r1); w.y = pack2bf(r2, r3); *(uint2*)o = w; }
        if (c + 1 < nch) RW_SSTORE((c + 1) & 1);
        __syncthreads();
    }
}
__device__ __forceinline__ void gla_chain(const Params& p, int l, int ch, LAS unsigned char* lds) {
    int tid = threadIdx.x; asm volatile("" : "+v"(tid));
    const int vc = tid >> 3, kg = tid & 7; const long long b = ch >> 2; const int h = ch & 3;
    const bf16_t* P = WSP(bf16_t, p.oP); const float* GA = WSP(float, p.oGA); bf16_t* O = WSP(bf16_t, p.oO); const float* ng = p.in[I_GLA_NORM] + l * 64;
    LAS float* OB = (LAS float*)(lds + 2 * GL_BUF);
    const long long tb = b * p.S; const int nch = (int)(p.S / SC_CH);
    float4 ga; uint4 g1, g2;
#define GL_GLOAD(c_) do { const long long t0_ = tb + (long long)(c_) * SC_CH; \
        if (tid < 256) { const int step = tid >> 3, c4 = tid & 7; ga = *(const float4*)(GA + (t0_ + step) * 128 + h * 32 + 4 * c4); g1 = *(const uint4*)(P + (t0_ + step) * PW + C_GLA + 256 + h * 64 + 8 * c4); } \
        else { const int idx = tid - 256, step = idx >> 3, vec = (idx >> 2) & 1, c8 = idx & 3; g2 = *(const uint4*)(P + (t0_ + step) * PW + C_GLA + vec * 128 + h * 32 + 8 * c8); } } while (0)
#define GL_SSTORE(buf_) do { LAS float* B_ = (LAS float*)(lds + (buf_) * GL_BUF); float f[8]; \
        if (tid < 256) { const int step = tid >> 3, c4 = tid & 7; *(LAS f32x4_t*)(B_ + step * GL_STEP + 4 * c4) = (f32x4_t){ga.x, ga.y, ga.z, ga.w}; \
            cvt8(g1, f); LAS float* d = B_ + step * GL_STEP + 96 + 8 * c4; *(LAS f32x4_t*)d = (f32x4_t){f[0], f[1], f[2], f[3]}; *(LAS f32x4_t*)(d + 4) = (f32x4_t){f[4], f[5], f[6], f[7]}; } \
        else { const int idx = tid - 256, step = idx >> 3, vec = (idx >> 2) & 1, c8 = idx & 3; \
            cvt8(g2, f); LAS float* d = B_ + step * GL_STEP + (vec == 0 ? 64 : 32) + 8 * c8; *(LAS f32x4_t*)d = (f32x4_t){f[0], f[1], f[2], f[3]}; *(LAS f32x4_t*)(d + 4) = (f32x4_t){f[4], f[5], f[6], f[7]}; } } while (0)
    f32x4_t st = (f32x4_t){0.f, 0.f, 0.f, 0.f};
    GL_GLOAD(0); GL_SSTORE(0); __syncthreads();
    for (int c = 0; c < nch; ++c) {
        if (c + 1 < nch) GL_GLOAD(c + 1);
        const LAS float* B = (const LAS float*)(lds + (c & 1) * GL_BUF);
        for (int s = 0; s < SC_CH; ++s) { const LAS float* x = B + s * GL_STEP + 4 * kg;
            const f32x4_t a = *(const LAS f32x4_t*)x, k = *(const LAS f32x4_t*)(x + 32), qv = *(const LAS f32x4_t*)(x + 64); const float v = B[s * GL_STEP + 96 + vc];
            st = st * a + k * v; const f32x4_t pq = st * qv;
            const float o = sum8((pq[0] + pq[1]) + (pq[2] + pq[3]));
            if (kg == 0) OB[s * 64 + vc] = o * 0.17677669529663687f; }
        __syncthreads();
        {   const int s = tid >> 4, v0 = 4 * (tid & 15); const long long t = tb + (long long)c * SC_CH + s;
            const f32x4_t o = *(const LAS f32x4_t*)(OB + s * 64 + v0);
            const float ms = sum16s(o[0] * o[0] + o[1] * o[1] + o[2] * o[2] + o[3] * o[3]) * (1.0f / 64.0f), rs = rsqrtf(ms + 1e-6f);
            bf16_t* d = O + t * 1024 + 768 + h * 64 + v0; const uint2 g = *(const uint2*)d; const float4 n4 = *(const float4*)(ng + v0);
            uint2 w; w.x = pack2bf(o[0] * rs * n4.x * u2f(g.x << 16), o[1] * rs * n4.y * u2f(g.x & 0xffff0000u)); w.y = pack2bf(o[2] * rs * n4.z * u2f(g.y << 16), o[3] * rs * n4.w * u2f(g.y & 0xffff0000u)); *(uint2*)d = w; }
        if (c + 1 < nch) GL_SSTORE((c + 1) & 1);
        __syncthreads();
    }
}
__device__ __forceinline__ void ph_scans(const Params& p, int l, LAS unsigned char* lds, int gC, int gG) {
    const int nchain = (int)(p.B * 4);
    for (int it = gC; it < 2 * nchain; it += gG) { if (it < nchain) rwkv_chain(p, l, it, lds); else gla_chain(p, l, it - nchain, lds); }
}
#endif
#ifdef CPU_EMU
struct Ctx { long long gtid, gsz, gw, nw; int lane, G, c; };
#define GEMM(A, lda, Bt, ldb, K, S, E) gemm_cpu(A, lda, Bt, ldb, K, S, E)
#define GRID_BARRIER() do { } while (0)
#else
struct Ctx { LAS unsigned char* lds; XcdBarrier bar; };
#define GEMM(A, lda, Bt, ldb, K, S, E) gemm_phase(cx.lds, A, lda, Bt, ldb, K, S, E)
#define GRID_BARRIER() xcd_barrier(cx.bar)
#endif
constexpr int N_PHASES = 56;

template <int KIND> DEVI void run_program(const Params& p, const Ctx& cx, int pb, int pe) {
    int ph = 0;
#define T p.T
#define DFF p.DFF
#ifdef CPU_EMU
    const long long gsz = cx.gsz, nw = cx.nw; const int gG = cx.G, gC = cx.c;
#else
#define gsz ((long long)gridDim.x * 512)
#define nw ((long long)gridDim.x * 8)
#define gG ((int)gridDim.x)
#define gC ((int)blockIdx.x)
#endif
#define H WSP(bf16_t, p.oH)
#define P WSP(bf16_t, p.oP)
#define O WSP(bf16_t, p.oO)
#define BO WSP(bf16_t, p.oBO)
#define MG WSP(bf16_t, p.oMG)
#define CQ WSP(bf16_t, p.oCQ)
#define CAO WSP(bf16_t, p.oCAO)
#define MEMN WSP(bf16_t, p.oMEMN)
#define ACT WSP(bf16_t, p.oACT)
#define WFFN WSP(bf16_t, p.oWFFN)
#ifdef CPU_EMU
#define OPAQUE_V(x) do { } while (0)
#define PH_IDX long long gtid = cx.gtid, gw = cx.gw; int lane = cx.lane
#else
#define OPAQUE_V(x) asm volatile("" : "+v"(x))
#define PH_IDX unsigned tx_ = threadIdx.x; OPAQUE_V(tx_); long long gtid = (long long)blockIdx.x * 512 + tx_, gw = (long long)(tx_ >> 6) * gridDim.x + blockIdx.x; int lane = tx_ & 63
#endif
#define PH_BEGIN(k) if (ph >= pb && ph < pe) { if constexpr (KIND < 0 || KIND == (k)) { PH_IDX; OPAQUE_V(gtid); OPAQUE_V(gw); OPAQUE_V(lane); (void)gtid; (void)gw; (void)lane;
#define PH_END   } if (ph + 1 < pe) GRID_BARRIER(); } ++ph;
    PH_BEGIN(0)
        ph_convert_layer(p, 0, gtid, gsz); ph_convert_layer(p, 1, gtid, gsz); ph_convert_ffn(p, gtid, gsz); ph_rope(p, gtid, gsz);
        ph_rmsnorm(p, p.in[I_MEM], p.B * 256, p.in[I_MEM_NORM], MEMN, 0, nullptr, gw, nw, lane);
        ph_rmsnorm(p, p.in[I_X], T, p.in[I_NORM_MIX], H, 1, p.out, gw, nw, lane);
    PH_END
    PH_BEGIN(1)
        { SchedPlain S; S.init(p.B * 256, 1024, 1024, 1024, gG, gC); EpStore E{WSP(bf16_t, p.oKV), 1024, 1.0f}; GEMM(MEMN, 1024, WSP(bf16_t, p.oWKV), 1024, 1024, S, E); }
    PH_END
    for (int l = 0; l < 2; ++l) {
#define W WSP(bf16_t, p.oWL[l])
        PH_BEGIN(1) { SchedPlain S; S.init(T, 3072, 1024, 1024, gG, gC); EpStore E{P, 3072, 1.0f}; GEMM(H, 1024, W + W_IN, 1024, 1024, S, E); } PH_END
        PH_BEGIN(2) ph_rope_apply(p, gtid, gsz); ph_compress1(p, l, gtid, gsz); ph_pool(p, l, gtid, gsz); ph_rwkv_prep(p, l, gtid, gsz); ph_gla_prep(p, l, gtid, gsz); PH_END
        PH_BEGIN(3) ph_compress2(p, l, gtid, gsz); PH_END
#ifdef CPU_EMU
        PH_BEGIN(4) ph_rwkv_scan(p, l, gw, nw, lane); ph_gla_scan(p, l, (gw + nw - (p.B * 4) % nw) % nw, nw, lane); ph_cmp_attn(p, gtid, gsz); PH_END
#else
        PH_BEGIN(4) ph_scans(p, l, cx.lds, gC, gG); ph_cmp_attn(p, gtid, gsz); PH_END
#endif
#ifdef CPU_EMU
        PH_BEGIN(5) ph_selwin(p, gtid, gsz); PH_END
#else
        PH_BEGIN(5) ph_selwin_mfma(p, cx.lds, gC, gG); PH_END
#endif
        for (int q = 0; q < 4; ++q) { const long long r0 = q * (T / 4);
            PH_BEGIN(6) { SchedBranch S; S.init(T / 4, gG, gC); EpStore E{BO, 4096, 1.0f}; GEMM(O + r0 * 1024, 1024, W + W_B, 256, 256, S, E); } PH_END
            PH_BEGIN(7) { SchedGate S; S.init(T / 4, gG, gC); EpGate E{BO, p.in[I_B_GATE] + l * 4096, MG, r0}; GEMM(H + r0 * 1024, 1024, W + W_G, 1024, 1024, S, E); } PH_END }
        PH_BEGIN(8) { SchedPlain S; S.init(T, 1024, 1024, 1024, gG, gC); EpResid E{p.out}; GEMM(MG, 1024, W + W_O, 1024, 1024, S, E); } PH_END
        PH_BEGIN(9) ph_rmsnorm(p, p.out, T, p.in[I_NORM_CA] + l * 1024, H, 0, nullptr, gw, nw, lane); PH_END
        PH_BEGIN(1) { SchedPlain S; S.init(T, 256, 1024, 1024, gG, gC); EpStore E{CQ, 256, 0.125f}; GEMM(H, 1024, W + W_CQ, 1024, 1024, S, E); } PH_END
#ifdef CPU_EMU
        PH_BEGIN(10) ph_ca_attn(p, l, gtid, gsz); PH_END
#else
        PH_BEGIN(10) ph_ca_attn_mfma(p, l, cx.lds, gC, gG); PH_END
#endif
        PH_BEGIN(8) { SchedPlain S; S.init(T, 1024, 256, 256, gG, gC); EpResid E{p.out}; GEMM(CAO, 256, W + W_CO, 256, 256, S, E); } PH_END
        PH_BEGIN(9) ph_rmsnorm(p, p.out, T, p.in[I_NORM_FFN] + l * 1024, H, l == 1 ? 2 : 0, nullptr, gw, nw, lane); if (l == 1) ph_convert_moe(p, gtid, gsz); PH_END
        if (l == 0) {
            PH_BEGIN(11) { SchedPlain S; S.init(T, 2 * DFF, 1024, 1024, gG, gC); EpSwiglu E{ACT, DFF, 0}; GEMM(H, 1024, WFFN, 1024, 1024, S, E); } PH_END
            PH_BEGIN(8) { SchedPlain S; S.init(T, 1024, DFF, DFF, gG, gC); EpResid E{p.out}; GEMM(ACT, DFF, WFFN + 2 * DFF * 1024, DFF, DFF, S, E); } PH_END
            PH_BEGIN(9) ph_rmsnorm(p, p.out, T, p.in[I_NORM_MIX] + 1024, H, 0, nullptr, gw, nw, lane); PH_END
        } else {
            PH_BEGIN(12) ph_moe_count(p, gtid, gsz); PH_END
            PH_BEGIN(12) ph_moe_offsets(p, gtid, gsz); PH_END
            PH_BEGIN(12) ph_moe_assign(p, gtid, gsz); PH_END
            PH_BEGIN(12) ph_moe_gather(p, gtid, gsz); PH_END
#define HS WSP(bf16_t, p.oHS)
#define ACTC WSP(bf16_t, p.oACTC)
#define MW WSP(bf16_t, p.oMOEW)
#define MC WSP(int, p.oMOEC)
            const int ct = (int)((p.NR / 256 + 3) / 4);
            for (int q = 0; q < 4; ++q) {
                PH_BEGIN(13) { SchedMoe S; const int nt_ = MC[16 + 8] / 256; S.t0 = q * ct; S.t1 = (q + 1) * ct < nt_ ? (q + 1) * ct : nt_; if (S.t1 < S.t0) S.t1 = S.t0; S.nN = (int)(2 * DFF / 256); S.G = gG; S.c = gC; S.lda = 1024; S.ldb = 1024; S.per_e = 3 * 1024 * DFF * 2;
#pragma unroll
                    for (int e = 0; e < 9; ++e) S.base[e] = MC[16 + e];
                    EpSwiglu E{ACTC, DFF, (long long)S.t0 * 256}; GEMM(HS, 1024, MW, 1024, 1024, S, E); } PH_END
                PH_BEGIN(14) { SchedMoe S; const int nt_ = MC[16 + 8] / 256; S.t0 = q * ct; S.t1 = (q + 1) * ct < nt_ ? (q + 1) * ct : nt_; if (S.t1 < S.t0) S.t1 = S.t0; S.nN = 4; S.G = gG; S.c = gC; S.lda = DFF; S.ldb = DFF; S.per_e = 3 * 1024 * DFF * 2;
#pragma unroll
                    for (int e = 0; e < 9; ++e) S.base[e] = MC[16 + e];
                    EpMoeDown E{WSP(bf16_t, p.oY), WSP(float, p.oROWW)}; GEMM(ACTC - (long long)S.t0 * 256 * DFF, DFF, MW + 2 * DFF * 1024, DFF, DFF, S, E); } PH_END }
            PH_BEGIN(15) ph_final(p, gw, nw, lane); PH_END
        }
    }
#undef PH_BEGIN
#undef PH_END
#undef H
#undef P
#undef O
#undef BO
#undef MG
#undef CQ
#undef CAO
#undef MEMN
#undef ACT
#undef WFFN
#undef T
#undef DFF
#undef W
#undef HS
#undef ACTC
#undef MW
#undef MC
#ifndef CPU_EMU
#undef gsz
#undef nw
#undef gG
#undef gC
#endif
}

#ifndef CPU_EMU
template <int KIND> __global__ __launch_bounds__(512, 2) void mk_fwd(Params p, int pb, int pe) {
    extern __shared__ __attribute__((aligned(16))) unsigned char shm[];
    Ctx cx; cx.lds = (LAS unsigned char*)shm;
    volatile LAS unsigned* xbw = (volatile LAS unsigned*)(cx.lds + STAGE_BYTES);
    if (threadIdx.x == 0) { xbw[0] = 0u; xbw[1] = 0u; xbw[2] = 0u; xbw[3] = 0u; }
    __syncthreads();
    cx.bar = xcd_barrier_post((unsigned*)(p.ws + p.oBAR), xbw);
    run_program<KIND>(p, cx, pb, pe);
}
#ifndef MK_ONE
#define MK_ONE 1
#endif
#if !MK_ONE
static const int kPhaseKind[N_PHASES] = { 0, 1,
    1, 2, 3, 4, 5, 6, 7, 6, 7, 6, 7, 6, 7, 8, 9, 1, 10, 8, 9, 11, 8, 9,
    1, 2, 3, 4, 5, 6, 7, 6, 7, 6, 7, 6, 7, 8, 9, 1, 10, 8, 9, 12, 12, 12, 12, 13, 14, 13, 14, 13, 14, 13, 14, 15 };
#endif
typedef void (*mk_fn)(Params, int, int);
extern "C" void kernel_launch(void* const* d_in, const int* in_sizes, int n_in, void* d_out, int out_size, void* d_ws, size_t ws_size, hipStream_t stream) {
    (void)in_sizes; (void)n_in; (void)out_size;
    Params p; memset(&p, 0, sizeof(p));
    for (int i = 0; i < N_INPUTS; ++i) p.in[i] = (const float*)d_in[i];
    p.out = (float*)d_out; p.ws = (unsigned char*)d_ws;
    make_layout(p, 32, 2048, 2816);
    for (int j = 0; j < 8; ++j) p.inv_freq[j] = (float)pow(500000.0, -(double)(2 * j) / 16.0);
    if ((size_t)p.wsNeed > ws_size) { fprintf(stderr, "workspace too small: need %lld have %zu\n", p.wsNeed, ws_size); return; }
    const size_t lds_bytes = STAGE_BYTES + 16;
#if MK_ONE
    static const mk_fn fns[1] = { mk_fwd<-1> }; const int nf = 1;
#else
    static const mk_fn fns[16] = { mk_fwd<0>, mk_fwd<1>, mk_fwd<2>, mk_fwd<3>, mk_fwd<4>, mk_fwd<5>, mk_fwd<6>, mk_fwd<7>, mk_fwd<8>, mk_fwd<9>, mk_fwd<10>, mk_fwd<11>, mk_fwd<12>, mk_fwd<13>, mk_fwd<14>, mk_fwd<15> }; const int nf = 16;
#endif
    static int grid = 0;
    if (!grid) { int dev = 0, cus = 0; (void)hipGetDevice(&dev); (void)hipDeviceGetAttribute(&cus, hipDeviceAttributeMultiprocessorCount, dev);
        for (int k = 0; k < nf; ++k) (void)hipFuncSetAttribute((const void*)fns[k], hipFuncAttributeMaxDynamicSharedMemorySize, (int)lds_bytes);
        int per_cu = 0; (void)hipOccupancyMaxActiveBlocksPerMultiprocessor(&per_cu, (const void*)fns[0], 512, lds_bytes); (void)hipGetLastError();
        grid = cus > 0 ? cus : 256; }
    (void)hipMemsetAsync(p.ws + p.oBAR, 0, 16384 + 4096, stream);
#if MK_ONE
    hipLaunchKernelGGL(fns[0], dim3(grid), dim3(512), lds_bytes, stream, p, 0, N_PHASES);
#else
    for (int ph = 0; ph < N_PHASES; ++ph) hipLaunchKernelGGL(fns[kPhaseKind[ph]], dim3(grid), dim3(512), lds_bytes, stream, p, ph, ph + 1);
#endif
}
#endif
```

```cpp
#ifndef CPU_EMU
#include <hip/hip_runtime.h>
#include <cstdio>
#include <cstdint>
#include <cstring>
#define DEVI __device__ __forceinline__
#define DEVM __device__ __forceinline__
#else
#include <cmath>
#include <cstdio>
#include <cstdint>
#include <cstring>
#include <cstdlib>
#define DEVI static inline
#define DEVM inline
struct uint4 { unsigned x, y, z, w; };
#endif

typedef unsigned short bf16_t;
#ifdef CPU_EMU
static inline float u2f(unsigned u) { float f; memcpy(&f, &u, 4); return f; }
static inline unsigned f2u(float f) { unsigned u; memcpy(&u, &f, 4); return u; }
#else
DEVI float u2f(unsigned u) { return __uint_as_float(u); }
DEVI unsigned f2u(float f) { return __float_as_uint(f); }
#endif
DEVI float bf2f(bf16_t b) { return u2f(((unsigned)b) << 16); }
DEVI bf16_t f2bf(float f) { unsigned u = f2u(f); u += 0x7FFFu + ((u >> 16) & 1u); return (bf16_t)(u >> 16); }
DEVI float sigmoidf_(float x) { return 1.0f / (1.0f + expf(-x)); }
DEVI float siluf_(float x) { return x / (1.0f + expf(-x)); }
DEVI float softplusf_(float x) { return x > 20.f ? x : log1pf(expf(x)); }
DEVI float gelu_tanhf_(float x) { return 0.5f * x * (1.0f + tanhf(0.7978845608028654f * (x + 0.044715f * x * x * x))); }

DEVI void st8(bf16_t* dst, const float* v) {
#ifndef CPU_EMU
    uint4 w; w.x = (unsigned)f2bf(v[0]) | ((unsigned)f2bf(v[1]) << 16); w.y = (unsigned)f2bf(v[2]) | ((unsigned)f2bf(v[3]) << 16); w.z = (unsigned)f2bf(v[4]) | ((unsigned)f2bf(v[5]) << 16); w.w = (unsigned)f2bf(v[6]) | ((unsigned)f2bf(v[7]) << 16);
    *(uint4*)dst = w;
#else
    for (int j = 0; j < 8; ++j) dst[j] = f2bf(v[j]);
#endif
}
DEVI void ld8(const bf16_t* src, float* v) {
#ifndef CPU_EMU
    const uint4 w = *(const uint4*)src; v[0] = u2f(w.x << 16); v[1] = u2f(w.x & 0xffff0000u); v[2] = u2f(w.y << 16); v[3] = u2f(w.y & 0xffff0000u); v[4] = u2f(w.z << 16); v[5] = u2f(w.z & 0xffff0000u); v[6] = u2f(w.w << 16); v[7] = u2f(w.w & 0xffff0000u);
#else
    for (int j = 0; j < 8; ++j) v[j] = bf2f(src[j]);
#endif
}
constexpr int DM = 1024;
constexpr int PW = 3072;
constexpr int INW = 2972;
constexpr int C_Q = 0, C_KC = 256, C_VC = 384, C_KS = 512, C_VS = 640, C_KW = 768, C_VW = 896, C_NG = 1024;
constexpr int C_POOL = 1040;
constexpr int C_RW = 1296;
constexpr int C_GLA = 2192;
constexpr int C_VRES = 2976;
constexpr int NCMPH = 128;

enum { I_X = 0, I_MEM, I_POS, I_NORM_MIX, I_W_IN, I_CMP_PE, I_CMP_W1, I_CMP_W2, I_POOL_W, I_POOL_SCALE, I_RW_MU, I_RW_W0, I_RW_W2, I_RW_A0, I_RW_A2, I_RW_G2,
       I_RW_V0, I_RW_V1, I_RW_V2, I_RW_KK, I_RW_KA, I_RW_RK, I_RW_LN, I_GLA_A2, I_GLA_AB, I_GLA_NORM, I_W_GATE, I_B_GATE, I_W_BRANCH, I_W_OUT, I_NORM_CA, I_MEM_NORM,
       I_CA_Q, I_CA_KV, I_CA_O, I_NORM_FFN, I_FFN_G, I_FFN_U, I_FFN_D, I_MOE_R, I_MOE_G, I_MOE_U, I_MOE_D, I_NORM_FINAL, N_INPUTS };

struct Params {
    const float* in[N_INPUTS];
    float* out;
    unsigned char* ws;
    long long B, S, T, DFF, NC, NR;
    float inv_freq[8];
    long long oBAR, oMOEC, oROPE, oKCMP, oVCMP, oUV, oW1T, oCB, oSELM, oKV, oTOKE, oTOKW, oTOKS, oR2T, oROWW, oCCNT, oCOFF;
    long long oWL[2], oWKV, oWFFN, oVF, oH, oP, oO, oBO, oMG, oRWW, oRWX, oGA, oCQ, oCAO, oMEMN, oACT, oY, oHS, oMOEW, oACTC, wsNeed;
};
constexpr long long W_IN = 0, W_G = W_IN + 3072LL * 1024, W_B = W_G + 4096LL * 1024, W_O = W_B + 4LL * 1024 * 256, W_CQ = W_O + 1024LL * 1024, W_CKV = W_CQ + 256LL * 1024,
                    W_CO = W_CKV + 512LL * 1024, W_LAYER = W_CO + 1024LL * 256;

static inline long long al256(long long x) { return (x + 255) & ~255LL; }
static inline void make_layout(Params& p, long long B, long long S, long long DFF) {
    p.B = B; p.S = S; p.T = B * S; p.DFF = DFF; p.NC = (S - 32) / 16 + 1; p.NR = 2 * p.T + 2048;
    const long long T = p.T;
    long long o = 0;
    auto take = [&](long long bytes) { long long r = o; o = al256(o + bytes); return r; };
    p.oBAR = take(16384); p.oMOEC = take(4096);
    p.oROPE = take(T * 16 * 4);
    p.oKCMP = take(B * p.NC * 128 * 4); p.oVCMP = take(B * p.NC * 128 * 4); p.oUV = take((T / 16) * 4 * 256 * 2); p.oW1T = take(2LL * 2 * 256 * 1024 * 2); p.oCB = take(2 * 2 * 128 * 4);
    p.oSELM = take(T * 2 * 4);
    p.oKV = take(2 * B * 256 * 512 * 2);
    p.oTOKE = take(T * 2 * 4); p.oTOKW = take(T * 2 * 4); p.oTOKS = take(T * 2 * 4); p.oR2T = take(p.NR * 4); p.oROWW = take(p.NR * 4);
    p.oCCNT = take((T / 64) * 8 * 4); p.oCOFF = take((T / 64) * 8 * 4);
    p.oWL[0] = take(W_LAYER * 2); p.oWL[1] = take(W_LAYER * 2); p.oWKV = take(2LL * 512 * 1024 * 2); p.oWFFN = take(3 * 1024 * DFF * 2);
    p.oVF = take(T * 256 * 2);
    p.oH = take(T * 1024 * 2);
    p.oP = take(T * 3072 * 2);
    p.oO = take(T * 1024 * 2);
    p.oBO = take(T * 2048);
    p.oMG = take(T * 2048);
    long long end_main = o;
    p.oRWW = p.oBO;
    p.oRWX = p.oRWW + T * 1024;
    p.oGA = p.oRWX + T * 2560;
    p.oCQ = p.oP; p.oCAO = p.oP + T * 512;
    p.oMEMN = p.oBO;
    p.oACT = p.oP;
    p.oY = p.oVF; long long q = al256(p.oY + p.NR * 2048);
    p.oHS = q; q = al256(q + p.NR * 2048);
    p.oMOEW = q; q = al256(q + 8LL * 3 * 1024 * DFF * 2);
    const long long ntmax = p.NR / 256, ct = (ntmax + 3) / 4;
    p.oACTC = q; q = al256(q + ct * 256 * DFF * 2);
    p.wsNeed = q > end_main ? q : end_main;
}
#define WSP(T_, off) ((T_*)(p.ws + (off)))

DEVI void cvt_T(bf16_t* dst, const float* src, long long K, long long N, long long Npad, long long ld, long long gtid, long long gsz) {
    for (long long i = gtid; i < Npad * K; i += gsz) { const long long n = i / K, k = i % K; dst[i] = n < N ? f2bf(src[k * ld + n]) : (bf16_t)0; }
}
DEVI void cvt_GU(bf16_t* dst, const float* wg, const float* wu, long long DFF, long long gtid, long long gsz) {
    for (long long i = gtid; i < 2 * DFF * 1024; i += gsz) { const long long rr = i / 1024, k = i % 1024, t = rr >> 8, w = rr & 255;
        dst[i] = f2bf((w < 128 ? wg : wu)[k * DFF + t * 128 + (w & 127)]); }
}
DEVI void ph_convert_layer(const Params& p, int l, long long gtid, long long gsz) {
    bf16_t* W = WSP(bf16_t, p.oWL[l]);
    for (long long i = gtid; i < 3072LL * 1024; i += gsz) { const long long n = i >> 10, k = i & 1023; float v = 0.f;
        if (n < 1036) v = p.in[I_W_IN][((long long)l * 1024 + k) * INW + n];
        else if (n >= C_POOL && n < C_VRES) v = p.in[I_W_IN][((long long)l * 1024 + k) * INW + n - 4];
        else if (n >= C_VRES && n < C_VRES + 32 && l == 1) v = p.in[I_RW_V1][k * 32 + (n - C_VRES)];
        W[W_IN + i] = f2bf(v); }
    for (int i = 0; i < 4; ++i) cvt_T(W + W_G + (long long)i * 1024 * 1024, p.in[I_W_GATE] + ((long long)l * 4 + i) * 1024 * 1024, 1024, 1024, 1024, 1024, gtid, gsz);
    for (int i = 0; i < 4; ++i) cvt_T(W + W_B + (long long)i * 1024 * 256, p.in[I_W_BRANCH] + ((long long)l * 4 + i) * 256 * 1024, 256, 1024, 1024, 1024, gtid, gsz);
    cvt_T(W + W_O, p.in[I_W_OUT] + (long long)l * 1024 * 1024, 1024, 1024, 1024, 1024, gtid, gsz);
    cvt_T(W + W_CQ, p.in[I_CA_Q] + (long long)l * 1024 * 256, 1024, 256, 256, 256, gtid, gsz);
    cvt_T(WSP(bf16_t, p.oWKV) + (long long)l * 512 * 1024, p.in[I_CA_KV] + (long long)l * 1024 * 512, 1024, 512, 512, 512, gtid, gsz);
    cvt_T(W + W_CO, p.in[I_CA_O] + (long long)l * 256 * 1024, 256, 1024, 1024, 1024, gtid, gsz);
}
DEVI void ph_convert_ffn(const Params& p, long long gtid, long long gsz) {
    bf16_t* W = WSP(bf16_t, p.oWFFN);
    cvt_GU(W, p.in[I_FFN_G], p.in[I_FFN_U], p.DFF, gtid, gsz);
    cvt_T(W + 2 * p.DFF * 1024, p.in[I_FFN_D], p.DFF, 1024, 1024, 1024, gtid, gsz);
}
DEVI void ph_convert_moe(const Params& p, long long gtid, long long gsz) {
    const long long DFF = p.DFF, per = 3 * 1024 * DFF;
    for (int e = 0; e < 8; ++e) { bf16_t* W = WSP(bf16_t, p.oMOEW) + e * per;
        cvt_GU(W, p.in[I_MOE_G] + (long long)e * 1024 * DFF, p.in[I_MOE_U] + (long long)e * 1024 * DFF, DFF, gtid, gsz);
        cvt_T(W + 2 * DFF * 1024, p.in[I_MOE_D] + (long long)e * DFF * 1024, DFF, 1024, 1024, 1024, gtid, gsz); }
}
DEVI void ph_rope(const Params& p, long long gtid, long long gsz) {
    const int* pos = (const int*)p.in[I_POS]; float* R = WSP(float, p.oROPE);
    for (long long i = gtid; i < p.T * 8; i += gsz) { const long long t = i >> 3; const int j = (int)(i & 7);
        const float ang = (float)pos[t] * p.inv_freq[j];
        double a = (double)ang; a -= 6.283185307179586476925 * floor(a * 0.15915494309189533577 + 0.5);
        const float ar = (float)a; R[t * 16 + j] = cosf(ar); R[t * 16 + 8 + j] = sinf(ar); }
}
DEVI void ph_rope_apply(const Params& p, long long gtid, long long gsz) {
    bf16_t* P = WSP(bf16_t, p.oP); const float* R = WSP(float, p.oROPE);
    for (long long i = gtid; i < p.T * 8; i += gsz) { const long long t = i >> 3; const int w = (int)(i & 7);
        const int col = w < 4 ? C_Q + w * 64 : (w < 6 ? C_KS + (w - 4) * 64 : C_KW + (w - 6) * 64);
        bf16_t* x = P + t * PW + col; const float* r = R + t * 16; const float sc = w < 4 ? 0.125f : 1.0f;
        for (int j = 0; j < 8; ++j) { const float a = bf2f(x[j]), b = bf2f(x[j + 8]), c = r[j], s = r[8 + j]; x[j] = f2bf((a * c - b * s) * sc); x[j + 8] = f2bf((b * c + a * s) * sc); }
        if (w < 4) for (int j = 16; j < 64; ++j) x[j] = f2bf(bf2f(x[j]) * 0.125f); }
}
DEVI void ph_compress2(const Params& p, int l, long long gtid, long long gsz) {
    const bf16_t* UV = WSP(bf16_t, p.oUV); const float* CB = WSP(float, p.oCB) + l * 256; const float* w2 = p.in[I_CMP_W2] + (long long)l * 2 * 128 * 64; const float* R = WSP(float, p.oROPE);
    float* KC = WSP(float, p.oKCMP); float* VC = WSP(float, p.oVCMP);
    const long long n_items = p.B * p.NC * 2 * 2 * 8, hb = p.S / 16;
    for (long long i = gtid; i < n_items; i += gsz) { const int d8 = (int)(i & 7), j = (int)((i >> 3) & 1), g = (int)((i >> 4) & 1); const long long bn = i >> 5, n = bn % p.NC, b = bn / p.NC;
        const bf16_t* u = UV + ((b * hb + n) * 4 + (2 * j + g)) * 256; const bf16_t* vv = u + 4 * 256 + 128; const float* w = w2 + (long long)j * 128 * 64; const float* cb = CB + j * 128;
        float a[8];
#pragma unroll
        for (int m = 0; m < 8; ++m) a[m] = 0.f;
        for (int f = 0; f < 128; ++f) { const float hv = gelu_tanhf_(bf2f(u[f]) + bf2f(vv[f]) + cb[f]);
#pragma unroll
            for (int m = 0; m < 8; ++m) a[m] += hv * w[f * 64 + d8 + 8 * m]; }
        if (j == 0) { const float* r = R + (b * p.S + n * 16 + 31) * 16; const float x0 = a[0], x1 = a[1], cs = r[d8], sn = r[8 + d8]; a[0] = x0 * cs - x1 * sn; a[1] = x1 * cs + x0 * sn; }
        float* dst = (j == 0 ? KC : VC) + (bn * 2 + g) * 64;
#pragma unroll
        for (int m = 0; m < 8; ++m) dst[d8 + 8 * m] = a[m]; }
}
DEVI void ph_convert_cmp(const Params& p, long long gtid, long long gsz) {
    bf16_t* W1T = WSP(bf16_t, p.oW1T); float* CB = WSP(float, p.oCB);
    for (long long i = gtid; i < 2LL * 2 * 256 * 1024; i += gsz) { const int k = (int)(i & 1023), n = (int)((i >> 10) & 255); const long long lj = i >> 18; const int half = n >> 7, f = n & 127, tap = k >> 6, d = k & 63;
        W1T[i] = f2bf(p.in[I_CMP_W1][((lj * 32 + half * 16 + tap) * 64 + d) * 128 + f]); }
    for (long long i = gtid; i < 2 * 2 * 128; i += gsz) { const int f = (int)(i & 127); const long long lj = i >> 7; float a = 0.f;
        for (int k = 0; k < 2048; ++k) a += p.in[I_CMP_PE][lj * 2048 + k] * p.in[I_CMP_W1][(lj * 2048 + k) * 128 + f];
        CB[i] = a; }
}
DEVI void ph_pool(const Params& p, int l, long long gtid, long long gsz) {
    const bf16_t* P = WSP(bf16_t, p.oP); bf16_t* O = WSP(bf16_t, p.oO);
    const float* pw = p.in[I_POOL_W] + (long long)l * 4 * 64 * 64; const float* ps = p.in[I_POOL_SCALE] + (long long)l * 256;
    for (long long i = gtid; i < p.T * 4; i += gsz) { const long long t = i >> 2; const int g = (int)(i & 3); const long long s = t % p.S; const int win = 2 << g;
        const int cnt = (int)(s + 1 < win ? s + 1 : win); const float inv = 1.0f / (float)cnt;
        float dv[64];
#pragma unroll
        for (int c = 0; c < 64; ++c) dv[c] = 0.f;
        for (int k = 0; k < cnt; ++k) { const bf16_t* x = P + (t - k) * PW + C_POOL + g * 64;
#pragma unroll
            for (int c = 0; c < 64; ++c) dv[c] += bf2f(x[c]); }
        { const bf16_t* x = P + t * PW + C_POOL + g * 64;
#pragma unroll
            for (int c = 0; c < 64; ++c) dv[c] = dv[c] * inv - bf2f(x[c]); }
        const float* w = pw + g * 64 * 64;
        for (int d = 0; d < 64; ++d) { float a = 0.f;
#pragma unroll
            for (int c = 0; c < 64; ++c) a += dv[c] * w[c * 64 + d];
            O[t * 1024 + 256 + g * 64 + d] = f2bf(a * ps[g * 64 + d]); } }
}
DEVI void st16bf(bf16_t* dst, const float (&v)[16]) { st8(dst, v); st8(dst + 8, v + 8); }
DEVI void ph_rwkv_prep(const Params& p, int l, long long gtid, long long gsz) {
    const bf16_t* P = WSP(bf16_t, p.oP); float* RWW = WSP(float, p.oRWW); bf16_t* RWX = WSP(bf16_t, p.oRWX); bf16_t* O = WSP(bf16_t, p.oO); bf16_t* VF = WSP(bf16_t, p.oVF);
    const float* mu = p.in[I_RW_MU] + l * 896; const float* w0 = p.in[I_RW_W0] + l * 256; const float* w2 = p.in[I_RW_W2] + l * 32 * 256; const float* a0 = p.in[I_RW_A0] + l * 256;
    const float* a2 = p.in[I_RW_A2] + l * 32 * 256; const float* g2 = p.in[I_RW_G2] + l * 64 * 256; const float* kkw = p.in[I_RW_KK] + l * 256; const float* kaw = p.in[I_RW_KA] + l * 256;
    const float* v0 = p.in[I_RW_V0]; const float* v2 = p.in[I_RW_V2];
    for (long long i = gtid; i < p.T * 16; i += gsz) { const long long t = i >> 4; const int h = (int)((i >> 2) & 3), cc = (int)(i & 3); const bool first = (t % p.S) == 0;
        const bf16_t* x = P + t * PW + C_RW; const bf16_t* xp = x - PW;
#define LERP(c) (first ? bf2f(x[c]) * (1.0f - mu[c]) : (bf2f(x[c]) + (bf2f(xp[c]) - bf2f(x[c])) * mu[c]))
        float nn = 0.f;
        for (int c = h * 64; c < h * 64 + 64; ++c) { const float kq = LERP(256 + c) * kkw[c]; nn += kq * kq; }
        const float rn = 1.0f / fmaxf(sqrtf(nn), 1e-12f);
        const int c0 = h * 64 + cc * 16;
        float zw[16], za[16], zg[16], zv[16];
#pragma unroll
        for (int u = 0; u < 16; ++u) { zw[u] = w0[c0 + u]; za[u] = a0[c0 + u]; zg[u] = 0.f; zv[u] = (l == 1) ? v0[c0 + u] : 0.f; }
        for (int j = 0; j < 32; ++j) { const float tw = tanhf(LERP(768 + j)), ad = LERP(800 + j), hv = (l == 1) ? bf2f(P[t * PW + C_VRES + j]) : 0.f;
#pragma unroll
            for (int u = 0; u < 16; ++u) { zw[u] += tw * w2[j * 256 + c0 + u]; za[u] += ad * a2[j * 256 + c0 + u]; if (l == 1) zv[u] += hv * v2[j * 256 + c0 + u]; } }
        for (int j = 0; j < 64; ++j) { const float sg = sigmoidf_(LERP(832 + j));
#pragma unroll
            for (int u = 0; u < 16; ++u) zg[u] += sg * g2[j * 256 + c0 + u]; }
        float o_r[16], o_k[16], o_v[16], o_kk[16], o_b[16];
#pragma unroll
        for (int u = 0; u < 16; ++u) { const int c = c0 + u;
            const float wlog = -softplusf_(-zw[u]) - 0.5f, dec = expf(-expf(wlog)), a = sigmoidf_(za[u]);
            const float r = LERP(c), k = LERP(256 + c); float v = LERP(512 + c);
            if (l == 1) { const float vf = bf2f(VF[t * 256 + c]); v = v + (vf - v) * sigmoidf_(zv[u]); }
            const float kk = k * kkw[c] * rn, k2 = k * (1.0f + (a - 1.0f) * kaw[c]);
            zw[u] = dec; o_r[u] = r; o_k[u] = k2; o_v[u] = v; o_kk[u] = kk; o_b[u] = kk * a;
            }
        float* ww = RWW + t * 256 + c0;
#pragma unroll
        for (int u = 0; u < 16; ++u) ww[u] = zw[u];
        bf16_t* rx = RWX + t * 1280 + c0;
        st16bf(rx, o_r); st16bf(rx + 256, o_k); st16bf(rx + 512, o_v); st16bf(rx + 768, o_kk); st16bf(rx + 1024, o_b);
        if (l == 0) st16bf(VF + t * 256 + c0, o_v);
        st16bf(O + t * 1024 + 512 + c0, zg);
        }
#undef LERP
}
DEVI float rwkv_row_step(float (&st)[64], const float* w, const bf16_t* r, const bf16_t* k, const bf16_t* kk, const bf16_t* b, float v) {
    float skk = 0.f;
#pragma unroll
    for (int c = 0; c < 64; ++c) skk += st[c] * bf2f(kk[c]);
    float y = 0.f;
#pragma unroll
    for (int c = 0; c < 64; ++c) { st[c] = st[c] * w[c] - skk * bf2f(b[c]) + v * bf2f(k[c]); y += st[c] * bf2f(r[c]); }
    return y;
}
DEVI void ph_gla_prep(const Params& p, int l, long long gtid, long long gsz) {
    const bf16_t* P = WSP(bf16_t, p.oP); float* GA = WSP(float, p.oGA); bf16_t* O = WSP(bf16_t, p.oO);
    const float* a2 = p.in[I_GLA_A2] + l * 16 * 128; const float* ab = p.in[I_GLA_AB] + l * 128;
    for (long long i = gtid; i < p.T * 128; i += gsz) { const long long t = i >> 7; const int c = (int)(i & 127); const bf16_t* ad = P + t * PW + C_GLA + 512;
        float z = ab[c];
        for (int j = 0; j < 16; ++j) z += bf2f(ad[j]) * a2[j * 128 + c];
        GA[i] = expf(-softplusf_(-z) * 0.0625f);
        const bf16_t* og = P + t * PW + C_GLA + 528; O[t * 1024 + 768 + c] = f2bf(siluf_(bf2f(og[c]))); O[t * 1024 + 768 + 128 + c] = f2bf(siluf_(bf2f(og[128 + c]))); }
}
DEVI float gla_col_step(float (&st)[32], const float* a, const bf16_t* q, const bf16_t* k, float v) {
    float o = 0.f;
#pragma unroll
    for (int c = 0; c < 32; ++c) { st[c] = st[c] * a[c] + bf2f(k[c]) * v; o += st[c] * bf2f(q[c]); }
    return o * 0.17677669529663687f;
}
DEVI void ph_cmp_attn(const Params& p, long long gtid, long long gsz) {
    const bf16_t* P = WSP(bf16_t, p.oP); const float* KC = WSP(float, p.oKCMP); const float* VC = WSP(float, p.oVCMP); unsigned* SELM = WSP(unsigned, p.oSELM); bf16_t* O = WSP(bf16_t, p.oO);
    for (long long i = gtid; i < p.T * 2; i += gsz) { const long long t = i >> 1, b = t / p.S, s = t % p.S; const int g = (int)(i & 1);
        const int nv = s >= 31 ? (int)((s - 31) / 16 + 1) : 0;
        const int cur = (int)(s >> 6);
        const float* kc = KC + (b * p.NC * 2 + g) * 64; const float* vc = VC + (b * p.NC * 2 + g) * 64;
        float q0[64], q1[64];
        { const bf16_t* q = P + t * PW + C_Q + (2 * g) * 64;
#pragma unroll
          for (int d = 0; d < 64; ++d) { q0[d] = bf2f(q[d]); q1[d] = bf2f(q[64 + d]); } }
        float m0 = -3e38f, m1 = -3e38f;
        for (int n = 0; n < nv; ++n) { const float* k = kc + n * 128; float s0 = 0.f, s1 = 0.f;
#pragma unroll
            for (int d = 0; d < 64; ++d) { s0 += q0[d] * k[d]; s1 += q1[d] * k[d]; }
            m0 = fmaxf(m0, s0); m1 = fmaxf(m1, s1); }
        float z0 = 0.f, z1 = 0.f;
        for (int n = 0; n < nv; ++n) { const float* k = kc + n * 128; float s0 = 0.f, s1 = 0.f;
#pragma unroll
            for (int d = 0; d < 64; ++d) { s0 += q0[d] * k[d]; s1 += q1[d] * k[d]; }
            z0 += expf(s0 - m0); z1 += expf(s1 - m1); }
        const float iz0 = nv ? 1.0f / z0 : 0.f, iz1 = nv ? 1.0f / z1 : 0.f;
        unsigned mask;
        if (cur < 8) mask = (2u << cur) - 1u;
        else {
            float tv0 = -3e38f, tv1 = -3e38f, tv2 = -3e38f, tv3 = -3e38f, tv4 = -3e38f; int ti0 = 0, ti1 = 0, ti2 = 0, ti3 = 0, ti4 = 0;
            float carry = 0.f;
            for (int j = 0; j <= cur - 2; ++j) { float imp = carry;
                for (int mm = 0; mm < 4; ++mm) { const int n = 4 * j + mm; float pn = 0.f;
                    if (n < nv) { const float* k = kc + n * 128; float s0 = 0.f, s1 = 0.f;
#pragma unroll
                        for (int d = 0; d < 64; ++d) { s0 += q0[d] * k[d]; s1 += q1[d] * k[d]; }
                        pn = expf(s0 - m0) * iz0 + expf(s1 - m1) * iz1; }
                    if (mm < 3) imp += pn; else { imp += 0.5f * pn; carry = 0.5f * pn; } }
                if (j >= 1) {
                    float v = imp; int id = j;
                    if (v > tv0) { float tf = tv0; tv0 = v; v = tf; int tt = ti0; ti0 = id; id = tt; }
                    if (v > tv1) { float tf = tv1; tv1 = v; v = tf; int tt = ti1; ti1 = id; id = tt; }
                    if (v > tv2) { float tf = tv2; tv2 = v; v = tf; int tt = ti2; ti2 = id; id = tt; }
                    if (v > tv3) { float tf = tv3; tv3 = v; v = tf; int tt = ti3; ti3 = id; id = tt; }
                    if (v > tv4) { tv4 = v; ti4 = id; } } }
            mask = 1u | (1u << cur) | (1u << (cur - 1)) | (1u << ti0) | (1u << ti1) | (1u << ti2) | (1u << ti3) | (1u << ti4);
        }
        SELM[i] = mask;
        for (int r = 0; r < 2; ++r) { const int hd = 2 * g + r; const float mr = r ? m1 : m0, izr = r ? iz1 : iz0;
            float o[64], qq[64];
            { const bf16_t* q = P + t * PW + C_Q + hd * 64;
#pragma unroll
              for (int d = 0; d < 64; ++d) { o[d] = 0.f; qq[d] = bf2f(q[d]); } }
            for (int n = 0; n < nv; ++n) { const float* k = kc + n * 128; const float* v = vc + n * 128; float sc = 0.f;
#pragma unroll
                for (int d = 0; d < 64; ++d) sc += qq[d] * k[d];
                const float pr = expf(sc - mr) * izr;
#pragma unroll
                for (int d = 0; d < 64; ++d) o[d] += pr * v[d]; }
            const float g0 = sigmoidf_(bf2f(P[t * PW + C_NG + hd * 3 + 0]));
#pragma unroll
            for (int d = 0; d < 64; ++d) O[t * 1024 + hd * 64 + d] = f2bf(g0 * o[d]); } }
}
DEVI void ph_selwin(const Params& p, long long gtid, long long gsz) {
    const bf16_t* P = WSP(bf16_t, p.oP); const unsigned* SELM = WSP(unsigned, p.oSELM); bf16_t* O = WSP(bf16_t, p.oO);
    for (long long i = gtid; i < p.T * 8; i += gsz) { const long long t = i >> 3, b = t / p.S, s = t % p.S; const int hd = (int)((i >> 1) & 3), g = hd >> 1, d0 = (int)(i & 1) * 32;
        unsigned qp[32]; float o[32];
        { const bf16_t* qq = P + t * PW + C_Q + hd * 64;
#pragma unroll
          for (int d = 0; d < 32; ++d) qp[d] = (unsigned)qq[2 * d] | ((unsigned)qq[2 * d + 1] << 16); }
        for (int pass = 0; pass < 2; ++pass) {
            const int ck = pass ? C_KW : C_KS, cv = pass ? C_VW : C_VS; const unsigned mask = SELM[t * 2 + g];
            float m = -3e38f, z = 0.f;
#pragma unroll
            for (int d = 0; d < 32; ++d) o[d] = 0.f;
            const long long lo = pass ? (s - 511 > 0 ? s - 511 : 0) : 0;
            for (long long kp = lo; kp <= s; ++kp) {
                if (!pass && !((mask >> (kp >> 6)) & 1u)) { kp |= 63; continue; }
                const bf16_t* k = P + (b * p.S + kp) * PW + ck + g * 64; const bf16_t* v = P + (b * p.S + kp) * PW + cv + g * 64 + d0; float sc = 0.f;
#pragma unroll
                for (int d = 0; d < 32; ++d) sc += u2f(qp[d] << 16) * bf2f(k[2 * d]) + u2f(qp[d] & 0xffff0000u) * bf2f(k[2 * d + 1]);
                if (sc > m) { const float f = expf(m - sc); z *= f;
#pragma unroll
                    for (int d = 0; d < 32; ++d) o[d] *= f;
                    m = sc; }
                const float pr = expf(sc - m); z += pr;
#pragma unroll
                for (int d = 0; d < 32; ++d) o[d] += pr * bf2f(v[d]); }
            const float gt = sigmoidf_(bf2f(P[t * PW + C_NG + hd * 3 + 1 + pass])) / z;
#pragma unroll
            for (int d = 0; d < 32; ++d) { bf16_t* od = O + t * 1024 + hd * 64 + d0 + d; *od = f2bf(bf2f(*od) + gt * o[d]); } } }
}
DEVI void ph_ca_attn(const Params& p, int l, long long gtid, long long gsz) {
    const bf16_t* CQ = WSP(bf16_t, p.oCQ); const bf16_t* KV = WSP(bf16_t, p.oKV) + (long long)l * 512; bf16_t* AO = WSP(bf16_t, p.oCAO);
    for (long long i = gtid; i < p.T * 4; i += gsz) { const long long t = i >> 2, b = t / p.S; const int hd = (int)(i & 3);
        float q[64], o[64];
#pragma unroll
        for (int d = 0; d < 64; ++d) { q[d] = bf2f(CQ[t * 256 + hd * 64 + d]); o[d] = 0.f; }
        float m = -3e38f, z = 0.f;
        for (int kp = 0; kp < 256; ++kp) { const bf16_t* k = KV + (b * 256 + kp) * 1024 + hd * 64; const bf16_t* v = k + 256; float sc = 0.f;
#pragma unroll
            for (int d = 0; d < 64; ++d) sc += q[d] * bf2f(k[d]);
            if (sc > m) { const float f = expf(m - sc); z *= f;
#pragma unroll
                for (int d = 0; d < 64; ++d) o[d] *= f;
                m = sc; }
            const float pr = expf(sc - m); z += pr;
#pragma unroll
            for (int d = 0; d < 64; ++d) o[d] += pr * bf2f(v[d]); }
        const float iz = 1.0f / z;
#pragma unroll
        for (int d = 0; d < 64; ++d) AO[t * 256 + hd * 64 + d] = f2bf(o[d] * iz); }
}
DEVI void ph_moe_count(const Params& p, long long gtid, long long gsz) {
    const int* TE = WSP(int, p.oTOKE); int* CC = WSP(int, p.oCCNT); int* R2T = WSP(int, p.oR2T);
    for (long long c = gtid; c < p.T / 64; c += gsz) { int cnt[8] = {0, 0, 0, 0, 0, 0, 0, 0};
        for (int j = 0; j < 128; ++j) { const int e = TE[c * 128 + j];
#pragma unroll
            for (int q = 0; q < 8; ++q) cnt[q] += (e == q); }
#pragma unroll
        for (int q = 0; q < 8; ++q) CC[c * 8 + q] = cnt[q]; }
    for (long long i = gtid; i < p.NR; i += gsz) R2T[i] = -1;
}
DEVI void ph_moe_offsets(const Params& p, long long gtid, long long gsz) {
    const int* CC = WSP(int, p.oCCNT); int* CO = WSP(int, p.oCOFF); int* MC = WSP(int, p.oMOEC);
    for (long long ee = gtid; ee < 8; ee += gsz) { const int e = (int)ee; int run = 0; for (long long c = 0; c < p.T / 64; ++c) { CO[c * 8 + e] = run; run += CC[c * 8 + e]; } MC[e] = run; }
}
DEVI void moe_bases(const Params& p, int (&base)[9]) { const int* MC = WSP(int, p.oMOEC); int run = 0;
#pragma unroll
    for (int e = 0; e < 8; ++e) { base[e] = run; run += (MC[e] + 255) & ~255; } base[8] = run; }
DEVI void ph_moe_assign(const Params& p, long long gtid, long long gsz) {
    const int* TE = WSP(int, p.oTOKE); const float* TW = WSP(float, p.oTOKW); const int* CO = WSP(int, p.oCOFF); int* TS = WSP(int, p.oTOKS); int* R2T = WSP(int, p.oR2T); float* RW = WSP(float, p.oROWW);
    int base[9]; moe_bases(p, base);
    if (gtid == 0) { int* MC = WSP(int, p.oMOEC);
#pragma unroll
        for (int e = 0; e < 9; ++e) MC[16 + e] = base[e]; }
    for (long long c = gtid; c < p.T / 64; c += gsz) { int run[8];
#pragma unroll
        for (int q = 0; q < 8; ++q) run[q] = base[q] + CO[c * 8 + q];
        for (int j = 0; j < 128; ++j) { const int e = TE[c * 128 + j]; int slot = 0;
#pragma unroll
            for (int q = 0; q < 8; ++q) if (e == q) { slot = run[q]; run[q] += 1; }
            TS[c * 128 + j] = slot; R2T[slot] = (int)(c * 64 + (j >> 1)); RW[slot] = TW[c * 128 + j]; } }
}
DEVI void ph_moe_gather(const Params& p, long long gtid, long long gsz) {
    const int* R2T = WSP(int, p.oR2T); const int* MC = WSP(int, p.oMOEC); const uint4* H = WSP(uint4, p.oH); uint4* HS = WSP(uint4, p.oHS);
    const long long rows = MC[16 + 8];
    for (long long i = gtid; i < rows * 128; i += gsz) { const long long r = i >> 7; const int j = (int)(i & 127); const int t = R2T[r];
        uint4 v; v.x = v.y = v.z = v.w = 0u; if (t >= 0) v = H[(long long)t * 128 + j]; HS[i] = v; }
}
struct Unit { int pm, pn, aux, pad; long long aoff, boff; };
constexpr int NXCD = 8, WGM = 8;
DEVI void tile_order(long long L, int nM, int nN, int& pm, int& pn) {
    const int nwg = nM * nN; int wgid = (int)L; { const int q = nwg / NXCD, r = nwg % NXCD, xcd = wgid % NXCD, off = wgid / NXCD; wgid = (xcd < r ? xcd * (q + 1) : r * (q + 1) + (xcd - r) * q) + off; }
    const int nig = WGM * nN, gid = wgid / nig, fm = gid * WGM, gsz = (nM - fm) < WGM ? (nM - fm) : WGM;
    pm = fm + ((wgid % nig) % gsz); pn = (wgid % nig) / gsz;
}
struct SchedPlain {
    int nM, nN, G, c; long long lda, ldb;
    DEVM void init(long long M, long long N, long long lda_, long long ldb_, int G_, int c_) { nM = (int)(M / 256); nN = (int)(N / 256); lda = lda_; ldb = ldb_; G = G_; c = c_; }
    DEVM bool next(int i, Unit& u) const { const long long L = (long long)i * G + c; if (L >= (long long)nM * nN) return false; tile_order(L, nM, nN, u.pm, u.pn); u.aux = 0; u.pad = 0;
        u.aoff = (long long)u.pm * 256 * lda * 2; u.boff = (long long)u.pn * 256 * ldb * 2; return true; }
    DEVM void a_ready(const Unit&) const {}
    DEVM void done(const Unit&) const {}
};
struct SchedBranch {
    int nM, G, c;
    DEVM void init(long long M, int G_, int c_) { nM = (int)(M / 256); G = G_; c = c_; }
    DEVM bool next(int i, Unit& u) const { const long long L = (long long)i * G + c; if (L >= (long long)nM * 16) return false; tile_order(L, nM, 16, u.pm, u.pn); u.aux = u.pn >> 2; u.pad = 0;
        u.aoff = (long long)u.pm * 256 * 1024 * 2 + (long long)u.aux * 256 * 2; u.boff = (long long)u.pn * 256 * 256 * 2; return true; }
    DEVM void a_ready(const Unit&) const {}
    DEVM void done(const Unit&) const {}
};
struct SchedGate {
    int nM, G, c;
    DEVM void init(long long M, int G_, int c_) { nM = (int)(M / 256); G = G_; c = c_; }
    DEVM bool next(int i, Unit& u) const { const long long tile = (long long)(i >> 2) * G + c; if (tile >= (long long)nM * 4) return false; tile_order(tile, nM, 4, u.pm, u.pn); u.aux = i & 3; u.pad = 0;
        u.aoff = (long long)u.pm * 256 * 1024 * 2; u.boff = (long long)(u.aux * 4 + u.pn) * 256 * 1024 * 2; return true; }
    DEVM void a_ready(const Unit&) const {}
    DEVM void done(const Unit&) const {}
};
struct SchedMoe {
    int t0, t1, nN, G, c; long long lda, ldb, per_e; int base[9];
    DEVM bool next(int i, Unit& u) const { const long long L = (long long)i * G + c; if (L >= (long long)(t1 - t0) * nN) return false; u.pm = t0 + (int)(L / nN); u.pn = (int)(L % nN); u.pad = 0;
        int e = 0;
#pragma unroll
        for (int q = 1; q < 8; ++q) e += (u.pm * 256 >= base[q]) ? 1 : 0;
        u.aux = e; u.aoff = (long long)u.pm * 256 * lda * 2; u.boff = (long long)e * per_e + (long long)u.pn * 256 * ldb * 2; return true; }
    DEVM void a_ready(const Unit&) const {}
    DEVM void done(const Unit&) const {}
};
struct SchedCmp {
    int nM, G, c;
    DEVM void init(long long rows, int G_, int c_) { nM = (int)(rows / 256); G = G_; c = c_; }
    DEVM bool next(int i, Unit& u) const { const long long L = (long long)i * G + c; if (L >= (long long)nM * 4) return false; const int combo = (int)(L / nM); u.pm = (int)(L % nM); u.pn = 0; u.aux = combo; u.pad = 0;
        u.aoff = (long long)u.pm * 256 * 16 * PW * 2 + (long long)(((combo >> 1) ? C_VC : C_KC) + (combo & 1) * 64) * 2; u.boff = (long long)(combo >> 1) * 256 * 1024 * 2; return true; }
    DEVM void a_ready(const Unit&) const {}
    DEVM void done(const Unit&) const {}
};
struct EpStore {
    bf16_t* O; long long ldo; float scale;
    DEVM void apply(const Unit& u, long long row, int c8, const float* lo, const float* hi) const { float a[8], b[8];
#pragma unroll
        for (int j = 0; j < 8; ++j) { a[j] = lo[j] * scale; b[j] = hi[j] * scale; }
        bf16_t* d = O + row * ldo + u.pn * 256 + c8; st8(d, a); st8(d + 128, b); }
};
struct EpUV {
    bf16_t* UV;
    DEVM void apply(const Unit& u, long long row, int c8, const float* lo, const float* hi) const { bf16_t* d = UV + (row * 4 + u.aux) * 256 + c8; st8(d, lo); st8(d + 128, hi); }
};
struct EpGate {
    const bf16_t* BO; const float* bias; bf16_t* MG; long long row0;
    DEVM void apply(const Unit& u, long long row, int c8, const float* lo, const float* hi) const {
#pragma unroll
        for (int hh = 0; hh < 2; ++hh) { const float* v = hh ? hi : lo; const int c = u.pn * 256 + hh * 128 + c8, n = u.aux * 1024 + c; float bo[8], mg[8], r[8]; ld8(BO + row * 4096 + n, bo);
            bf16_t* m = MG + (row0 + row) * 1024 + c;
            if (u.aux) ld8(m, mg);
#pragma unroll
            for (int j = 0; j < 8; ++j) { r[j] = sigmoidf_(v[j] + bias[n + j]) * bo[j]; if (u.aux) r[j] += mg[j]; }
            st8(m, r); } }
};
struct EpResid {
    float* X;
    DEVM void apply(const Unit& u, long long row, int c8, const float* lo, const float* hi) const { float* x = X + row * 1024 + u.pn * 256 + c8;
#ifndef CPU_EMU
        float4 a = *(float4*)x, b = *(float4*)(x + 4), c = *(float4*)(x + 128), d = *(float4*)(x + 132);
        a.x += lo[0]; a.y += lo[1]; a.z += lo[2]; a.w += lo[3]; b.x += lo[4]; b.y += lo[5]; b.z += lo[6]; b.w += lo[7];
        c.x += hi[0]; c.y += hi[1]; c.z += hi[2]; c.w += hi[3]; d.x += hi[4]; d.y += hi[5]; d.z += hi[6]; d.w += hi[7];
        *(float4*)x = a; *(float4*)(x + 4) = b; *(float4*)(x + 128) = c; *(float4*)(x + 132) = d;
#else
        for (int j = 0; j < 8; ++j) { x[j] += lo[j]; x[128 + j] += hi[j]; }
#endif
    }
};
struct EpSwiglu {
    bf16_t* ACT; long long ldo; long long row0;
    DEVM void apply(const Unit& u, long long row, int c8, const float* lo, const float* hi) const { float r[8];
#pragma unroll
        for (int j = 0; j < 8; ++j) r[j] = siluf_(lo[j]) * hi[j];
        st8(ACT + (row - row0) * ldo + u.pn * 128 + c8, r); }
};
struct EpMoeDown {
    bf16_t* Y; const float* roww;
    DEVM void apply(const Unit& u, long long row, int c8, const float* lo, const float* hi) const { const float w = roww[row]; float a[8], b[8];
#pragma unroll
        for (int j = 0; j < 8; ++j) { a[j] = lo[j] * w; b[j] = hi[j] * w; }
        bf16_t* d = Y + row * 1024 + u.pn * 256 + c8; st8(d, a); st8(d + 128, b); }
};

#ifdef CPU_EMU
template <class Sched, class Epi> static void gemm_cpu(const bf16_t* A, long long lda, const bf16_t* Bt, long long ldb, long long K, const Sched& S, const Epi& E, long long kstepA = 64) {
    Unit u;
    for (int i = 0; S.next(i, u); ++i) {
        const bf16_t* a0 = (const bf16_t*)((const char*)A + u.aoff); const bf16_t* b0 = (const bf16_t*)((const char*)Bt + u.boff);
#pragma omp parallel for
        for (int r = 0; r < 256; ++r) { float arow[4096]; for (long long k = 0; k < K; ++k) arow[k] = bf2f(a0[r * lda + (k >> 6) * kstepA + (k & 63)]);
            for (int c8 = 0; c8 < 128; c8 += 8) { float lo[8], hi[8];
                for (int j = 0; j < 8; ++j) { const bf16_t* bl = b0 + (c8 + j) * ldb; const bf16_t* bh = b0 + (128 + c8 + j) * ldb; float s0 = 0.f, s1 = 0.f;
                    for (long long k = 0; k < K; ++k) { s0 += arow[k] * bf2f(bl[k]); s1 += arow[k] * bf2f(bh[k]); } lo[j] = s0; hi[j] = s1; }
                E.apply(u, (long long)u.pm * 256 + r, c8, lo, hi); } } }
}
#endif

#ifndef CPU_EMU
DEVI float wave_sum(float v) {
#pragma unroll
    for (int o = 32; o > 0; o >>= 1) v += __shfl_xor(v, o);
    return v; }
DEVI void row_load(const float* src, float (&v)[16], int lane) {
#pragma unroll
    for (int j = 0; j < 4; ++j) { const float4 f = *(const float4*)(src + j * 256 + lane * 4); v[4 * j] = f.x; v[4 * j + 1] = f.y; v[4 * j + 2] = f.z; v[4 * j + 3] = f.w; } }
DEVI void row_store_bf16(bf16_t* dst, const float (&v)[16], int lane) {
#pragma unroll
    for (int j = 0; j < 4; ++j) { uint2 w; w.x = (unsigned)f2bf(v[4 * j]) | ((unsigned)f2bf(v[4 * j + 1]) << 16); w.y = (unsigned)f2bf(v[4 * j + 2]) | ((unsigned)f2bf(v[4 * j + 3]) << 16); *(uint2*)(dst + j * 256 + lane * 4) = w; } }
#endif
DEVI void ph_rmsnorm(const Params& p, const float* src, long long rows, const float* gain, bf16_t* dst, int mode, float* xcopy, long long gw, long long nw, int lane) {
    const float* router = p.in[I_MOE_R]; int* TE = WSP(int, p.oTOKE); float* TW = WSP(float, p.oTOKW);
#ifndef CPU_EMU
    for (long long r = gw; r < rows; r += nw) { float v[16], g[16]; row_load(src + r * 1024, v, lane); row_load(gain, g, lane);
        float ss = 0.f;
#pragma unroll
        for (int j = 0; j < 16; ++j) ss += v[j] * v[j];
        ss = wave_sum(ss); const float rs = rsqrtf(ss * (1.0f / 1024.0f) + 1e-6f);
        if (mode == 1) {
#pragma unroll
            for (int j = 0; j < 4; ++j) *(float4*)(xcopy + r * 1024 + j * 256 + lane * 4) = make_float4(v[4 * j], v[4 * j + 1], v[4 * j + 2], v[4 * j + 3]); }
#pragma unroll
        for (int j = 0; j < 16; ++j) v[j] = v[j] * rs * g[j];
        row_store_bf16(dst + r * 1024, v, lane);
        if (mode == 2) { float lg[8];
#pragma unroll
            for (int e = 0; e < 8; ++e) { float a = 0.f;
#pragma unroll
                for (int j = 0; j < 16; ++j) a += v[j] * router[(long long)((j >> 2) * 256 + lane * 4 + (j & 3)) * 8 + e];
                lg[e] = wave_sum(a); }
            int i0 = 0; float v0 = lg[0];
#pragma unroll
            for (int e = 1; e < 8; ++e) if (lg[e] > v0) { v0 = lg[e]; i0 = e; }
            int i1 = -1; float v1 = -3e38f;
#pragma unroll
            for (int e = 0; e < 8; ++e) if (e != i0 && lg[e] > v1) { v1 = lg[e]; i1 = e; }
            const float w0 = 1.0f / (1.0f + expf(v1 - v0));
            if (lane == 0) { TE[r * 2] = i0; TE[r * 2 + 1] = i1; TW[r * 2] = w0; TW[r * 2 + 1] = 1.0f - w0; } } }
#else
    (void)lane;
    for (long long r = gw; r < rows; r += nw) { const float* x = src + r * 1024; float ss = 0.f; for (int c = 0; c < 1024; ++c) ss += x[c] * x[c];
        const float rs = 1.0f / sqrtf(ss / 1024.0f + 1e-6f); float hv[1024];
        for (int c = 0; c < 1024; ++c) { hv[c] = x[c] * rs * gain[c]; dst[r * 1024 + c] = f2bf(hv[c]); if (mode == 1) xcopy[r * 1024 + c] = x[c]; }
        if (mode == 2) { float lg[8]; for (int e = 0; e < 8; ++e) { float a = 0.f; for (int c = 0; c < 1024; ++c) a += hv[c] * router[c * 8 + e]; lg[e] = a; }
            int i0 = 0; float v0 = lg[0]; for (int e = 1; e < 8; ++e) if (lg[e] > v0) { v0 = lg[e]; i0 = e; }
            int i1 = -1; float v1 = -3e38f; for (int e = 0; e < 8; ++e) if (e != i0 && lg[e] > v1) { v1 = lg[e]; i1 = e; }
            const float w0 = 1.0f / (1.0f + expf(v1 - v0)); TE[r * 2] = i0; TE[r * 2 + 1] = i1; TW[r * 2] = w0; TW[r * 2 + 1] = 1.0f - w0; } }
#endif
}
DEVI void ph_final(const Params& p, long long gw, long long nw, int lane) {
    const int* TS = WSP(int, p.oTOKS); const bf16_t* Y = WSP(bf16_t, p.oY); const float* gain = p.in[I_NORM_FINAL]; float* X = p.out;
#ifndef CPU_EMU
    for (long long r = gw; r < p.T; r += nw) { float v[16], g[16]; row_load(X + r * 1024, v, lane); row_load(gain, g, lane);
        const bf16_t* y0 = Y + (long long)TS[r * 2] * 1024; const bf16_t* y1 = Y + (long long)TS[r * 2 + 1] * 1024;
#pragma unroll
        for (int j = 0; j < 4; ++j) { const uint2 a = *(const uint2*)(y0 + j * 256 + lane * 4), b = *(const uint2*)(y1 + j * 256 + lane * 4);
            v[4 * j] += u2f(a.x << 16) + u2f(b.x << 16); v[4 * j + 1] += u2f(a.x & 0xffff0000u) + u2f(b.x & 0xffff0000u); v[4 * j + 2] += u2f(a.y << 16) + u2f(b.y << 16); v[4 * j + 3] += u2f(a.y & 0xffff0000u) + u2f(b.y & 0xffff0000u); }
        float ss = 0.f;
#pragma unroll
        for (int j = 0; j < 16; ++j) ss += v[j] * v[j];
        ss = wave_sum(ss); const float rs = rsqrtf(ss * (1.0f / 1024.0f) + 1e-6f);
#pragma unroll
        for (int j = 0; j < 4; ++j) *(float4*)(X + r * 1024 + j * 256 + lane * 4) = make_float4(v[4 * j] * rs * g[4 * j], v[4 * j + 1] * rs * g[4 * j + 1], v[4 * j + 2] * rs * g[4 * j + 2], v[4 * j + 3] * rs * g[4 * j + 3]); }
#else
    (void)lane;
    for (long long r = gw; r < p.T; r += nw) { float v[1024]; float ss = 0.f; const bf16_t* y0 = Y + (long long)TS[r * 2] * 1024; const bf16_t* y1 = Y + (long long)TS[r * 2 + 1] * 1024;
        for (int c = 0; c < 1024; ++c) { v[c] = X[r * 1024 + c] + bf2f(y0[c]) + bf2f(y1[c]); ss += v[c] * v[c]; }
        const float rs = 1.0f / sqrtf(ss / 1024.0f + 1e-6f); for (int c = 0; c < 1024; ++c) X[r * 1024 + c] = v[c] * rs * gain[c]; }
#endif
}
DEVI void ph_rwkv_scan(const Params& p, int l, long long gw, long long nw, int lane) {
    const float* RWW = WSP(float, p.oRWW); const bf16_t* RWX = WSP(bf16_t, p.oRWX); bf16_t* O = WSP(bf16_t, p.oO); const float* lng = p.in[I_RW_LN] + l * 256; const float* rkw = p.in[I_RW_RK] + l * 256; (void)rkw;
    for (long long ch = gw; ch < p.B * 4; ch += nw) { const long long b = ch >> 2; const int h = (int)(ch & 3);
#ifndef CPU_EMU
        float st[64];
#pragma unroll
        for (int c = 0; c < 64; ++c) st[c] = 0.f;
        for (long long s = 0; s < p.S; ++s) { const long long t = b * p.S + s; const bf16_t* rx = RWX + t * 1280 + h * 64; const float v = bf2f(rx[512 + lane]);
            const float y = rwkv_row_step(st, RWW + t * 256 + h * 64, rx, rx + 256, rx + 768, rx + 1024, v);
            const float mean = wave_sum(y) * (1.0f / 64.0f), dy = y - mean, var = wave_sum(dy * dy) * (1.0f / 64.0f);
            const float yn = dy * rsqrtf(var + 64e-5f) * lng[h * 64 + lane] + 0.f;
            bf16_t* o = O + t * 1024 + 512 + h * 64 + lane; *o = f2bf(yn * bf2f(*o)); }
#else
        (void)lane;
        static float st[64][64]; for (int v = 0; v < 64; ++v) for (int c = 0; c < 64; ++c) st[v][c] = 0.f;
        for (long long s = 0; s < p.S; ++s) { const long long t = b * p.S + s; const bf16_t* rx = RWX + t * 1280 + h * 64; float y[64], mean = 0.f, var = 0.f;
            for (int v = 0; v < 64; ++v) { y[v] = rwkv_row_step(st[v], RWW + t * 256 + h * 64, rx, rx + 256, rx + 768, rx + 1024, bf2f(rx[512 + v])); mean += y[v]; }
            mean /= 64.f; for (int v = 0; v < 64; ++v) var += (y[v] - mean) * (y[v] - mean); var /= 64.f;
            float rkv = 0.f; for (int cq = 0; cq < 64; ++cq) rkv += bf2f(rx[cq]) * bf2f(rx[256 + cq]) * rkw[h * 64 + cq];
            for (int v = 0; v < 64; ++v) { const float yn = (y[v] - mean) / sqrtf(var + 64e-5f) * lng[h * 64 + v] + rkv * bf2f(rx[512 + v]);
                bf16_t* o = O + t * 1024 + 512 + h * 64 + v; *o = f2bf(yn * bf2f(*o)); } }
#endif
    }
}
DEVI void ph_gla_scan(const Params& p, int l, long long gw, long long nw, int lane) {
    const bf16_t* P = WSP(bf16_t, p.oP); const float* GA = WSP(float, p.oGA); bf16_t* O = WSP(bf16_t, p.oO); const float* ng = p.in[I_GLA_NORM] + l * 64;
    for (long long ch = gw; ch < p.B * 4; ch += nw) { const long long b = ch >> 2; const int h = (int)(ch & 3);
#ifndef CPU_EMU
        float st[32];
#pragma unroll
        for (int c = 0; c < 32; ++c) st[c] = 0.f;
        for (long long s = 0; s < p.S; ++s) { const long long t = b * p.S + s; const bf16_t* x = P + t * PW + C_GLA;
            const float o = gla_col_step(st, GA + t * 128 + h * 32, x + h * 32, x + 128 + h * 32, bf2f(x[256 + h * 64 + lane]));
            const float ms = wave_sum(o * o) * (1.0f / 64.0f), on = o * rsqrtf(ms + 1e-6f) * ng[lane];
            bf16_t* d = O + t * 1024 + 768 + h * 64 + lane; *d = f2bf(on * bf2f(*d)); }
#else
        (void)lane;
        static float st[64][32]; for (int v = 0; v < 64; ++v) for (int c = 0; c < 32; ++c) st[v][c] = 0.f;
        for (long long s = 0; s < p.S; ++s) { const long long t = b * p.S + s; const bf16_t* x = P + t * PW + C_GLA; float o[64], ms = 0.f;
            for (int v = 0; v < 64; ++v) { o[v] = gla_col_step(st[v], GA + t * 128 + h * 32, x + h * 32, x + 128 + h * 32, bf2f(x[256 + h * 64 + v])); ms += o[v] * o[v]; }
            ms /= 64.f;
            for (int v = 0; v < 64; ++v) { bf16_t* d = O + t * 1024 + 768 + h * 64 + v; *d = f2bf(o[v] / sqrtf(ms + 1e-6f) * ng[v] * bf2f(*d)); } }
#endif
    }
}
#ifndef CPU_EMU
#define LAS __attribute__((address_space(3)))
typedef short bf16x8 __attribute__((ext_vector_type(8)));
typedef float f32x4 __attribute__((ext_vector_type(4)));
constexpr int HALF = 128, BK = 64, HTB = HALF * BK * 2, STAGE_BYTES = 8 * HTB;
__device__ __forceinline__ int lds_byte(int r, int c) { const int st = (r >> 4) * 2 + (c >> 5), rr = r & 15, cc = c & 31, ob = rr * 64 + cc * 2; return st * 1024 + (ob ^ (((ob >> 9) & 1) << 5)); }
__device__ __forceinline__ void stage_rc(int b, int& R, int& C) { const int st = b / 1024, sb = b % 1024, swz = sb ^ (((sb >> 9) & 1) << 5); R = (st >> 1) * 16 + swz / 64; C = (st & 1) * 32 + (swz % 64) / 2; }
__device__ __forceinline__ int perm32(int rho) { const int n = rho >> 4, i = rho & 15; return 8 * (i >> 2) + 4 * n + (i & 3); }

template <class Epi, class Sched>
__device__ __forceinline__ void gemm_phase(LAS unsigned char* lds, const bf16_t* A, long long lda, const bf16_t* Bt, long long ldb, long long K, const Sched& S, const Epi& E, long long kstepA_elems = 64) {
    int tid = threadIdx.x; asm volatile("" : "+v"(tid));
    const int wid = __builtin_amdgcn_readfirstlane(tid >> 6), lane = tid & 63, wr = wid >> 2, wc = wid & 3, fr = lane & 15, fq = lane >> 4;
    { unsigned long long a_ = (unsigned long long)A, b_ = (unsigned long long)Bt; unsigned alo = __builtin_amdgcn_readfirstlane((unsigned)a_), ahi = __builtin_amdgcn_readfirstlane((unsigned)(a_ >> 32)),
        blo = __builtin_amdgcn_readfirstlane((unsigned)b_), bhi = __builtin_amdgcn_readfirstlane((unsigned)(b_ >> 32));
      int lda_ = __builtin_amdgcn_readfirstlane((int)lda), ldb_ = __builtin_amdgcn_readfirstlane((int)ldb), k_ = __builtin_amdgcn_readfirstlane((int)K), ks_ = __builtin_amdgcn_readfirstlane((int)kstepA_elems);
      asm volatile("" : "+s"(alo), "+s"(ahi), "+s"(blo), "+s"(bhi), "+s"(lda_), "+s"(ldb_), "+s"(k_), "+s"(ks_)); kstepA_elems = ks_;
      A = (const bf16_t*)(((unsigned long long)ahi << 32) | alo); Bt = (const bf16_t*)(((unsigned long long)bhi << 32) | blo); lda = lda_; ldb = ldb_; K = k_; }
    const int nt = (int)(K / BK);
    unsigned voffA[2], voffB[2];
#pragma unroll
    for (int i = 0; i < 2; ++i) { int R, C; stage_rc(tid * 16 + i * 8192, R, C); const int Rb = (R & ~31) + perm32(R & 31);
        voffA[i] = (unsigned)(R * (int)lda + C) * 2u; voffB[i] = (unsigned)(Rb * (int)ldb + C) * 2u; }
    const size_t kstep = (size_t)(BK * 2), kstepA = (size_t)kstepA_elems * 2;
    const size_t hstepA = (size_t)HALF * lda * 2, hstepB = (size_t)HALF * ldb * 2;
    const unsigned ldsw = (unsigned)wid * 1024u;
    const int aoff = lds_byte(wr * 64 + fr, fq * 8), boff = lds_byte(wc * 32 + fr, fq * 8);
#define PG8_SA(b, h) (((b) * 2 + (h)) * HTB)
#define PG8_SB(b, h) ((4 + (b) * 2 + (h)) * HTB)
#define PG8_STAGE(bufoff, gbase, voff) do { _Pragma("unroll") for (int _i = 0; _i < 2; ++_i) \
        __builtin_amdgcn_global_load_lds((const unsigned*)((const char*)(gbase) + (voff)[_i]), (LAS unsigned*)(lds + (bufoff) + ldsw + _i * 8192), 16, 0, 0); } while (0)
#define PG8_LDA(dst, b, h) do { _Pragma("unroll") for (int m = 0; m < 4; ++m) _Pragma("unroll") for (int k = 0; k < 2; ++k) dst[m][k] = *(const LAS bf16x8*)(lds + PG8_SA(b, h) + aoff + m * 2048 + k * 1024); } while (0)
#define PG8_LDB(dst, b, h) do { _Pragma("unroll") for (int n = 0; n < 2; ++n) _Pragma("unroll") for (int k = 0; k < 2; ++k) dst[n][k] = *(const LAS bf16x8*)(lds + PG8_SB(b, h) + boff + n * 2048 + k * 1024); } while (0)
#define PG8_MMA(ai, bj, At, Bt_) do { __builtin_amdgcn_s_setprio(1); _Pragma("unroll") for (int m = 0; m < 4; ++m) _Pragma("unroll") for (int n = 0; n < 2; ++n) _Pragma("unroll") for (int k = 0; k < 2; ++k) \
        acc[ai][bj][m][n] = __builtin_amdgcn_mfma_f32_16x16x32_bf16(Bt_[n][k], At[m][k], acc[ai][bj][m][n], 0, 0, 0); __builtin_amdgcn_s_setprio(0); } while (0)
#define PG8_WAIT_V(n) asm volatile("s_waitcnt vmcnt(" #n ")" ::: "memory")
#define PG8_WAIT_L(n) asm volatile("s_waitcnt lgkmcnt(" #n ")" ::: "memory")
#define PG8_BAR __builtin_amdgcn_s_barrier()
#define PG8_SCHED __builtin_amdgcn_sched_barrier(0)
    Unit cur, nxt; int ui = 0;
    if (!S.next(0, cur)) return;
    f32x4 acc[2][2][4][2];
#pragma unroll
    for (int a = 0; a < 2; ++a)
#pragma unroll
        for (int b = 0; b < 2; ++b)
#pragma unroll
            for (int m = 0; m < 4; ++m)
#pragma unroll
                for (int n = 0; n < 2; ++n) acc[a][b][m][n] = (f32x4){0.f, 0.f, 0.f, 0.f};
    bf16x8 At[4][2], B0[2][2], B1[2][2];
    const char* cA = (const char*)A + cur.aoff; const char* cB = (const char*)Bt + cur.boff;
    S.a_ready(cur);
    PG8_STAGE(PG8_SB(0, 0), cB, voffB); PG8_STAGE(PG8_SA(0, 0), cA, voffA); PG8_STAGE(PG8_SB(0, 1), cB + hstepB, voffB); PG8_STAGE(PG8_SA(0, 1), cA + hstepA, voffA);
    if (wr == 1) PG8_BAR;
    PG8_WAIT_V(4); PG8_BAR;
    PG8_STAGE(PG8_SB(1, 0), cB + kstep, voffB); PG8_STAGE(PG8_SA(1, 0), cA + kstepA, voffA); PG8_STAGE(PG8_SB(1, 1), cB + hstepB + kstep, voffB);
    PG8_WAIT_V(6); PG8_BAR;
    for (;;) {
        const bool has_next = S.next(ui + 1, nxt);
        const char* nA = has_next ? (const char*)A + nxt.aoff : cA; const char* nB = has_next ? (const char*)Bt + nxt.boff : cB;
#pragma nounroll
        for (int t = 0; t < nt; t += 2) {
            const bool last = (t == nt - 2);
            const char* a1 = cA + (size_t)(t + 1) * kstepA;
            const char* a2 = last ? nA : cA + (size_t)(t + 2) * kstepA; const char* b2 = last ? nB : cB + (size_t)(t + 2) * kstep;
            const char* a3 = a2 + kstepA; const char* b3 = b2 + kstep;
            if (last && has_next) S.a_ready(nxt);
            PG8_LDB(B0, 0, 0); PG8_SCHED; PG8_LDA(At, 0, 0); PG8_STAGE(PG8_SA(1, 1), a1 + hstepA, voffA);
            PG8_WAIT_L(8); PG8_BAR; PG8_WAIT_L(0); PG8_MMA(0, 0, At, B0); PG8_BAR; PG8_SCHED;
            PG8_LDB(B1, 0, 1); PG8_STAGE(PG8_SB(0, 0), b2, voffB);
            PG8_BAR; PG8_WAIT_L(0); PG8_MMA(0, 1, At, B1); PG8_BAR;
            PG8_LDA(At, 0, 1); PG8_STAGE(PG8_SA(0, 0), a2, voffA);
            PG8_BAR; PG8_WAIT_L(0); PG8_MMA(1, 0, At, B0); PG8_BAR; PG8_SCHED;
            PG8_STAGE(PG8_SB(0, 1), b2 + hstepB, voffB);
            PG8_WAIT_V(6); PG8_BAR; PG8_MMA(1, 1, At, B1); PG8_BAR;
            PG8_LDB(B0, 1, 0); PG8_SCHED; PG8_LDA(At, 1, 0); PG8_STAGE(PG8_SA(0, 1), a2 + hstepA, voffA);
            PG8_WAIT_L(8); PG8_BAR; PG8_WAIT_L(0); PG8_MMA(0, 0, At, B0); PG8_BAR; PG8_SCHED;
            PG8_LDB(B1, 1, 1); PG8_STAGE(PG8_SB(1, 0), b3, voffB);
            PG8_BAR; PG8_WAIT_L(0); PG8_MMA(0, 1, At, B1); PG8_BAR;
            PG8_LDA(At, 1, 1); PG8_STAGE(PG8_SA(1, 0), a3, voffA);
            PG8_BAR; PG8_WAIT_L(0); PG8_MMA(1, 0, At, B0); PG8_BAR; PG8_SCHED;
            PG8_STAGE(PG8_SB(1, 1), b3 + hstepB, voffB);
            PG8_WAIT_V(6); PG8_BAR; PG8_MMA(1, 1, At, B1); PG8_BAR;
        }
#pragma unroll
        for (int ai = 0; ai < 2; ++ai)
#pragma unroll
            for (int m = 0; m < 4; ++m) { float lo[8], hi[8];
#pragma unroll
                for (int j = 0; j < 8; ++j) { lo[j] = acc[ai][0][m][j >> 2][j & 3]; hi[j] = acc[ai][1][m][j >> 2][j & 3]; }
                E.apply(cur, (long long)cur.pm * 256 + ai * HALF + wr * 64 + m * 16 + fr, wc * 32 + 8 * fq, lo, hi); PG8_SCHED; }
        S.done(cur);
        if (!has_next) break;
#pragma unroll
        for (int a = 0; a < 2; ++a)
#pragma unroll
            for (int b = 0; b < 2; ++b)
#pragma unroll
                for (int m = 0; m < 4; ++m)
#pragma unroll
                    for (int n = 0; n < 2; ++n) acc[a][b][m][n] = (f32x4){0.f, 0.f, 0.f, 0.f};
        cur = nxt; cA = nA; cB = nB; ++ui;
    }
    PG8_WAIT_V(0);
    if (wr == 0) PG8_BAR;
    PG8_BAR;
#undef PG8_SA
#undef PG8_SB
#undef PG8_STAGE
#undef PG8_LDA
#undef PG8_LDB
#undef PG8_MMA
#undef PG8_WAIT_V
#undef PG8_WAIT_L
#undef PG8_BAR
#undef PG8_SCHED
}

#define XB_TMO      128
#define XB_XCNT(j)  (256  + 64 * (j))
#define XB_XSUB(j)  (1280 + 64 * (j))
#define XB_XGEN(j)  (2304 + 64 * (j))
#define XB_TOP      3328
#define XB_TOPGEN   3392
#define XCD_BAR_WORDS 3456
#define XB_SPIN_CAP (1u << 18)
__device__ __forceinline__ unsigned xb_ld(unsigned* p)              { return __hip_atomic_load(p, __ATOMIC_RELAXED, __HIP_MEMORY_SCOPE_AGENT); }
__device__ __forceinline__ unsigned xb_add(unsigned* p, unsigned v) { return __hip_atomic_fetch_add(p, v, __ATOMIC_RELAXED, __HIP_MEMORY_SCOPE_AGENT); }
__device__ __forceinline__ unsigned xb_xcc_id() { return (unsigned)__builtin_amdgcn_s_getreg((3 << 11) | 20) & 0xFu; }
#define XB_SPIN(cond, bar) do { unsigned _sp = 0; while (cond) { __builtin_amdgcn_s_sleep(1); \
    if ((++_sp & 255u) == 0u) { if (xb_ld(&(bar)[XB_TMO])) break; if (_sp > XB_SPIN_CAP) { atomicAdd(&(bar)[XB_TMO], 1u); break; } } } } while (0)
struct XcdBarrier { unsigned* bar; unsigned x; volatile LAS unsigned* st; };
__device__ __forceinline__ XcdBarrier xcd_barrier_post(unsigned* bar, volatile LAS unsigned* st) {
    XcdBarrier b; b.bar = bar; b.x = xb_xcc_id(); b.st = st;
    if (threadIdx.x == 0) (void)xb_add(&bar[XB_XCNT(b.x)], 1u);
    return b;
}
__device__ __forceinline__ void xcd_barrier_complete(unsigned* bar, unsigned x, unsigned& nloc, unsigned& nx) {
    const unsigned G = gridDim.x * gridDim.y * gridDim.z;
    unsigned sum, cnt, mine, sp = 0u;
    for (;;) {
        sum = 0u; cnt = 0u; mine = 0u;
#pragma unroll
        for (unsigned j = 0; j < 16; ++j) { const unsigned c = xb_ld(&bar[XB_XCNT(j)]); sum += c; cnt += (c > 0u) ? 1u : 0u; mine = (j == x) ? c : mine; }
        if (sum == G) break;
        __builtin_amdgcn_s_sleep(1);
        if ((++sp & 255u) == 0u) { if (xb_ld(&bar[XB_TMO])) break; if (sp > XB_SPIN_CAP) { atomicAdd(&bar[XB_TMO], 1u); break; } }
    }
    nloc = mine > 0u ? mine : 1u; nx = cnt > 0u ? cnt : 1u;
}
__device__ __forceinline__ void xcd_barrier(const XcdBarrier& b) {
    asm volatile("s_waitcnt vmcnt(0)" ::: "memory");
    __syncthreads();
    if (threadIdx.x == 0) {
        unsigned* bar = b.bar;
        __builtin_amdgcn_s_waitcnt(0);
        unsigned nloc = b.st[0], nx = b.st[1];
        if (nloc == 0u) { xcd_barrier_complete(bar, b.x, nloc, nx); b.st[0] = nloc; b.st[1] = nx; }
        const unsigned old = xb_add(&bar[XB_XSUB(b.x)], 1u);
        const unsigned gen = old / nloc;
        if (old + 1u == (gen + 1u) * nloc) {
            __builtin_amdgcn_fence(__ATOMIC_RELEASE, "agent");
            asm volatile("s_waitcnt vmcnt(0)" ::: "memory");
            const unsigned og = xb_add(&bar[XB_TOP], 1u);
            const unsigned tg = og / nx;
            if (og + 1u == (tg + 1u) * nx) xb_add(&bar[XB_TOPGEN], 1u);
            else XB_SPIN(xb_ld(&bar[XB_TOPGEN]) == tg, bar);
            __builtin_amdgcn_fence(__ATOMIC_ACQUIRE, "agent");
            xb_add(&bar[XB_XGEN(b.x)], 1u);
            asm volatile("s_waitcnt vmcnt(0)" ::: "memory");
        } else {
            XB_SPIN(xb_ld(&bar[XB_XGEN(b.x)]) == gen, bar);
            __builtin_amdgcn_fence(__ATOMIC_ACQUIRE, "agent");
            asm volatile("s_waitcnt vmcnt(0)" ::: "memory");
        }
    }
    __syncthreads();
}
#endif
#ifndef CPU_EMU
typedef short bf16x8_t __attribute__((ext_vector_type(8)));
typedef short bf16x4_t __attribute__((ext_vector_type(4)));
typedef float f32x4_t __attribute__((ext_vector_type(4)));
typedef unsigned u32x4_t __attribute__((ext_vector_type(4)));
constexpr int AT_KS = 144, AT_VS = 136;
constexpr int AT_KBYTES = 64 * AT_KS, AT_VBYTES = 64 * AT_VS, AT_BUF = AT_KBYTES + AT_VBYTES;
struct AttnState { float m, l; f32x4_t o[4]; };
__device__ __forceinline__ void attn_init(AttnState& s) { s.m = -1e30f; s.l = 0.f;
#pragma unroll
    for (int d = 0; d < 4; ++d) s.o[d] = (f32x4_t){0.f, 0.f, 0.f, 0.f}; }
__device__ __forceinline__ unsigned pack2bf(float lo, float hi) { return (unsigned)f2bf(lo) | ((unsigned)f2bf(hi) << 16); }
template <class Valid> __device__ __forceinline__ void attn_tile(const LAS unsigned char* kt, const LAS unsigned char* vt, const bf16x8_t (&bq)[2], AttnState& st, int lane, const Valid& valid) {
    const int r = lane & 15, q = lane >> 4;
    f32x4_t s[4];
#pragma unroll
    for (int kb = 0; kb < 4; ++kb) { s[kb] = (f32x4_t){0.f, 0.f, 0.f, 0.f};
#pragma unroll
        for (int ks = 0; ks < 2; ++ks) { const bf16x8_t a = *(const LAS bf16x8_t*)(kt + (16 * kb + r) * AT_KS + (32 * ks + 8 * q) * 2); s[kb] = __builtin_amdgcn_mfma_f32_16x16x32_bf16(a, bq[ks], s[kb], 0, 0, 0); } }
    float mx = -1e30f;
#pragma unroll
    for (int kb = 0; kb < 4; ++kb)
#pragma unroll
        for (int j = 0; j < 4; ++j) { const float v = valid(kb, j) ? s[kb][j] * 1.44269504f : -1e30f; s[kb][j] = v; mx = fmaxf(mx, v); }
    mx = fmaxf(mx, __shfl_xor(mx, 16)); mx = fmaxf(mx, __shfl_xor(mx, 32));
    const float mn = fmaxf(st.m, mx), alpha = __builtin_amdgcn_exp2f(st.m - mn);
    float rs = 0.f;
#pragma unroll
    for (int kb = 0; kb < 4; ++kb)
#pragma unroll
        for (int j = 0; j < 4; ++j) { const float pv = s[kb][j] > -1e29f ? __builtin_amdgcn_exp2f(s[kb][j] - mn) : 0.f; s[kb][j] = pv; rs += pv; }
    rs += __shfl_xor(rs, 16); rs += __shfl_xor(rs, 32);
    st.l = st.l * alpha + rs; st.m = mn;
    bf16x8_t pb[2];
#pragma unroll
    for (int kk = 0; kk < 2; ++kk) { uint4 w; w.x = pack2bf(s[2 * kk][0], s[2 * kk][1]); w.y = pack2bf(s[2 * kk][2], s[2 * kk][3]); w.z = pack2bf(s[2 * kk + 1][0], s[2 * kk + 1][1]); w.w = pack2bf(s[2 * kk + 1][2], s[2 * kk + 1][3]);
        pb[kk] = __builtin_bit_cast(bf16x8_t, w); }
#pragma unroll
    for (int db = 0; db < 4; ++db) { st.o[db] = st.o[db] * alpha;
#pragma unroll
        for (int kk = 0; kk < 2; ++kk) { const LAS unsigned char* vp = vt + (16 * db + r) * AT_VS + (32 * kk + 4 * q) * 2;
            const bf16x4_t lo = *(const LAS bf16x4_t*)vp, hi = *(const LAS bf16x4_t*)(vp + 32);
            const bf16x8_t a = __builtin_shufflevector(lo, hi, 0, 1, 2, 3, 4, 5, 6, 7);
            st.o[db] = __builtin_amdgcn_mfma_f32_16x16x32_bf16(a, pb[kk], st.o[db], 0, 0, 0); } }
}
__device__ __forceinline__ void attn_stage_store(LAS unsigned char* buf, int tid, const uint4& kc, const uint4& vc) {
    const int key = tid >> 3, c = tid & 7;
    *(LAS u32x4_t*)(buf + key * AT_KS + c * 16) = (u32x4_t){kc.x, kc.y, kc.z, kc.w};
    LAS unsigned short* vt = (LAS unsigned short*)(buf + AT_KBYTES);
    const unsigned w[4] = {vc.x, vc.y, vc.z, vc.w};
#pragma unroll
    for (int i = 0; i < 4; ++i) { vt[((8 * c + 2 * i) * AT_VS) / 2 + key] = (unsigned short)(w[i] & 0xffffu); vt[((8 * c + 2 * i + 1) * AT_VS) / 2 + key] = (unsigned short)(w[i] >> 16); }
}
__device__ __forceinline__ void ph_selwin_mfma(const Params& p, LAS unsigned char* lds, int gC, int gG) {
    int tid = threadIdx.x; asm volatile("" : "+v"(tid));
    const int wid = tid >> 6, lane = tid & 63, r = lane & 15, q = lane >> 4;
    const bf16_t* P = WSP(bf16_t, p.oP); const unsigned* SELM = WSP(unsigned, p.oSELM); bf16_t* O = WSP(bf16_t, p.oO);
    const int nqb = (int)(p.S >> 6), units = (int)(p.B * 2) * nqb;
    for (int u = gC; u < units; u += gG) {
        const int cur = nqb - 1 - (u % nqb), bg = u / nqb, b = bg >> 1, g = bg & 1;
        const long long t0 = (long long)b * p.S + (long long)cur * 64;
        const int hd = 2 * g + (wid >> 2); const int tq = (wid & 3) * 16 + r; const long long tok = t0 + tq; const int sq = cur * 64 + tq;
        bf16x8_t bq[2];
#pragma unroll
        for (int ks = 0; ks < 2; ++ks) bq[ks] = *(const bf16x8_t*)(P + tok * PW + C_Q + hd * 64 + 32 * ks + 8 * q);
        unsigned un = SELM[(t0 + lane) * 2 + g];
#pragma unroll
        for (int o = 32; o > 0; o >>= 1) un |= __shfl_xor(un, o);
        un = __builtin_amdgcn_readfirstlane(un);
        const unsigned mymask = SELM[tok * 2 + g];
        const int wlo = cur - 8 > 0 ? cur - 8 : 0, nwin = cur - wlo + 1, nsel = __builtin_popcount(un), ntile = nwin + nsel;
        AttnState sw, ss; attn_init(sw); attn_init(ss);
        unsigned rem = un; int blk = wlo;
        uint4 kc, vc;
        { const long long kr = ((long long)b * p.S + (long long)blk * 64 + (tid >> 3)) * PW + g * 64 + (tid & 7) * 8; kc = *(const uint4*)(P + kr + C_KW); vc = *(const uint4*)(P + kr + C_VW); }
        attn_stage_store(lds, tid, kc, vc);
        __syncthreads();
        for (int i = 0; i < ntile; ++i) {
            const bool win = i < nwin; const int cb = blk;
            int nb = 0; bool nwinf = false; const bool has = i + 1 < ntile;
            if (has) { if (i + 1 < nwin) { nb = wlo + i + 1; nwinf = true; } else { nb = __builtin_ctz(rem); rem &= rem - 1; }
                const long long kr = ((long long)b * p.S + (long long)nb * 64 + (tid >> 3)) * PW + g * 64 + (tid & 7) * 8;
                kc = *(const uint4*)(P + kr + (nwinf ? C_KW : C_KS)); vc = *(const uint4*)(P + kr + (nwinf ? C_VW : C_VS)); }
            const LAS unsigned char* buf = lds + (i & 1) * AT_BUF;
            const int kbase = cb * 64 + 4 * q;
            if (win) attn_tile(buf, buf + AT_KBYTES, bq, sw, lane, [&](int kb, int j) { const int key = kbase + 16 * kb + j; return key <= sq && key > sq - 512; });
            else { const bool on = (mymask >> cb) & 1u; attn_tile(buf, buf + AT_KBYTES, bq, ss, lane, [&](int kb, int j) { const int key = kbase + 16 * kb + j; return on && key <= sq; }); }
            if (has) attn_stage_store(lds + ((i + 1) & 1) * AT_BUF, tid, kc, vc);
            blk = nb;
            __syncthreads();
        }
        const float g1 = sigmoidf_(bf2f(P[tok * PW + C_NG + hd * 3 + 1])) / ss.l, g2 = sigmoidf_(bf2f(P[tok * PW + C_NG + hd * 3 + 2])) / sw.l;
#pragma unroll
        for (int db = 0; db < 4; ++db) { bf16_t* od = O + tok * 1024 + hd * 64 + 16 * db + 4 * q; const uint2 pv = *(const uint2*)od;
            const float r0 = u2f(pv.x << 16) + g1 * ss.o[db][0] + g2 * sw.o[db][0], r1 = u2f(pv.x & 0xffff0000u) + g1 * ss.o[db][1] + g2 * sw.o[db][1];
            const float r2 = u2f(pv.y << 16) + g1 * ss.o[db][2] + g2 * sw.o[db][2], r3 = u2f(pv.y & 0xffff0000u) + g1 * ss.o[db][3] + g2 * sw.o[db][3];
            uint2 w; w.x = pack2bf(r0, r1); w.y = pack2bf(r2, r3); *(uint2*)od = w; }
    }
}
__device__ __forceinline__ void ph_ca_attn_mfma(const Params& p, int l, LAS unsigned char* lds, int gC, int gG) {
    int tid = threadIdx.x; asm volatile("" : "+v"(tid));
    const int wid = tid >> 6, lane = tid & 63, r = lane & 15, q = lane >> 4;
    const bf16_t* CQ = WSP(bf16_t, p.oCQ); const bf16_t* KV = WSP(bf16_t, p.oKV) + (long long)l * 512; bf16_t* AO = WSP(bf16_t, p.oCAO);
    const int nqb = (int)(p.S >> 7), units = (int)(p.B * 4) * nqb;
    for (int u = gC; u < units; u += gG) {
        const int qb = u % nqb, bh = u / nqb, b = bh >> 2, hd = bh & 3;
        const long long tok = (long long)b * p.S + (long long)qb * 128 + wid * 16 + r;
        bf16x8_t bq[2];
#pragma unroll
        for (int ks = 0; ks < 2; ++ks) bq[ks] = *(const bf16x8_t*)(CQ + tok * 256 + hd * 64 + 32 * ks + 8 * q);
        AttnState st; attn_init(st);
        uint4 kc, vc;
        { const long long kr = ((long long)b * 256 + (tid >> 3)) * 1024 + hd * 64 + (tid & 7) * 8; kc = *(const uint4*)(KV + kr); vc = *(const uint4*)(KV + kr + 256); }
        attn_stage_store(lds, tid, kc, vc);
        __syncthreads();
        for (int i = 0; i < 4; ++i) {
            if (i < 3) { const long long kr = ((long long)b * 256 + (i + 1) * 64 + (tid >> 3)) * 1024 + hd * 64 + (tid & 7) * 8; kc = *(const uint4*)(KV + kr); vc = *(const uint4*)(KV + kr + 256); }
            const LAS unsigned char* buf = lds + (i & 1) * AT_BUF;
            attn_tile(buf, buf + AT_KBYTES, bq, st, lane, [](int, int) { return true; });
            if (i < 3) attn_stage_store(lds + ((i + 1) & 1) * AT_BUF, tid, kc, vc);
            __syncthreads();
        }
        const float il = 1.0f / st.l;
#pragma unroll
        for (int db = 0; db < 4; ++db) { uint2 w; w.x = pack2bf(st.o[db][0] * il, st.o[db][1] * il); w.y = pack2bf(st.o[db][2] * il, st.o[db][3] * il); *(uint2*)(AO + tok * 256 + hd * 64 + 16 * db + 4 * q) = w; }
    }
}
#endif
#ifndef CPU_EMU
typedef float f32x2_t __attribute__((ext_vector_type(2)));
template <int CTRL> __device__ __forceinline__ float dpp_mov(float x) { return __builtin_bit_cast(float, __builtin_amdgcn_update_dpp(0, __builtin_bit_cast(int, x), CTRL, 0xF, 0xF, true)); }
__device__ __forceinline__ float sum8(float x) { x += dpp_mov<0xB1>(x); x += dpp_mov<0x4E>(x); x += dpp_mov<0x141>(x); return x; }
__device__ __forceinline__ float sum16s(float x) { x += __shfl_xor(x, 1); x += __shfl_xor(x, 2); x += __shfl_xor(x, 4); x += __shfl_xor(x, 8); return x; }
constexpr int SC_CH = 32;
constexpr int RW_STEP = 384, RW_BUF = SC_CH * RW_STEP * 4;
constexpr int GL_STEP = 160, GL_BUF = SC_CH * GL_STEP * 4;
__device__ __forceinline__ void cvt8(const uint4& w, float (&f)[8]) { f[0] = u2f(w.x << 16); f[1] = u2f(w.x & 0xffff0000u); f[2] = u2f(w.y << 16); f[3] = u2f(w.y & 0xffff0000u); f[4] = u2f(w.z << 16); f[5] = u2f(w.z & 0xffff0000u); f[6] = u2f(w.w << 16); f[7] = u2f(w.w & 0xffff0000u); }

__device__ __forceinline__ void rwkv_chain(const Params& p, int l, int ch, LAS unsigned char* lds) {
    int tid = threadIdx.x; asm volatile("" : "+v"(tid));
    const int row = tid >> 3, cg = tid & 7; const long long b = ch >> 2; const int h = ch & 3;
    const float* RWW = WSP(float, p.oRWW); const bf16_t* RWX = WSP(bf16_t, p.oRWX); bf16_t* O = WSP(bf16_t, p.oO); const float* lng = p.in[I_RW_LN] + l * 256 + h * 64; const float* rkw = p.in[I_RW_RK] + l * 256 + h * 64;
    LAS float* YB = (LAS float*)(lds + 2 * RW_BUF);
    const long long tb = b * p.S; const int nch = (int)(p.S / SC_CH);
    float4 gw;
    uint4 gx0, gx1, gx2;
#define RW_GLOAD1(idx_, dst_) do { const int idx = (idx_); if (idx < 1280) { const int step = idx / 40, rem = idx % 40, vec = rem >> 3, c8 = rem & 7; dst_ = *(const uint4*)(RWX + (t0_ + step) * 1280 + vec * 256 + h * 64 + 8 * c8); } } while (0)
#define RW_GLOAD(c_) do { const long long t0_ = tb + (long long)(c_) * SC_CH; gw = *(const float4*)(RWW + (t0_ + (tid >> 4)) * 256 + h * 64 + 4 * (tid & 15)); RW_GLOAD1(tid, gx0); RW_GLOAD1(tid + 512, gx1); RW_GLOAD1(tid + 1024, gx2); } while (0)
#define RW_SSTORE1(idx_, src_) do { const int idx = (idx_); if (idx < 1280) { const int step = idx / 40, rem = idx % 40, vec = rem >> 3, c8 = rem & 7; \
        const int slot = vec == 0 ? 4 : (vec == 1 ? 3 : (vec == 2 ? 5 : (vec == 3 ? 1 : 2))); float f[8]; cvt8(src_, f); LAS float* d = B_ + step * RW_STEP + slot * 64 + 8 * c8; \
        *(LAS f32x4_t*)d = (f32x4_t){f[0], f[1], f[2], f[3]}; *(LAS f32x4_t*)(d + 4) = (f32x4_t){f[4], f[5], f[6], f[7]}; } } while (0)
#define RW_SSTORE(buf_) do { LAS float* B_ = (LAS float*)(lds + (buf_) * RW_BUF); *(LAS f32x4_t*)(B_ + (tid >> 4) * RW_STEP + 4 * (tid & 15)) = (f32x4_t){gw.x, gw.y, gw.z, gw.w}; \
        RW_SSTORE1(tid, gx0); RW_SSTORE1(tid + 512, gx1); RW_SSTORE1(tid + 1024, gx2); } while (0)
    f32x2_t st[4];
#pragma unroll
    for (int i = 0; i < 4; ++i) st[i] = (f32x2_t){0.f, 0.f};
    RW_GLOAD(0); RW_SSTORE(0); __syncthreads();
    for (int c = 0; c < nch; ++c) {
        if (c + 1 < nch) RW_GLOAD(c + 1);
        const LAS float* B = (const LAS float*)(lds + (c & 1) * RW_BUF);
        for (int s = 0; s < SC_CH; ++s) { const LAS float* x = B + s * RW_STEP + 8 * cg;
            f32x2_t w[4], kk[4], bb[4], k[4], r[4];
#pragma unroll
            for (int i = 0; i < 2; ++i) { const f32x4_t a0 = *(const LAS f32x4_t*)(x + 4 * i), a1 = *(const LAS f32x4_t*)(x + 64 + 4 * i), a2 = *(const LAS f32x4_t*)(x + 128 + 4 * i), a3 = *(const LAS f32x4_t*)(x + 192 + 4 * i), a4 = *(const LAS f32x4_t*)(x + 256 + 4 * i);
                w[2 * i] = (f32x2_t){a0[0], a0[1]}; w[2 * i + 1] = (f32x2_t){a0[2], a0[3]}; kk[2 * i] = (f32x2_t){a1[0], a1[1]}; kk[2 * i + 1] = (f32x2_t){a1[2], a1[3]};
                bb[2 * i] = (f32x2_t){a2[0], a2[1]}; bb[2 * i + 1] = (f32x2_t){a2[2], a2[3]}; k[2 * i] = (f32x2_t){a3[0], a3[1]}; k[2 * i + 1] = (f32x2_t){a3[2], a3[3]};
                r[2 * i] = (f32x2_t){a4[0], a4[1]}; r[2 * i + 1] = (f32x2_t){a4[2], a4[3]}; }
            const float v = B[s * RW_STEP + 320 + row];
            f32x2_t a = st[0] * kk[0] + st[1] * kk[1]; a += st[2] * kk[2] + st[3] * kk[3];
            const float skk = sum8(a[0] + a[1]);
            f32x2_t y2 = (f32x2_t){0.f, 0.f};
#pragma unroll
            for (int i = 0; i < 4; ++i) { st[i] = st[i] * w[i] - bb[i] * skk + k[i] * v; y2 += st[i] * r[i]; }
            const float y = sum8(y2[0] + y2[1]);
            if (cg == 0) YB[s * 64 + row] = y; }
        __syncthreads();
        {
            const int s = tid >> 4, v0 = 4 * (tid & 15); const long long t = tb + (long long)c * SC_CH + s;
            const f32x4_t y = *(const LAS f32x4_t*)(YB + s * 64 + v0); const f32x4_t vv = *(const LAS f32x4_t*)(B + s * RW_STEP + 320 + v0);
            const float mean = sum16s(y[0] + y[1] + y[2] + y[3]) * (1.0f / 64.0f);
            const float d0 = y[0] - mean, d1 = y[1] - mean, d2 = y[2] - mean, d3 = y[3] - mean;
            const float var = sum16s(d0 * d0 + d1 * d1 + d2 * d2 + d3 * d3) * (1.0f / 64.0f), rstd = rsqrtf(var + 64e-5f);
            const f32x4_t rr = *(const LAS f32x4_t*)(B + s * RW_STEP + 256 + v0), kq = *(const LAS f32x4_t*)(B + s * RW_STEP + 192 + v0); const float4 rw4 = *(const float4*)(rkw + v0);
            const float rk = sum16s(rr[0] * kq[0] * rw4.x + rr[1] * kq[1] * rw4.y + rr[2] * kq[2] * rw4.z + rr[3] * kq[3] * rw4.w);
            bf16_t* o = O + t * 1024 + 512 + h * 64 + v0; const uint2 g = *(const uint2*)o; const float4 ln = *(const float4*)(lng + v0);
            const float r0 = (d0 * rstd * ln.x + rk * vv[0]) * u2f(g.x << 16), r1 = (d1 * rstd * ln.y + rk * vv[1]) * u2f(g.x & 0xffff0000u);
            const float r2 = (d2 * rstd * ln.z + rk * vv[2]) * u2f(g.y << 16), r3 = (d3 * rstd * ln.w + rk * vv[3]) * u2f(g.y & 0xffff0000u);
            uint2 w; w.x = pack2bf(r0, r1); w.y = pack2bf(r2, r3); *(uint2*)o = w; }
        if (c + 1 < nch) RW_SSTORE((c + 1) & 1);
        __syncthreads();
    }
}
__device__ __forceinline__ void gla_chain(const Params& p, int l, int ch, LAS unsigned char* lds) {
    int tid = threadIdx.x; asm volatile("" : "+v"(tid));
    const int vc = tid >> 3, kg = tid & 7; const long long b = ch >> 2; const int h = ch & 3;
    const bf16_t* P = WSP(bf16_t, p.oP); const float* GA = WSP(float, p.oGA); bf16_t* O = WSP(bf16_t, p.oO); const float* ng = p.in[I_GLA_NORM] + l * 64;
    LAS float* OB = (LAS float*)(lds + 2 * GL_BUF);
    const long long tb = b * p.S; const int nch = (int)(p.S / SC_CH);
    float4 ga; uint4 g1, g2;
#define GL_GLOAD(c_) do { const long long t0_ = tb + (long long)(c_) * SC_CH; \
        if (tid < 256) { const int step = tid >> 3, c4 = tid & 7; ga = *(const float4*)(GA + (t0_ + step) * 128 + h * 32 + 4 * c4); g1 = *(const uint4*)(P + (t0_ + step) * PW + C_GLA + 256 + h * 64 + 8 * c4); } \
        else { const int idx = tid - 256, step = idx >> 3, vec = (idx >> 2) & 1, c8 = idx & 3; g2 = *(const uint4*)(P + (t0_ + step) * PW + C_GLA + vec * 128 + h * 32 + 8 * c8); } } while (0)
#define GL_SSTORE(buf_) do { LAS float* B_ = (LAS float*)(lds + (buf_) * GL_BUF); float f[8]; \
        if (tid < 256) { const int step = tid >> 3, c4 = tid & 7; *(LAS f32x4_t*)(B_ + step * GL_STEP + 4 * c4) = (f32x4_t){ga.x, ga.y, ga.z, ga.w}; \
            cvt8(g1, f); LAS float* d = B_ + step * GL_STEP + 96 + 8 * c4; *(LAS f32x4_t*)d = (f32x4_t){f[0], f[1], f[2], f[3]}; *(LAS f32x4_t*)(d + 4) = (f32x4_t){f[4], f[5], f[6], f[7]}; } \
        else { const int idx = tid - 256, step = idx >> 3, vec = (idx >> 2) & 1, c8 = idx & 3; \
            cvt8(g2, f); LAS float* d = B_ + step * GL_STEP + (vec == 0 ? 64 : 32) + 8 * c8; *(LAS f32x4_t*)d = (f32x4_t){f[0], f[1], f[2], f[3]}; *(LAS f32x4_t*)(d + 4) = (f32x4_t){f[4], f[5], f[6], f[7]}; } } while (0)
    f32x4_t st = (f32x4_t){0.f, 0.f, 0.f, 0.f};
    GL_GLOAD(0); GL_SSTORE(0); __syncthreads();
    for (int c = 0; c < nch; ++c) {
        if (c + 1 < nch) GL_GLOAD(c + 1);
        const LAS float* B = (const LAS float*)(lds + (c & 1) * GL_BUF);
        for (int s = 0; s < SC_CH; ++s) { const LAS float* x = B + s * GL_STEP + 4 * kg;
            const f32x4_t a = *(const LAS f32x4_t*)x, k = *(const LAS f32x4_t*)(x + 32), qv = *(const LAS f32x4_t*)(x + 64); const float v = B[s * GL_STEP + 96 + vc];
            st = st * a + k * v; const f32x4_t pq = st * qv;
            const float o = sum8((pq[0] + pq[1]) + (pq[2] + pq[3]));
            if (kg == 0) OB[s * 64 + vc] = o * 0.17677669529663687f; }
        __syncthreads();
        {   const int s = tid >> 4, v0 = 4 * (tid & 15); const long long t = tb + (long long)c * SC_CH + s;
            const f32x4_t o = *(const LAS f32x4_t*)(OB + s * 64 + v0);
            const float ms = sum16s(o[0] * o[0] + o[1] * o[1] + o[2] * o[2] + o[3] * o[3]) * (1.0f / 64.0f), rs = rsqrtf(ms + 1e-6f);
            bf16_t* d = O + t * 1024 + 768 + h * 64 + v0; const uint2 g = *(const uint2*)d; const float4 n4 = *(const float4*)(ng + v0);
            uint2 w; w.x = pack2bf(o[0] * rs * n4.x * u2f(g.x << 16), o[1] * rs * n4.y * u2f(g.x & 0xffff0000u)); w.y = pack2bf(o[2] * rs * n4.z * u2f(g.y << 16), o[3] * rs * n4.w * u2f(g.y & 0xffff0000u)); *(uint2*)d = w; }
        if (c + 1 < nch) GL_SSTORE((c + 1) & 1);
        __syncthreads();
    }
}
__device__ __forceinline__ void ph_scans(const Params& p, int l, LAS unsigned char* lds, int gC, int gG) {
    const int nchain = (int)(p.B * 4);
    for (int it = gC; it < 2 * nchain; it += gG) { if (it < nchain) rwkv_chain(p, l, it, lds); else gla_chain(p, l, it - nchain, lds); }
}
#endif
#ifdef CPU_EMU
struct Ctx { long long gtid, gsz, gw, nw; int lane, G, c; };
#define GEMM(A, lda, Bt, ldb, K, S, E) gemm_cpu(A, lda, Bt, ldb, K, S, E)
#define GEMMK(A, lda, Bt, ldb, K, S, E, ks) gemm_cpu(A, lda, Bt, ldb, K, S, E, ks)
#define GRID_BARRIER() do { } while (0)
#else
struct Ctx { LAS unsigned char* lds; XcdBarrier bar; };
#define GEMM(A, lda, Bt, ldb, K, S, E) gemm_phase(cx.lds, A, lda, Bt, ldb, K, S, E)
#define GEMMK(A, lda, Bt, ldb, K, S, E, ks) gemm_phase(cx.lds, A, lda, Bt, ldb, K, S, E, ks)
#define GRID_BARRIER() xcd_barrier(cx.bar)
#endif
constexpr int N_PHASES = 56;
#ifndef PROBE_CONV
#define PROBE_CONV 1
#endif
#ifndef PROBE_PREP
#define PROBE_PREP 1
#endif
#ifndef PROBE_GEMM
#define PROBE_GEMM 1
#endif
#ifndef PROBE_CMP
#define PROBE_CMP 1
#endif

template <int KIND> DEVI void run_program(const Params& p, const Ctx& cx, int pb, int pe) {
    int ph = 0;
#define T p.T
#define DFF p.DFF
#ifdef CPU_EMU
    const long long gsz = cx.gsz, nw = cx.nw; const int gG = cx.G, gC = cx.c;
#else
#define gsz ((long long)gridDim.x * 512)
#define nw ((long long)gridDim.x * 8)
#define gG ((int)gridDim.x)
#define gC ((int)blockIdx.x)
#endif
#define H WSP(bf16_t, p.oH)
#define P WSP(bf16_t, p.oP)
#define O WSP(bf16_t, p.oO)
#define BO WSP(bf16_t, p.oBO)
#define MG WSP(bf16_t, p.oMG)
#define CQ WSP(bf16_t, p.oCQ)
#define CAO WSP(bf16_t, p.oCAO)
#define MEMN WSP(bf16_t, p.oMEMN)
#define ACT WSP(bf16_t, p.oACT)
#define WFFN WSP(bf16_t, p.oWFFN)
#ifdef CPU_EMU
#define OPAQUE_V(x) do { } while (0)
#define PH_IDX long long gtid = cx.gtid, gw = cx.gw; int lane = cx.lane
#else
#define OPAQUE_V(x) asm volatile("" : "+v"(x))
#define PH_IDX unsigned tx_ = threadIdx.x; OPAQUE_V(tx_); long long gtid = (long long)blockIdx.x * 512 + tx_, gw = (long long)(tx_ >> 6) * gridDim.x + blockIdx.x; int lane = tx_ & 63
#endif
#define PH_BEGIN(k) if (ph >= pb && ph < pe) { if constexpr (KIND < 0 || KIND == (k)) { PH_IDX; OPAQUE_V(gtid); OPAQUE_V(gw); OPAQUE_V(lane); (void)gtid; (void)gw; (void)lane;
#define PH_END   } if (ph + 1 < pe) GRID_BARRIER(); } ++ph;
    PH_BEGIN(0)
        for (int rep_ = 0; rep_ < PROBE_CONV; ++rep_) { ph_convert_layer(p, 0, gtid, gsz); ph_convert_layer(p, 1, gtid, gsz); ph_convert_ffn(p, gtid, gsz); ph_convert_cmp(p, gtid, gsz); } ph_rope(p, gtid, gsz);
        ph_rmsnorm(p, p.in[I_MEM], p.B * 256, p.in[I_MEM_NORM], MEMN, 0, nullptr, gw, nw, lane);
        ph_rmsnorm(p, p.in[I_X], T, p.in[I_NORM_MIX], H, 1, p.out, gw, nw, lane);
    PH_END
    PH_BEGIN(1)
        { SchedPlain S; S.init(p.B * 256, 1024, 1024, 1024, gG, gC); EpStore E{WSP(bf16_t, p.oKV), 1024, 1.0f}; GEMM(MEMN, 1024, WSP(bf16_t, p.oWKV), 1024, 1024, S, E); }
    PH_END
    for (int l = 0; l < 2; ++l) {
#define W WSP(bf16_t, p.oWL[l])
        PH_BEGIN(1) for (int rep_ = 0; rep_ < PROBE_GEMM; ++rep_) { SchedPlain S; S.init(T, 3072, 1024, 1024, gG, gC); EpStore E{P, 3072, 1.0f}; GEMM(H, 1024, W + W_IN, 1024, 1024, S, E); } PH_END
        PH_BEGIN(2) ph_rope_apply(p, gtid, gsz); { SchedCmp S; S.init(T / 16, gG, gC); EpUV E{WSP(bf16_t, p.oUV)}; GEMMK(P, 16LL * PW, WSP(bf16_t, p.oW1T) + (long long)l * 2 * 256 * 1024, 1024, 1024, S, E, (long long)PW); }
            ph_pool(p, l, gtid, gsz); ph_rwkv_prep(p, l, gtid, gsz); ph_gla_prep(p, l, gtid, gsz);
#if PROBE_PREP == 2
            ph_pool(p, l, gtid, gsz);
#elif PROBE_PREP == 3
            ph_pool(p, l, gtid, gsz); ph_gla_prep(p, l, gtid, gsz);
#elif PROBE_PREP == 4
            ph_rwkv_prep(p, l, gtid, gsz);
#endif
 PH_END
        PH_BEGIN(3) ph_compress2(p, l, gtid, gsz); PH_END
#ifdef CPU_EMU
        PH_BEGIN(4) ph_rwkv_scan(p, l, gw, nw, lane); ph_gla_scan(p, l, (gw + nw - (p.B * 4) % nw) % nw, nw, lane); ph_cmp_attn(p, gtid, gsz); PH_END
#else
        PH_BEGIN(4) ph_scans(p, l, cx.lds, gC, gG); for (int rep_ = 0; rep_ < PROBE_CMP; ++rep_) ph_cmp_attn(p, gtid, gsz); PH_END
#endif
#ifdef CPU_EMU
        PH_BEGIN(5) ph_selwin(p, gtid, gsz); PH_END
#else
        PH_BEGIN(5) ph_selwin_mfma(p, cx.lds, gC, gG); PH_END
#endif
        for (int q = 0; q < 4; ++q) { const long long r0 = q * (T / 4);
            PH_BEGIN(6) { SchedBranch S; S.init(T / 4, gG, gC); EpStore E{BO, 4096, 1.0f}; GEMM(O + r0 * 1024, 1024, W + W_B, 256, 256, S, E); } PH_END
            PH_BEGIN(7) { SchedGate S; S.init(T / 4, gG, gC); EpGate E{BO, p.in[I_B_GATE] + l * 4096, MG, r0}; GEMM(H + r0 * 1024, 1024, W + W_G, 1024, 1024, S, E); } PH_END }
        PH_BEGIN(8) { SchedPlain S; S.init(T, 1024, 1024, 1024, gG, gC); EpResid E{p.out}; GEMM(MG, 1024, W + W_O, 1024, 1024, S, E); } PH_END
        PH_BEGIN(9) ph_rmsnorm(p, p.out, T, p.in[I_NORM_CA] + l * 1024, H, 0, nullptr, gw, nw, lane); PH_END
        PH_BEGIN(1) { SchedPlain S; S.init(T, 256, 1024, 1024, gG, gC); EpStore E{CQ, 256, 0.125f}; GEMM(H, 1024, W + W_CQ, 1024, 1024, S, E); } PH_END
#ifdef CPU_EMU
        PH_BEGIN(10) ph_ca_attn(p, l, gtid, gsz); PH_END
#else
        PH_BEGIN(10) ph_ca_attn_mfma(p, l, cx.lds, gC, gG); PH_END
#endif
        PH_BEGIN(8) { SchedPlain S; S.init(T, 1024, 256, 256, gG, gC); EpResid E{p.out}; GEMM(CAO, 256, W + W_CO, 256, 256, S, E); } PH_END
        PH_BEGIN(9) ph_rmsnorm(p, p.out, T, p.in[I_NORM_FFN] + l * 1024, H, l == 1 ? 2 : 0, nullptr, gw, nw, lane); if (l == 1) for (int rep_ = 0; rep_ < PROBE_CONV; ++rep_) ph_convert_moe(p, gtid, gsz); PH_END
        if (l == 0) {
            PH_BEGIN(11) { SchedPlain S; S.init(T, 2 * DFF, 1024, 1024, gG, gC); EpSwiglu E{ACT, DFF, 0}; GEMM(H, 1024, WFFN, 1024, 1024, S, E); } PH_END
            PH_BEGIN(8) { SchedPlain S; S.init(T, 1024, DFF, DFF, gG, gC); EpResid E{p.out}; GEMM(ACT, DFF, WFFN + 2 * DFF * 1024, DFF, DFF, S, E); } PH_END
            PH_BEGIN(9) ph_rmsnorm(p, p.out, T, p.in[I_NORM_MIX] + 1024, H, 0, nullptr, gw, nw, lane); PH_END
        } else {
            PH_BEGIN(12) ph_moe_count(p, gtid, gsz); PH_END
            PH_BEGIN(12) ph_moe_offsets(p, gtid, gsz); PH_END
            PH_BEGIN(12) ph_moe_assign(p, gtid, gsz); PH_END
            PH_BEGIN(12) ph_moe_gather(p, gtid, gsz); PH_END
#define HS WSP(bf16_t, p.oHS)
#define ACTC WSP(bf16_t, p.oACTC)
#define MW WSP(bf16_t, p.oMOEW)
#define MC WSP(int, p.oMOEC)
            const int ct = (int)((p.NR / 256 + 3) / 4);
            for (int q = 0; q < 4; ++q) {
                PH_BEGIN(13) { SchedMoe S; const int nt_ = MC[16 + 8] / 256; S.t0 = q * ct; S.t1 = (q + 1) * ct < nt_ ? (q + 1) * ct : nt_; if (S.t1 < S.t0) S.t1 = S.t0; S.nN = (int)(2 * DFF / 256); S.G = gG; S.c = gC; S.lda = 1024; S.ldb = 1024; S.per_e = 3 * 1024 * DFF * 2;
#pragma unroll
                    for (int e = 0; e < 9; ++e) S.base[e] = MC[16 + e];
                    EpSwiglu E{ACTC, DFF, (long long)S.t0 * 256}; GEMM(HS, 1024, MW, 1024, 1024, S, E); } PH_END
                PH_BEGIN(14) { SchedMoe S; const int nt_ = MC[16 + 8] / 256; S.t0 = q * ct; S.t1 = (q + 1) * ct < nt_ ? (q + 1) * ct : nt_; if (S.t1 < S.t0) S.t1 = S.t0; S.nN = 4; S.G = gG; S.c = gC; S.lda = DFF; S.ldb = DFF; S.per_e = 3 * 1024 * DFF * 2;
#pragma unroll
                    for (int e = 0; e < 9; ++e) S.base[e] = MC[16 + e];
                    EpMoeDown E{WSP(bf16_t, p.oY), WSP(float, p.oROWW)}; GEMM(ACTC - (long long)S.t0 * 256 * DFF, DFF, MW + 2 * DFF * 1024, DFF, DFF, S, E); } PH_END }
            PH_BEGIN(15) ph_final(p, gw, nw, lane); PH_END
        }
    }
#undef PH_BEGIN
#undef PH_END
#undef H
#undef P
#undef O
#undef BO
#undef MG
#undef CQ
#undef CAO
#undef MEMN
#undef ACT
#undef WFFN
#undef T
#undef DFF
#undef W
#undef HS
#undef ACTC
#undef MW
#undef MC
#ifndef CPU_EMU
#undef gsz
#undef nw
#undef gG
#undef gC
#endif
}

#ifndef CPU_EMU
template <int KIND> __global__ __launch_bounds__(512, 2) void mk_fwd(Params p, int pb, int pe) {
    extern __shared__ __attribute__((aligned(16))) unsigned char shm[];
    Ctx cx; cx.lds = (LAS unsigned char*)shm;
    volatile LAS unsigned* xbw = (volatile LAS unsigned*)(cx.lds + STAGE_BYTES);
    if (threadIdx.x == 0) { xbw[0] = 0u; xbw[1] = 0u; xbw[2] = 0u; xbw[3] = 0u; }
    __syncthreads();
    cx.bar = xcd_barrier_post((unsigned*)(p.ws + p.oBAR), xbw);
    run_program<KIND>(p, cx, pb, pe);
}
#ifndef MK_ONE
#define MK_ONE 1
#endif
#if !MK_ONE
static const int kPhaseKind[N_PHASES] = { 0, 1,
    1, 2, 3, 4, 5, 6, 7, 6, 7, 6, 7, 6, 7, 8, 9, 1, 10, 8, 9, 11, 8, 9,
    1, 2, 3, 4, 5, 6, 7, 6, 7, 6, 7, 6, 7, 8, 9, 1, 10, 8, 9, 12, 12, 12, 12, 13, 14, 13, 14, 13, 14, 13, 14, 15 };
#endif
typedef void (*mk_fn)(Params, int, int);
extern "C" void kernel_launch(void* const* d_in, const int* in_sizes, int n_in, void* d_out, int out_size, void* d_ws, size_t ws_size, hipStream_t stream) {
    (void)in_sizes; (void)n_in; (void)out_size;
    Params p; memset(&p, 0, sizeof(p));
    for (int i = 0; i < N_INPUTS; ++i) p.in[i] = (const float*)d_in[i];
    p.out = (float*)d_out; p.ws = (unsigned char*)d_ws;
    make_layout(p, 32, 2048, 2816);
    for (int j = 0; j < 8; ++j) p.inv_freq[j] = (float)pow(500000.0, -(double)(2 * j) / 16.0);
    if ((size_t)p.wsNeed > ws_size) { fprintf(stderr, "workspace too small: need %lld have %zu\n", p.wsNeed, ws_size); return; }
    const size_t lds_bytes = STAGE_BYTES + 16;
#if MK_ONE
    static const mk_fn fns[1] = { mk_fwd<-1> }; const int nf = 1;
#else
    static const mk_fn fns[16] = { mk_fwd<0>, mk_fwd<1>, mk_fwd<2>, mk_fwd<3>, mk_fwd<4>, mk_fwd<5>, mk_fwd<6>, mk_fwd<7>, mk_fwd<8>, mk_fwd<9>, mk_fwd<10>, mk_fwd<11>, mk_fwd<12>, mk_fwd<13>, mk_fwd<14>, mk_fwd<15> }; const int nf = 16;
#endif
    static int grid = 0;
    if (!grid) { int dev = 0, cus = 0; (void)hipGetDevice(&dev); (void)hipDeviceGetAttribute(&cus, hipDeviceAttributeMultiprocessorCount, dev);
        for (int k = 0; k < nf; ++k) (void)hipFuncSetAttribute((const void*)fns[k], hipFuncAttributeMaxDynamicSharedMemorySize, (int)lds_bytes);
        int per_cu = 0; (void)hipOccupancyMaxActiveBlocksPerMultiprocessor(&per_cu, (const void*)fns[0], 512, lds_bytes); (void)hipGetLastError();
        grid = cus > 0 ? cus : 256; }
    (void)hipMemsetAsync(p.ws + p.oBAR, 0, 16384 + 4096, stream);
#if MK_ONE
    hipLaunchKernelGGL(fns[0], dim3(grid), dim3(512), lds_bytes, stream, p, 0, N_PHASES);
#else
    for (int ph = 0; ph < N_PHASES; ++ph) hipLaunchKernelGGL(fns[kPhaseKind[ph]], dim3(grid), dim3(512), lds_bytes, stream, p, ph, ph + 1);
#endif
}
#endif
```

```cpp
#ifndef CPU_EMU
#include <hip/hip_runtime.h>
#include <cstdio>
#include <cstdint>
#include <cstring>
#define DEVI __device__ __forceinline__
#define DEVM __device__ __forceinline__
#else
#include <cmath>
#include <cstdio>
#include <cstdint>
#include <cstring>
#include <cstdlib>
#define DEVI static inline
#define DEVM inline
struct uint4 { unsigned x, y, z, w; };
#endif

typedef unsigned short bf16_t;
#ifdef CPU_EMU
static inline float u2f(unsigned u) { float f; memcpy(&f, &u, 4); return f; }
static inline unsigned f2u(float f) { unsigned u; memcpy(&u, &f, 4); return u; }
#else
DEVI float u2f(unsigned u) { return __uint_as_float(u); }
DEVI unsigned f2u(float f) { return __float_as_uint(f); }
#endif
DEVI float bf2f(bf16_t b) { return u2f(((unsigned)b) << 16); }
DEVI bf16_t f2bf(float f) { unsigned u = f2u(f); u += 0x7FFFu + ((u >> 16) & 1u); return (bf16_t)(u >> 16); }
DEVI float sigmoidf_(float x) { return 1.0f / (1.0f + expf(-x)); }
DEVI float siluf_(float x) { return x / (1.0f + expf(-x)); }
DEVI float softplusf_(float x) { return x > 20.f ? x : log1pf(expf(x)); }
DEVI float gelu_tanhf_(float x) { return 0.5f * x * (1.0f + tanhf(0.7978845608028654f * (x + 0.044715f * x * x * x))); }

DEVI void st8(bf16_t* dst, const float* v) {
#ifndef CPU_EMU
    uint4 w; w.x = (unsigned)f2bf(v[0]) | ((unsigned)f2bf(v[1]) << 16); w.y = (unsigned)f2bf(v[2]) | ((unsigned)f2bf(v[3]) << 16); w.z = (unsigned)f2bf(v[4]) | ((unsigned)f2bf(v[5]) << 16); w.w = (unsigned)f2bf(v[6]) | ((unsigned)f2bf(v[7]) << 16);
    *(uint4*)dst = w;
#else
    for (int j = 0; j < 8; ++j) dst[j] = f2bf(v[j]);
#endif
}
DEVI void ld8(const bf16_t* src, float* v) {
#ifndef CPU_EMU
    const uint4 w = *(const uint4*)src; v[0] = u2f(w.x << 16); v[1] = u2f(w.x & 0xffff0000u); v[2] = u2f(w.y << 16); v[3] = u2f(w.y & 0xffff0000u); v[4] = u2f(w.z << 16); v[5] = u2f(w.z & 0xffff0000u); v[6] = u2f(w.w << 16); v[7] = u2f(w.w & 0xffff0000u);
#else
    for (int j = 0; j < 8; ++j) v[j] = bf2f(src[j]);
#endif
}
#ifdef CPU_EMU
#define SCHED_FENCE() do { } while (0)
#define LDSQ
DEVI void ld8l(const bf16_t* src, float* v) { ld8(src, v); }
#else
#define SCHED_FENCE() __builtin_amdgcn_sched_barrier(0)
#define LDSQ __attribute__((address_space(3)))
typedef unsigned u32x4l_t __attribute__((ext_vector_type(4)));
DEVI void ld8l(const LDSQ bf16_t* src, float* v) { const u32x4l_t w = *(const LDSQ u32x4l_t*)src; v[0] = u2f(w[0] << 16); v[1] = u2f(w[0] & 0xffff0000u); v[2] = u2f(w[1] << 16); v[3] = u2f(w[1] & 0xffff0000u);
    v[4] = u2f(w[2] << 16); v[5] = u2f(w[2] & 0xffff0000u); v[6] = u2f(w[3] << 16); v[7] = u2f(w[3] & 0xffff0000u); }
#endif
constexpr int DM = 1024;
constexpr int PW = 3072;
constexpr int INW = 2972;
constexpr int C_Q = 0, C_KC = 256, C_VC = 384, C_KS = 512, C_VS = 640, C_KW = 768, C_VW = 896, C_NG = 1024;
constexpr int C_POOL = 1040;
constexpr int C_RW = 1296;
constexpr int C_GLA = 2192;
constexpr int C_VRES = 2976;
constexpr int NCMPH = 128;

enum { I_X = 0, I_MEM, I_POS, I_NORM_MIX, I_W_IN, I_CMP_PE, I_CMP_W1, I_CMP_W2, I_POOL_W, I_POOL_SCALE, I_RW_MU, I_RW_W0, I_RW_W2, I_RW_A0, I_RW_A2, I_RW_G2,
       I_RW_V0, I_RW_V1, I_RW_V2, I_RW_KK, I_RW_KA, I_RW_RK, I_RW_LN, I_GLA_A2, I_GLA_AB, I_GLA_NORM, I_W_GATE, I_B_GATE, I_W_BRANCH, I_W_OUT, I_NORM_CA, I_MEM_NORM,
       I_CA_Q, I_CA_KV, I_CA_O, I_NORM_FFN, I_FFN_G, I_FFN_U, I_FFN_D, I_MOE_R, I_MOE_G, I_MOE_U, I_MOE_D, I_NORM_FINAL, N_INPUTS };

struct Params {
    const float* in[N_INPUTS];
    float* out;
    unsigned char* ws;
    long long B, S, T, DFF, NC, NR;
    float inv_freq[8];
    long long oBAR, oMOEC, oROPE, oKCMP, oVCMP, oUV, oW1T, oCB, oSELM, oKV, oTOKE, oTOKW, oTOKS, oR2T, oROWW, oCCNT, oCOFF;
    long long oWL[2], oWKV, oWFFN, oVF, oH, oP, oO, oBO, oMG, oRWW, oRWX, oGA, oCQ, oCAO, oMEMN, oACT, oY, oHS, oMOEW, oACTC, wsNeed;
};
constexpr long long W_IN = 0, W_G = W_IN + 3072LL * 1024, W_B = W_G + 4096LL * 1024, W_O = W_B + 4LL * 1024 * 256, W_CQ = W_O + 1024LL * 1024, W_CKV = W_CQ + 256LL * 1024,
                    W_CO = W_CKV + 512LL * 1024, W_LAYER = W_CO + 1024LL * 256;

static inline long long al256(long long x) { return (x + 255) & ~255LL; }
static inline void make_layout(Params& p, long long B, long long S, long long DFF) {
    p.B = B; p.S = S; p.T = B * S; p.DFF = DFF; p.NC = (S - 32) / 16 + 1; p.NR = 2 * p.T + 2048;
    const long long T = p.T;
    long long o = 0;
    auto take = [&](long long bytes) { long long r = o; o = al256(o + bytes); return r; };
    p.oBAR = take(16384); p.oMOEC = take(4096);
    p.oROPE = take(T * 16 * 4);
    p.oKCMP = take(B * p.NC * 128 * 4); p.oVCMP = take(B * p.NC * 128 * 4); p.oUV = take((T / 16) * 4 * 256 * 2); p.oW1T = take(2LL * 2 * 256 * 1024 * 2); p.oCB = take(2 * 2 * 128 * 4);
    p.oSELM = take(T * 2 * 4);
    p.oKV = take(2 * B * 256 * 512 * 2);
    p.oTOKE = take(T * 2 * 4); p.oTOKW = take(T * 2 * 4); p.oTOKS = take(T * 2 * 4); p.oR2T = take(p.NR * 4); p.oROWW = take(p.NR * 4);
    p.oCCNT = take((T / 64) * 8 * 4); p.oCOFF = take((T / 64) * 8 * 4);
    p.oWL[0] = take(W_LAYER * 2); p.oWL[1] = take(W_LAYER * 2); p.oWKV = take(2LL * 512 * 1024 * 2); p.oWFFN = take(3 * 1024 * DFF * 2);
    p.oVF = take(T * 256 * 2);
    p.oH = take(T * 1024 * 2);
    p.oP = take(T * 3072 * 2);
    p.oO = take(T * 1024 * 2);
    p.oBO = take(T * 2048);
    p.oMG = take(T * 2048);
    long long end_main = o;
    p.oRWW = p.oBO;
    p.oRWX = p.oRWW + T * 1024;
    p.oGA = p.oRWX + T * 2560;
    p.oCQ = p.oP; p.oCAO = p.oP + T * 512;
    p.oMEMN = p.oBO;
    p.oACT = p.oP;
    p.oY = p.oVF; long long q = al256(p.oY + p.NR * 2048);
    p.oHS = q; q = al256(q + p.NR * 2048);
    p.oMOEW = q; q = al256(q + 8LL * 3 * 1024 * DFF * 2);
    const long long ntmax = p.NR / 256, ct = (ntmax + 3) / 4;
    p.oACTC = q; q = al256(q + ct * 256 * DFF * 2);
    p.wsNeed = q > end_main ? q : end_main;
}
#define WSP(T_, off) ((T_*)(p.ws + (off)))

DEVI void cvt_T(bf16_t* dst, const float* src, long long K, long long N, long long Npad, long long ld, long long gtid, long long gsz) {
    for (long long i = gtid; i < Npad * K; i += gsz) { const long long n = i / K, k = i % K; dst[i] = n < N ? f2bf(src[k * ld + n]) : (bf16_t)0; }
}
DEVI void cvt_GU(bf16_t* dst, const float* wg, const float* wu, long long DFF, long long gtid, long long gsz) {
    for (long long i = gtid; i < 2 * DFF * 1024; i += gsz) { const long long rr = i / 1024, k = i % 1024, t = rr >> 8, w = rr & 255;
        dst[i] = f2bf((w < 128 ? wg : wu)[k * DFF + t * 128 + (w & 127)]); }
}
DEVI void ph_convert_layer(const Params& p, int l, long long gtid, long long gsz) {
    bf16_t* W = WSP(bf16_t, p.oWL[l]);
    for (long long i = gtid; i < 3072LL * 1024; i += gsz) { const long long n = i >> 10, k = i & 1023; float v = 0.f;
        if (n < 1036) v = p.in[I_W_IN][((long long)l * 1024 + k) * INW + n];
        else if (n >= C_POOL && n < C_VRES) v = p.in[I_W_IN][((long long)l * 1024 + k) * INW + n - 4];
        else if (n >= C_VRES && n < C_VRES + 32 && l == 1) v = p.in[I_RW_V1][k * 32 + (n - C_VRES)];
        W[W_IN + i] = f2bf(v); }
    for (int i = 0; i < 4; ++i) cvt_T(W + W_G + (long long)i * 1024 * 1024, p.in[I_W_GATE] + ((long long)l * 4 + i) * 1024 * 1024, 1024, 1024, 1024, 1024, gtid, gsz);
    for (int i = 0; i < 4; ++i) cvt_T(W + W_B + (long long)i * 1024 * 256, p.in[I_W_BRANCH] + ((long long)l * 4 + i) * 256 * 1024, 256, 1024, 1024, 1024, gtid, gsz);
    cvt_T(W + W_O, p.in[I_W_OUT] + (long long)l * 1024 * 1024, 1024, 1024, 1024, 1024, gtid, gsz);
    cvt_T(W + W_CQ, p.in[I_CA_Q] + (long long)l * 1024 * 256, 1024, 256, 256, 256, gtid, gsz);
    cvt_T(WSP(bf16_t, p.oWKV) + (long long)l * 512 * 1024, p.in[I_CA_KV] + (long long)l * 1024 * 512, 1024, 512, 512, 512, gtid, gsz);
    cvt_T(W + W_CO, p.in[I_CA_O] + (long long)l * 256 * 1024, 256, 1024, 1024, 1024, gtid, gsz);
}
DEVI void ph_convert_ffn(const Params& p, long long gtid, long long gsz) {
    bf16_t* W = WSP(bf16_t, p.oWFFN);
    cvt_GU(W, p.in[I_FFN_G], p.in[I_FFN_U], p.DFF, gtid, gsz);
    cvt_T(W + 2 * p.DFF * 1024, p.in[I_FFN_D], p.DFF, 1024, 1024, 1024, gtid, gsz);
}
DEVI void ph_convert_moe(const Params& p, long long gtid, long long gsz) {
    const long long DFF = p.DFF, per = 3 * 1024 * DFF;
    for (int e = 0; e < 8; ++e) { bf16_t* W = WSP(bf16_t, p.oMOEW) + e * per;
        cvt_GU(W, p.in[I_MOE_G] + (long long)e * 1024 * DFF, p.in[I_MOE_U] + (long long)e * 1024 * DFF, DFF, gtid, gsz);
        cvt_T(W + 2 * DFF * 1024, p.in[I_MOE_D] + (long long)e * DFF * 1024, DFF, 1024, 1024, 1024, gtid, gsz); }
}
DEVI void ph_rope(const Params& p, long long gtid, long long gsz) {
    const int* pos = (const int*)p.in[I_POS]; float* R = WSP(float, p.oROPE);
    for (long long i = gtid; i < p.T * 8; i += gsz) { const long long t = i >> 3; const int j = (int)(i & 7);
        const float ang = (float)pos[t] * p.inv_freq[j];
        double a = (double)ang; a -= 6.283185307179586476925 * floor(a * 0.15915494309189533577 + 0.5);
        const float ar = (float)a; R[t * 16 + j] = cosf(ar); R[t * 16 + 8 + j] = sinf(ar); }
}
DEVI void ph_rope_apply(const Params& p, long long gtid, long long gsz) {
    bf16_t* P = WSP(bf16_t, p.oP); const float* R = WSP(float, p.oROPE);
    for (long long i = gtid; i < p.T * 8; i += gsz) { const long long t = i >> 3; const int w = (int)(i & 7);
        const int col = w < 4 ? C_Q + w * 64 : (w < 6 ? C_KS + (w - 4) * 64 : C_KW + (w - 6) * 64);
        bf16_t* x = P + t * PW + col; const float* r = R + t * 16; const float sc = w < 4 ? 0.125f : 1.0f;
        for (int j = 0; j < 8; ++j) { const float a = bf2f(x[j]), b = bf2f(x[j + 8]), c = r[j], s = r[8 + j]; x[j] = f2bf((a * c - b * s) * sc); x[j + 8] = f2bf((b * c + a * s) * sc); }
        if (w < 4) for (int j = 16; j < 64; ++j) x[j] = f2bf(bf2f(x[j]) * 0.125f); }
}
DEVI void ph_compress2(const Params& p, int l, long long gtid, long long gsz) {
    const bf16_t* UV = WSP(bf16_t, p.oUV); const float* CB = WSP(float, p.oCB) + l * 256; const float* w2 = p.in[I_CMP_W2] + (long long)l * 2 * 128 * 64; const float* R = WSP(float, p.oROPE);
    float* KC = WSP(float, p.oKCMP); float* VC = WSP(float, p.oVCMP);
    const long long n_items = p.B * p.NC * 2 * 2 * 8, hb = p.S / 16;
    for (long long i = gtid; i < n_items; i += gsz) { const int d8 = (int)(i & 7), j = (int)((i >> 3) & 1), g = (int)((i >> 4) & 1); const long long bn = i >> 5, n = bn % p.NC, b = bn / p.NC;
        const bf16_t* u = UV + ((b * hb + n) * 4 + (2 * j + g)) * 256; const bf16_t* vv = u + 4 * 256 + 128; const float* w = w2 + (long long)j * 128 * 64; const float* cb = CB + j * 128;
        float a[8];
#pragma unroll
        for (int m = 0; m < 8; ++m) a[m] = 0.f;
        for (int f = 0; f < 128; ++f) { const float hv = gelu_tanhf_(bf2f(u[f]) + bf2f(vv[f]) + cb[f]);
#pragma unroll
            for (int m = 0; m < 8; ++m) a[m] += hv * w[f * 64 + d8 + 8 * m]; }
        if (j == 0) { const float* r = R + (b * p.S + n * 16 + 31) * 16; const float x0 = a[0], x1 = a[1], cs = r[d8], sn = r[8 + d8]; a[0] = x0 * cs - x1 * sn; a[1] = x1 * cs + x0 * sn; }
        float* dst = (j == 0 ? KC : VC) + (bn * 2 + g) * 64;
#pragma unroll
        for (int m = 0; m < 8; ++m) dst[d8 + 8 * m] = a[m]; }
}
DEVI void ph_convert_cmp(const Params& p, long long gtid, long long gsz) {
    bf16_t* W1T = WSP(bf16_t, p.oW1T); float* CB = WSP(float, p.oCB);
    for (long long i = gtid; i < 2LL * 2 * 256 * 1024; i += gsz) { const int k = (int)(i & 1023), n = (int)((i >> 10) & 255); const long long lj = i >> 18; const int half = n >> 7, f = n & 127, tap = k >> 6, d = k & 63;
        W1T[i] = f2bf(p.in[I_CMP_W1][((lj * 32 + half * 16 + tap) * 64 + d) * 128 + f]); }
    for (long long i = gtid; i < 2 * 2 * 128; i += gsz) { const int f = (int)(i & 127); const long long lj = i >> 7; float a = 0.f;
        for (int k = 0; k < 2048; ++k) a += p.in[I_CMP_PE][lj * 2048 + k] * p.in[I_CMP_W1][(lj * 2048 + k) * 128 + f];
        CB[i] = a; }
}
DEVI void ph_pool(const Params& p, int l, long long gtid, long long gsz) {
    const bf16_t* P = WSP(bf16_t, p.oP); bf16_t* O = WSP(bf16_t, p.oO);
    const float* pw = p.in[I_POOL_W] + (long long)l * 4 * 64 * 64; const float* ps = p.in[I_POOL_SCALE] + (long long)l * 256;
    for (long long i = gtid; i < p.T * 16; i += gsz) { const long long t = i >> 4; const int g = (int)((i >> 2) & 3), dq = (int)(i & 3); const long long s = t % p.S; const int win = 2 << g;
        const int cnt = (int)(s + 1 < win ? s + 1 : win); const float inv = 1.0f / (float)cnt;
        const float* w = pw + g * 64 * 64 + dq * 16; float a[16];
#pragma unroll
        for (int d = 0; d < 16; ++d) a[d] = 0.f;
        for (int c8 = 0; c8 < 8; ++c8) { float dv[8], f[8];
#pragma unroll
            for (int j = 0; j < 8; ++j) dv[j] = 0.f;
            for (int k = 0; k < cnt; ++k) { ld8(P + (t - k) * PW + C_POOL + g * 64 + 8 * c8, f);
#pragma unroll
                for (int j = 0; j < 8; ++j) dv[j] += f[j]; }
            ld8(P + t * PW + C_POOL + g * 64 + 8 * c8, f);
#pragma unroll
            for (int j = 0; j < 8; ++j) { dv[j] = dv[j] * inv - f[j];
#pragma unroll
                for (int d = 0; d < 16; ++d) a[d] += dv[j] * w[(8 * c8 + j) * 64 + d]; } }
#pragma unroll
        for (int d = 0; d < 16; ++d) a[d] *= ps[g * 64 + dq * 16 + d];
        st8(O + t * 1024 + 256 + g * 64 + dq * 16, a); st8(O + t * 1024 + 256 + g * 64 + dq * 16 + 8, a + 8); }
}
DEVI void st16bf(bf16_t* dst, const float (&v)[16]) { st8(dst, v); st8(dst + 8, v + 8); }
DEVI float pick8v(float a0, float a1, float a2, float a3, float a4, float a5, float a6, float a7, int i) {
    float r = a0; r = (i == 1) ? a1 : r; r = (i == 2) ? a2 : r; r = (i == 3) ? a3 : r; r = (i == 4) ? a4 : r; r = (i == 5) ? a5 : r; r = (i == 6) ? a6 : r; r = (i == 7) ? a7 : r; return r; }
#define pick8(a, i) pick8v((a)[0], (a)[1], (a)[2], (a)[3], (a)[4], (a)[5], (a)[6], (a)[7], (i))
DEVI void lerp8(const bf16_t* x, const bf16_t* xp, const float* mu, bool first, float* out) {
    float a[8], b[8]; ld8(x, a);
    if (first) {
#pragma unroll
        for (int j = 0; j < 8; ++j) b[j] = 0.f; } else ld8(xp, b);
#pragma unroll
    for (int j = 0; j < 8; ++j) out[j] = a[j] + (b[j] - a[j]) * mu[j];
}
DEVI void rwkv_fill_wl(const Params& p, int l, LDSQ bf16_t* wl, int tid, int nthr) {
    const float* w2 = p.in[I_RW_W2] + l * 32 * 256; const float* a2 = p.in[I_RW_A2] + l * 32 * 256; const float* g2 = p.in[I_RW_G2] + l * 64 * 256; const float* v2 = p.in[I_RW_V2];
    for (int i = tid; i < 160 * 256; i += nthr) { const int r = i >> 8, c = i & 255; float v;
        if (r < 32) v = w2[r * 256 + c]; else if (r < 64) v = a2[(r - 32) * 256 + c]; else if (r < 96) v = (l == 1) ? v2[(r - 64) * 256 + c] : 0.f; else v = g2[(r - 96) * 256 + c];
        wl[i] = f2bf(v); }
}
DEVI void ph_rwkv_prep(const Params& p, int l, const LDSQ bf16_t* wl, long long gtid, long long gsz) {
    const bf16_t* P = WSP(bf16_t, p.oP); float* RWW = WSP(float, p.oRWW); bf16_t* RWX = WSP(bf16_t, p.oRWX); bf16_t* O = WSP(bf16_t, p.oO); bf16_t* VF = WSP(bf16_t, p.oVF);
    const float* mu = p.in[I_RW_MU] + l * 896; const float* w0 = p.in[I_RW_W0] + l * 256; const float* a0 = p.in[I_RW_A0] + l * 256;
    const float* kkw = p.in[I_RW_KK] + l * 256; const float* kaw = p.in[I_RW_KA] + l * 256; const float* v0 = p.in[I_RW_V0];
    for (long long i = gtid; i < p.T * 16; i += gsz) { const long long t = i >> 4; const int h = (int)((i >> 2) & 3), cc = (int)(i & 3); const bool first = (t % p.S) == 0;
        const bf16_t* x = P + t * PW + C_RW; const bf16_t* xp = x - PW; const int c0 = h * 64 + cc * 16;
        float nn = 0.f;
#pragma nounroll
        for (int q8 = 0; q8 < 8; ++q8) { float kq[8]; lerp8(x + 256 + h * 64 + 8 * q8, xp + 256 + h * 64 + 8 * q8, mu + 256 + h * 64 + 8 * q8, first, kq);
#pragma unroll
            for (int j = 0; j < 8; ++j) { const float e = kq[j] * kkw[h * 64 + 8 * q8 + j]; nn += e * e; } }
        const float rn = 1.0f / fmaxf(sqrtf(nn), 1e-12f);
        float zw[16], za[16], zg[16], zv[16];
#pragma unroll
        for (int u = 0; u < 16; ++u) { zw[u] = w0[c0 + u]; za[u] = a0[c0 + u]; zg[u] = 0.f; zv[u] = (l == 1) ? v0[c0 + u] : 0.f; }
#pragma nounroll
        for (int j8 = 0; j8 < 4; ++j8) { float tw[8], ad[8], hv[8]; lerp8(x + 768 + 8 * j8, xp + 768 + 8 * j8, mu + 768 + 8 * j8, first, tw); lerp8(x + 800 + 8 * j8, xp + 800 + 8 * j8, mu + 800 + 8 * j8, first, ad);
            if (l == 1) ld8(P + t * PW + C_VRES + 8 * j8, hv); else {
#pragma unroll
                for (int jj = 0; jj < 8; ++jj) hv[jj] = 0.f; }
#pragma nounroll
            for (int jj = 0; jj < 8; ++jj) { const int j = 8 * j8 + jj; const float twv = tanhf(pick8(tw, jj)), adv = pick8(ad, jj), hvv = pick8(hv, jj); float ww[16], wa[16], wv[16];
                ld8l(wl + j * 256 + c0, ww); ld8l(wl + j * 256 + c0 + 8, ww + 8); ld8l(wl + (32 + j) * 256 + c0, wa); ld8l(wl + (32 + j) * 256 + c0 + 8, wa + 8);
                if (l == 1) { ld8l(wl + (64 + j) * 256 + c0, wv); ld8l(wl + (64 + j) * 256 + c0 + 8, wv + 8); }
#pragma unroll
                for (int u = 0; u < 16; ++u) { zw[u] += twv * ww[u]; za[u] += adv * wa[u]; if (l == 1) zv[u] += hvv * wv[u]; }
                SCHED_FENCE(); } }
#pragma nounroll
        for (int j8 = 0; j8 < 8; ++j8) { float gd[8]; lerp8(x + 832 + 8 * j8, xp + 832 + 8 * j8, mu + 832 + 8 * j8, first, gd);
#pragma nounroll
            for (int jj = 0; jj < 8; ++jj) { const int j = 8 * j8 + jj; const float sg = sigmoidf_(pick8(gd, jj)); float wg[16]; ld8l(wl + (96 + j) * 256 + c0, wg); ld8l(wl + (96 + j) * 256 + c0 + 8, wg + 8);
#pragma unroll
                for (int u = 0; u < 16; ++u) zg[u] += sg * wg[u];
                SCHED_FENCE(); } }
        st16bf(O + t * 1024 + 512 + c0, zg);
#pragma unroll
        for (int hf = 0; hf < 2; ++hf) { const int cb = c0 + 8 * hf; float r8[8], k8[8], v8[8], vf8[8], kk8[8], b8[8], d8[8];
            lerp8(x + cb, xp + cb, mu + cb, first, r8); lerp8(x + 256 + cb, xp + 256 + cb, mu + 256 + cb, first, k8); lerp8(x + 512 + cb, xp + 512 + cb, mu + 512 + cb, first, v8);
            if (l == 1) ld8(VF + t * 256 + cb, vf8);
#pragma unroll
            for (int u = 0; u < 8; ++u) { const int c = cb + u, uu = 8 * hf + u;
                const float wlog = -softplusf_(-zw[uu]) - 0.5f, dec = expf(-expf(wlog)), a = sigmoidf_(za[uu]);
                const float k = k8[u]; float v = v8[u];
                if (l == 1) v = v + (vf8[u] - v) * sigmoidf_(zv[uu]);
                const float kk = k * kkw[c] * rn;
                d8[u] = dec; k8[u] = k * (1.0f + (a - 1.0f) * kaw[c]); v8[u] = v; kk8[u] = kk; b8[u] = kk * a; }
            float* ww = RWW + t * 256 + cb;
#pragma unroll
            for (int u = 0; u < 8; ++u) ww[u] = d8[u];
            bf16_t* rx = RWX + t * 1280 + cb;
            st8(rx, r8); st8(rx + 256, k8); st8(rx + 512, v8); st8(rx + 768, kk8); st8(rx + 1024, b8);
            if (l == 0) st8(VF + t * 256 + cb, v8);
            SCHED_FENCE(); } }
}
DEVI float rwkv_row_step(float (&st)[64], const float* w, const bf16_t* r, const bf16_t* k, const bf16_t* kk, const bf16_t* b, float v) {
    float skk = 0.f;
#pragma unroll
    for (int c = 0; c < 64; ++c) skk += st[c] * bf2f(kk[c]);
    float y = 0.f;
#pragma unroll
    for (int c = 0; c < 64; ++c) { st[c] = st[c] * w[c] - skk * bf2f(b[c]) + v * bf2f(k[c]); y += st[c] * bf2f(r[c]); }
    return y;
}
DEVI void ph_gla_prep(const Params& p, int l, long long gtid, long long gsz) {
    const bf16_t* P = WSP(bf16_t, p.oP); float* GA = WSP(float, p.oGA); bf16_t* O = WSP(bf16_t, p.oO);
    const float* a2 = p.in[I_GLA_A2] + l * 16 * 128; const float* ab = p.in[I_GLA_AB] + l * 128;
    for (long long i = gtid; i < p.T * 128; i += gsz) { const long long t = i >> 7; const int c = (int)(i & 127); const bf16_t* ad = P + t * PW + C_GLA + 512;
        float z = ab[c];
        for (int j = 0; j < 16; ++j) z += bf2f(ad[j]) * a2[j * 128 + c];
        GA[i] = expf(-softplusf_(-z) * 0.0625f);
        const bf16_t* og = P + t * PW + C_GLA + 528; O[t * 1024 + 768 + c] = f2bf(siluf_(bf2f(og[c]))); O[t * 1024 + 768 + 128 + c] = f2bf(siluf_(bf2f(og[128 + c]))); }
}
DEVI float gla_col_step(float (&st)[32], const float* a, const bf16_t* q, const bf16_t* k, float v) {
    float o = 0.f;
#pragma unroll
    for (int c = 0; c < 32; ++c) { st[c] = st[c] * a[c] + bf2f(k[c]) * v; o += st[c] * bf2f(q[c]); }
    return o * 0.17677669529663687f;
}
DEVI void ph_cmp_attn(const Params& p, long long gtid, long long gsz) {
    const bf16_t* P = WSP(bf16_t, p.oP); const float* KC = WSP(float, p.oKCMP); const float* VC = WSP(float, p.oVCMP); unsigned* SELM = WSP(unsigned, p.oSELM); bf16_t* O = WSP(bf16_t, p.oO);
    for (long long i = gtid; i < p.T * 2; i += gsz) { const long long t = i >> 1, b = t / p.S, s = t % p.S; const int g = (int)(i & 1);
        const int nv = s >= 31 ? (int)((s - 31) / 16 + 1) : 0;
        const int cur = (int)(s >> 6);
        const float* kc = KC + (b * p.NC * 2 + g) * 64; const float* vc = VC + (b * p.NC * 2 + g) * 64;
        float q0[64], q1[64];
        { const bf16_t* q = P + t * PW + C_Q + (2 * g) * 64;
#pragma unroll
          for (int d = 0; d < 64; ++d) { q0[d] = bf2f(q[d]); q1[d] = bf2f(q[64 + d]); } }
        float m0 = -3e38f, m1 = -3e38f;
        for (int n = 0; n < nv; ++n) { const float* k = kc + n * 128; float s0 = 0.f, s1 = 0.f;
#pragma unroll
            for (int d = 0; d < 64; ++d) { s0 += q0[d] * k[d]; s1 += q1[d] * k[d]; }
            m0 = fmaxf(m0, s0); m1 = fmaxf(m1, s1); }
        float z0 = 0.f, z1 = 0.f;
        for (int n = 0; n < nv; ++n) { const float* k = kc + n * 128; float s0 = 0.f, s1 = 0.f;
#pragma unroll
            for (int d = 0; d < 64; ++d) { s0 += q0[d] * k[d]; s1 += q1[d] * k[d]; }
            z0 += expf(s0 - m0); z1 += expf(s1 - m1); }
        const float iz0 = nv ? 1.0f / z0 : 0.f, iz1 = nv ? 1.0f / z1 : 0.f;
        unsigned mask;
        if (cur < 8) mask = (2u << cur) - 1u;
        else {
            float tv0 = -3e38f, tv1 = -3e38f, tv2 = -3e38f, tv3 = -3e38f, tv4 = -3e38f; int ti0 = 0, ti1 = 0, ti2 = 0, ti3 = 0, ti4 = 0;
            float carry = 0.f;
            for (int j = 0; j <= cur - 2; ++j) { float imp = carry;
                for (int mm = 0; mm < 4; ++mm) { const int n = 4 * j + mm; float pn = 0.f;
                    if (n < nv) { const float* k = kc + n * 128; float s0 = 0.f, s1 = 0.f;
#pragma unroll
                        for (int d = 0; d < 64; ++d) { s0 += q0[d] * k[d]; s1 += q1[d] * k[d]; }
                        pn = expf(s0 - m0) * iz0 + expf(s1 - m1) * iz1; }
                    if (mm < 3) imp += pn; else { imp += 0.5f * pn; carry = 0.5f * pn; } }
                if (j >= 1) {
                    float v = imp; int id = j;
                    if (v > tv0) { float tf = tv0; tv0 = v; v = tf; int tt = ti0; ti0 = id; id = tt; }
                    if (v > tv1) { float tf = tv1; tv1 = v; v = tf; int tt = ti1; ti1 = id; id = tt; }
                    if (v > tv2) { float tf = tv2; tv2 = v; v = tf; int tt = ti2; ti2 = id; id = tt; }
                    if (v > tv3) { float tf = tv3; tv3 = v; v = tf; int tt = ti3; ti3 = id; id = tt; }
                    if (v > tv4) { tv4 = v; ti4 = id; } } }
            mask = 1u | (1u << cur) | (1u << (cur - 1)) | (1u << ti0) | (1u << ti1) | (1u << ti2) | (1u << ti3) | (1u << ti4);
        }
        SELM[i] = mask;
        for (int r = 0; r < 2; ++r) { const int hd = 2 * g + r; const float mr = r ? m1 : m0, izr = r ? iz1 : iz0;
            float o[64], qq[64];
            { const bf16_t* q = P + t * PW + C_Q + hd * 64;
#pragma unroll
              for (int d = 0; d < 64; ++d) { o[d] = 0.f; qq[d] = bf2f(q[d]); } }
            for (int n = 0; n < nv; ++n) { const float* k = kc + n * 128; const float* v = vc + n * 128; float sc = 0.f;
#pragma unroll
                for (int d = 0; d < 64; ++d) sc += qq[d] * k[d];
                const float pr = expf(sc - mr) * izr;
#pragma unroll
                for (int d = 0; d < 64; ++d) o[d] += pr * v[d]; }
            const float g0 = sigmoidf_(bf2f(P[t * PW + C_NG + hd * 3 + 0]));
#pragma unroll
            for (int d = 0; d < 64; ++d) O[t * 1024 + hd * 64 + d] = f2bf(g0 * o[d]); } }
}
DEVI void ph_selwin(const Params& p, long long gtid, long long gsz) {
    const bf16_t* P = WSP(bf16_t, p.oP); const unsigned* SELM = WSP(unsigned, p.oSELM); bf16_t* O = WSP(bf16_t, p.oO);
    for (long long i = gtid; i < p.T * 8; i += gsz) { const long long t = i >> 3, b = t / p.S, s = t % p.S; const int hd = (int)((i >> 1) & 3), g = hd >> 1, d0 = (int)(i & 1) * 32;
        unsigned qp[32]; float o[32];
        { const bf16_t* qq = P + t * PW + C_Q + hd * 64;
#pragma unroll
          for (int d = 0; d < 32; ++d) qp[d] = (unsigned)qq[2 * d] | ((unsigned)qq[2 * d + 1] << 16); }
        for (int pass = 0; pass < 2; ++pass) {
            const int ck = pass ? C_KW : C_KS, cv = pass ? C_VW : C_VS; const unsigned mask = SELM[t * 2 + g];
            float m = -3e38f, z = 0.f;
#pragma unroll
            for (int d = 0; d < 32; ++d) o[d] = 0.f;
            const long long lo = pass ? (s - 511 > 0 ? s - 511 : 0) : 0;
            for (long long kp = lo; kp <= s; ++kp) {
                if (!pass && !((mask >> (kp >> 6)) & 1u)) { kp |= 63; continue; }
                const bf16_t* k = P + (b * p.S + kp) * PW + ck + g * 64; const bf16_t* v = P + (b * p.S + kp) * PW + cv + g * 64 + d0; float sc = 0.f;
#pragma unroll
                for (int d = 0; d < 32; ++d) sc += u2f(qp[d] << 16) * bf2f(k[2 * d]) + u2f(qp[d] & 0xffff0000u) * bf2f(k[2 * d + 1]);
                if (sc > m) { const float f = expf(m - sc); z *= f;
#pragma unroll
                    for (int d = 0; d < 32; ++d) o[d] *= f;
                    m = sc; }
                const float pr = expf(sc - m); z += pr;
#pragma unroll
                for (int d = 0; d < 32; ++d) o[d] += pr * bf2f(v[d]); }
            const float gt = sigmoidf_(bf2f(P[t * PW + C_NG + hd * 3 + 1 + pass])) / z;
#pragma unroll
            for (int d = 0; d < 32; ++d) { bf16_t* od = O + t * 1024 + hd * 64 + d0 + d; *od = f2bf(bf2f(*od) + gt * o[d]); } } }
}
DEVI void ph_ca_attn(const Params& p, int l, long long gtid, long long gsz) {
    const bf16_t* CQ = WSP(bf16_t, p.oCQ); const bf16_t* KV = WSP(bf16_t, p.oKV) + (long long)l * 512; bf16_t* AO = WSP(bf16_t, p.oCAO);
    for (long long i = gtid; i < p.T * 4; i += gsz) { const long long t = i >> 2, b = t / p.S; const int hd = (int)(i & 3);
        float q[64], o[64];
#pragma unroll
        for (int d = 0; d < 64; ++d) { q[d] = bf2f(CQ[t * 256 + hd * 64 + d]); o[d] = 0.f; }
        float m = -3e38f, z = 0.f;
        for (int kp = 0; kp < 256; ++kp) { const bf16_t* k = KV + (b * 256 + kp) * 1024 + hd * 64; const bf16_t* v = k + 256; float sc = 0.f;
#pragma unroll
            for (int d = 0; d < 64; ++d) sc += q[d] * bf2f(k[d]);
            if (sc > m) { const float f = expf(m - sc); z *= f;
#pragma unroll
                for (int d = 0; d < 64; ++d) o[d] *= f;
                m = sc; }
            const float pr = expf(sc - m); z += pr;
#pragma unroll
            for (int d = 0; d < 64; ++d) o[d] += pr * bf2f(v[d]); }
        const float iz = 1.0f / z;
#pragma unroll
        for (int d = 0; d < 64; ++d) AO[t * 256 + hd * 64 + d] = f2bf(o[d] * iz); }
}
DEVI void ph_moe_count(const Params& p, long long gtid, long long gsz) {
    const int* TE = WSP(int, p.oTOKE); int* CC = WSP(int, p.oCCNT); int* R2T = WSP(int, p.oR2T);
    for (long long c = gtid; c < p.T / 64; c += gsz) { int cnt[8] = {0, 0, 0, 0, 0, 0, 0, 0};
        for (int j = 0; j < 128; ++j) { const int e = TE[c * 128 + j];
#pragma unroll
            for (int q = 0; q < 8; ++q) cnt[q] += (e == q); }
#pragma unroll
        for (int q = 0; q < 8; ++q) CC[c * 8 + q] = cnt[q]; }
    for (long long i = gtid; i < p.NR; i += gsz) R2T[i] = -1;
}
DEVI void ph_moe_offsets(const Params& p, long long gtid, long long gsz) {
    const int* CC = WSP(int, p.oCCNT); int* CO = WSP(int, p.oCOFF); int* MC = WSP(int, p.oMOEC);
    for (long long ee = gtid; ee < 8; ee += gsz) { const int e = (int)ee; int run = 0; for (long long c = 0; c < p.T / 64; ++c) { CO[c * 8 + e] = run; run += CC[c * 8 + e]; } MC[e] = run; }
}
DEVI void moe_bases(const Params& p, int (&base)[9]) { const int* MC = WSP(int, p.oMOEC); int run = 0;
#pragma unroll
    for (int e = 0; e < 8; ++e) { base[e] = run; run += (MC[e] + 255) & ~255; } base[8] = run; }
DEVI void ph_moe_assign(const Params& p, long long gtid, long long gsz) {
    const int* TE = WSP(int, p.oTOKE); const float* TW = WSP(float, p.oTOKW); const int* CO = WSP(int, p.oCOFF); int* TS = WSP(int, p.oTOKS); int* R2T = WSP(int, p.oR2T); float* RW = WSP(float, p.oROWW);
    int base[9]; moe_bases(p, base);
    if (gtid == 0) { int* MC = WSP(int, p.oMOEC);
#pragma unroll
        for (int e = 0; e < 9; ++e) MC[16 + e] = base[e]; }
    for (long long c = gtid; c < p.T / 64; c += gsz) { int run[8];
#pragma unroll
        for (int q = 0; q < 8; ++q) run[q] = base[q] + CO[c * 8 + q];
        for (int j = 0; j < 128; ++j) { const int e = TE[c * 128 + j]; int slot = 0;
#pragma unroll
            for (int q = 0; q < 8; ++q) if (e == q) { slot = run[q]; run[q] += 1; }
            TS[c * 128 + j] = slot; R2T[slot] = (int)(c * 64 + (j >> 1)); RW[slot] = TW[c * 128 + j]; } }
}
DEVI void ph_moe_gather(const Params& p, long long gtid, long long gsz) {
    const int* R2T = WSP(int, p.oR2T); const int* MC = WSP(int, p.oMOEC); const uint4* H = WSP(uint4, p.oH); uint4* HS = WSP(uint4, p.oHS);
    const long long rows = MC[16 + 8];
    for (long long i = gtid; i < rows * 128; i += gsz) { const long long r = i >> 7; const int j = (int)(i & 127); const int t = R2T[r];
        uint4 v; v.x = v.y = v.z = v.w = 0u; if (t >= 0) v = H[(long long)t * 128 + j]; HS[i] = v; }
}
struct Unit { int pm, pn, aux, pad; long long aoff, boff; };
constexpr int NXCD = 8, WGM = 8;
DEVI void tile_order(long long L, int nM, int nN, int& pm, int& pn) {
    const int nwg = nM * nN; int wgid = (int)L; { const int q = nwg / NXCD, r = nwg % NXCD, xcd = wgid % NXCD, off = wgid / NXCD; wgid = (xcd < r ? xcd * (q + 1) : r * (q + 1) + (xcd - r) * q) + off; }
    const int nig = WGM * nN, gid = wgid / nig, fm = gid * WGM, gsz = (nM - fm) < WGM ? (nM - fm) : WGM;
    pm = fm + ((wgid % nig) % gsz); pn = (wgid % nig) / gsz;
}
struct SchedPlain {
    int nM, nN, G, c; long long lda, ldb;
    DEVM void init(long long M, long long N, long long lda_, long long ldb_, int G_, int c_) { nM = (int)(M / 256); nN = (int)(N / 256); lda = lda_; ldb = ldb_; G = G_; c = c_; }
    DEVM bool next(int i, Unit& u) const { const long long L = (long long)i * G + c; if (L >= (long long)nM * nN) return false; tile_order(L, nM, nN, u.pm, u.pn); u.aux = 0; u.pad = 0;
        u.aoff = (long long)u.pm * 256 * lda * 2; u.boff = (long long)u.pn * 256 * ldb * 2; return true; }
    DEVM void a_ready(const Unit&) const {}
    DEVM void done(const Unit&) const {}
};
struct SchedBranch {
    int nM, G, c;
    DEVM void init(long long M, int G_, int c_) { nM = (int)(M / 256); G = G_; c = c_; }
    DEVM bool next(int i, Unit& u) const { const long long L = (long long)i * G + c; if (L >= (long long)nM * 16) return false; tile_order(L, nM, 16, u.pm, u.pn); u.aux = u.pn >> 2; u.pad = 0;
        u.aoff = (long long)u.pm * 256 * 1024 * 2 + (long long)u.aux * 256 * 2; u.boff = (long long)u.pn * 256 * 256 * 2; return true; }
    DEVM void a_ready(const Unit&) const {}
    DEVM void done(const Unit&) const {}
};
struct SchedGate {
    int nM, G, c;
    DEVM void init(long long M, int G_, int c_) { nM = (int)(M / 256); G = G_; c = c_; }
    DEVM bool next(int i, Unit& u) const { const long long tile = (long long)(i >> 2) * G + c; if (tile >= (long long)nM * 4) return false; tile_order(tile, nM, 4, u.pm, u.pn); u.aux = i & 3; u.pad = 0;
        u.aoff = (long long)u.pm * 256 * 1024 * 2; u.boff = (long long)(u.aux * 4 + u.pn) * 256 * 1024 * 2; return true; }
    DEVM void a_ready(const Unit&) const {}
    DEVM void done(const Unit&) const {}
};
struct SchedMoe {
    int t0, t1, nN, G, c; long long lda, ldb, per_e; int base[9];
    DEVM bool next(int i, Unit& u) const { const long long L = (long long)i * G + c; if (L >= (long long)(t1 - t0) * nN) return false; u.pm = t0 + (int)(L / nN); u.pn = (int)(L % nN); u.pad = 0;
        int e = 0;
#pragma unroll
        for (int q = 1; q < 8; ++q) e += (u.pm * 256 >= base[q]) ? 1 : 0;
        u.aux = e; u.aoff = (long long)u.pm * 256 * lda * 2; u.boff = (long long)e * per_e + (long long)u.pn * 256 * ldb * 2; return true; }
    DEVM void a_ready(const Unit&) const {}
    DEVM void done(const Unit&) const {}
};
struct SchedCmp {
    int nM, G, c;
    DEVM void init(long long rows, int G_, int c_) { nM = (int)(rows / 256); G = G_; c = c_; }
    DEVM bool next(int i, Unit& u) const { const long long L = (long long)i * G + c; if (L >= (long long)nM * 4) return false; const int combo = (int)(L / nM); u.pm = (int)(L % nM); u.pn = 0; u.aux = combo; u.pad = 0;
        u.aoff = (long long)u.pm * 256 * 16 * PW * 2 + (long long)(((combo >> 1) ? C_VC : C_KC) + (combo & 1) * 64) * 2; u.boff = (long long)(combo >> 1) * 256 * 1024 * 2; return true; }
    DEVM void a_ready(const Unit&) const {}
    DEVM void done(const Unit&) const {}
};
struct EpStore {
    bf16_t* O; long long ldo; float scale;
    DEVM void apply(const Unit& u, long long row, int c8, const float* lo, const float* hi) const { float a[8], b[8];
#pragma unroll
        for (int j = 0; j < 8; ++j) { a[j] = lo[j] * scale; b[j] = hi[j] * scale; }
        bf16_t* d = O + row * ldo + u.pn * 256 + c8; st8(d, a); st8(d + 128, b); }
};
struct EpUV {
    bf16_t* UV;
    DEVM void apply(const Unit& u, long long row, int c8, const float* lo, const float* hi) const { bf16_t* d = UV + (row * 4 + u.aux) * 256 + c8; st8(d, lo); st8(d + 128, hi); }
};
struct EpGate {
    const bf16_t* BO; const float* bias; bf16_t* MG; long long row0;
    DEVM void apply(const Unit& u, long long row, int c8, const float* lo, const float* hi) const {
#pragma unroll
        for (int hh = 0; hh < 2; ++hh) { const float* v = hh ? hi : lo; const int c = u.pn * 256 + hh * 128 + c8, n = u.aux * 1024 + c; float bo[8], mg[8], r[8]; ld8(BO + row * 4096 + n, bo);
            bf16_t* m = MG + (row0 + row) * 1024 + c;
            if (u.aux) ld8(m, mg);
#pragma unroll
            for (int j = 0; j < 8; ++j) { r[j] = sigmoidf_(v[j] + bias[n + j]) * bo[j]; if (u.aux) r[j] += mg[j]; }
            st8(m, r); } }
};
struct EpResid {
    float* X;
    DEVM void apply(const Unit& u, long long row, int c8, const float* lo, const float* hi) const { float* x = X + row * 1024 + u.pn * 256 + c8;
#ifndef CPU_EMU
        float4 a = *(float4*)x, b = *(float4*)(x + 4), c = *(float4*)(x + 128), d = *(float4*)(x + 132);
        a.x += lo[0]; a.y += lo[1]; a.z += lo[2]; a.w += lo[3]; b.x += lo[4]; b.y += lo[5]; b.z += lo[6]; b.w += lo[7];
        c.x += hi[0]; c.y += hi[1]; c.z += hi[2]; c.w += hi[3]; d.x += hi[4]; d.y += hi[5]; d.z += hi[6]; d.w += hi[7];
        *(float4*)x = a; *(float4*)(x + 4) = b; *(float4*)(x + 128) = c; *(float4*)(x + 132) = d;
#else
        for (int j = 0; j < 8; ++j) { x[j] += lo[j]; x[128 + j] += hi[j]; }
#endif
    }
};
struct EpSwiglu {
    bf16_t* ACT; long long ldo; long long row0;
    DEVM void apply(const Unit& u, long long row, int c8, const float* lo, const float* hi) const { float r[8];
#pragma unroll
        for (int j = 0; j < 8; ++j) r[j] = siluf_(lo[j]) * hi[j];
        st8(ACT + (row - row0) * ldo + u.pn * 128 + c8, r); }
};
struct EpMoeDown {
    bf16_t* Y; const float* roww;
    DEVM void apply(const Unit& u, long long row, int c8, const float* lo, const float* hi) const { const float w = roww[row]; float a[8], b[8];
#pragma unroll
        for (int j = 0; j < 8; ++j) { a[j] = lo[j] * w; b[j] = hi[j] * w; }
        bf16_t* d = Y + row * 1024 + u.pn * 256 + c8; st8(d, a); st8(d + 128, b); }
};

#ifdef CPU_EMU
template <class Sched, class Epi> static void gemm_cpu(const bf16_t* A, long long lda, const bf16_t* Bt, long long ldb, long long K, const Sched& S, const Epi& E, long long kstepA = 64) {
    Unit u;
    for (int i = 0; S.next(i, u); ++i) {
        const bf16_t* a0 = (const bf16_t*)((const char*)A + u.aoff); const bf16_t* b0 = (const bf16_t*)((const char*)Bt + u.boff);
#pragma omp parallel for
        for (int r = 0; r < 256; ++r) { float arow[4096]; for (long long k = 0; k < K; ++k) arow[k] = bf2f(a0[r * lda + (k >> 6) * kstepA + (k & 63)]);
            for (int c8 = 0; c8 < 128; c8 += 8) { float lo[8], hi[8];
                for (int j = 0; j < 8; ++j) { const bf16_t* bl = b0 + (c8 + j) * ldb; const bf16_t* bh = b0 + (128 + c8 + j) * ldb; float s0 = 0.f, s1 = 0.f;
                    for (long long k = 0; k < K; ++k) { s0 += arow[k] * bf2f(bl[k]); s1 += arow[k] * bf2f(bh[k]); } lo[j] = s0; hi[j] = s1; }
                E.apply(u, (long long)u.pm * 256 + r, c8, lo, hi); } } }
}
#endif

#ifndef CPU_EMU
DEVI float wave_sum(float v) {
#pragma unroll
    for (int o = 32; o > 0; o >>= 1) v += __shfl_xor(v, o);
    return v; }
DEVI void row_load(const float* src, float (&v)[16], int lane) {
#pragma unroll
    for (int j = 0; j < 4; ++j) { const float4 f = *(const float4*)(src + j * 256 + lane * 4); v[4 * j] = f.x; v[4 * j + 1] = f.y; v[4 * j + 2] = f.z; v[4 * j + 3] = f.w; } }
DEVI void row_store_bf16(bf16_t* dst, const float (&v)[16], int lane) {
#pragma unroll
    for (int j = 0; j < 4; ++j) { uint2 w; w.x = (unsigned)f2bf(v[4 * j]) | ((unsigned)f2bf(v[4 * j + 1]) << 16); w.y = (unsigned)f2bf(v[4 * j + 2]) | ((unsigned)f2bf(v[4 * j + 3]) << 16); *(uint2*)(dst + j * 256 + lane * 4) = w; } }
#endif
DEVI void ph_rmsnorm(const Params& p, const float* src, long long rows, const float* gain, bf16_t* dst, int mode, float* xcopy, long long gw, long long nw, int lane) {
    const float* router = p.in[I_MOE_R]; int* TE = WSP(int, p.oTOKE); float* TW = WSP(float, p.oTOKW);
#ifndef CPU_EMU
    for (long long r = gw; r < rows; r += nw) { float v[16], g[16]; row_load(src + r * 1024, v, lane); row_load(gain, g, lane);
        float ss = 0.f;
#pragma unroll
        for (int j = 0; j < 16; ++j) ss += v[j] * v[j];
        ss = wave_sum(ss); const float rs = rsqrtf(ss * (1.0f / 1024.0f) + 1e-6f);
        if (mode == 1) {
#pragma unroll
            for (int j = 0; j < 4; ++j) *(float4*)(xcopy + r * 1024 + j * 256 + lane * 4) = make_float4(v[4 * j], v[4 * j + 1], v[4 * j + 2], v[4 * j + 3]); }
#pragma unroll
        for (int j = 0; j < 16; ++j) v[j] = v[j] * rs * g[j];
        row_store_bf16(dst + r * 1024, v, lane);
        if (mode == 2) { float lg[8];
#pragma unroll
            for (int e = 0; e < 8; ++e) { float a = 0.f;
#pragma unroll
                for (int j = 0; j < 16; ++j) a += v[j] * router[(long long)((j >> 2) * 256 + lane * 4 + (j & 3)) * 8 + e];
                lg[e] = wave_sum(a); }
            int i0 = 0; float v0 = lg[0];
#pragma unroll
            for (int e = 1; e < 8; ++e) if (lg[e] > v0) { v0 = lg[e]; i0 = e; }
            int i1 = -1; float v1 = -3e38f;
#pragma unroll
            for (int e = 0; e < 8; ++e) if (e != i0 && lg[e] > v1) { v1 = lg[e]; i1 = e; }
            const float w0 = 1.0f / (1.0f + expf(v1 - v0));
            if (lane == 0) { TE[r * 2] = i0; TE[r * 2 + 1] = i1; TW[r * 2] = w0; TW[r * 2 + 1] = 1.0f - w0; } } }
#else
    (void)lane;
    for (long long r = gw; r < rows; r += nw) { const float* x = src + r * 1024; float ss = 0.f; for (int c = 0; c < 1024; ++c) ss += x[c] * x[c];
        const float rs = 1.0f / sqrtf(ss / 1024.0f + 1e-6f); float hv[1024];
        for (int c = 0; c < 1024; ++c) { hv[c] = x[c] * rs * gain[c]; dst[r * 1024 + c] = f2bf(hv[c]); if (mode == 1) xcopy[r * 1024 + c] = x[c]; }
        if (mode == 2) { float lg[8]; for (int e = 0; e < 8; ++e) { float a = 0.f; for (int c = 0; c < 1024; ++c) a += hv[c] * router[c * 8 + e]; lg[e] = a; }
            int i0 = 0; float v0 = lg[0]; for (int e = 1; e < 8; ++e) if (lg[e] > v0) { v0 = lg[e]; i0 = e; }
            int i1 = -1; float v1 = -3e38f; for (int e = 0; e < 8; ++e) if (e != i0 && lg[e] > v1) { v1 = lg[e]; i1 = e; }
            const float w0 = 1.0f / (1.0f + expf(v1 - v0)); TE[r * 2] = i0; TE[r * 2 + 1] = i1; TW[r * 2] = w0; TW[r * 2 + 1] = 1.0f - w0; } }
#endif
}
DEVI void ph_final(const Params& p, long long gw, long long nw, int lane) {
    const int* TS = WSP(int, p.oTOKS); const bf16_t* Y = WSP(bf16_t, p.oY); const float* gain = p.in[I_NORM_FINAL]; float* X = p.out;
#ifndef CPU_EMU
    for (long long r = gw; r < p.T; r += nw) { float v[16], g[16]; row_load(X + r * 1024, v, lane); row_load(gain, g, lane);
        const bf16_t* y0 = Y + (long long)TS[r * 2] * 1024; const bf16_t* y1 = Y + (long long)TS[r * 2 + 1] * 1024;
#pragma unroll
        for (int j = 0; j < 4; ++j) { const uint2 a = *(const uint2*)(y0 + j * 256 + lane * 4), b = *(const uint2*)(y1 + j * 256 + lane * 4);
            v[4 * j] += u2f(a.x << 16) + u2f(b.x << 16); v[4 * j + 1] += u2f(a.x & 0xffff0000u) + u2f(b.x & 0xffff0000u); v[4 * j + 2] += u2f(a.y << 16) + u2f(b.y << 16); v[4 * j + 3] += u2f(a.y & 0xffff0000u) + u2f(b.y & 0xffff0000u); }
        float ss = 0.f;
#pragma unroll
        for (int j = 0; j < 16; ++j) ss += v[j] * v[j];
        ss = wave_sum(ss); const float rs = rsqrtf(ss * (1.0f / 1024.0f) + 1e-6f);
#pragma unroll
        for (int j = 0; j < 4; ++j) *(float4*)(X + r * 1024 + j * 256 + lane * 4) = make_float4(v[4 * j] * rs * g[4 * j], v[4 * j + 1] * rs * g[4 * j + 1], v[4 * j + 2] * rs * g[4 * j + 2], v[4 * j + 3] * rs * g[4 * j + 3]); }
#else
    (void)lane;
    for (long long r = gw; r < p.T; r += nw) { float v[1024]; float ss = 0.f; const bf16_t* y0 = Y + (long long)TS[r * 2] * 1024; const bf16_t* y1 = Y + (long long)TS[r * 2 + 1] * 1024;
        for (int c = 0; c < 1024; ++c) { v[c] = X[r * 1024 + c] + bf2f(y0[c]) + bf2f(y1[c]); ss += v[c] * v[c]; }
        const float rs = 1.0f / sqrtf(ss / 1024.0f + 1e-6f); for (int c = 0; c < 1024; ++c) X[r * 1024 + c] = v[c] * rs * gain[c]; }
#endif
}
DEVI void ph_rwkv_scan(const Params& p, int l, long long gw, long long nw, int lane) {
    const float* RWW = WSP(float, p.oRWW); const bf16_t* RWX = WSP(bf16_t, p.oRWX); bf16_t* O = WSP(bf16_t, p.oO); const float* lng = p.in[I_RW_LN] + l * 256; const float* rkw = p.in[I_RW_RK] + l * 256; (void)rkw;
    for (long long ch = gw; ch < p.B * 4; ch += nw) { const long long b = ch >> 2; const int h = (int)(ch & 3);
#ifndef CPU_EMU
        float st[64];
#pragma unroll
        for (int c = 0; c < 64; ++c) st[c] = 0.f;
        for (long long s = 0; s < p.S; ++s) { const long long t = b * p.S + s; const bf16_t* rx = RWX + t * 1280 + h * 64; const float v = bf2f(rx[512 + lane]);
            const float y = rwkv_row_step(st, RWW + t * 256 + h * 64, rx, rx + 256, rx + 768, rx + 1024, v);
            const float mean = wave_sum(y) * (1.0f / 64.0f), dy = y - mean, var = wave_sum(dy * dy) * (1.0f / 64.0f);
            const float yn = dy * rsqrtf(var + 64e-5f) * lng[h * 64 + lane] + 0.f;
            bf16_t* o = O + t * 1024 + 512 + h * 64 + lane; *o = f2bf(yn * bf2f(*o)); }
#else
        (void)lane;
        static float st[64][64]; for (int v = 0; v < 64; ++v) for (int c = 0; c < 64; ++c) st[v][c] = 0.f;
        for (long long s = 0; s < p.S; ++s) { const long long t = b * p.S + s; const bf16_t* rx = RWX + t * 1280 + h * 64; float y[64], mean = 0.f, var = 0.f;
            for (int v = 0; v < 64; ++v) { y[v] = rwkv_row_step(st[v], RWW + t * 256 + h * 64, rx, rx + 256, rx + 768, rx + 1024, bf2f(rx[512 + v])); mean += y[v]; }
            mean /= 64.f; for (int v = 0; v < 64; ++v) var += (y[v] - mean) * (y[v] - mean); var /= 64.f;
            float rkv = 0.f; for (int cq = 0; cq < 64; ++cq) rkv += bf2f(rx[cq]) * bf2f(rx[256 + cq]) * rkw[h * 64 + cq];
            for (int v = 0; v < 64; ++v) { const float yn = (y[v] - mean) / sqrtf(var + 64e-5f) * lng[h * 64 + v] + rkv * bf2f(rx[512 + v]);
                bf16_t* o = O + t * 1024 + 512 + h * 64 + v; *o = f2bf(yn * bf2f(*o)); } }
#endif
    }
}
DEVI void ph_gla_scan(const Params& p, int l, long long gw, long long nw, int lane) {
    const bf16_t* P = WSP(bf16_t, p.oP); const float* GA = WSP(float, p.oGA); bf16_t* O = WSP(bf16_t, p.oO); const float* ng = p.in[I_GLA_NORM] + l * 64;
    for (long long ch = gw; ch < p.B * 4; ch += nw) { const long long b = ch >> 2; const int h = (int)(ch & 3);
#ifndef CPU_EMU
        float st[32];
#pragma unroll
        for (int c = 0; c < 32; ++c) st[c] = 0.f;
        for (long long s = 0; s < p.S; ++s) { const long long t = b * p.S + s; const bf16_t* x = P + t * PW + C_GLA;
            const float o = gla_col_step(st, GA + t * 128 + h * 32, x + h * 32, x + 128 + h * 32, bf2f(x[256 + h * 64 + lane]));
            const float ms = wave_sum(o * o) * (1.0f / 64.0f), on = o * rsqrtf(ms + 1e-6f) * ng[lane];
            bf16_t* d = O + t * 1024 + 768 + h * 64 + lane; *d = f2bf(on * bf2f(*d)); }
#else
        (void)lane;
        static float st[64][32]; for (int v = 0; v < 64; ++v) for (int c = 0; c < 32; ++c) st[v][c] = 0.f;
        for (long long s = 0; s < p.S; ++s) { const long long t = b * p.S + s; const bf16_t* x = P + t * PW + C_GLA; float o[64], ms = 0.f;
            for (int v = 0; v < 64; ++v) { o[v] = gla_col_step(st[v], GA + t * 128 + h * 32, x + h * 32, x + 128 + h * 32, bf2f(x[256 + h * 64 + v])); ms += o[v] * o[v]; }
            ms /= 64.f;
            for (int v = 0; v < 64; ++v) { bf16_t* d = O + t * 1024 + 768 + h * 64 + v; *d = f2bf(o[v] / sqrtf(ms + 1e-6f) * ng[v] * bf2f(*d)); } }
#endif
    }
}
#ifndef CPU_EMU
#define LAS __attribute__((address_space(3)))
__device__ __forceinline__ int mk_lane() { return (int)__builtin_amdgcn_mbcnt_hi(~0u, __builtin_amdgcn_mbcnt_lo(~0u, 0u)); }
typedef short bf16x8 __attribute__((ext_vector_type(8)));
typedef float f32x4 __attribute__((ext_vector_type(4)));
constexpr int HALF = 128, BK = 64, HTB = HALF * BK * 2, STAGE_BYTES = 8 * HTB;
__device__ __forceinline__ int lds_byte(int r, int c) { const int st = (r >> 4) * 2 + (c >> 5), rr = r & 15, cc = c & 31, ob = rr * 64 + cc * 2; return st * 1024 + (ob ^ (((ob >> 9) & 1) << 5)); }
__device__ __forceinline__ void stage_rc(int b, int& R, int& C) { const int st = b / 1024, sb = b % 1024, swz = sb ^ (((sb >> 9) & 1) << 5); R = (st >> 1) * 16 + swz / 64; C = (st & 1) * 32 + (swz % 64) / 2; }
__device__ __forceinline__ int perm32(int rho) { const int n = rho >> 4, i = rho & 15; return 8 * (i >> 2) + 4 * n + (i & 3); }

template <class Epi, class Sched>
__device__ __forceinline__ void gemm_phase(int wv, LAS unsigned char* lds, const bf16_t* A, long long lda, const bf16_t* Bt, long long ldb, long long K, const Sched& S, const Epi& E, long long kstepA_elems = 64) {
    int tid = wv * 64 + mk_lane(); asm volatile("" : "+v"(tid));
    const int wid = wv, lane = tid & 63, wr = wid >> 2, wc = wid & 3, fr = lane & 15, fq = lane >> 4;
    { unsigned long long a_ = (unsigned long long)A, b_ = (unsigned long long)Bt; unsigned alo = __builtin_amdgcn_readfirstlane((unsigned)a_), ahi = __builtin_amdgcn_readfirstlane((unsigned)(a_ >> 32)),
        blo = __builtin_amdgcn_readfirstlane((unsigned)b_), bhi = __builtin_amdgcn_readfirstlane((unsigned)(b_ >> 32));
      int lda_ = __builtin_amdgcn_readfirstlane((int)lda), ldb_ = __builtin_amdgcn_readfirstlane((int)ldb), k_ = __builtin_amdgcn_readfirstlane((int)K), ks_ = __builtin_amdgcn_readfirstlane((int)kstepA_elems);
      asm volatile("" : "+s"(alo), "+s"(ahi), "+s"(blo), "+s"(bhi), "+s"(lda_), "+s"(ldb_), "+s"(k_), "+s"(ks_)); kstepA_elems = ks_;
      A = (const bf16_t*)(((unsigned long long)ahi << 32) | alo); Bt = (const bf16_t*)(((unsigned long long)bhi << 32) | blo); lda = lda_; ldb = ldb_; K = k_; }
    const int nt = (int)(K / BK);
    unsigned voffA[2], voffB[2];
#pragma unroll
    for (int i = 0; i < 2; ++i) { int R, C; stage_rc(tid * 16 + i * 8192, R, C); const int Rb = (R & ~31) + perm32(R & 31);
        voffA[i] = (unsigned)(R * (int)lda + C) * 2u; voffB[i] = (unsigned)(Rb * (int)ldb + C) * 2u; }
    const size_t kstep = (size_t)(BK * 2), kstepA = (size_t)kstepA_elems * 2;
    const size_t hstepA = (size_t)HALF * lda * 2, hstepB = (size_t)HALF * ldb * 2;
    const unsigned ldsw = (unsigned)wid * 1024u;
    const int aoff = lds_byte(wr * 64 + fr, fq * 8), boff = lds_byte(wc * 32 + fr, fq * 8);
#define PG8_SA(b, h) (((b) * 2 + (h)) * HTB)
#define PG8_SB(b, h) ((4 + (b) * 2 + (h)) * HTB)
#define PG8_STAGE(bufoff, gbase, voff) do { _Pragma("unroll") for (int _i = 0; _i < 2; ++_i) \
        __builtin_amdgcn_global_load_lds((const unsigned*)((const char*)(gbase) + (voff)[_i]), (LAS unsigned*)(lds + (bufoff) + ldsw + _i * 8192), 16, 0, 0); } while (0)
#define PG8_LDA(dst, b, h) do { _Pragma("unroll") for (int m = 0; m < 4; ++m) _Pragma("unroll") for (int k = 0; k < 2; ++k) dst[m][k] = *(const LAS bf16x8*)(lds + PG8_SA(b, h) + aoff + m * 2048 + k * 1024); } while (0)
#define PG8_LDB(dst, b, h) do { _Pragma("unroll") for (int n = 0; n < 2; ++n) _Pragma("unroll") for (int k = 0; k < 2; ++k) dst[n][k] = *(const LAS bf16x8*)(lds + PG8_SB(b, h) + boff + n * 2048 + k * 1024); } while (0)
#define PG8_MMA(ai, bj, At, Bt_) do { __builtin_amdgcn_s_setprio(1); _Pragma("unroll") for (int m = 0; m < 4; ++m) _Pragma("unroll") for (int n = 0; n < 2; ++n) _Pragma("unroll") for (int k = 0; k < 2; ++k) \
        acc[ai][bj][m][n] = __builtin_amdgcn_mfma_f32_16x16x32_bf16(Bt_[n][k], At[m][k], acc[ai][bj][m][n], 0, 0, 0); __builtin_amdgcn_s_setprio(0); } while (0)
#define PG8_WAIT_V(n) asm volatile("s_waitcnt vmcnt(" #n ")" ::: "memory")
#define PG8_WAIT_L(n) asm volatile("s_waitcnt lgkmcnt(" #n ")" ::: "memory")
#define PG8_BAR __builtin_amdgcn_s_barrier()
#define PG8_SCHED __builtin_amdgcn_sched_barrier(0)
    Unit cur, nxt; int ui = 0;
    if (!S.next(0, cur)) return;
    f32x4 acc[2][2][4][2];
#pragma unroll
    for (int a = 0; a < 2; ++a)
#pragma unroll
        for (int b = 0; b < 2; ++b)
#pragma unroll
            for (int m = 0; m < 4; ++m)
#pragma unroll
                for (int n = 0; n < 2; ++n) acc[a][b][m][n] = (f32x4){0.f, 0.f, 0.f, 0.f};
    bf16x8 At[4][2], B0[2][2], B1[2][2];
    const char* cA = (const char*)A + cur.aoff; const char* cB = (const char*)Bt + cur.boff;
    S.a_ready(cur);
    PG8_STAGE(PG8_SB(0, 0), cB, voffB); PG8_STAGE(PG8_SA(0, 0), cA, voffA); PG8_STAGE(PG8_SB(0, 1), cB + hstepB, voffB); PG8_STAGE(PG8_SA(0, 1), cA + hstepA, voffA);
    if (wr == 1) PG8_BAR;
    PG8_WAIT_V(4); PG8_BAR;
    PG8_STAGE(PG8_SB(1, 0), cB + kstep, voffB); PG8_STAGE(PG8_SA(1, 0), cA + kstepA, voffA); PG8_STAGE(PG8_SB(1, 1), cB + hstepB + kstep, voffB);
    PG8_WAIT_V(6); PG8_BAR;
    for (;;) {
        const bool has_next = S.next(ui + 1, nxt);
        const char* nA = has_next ? (const char*)A + nxt.aoff : cA; const char* nB = has_next ? (const char*)Bt + nxt.boff : cB;
#pragma nounroll
        for (int t = 0; t < nt; t += 2) {
            const bool last = (t == nt - 2);
            const char* a1 = cA + (size_t)(t + 1) * kstepA;
            const char* a2 = last ? nA : cA + (size_t)(t + 2) * kstepA; const char* b2 = last ? nB : cB + (size_t)(t + 2) * kstep;
            const char* a3 = a2 + kstepA; const char* b3 = b2 + kstep;
            if (last && has_next) S.a_ready(nxt);
            PG8_LDB(B0, 0, 0); PG8_SCHED; PG8_LDA(At, 0, 0); PG8_STAGE(PG8_SA(1, 1), a1 + hstepA, voffA);
            PG8_WAIT_L(8); PG8_BAR; PG8_WAIT_L(0); PG8_MMA(0, 0, At, B0); PG8_BAR; PG8_SCHED;
            PG8_LDB(B1, 0, 1); PG8_STAGE(PG8_SB(0, 0), b2, voffB);
            PG8_BAR; PG8_WAIT_L(0); PG8_MMA(0, 1, At, B1); PG8_BAR;
            PG8_LDA(At, 0, 1); PG8_STAGE(PG8_SA(0, 0), a2, voffA);
            PG8_BAR; PG8_WAIT_L(0); PG8_MMA(1, 0, At, B0); PG8_BAR; PG8_SCHED;
            PG8_STAGE(PG8_SB(0, 1), b2 + hstepB, voffB);
            PG8_WAIT_V(6); PG8_BAR; PG8_MMA(1, 1, At, B1); PG8_BAR;
            PG8_LDB(B0, 1, 0); PG8_SCHED; PG8_LDA(At, 1, 0); PG8_STAGE(PG8_SA(0, 1), a2 + hstepA, voffA);
            PG8_WAIT_L(8); PG8_BAR; PG8_WAIT_L(0); PG8_MMA(0, 0, At, B0); PG8_BAR; PG8_SCHED;
            PG8_LDB(B1, 1, 1); PG8_STAGE(PG8_SB(1, 0), b3, voffB);
            PG8_BAR; PG8_WAIT_L(0); PG8_MMA(0, 1, At, B1); PG8_BAR;
            PG8_LDA(At, 1, 1); PG8_STAGE(PG8_SA(1, 0), a3, voffA);
            PG8_BAR; PG8_WAIT_L(0); PG8_MMA(1, 0, At, B0); PG8_BAR; PG8_SCHED;
            PG8_STAGE(PG8_SB(1, 1), b3 + hstepB, voffB);
            PG8_WAIT_V(6); PG8_BAR; PG8_MMA(1, 1, At, B1); PG8_BAR;
        }
#pragma unroll
        for (int ai = 0; ai < 2; ++ai)
#pragma unroll
            for (int m = 0; m < 4; ++m) { float lo[8], hi[8];
#pragma unroll
                for (int j = 0; j < 8; ++j) { lo[j] = acc[ai][0][m][j >> 2][j & 3]; hi[j] = acc[ai][1][m][j >> 2][j & 3]; }
                E.apply(cur, (long long)cur.pm * 256 + ai * HALF + wr * 64 + m * 16 + fr, wc * 32 + 8 * fq, lo, hi); PG8_SCHED; }
        S.done(cur);
        if (!has_next) break;
#pragma unroll
        for (int a = 0; a < 2; ++a)
#pragma unroll
            for (int b = 0; b < 2; ++b)
#pragma unroll
                for (int m = 0; m < 4; ++m)
#pragma unroll
                    for (int n = 0; n < 2; ++n) acc[a][b][m][n] = (f32x4){0.f, 0.f, 0.f, 0.f};
        cur = nxt; cA = nA; cB = nB; ++ui;
    }
    PG8_WAIT_V(0);
    if (wr == 0) PG8_BAR;
    PG8_BAR;
#undef PG8_SA
#undef PG8_SB
#undef PG8_STAGE
#undef PG8_LDA
#undef PG8_LDB
#undef PG8_MMA
#undef PG8_WAIT_V
#undef PG8_WAIT_L
#undef PG8_BAR
#undef PG8_SCHED
}

#define XB_TMO      128
#define XB_XCNT(j)  (256  + 64 * (j))
#define XB_XSUB(j)  (1280 + 64 * (j))
#define XB_XGEN(j)  (2304 + 64 * (j))
#define XB_TOP      3328
#define XB_TOPGEN   3392
#define XCD_BAR_WORDS 3456
#define XB_SPIN_CAP (1u << 18)
__device__ __forceinline__ unsigned xb_ld(unsigned* p)              { return __hip_atomic_load(p, __ATOMIC_RELAXED, __HIP_MEMORY_SCOPE_AGENT); }
__device__ __forceinline__ unsigned xb_add(unsigned* p, unsigned v) { return __hip_atomic_fetch_add(p, v, __ATOMIC_RELAXED, __HIP_MEMORY_SCOPE_AGENT); }
__device__ __forceinline__ unsigned xb_xcc_id() { return (unsigned)__builtin_amdgcn_s_getreg((3 << 11) | 20) & 0xFu; }
#define XB_SPIN(cond, bar) do { unsigned _sp = 0; while (cond) { __builtin_amdgcn_s_sleep(1); \
    if ((++_sp & 255u) == 0u) { if (xb_ld(&(bar)[XB_TMO])) break; if (_sp > XB_SPIN_CAP) { atomicAdd(&(bar)[XB_TMO], 1u); break; } } } } while (0)
struct XcdBarrier { unsigned* bar; unsigned x; volatile LAS unsigned* st; int wv; };
__device__ __forceinline__ XcdBarrier xcd_barrier_post(unsigned* bar, volatile LAS unsigned* st, int wv) {
    XcdBarrier b; b.bar = bar; b.x = xb_xcc_id(); b.st = st; b.wv = wv;
    if (wv == 0 && mk_lane() == 0) (void)xb_add(&bar[XB_XCNT(b.x)], 1u);
    return b;
}
__device__ __forceinline__ void xcd_barrier_complete(unsigned* bar, unsigned x, unsigned& nloc, unsigned& nx) {
    const unsigned G = gridDim.x * gridDim.y * gridDim.z;
    unsigned sum, cnt, mine, sp = 0u;
    for (;;) {
        sum = 0u; cnt = 0u; mine = 0u;
#pragma unroll
        for (unsigned j = 0; j < 16; ++j) { const unsigned c = xb_ld(&bar[XB_XCNT(j)]); sum += c; cnt += (c > 0u) ? 1u : 0u; mine = (j == x) ? c : mine; }
        if (sum == G) break;
        __builtin_amdgcn_s_sleep(1);
        if ((++sp & 255u) == 0u) { if (xb_ld(&bar[XB_TMO])) break; if (sp > XB_SPIN_CAP) { atomicAdd(&bar[XB_TMO], 1u); break; } }
    }
    nloc = mine > 0u ? mine : 1u; nx = cnt > 0u ? cnt : 1u;
}
__device__ __forceinline__ void xcd_barrier(const XcdBarrier& b) {
    asm volatile("s_waitcnt vmcnt(0)" ::: "memory");
    __syncthreads();
    if (b.wv == 0 && mk_lane() == 0) {
        unsigned* bar = b.bar;
        __builtin_amdgcn_s_waitcnt(0);
        unsigned nloc = b.st[0], nx = b.st[1];
        if (nloc == 0u) { xcd_barrier_complete(bar, b.x, nloc, nx); b.st[0] = nloc; b.st[1] = nx; }
        const unsigned old = xb_add(&bar[XB_XSUB(b.x)], 1u);
        const unsigned gen = old / nloc;
        if (old + 1u == (gen + 1u) * nloc) {
            __builtin_amdgcn_fence(__ATOMIC_RELEASE, "agent");
            asm volatile("s_waitcnt vmcnt(0)" ::: "memory");
            const unsigned og = xb_add(&bar[XB_TOP], 1u);
            const unsigned tg = og / nx;
            if (og + 1u == (tg + 1u) * nx) xb_add(&bar[XB_TOPGEN], 1u);
            else XB_SPIN(xb_ld(&bar[XB_TOPGEN]) == tg, bar);
            __builtin_amdgcn_fence(__ATOMIC_ACQUIRE, "agent");
            xb_add(&bar[XB_XGEN(b.x)], 1u);
            asm volatile("s_waitcnt vmcnt(0)" ::: "memory");
        } else {
            XB_SPIN(xb_ld(&bar[XB_XGEN(b.x)]) == gen, bar);
            __builtin_amdgcn_fence(__ATOMIC_ACQUIRE, "agent");
            asm volatile("s_waitcnt vmcnt(0)" ::: "memory");
        }
    }
    __syncthreads();
}
#endif
#ifndef CPU_EMU
typedef short bf16x8_t __attribute__((ext_vector_type(8)));
typedef short bf16x4_t __attribute__((ext_vector_type(4)));
typedef float f32x4_t __attribute__((ext_vector_type(4)));
typedef unsigned u32x4_t __attribute__((ext_vector_type(4)));
constexpr int AT_KS = 144, AT_VS = 136;
constexpr int AT_KBYTES = 64 * AT_KS, AT_VBYTES = 64 * AT_VS, AT_BUF = AT_KBYTES + AT_VBYTES;
struct AttnState { float m, l; f32x4_t o[4]; };
__device__ __forceinline__ void attn_init(AttnState& s) { s.m = -1e30f; s.l = 0.f;
#pragma unroll
    for (int d = 0; d < 4; ++d) s.o[d] = (f32x4_t){0.f, 0.f, 0.f, 0.f}; }
__device__ __forceinline__ unsigned pack2bf(float lo, float hi) { return (unsigned)f2bf(lo) | ((unsigned)f2bf(hi) << 16); }
template <class Valid> __device__ __forceinline__ void attn_tile(const LAS unsigned char* kt, const LAS unsigned char* vt, const bf16x8_t (&bq)[2], AttnState& st, int lane, const Valid& valid) {
    const int r = lane & 15, q = lane >> 4;
    f32x4_t s[4];
#pragma unroll
    for (int kb = 0; kb < 4; ++kb) { s[kb] = (f32x4_t){0.f, 0.f, 0.f, 0.f};
#pragma unroll
        for (int ks = 0; ks < 2; ++ks) { const bf16x8_t a = *(const LAS bf16x8_t*)(kt + (16 * kb + r) * AT_KS + (32 * ks + 8 * q) * 2); s[kb] = __builtin_amdgcn_mfma_f32_16x16x32_bf16(a, bq[ks], s[kb], 0, 0, 0); } }
    float mx = -1e30f;
#pragma unroll
    for (int kb = 0; kb < 4; ++kb)
#pragma unroll
        for (int j = 0; j < 4; ++j) { const float v = valid(kb, j) ? s[kb][j] * 1.44269504f : -1e30f; s[kb][j] = v; mx = fmaxf(mx, v); }
    mx = fmaxf(mx, __shfl_xor(mx, 16)); mx = fmaxf(mx, __shfl_xor(mx, 32));
    const float mn = fmaxf(st.m, mx), alpha = __builtin_amdgcn_exp2f(st.m - mn);
    float rs = 0.f;
#pragma unroll
    for (int kb = 0; kb < 4; ++kb)
#pragma unroll
        for (int j = 0; j < 4; ++j) { const float pv = s[kb][j] > -1e29f ? __builtin_amdgcn_exp2f(s[kb][j] - mn) : 0.f; s[kb][j] = pv; rs += pv; }
    rs += __shfl_xor(rs, 16); rs += __shfl_xor(rs, 32);
    st.l = st.l * alpha + rs; st.m = mn;
    bf16x8_t pb[2];
#pragma unroll
    for (int kk = 0; kk < 2; ++kk) { uint4 w; w.x = pack2bf(s[2 * kk][0], s[2 * kk][1]); w.y = pack2bf(s[2 * kk][2], s[2 * kk][3]); w.z = pack2bf(s[2 * kk + 1][0], s[2 * kk + 1][1]); w.w = pack2bf(s[2 * kk + 1][2], s[2 * kk + 1][3]);
        pb[kk] = __builtin_bit_cast(bf16x8_t, w); }
#pragma unroll
    for (int db = 0; db < 4; ++db) { st.o[db] = st.o[db] * alpha;
#pragma unroll
        for (int kk = 0; kk < 2; ++kk) { const LAS unsigned char* vp = vt + (16 * db + r) * AT_VS + (32 * kk + 4 * q) * 2;
            const bf16x4_t lo = *(const LAS bf16x4_t*)vp, hi = *(const LAS bf16x4_t*)(vp + 32);
            const bf16x8_t a = __builtin_shufflevector(lo, hi, 0, 1, 2, 3, 4, 5, 6, 7);
            st.o[db] = __builtin_amdgcn_mfma_f32_16x16x32_bf16(a, pb[kk], st.o[db], 0, 0, 0); } }
}
__device__ __forceinline__ void attn_stage_store(LAS unsigned char* buf, int tid, const uint4& kc, const uint4& vc) {
    const int key = tid >> 3, c = tid & 7;
    *(LAS u32x4_t*)(buf + key * AT_KS + c * 16) = (u32x4_t){kc.x, kc.y, kc.z, kc.w};
    LAS unsigned short* vt = (LAS unsigned short*)(buf + AT_KBYTES);
    const unsigned w[4] = {vc.x, vc.y, vc.z, vc.w};
#pragma unroll
    for (int i = 0; i < 4; ++i) { vt[((8 * c + 2 * i) * AT_VS) / 2 + key] = (unsigned short)(w[i] & 0xffffu); vt[((8 * c + 2 * i + 1) * AT_VS) / 2 + key] = (unsigned short)(w[i] >> 16); }
}
__device__ __forceinline__ void ph_selwin_mfma(const Params& p, int wv, LAS unsigned char* lds, int gC, int gG) {
    int tid = wv * 64 + mk_lane(); asm volatile("" : "+v"(tid));
    const int wid = tid >> 6, lane = tid & 63, r = lane & 15, q = lane >> 4;
    const bf16_t* P = WSP(bf16_t, p.oP); const unsigned* SELM = WSP(unsigned, p.oSELM); bf16_t* O = WSP(bf16_t, p.oO);
    const int nqb = (int)(p.S >> 6), units = (int)(p.B * 2) * nqb;
    for (int u = gC; u < units; u += gG) {
        const int cur = nqb - 1 - (u % nqb), bg = u / nqb, b = bg >> 1, g = bg & 1;
        const long long t0 = (long long)b * p.S + (long long)cur * 64;
        const int hd = 2 * g + (wid >> 2); const int tq = (wid & 3) * 16 + r; const long long tok = t0 + tq; const int sq = cur * 64 + tq;
        bf16x8_t bq[2];
#pragma unroll
        for (int ks = 0; ks < 2; ++ks) bq[ks] = *(const bf16x8_t*)(P + tok * PW + C_Q + hd * 64 + 32 * ks + 8 * q);
        unsigned un = SELM[(t0 + lane) * 2 + g];
#pragma unroll
        for (int o = 32; o > 0; o >>= 1) un |= __shfl_xor(un, o);
        un = __builtin_amdgcn_readfirstlane(un);
        const unsigned mymask = SELM[tok * 2 + g];
        const int wlo = cur - 8 > 0 ? cur - 8 : 0, nwin = cur - wlo + 1, nsel = __builtin_popcount(un), ntile = nwin + nsel;
        AttnState sw, ss; attn_init(sw); attn_init(ss);
        unsigned rem = un; int blk = wlo;
        uint4 kc, vc;
        { const long long kr = ((long long)b * p.S + (long long)blk * 64 + (tid >> 3)) * PW + g * 64 + (tid & 7) * 8; kc = *(const uint4*)(P + kr + C_KW); vc = *(const uint4*)(P + kr + C_VW); }
        attn_stage_store(lds, tid, kc, vc);
        __syncthreads();
        for (int i = 0; i < ntile; ++i) {
            const bool win = i < nwin; const int cb = blk;
            int nb = 0; bool nwinf = false; const bool has = i + 1 < ntile;
            if (has) { if (i + 1 < nwin) { nb = wlo + i + 1; nwinf = true; } else { nb = __builtin_ctz(rem); rem &= rem - 1; }
                const long long kr = ((long long)b * p.S + (long long)nb * 64 + (tid >> 3)) * PW + g * 64 + (tid & 7) * 8;
                kc = *(const uint4*)(P + kr + (nwinf ? C_KW : C_KS)); vc = *(const uint4*)(P + kr + (nwinf ? C_VW : C_VS)); }
            const LAS unsigned char* buf = lds + (i & 1) * AT_BUF;
            const int kbase = cb * 64 + 4 * q;
            if (win) attn_tile(buf, buf + AT_KBYTES, bq, sw, lane, [&](int kb, int j) { const int key = kbase + 16 * kb + j; return key <= sq && key > sq - 512; });
            else { const bool on = (mymask >> cb) & 1u; attn_tile(buf, buf + AT_KBYTES, bq, ss, lane, [&](int kb, int j) { const int key = kbase + 16 * kb + j; return on && key <= sq; }); }
            if (has) attn_stage_store(lds + ((i + 1) & 1) * AT_BUF, tid, kc, vc);
            blk = nb;
            __syncthreads();
        }
        const float g1 = sigmoidf_(bf2f(P[tok * PW + C_NG + hd * 3 + 1])) / ss.l, g2 = sigmoidf_(bf2f(P[tok * PW + C_NG + hd * 3 + 2])) / sw.l;
#pragma unroll
        for (int db = 0; db < 4; ++db) { bf16_t* od = O + tok * 1024 + hd * 64 + 16 * db + 4 * q; const uint2 pv = *(const uint2*)od;
            const float r0 = u2f(pv.x << 16) + g1 * ss.o[db][0] + g2 * sw.o[db][0], r1 = u2f(pv.x & 0xffff0000u) + g1 * ss.o[db][1] + g2 * sw.o[db][1];
            const float r2 = u2f(pv.y << 16) + g1 * ss.o[db][2] + g2 * sw.o[db][2], r3 = u2f(pv.y & 0xffff0000u) + g1 * ss.o[db][3] + g2 * sw.o[db][3];
            uint2 w; w.x = pack2bf(r0, r1); w.y = pack2bf(r2, r3); *(uint2*)od = w; }
    }
}
__device__ __forceinline__ void ph_ca_attn_mfma(const Params& p, int l, int wv, LAS unsigned char* lds, int gC, int gG) {
    int tid = wv * 64 + mk_lane(); asm volatile("" : "+v"(tid));
    const int wid = tid >> 6, lane = tid & 63, r = lane & 15, q = lane >> 4;
    const bf16_t* CQ = WSP(bf16_t, p.oCQ); const bf16_t* KV = WSP(bf16_t, p.oKV) + (long long)l * 512; bf16_t* AO = WSP(bf16_t, p.oCAO);
    const int nqb = (int)(p.S >> 7), units = (int)(p.B * 4) * nqb;
    for (int u = gC; u < units; u += gG) {
        const int qb = u % nqb, bh = u / nqb, b = bh >> 2, hd = bh & 3;
        const long long tok = (long long)b * p.S + (long long)qb * 128 + wid * 16 + r;
        bf16x8_t bq[2];
#pragma unroll
        for (int ks = 0; ks < 2; ++ks) bq[ks] = *(const bf16x8_t*)(CQ + tok * 256 + hd * 64 + 32 * ks + 8 * q);
        AttnState st; attn_init(st);
        uint4 kc, vc;
        { const long long kr = ((long long)b * 256 + (tid >> 3)) * 1024 + hd * 64 + (tid & 7) * 8; kc = *(const uint4*)(KV + kr); vc = *(const uint4*)(KV + kr + 256); }
        attn_stage_store(lds, tid, kc, vc);
        __syncthreads();
        for (int i = 0; i < 4; ++i) {
            if (i < 3) { const long long kr = ((long long)b * 256 + (i + 1) * 64 + (tid >> 3)) * 1024 + hd * 64 + (tid & 7) * 8; kc = *(const uint4*)(KV + kr); vc = *(const uint4*)(KV + kr + 256); }
            const LAS unsigned char* buf = lds + (i & 1) * AT_BUF;
            attn_tile(buf, buf + AT_KBYTES, bq, st, lane, [](int, int) { return true; });
            if (i < 3) attn_stage_store(lds + ((i + 1) & 1) * AT_BUF, tid, kc, vc);
            __syncthreads();
        }
        const float il = 1.0f / st.l;
#pragma unroll
        for (int db = 0; db < 4; ++db) { uint2 w; w.x = pack2bf(st.o[db][0] * il, st.o[db][1] * il); w.y = pack2bf(st.o[db][2] * il, st.o[db][3] * il); *(uint2*)(AO + tok * 256 + hd * 64 + 16 * db + 4 * q) = w; }
    }
}
#endif
#ifndef CPU_EMU
typedef float f32x2_t __attribute__((ext_vector_type(2)));
template <int CTRL> __device__ __forceinline__ float dpp_mov(float x) { return __builtin_bit_cast(float, __builtin_amdgcn_update_dpp(0, __builtin_bit_cast(int, x), CTRL, 0xF, 0xF, true)); }
__device__ __forceinline__ float sum8(float x) { x += dpp_mov<0xB1>(x); x += dpp_mov<0x4E>(x); x += dpp_mov<0x141>(x); return x; }
__device__ __forceinline__ float sum16s(float x) { x += __shfl_xor(x, 1); x += __shfl_xor(x, 2); x += __shfl_xor(x, 4); x += __shfl_xor(x, 8); return x; }
constexpr int SC_CH = 32;
constexpr int RW_STEP = 384, RW_BUF = SC_CH * RW_STEP * 4;
constexpr int GL_STEP = 160, GL_BUF = SC_CH * GL_STEP * 4;
__device__ __forceinline__ void cvt8(const uint4& w, float (&f)[8]) { f[0] = u2f(w.x << 16); f[1] = u2f(w.x & 0xffff0000u); f[2] = u2f(w.y << 16); f[3] = u2f(w.y & 0xffff0000u); f[4] = u2f(w.z << 16); f[5] = u2f(w.z & 0xffff0000u); f[6] = u2f(w.w << 16); f[7] = u2f(w.w & 0xffff0000u); }

__device__ __forceinline__ void rwkv_chain(const Params& p, int l, int ch, int wv, LAS unsigned char* lds) {
    int tid = wv * 64 + mk_lane(); asm volatile("" : "+v"(tid));
    const int row = tid >> 3, cg = tid & 7; const long long b = ch >> 2; const int h = ch & 3;
    const float* RWW = WSP(float, p.oRWW); const bf16_t* RWX = WSP(bf16_t, p.oRWX); bf16_t* O = WSP(bf16_t, p.oO); const float* lng = p.in[I_RW_LN] + l * 256 + h * 64; const float* rkw = p.in[I_RW_RK] + l * 256 + h * 64;
    LAS float* YB = (LAS float*)(lds + 2 * RW_BUF);
    const long long tb = b * p.S; const int nch = (int)(p.S / SC_CH);
    float4 gw;
    uint4 gx0, gx1, gx2;
#define RW_GLOAD1(idx_, dst_) do { const int idx = (idx_); if (idx < 1280) { const int step = idx / 40, rem = idx % 40, vec = rem >> 3, c8 = rem & 7; dst_ = *(const uint4*)(RWX + (t0_ + step) * 1280 + vec * 256 + h * 64 + 8 * c8); } } while (0)
#define RW_GLOAD(c_) do { const long long t0_ = tb + (long long)(c_) * SC_CH; gw = *(const float4*)(RWW + (t0_ + (tid >> 4)) * 256 + h * 64 + 4 * (tid & 15)); RW_GLOAD1(tid, gx0); RW_GLOAD1(tid + 512, gx1); RW_GLOAD1(tid + 1024, gx2); } while (0)
#define RW_SSTORE1(idx_, src_) do { const int idx = (idx_); if (idx < 1280) { const int step = idx / 40, rem = idx % 40, vec = rem >> 3, c8 = rem & 7; \
        const int slot = vec == 0 ? 4 : (vec == 1 ? 3 : (vec == 2 ? 5 : (vec == 3 ? 1 : 2))); float f[8]; cvt8(src_, f); LAS float* d = B_ + step * RW_STEP + slot * 64 + 8 * c8; \
        *(LAS f32x4_t*)d = (f32x4_t){f[0], f[1], f[2], f[3]}; *(LAS f32x4_t*)(d + 4) = (f32x4_t){f[4], f[5], f[6], f[7]}; } } while (0)
#define RW_SSTORE(buf_) do { LAS float* B_ = (LAS float*)(lds + (buf_) * RW_BUF); *(LAS f32x4_t*)(B_ + (tid >> 4) * RW_STEP + 4 * (tid & 15)) = (f32x4_t){gw.x, gw.y, gw.z, gw.w}; \
        RW_SSTORE1(tid, gx0); RW_SSTORE1(tid + 512, gx1); RW_SSTORE1(tid + 1024, gx2); } while (0)
    f32x2_t st[4];
#pragma unroll
    for (int i = 0; i < 4; ++i) st[i] = (f32x2_t){0.f, 0.f};
    RW_GLOAD(0); RW_SSTORE(0); __syncthreads();
    for (int c = 0; c < nch; ++c) {
        if (c + 1 < nch) RW_GLOAD(c + 1);
        const LAS float* B = (const LAS float*)(lds + (c & 1) * RW_BUF);
        for (int s = 0; s < SC_CH; ++s) { const LAS float* x = B + s * RW_STEP + 8 * cg;
            f32x2_t w[4], kk[4], bb[4], k[4], r[4];
#pragma unroll
            for (int i = 0; i < 2; ++i) { const f32x4_t a0 = *(const LAS f32x4_t*)(x + 4 * i), a1 = *(const LAS f32x4_t*)(x + 64 + 4 * i), a2 = *(const LAS f32x4_t*)(x + 128 + 4 * i), a3 = *(const LAS f32x4_t*)(x + 192 + 4 * i), a4 = *(const LAS f32x4_t*)(x + 256 + 4 * i);
                w[2 * i] = (f32x2_t){a0[0], a0[1]}; w[2 * i + 1] = (f32x2_t){a0[2], a0[3]}; kk[2 * i] = (f32x2_t){a1[0], a1[1]}; kk[2 * i + 1] = (f32x2_t){a1[2], a1[3]};
                bb[2 * i] = (f32x2_t){a2[0], a2[1]}; bb[2 * i + 1] = (f32x2_t){a2[2], a2[3]}; k[2 * i] = (f32x2_t){a3[0], a3[1]}; k[2 * i + 1] = (f32x2_t){a3[2], a3[3]};
                r[2 * i] = (f32x2_t){a4[0], a4[1]}; r[2 * i + 1] = (f32x2_t){a4[2], a4[3]}; }
            const float v = B[s * RW_STEP + 320 + row];
            f32x2_t a = st[0] * kk[0] + st[1] * kk[1]; a += st[2] * kk[2] + st[3] * kk[3];
            const float skk = sum8(a[0] + a[1]);
            f32x2_t y2 = (f32x2_t){0.f, 0.f};
#pragma unroll
            for (int i = 0; i < 4; ++i) { st[i] = st[i] * w[i] - bb[i] * skk + k[i] * v; y2 += st[i] * r[i]; }
            const float y = sum8(y2[0] + y2[1]);
            if (cg == 0) YB[s * 64 + row] = y; }
        __syncthreads();
        {
            const int s = tid >> 4, v0 = 4 * (tid & 15); const long long t = tb + (long long)c * SC_CH + s;
            const f32x4_t y = *(const LAS f32x4_t*)(YB + s * 64 + v0); const f32x4_t vv = *(const LAS f32x4_t*)(B + s * RW_STEP + 320 + v0);
            const float mean = sum16s(y[0] + y[1] + y[2] + y[3]) * (1.0f / 64.0f);
            const float d0 = y[0] - mean, d1 = y[1] - mean, d2 = y[2] - mean, d3 = y[3] - mean;
            const float var = sum16s(d0 * d0 + d1 * d1 + d2 * d2 + d3 * d3) * (1.0f / 64.0f), rstd = rsqrtf(var + 64e-5f);
            const f32x4_t rr = *(const LAS f32x4_t*)(B + s * RW_STEP + 256 + v0), kq = *(const LAS f32x4_t*)(B + s * RW_STEP + 192 + v0); const float4 rw4 = *(const float4*)(rkw + v0);
            const float rk = sum16s(rr[0] * kq[0] * rw4.x + rr[1] * kq[1] * rw4.y + rr[2] * kq[2] * rw4.z + rr[3] * kq[3] * rw4.w);
            bf16_t* o = O + t * 1024 + 512 + h * 64 + v0; const uint2 g = *(const uint2*)o; const float4 ln = *(const float4*)(lng + v0);
            const float r0 = (d0 * rstd * ln.x + rk * vv[0]) * u2f(g.x << 16), r1 = (d1 * rstd * ln.y + rk * vv[1]) * u2f(g.x & 0xffff0000u);
            const float r2 = (d2 * rstd * ln.z + rk * vv[2]) * u2f(g.y << 16), r3 = (d3 * rstd * ln.w + rk * vv[3]) * u2f(g.y & 0xffff0000u);
            uint2 w; w.x = pack2bf(r0, r1); w.y = pack2bf(r2, r3); *(uint2*)o = w; }
        if (c + 1 < nch) RW_SSTORE((c + 1) & 1);
        __syncthreads();
    }
}
__device__ __forceinline__ void gla_chain(const Params& p, int l, int ch, int wv, LAS unsigned char* lds) {
    int tid = wv * 64 + mk_lane(); asm volatile("" : "+v"(tid));
    const int vc = tid >> 3, kg = tid & 7; const long long b = ch >> 2; const int h = ch & 3;
    const bf16_t* P = WSP(bf16_t, p.oP); const float* GA = WSP(float, p.oGA); bf16_t* O = WSP(bf16_t, p.oO); const float* ng = p.in[I_GLA_NORM] + l * 64;
    LAS float* OB = (LAS float*)(lds + 2 * GL_BUF);
    const long long tb = b * p.S; const int nch = (int)(p.S / SC_CH);
    float4 ga; uint4 g1, g2;
#define GL_GLOAD(c_) do { const long long t0_ = tb + (long long)(c_) * SC_CH; \
        if (tid < 256) { const int step = tid >> 3, c4 = tid & 7; ga = *(const float4*)(GA + (t0_ + step) * 128 + h * 32 + 4 * c4); g1 = *(const uint4*)(P + (t0_ + step) * PW + C_GLA + 256 + h * 64 + 8 * c4); } \
        else { const int idx = tid - 256, step = idx >> 3, vec = (idx >> 2) & 1, c8 = idx & 3; g2 = *(const uint4*)(P + (t0_ + step) * PW + C_GLA + vec * 128 + h * 32 + 8 * c8); } } while (0)
#define GL_SSTORE(buf_) do { LAS float* B_ = (LAS float*)(lds + (buf_) * GL_BUF); float f[8]; \
        if (tid < 256) { const int step = tid >> 3, c4 = tid & 7; *(LAS f32x4_t*)(B_ + step * GL_STEP + 4 * c4) = (f32x4_t){ga.x, ga.y, ga.z, ga.w}; \
            cvt8(g1, f); LAS float* d = B_ + step * GL_STEP + 96 + 8 * c4; *(LAS f32x4_t*)d = (f32x4_t){f[0], f[1], f[2], f[3]}; *(LAS f32x4_t*)(d + 4) = (f32x4_t){f[4], f[5], f[6], f[7]}; } \
        else { const int idx = tid - 256, step = idx >> 3, vec = (idx >> 2) & 1, c8 = idx & 3; \
            cvt8(g2, f); LAS float* d = B_ + step * GL_STEP + (vec == 0 ? 64 : 32) + 8 * c8; *(LAS f32x4_t*)d = (f32x4_t){f[0], f[1], f[2], f[3]}; *(LAS f32x4_t*)(d + 4) = (f32x4_t){f[4], f[5], f[6], f[7]}; } } while (0)
    f32x4_t st = (f32x4_t){0.f, 0.f, 0.f, 0.f};
    GL_GLOAD(0); GL_SSTORE(0); __syncthreads();
    for (int c = 0; c < nch; ++c) {
        if (c + 1 < nch) GL_GLOAD(c + 1);
        const LAS float* B = (const LAS float*)(lds + (c & 1) * GL_BUF);
        for (int s = 0; s < SC_CH; ++s) { const LAS float* x = B + s * GL_STEP + 4 * kg;
            const f32x4_t a = *(const LAS f32x4_t*)x, k = *(const LAS f32x4_t*)(x + 32), qv = *(const LAS f32x4_t*)(x + 64); const float v = B[s * GL_STEP + 96 + vc];
            st = st * a + k * v; const f32x4_t pq = st * qv;
            const float o = sum8((pq[0] + pq[1]) + (pq[2] + pq[3]));
            if (kg == 0) OB[s * 64 + vc] = o * 0.17677669529663687f; }
        __syncthreads();
        {   const int s = tid >> 4, v0 = 4 * (tid & 15); const long long t = tb + (long long)c * SC_CH + s;
            const f32x4_t o = *(const LAS f32x4_t*)(OB + s * 64 + v0);
            const float ms = sum16s(o[0] * o[0] + o[1] * o[1] + o[2] * o[2] + o[3] * o[3]) * (1.0f / 64.0f), rs = rsqrtf(ms + 1e-6f);
            bf16_t* d = O + t * 1024 + 768 + h * 64 + v0; const uint2 g = *(const uint2*)d; const float4 n4 = *(const float4*)(ng + v0);
            uint2 w; w.x = pack2bf(o[0] * rs * n4.x * u2f(g.x << 16), o[1] * rs * n4.y * u2f(g.x & 0xffff0000u)); w.y = pack2bf(o[2] * rs * n4.z * u2f(g.y << 16), o[3] * rs * n4.w * u2f(g.y & 0xffff0000u)); *(uint2*)d = w; }
        if (c + 1 < nch) GL_SSTORE((c + 1) & 1);
        __syncthreads();
    }
}
__device__ __forceinline__ void ph_scans(const Params& p, int l, int wv, LAS unsigned char* lds, int gC, int gG) {
    const int nchain = (int)(p.B * 4);
    for (int it = gC; it < 2 * nchain; it += gG) { if (it < nchain) rwkv_chain(p, l, it, wv, lds); else gla_chain(p, l, it - nchain, wv, lds); }
}
#endif
#ifdef CPU_EMU
struct Ctx { long long gtid, gsz, gw, nw; int lane, G, c; };
#define GEMM(A, lda, Bt, ldb, K, S, E) gemm_cpu(A, lda, Bt, ldb, K, S, E)
#define GEMMK(A, lda, Bt, ldb, K, S, E, ks) gemm_cpu(A, lda, Bt, ldb, K, S, E, ks)
#define GRID_BARRIER() do { } while (0)
#else
struct Ctx { LAS unsigned char* lds; XcdBarrier bar; int wv; };
#define GEMM(A, lda, Bt, ldb, K, S, E) gemm_phase(cx.wv, cx.lds, A, lda, Bt, ldb, K, S, E)
#define GEMMK(A, lda, Bt, ldb, K, S, E, ks) gemm_phase(cx.wv, cx.lds, A, lda, Bt, ldb, K, S, E, ks)
#define GRID_BARRIER() xcd_barrier(cx.bar)
#endif
constexpr int N_PHASES = 56;
#ifndef PROBE_CONV
#define PROBE_CONV 1
#endif
#ifndef PROBE_PREP
#define PROBE_PREP 1
#endif
#ifndef PROBE_GEMM
#define PROBE_GEMM 1
#endif
#ifndef PROBE_CMP
#define PROBE_CMP 1
#endif

template <int KIND> DEVI void run_program(const Params& p, const Ctx& cx, int pb, int pe) {
    int ph = 0;
#define T p.T
#define DFF p.DFF
#ifdef CPU_EMU
    const long long gsz = cx.gsz, nw = cx.nw; const int gG = cx.G, gC = cx.c;
#else
#define gsz ((long long)gridDim.x * 512)
#define nw ((long long)gridDim.x * 8)
#define gG ((int)gridDim.x)
#define gC ((int)blockIdx.x)
#endif
#define H WSP(bf16_t, p.oH)
#define P WSP(bf16_t, p.oP)
#define O WSP(bf16_t, p.oO)
#define BO WSP(bf16_t, p.oBO)
#define MG WSP(bf16_t, p.oMG)
#define CQ WSP(bf16_t, p.oCQ)
#define CAO WSP(bf16_t, p.oCAO)
#define MEMN WSP(bf16_t, p.oMEMN)
#define ACT WSP(bf16_t, p.oACT)
#define WFFN WSP(bf16_t, p.oWFFN)
#ifdef CPU_EMU
#define OPAQUE_V(x) do { } while (0)
#define PH_IDX long long gtid = cx.gtid, gw = cx.gw; int lane = cx.lane
#else
#define OPAQUE_V(x) asm volatile("" : "+v"(x))
#define PH_IDX unsigned tx_ = (unsigned)(cx.wv * 64 + mk_lane()); OPAQUE_V(tx_); long long gtid = (long long)blockIdx.x * 512 + tx_, gw = (long long)(tx_ >> 6) * gridDim.x + blockIdx.x; int lane = tx_ & 63
#endif
#define PH_BEGIN(k) if (ph >= pb && ph < pe) { if constexpr (KIND < 0 || KIND == (k)) { PH_IDX; OPAQUE_V(gtid); OPAQUE_V(gw); OPAQUE_V(lane); (void)gtid; (void)gw; (void)lane;
#define PH_END   } if (ph + 1 < pe) GRID_BARRIER(); } ++ph;
    PH_BEGIN(0)
        for (int rep_ = 0; rep_ < PROBE_CONV; ++rep_) { ph_convert_layer(p, 0, gtid, gsz); ph_convert_layer(p, 1, gtid, gsz); ph_convert_ffn(p, gtid, gsz); ph_convert_cmp(p, gtid, gsz); } ph_rope(p, gtid, gsz);
        ph_rmsnorm(p, p.in[I_MEM], p.B * 256, p.in[I_MEM_NORM], MEMN, 0, nullptr, gw, nw, lane);
        ph_rmsnorm(p, p.in[I_X], T, p.in[I_NORM_MIX], H, 1, p.out, gw, nw, lane);
    PH_END
    PH_BEGIN(1)
        { SchedPlain S; S.init(p.B * 256, 1024, 1024, 1024, gG, gC); EpStore E{WSP(bf16_t, p.oKV), 1024, 1.0f}; GEMM(MEMN, 1024, WSP(bf16_t, p.oWKV), 1024, 1024, S, E); }
    PH_END
    for (int l = 0; l < 2; ++l) {
#define W WSP(bf16_t, p.oWL[l])
        PH_BEGIN(1) for (int rep_ = 0; rep_ < PROBE_GEMM; ++rep_) { SchedPlain S; S.init(T, 3072, 1024, 1024, gG, gC); EpStore E{P, 3072, 1.0f}; GEMM(H, 1024, W + W_IN, 1024, 1024, S, E); } PH_END
        PH_BEGIN(2) ph_rope_apply(p, gtid, gsz); { SchedCmp S; S.init(T / 16, gG, gC); EpUV E{WSP(bf16_t, p.oUV)}; GEMMK(P, 16LL * PW, WSP(bf16_t, p.oW1T) + (long long)l * 2 * 256 * 1024, 1024, 1024, S, E, (long long)PW); }
            ph_pool(p, l, gtid, gsz); ph_gla_prep(p, l, gtid, gsz);
#ifdef CPU_EMU
            { static bf16_t wl_[160 * 256]; rwkv_fill_wl(p, l, wl_, 0, 1); ph_rwkv_prep(p, l, wl_, gtid, gsz); }
#else
            { LDSQ bf16_t* wl_ = (LDSQ bf16_t*)cx.lds; rwkv_fill_wl(p, l, wl_, (int)tx_, 512); __syncthreads(); ph_rwkv_prep(p, l, wl_, gtid, gsz); }
#endif
#if PROBE_PREP == 2
            ph_pool(p, l, gtid, gsz);
#elif PROBE_PREP == 3
            ph_pool(p, l, gtid, gsz); ph_gla_prep(p, l, gtid, gsz);
#endif
 PH_END
        PH_BEGIN(3) ph_compress2(p, l, gtid, gsz); PH_END
#ifdef CPU_EMU
        PH_BEGIN(4) ph_rwkv_scan(p, l, gw, nw, lane); ph_gla_scan(p, l, (gw + nw - (p.B * 4) % nw) % nw, nw, lane); ph_cmp_attn(p, gtid, gsz); PH_END
#else
        PH_BEGIN(4) ph_scans(p, l, cx.wv, cx.lds, gC, gG); for (int rep_ = 0; rep_ < PROBE_CMP; ++rep_) ph_cmp_attn(p, gtid, gsz); PH_END
#endif
#ifdef CPU_EMU
        PH_BEGIN(5) ph_selwin(p, gtid, gsz); PH_END
#else
        PH_BEGIN(5) ph_selwin_mfma(p, cx.wv, cx.lds, gC, gG); PH_END
#endif
        for (int q = 0; q < 4; ++q) { const long long r0 = q * (T / 4);
            PH_BEGIN(6) { SchedBranch S; S.init(T / 4, gG, gC); EpStore E{BO, 4096, 1.0f}; GEMM(O + r0 * 1024, 1024, W + W_B, 256, 256, S, E); } PH_END
            PH_BEGIN(7) { SchedGate S; S.init(T / 4, gG, gC); EpGate E{BO, p.in[I_B_GATE] + l * 4096, MG, r0}; GEMM(H + r0 * 1024, 1024, W + W_G, 1024, 1024, S, E); } PH_END }
        PH_BEGIN(8) { SchedPlain S; S.init(T, 1024, 1024, 1024, gG, gC); EpResid E{p.out}; GEMM(MG, 1024, W + W_O, 1024, 1024, S, E); } PH_END
        PH_BEGIN(9) ph_rmsnorm(p, p.out, T, p.in[I_NORM_CA] + l * 1024, H, 0, nullptr, gw, nw, lane); PH_END
        PH_BEGIN(1) { SchedPlain S; S.init(T, 256, 1024, 1024, gG, gC); EpStore E{CQ, 256, 0.125f}; GEMM(H, 1024, W + W_CQ, 1024, 1024, S, E); } PH_END
#ifdef CPU_EMU
        PH_BEGIN(10) ph_ca_attn(p, l, gtid, gsz); PH_END
#else
        PH_BEGIN(10) ph_ca_attn_mfma(p, l, cx.wv, cx.lds, gC, gG); PH_END
#endif
        PH_BEGIN(8) { SchedPlain S; S.init(T, 1024, 256, 256, gG, gC); EpResid E{p.out}; GEMM(CAO, 256, W + W_CO, 256, 256, S, E); } PH_END
        PH_BEGIN(9) ph_rmsnorm(p, p.out, T, p.in[I_NORM_FFN] + l * 1024, H, l == 1 ? 2 : 0, nullptr, gw, nw, lane); if (l == 1) for (int rep_ = 0; rep_ < PROBE_CONV; ++rep_) ph_convert_moe(p, gtid, gsz); PH_END
        if (l == 0) {
            PH_BEGIN(11) { SchedPlain S; S.init(T, 2 * DFF, 1024, 1024, gG, gC); EpSwiglu E{ACT, DFF, 0}; GEMM(H, 1024, WFFN, 1024, 1024, S, E); } PH_END
            PH_BEGIN(8) { SchedPlain S; S.init(T, 1024, DFF, DFF, gG, gC); EpResid E{p.out}; GEMM(ACT, DFF, WFFN + 2 * DFF * 1024, DFF, DFF, S, E); } PH_END
            PH_BEGIN(9) ph_rmsnorm(p, p.out, T, p.in[I_NORM_MIX] + 1024, H, 0, nullptr, gw, nw, lane); PH_END
        } else {
            PH_BEGIN(12) ph_moe_count(p, gtid, gsz); PH_END
            PH_BEGIN(12) ph_moe_offsets(p, gtid, gsz); PH_END
            PH_BEGIN(12) ph_moe_assign(p, gtid, gsz); PH_END
            PH_BEGIN(12) ph_moe_gather(p, gtid, gsz); PH_END
#define HS WSP(bf16_t, p.oHS)
#define ACTC WSP(bf16_t, p.oACTC)
#define MW WSP(bf16_t, p.oMOEW)
#define MC WSP(int, p.oMOEC)
            const int ct = (int)((p.NR / 256 + 3) / 4);
            for (int q = 0; q < 4; ++q) {
                PH_BEGIN(13) { SchedMoe S; const int nt_ = MC[16 + 8] / 256; S.t0 = q * ct; S.t1 = (q + 1) * ct < nt_ ? (q + 1) * ct : nt_; if (S.t1 < S.t0) S.t1 = S.t0; S.nN = (int)(2 * DFF / 256); S.G = gG; S.c = gC; S.lda = 1024; S.ldb = 1024; S.per_e = 3 * 1024 * DFF * 2;
#pragma unroll
                    for (int e = 0; e < 9; ++e) S.base[e] = MC[16 + e];
                    EpSwiglu E{ACTC, DFF, (long long)S.t0 * 256}; GEMM(HS, 1024, MW, 1024, 1024, S, E); } PH_END
                PH_BEGIN(14) { SchedMoe S; const int nt_ = MC[16 + 8] / 256; S.t0 = q * ct; S.t1 = (q + 1) * ct < nt_ ? (q + 1) * ct : nt_; if (S.t1 < S.t0) S.t1 = S.t0; S.nN = 4; S.G = gG; S.c = gC; S.lda = DFF; S.ldb = DFF; S.per_e = 3 * 1024 * DFF * 2;
#pragma unroll
                    for (int e = 0; e < 9; ++e) S.base[e] = MC[16 + e];
                    EpMoeDown E{WSP(bf16_t, p.oY), WSP(float, p.oROWW)}; GEMM(ACTC - (long long)S.t0 * 256 * DFF, DFF, MW + 2 * DFF * 1024, DFF, DFF, S, E); } PH_END }
            PH_BEGIN(15) ph_final(p, gw, nw, lane); PH_END
        }
    }
#undef PH_BEGIN
#undef PH_END
#undef H
#undef P
#undef O
#undef BO
#undef MG
#undef CQ
#undef CAO
#undef MEMN
#undef ACT
#undef WFFN
#undef T
#undef DFF
#undef W
#undef HS
#undef ACTC
#undef MW
#undef MC
#ifndef CPU_EMU
#undef gsz
#undef nw
#undef gG
#undef gC
#endif
}

#ifndef CPU_EMU
template <int KIND> __global__ __launch_bounds__(512, 2) void mk_fwd(Params p, int pb, int pe) {
    extern __shared__ __attribute__((aligned(16))) unsigned char shm[];
    Ctx cx; cx.lds = (LAS unsigned char*)shm;
    volatile LAS unsigned* xbw = (volatile LAS unsigned*)(cx.lds + STAGE_BYTES);
    if (threadIdx.x == 0) { xbw[0] = 0u; xbw[1] = 0u; xbw[2] = 0u; xbw[3] = 0u; }
    __syncthreads();
    cx.wv = __builtin_amdgcn_readfirstlane((int)(threadIdx.x >> 6));
    cx.bar = xcd_barrier_post((unsigned*)(p.ws + p.oBAR), xbw, cx.wv);
    run_program<KIND>(p, cx, pb, pe);
}
#ifndef MK_ONE
#define MK_ONE 1
#endif
#if !MK_ONE
static const int kPhaseKind[N_PHASES] = { 0, 1,
    1, 2, 3, 4, 5, 6, 7, 6, 7, 6, 7, 6, 7, 8, 9, 1, 10, 8, 9, 11, 8, 9,
    1, 2, 3, 4, 5, 6, 7, 6, 7, 6, 7, 6, 7, 8, 9, 1, 10, 8, 9, 12, 12, 12, 12, 13, 14, 13, 14, 13, 14, 13, 14, 15 };
#endif
typedef void (*mk_fn)(Params, int, int);
extern "C" void kernel_launch(void* const* d_in, const int* in_sizes, int n_in, void* d_out, int out_size, void* d_ws, size_t ws_size, hipStream_t stream) {
    (void)in_sizes; (void)n_in; (void)out_size;
    Params p; memset(&p, 0, sizeof(p));
    for (int i = 0; i < N_INPUTS; ++i) p.in[i] = (const float*)d_in[i];
    p.out = (float*)d_out; p.ws = (unsigned char*)d_ws;
    make_layout(p, 32, 2048, 2816);
    for (int j = 0; j < 8; ++j) p.inv_freq[j] = (float)pow(500000.0, -(double)(2 * j) / 16.0);
    if ((size_t)p.wsNeed > ws_size) { fprintf(stderr, "workspace too small: need %lld have %zu\n", p.wsNeed, ws_size); return; }
    const size_t lds_bytes = STAGE_BYTES + 16;
#if MK_ONE
    static const mk_fn fns[1] = { mk_fwd<-1> }; const int nf = 1;
#else
    static const mk_fn fns[16] = { mk_fwd<0>, mk_fwd<1>, mk_fwd<2>, mk_fwd<3>, mk_fwd<4>, mk_fwd<5>, mk_fwd<6>, mk_fwd<7>, mk_fwd<8>, mk_fwd<9>, mk_fwd<10>, mk_fwd<11>, mk_fwd<12>, mk_fwd<13>, mk_fwd<14>, mk_fwd<15> }; const int nf = 16;
#endif
    static int grid = 0;
    if (!grid) { int dev = 0, cus = 0; (void)hipGetDevice(&dev); (void)hipDeviceGetAttribute(&cus, hipDeviceAttributeMultiprocessorCount, dev);
        for (int k = 0; k < nf; ++k) (void)hipFuncSetAttribute((const void*)fns[k], hipFuncAttributeMaxDynamicSharedMemorySize, (int)lds_bytes);
        int per_cu = 0; (void)hipOccupancyMaxActiveBlocksPerMultiprocessor(&per_cu, (const void*)fns[0], 512, lds_bytes); (void)hipGetLastError();
        grid = cus > 0 ? cus : 256; }
    (void)hipMemsetAsync(p.ws + p.oBAR, 0, 16384 + 4096, stream);
#if MK_ONE
    hipLaunchKernelGGL(fns[0], dim3(grid), dim3(512), lds_bytes, stream, p, 0, N_PHASES);
#else
    for (int ph = 0; ph < N_PHASES; ++ph) hipLaunchKernelGGL(fns[kPhaseKind[ph]], dim3(grid), dim3(512), lds_bytes, stream, p, ph, ph + 1);
#endif
}
#endif
```

```cpp
#ifndef CPU_EMU
#include <hip/hip_runtime.h>
#include <cstdio>
#include <cstdint>
#include <cstring>
#define DEVI __device__ __forceinline__
#define DEVM __device__ __forceinline__
#else
#include <cmath>
#include <cstdio>
#include <cstdint>
#include <cstring>
#include <cstdlib>
#define DEVI static inline
#define DEVM inline
struct uint4 { unsigned x, y, z, w; };
#endif

typedef unsigned short bf16_t;
#ifdef CPU_EMU
static inline float u2f(unsigned u) { float f; memcpy(&f, &u, 4); return f; }
static inline unsigned f2u(float f) { unsigned u; memcpy(&u, &f, 4); return u; }
#else
DEVI float u2f(unsigned u) { return __uint_as_float(u); }
DEVI unsigned f2u(float f) { return __float_as_uint(f); }
#endif
DEVI float bf2f(bf16_t b) { return u2f(((unsigned)b) << 16); }
DEVI bf16_t f2bf(float f) { unsigned u = f2u(f); u += 0x7FFFu + ((u >> 16) & 1u); return (bf16_t)(u >> 16); }
DEVI float sigmoidf_(float x) { return 1.0f / (1.0f + expf(-x)); }
DEVI float siluf_(float x) { return x / (1.0f + expf(-x)); }
DEVI float softplusf_(float x) { return x > 20.f ? x : log1pf(expf(x)); }
DEVI float gelu_tanhf_(float x) { return 0.5f * x * (1.0f + tanhf(0.7978845608028654f * (x + 0.044715f * x * x * x))); }

DEVI void st8(bf16_t* dst, const float* v) {
#ifndef CPU_EMU
    uint4 w; w.x = (unsigned)f2bf(v[0]) | ((unsigned)f2bf(v[1]) << 16); w.y = (unsigned)f2bf(v[2]) | ((unsigned)f2bf(v[3]) << 16); w.z = (unsigned)f2bf(v[4]) | ((unsigned)f2bf(v[5]) << 16); w.w = (unsigned)f2bf(v[6]) | ((unsigned)f2bf(v[7]) << 16);
    *(uint4*)dst = w;
#else
    for (int j = 0; j < 8; ++j) dst[j] = f2bf(v[j]);
#endif
}
DEVI void ld8(const bf16_t* src, float* v) {
#ifndef CPU_EMU
    const uint4 w = *(const uint4*)src; v[0] = u2f(w.x << 16); v[1] = u2f(w.x & 0xffff0000u); v[2] = u2f(w.y << 16); v[3] = u2f(w.y & 0xffff0000u); v[4] = u2f(w.z << 16); v[5] = u2f(w.z & 0xffff0000u); v[6] = u2f(w.w << 16); v[7] = u2f(w.w & 0xffff0000u);
#else
    for (int j = 0; j < 8; ++j) v[j] = bf2f(src[j]);
#endif
}
#ifdef CPU_EMU
#define SCHED_FENCE() do { } while (0)
#define LDSQ
DEVI void ld8l(const bf16_t* src, float* v) { ld8(src, v); }
#else
#define SCHED_FENCE() __builtin_amdgcn_sched_barrier(0)
#define LDSQ __attribute__((address_space(3)))
typedef unsigned u32x4l_t __attribute__((ext_vector_type(4)));
DEVI void ld8l(const LDSQ bf16_t* src, float* v) { const u32x4l_t w = *(const LDSQ u32x4l_t*)src; v[0] = u2f(w[0] << 16); v[1] = u2f(w[0] & 0xffff0000u); v[2] = u2f(w[1] << 16); v[3] = u2f(w[1] & 0xffff0000u);
    v[4] = u2f(w[2] << 16); v[5] = u2f(w[2] & 0xffff0000u); v[6] = u2f(w[3] << 16); v[7] = u2f(w[3] & 0xffff0000u); }
#endif
constexpr int DM = 1024;
constexpr int PW = 3072;
constexpr int INW = 2972;
constexpr int C_Q = 0, C_KC = 256, C_VC = 384, C_KS = 512, C_VS = 640, C_KW = 768, C_VW = 896, C_NG = 1024;
constexpr int C_POOL = 1040;
constexpr int C_RW = 1296;
constexpr int C_GLA = 2192;
constexpr int C_VRES = 2976;
constexpr int NCMPH = 128;

enum { I_X = 0, I_MEM, I_POS, I_NORM_MIX, I_W_IN, I_CMP_PE, I_CMP_W1, I_CMP_W2, I_POOL_W, I_POOL_SCALE, I_RW_MU, I_RW_W0, I_RW_W2, I_RW_A0, I_RW_A2, I_RW_G2,
       I_RW_V0, I_RW_V1, I_RW_V2, I_RW_KK, I_RW_KA, I_RW_RK, I_RW_LN, I_GLA_A2, I_GLA_AB, I_GLA_NORM, I_W_GATE, I_B_GATE, I_W_BRANCH, I_W_OUT, I_NORM_CA, I_MEM_NORM,
       I_CA_Q, I_CA_KV, I_CA_O, I_NORM_FFN, I_FFN_G, I_FFN_U, I_FFN_D, I_MOE_R, I_MOE_G, I_MOE_U, I_MOE_D, I_NORM_FINAL, N_INPUTS };

struct Params {
    const float* in[N_INPUTS];
    float* out;
    unsigned char* ws;
    long long B, S, T, DFF, NC, NR;
    float inv_freq[8];
    long long oBAR, oMOEC, oROPE, oKCMP, oVCMP, oUV, oW1T, oCB, oSELM, oKV, oTOKE, oTOKW, oTOKS, oR2T, oROWW, oCCNT, oCOFF;
    long long oWL[2], oWKV, oWFFN, oVF, oH, oP, oO, oBO, oMG, oRWW, oRWX, oGA, oCQ, oCAO, oMEMN, oACT, oY, oHS, oMOEW, oACTC, wsNeed;
};
constexpr long long W_IN = 0, W_G = W_IN + 3072LL * 1024, W_B = W_G + 4096LL * 1024, W_O = W_B + 4LL * 1024 * 256, W_CQ = W_O + 1024LL * 1024, W_CKV = W_CQ + 256LL * 1024,
                    W_CO = W_CKV + 512LL * 1024, W_LAYER = W_CO + 1024LL * 256;

static inline long long al256(long long x) { return (x + 255) & ~255LL; }
static inline void make_layout(Params& p, long long B, long long S, long long DFF) {
    p.B = B; p.S = S; p.T = B * S; p.DFF = DFF; p.NC = (S - 32) / 16 + 1; p.NR = 2 * p.T + 2048;
    const long long T = p.T;
    long long o = 0;
    auto take = [&](long long bytes) { long long r = o; o = al256(o + bytes); return r; };
    p.oBAR = take(16384); p.oMOEC = take(4096);
    p.oROPE = take(T * 16 * 4);
    p.oKCMP = take(B * p.NC * 128 * 4); p.oVCMP = take(B * p.NC * 128 * 4); p.oUV = take((T / 16) * 4 * 256 * 2); p.oW1T = take(2LL * 2 * 256 * 1024 * 2); p.oCB = take(2 * 2 * 128 * 4);
    p.oSELM = take(T * 2 * 4);
    p.oKV = take(2 * B * 256 * 512 * 2);
    p.oTOKE = take(T * 2 * 4); p.oTOKW = take(T * 2 * 4); p.oTOKS = take(T * 2 * 4); p.oR2T = take(p.NR * 4); p.oROWW = take(p.NR * 4);
    p.oCCNT = take((T / 64) * 8 * 4); p.oCOFF = take((T / 64) * 8 * 4);
    p.oWL[0] = take(W_LAYER * 2); p.oWL[1] = take(W_LAYER * 2); p.oWKV = take(2LL * 512 * 1024 * 2); p.oWFFN = take(3 * 1024 * DFF * 2);
    p.oVF = take(T * 256 * 2);
    p.oH = take(T * 1024 * 2);
    p.oP = take(T * 3072 * 2);
    p.oO = take(T * 1024 * 2);
    p.oBO = take(T * 2048);
    p.oMG = take(T * 2048);
    long long end_main = o;
    p.oRWW = p.oBO;
    p.oRWX = p.oRWW + T * 1024;
    p.oGA = p.oRWX + T * 2560;
    p.oCQ = p.oP; p.oCAO = p.oP + T * 512;
    p.oMEMN = p.oBO;
    p.oACT = p.oP;
    p.oY = p.oVF; long long q = al256(p.oY + p.NR * 2048);
    p.oHS = q; q = al256(q + p.NR * 2048);
    p.oMOEW = q; q = al256(q + 8LL * 3 * 1024 * DFF * 2);
    const long long ntmax = p.NR / 256, ct = (ntmax + 3) / 4;
    p.oACTC = q; q = al256(q + ct * 256 * DFF * 2);
    p.wsNeed = q > end_main ? q : end_main;
}
#define WSP(T_, off) ((T_*)(p.ws + (off)))

DEVI void cvt_T(bf16_t* dst, const float* src, long long K, long long N, long long Npad, long long ld, long long gtid, long long gsz) {
    for (long long i = gtid; i < Npad * K; i += gsz) { const long long n = i / K, k = i % K; dst[i] = n < N ? f2bf(src[k * ld + n]) : (bf16_t)0; }
}
DEVI void cvt_GU(bf16_t* dst, const float* wg, const float* wu, long long DFF, long long gtid, long long gsz) {
    for (long long i = gtid; i < 2 * DFF * 1024; i += gsz) { const long long rr = i / 1024, k = i % 1024, t = rr >> 8, w = rr & 255;
        dst[i] = f2bf((w < 128 ? wg : wu)[k * DFF + t * 128 + (w & 127)]); }
}
DEVI void ph_convert_layer(const Params& p, int l, long long gtid, long long gsz) {
    bf16_t* W = WSP(bf16_t, p.oWL[l]);
    for (long long i = gtid; i < 3072LL * 1024; i += gsz) { const long long n = i >> 10, k = i & 1023; float v = 0.f;
        if (n < 1036) v = p.in[I_W_IN][((long long)l * 1024 + k) * INW + n];
        else if (n >= C_POOL && n < C_VRES) v = p.in[I_W_IN][((long long)l * 1024 + k) * INW + n - 4];
        else if (n >= C_VRES && n < C_VRES + 32 && l == 1) v = p.in[I_RW_V1][k * 32 + (n - C_VRES)];
        W[W_IN + i] = f2bf(v); }
    for (int i = 0; i < 4; ++i) cvt_T(W + W_G + (long long)i * 1024 * 1024, p.in[I_W_GATE] + ((long long)l * 4 + i) * 1024 * 1024, 1024, 1024, 1024, 1024, gtid, gsz);
    for (int i = 0; i < 4; ++i) cvt_T(W + W_B + (long long)i * 1024 * 256, p.in[I_W_BRANCH] + ((long long)l * 4 + i) * 256 * 1024, 256, 1024, 1024, 1024, gtid, gsz);
    cvt_T(W + W_O, p.in[I_W_OUT] + (long long)l * 1024 * 1024, 1024, 1024, 1024, 1024, gtid, gsz);
    cvt_T(W + W_CQ, p.in[I_CA_Q] + (long long)l * 1024 * 256, 1024, 256, 256, 256, gtid, gsz);
    cvt_T(WSP(bf16_t, p.oWKV) + (long long)l * 512 * 1024, p.in[I_CA_KV] + (long long)l * 1024 * 512, 1024, 512, 512, 512, gtid, gsz);
    cvt_T(W + W_CO, p.in[I_CA_O] + (long long)l * 256 * 1024, 256, 1024, 1024, 1024, gtid, gsz);
}
DEVI void ph_convert_ffn(const Params& p, long long gtid, long long gsz) {
    bf16_t* W = WSP(bf16_t, p.oWFFN);
    cvt_GU(W, p.in[I_FFN_G], p.in[I_FFN_U], p.DFF, gtid, gsz);
    cvt_T(W + 2 * p.DFF * 1024, p.in[I_FFN_D], p.DFF, 1024, 1024, 1024, gtid, gsz);
}
DEVI void ph_convert_moe(const Params& p, long long gtid, long long gsz) {
    const long long DFF = p.DFF, per = 3 * 1024 * DFF;
    for (int e = 0; e < 8; ++e) { bf16_t* W = WSP(bf16_t, p.oMOEW) + e * per;
        cvt_GU(W, p.in[I_MOE_G] + (long long)e * 1024 * DFF, p.in[I_MOE_U] + (long long)e * 1024 * DFF, DFF, gtid, gsz);
        cvt_T(W + 2 * DFF * 1024, p.in[I_MOE_D] + (long long)e * DFF * 1024, DFF, 1024, 1024, 1024, gtid, gsz); }
}
DEVI void ph_rope(const Params& p, long long gtid, long long gsz) {
    const int* pos = (const int*)p.in[I_POS]; float* R = WSP(float, p.oROPE);
    for (long long i = gtid; i < p.T * 8; i += gsz) { const long long t = i >> 3; const int j = (int)(i & 7);
        const float ang = (float)pos[t] * p.inv_freq[j];
        double a = (double)ang; a -= 6.283185307179586476925 * floor(a * 0.15915494309189533577 + 0.5);
        const float ar = (float)a; R[t * 16 + j] = cosf(ar); R[t * 16 + 8 + j] = sinf(ar); }
}
DEVI void ph_rope_apply(const Params& p, long long gtid, long long gsz) {
    bf16_t* P = WSP(bf16_t, p.oP); const float* R = WSP(float, p.oROPE);
    for (long long i = gtid; i < p.T * 8; i += gsz) { const long long t = i >> 3; const int w = (int)(i & 7);
        const int col = w < 4 ? C_Q + w * 64 : (w < 6 ? C_KS + (w - 4) * 64 : C_KW + (w - 6) * 64);
        bf16_t* x = P + t * PW + col; const float* r = R + t * 16; const float sc = w < 4 ? 0.125f : 1.0f;
        for (int j = 0; j < 8; ++j) { const float a = bf2f(x[j]), b = bf2f(x[j + 8]), c = r[j], s = r[8 + j]; x[j] = f2bf((a * c - b * s) * sc); x[j + 8] = f2bf((b * c + a * s) * sc); }
        if (w < 4) for (int j = 16; j < 64; ++j) x[j] = f2bf(bf2f(x[j]) * 0.125f); }
}
DEVI void ph_compress2(const Params& p, int l, long long gtid, long long gsz) {
    const bf16_t* UV = WSP(bf16_t, p.oUV); const float* CB = WSP(float, p.oCB) + l * 256; const float* w2 = p.in[I_CMP_W2] + (long long)l * 2 * 128 * 64; const float* R = WSP(float, p.oROPE);
    float* KC = WSP(float, p.oKCMP); float* VC = WSP(float, p.oVCMP);
    const long long n_items = p.B * p.NC * 2 * 2 * 8, hb = p.S / 16;
    for (long long i = gtid; i < n_items; i += gsz) { const int d8 = (int)(i & 7), j = (int)((i >> 3) & 1), g = (int)((i >> 4) & 1); const long long bn = i >> 5, n = bn % p.NC, b = bn / p.NC;
        const bf16_t* u = UV + ((b * hb + n) * 4 + (2 * j + g)) * 256; const bf16_t* vv = u + 4 * 256 + 128; const float* w = w2 + (long long)j * 128 * 64; const float* cb = CB + j * 128;
        float a[8];
#pragma unroll
        for (int m = 0; m < 8; ++m) a[m] = 0.f;
        for (int f = 0; f < 128; ++f) { const float hv = gelu_tanhf_(bf2f(u[f]) + bf2f(vv[f]) + cb[f]);
#pragma unroll
            for (int m = 0; m < 8; ++m) a[m] += hv * w[f * 64 + d8 + 8 * m]; }
        if (j == 0) { const float* r = R + (b * p.S + n * 16 + 31) * 16; const float x0 = a[0], x1 = a[1], cs = r[d8], sn = r[8 + d8]; a[0] = x0 * cs - x1 * sn; a[1] = x1 * cs + x0 * sn; }
        float* dst = (j == 0 ? KC : VC) + (bn * 2 + g) * 64;
#pragma unroll
        for (int m = 0; m < 8; ++m) dst[d8 + 8 * m] = a[m]; }
}
DEVI void ph_convert_cmp(const Params& p, long long gtid, long long gsz) {
    bf16_t* W1T = WSP(bf16_t, p.oW1T); float* CB = WSP(float, p.oCB);
    for (long long i = gtid; i < 2LL * 2 * 256 * 1024; i += gsz) { const int k = (int)(i & 1023), n = (int)((i >> 10) & 255); const long long lj = i >> 18; const int half = n >> 7, f = n & 127, tap = k >> 6, d = k & 63;
        W1T[i] = f2bf(p.in[I_CMP_W1][((lj * 32 + half * 16 + tap) * 64 + d) * 128 + f]); }
    for (long long i = gtid; i < 2 * 2 * 128; i += gsz) { const int f = (int)(i & 127); const long long lj = i >> 7; float a = 0.f;
        for (int k = 0; k < 2048; ++k) a += p.in[I_CMP_PE][lj * 2048 + k] * p.in[I_CMP_W1][(lj * 2048 + k) * 128 + f];
        CB[i] = a; }
}
DEVI void ph_pool(const Params& p, int l, long long gtid, long long gsz) {
    const bf16_t* P = WSP(bf16_t, p.oP); bf16_t* O = WSP(bf16_t, p.oO);
    const float* pw = p.in[I_POOL_W] + (long long)l * 4 * 64 * 64; const float* ps = p.in[I_POOL_SCALE] + (long long)l * 256;
    for (long long i = gtid; i < p.T * 16; i += gsz) { const long long t = i >> 4; const int g = (int)((i >> 2) & 3), dq = (int)(i & 3); const long long s = t % p.S; const int win = 2 << g;
        const int cnt = (int)(s + 1 < win ? s + 1 : win); const float inv = 1.0f / (float)cnt;
        const float* w = pw + g * 64 * 64 + dq * 16; float a[16];
#pragma unroll
        for (int d = 0; d < 16; ++d) a[d] = 0.f;
        for (int c8 = 0; c8 < 8; ++c8) { float dv[8], f[8];
#pragma unroll
            for (int j = 0; j < 8; ++j) dv[j] = 0.f;
            for (int k = 0; k < cnt; ++k) { ld8(P + (t - k) * PW + C_POOL + g * 64 + 8 * c8, f);
#pragma unroll
                for (int j = 0; j < 8; ++j) dv[j] += f[j]; }
            ld8(P + t * PW + C_POOL + g * 64 + 8 * c8, f);
#pragma unroll
            for (int j = 0; j < 8; ++j) { dv[j] = dv[j] * inv - f[j];
#pragma unroll
                for (int d = 0; d < 16; ++d) a[d] += dv[j] * w[(8 * c8 + j) * 64 + d]; } }
#pragma unroll
        for (int d = 0; d < 16; ++d) a[d] *= ps[g * 64 + dq * 16 + d];
        st8(O + t * 1024 + 256 + g * 64 + dq * 16, a); st8(O + t * 1024 + 256 + g * 64 + dq * 16 + 8, a + 8); }
}
DEVI void st16bf(bf16_t* dst, const float (&v)[16]) { st8(dst, v); st8(dst + 8, v + 8); }
DEVI float pick8v(float a0, float a1, float a2, float a3, float a4, float a5, float a6, float a7, int i) {
    float r = a0; r = (i == 1) ? a1 : r; r = (i == 2) ? a2 : r; r = (i == 3) ? a3 : r; r = (i == 4) ? a4 : r; r = (i == 5) ? a5 : r; r = (i == 6) ? a6 : r; r = (i == 7) ? a7 : r; return r; }
#define pick8(a, i) pick8v((a)[0], (a)[1], (a)[2], (a)[3], (a)[4], (a)[5], (a)[6], (a)[7], (i))
DEVI void lerp8(const bf16_t* x, const bf16_t* xp, const float* mu, bool first, float* out) {
    float a[8], b[8]; ld8(x, a);
    if (first) {
#pragma unroll
        for (int j = 0; j < 8; ++j) b[j] = 0.f; } else ld8(xp, b);
#pragma unroll
    for (int j = 0; j < 8; ++j) out[j] = a[j] + (b[j] - a[j]) * mu[j];
}
DEVI void rwkv_fill_wl(const Params& p, int l, LDSQ bf16_t* wl, int tid, int nthr) {
    const float* w2 = p.in[I_RW_W2] + l * 32 * 256; const float* a2 = p.in[I_RW_A2] + l * 32 * 256; const float* g2 = p.in[I_RW_G2] + l * 64 * 256; const float* v2 = p.in[I_RW_V2];
    for (int i = tid; i < 160 * 256; i += nthr) { const int r = i >> 8, c = i & 255; float v;
        if (r < 32) v = w2[r * 256 + c]; else if (r < 64) v = a2[(r - 32) * 256 + c]; else if (r < 96) v = (l == 1) ? v2[(r - 64) * 256 + c] : 0.f; else v = g2[(r - 96) * 256 + c];
        wl[i] = f2bf(v); }
}
DEVI void ph_rwkv_prep(const Params& p, int l, const LDSQ bf16_t* wl, long long gtid, long long gsz) {
    const bf16_t* P = WSP(bf16_t, p.oP); float* RWW = WSP(float, p.oRWW); bf16_t* RWX = WSP(bf16_t, p.oRWX); bf16_t* O = WSP(bf16_t, p.oO); bf16_t* VF = WSP(bf16_t, p.oVF);
    const float* mu = p.in[I_RW_MU] + l * 896; const float* w0 = p.in[I_RW_W0] + l * 256; const float* a0 = p.in[I_RW_A0] + l * 256;
    const float* kkw = p.in[I_RW_KK] + l * 256; const float* kaw = p.in[I_RW_KA] + l * 256; const float* v0 = p.in[I_RW_V0];
    for (long long i = gtid; i < p.T * 16; i += gsz) { const long long t = i >> 4; const int h = (int)((i >> 2) & 3), cc = (int)(i & 3); const bool first = (t % p.S) == 0;
        const bf16_t* x = P + t * PW + C_RW; const bf16_t* xp = x - PW; const int c0 = h * 64 + cc * 16;
        float nn = 0.f;
#pragma nounroll
        for (int q8 = 0; q8 < 8; ++q8) { float kq[8]; lerp8(x + 256 + h * 64 + 8 * q8, xp + 256 + h * 64 + 8 * q8, mu + 256 + h * 64 + 8 * q8, first, kq);
#pragma unroll
            for (int j = 0; j < 8; ++j) { const float e = kq[j] * kkw[h * 64 + 8 * q8 + j]; nn += e * e; } }
        const float rn = 1.0f / fmaxf(sqrtf(nn), 1e-12f);
        float zw[16], za[16], zg[16], zv[16];
#pragma unroll
        for (int u = 0; u < 16; ++u) { zw[u] = w0[c0 + u]; za[u] = a0[c0 + u]; zg[u] = 0.f; zv[u] = (l == 1) ? v0[c0 + u] : 0.f; }
#pragma nounroll
        for (int j8 = 0; j8 < 4; ++j8) { float tw[8], ad[8], hv[8]; lerp8(x + 768 + 8 * j8, xp + 768 + 8 * j8, mu + 768 + 8 * j8, first, tw); lerp8(x + 800 + 8 * j8, xp + 800 + 8 * j8, mu + 800 + 8 * j8, first, ad);
            if (l == 1) ld8(P + t * PW + C_VRES + 8 * j8, hv); else {
#pragma unroll
                for (int jj = 0; jj < 8; ++jj) hv[jj] = 0.f; }
#pragma nounroll
            for (int jj = 0; jj < 8; ++jj) { const int j = 8 * j8 + jj; const float twv = tanhf(pick8(tw, jj)), adv = pick8(ad, jj), hvv = pick8(hv, jj); float ww[16], wa[16], wv[16];
                ld8l(wl + j * 256 + c0, ww); ld8l(wl + j * 256 + c0 + 8, ww + 8); ld8l(wl + (32 + j) * 256 + c0, wa); ld8l(wl + (32 + j) * 256 + c0 + 8, wa + 8);
                if (l == 1) { ld8l(wl + (64 + j) * 256 + c0, wv); ld8l(wl + (64 + j) * 256 + c0 + 8, wv + 8); }
#pragma unroll
                for (int u = 0; u < 16; ++u) { zw[u] += twv * ww[u]; za[u] += adv * wa[u]; if (l == 1) zv[u] += hvv * wv[u]; }
                SCHED_FENCE(); } }
#pragma nounroll
        for (int j8 = 0; j8 < 8; ++j8) { float gd[8]; lerp8(x + 832 + 8 * j8, xp + 832 + 8 * j8, mu + 832 + 8 * j8, first, gd);
#pragma nounroll
            for (int jj = 0; jj < 8; ++jj) { const int j = 8 * j8 + jj; const float sg = sigmoidf_(pick8(gd, jj)); float wg[16]; ld8l(wl + (96 + j) * 256 + c0, wg); ld8l(wl + (96 + j) * 256 + c0 + 8, wg + 8);
#pragma unroll
                for (int u = 0; u < 16; ++u) zg[u] += sg * wg[u];
                SCHED_FENCE(); } }
        st16bf(O + t * 1024 + 512 + c0, zg);
#pragma unroll
        for (int hf = 0; hf < 2; ++hf) { const int cb = c0 + 8 * hf; float r8[8], k8[8], v8[8], vf8[8], kk8[8], b8[8], d8[8];
            lerp8(x + cb, xp + cb, mu + cb, first, r8); lerp8(x + 256 + cb, xp + 256 + cb, mu + 256 + cb, first, k8); lerp8(x + 512 + cb, xp + 512 + cb, mu + 512 + cb, first, v8);
            if (l == 1) ld8(VF + t * 256 + cb, vf8);
#pragma unroll
            for (int u = 0; u < 8; ++u) { const int c = cb + u, uu = 8 * hf + u;
                const float wlog = -softplusf_(-zw[uu]) - 0.5f, dec = expf(-expf(wlog)), a = sigmoidf_(za[uu]);
                const float k = k8[u]; float v = v8[u];
                if (l == 1) v = v + (vf8[u] - v) * sigmoidf_(zv[uu]);
                const float kk = k * kkw[c] * rn;
                d8[u] = dec; k8[u] = k * (1.0f + (a - 1.0f) * kaw[c]); v8[u] = v; kk8[u] = kk; b8[u] = kk * a; }
            float* ww = RWW + t * 256 + cb;
#pragma unroll
            for (int u = 0; u < 8; ++u) ww[u] = d8[u];
            bf16_t* rx = RWX + t * 1280 + cb;
            st8(rx, r8); st8(rx + 256, k8); st8(rx + 512, v8); st8(rx + 768, kk8); st8(rx + 1024, b8);
            if (l == 0) st8(VF + t * 256 + cb, v8);
            SCHED_FENCE(); } }
}
DEVI float rwkv_row_step(float (&st)[64], const float* w, const bf16_t* r, const bf16_t* k, const bf16_t* kk, const bf16_t* b, float v) {
    float skk = 0.f;
#pragma unroll
    for (int c = 0; c < 64; ++c) skk += st[c] * bf2f(kk[c]);
    float y = 0.f;
#pragma unroll
    for (int c = 0; c < 64; ++c) { st[c] = st[c] * w[c] - skk * bf2f(b[c]) + v * bf2f(k[c]); y += st[c] * bf2f(r[c]); }
    return y;
}
DEVI void ph_gla_prep(const Params& p, int l, long long gtid, long long gsz) {
    const bf16_t* P = WSP(bf16_t, p.oP); float* GA = WSP(float, p.oGA); bf16_t* O = WSP(bf16_t, p.oO);
    const float* a2 = p.in[I_GLA_A2] + l * 16 * 128; const float* ab = p.in[I_GLA_AB] + l * 128;
    for (long long i = gtid; i < p.T * 128; i += gsz) { const long long t = i >> 7; const int c = (int)(i & 127); const bf16_t* ad = P + t * PW + C_GLA + 512;
        float z = ab[c];
        for (int j = 0; j < 16; ++j) z += bf2f(ad[j]) * a2[j * 128 + c];
        GA[i] = expf(-softplusf_(-z) * 0.0625f);
        const bf16_t* og = P + t * PW + C_GLA + 528; O[t * 1024 + 768 + c] = f2bf(siluf_(bf2f(og[c]))); O[t * 1024 + 768 + 128 + c] = f2bf(siluf_(bf2f(og[128 + c]))); }
}
DEVI float gla_col_step(float (&st)[32], const float* a, const bf16_t* q, const bf16_t* k, float v) {
    float o = 0.f;
#pragma unroll
    for (int c = 0; c < 32; ++c) { st[c] = st[c] * a[c] + bf2f(k[c]) * v; o += st[c] * bf2f(q[c]); }
    return o * 0.17677669529663687f;
}
DEVI void ph_cmp_attn(const Params& p, long long gtid, long long gsz) {
    const bf16_t* P = WSP(bf16_t, p.oP); const float* KC = WSP(float, p.oKCMP); const float* VC = WSP(float, p.oVCMP); unsigned* SELM = WSP(unsigned, p.oSELM); bf16_t* O = WSP(bf16_t, p.oO);
    for (long long i = gtid; i < p.T * 2; i += gsz) { const long long t = i >> 1, b = t / p.S, s = t % p.S; const int g = (int)(i & 1);
        const int nv = s >= 31 ? (int)((s - 31) / 16 + 1) : 0;
        const int cur = (int)(s >> 6);
        const float* kc = KC + (b * p.NC * 2 + g) * 64; const float* vc = VC + (b * p.NC * 2 + g) * 64;
        float q0[64], q1[64];
        { const bf16_t* q = P + t * PW + C_Q + (2 * g) * 64;
#pragma unroll
          for (int d = 0; d < 64; ++d) { q0[d] = bf2f(q[d]); q1[d] = bf2f(q[64 + d]); } }
        float m0 = -3e38f, m1 = -3e38f;
        for (int n = 0; n < nv; ++n) { const float* k = kc + n * 128; float s0 = 0.f, s1 = 0.f;
#pragma unroll
            for (int d = 0; d < 64; ++d) { s0 += q0[d] * k[d]; s1 += q1[d] * k[d]; }
            m0 = fmaxf(m0, s0); m1 = fmaxf(m1, s1); }
        float z0 = 0.f, z1 = 0.f;
        for (int n = 0; n < nv; ++n) { const float* k = kc + n * 128; float s0 = 0.f, s1 = 0.f;
#pragma unroll
            for (int d = 0; d < 64; ++d) { s0 += q0[d] * k[d]; s1 += q1[d] * k[d]; }
            z0 += expf(s0 - m0); z1 += expf(s1 - m1); }
        const float iz0 = nv ? 1.0f / z0 : 0.f, iz1 = nv ? 1.0f / z1 : 0.f;
        unsigned mask;
        if (cur < 8) mask = (2u << cur) - 1u;
        else {
            float tv0 = -3e38f, tv1 = -3e38f, tv2 = -3e38f, tv3 = -3e38f, tv4 = -3e38f; int ti0 = 0, ti1 = 0, ti2 = 0, ti3 = 0, ti4 = 0;
            float carry = 0.f;
            for (int j = 0; j <= cur - 2; ++j) { float imp = carry;
                for (int mm = 0; mm < 4; ++mm) { const int n = 4 * j + mm; float pn = 0.f;
                    if (n < nv) { const float* k = kc + n * 128; float s0 = 0.f, s1 = 0.f;
#pragma unroll
                        for (int d = 0; d < 64; ++d) { s0 += q0[d] * k[d]; s1 += q1[d] * k[d]; }
                        pn = expf(s0 - m0) * iz0 + expf(s1 - m1) * iz1; }
                    if (mm < 3) imp += pn; else { imp += 0.5f * pn; carry = 0.5f * pn; } }
                if (j >= 1) {
                    float v = imp; int id = j;
                    if (v > tv0) { float tf = tv0; tv0 = v; v = tf; int tt = ti0; ti0 = id; id = tt; }
                    if (v > tv1) { float tf = tv1; tv1 = v; v = tf; int tt = ti1; ti1 = id; id = tt; }
                    if (v > tv2) { float tf = tv2; tv2 = v; v = tf; int tt = ti2; ti2 = id; id = tt; }
                    if (v > tv3) { float tf = tv3; tv3 = v; v = tf; int tt = ti3; ti3 = id; id = tt; }
                    if (v > tv4) { tv4 = v; ti4 = id; } } }
            mask = 1u | (1u << cur) | (1u << (cur - 1)) | (1u << ti0) | (1u << ti1) | (1u << ti2) | (1u << ti3) | (1u << ti4);
        }
        SELM[i] = mask;
        for (int r = 0; r < 2; ++r) { const int hd = 2 * g + r; const float mr = r ? m1 : m0, izr = r ? iz1 : iz0;
            float o[64], qq[64];
            { const bf16_t* q = P + t * PW + C_Q + hd * 64;
#pragma unroll
              for (int d = 0; d < 64; ++d) { o[d] = 0.f; qq[d] = bf2f(q[d]); } }
            for (int n = 0; n < nv; ++n) { const float* k = kc + n * 128; const float* v = vc + n * 128; float sc = 0.f;
#pragma unroll
                for (int d = 0; d < 64; ++d) sc += qq[d] * k[d];
                const float pr = expf(sc - mr) * izr;
#pragma unroll
                for (int d = 0; d < 64; ++d) o[d] += pr * v[d]; }
            const float g0 = sigmoidf_(bf2f(P[t * PW + C_NG + hd * 3 + 0]));
#pragma unroll
            for (int d = 0; d < 64; ++d) O[t * 1024 + hd * 64 + d] = f2bf(g0 * o[d]); } }
}
DEVI void ph_selwin(const Params& p, long long gtid, long long gsz) {
    const bf16_t* P = WSP(bf16_t, p.oP); const unsigned* SELM = WSP(unsigned, p.oSELM); bf16_t* O = WSP(bf16_t, p.oO);
    for (long long i = gtid; i < p.T * 8; i += gsz) { const long long t = i >> 3, b = t / p.S, s = t % p.S; const int hd = (int)((i >> 1) & 3), g = hd >> 1, d0 = (int)(i & 1) * 32;
        unsigned qp[32]; float o[32];
        { const bf16_t* qq = P + t * PW + C_Q + hd * 64;
#pragma unroll
          for (int d = 0; d < 32; ++d) qp[d] = (unsigned)qq[2 * d] | ((unsigned)qq[2 * d + 1] << 16); }
        for (int pass = 0; pass < 2; ++pass) {
            const int ck = pass ? C_KW : C_KS, cv = pass ? C_VW : C_VS; const unsigned mask = SELM[t * 2 + g];
            float m = -3e38f, z = 0.f;
#pragma unroll
            for (int d = 0; d < 32; ++d) o[d] = 0.f;
            const long long lo = pass ? (s - 511 > 0 ? s - 511 : 0) : 0;
            for (long long kp = lo; kp <= s; ++kp) {
                if (!pass && !((mask >> (kp >> 6)) & 1u)) { kp |= 63; continue; }
                const bf16_t* k = P + (b * p.S + kp) * PW + ck + g * 64; const bf16_t* v = P + (b * p.S + kp) * PW + cv + g * 64 + d0; float sc = 0.f;
#pragma unroll
                for (int d = 0; d < 32; ++d) sc += u2f(qp[d] << 16) * bf2f(k[2 * d]) + u2f(qp[d] & 0xffff0000u) * bf2f(k[2 * d + 1]);
                if (sc > m) { const float f = expf(m - sc); z *= f;
#pragma unroll
                    for (int d = 0; d < 32; ++d) o[d] *= f;
                    m = sc; }
                const float pr = expf(sc - m); z += pr;
#pragma unroll
                for (int d = 0; d < 32; ++d) o[d] += pr * bf2f(v[d]); }
            const float gt = sigmoidf_(bf2f(P[t * PW + C_NG + hd * 3 + 1 + pass])) / z;
#pragma unroll
            for (int d = 0; d < 32; ++d) { bf16_t* od = O + t * 1024 + hd * 64 + d0 + d; *od = f2bf(bf2f(*od) + gt * o[d]); } } }
}
DEVI void ph_ca_attn(const Params& p, int l, long long gtid, long long gsz) {
    const bf16_t* CQ = WSP(bf16_t, p.oCQ); const bf16_t* KV = WSP(bf16_t, p.oKV) + (long long)l * 512; bf16_t* AO = WSP(bf16_t, p.oCAO);
    for (long long i = gtid; i < p.T * 4; i += gsz) { const long long t = i >> 2, b = t / p.S; const int hd = (int)(i & 3);
        float q[64], o[64];
#pragma unroll
        for (int d = 0; d < 64; ++d) { q[d] = bf2f(CQ[t * 256 + hd * 64 + d]); o[d] = 0.f; }
        float m = -3e38f, z = 0.f;
        for (int kp = 0; kp < 256; ++kp) { const bf16_t* k = KV + (b * 256 + kp) * 1024 + hd * 64; const bf16_t* v = k + 256; float sc = 0.f;
#pragma unroll
            for (int d = 0; d < 64; ++d) sc += q[d] * bf2f(k[d]);
            if (sc > m) { const float f = expf(m - sc); z *= f;
#pragma unroll
                for (int d = 0; d < 64; ++d) o[d] *= f;
                m = sc; }
            const float pr = expf(sc - m); z += pr;
#pragma unroll
            for (int d = 0; d < 64; ++d) o[d] += pr * bf2f(v[d]); }
        const float iz = 1.0f / z;
#pragma unroll
        for (int d = 0; d < 64; ++d) AO[t * 256 + hd * 64 + d] = f2bf(o[d] * iz); }
}
DEVI void ph_moe_count(const Params& p, long long gtid, long long gsz) {
    const int* TE = WSP(int, p.oTOKE); int* CC = WSP(int, p.oCCNT); int* R2T = WSP(int, p.oR2T);
    for (long long c = gtid; c < p.T / 64; c += gsz) { int cnt[8] = {0, 0, 0, 0, 0, 0, 0, 0};
        for (int j = 0; j < 128; ++j) { const int e = TE[c * 128 + j];
#pragma unroll
            for (int q = 0; q < 8; ++q) cnt[q] += (e == q); }
#pragma unroll
        for (int q = 0; q < 8; ++q) CC[c * 8 + q] = cnt[q]; }
    for (long long i = gtid; i < p.NR; i += gsz) R2T[i] = -1;
}
DEVI void ph_moe_offsets(const Params& p, long long gtid, long long gsz) {
    const int* CC = WSP(int, p.oCCNT); int* CO = WSP(int, p.oCOFF); int* MC = WSP(int, p.oMOEC);
    for (long long ee = gtid; ee < 8; ee += gsz) { const int e = (int)ee; int run = 0; for (long long c = 0; c < p.T / 64; ++c) { CO[c * 8 + e] = run; run += CC[c * 8 + e]; } MC[e] = run; }
}
DEVI void moe_bases(const Params& p, int (&base)[9]) { const int* MC = WSP(int, p.oMOEC); int run = 0;
#pragma unroll
    for (int e = 0; e < 8; ++e) { base[e] = run; run += (MC[e] + 255) & ~255; } base[8] = run; }
DEVI void ph_moe_assign(const Params& p, long long gtid, long long gsz) {
    const int* TE = WSP(int, p.oTOKE); const float* TW = WSP(float, p.oTOKW); const int* CO = WSP(int, p.oCOFF); int* TS = WSP(int, p.oTOKS); int* R2T = WSP(int, p.oR2T); float* RW = WSP(float, p.oROWW);
    int base[9]; moe_bases(p, base);
    if (gtid == 0) { int* MC = WSP(int, p.oMOEC);
#pragma unroll
        for (int e = 0; e < 9; ++e) MC[16 + e] = base[e]; }
    for (long long c = gtid; c < p.T / 64; c += gsz) { int run[8];
#pragma unroll
        for (int q = 0; q < 8; ++q) run[q] = base[q] + CO[c * 8 + q];
        for (int j = 0; j < 128; ++j) { const int e = TE[c * 128 + j]; int slot = 0;
#pragma unroll
            for (int q = 0; q < 8; ++q) if (e == q) { slot = run[q]; run[q] += 1; }
            TS[c * 128 + j] = slot; R2T[slot] = (int)(c * 64 + (j >> 1)); RW[slot] = TW[c * 128 + j]; } }
}
DEVI void ph_moe_gather(const Params& p, long long gtid, long long gsz) {
    const int* R2T = WSP(int, p.oR2T); const int* MC = WSP(int, p.oMOEC); const uint4* H = WSP(uint4, p.oH); uint4* HS = WSP(uint4, p.oHS);
    const long long rows = MC[16 + 8];
    for (long long i = gtid; i < rows * 128; i += gsz) { const long long r = i >> 7; const int j = (int)(i & 127); const int t = R2T[r];
        uint4 v; v.x = v.y = v.z = v.w = 0u; if (t >= 0) v = H[(long long)t * 128 + j]; HS[i] = v; }
}
struct Unit { int pm, pn, aux, pad; long long aoff, boff; };
constexpr int NXCD = 8, WGM = 8;
DEVI void tile_order(long long L, int nM, int nN, int& pm, int& pn) {
    const int nwg = nM * nN; int wgid = (int)L; { const int q = nwg / NXCD, r = nwg % NXCD, xcd = wgid % NXCD, off = wgid / NXCD; wgid = (xcd < r ? xcd * (q + 1) : r * (q + 1) + (xcd - r) * q) + off; }
    const int nig = WGM * nN, gid = wgid / nig, fm = gid * WGM, gsz = (nM - fm) < WGM ? (nM - fm) : WGM;
    pm = fm + ((wgid % nig) % gsz); pn = (wgid % nig) / gsz;
}
struct SchedPlain {
    int nM, nN, G, c; long long lda, ldb;
    DEVM void init(long long M, long long N, long long lda_, long long ldb_, int G_, int c_) { nM = (int)(M / 256); nN = (int)(N / 256); lda = lda_; ldb = ldb_; G = G_; c = c_; }
    DEVM bool next(int i, Unit& u) const { const long long L = (long long)i * G + c; if (L >= (long long)nM * nN) return false; tile_order(L, nM, nN, u.pm, u.pn); u.aux = 0; u.pad = 0;
        u.aoff = (long long)u.pm * 256 * lda * 2; u.boff = (long long)u.pn * 256 * ldb * 2; return true; }
    DEVM void a_ready(const Unit&) const {}
    DEVM void done(const Unit&) const {}
};
struct SchedBranch {
    int nM, G, c;
    DEVM void init(long long M, int G_, int c_) { nM = (int)(M / 256); G = G_; c = c_; }
    DEVM bool next(int i, Unit& u) const { const long long L = (long long)i * G + c; if (L >= (long long)nM * 16) return false; tile_order(L, nM, 16, u.pm, u.pn); u.aux = u.pn >> 2; u.pad = 0;
        u.aoff = (long long)u.pm * 256 * 1024 * 2 + (long long)u.aux * 256 * 2; u.boff = (long long)u.pn * 256 * 256 * 2; return true; }
    DEVM void a_ready(const Unit&) const {}
    DEVM void done(const Unit&) const {}
};
struct SchedGate {
    int nM, G, c;
    DEVM void init(long long M, int G_, int c_) { nM = (int)(M / 256); G = G_; c = c_; }
    DEVM bool next(int i, Unit& u) const { const long long tile = (long long)(i >> 2) * G + c; if (tile >= (long long)nM * 4) return false; tile_order(tile, nM, 4, u.pm, u.pn); u.aux = i & 3; u.pad = 0;
        u.aoff = (long long)u.pm * 256 * 1024 * 2; u.boff = (long long)(u.aux * 4 + u.pn) * 256 * 1024 * 2; return true; }
    DEVM void a_ready(const Unit&) const {}
    DEVM void done(const Unit&) const {}
};
struct SchedMoe {
    int t0, t1, nN, G, c; long long lda, ldb, per_e; int base[9];
    DEVM bool next(int i, Unit& u) const { const long long L = (long long)i * G + c; if (L >= (long long)(t1 - t0) * nN) return false; u.pm = t0 + (int)(L / nN); u.pn = (int)(L % nN); u.pad = 0;
        int e = 0;
#pragma unroll
        for (int q = 1; q < 8; ++q) e += (u.pm * 256 >= base[q]) ? 1 : 0;
        u.aux = e; u.aoff = (long long)u.pm * 256 * lda * 2; u.boff = (long long)e * per_e + (long long)u.pn * 256 * ldb * 2; return true; }
    DEVM void a_ready(const Unit&) const {}
    DEVM void done(const Unit&) const {}
};
struct SchedCmp {
    int nM, G, c;
    DEVM void init(long long rows, int G_, int c_) { nM = (int)(rows / 256); G = G_; c = c_; }
    DEVM bool next(int i, Unit& u) const { const long long L = (long long)i * G + c; if (L >= (long long)nM * 4) return false; const int combo = (int)(L / nM); u.pm = (int)(L % nM); u.pn = 0; u.aux = combo; u.pad = 0;
        u.aoff = (long long)u.pm * 256 * 16 * PW * 2 + (long long)(((combo >> 1) ? C_VC : C_KC) + (combo & 1) * 64) * 2; u.boff = (long long)(combo >> 1) * 256 * 1024 * 2; return true; }
    DEVM void a_ready(const Unit&) const {}
    DEVM void done(const Unit&) const {}
};
struct EpStore {
    bf16_t* O; long long ldo; float scale;
    DEVM void apply(const Unit& u, long long row, int c8, const float* lo, const float* hi) const { float a[8], b[8];
#pragma unroll
        for (int j = 0; j < 8; ++j) { a[j] = lo[j] * scale; b[j] = hi[j] * scale; }
        bf16_t* d = O + row * ldo + u.pn * 256 + c8; st8(d, a); st8(d + 128, b); }
};
struct EpUV {
    bf16_t* UV;
    DEVM void apply(const Unit& u, long long row, int c8, const float* lo, const float* hi) const { bf16_t* d = UV + (row * 4 + u.aux) * 256 + c8; st8(d, lo); st8(d + 128, hi); }
};
struct EpGate {
    const bf16_t* BO; const float* bias; bf16_t* MG; long long row0;
    DEVM void apply(const Unit& u, long long row, int c8, const float* lo, const float* hi) const {
#pragma unroll
        for (int hh = 0; hh < 2; ++hh) { const float* v = hh ? hi : lo; const int c = u.pn * 256 + hh * 128 + c8, n = u.aux * 1024 + c; float bo[8], mg[8], r[8]; ld8(BO + row * 4096 + n, bo);
            bf16_t* m = MG + (row0 + row) * 1024 + c;
            if (u.aux) ld8(m, mg);
#pragma unroll
            for (int j = 0; j < 8; ++j) { r[j] = sigmoidf_(v[j] + bias[n + j]) * bo[j]; if (u.aux) r[j] += mg[j]; }
            st8(m, r); } }
};
struct EpResid {
    float* X;
    DEVM void apply(const Unit& u, long long row, int c8, const float* lo, const float* hi) const { float* x = X + row * 1024 + u.pn * 256 + c8;
#ifndef CPU_EMU
        float4 a = *(float4*)x, b = *(float4*)(x + 4), c = *(float4*)(x + 128), d = *(float4*)(x + 132);
        a.x += lo[0]; a.y += lo[1]; a.z += lo[2]; a.w += lo[3]; b.x += lo[4]; b.y += lo[5]; b.z += lo[6]; b.w += lo[7];
        c.x += hi[0]; c.y += hi[1]; c.z += hi[2]; c.w += hi[3]; d.x += hi[4]; d.y += hi[5]; d.z += hi[6]; d.w += hi[7];
        *(float4*)x = a; *(float4*)(x + 4) = b; *(float4*)(x + 128) = c; *(float4*)(x + 132) = d;
#else
        for (int j = 0; j < 8; ++j) { x[j] += lo[j]; x[128 + j] += hi[j]; }
#endif
    }
};
struct EpSwiglu {
    bf16_t* ACT; long long ldo; long long row0;
    DEVM void apply(const Unit& u, long long row, int c8, const float* lo, const float* hi) const { float r[8];
#pragma unroll
        for (int j = 0; j < 8; ++j) r[j] = siluf_(lo[j]) * hi[j];
        st8(ACT + (row - row0) * ldo + u.pn * 128 + c8, r); }
};
struct EpMoeDown {
    bf16_t* Y; const float* roww;
    DEVM void apply(const Unit& u, long long row, int c8, const float* lo, const float* hi) const { const float w = roww[row]; float a[8], b[8];
#pragma unroll
        for (int j = 0; j < 8; ++j) { a[j] = lo[j] * w; b[j] = hi[j] * w; }
        bf16_t* d = Y + row * 1024 + u.pn * 256 + c8; st8(d, a); st8(d + 128, b); }
};

#ifdef CPU_EMU
template <class Sched, class Epi> static void gemm_cpu(const bf16_t* A, long long lda, const bf16_t* Bt, long long ldb, long long K, const Sched& S, const Epi& E, long long kstepA = 64) {
    Unit u;
    for (int i = 0; S.next(i, u); ++i) {
        const bf16_t* a0 = (const bf16_t*)((const char*)A + u.aoff); const bf16_t* b0 = (const bf16_t*)((const char*)Bt + u.boff);
#pragma omp parallel for
        for (int r = 0; r < 256; ++r) { float arow[4096]; for (long long k = 0; k < K; ++k) arow[k] = bf2f(a0[r * lda + (k >> 6) * kstepA + (k & 63)]);
            for (int c8 = 0; c8 < 128; c8 += 8) { float lo[8], hi[8];
                for (int j = 0; j < 8; ++j) { const bf16_t* bl = b0 + (c8 + j) * ldb; const bf16_t* bh = b0 + (128 + c8 + j) * ldb; float s0 = 0.f, s1 = 0.f;
                    for (long long k = 0; k < K; ++k) { s0 += arow[k] * bf2f(bl[k]); s1 += arow[k] * bf2f(bh[k]); } lo[j] = s0; hi[j] = s1; }
                E.apply(u, (long long)u.pm * 256 + r, c8, lo, hi); } } }
}
#endif

#ifndef CPU_EMU
DEVI float wave_sum(float v) {
#pragma unroll
    for (int o = 32; o > 0; o >>= 1) v += __shfl_xor(v, o);
    return v; }
DEVI void row_load(const float* src, float (&v)[16], int lane) {
#pragma unroll
    for (int j = 0; j < 4; ++j) { const float4 f = *(const float4*)(src + j * 256 + lane * 4); v[4 * j] = f.x; v[4 * j + 1] = f.y; v[4 * j + 2] = f.z; v[4 * j + 3] = f.w; } }
DEVI void row_store_bf16(bf16_t* dst, const float (&v)[16], int lane) {
#pragma unroll
    for (int j = 0; j < 4; ++j) { uint2 w; w.x = (unsigned)f2bf(v[4 * j]) | ((unsigned)f2bf(v[4 * j + 1]) << 16); w.y = (unsigned)f2bf(v[4 * j + 2]) | ((unsigned)f2bf(v[4 * j + 3]) << 16); *(uint2*)(dst + j * 256 + lane * 4) = w; } }
#endif
DEVI void ph_rmsnorm(const Params& p, const float* src, long long rows, const float* gain, bf16_t* dst, int mode, float* xcopy, long long gw, long long nw, int lane) {
    const float* router = p.in[I_MOE_R]; int* TE = WSP(int, p.oTOKE); float* TW = WSP(float, p.oTOKW);
#ifndef CPU_EMU
    for (long long r = gw; r < rows; r += nw) { float v[16], g[16]; row_load(src + r * 1024, v, lane); row_load(gain, g, lane);
        float ss = 0.f;
#pragma unroll
        for (int j = 0; j < 16; ++j) ss += v[j] * v[j];
        ss = wave_sum(ss); const float rs = rsqrtf(ss * (1.0f / 1024.0f) + 1e-6f);
        if (mode == 1) {
#pragma unroll
            for (int j = 0; j < 4; ++j) *(float4*)(xcopy + r * 1024 + j * 256 + lane * 4) = make_float4(v[4 * j], v[4 * j + 1], v[4 * j + 2], v[4 * j + 3]); }
#pragma unroll
        for (int j = 0; j < 16; ++j) v[j] = v[j] * rs * g[j];
        row_store_bf16(dst + r * 1024, v, lane);
        if (mode == 2) { float lg[8];
#pragma unroll
            for (int e = 0; e < 8; ++e) { float a = 0.f;
#pragma unroll
                for (int j = 0; j < 16; ++j) a += v[j] * router[(long long)((j >> 2) * 256 + lane * 4 + (j & 3)) * 8 + e];
                lg[e] = wave_sum(a); }
            int i0 = 0; float v0 = lg[0];
#pragma unroll
            for (int e = 1; e < 8; ++e) if (lg[e] > v0) { v0 = lg[e]; i0 = e; }
            int i1 = -1; float v1 = -3e38f;
#pragma unroll
            for (int e = 0; e < 8; ++e) if (e != i0 && lg[e] > v1) { v1 = lg[e]; i1 = e; }
            const float w0 = 1.0f / (1.0f + expf(v1 - v0));
            if (lane == 0) { TE[r * 2] = i0; TE[r * 2 + 1] = i1; TW[r * 2] = w0; TW[r * 2 + 1] = 1.0f - w0; } } }
#else
    (void)lane;
    for (long long r = gw; r < rows; r += nw) { const float* x = src + r * 1024; float ss = 0.f; for (int c = 0; c < 1024; ++c) ss += x[c] * x[c];
        const float rs = 1.0f / sqrtf(ss / 1024.0f + 1e-6f); float hv[1024];
        for (int c = 0; c < 1024; ++c) { hv[c] = x[c] * rs * gain[c]; dst[r * 1024 + c] = f2bf(hv[c]); if (mode == 1) xcopy[r * 1024 + c] = x[c]; }
        if (mode == 2) { float lg[8]; for (int e = 0; e < 8; ++e) { float a = 0.f; for (int c = 0; c < 1024; ++c) a += hv[c] * router[c * 8 + e]; lg[e] = a; }
            int i0 = 0; float v0 = lg[0]; for (int e = 1; e < 8; ++e) if (lg[e] > v0) { v0 = lg[e]; i0 = e; }
            int i1 = -1; float v1 = -3e38f; for (int e = 0; e < 8; ++e) if (e != i0 && lg[e] > v1) { v1 = lg[e]; i1 = e; }
            const float w0 = 1.0f / (1.0f + expf(v1 - v0)); TE[r * 2] = i0; TE[r * 2 + 1] = i1; TW[r * 2] = w0; TW[r * 2 + 1] = 1.0f - w0; } }
#endif
}
DEVI void ph_final(const Params& p, long long gw, long long nw, int lane) {
    const int* TS = WSP(int, p.oTOKS); const bf16_t* Y = WSP(bf16_t, p.oY); const float* gain = p.in[I_NORM_FINAL]; float* X = p.out;
#ifndef CPU_EMU
    for (long long r = gw; r < p.T; r += nw) { float v[16], g[16]; row_load(X + r * 1024, v, lane); row_load(gain, g, lane);
        const bf16_t* y0 = Y + (long long)TS[r * 2] * 1024; const bf16_t* y1 = Y + (long long)TS[r * 2 + 1] * 1024;
#pragma unroll
        for (int j = 0; j < 4; ++j) { const uint2 a = *(const uint2*)(y0 + j * 256 + lane * 4), b = *(const uint2*)(y1 + j * 256 + lane * 4);
            v[4 * j] += u2f(a.x << 16) + u2f(b.x << 16); v[4 * j + 1] += u2f(a.x & 0xffff0000u) + u2f(b.x & 0xffff0000u); v[4 * j + 2] += u2f(a.y << 16) + u2f(b.y << 16); v[4 * j + 3] += u2f(a.y & 0xffff0000u) + u2f(b.y & 0xffff0000u); }
        float ss = 0.f;
#pragma unroll
        for (int j = 0; j < 16; ++j) ss += v[j] * v[j];
        ss = wave_sum(ss); const float rs = rsqrtf(ss * (1.0f / 1024.0f) + 1e-6f);
#pragma unroll
        for (int j = 0; j < 4; ++j) *(float4*)(X + r * 1024 + j * 256 + lane * 4) = make_float4(v[4 * j] * rs * g[4 * j], v[4 * j + 1] * rs * g[4 * j + 1], v[4 * j + 2] * rs * g[4 * j + 2], v[4 * j + 3] * rs * g[4 * j + 3]); }
#else
    (void)lane;
    for (long long r = gw; r < p.T; r += nw) { float v[1024]; float ss = 0.f; const bf16_t* y0 = Y + (long long)TS[r * 2] * 1024; const bf16_t* y1 = Y + (long long)TS[r * 2 + 1] * 1024;
        for (int c = 0; c < 1024; ++c) { v[c] = X[r * 1024 + c] + bf2f(y0[c]) + bf2f(y1[c]); ss += v[c] * v[c]; }
        const float rs = 1.0f / sqrtf(ss / 1024.0f + 1e-6f); for (int c = 0; c < 1024; ++c) X[r * 1024 + c] = v[c] * rs * gain[c]; }
#endif
}
DEVI void ph_rwkv_scan(const Params& p, int l, long long gw, long long nw, int lane) {
    const float* RWW = WSP(float, p.oRWW); const bf16_t* RWX = WSP(bf16_t, p.oRWX); bf16_t* O = WSP(bf16_t, p.oO); const float* lng = p.in[I_RW_LN] + l * 256; const float* rkw = p.in[I_RW_RK] + l * 256; (void)rkw;
    for (long long ch = gw; ch < p.B * 4; ch += nw) { const long long b = ch >> 2; const int h = (int)(ch & 3);
#ifndef CPU_EMU
        float st[64];
#pragma unroll
        for (int c = 0; c < 64; ++c) st[c] = 0.f;
        for (long long s = 0; s < p.S; ++s) { const long long t = b * p.S + s; const bf16_t* rx = RWX + t * 1280 + h * 64; const float v = bf2f(rx[512 + lane]);
            const float y = rwkv_row_step(st, RWW + t * 256 + h * 64, rx, rx + 256, rx + 768, rx + 1024, v);
            const float mean = wave_sum(y) * (1.0f / 64.0f), dy = y - mean, var = wave_sum(dy * dy) * (1.0f / 64.0f);
            const float yn = dy * rsqrtf(var + 64e-5f) * lng[h * 64 + lane] + 0.f;
            bf16_t* o = O + t * 1024 + 512 + h * 64 + lane; *o = f2bf(yn * bf2f(*o)); }
#else
        (void)lane;
        static float st[64][64]; for (int v = 0; v < 64; ++v) for (int c = 0; c < 64; ++c) st[v][c] = 0.f;
        for (long long s = 0; s < p.S; ++s) { const long long t = b * p.S + s; const bf16_t* rx = RWX + t * 1280 + h * 64; float y[64], mean = 0.f, var = 0.f;
            for (int v = 0; v < 64; ++v) { y[v] = rwkv_row_step(st[v], RWW + t * 256 + h * 64, rx, rx + 256, rx + 768, rx + 1024, bf2f(rx[512 + v])); mean += y[v]; }
            mean /= 64.f; for (int v = 0; v < 64; ++v) var += (y[v] - mean) * (y[v] - mean); var /= 64.f;
            float rkv = 0.f; for (int cq = 0; cq < 64; ++cq) rkv += bf2f(rx[cq]) * bf2f(rx[256 + cq]) * rkw[h * 64 + cq];
            for (int v = 0; v < 64; ++v) { const float yn = (y[v] - mean) / sqrtf(var + 64e-5f) * lng[h * 64 + v] + rkv * bf2f(rx[512 + v]);
                bf16_t* o = O + t * 1024 + 512 + h * 64 + v; *o = f2bf(yn * bf2f(*o)); } }
#endif
    }
}
DEVI void ph_gla_scan(const Params& p, int l, long long gw, long long nw, int lane) {
    const bf16_t* P = WSP(bf16_t, p.oP); const float* GA = WSP(float, p.oGA); bf16_t* O = WSP(bf16_t, p.oO); const float* ng = p.in[I_GLA_NORM] + l * 64;
    for (long long ch = gw; ch < p.B * 4; ch += nw) { const long long b = ch >> 2; const int h = (int)(ch & 3);
#ifndef CPU_EMU
        float st[32];
#pragma unroll
        for (int c = 0; c < 32; ++c) st[c] = 0.f;
        for (long long s = 0; s < p.S; ++s) { const long long t = b * p.S + s; const bf16_t* x = P + t * PW + C_GLA;
            const float o = gla_col_step(st, GA + t * 128 + h * 32, x + h * 32, x + 128 + h * 32, bf2f(x[256 + h * 64 + lane]));
            const float ms = wave_sum(o * o) * (1.0f / 64.0f), on = o * rsqrtf(ms + 1e-6f) * ng[lane];
            bf16_t* d = O + t * 1024 + 768 + h * 64 + lane; *d = f2bf(on * bf2f(*d)); }
#else
        (void)lane;
        static float st[64][32]; for (int v = 0; v < 64; ++v) for (int c = 0; c < 32; ++c) st[v][c] = 0.f;
        for (long long s = 0; s < p.S; ++s) { const long long t = b * p.S + s; const bf16_t* x = P + t * PW + C_GLA; float o[64], ms = 0.f;
            for (int v = 0; v < 64; ++v) { o[v] = gla_col_step(st[v], GA + t * 128 + h * 32, x + h * 32, x + 128 + h * 32, bf2f(x[256 + h * 64 + v])); ms += o[v] * o[v]; }
            ms /= 64.f;
            for (int v = 0; v < 64; ++v) { bf16_t* d = O + t * 1024 + 768 + h * 64 + v; *d = f2bf(o[v] / sqrtf(ms + 1e-6f) * ng[v] * bf2f(*d)); } }
#endif
    }
}
#ifndef CPU_EMU
#define LAS __attribute__((address_space(3)))
__device__ __forceinline__ int mk_lane() { return (int)__builtin_amdgcn_mbcnt_hi(~0u, __builtin_amdgcn_mbcnt_lo(~0u, 0u)); }
typedef short bf16x8 __attribute__((ext_vector_type(8)));
typedef float f32x4 __attribute__((ext_vector_type(4)));
constexpr int HALF = 128, BK = 64, HTB = HALF * BK * 2, STAGE_BYTES = 8 * HTB;
__device__ __forceinline__ int lds_byte(int r, int c) { const int st = (r >> 4) * 2 + (c >> 5), rr = r & 15, cc = c & 31, ob = rr * 64 + cc * 2; return st * 1024 + (ob ^ (((ob >> 9) & 1) << 5)); }
__device__ __forceinline__ void stage_rc(int b, int& R, int& C) { const int st = b / 1024, sb = b % 1024, swz = sb ^ (((sb >> 9) & 1) << 5); R = (st >> 1) * 16 + swz / 64; C = (st & 1) * 32 + (swz % 64) / 2; }
__device__ __forceinline__ int perm32(int rho) { const int n = rho >> 4, i = rho & 15; return 8 * (i >> 2) + 4 * n + (i & 3); }

template <class Epi, class Sched>
__device__ __forceinline__ void gemm_phase(int wv, LAS unsigned char* lds, const bf16_t* A, long long lda, const bf16_t* Bt, long long ldb, long long K, const Sched& S, const Epi& E, long long kstepA_elems = 64) {
    int tid = wv * 64 + mk_lane(); asm volatile("" : "+v"(tid));
    const int wid = wv, lane = tid & 63, wr = wid >> 2, wc = wid & 3, fr = lane & 15, fq = lane >> 4;
    { unsigned long long a_ = (unsigned long long)A, b_ = (unsigned long long)Bt; unsigned alo = __builtin_amdgcn_readfirstlane((unsigned)a_), ahi = __builtin_amdgcn_readfirstlane((unsigned)(a_ >> 32)),
        blo = __builtin_amdgcn_readfirstlane((unsigned)b_), bhi = __builtin_amdgcn_readfirstlane((unsigned)(b_ >> 32));
      int lda_ = __builtin_amdgcn_readfirstlane((int)lda), ldb_ = __builtin_amdgcn_readfirstlane((int)ldb), k_ = __builtin_amdgcn_readfirstlane((int)K), ks_ = __builtin_amdgcn_readfirstlane((int)kstepA_elems);
      asm volatile("" : "+s"(alo), "+s"(ahi), "+s"(blo), "+s"(bhi), "+s"(lda_), "+s"(ldb_), "+s"(k_), "+s"(ks_)); kstepA_elems = ks_;
      A = (const bf16_t*)(((unsigned long long)ahi << 32) | alo); Bt = (const bf16_t*)(((unsigned long long)bhi << 32) | blo); lda = lda_; ldb = ldb_; K = k_; }
    const int nt = (int)(K / BK);
    unsigned voffA[2], voffB[2];
#pragma unroll
    for (int i = 0; i < 2; ++i) { int R, C; stage_rc(tid * 16 + i * 8192, R, C); const int Rb = (R & ~31) + perm32(R & 31);
        voffA[i] = (unsigned)(R * (int)lda + C) * 2u; voffB[i] = (unsigned)(Rb * (int)ldb + C) * 2u; }
    const size_t kstep = (size_t)(BK * 2), kstepA = (size_t)kstepA_elems * 2;
    const size_t hstepA = (size_t)HALF * lda * 2, hstepB = (size_t)HALF * ldb * 2;
    const unsigned ldsw = (unsigned)wid * 1024u;
    const int aoff = lds_byte(wr * 64 + fr, fq * 8), boff = lds_byte(wc * 32 + fr, fq * 8);
#define PG8_SA(b, h) (((b) * 2 + (h)) * HTB)
#define PG8_SB(b, h) ((4 + (b) * 2 + (h)) * HTB)
#define PG8_STAGE(bufoff, gbase, voff) do { _Pragma("unroll") for (int _i = 0; _i < 2; ++_i) \
        __builtin_amdgcn_global_load_lds((const unsigned*)((const char*)(gbase) + (voff)[_i]), (LAS unsigned*)(lds + (bufoff) + ldsw + _i * 8192), 16, 0, 0); } while (0)
#define PG8_LDA(dst, b, h) do { _Pragma("unroll") for (int m = 0; m < 4; ++m) _Pragma("unroll") for (int k = 0; k < 2; ++k) dst[m][k] = *(const LAS bf16x8*)(lds + PG8_SA(b, h) + aoff + m * 2048 + k * 1024); } while (0)
#define PG8_LDB(dst, b, h) do { _Pragma("unroll") for (int n = 0; n < 2; ++n) _Pragma("unroll") for (int k = 0; k < 2; ++k) dst[n][k] = *(const LAS bf16x8*)(lds + PG8_SB(b, h) + boff + n * 2048 + k * 1024); } while (0)
#define PG8_MMA(ai, bj, At, Bt_) do { __builtin_amdgcn_s_setprio(1); _Pragma("unroll") for (int m = 0; m < 4; ++m) _Pragma("unroll") for (int n = 0; n < 2; ++n) _Pragma("unroll") for (int k = 0; k < 2; ++k) \
        acc[ai][bj][m][n] = __builtin_amdgcn_mfma_f32_16x16x32_bf16(Bt_[n][k], At[m][k], acc[ai][bj][m][n], 0, 0, 0); __builtin_amdgcn_s_setprio(0); } while (0)
#define PG8_WAIT_V(n) asm volatile("s_waitcnt vmcnt(" #n ")" ::: "memory")
#define PG8_WAIT_L(n) asm volatile("s_waitcnt lgkmcnt(" #n ")" ::: "memory")
#define PG8_BAR __builtin_amdgcn_s_barrier()
#define PG8_SCHED __builtin_amdgcn_sched_barrier(0)
    Unit cur, nxt; int ui = 0;
    if (!S.next(0, cur)) return;
    f32x4 acc[2][2][4][2];
#pragma unroll
    for (int a = 0; a < 2; ++a)
#pragma unroll
        for (int b = 0; b < 2; ++b)
#pragma unroll
            for (int m = 0; m < 4; ++m)
#pragma unroll
                for (int n = 0; n < 2; ++n) acc[a][b][m][n] = (f32x4){0.f, 0.f, 0.f, 0.f};
    bf16x8 At[4][2], B0[2][2], B1[2][2];
    const char* cA = (const char*)A + cur.aoff; const char* cB = (const char*)Bt + cur.boff;
    S.a_ready(cur);
    PG8_STAGE(PG8_SB(0, 0), cB, voffB); PG8_STAGE(PG8_SA(0, 0), cA, voffA); PG8_STAGE(PG8_SB(0, 1), cB + hstepB, voffB); PG8_STAGE(PG8_SA(0, 1), cA + hstepA, voffA);
    if (wr == 1) PG8_BAR;
    PG8_WAIT_V(4); PG8_BAR;
    PG8_STAGE(PG8_SB(1, 0), cB + kstep, voffB); PG8_STAGE(PG8_SA(1, 0), cA + kstepA, voffA); PG8_STAGE(PG8_SB(1, 1), cB + hstepB + kstep, voffB);
    PG8_WAIT_V(6); PG8_BAR;
    for (;;) {
        const bool has_next = S.next(ui + 1, nxt);
        const char* nA = has_next ? (const char*)A + nxt.aoff : cA; const char* nB = has_next ? (const char*)Bt + nxt.boff : cB;
#pragma nounroll
        for (int t = 0; t < nt; t += 2) {
            const bool last = (t == nt - 2);
            const char* a1 = cA + (size_t)(t + 1) * kstepA;
            const char* a2 = last ? nA : cA + (size_t)(t + 2) * kstepA; const char* b2 = last ? nB : cB + (size_t)(t + 2) * kstep;
            const char* a3 = a2 + kstepA; const char* b3 = b2 + kstep;
            if (last && has_next) S.a_ready(nxt);
            PG8_LDB(B0, 0, 0); PG8_SCHED; PG8_LDA(At, 0, 0); PG8_STAGE(PG8_SA(1, 1), a1 + hstepA, voffA);
            PG8_WAIT_L(8); PG8_BAR; PG8_WAIT_L(0); PG8_MMA(0, 0, At, B0); PG8_BAR; PG8_SCHED;
            PG8_LDB(B1, 0, 1); PG8_STAGE(PG8_SB(0, 0), b2, voffB);
            PG8_BAR; PG8_WAIT_L(0); PG8_MMA(0, 1, At, B1); PG8_BAR;
            PG8_LDA(At, 0, 1); PG8_STAGE(PG8_SA(0, 0), a2, voffA);
            PG8_BAR; PG8_WAIT_L(0); PG8_MMA(1, 0, At, B0); PG8_BAR; PG8_SCHED;
            PG8_STAGE(PG8_SB(0, 1), b2 + hstepB, voffB);
            PG8_WAIT_V(6); PG8_BAR; PG8_MMA(1, 1, At, B1); PG8_BAR;
            PG8_LDB(B0, 1, 0); PG8_SCHED; PG8_LDA(At, 1, 0); PG8_STAGE(PG8_SA(0, 1), a2 + hstepA, voffA);
            PG8_WAIT_L(8); PG8_BAR; PG8_WAIT_L(0); PG8_MMA(0, 0, At, B0); PG8_BAR; PG8_SCHED;
            PG8_LDB(B1, 1, 1); PG8_STAGE(PG8_SB(1, 0), b3, voffB);
            PG8_BAR; PG8_WAIT_L(0); PG8_MMA(0, 1, At, B1); PG8_BAR;
            PG8_LDA(At, 1, 1); PG8_STAGE(PG8_SA(1, 0), a3, voffA);
            PG8_BAR; PG8_WAIT_L(0); PG8_MMA(1, 0, At, B0); PG8_BAR; PG8_SCHED;
            PG8_STAGE(PG8_SB(1, 1), b3 + hstepB, voffB);
            PG8_WAIT_V(6); PG8_BAR; PG8_MMA(1, 1, At, B1); PG8_BAR;
        }
#pragma unroll
        for (int ai = 0; ai < 2; ++ai)
#pragma unroll
            for (int m = 0; m < 4; ++m) { float lo[8], hi[8];
#pragma unroll
                for (int j = 0; j < 8; ++j) { lo[j] = acc[ai][0][m][j >> 2][j & 3]; hi[j] = acc[ai][1][m][j >> 2][j & 3]; }
                E.apply(cur, (long long)cur.pm * 256 + ai * HALF + wr * 64 + m * 16 + fr, wc * 32 + 8 * fq, lo, hi); PG8_SCHED; }
        S.done(cur);
        if (!has_next) break;
#pragma unroll
        for (int a = 0; a < 2; ++a)
#pragma unroll
            for (int b = 0; b < 2; ++b)
#pragma unroll
                for (int m = 0; m < 4; ++m)
#pragma unroll
                    for (int n = 0; n < 2; ++n) acc[a][b][m][n] = (f32x4){0.f, 0.f, 0.f, 0.f};
        cur = nxt; cA = nA; cB = nB; ++ui;
    }
    PG8_WAIT_V(0);
    if (wr == 0) PG8_BAR;
    PG8_BAR;
#undef PG8_SA
#undef PG8_SB
#undef PG8_STAGE
#undef PG8_LDA
#undef PG8_LDB
#undef PG8_MMA
#undef PG8_WAIT_V
#undef PG8_WAIT_L
#undef PG8_BAR
#undef PG8_SCHED
}

#define XB_TMO      128
#define XB_XCNT(j)  (256  + 64 * (j))
#define XB_XSUB(j)  (1280 + 64 * (j))
#define XB_XGEN(j)  (2304 + 64 * (j))
#define XB_TOP      3328
#define XB_TOPGEN   3392
#define XCD_BAR_WORDS 3456
#define XB_SPIN_CAP (1u << 18)
__device__ __forceinline__ unsigned xb_ld(unsigned* p)              { return __hip_atomic_load(p, __ATOMIC_RELAXED, __HIP_MEMORY_SCOPE_AGENT); }
__device__ __forceinline__ unsigned xb_add(unsigned* p, unsigned v) { return __hip_atomic_fetch_add(p, v, __ATOMIC_RELAXED, __HIP_MEMORY_SCOPE_AGENT); }
__device__ __forceinline__ unsigned xb_xcc_id() { return (unsigned)__builtin_amdgcn_s_getreg((3 << 11) | 20) & 0xFu; }
#define XB_SPIN(cond, bar) do { unsigned _sp = 0; while (cond) { __builtin_amdgcn_s_sleep(1); \
    if ((++_sp & 255u) == 0u) { if (xb_ld(&(bar)[XB_TMO])) break; if (_sp > XB_SPIN_CAP) { atomicAdd(&(bar)[XB_TMO], 1u); break; } } } } while (0)
struct XcdBarrier { unsigned* bar; unsigned x; volatile LAS unsigned* st; int wv; };
__device__ __forceinline__ XcdBarrier xcd_barrier_post(unsigned* bar, volatile LAS unsigned* st, int wv) {
    XcdBarrier b; b.bar = bar; b.x = xb_xcc_id(); b.st = st; b.wv = wv;
    if (wv == 0 && mk_lane() == 0) (void)xb_add(&bar[XB_XCNT(b.x)], 1u);
    return b;
}
__device__ __forceinline__ void xcd_barrier_complete(unsigned* bar, unsigned x, unsigned& nloc, unsigned& nx) {
    const unsigned G = gridDim.x * gridDim.y * gridDim.z;
    unsigned sum, cnt, mine, sp = 0u;
    for (;;) {
        sum = 0u; cnt = 0u; mine = 0u;
#pragma unroll
        for (unsigned j = 0; j < 16; ++j) { const unsigned c = xb_ld(&bar[XB_XCNT(j)]); sum += c; cnt += (c > 0u) ? 1u : 0u; mine = (j == x) ? c : mine; }
        if (sum == G) break;
        __builtin_amdgcn_s_sleep(1);
        if ((++sp & 255u) == 0u) { if (xb_ld(&bar[XB_TMO])) break; if (sp > XB_SPIN_CAP) { atomicAdd(&bar[XB_TMO], 1u); break; } }
    }
    nloc = mine > 0u ? mine : 1u; nx = cnt > 0u ? cnt : 1u;
}
__device__ __forceinline__ void xcd_barrier(const XcdBarrier& b) {
    asm volatile("s_waitcnt vmcnt(0)" ::: "memory");
    __syncthreads();
    if (b.wv == 0 && mk_lane() == 0) {
        unsigned* bar = b.bar;
        __builtin_amdgcn_s_waitcnt(0);
        unsigned nloc = b.st[0], nx = b.st[1];
        if (nloc == 0u) { xcd_barrier_complete(bar, b.x, nloc, nx); b.st[0] = nloc; b.st[1] = nx; }
        const unsigned old = xb_add(&bar[XB_XSUB(b.x)], 1u);
        const unsigned gen = old / nloc;
        if (old + 1u == (gen + 1u) * nloc) {
            __builtin_amdgcn_fence(__ATOMIC_RELEASE, "agent");
            asm volatile("s_waitcnt vmcnt(0)" ::: "memory");
            const unsigned og = xb_add(&bar[XB_TOP], 1u);
            const unsigned tg = og / nx;
            if (og + 1u == (tg + 1u) * nx) xb_add(&bar[XB_TOPGEN], 1u);
            else XB_SPIN(xb_ld(&bar[XB_TOPGEN]) == tg, bar);
            __builtin_amdgcn_fence(__ATOMIC_ACQUIRE, "agent");
            xb_add(&bar[XB_XGEN(b.x)], 1u);
            asm volatile("s_waitcnt vmcnt(0)" ::: "memory");
        } else {
            XB_SPIN(xb_ld(&bar[XB_XGEN(b.x)]) == gen, bar);
            __builtin_amdgcn_fence(__ATOMIC_ACQUIRE, "agent");
            asm volatile("s_waitcnt vmcnt(0)" ::: "memory");
        }
    }
    __syncthreads();
}
#endif
#ifndef CPU_EMU
typedef short bf16x8_t __attribute__((ext_vector_type(8)));
typedef short bf16x4_t __attribute__((ext_vector_type(4)));
typedef float f32x4_t __attribute__((ext_vector_type(4)));
typedef unsigned u32x4_t __attribute__((ext_vector_type(4)));
constexpr int AT_KS = 144, AT_VS = 136;
constexpr int AT_KBYTES = 64 * AT_KS, AT_VBYTES = 64 * AT_VS, AT_BUF = AT_KBYTES + AT_VBYTES;
struct AttnState { float m, l; f32x4_t o[4]; };
__device__ __forceinline__ void attn_init(AttnState& s) { s.m = -1e30f; s.l = 0.f;
#pragma unroll
    for (int d = 0; d < 4; ++d) s.o[d] = (f32x4_t){0.f, 0.f, 0.f, 0.f}; }
__device__ __forceinline__ unsigned pack2bf(float lo, float hi) { return (unsigned)f2bf(lo) | ((unsigned)f2bf(hi) << 16); }
template <class Valid> __device__ __forceinline__ void attn_tile(const LAS unsigned char* kt, const LAS unsigned char* vt, const bf16x8_t (&bq)[2], AttnState& st, int lane, const Valid& valid) {
    const int r = lane & 15, q = lane >> 4;
    f32x4_t s[4];
#pragma unroll
    for (int kb = 0; kb < 4; ++kb) { s[kb] = (f32x4_t){0.f, 0.f, 0.f, 0.f};
#pragma unroll
        for (int ks = 0; ks < 2; ++ks) { const bf16x8_t a = *(const LAS bf16x8_t*)(kt + (16 * kb + r) * AT_KS + (32 * ks + 8 * q) * 2); s[kb] = __builtin_amdgcn_mfma_f32_16x16x32_bf16(a, bq[ks], s[kb], 0, 0, 0); } }
    float mx = -1e30f;
#pragma unroll
    for (int kb = 0; kb < 4; ++kb)
#pragma unroll
        for (int j = 0; j < 4; ++j) { const float v = valid(kb, j) ? s[kb][j] * 1.44269504f : -1e30f; s[kb][j] = v; mx = fmaxf(mx, v); }
    mx = fmaxf(mx, __shfl_xor(mx, 16)); mx = fmaxf(mx, __shfl_xor(mx, 32));
    const float mn = fmaxf(st.m, mx), alpha = __builtin_amdgcn_exp2f(st.m - mn);
    float rs = 0.f;
#pragma unroll
    for (int kb = 0; kb < 4; ++kb)
#pragma unroll
        for (int j = 0; j < 4; ++j) { const float pv = s[kb][j] > -1e29f ? __builtin_amdgcn_exp2f(s[kb][j] - mn) : 0.f; s[kb][j] = pv; rs += pv; }
    rs += __shfl_xor(rs, 16); rs += __shfl_xor(rs, 32);
    st.l = st.l * alpha + rs; st.m = mn;
    bf16x8_t pb[2];
#pragma unroll
    for (int kk = 0; kk < 2; ++kk) { uint4 w; w.x = pack2bf(s[2 * kk][0], s[2 * kk][1]); w.y = pack2bf(s[2 * kk][2], s[2 * kk][3]); w.z = pack2bf(s[2 * kk + 1][0], s[2 * kk + 1][1]); w.w = pack2bf(s[2 * kk + 1][2], s[2 * kk + 1][3]);
        pb[kk] = __builtin_bit_cast(bf16x8_t, w); }
#pragma unroll
    for (int db = 0; db < 4; ++db) { st.o[db] = st.o[db] * alpha;
#pragma unroll
        for (int kk = 0; kk < 2; ++kk) { const LAS unsigned char* vp = vt + (16 * db + r) * AT_VS + (32 * kk + 4 * q) * 2;
            const bf16x4_t lo = *(const LAS bf16x4_t*)vp, hi = *(const LAS bf16x4_t*)(vp + 32);
            const bf16x8_t a = __builtin_shufflevector(lo, hi, 0, 1, 2, 3, 4, 5, 6, 7);
            st.o[db] = __builtin_amdgcn_mfma_f32_16x16x32_bf16(a, pb[kk], st.o[db], 0, 0, 0); } }
}
__device__ __forceinline__ void attn_stage_store(LAS unsigned char* buf, int tid, const uint4& kc, const uint4& vc) {
    const int key = tid >> 3, c = tid & 7;
    *(LAS u32x4_t*)(buf + key * AT_KS + c * 16) = (u32x4_t){kc.x, kc.y, kc.z, kc.w};
    LAS unsigned short* vt = (LAS unsigned short*)(buf + AT_KBYTES);
    const unsigned w[4] = {vc.x, vc.y, vc.z, vc.w};
#pragma unroll
    for (int i = 0; i < 4; ++i) { vt[((8 * c + 2 * i) * AT_VS) / 2 + key] = (unsigned short)(w[i] & 0xffffu); vt[((8 * c + 2 * i + 1) * AT_VS) / 2 + key] = (unsigned short)(w[i] >> 16); }
}
__device__ __forceinline__ void ph_selwin_mfma(const Params& p, int wv, LAS unsigned char* lds, int gC, int gG) {
    int tid = wv * 64 + mk_lane(); asm volatile("" : "+v"(tid));
    const int wid = tid >> 6, lane = tid & 63, r = lane & 15, q = lane >> 4;
    const bf16_t* P = WSP(bf16_t, p.oP); const unsigned* SELM = WSP(unsigned, p.oSELM); bf16_t* O = WSP(bf16_t, p.oO);
    const int nqb = (int)(p.S >> 6), units = (int)(p.B * 2) * nqb;
    for (int u = gC; u < units; u += gG) {
        const int cur = nqb - 1 - (u % nqb), bg = u / nqb, b = bg >> 1, g = bg & 1;
        const long long t0 = (long long)b * p.S + (long long)cur * 64;
        const int hd = 2 * g + (wid >> 2); const int tq = (wid & 3) * 16 + r; const long long tok = t0 + tq; const int sq = cur * 64 + tq;
        bf16x8_t bq[2];
#pragma unroll
        for (int ks = 0; ks < 2; ++ks) bq[ks] = *(const bf16x8_t*)(P + tok * PW + C_Q + hd * 64 + 32 * ks + 8 * q);
        unsigned un = SELM[(t0 + lane) * 2 + g];
#pragma unroll
        for (int o = 32; o > 0; o >>= 1) un |= __shfl_xor(un, o);
        un = __builtin_amdgcn_readfirstlane(un);
        const unsigned mymask = SELM[tok * 2 + g];
        const int wlo = cur - 8 > 0 ? cur - 8 : 0, nwin = cur - wlo + 1, nsel = __builtin_popcount(un), ntile = nwin + nsel;
        AttnState sw, ss; attn_init(sw); attn_init(ss);
        unsigned rem = un; int blk = wlo;
        uint4 kc, vc;
        { const long long kr = ((long long)b * p.S + (long long)blk * 64 + (tid >> 3)) * PW + g * 64 + (tid & 7) * 8; kc = *(const uint4*)(P + kr + C_KW); vc = *(const uint4*)(P + kr + C_VW); }
        attn_stage_store(lds, tid, kc, vc);
        __syncthreads();
        for (int i = 0; i < ntile; ++i) {
            const bool win = i < nwin; const int cb = blk;
            int nb = 0; bool nwinf = false; const bool has = i + 1 < ntile;
            if (has) { if (i + 1 < nwin) { nb = wlo + i + 1; nwinf = true; } else { nb = __builtin_ctz(rem); rem &= rem - 1; }
                const long long kr = ((long long)b * p.S + (long long)nb * 64 + (tid >> 3)) * PW + g * 64 + (tid & 7) * 8;
                kc = *(const uint4*)(P + kr + (nwinf ? C_KW : C_KS)); vc = *(const uint4*)(P + kr + (nwinf ? C_VW : C_VS)); }
            const LAS unsigned char* buf = lds + (i & 1) * AT_BUF;
            const int kbase = cb * 64 + 4 * q;
            if (win) attn_tile(buf, buf + AT_KBYTES, bq, sw, lane, [&](int kb, int j) { const int key = kbase + 16 * kb + j; return key <= sq && key > sq - 512; });
            else { const bool on = (mymask >> cb) & 1u; attn_tile(buf, buf + AT_KBYTES, bq, ss, lane, [&](int kb, int j) { const int key = kbase + 16 * kb + j; return on && key <= sq; }); }
            if (has) attn_stage_store(lds + ((i + 1) & 1) * AT_BUF, tid, kc, vc);
            blk = nb;
            __syncthreads();
        }
        const float g1 = sigmoidf_(bf2f(P[tok * PW + C_NG + hd * 3 + 1])) / ss.l, g2 = sigmoidf_(bf2f(P[tok * PW + C_NG + hd * 3 + 2])) / sw.l;
#pragma unroll
        for (int db = 0; db < 4; ++db) { bf16_t* od = O + tok * 1024 + hd * 64 + 16 * db + 4 * q; const uint2 pv = *(const uint2*)od;
            const float r0 = u2f(pv.x << 16) + g1 * ss.o[db][0] + g2 * sw.o[db][0], r1 = u2f(pv.x & 0xffff0000u) + g1 * ss.o[db][1] + g2 * sw.o[db][1];
            const float r2 = u2f(pv.y << 16) + g1 * ss.o[db][2] + g2 * sw.o[db][2], r3 = u2f(pv.y & 0xffff0000u) + g1 * ss.o[db][3] + g2 * sw.o[db][3];
            uint2 w; w.x = pack2bf(r0, r1); w.y = pack2bf(r2, r3); *(uint2*)od = w; }
    }
}
__device__ __forceinline__ void ph_ca_attn_mfma(const Params& p, int l, int wv, LAS unsigned char* lds, int gC, int gG) {
    int tid = wv * 64 + mk_lane(); asm volatile("" : "+v"(tid));
    const int wid = tid >> 6, lane = tid & 63, r = lane & 15, q = lane >> 4;
    const bf16_t* CQ = WSP(bf16_t, p.oCQ); const bf16_t* KV = WSP(bf16_t, p.oKV) + (long long)l * 512; bf16_t* AO = WSP(bf16_t, p.oCAO);
    const int nqb = (int)(p.S >> 7), units = (int)(p.B * 4) * nqb;
    for (int u = gC; u < units; u += gG) {
        const int qb = u % nqb, bh = u / nqb, b = bh >> 2, hd = bh & 3;
        const long long tok = (long long)b * p.S + (long long)qb * 128 + wid * 16 + r;
        bf16x8_t bq[2];
#pragma unroll
        for (int ks = 0; ks < 2; ++ks) bq[ks] = *(const bf16x8_t*)(CQ + tok * 256 + hd * 64 + 32 * ks + 8 * q);
        AttnState st; attn_init(st);
        uint4 kc, vc;
        { const long long kr = ((long long)b * 256 + (tid >> 3)) * 1024 + hd * 64 + (tid & 7) * 8; kc = *(const uint4*)(KV + kr); vc = *(const uint4*)(KV + kr + 256); }
        attn_stage_store(lds, tid, kc, vc);
        __syncthreads();
        for (int i = 0; i < 4; ++i) {
            if (i < 3) { const long long kr = ((long long)b * 256 + (i + 1) * 64 + (tid >> 3)) * 1024 + hd * 64 + (tid & 7) * 8; kc = *(const uint4*)(KV + kr); vc = *(const uint4*)(KV + kr + 256); }
            const LAS unsigned char* buf = lds + (i & 1) * AT_BUF;
            attn_tile(buf, buf + AT_KBYTES, bq, st, lane, [](int, int) { return true; });
            if (i < 3) attn_stage_store(lds + ((i + 1) & 1) * AT_BUF, tid, kc, vc);
            __syncthreads();
        }
        const float il = 1.0f / st.l;
#pragma unroll
        for (int db = 0; db < 4; ++db) { uint2 w; w.x = pack2bf(st.o[db][0] * il, st.o[db][1] * il); w.y = pack2bf(st.o[db][2] * il, st.o[db][3] * il); *(uint2*)(AO + tok * 256 + hd * 64 + 16 * db + 4 * q) = w; }
    }
}
#endif
#ifndef CPU_EMU
constexpr int CM_VS = 264;
constexpr int CM_KBYTES = 128 * AT_KS, CM_VBYTES = 64 * CM_VS;
__device__ __forceinline__ void ph_cmp_attn_mfma(const Params& p, int wv, LAS unsigned char* lds, int gC, int gG) {
    int tid = wv * 64 + mk_lane(); asm volatile("" : "+v"(tid));
    const int lane = tid & 63, r = lane & 15, q = lane >> 4;
    const bf16_t* P = WSP(bf16_t, p.oP); const float* KC = WSP(float, p.oKCMP); const float* VC = WSP(float, p.oVCMP); unsigned* SELM = WSP(unsigned, p.oSELM); bf16_t* O = WSP(bf16_t, p.oO);
    const int nqb = (int)(p.S >> 6), units = (int)(p.B * 2) * nqb, NCk = (int)p.NC;
    LAS unsigned char* kt = lds; LAS unsigned char* vt = lds + CM_KBYTES;
    for (int u = gC; u < units; u += gG) {
        const int cur = u % nqb, bg = u / nqb, b = bg >> 1, g = bg & 1;
        __syncthreads();
        {
            const int key = tid >> 2, d0 = 16 * (tid & 3); float kf[16], vf[16];
            if (key < NCk) { const float* ks = KC + (((long long)b * NCk + key) * 2 + g) * 64 + d0; const float* vs = VC + (((long long)b * NCk + key) * 2 + g) * 64 + d0;
#pragma unroll
                for (int i = 0; i < 4; ++i) { const float4 a = *(const float4*)(ks + 4 * i), c = *(const float4*)(vs + 4 * i); kf[4 * i] = a.x; kf[4 * i + 1] = a.y; kf[4 * i + 2] = a.z; kf[4 * i + 3] = a.w; vf[4 * i] = c.x; vf[4 * i + 1] = c.y; vf[4 * i + 2] = c.z; vf[4 * i + 3] = c.w; } }
            else {
#pragma unroll
                for (int i = 0; i < 16; ++i) { kf[i] = 0.f; vf[i] = 0.f; } }
            *(LAS u32x4_t*)(kt + key * AT_KS + d0 * 2) = (u32x4_t){pack2bf(kf[0], kf[1]), pack2bf(kf[2], kf[3]), pack2bf(kf[4], kf[5]), pack2bf(kf[6], kf[7])};
            *(LAS u32x4_t*)(kt + key * AT_KS + d0 * 2 + 16) = (u32x4_t){pack2bf(kf[8], kf[9]), pack2bf(kf[10], kf[11]), pack2bf(kf[12], kf[13]), pack2bf(kf[14], kf[15])};
            LAS unsigned short* v16 = (LAS unsigned short*)vt;
#pragma unroll
            for (int i = 0; i < 16; ++i) v16[((d0 + i) * CM_VS) / 2 + key] = f2bf(vf[i]); }
        __syncthreads();
        const int tl = 8 * wv + (r >> 1), hd = 2 * g + (r & 1); const long long tok = (long long)b * p.S + (long long)cur * 64 + tl; const int sq = cur * 64 + tl;
        bf16x8_t bq[2];
#pragma unroll
        for (int ks = 0; ks < 2; ++ks) bq[ks] = *(const bf16x8_t*)(P + tok * PW + C_Q + hd * 64 + 32 * ks + 8 * q);
        const int nv = sq >= 31 ? (sq - 31) / 16 + 1 : 0;
        f32x4_t s[8];
#pragma unroll
        for (int kb = 0; kb < 8; ++kb) { s[kb] = (f32x4_t){0.f, 0.f, 0.f, 0.f};
#pragma unroll
            for (int ks = 0; ks < 2; ++ks) { const bf16x8_t a = *(const LAS bf16x8_t*)(kt + (16 * kb + r) * AT_KS + (32 * ks + 8 * q) * 2); s[kb] = __builtin_amdgcn_mfma_f32_16x16x32_bf16(a, bq[ks], s[kb], 0, 0, 0); } }
        float mx = -1e30f;
#pragma unroll
        for (int kb = 0; kb < 8; ++kb)
#pragma unroll
            for (int j = 0; j < 4; ++j) { const bool ok = 16 * kb + 4 * q + j < nv; const float v = ok ? s[kb][j] * 1.44269504f : -1e30f; s[kb][j] = v; mx = fmaxf(mx, v); }
        mx = fmaxf(mx, __shfl_xor(mx, 16)); mx = fmaxf(mx, __shfl_xor(mx, 32));
        float sum = 0.f;
#pragma unroll
        for (int kb = 0; kb < 8; ++kb)
#pragma unroll
            for (int j = 0; j < 4; ++j) { const float pv = s[kb][j] > -1e29f ? __builtin_amdgcn_exp2f(s[kb][j] - mx) : 0.f; s[kb][j] = pv; sum += pv; }
        sum += __shfl_xor(sum, 16); sum += __shfl_xor(sum, 32);
        const float inv = nv > 0 ? 1.0f / sum : 0.f;
#pragma unroll
        for (int kb = 0; kb < 8; ++kb) s[kb] = s[kb] * inv;
        f32x4_t o[4];
#pragma unroll
        for (int db = 0; db < 4; ++db) o[db] = (f32x4_t){0.f, 0.f, 0.f, 0.f};
#pragma unroll
        for (int kk = 0; kk < 4; ++kk) { u32x4_t w = (u32x4_t){pack2bf(s[2 * kk][0], s[2 * kk][1]), pack2bf(s[2 * kk][2], s[2 * kk][3]), pack2bf(s[2 * kk + 1][0], s[2 * kk + 1][1]), pack2bf(s[2 * kk + 1][2], s[2 * kk + 1][3])};
            const bf16x8_t pb = __builtin_bit_cast(bf16x8_t, w);
#pragma unroll
            for (int db = 0; db < 4; ++db) { const LAS unsigned char* vp = vt + (16 * db + r) * CM_VS + (32 * kk + 4 * q) * 2;
                const bf16x4_t lo = *(const LAS bf16x4_t*)vp, hi = *(const LAS bf16x4_t*)(vp + 32);
                o[db] = __builtin_amdgcn_mfma_f32_16x16x32_bf16(__builtin_shufflevector(lo, hi, 0, 1, 2, 3, 4, 5, 6, 7), pb, o[db], 0, 0, 0); } }
        const float g0 = sigmoidf_(bf2f(P[tok * PW + C_NG + hd * 3]));
#pragma unroll
        for (int db = 0; db < 4; ++db) { uint2 w; w.x = pack2bf(g0 * o[db][0], g0 * o[db][1]); w.y = pack2bf(g0 * o[db][2], g0 * o[db][3]); *(uint2*)(O + tok * 1024 + hd * 64 + 16 * db + 4 * q) = w; }
        float imp[8], tcar[8];
#pragma unroll
        for (int kb = 0; kb < 8; ++kb) { imp[kb] = s[kb][0] + s[kb][1] + s[kb][2] + 0.5f * s[kb][3]; tcar[kb] = __shfl(0.5f * s[kb][3], (lane + 48) & 63); }
#pragma unroll
        for (int kb = 0; kb < 8; ++kb) { const float cin = q >= 1 ? tcar[kb] : (kb >= 1 ? tcar[kb >= 1 ? kb - 1 : 0] : 0.f); imp[kb] += cin; imp[kb] += __shfl_xor(imp[kb], 1); }
        unsigned mask;
        if (cur < 8) mask = (2u << cur) - 1u;
        else {
            mask = 1u | (1u << cur) | (1u << (cur - 1));
#pragma unroll
            for (int kb = 0; kb < 8; ++kb) { const int jj = 4 * kb + q; if (!(jj >= 1 && jj <= cur - 2)) imp[kb] = -3e38f; }
            for (int rd = 0; rd < 5; ++rd) { float bv = -3e38f; int bi = 1 << 20;
#pragma unroll
                for (int kb = 0; kb < 8; ++kb) if (imp[kb] > bv) { bv = imp[kb]; bi = 4 * kb + q; }
#pragma unroll
                for (int sh = 16; sh <= 32; sh <<= 1) { const float ov = __shfl_xor(bv, sh); const int oi = __shfl_xor(bi, sh); if (ov > bv || (ov == bv && oi < bi)) { bv = ov; bi = oi; } }
                mask |= 1u << bi;
#pragma unroll
                for (int kb = 0; kb < 8; ++kb) if (bi == 4 * kb + q) imp[kb] = -3e38f; }
        }
        if (q == 0 && (r & 1) == 0) SELM[tok * 2 + g] = mask;
    }
}
#endif
#ifndef CPU_EMU
typedef float f32x2_t __attribute__((ext_vector_type(2)));
template <int CTRL> __device__ __forceinline__ float dpp_mov(float x) { return __builtin_bit_cast(float, __builtin_amdgcn_update_dpp(0, __builtin_bit_cast(int, x), CTRL, 0xF, 0xF, true)); }
__device__ __forceinline__ float sum8(float x) { x += dpp_mov<0xB1>(x); x += dpp_mov<0x4E>(x); x += dpp_mov<0x141>(x); return x; }
__device__ __forceinline__ float sum16s(float x) { x += __shfl_xor(x, 1); x += __shfl_xor(x, 2); x += __shfl_xor(x, 4); x += __shfl_xor(x, 8); return x; }
constexpr int SC_CH = 32;
constexpr int RW_STEP = 384, RW_BUF = SC_CH * RW_STEP * 4;
constexpr int GL_STEP = 160, GL_BUF = SC_CH * GL_STEP * 4;
__device__ __forceinline__ void cvt8(const uint4& w, float (&f)[8]) { f[0] = u2f(w.x << 16); f[1] = u2f(w.x & 0xffff0000u); f[2] = u2f(w.y << 16); f[3] = u2f(w.y & 0xffff0000u); f[4] = u2f(w.z << 16); f[5] = u2f(w.z & 0xffff0000u); f[6] = u2f(w.w << 16); f[7] = u2f(w.w & 0xffff0000u); }

__device__ __forceinline__ void rwkv_chain(const Params& p, int l, int ch, int wv, LAS unsigned char* lds) {
    int tid = wv * 64 + mk_lane(); asm volatile("" : "+v"(tid));
    const int row = tid >> 3, cg = tid & 7; const long long b = ch >> 2; const int h = ch & 3;
    const float* RWW = WSP(float, p.oRWW); const bf16_t* RWX = WSP(bf16_t, p.oRWX); bf16_t* O = WSP(bf16_t, p.oO); const float* lng = p.in[I_RW_LN] + l * 256 + h * 64; const float* rkw = p.in[I_RW_RK] + l * 256 + h * 64;
    LAS float* YB = (LAS float*)(lds + 2 * RW_BUF);
    const long long tb = b * p.S; const int nch = (int)(p.S / SC_CH);
    float4 gw;
    uint4 gx0, gx1, gx2;
#define RW_GLOAD1(idx_, dst_) do { const int idx = (idx_); if (idx < 1280) { const int step = idx / 40, rem = idx % 40, vec = rem >> 3, c8 = rem & 7; dst_ = *(const uint4*)(RWX + (t0_ + step) * 1280 + vec * 256 + h * 64 + 8 * c8); } } while (0)
#define RW_GLOAD(c_) do { const long long t0_ = tb + (long long)(c_) * SC_CH; gw = *(const float4*)(RWW + (t0_ + (tid >> 4)) * 256 + h * 64 + 4 * (tid & 15)); RW_GLOAD1(tid, gx0); RW_GLOAD1(tid + 512, gx1); RW_GLOAD1(tid + 1024, gx2); } while (0)
#define RW_SSTORE1(idx_, src_) do { const int idx = (idx_); if (idx < 1280) { const int step = idx / 40, rem = idx % 40, vec = rem >> 3, c8 = rem & 7; \
        const int slot = vec == 0 ? 4 : (vec == 1 ? 3 : (vec == 2 ? 5 : (vec == 3 ? 1 : 2))); float f[8]; cvt8(src_, f); LAS float* d = B_ + step * RW_STEP + slot * 64 + 8 * c8; \
        *(LAS f32x4_t*)d = (f32x4_t){f[0], f[1], f[2], f[3]}; *(LAS f32x4_t*)(d + 4) = (f32x4_t){f[4], f[5], f[6], f[7]}; } } while (0)
#define RW_SSTORE(buf_) do { LAS float* B_ = (LAS float*)(lds + (buf_) * RW_BUF); *(LAS f32x4_t*)(B_ + (tid >> 4) * RW_STEP + 4 * (tid & 15)) = (f32x4_t){gw.x, gw.y, gw.z, gw.w}; \
        RW_SSTORE1(tid, gx0); RW_SSTORE1(tid + 512, gx1); RW_SSTORE1(tid + 1024, gx2); } while (0)
    f32x2_t st[4];
#pragma unroll
    for (int i = 0; i < 4; ++i) st[i] = (f32x2_t){0.f, 0.f};
    RW_GLOAD(0); RW_SSTORE(0); __syncthreads();
    for (int c = 0; c < nch; ++c) {
        if (c + 1 < nch) RW_GLOAD(c + 1);
        const LAS float* B = (const LAS float*)(lds + (c & 1) * RW_BUF);
        for (int s = 0; s < SC_CH; ++s) { const LAS float* x = B + s * RW_STEP + 8 * cg;
            f32x2_t w[4], kk[4], bb[4], k[4], r[4];
#pragma unroll
            for (int i = 0; i < 2; ++i) { const f32x4_t a0 = *(const LAS f32x4_t*)(x + 4 * i), a1 = *(const LAS f32x4_t*)(x + 64 + 4 * i), a2 = *(const LAS f32x4_t*)(x + 128 + 4 * i), a3 = *(const LAS f32x4_t*)(x + 192 + 4 * i), a4 = *(const LAS f32x4_t*)(x + 256 + 4 * i);
                w[2 * i] = (f32x2_t){a0[0], a0[1]}; w[2 * i + 1] = (f32x2_t){a0[2], a0[3]}; kk[2 * i] = (f32x2_t){a1[0], a1[1]}; kk[2 * i + 1] = (f32x2_t){a1[2], a1[3]};
                bb[2 * i] = (f32x2_t){a2[0], a2[1]}; bb[2 * i + 1] = (f32x2_t){a2[2], a2[3]}; k[2 * i] = (f32x2_t){a3[0], a3[1]}; k[2 * i + 1] = (f32x2_t){a3[2], a3[3]};
                r[2 * i] = (f32x2_t){a4[0], a4[1]}; r[2 * i + 1] = (f32x2_t){a4[2], a4[3]}; }
            const float v = B[s * RW_STEP + 320 + row];
            f32x2_t a = st[0] * kk[0] + st[1] * kk[1]; a += st[2] * kk[2] + st[3] * kk[3];
            const float skk = sum8(a[0] + a[1]);
            f32x2_t y2 = (f32x2_t){0.f, 0.f};
#pragma unroll
            for (int i = 0; i < 4; ++i) { st[i] = st[i] * w[i] - bb[i] * skk + k[i] * v; y2 += st[i] * r[i]; }
            const float y = sum8(y2[0] + y2[1]);
            if (cg == 0) YB[s * 64 + row] = y; }
        __syncthreads();
        {
            const int s = tid >> 4, v0 = 4 * (tid & 15); const long long t = tb + (long long)c * SC_CH + s;
            const f32x4_t y = *(const LAS f32x4_t*)(YB + s * 64 + v0); const f32x4_t vv = *(const LAS f32x4_t*)(B + s * RW_STEP + 320 + v0);
            const float mean = sum16s(y[0] + y[1] + y[2] + y[3]) * (1.0f / 64.0f);
            const float d0 = y[0] - mean, d1 = y[1] - mean, d2 = y[2] - mean, d3 = y[3] - mean;
            const float var = sum16s(d0 * d0 + d1 * d1 + d2 * d2 + d3 * d3) * (1.0f / 64.0f), rstd = rsqrtf(var + 64e-5f);
            const f32x4_t rr = *(const LAS f32x4_t*)(B + s * RW_STEP + 256 + v0), kq = *(const LAS f32x4_t*)(B + s * RW_STEP + 192 + v0); const float4 rw4 = *(const float4*)(rkw + v0);
            const float rk = sum16s(rr[0] * kq[0] * rw4.x + rr[1] * kq[1] * rw4.y + rr[2] * kq[2] * rw4.z + rr[3] * kq[3] * rw4.w);
            bf16_t* o = O + t * 1024 + 512 + h * 64 + v0; const uint2 g = *(const uint2*)o; const float4 ln = *(const float4*)(lng + v0);
            const float r0 = (d0 * rstd * ln.x + rk * vv[0]) * u2f(g.x << 16), r1 = (d1 * rstd * ln.y + rk * vv[1]) * u2f(g.x & 0xffff0000u);
            const float r2 = (d2 * rstd * ln.z + rk * vv[2]) * u2f(g.y << 16), r3 = (d3 * rstd * ln.w + rk * vv[3]) * u2f(g.y & 0xffff0000u);
            uint2 w; w.x = pack2bf(r0, r1); w.y = pack2bf(r2, r3); *(uint2*)o = w; }
        if (c + 1 < nch) RW_SSTORE((c + 1) & 1);
        __syncthreads();
    }
}
__device__ __forceinline__ void gla_chain(const Params& p, int l, int ch, int wv, LAS unsigned char* lds) {
    int tid = wv * 64 + mk_lane(); asm volatile("" : "+v"(tid));
    const int vc = tid >> 3, kg = tid & 7; const long long b = ch >> 2; const int h = ch & 3;
    const bf16_t* P = WSP(bf16_t, p.oP); const float* GA = WSP(float, p.oGA); bf16_t* O = WSP(bf16_t, p.oO); const float* ng = p.in[I_GLA_NORM] + l * 64;
    LAS float* OB = (LAS float*)(lds + 2 * GL_BUF);
    const long long tb = b * p.S; const int nch = (int)(p.S / SC_CH);
    float4 ga; uint4 g1, g2;
#define GL_GLOAD(c_) do { const long long t0_ = tb + (long long)(c_) * SC_CH; \
        if (tid < 256) { const int step = tid >> 3, c4 = tid & 7; ga = *(const float4*)(GA + (t0_ + step) * 128 + h * 32 + 4 * c4); g1 = *(const uint4*)(P + (t0_ + step) * PW + C_GLA + 256 + h * 64 + 8 * c4); } \
        else { const int idx = tid - 256, step = idx >> 3, vec = (idx >> 2) & 1, c8 = idx & 3; g2 = *(const uint4*)(P + (t0_ + step) * PW + C_GLA + vec * 128 + h * 32 + 8 * c8); } } while (0)
#define GL_SSTORE(buf_) do { LAS float* B_ = (LAS float*)(lds + (buf_) * GL_BUF); float f[8]; \
        if (tid < 256) { const int step = tid >> 3, c4 = tid & 7; *(LAS f32x4_t*)(B_ + step * GL_STEP + 4 * c4) = (f32x4_t){ga.x, ga.y, ga.z, ga.w}; \
            cvt8(g1, f); LAS float* d = B_ + step * GL_STEP + 96 + 8 * c4; *(LAS f32x4_t*)d = (f32x4_t){f[0], f[1], f[2], f[3]}; *(LAS f32x4_t*)(d + 4) = (f32x4_t){f[4], f[5], f[6], f[7]}; } \
        else { const int idx = tid - 256, step = idx >> 3, vec = (idx >> 2) & 1, c8 = idx & 3; \
            cvt8(g2, f); LAS float* d = B_ + step * GL_STEP + (vec == 0 ? 64 : 32) + 8 * c8; *(LAS f32x4_t*)d = (f32x4_t){f[0], f[1], f[2], f[3]}; *(LAS f32x4_t*)(d + 4) = (f32x4_t){f[4], f[5], f[6], f[7]}; } } while (0)
    f32x4_t st = (f32x4_t){0.f, 0.f, 0.f, 0.f};
    GL_GLOAD(0); GL_SSTORE(0); __syncthreads();
    for (int c = 0; c < nch; ++c) {
        if (c + 1 < nch) GL_GLOAD(c + 1);
        const LAS float* B = (const LAS float*)(lds + (c & 1) * GL_BUF);
        for (int s = 0; s < SC_CH; ++s) { const LAS float* x = B + s * GL_STEP + 4 * kg;
            const f32x4_t a = *(const LAS f32x4_t*)x, k = *(const LAS f32x4_t*)(x + 32), qv = *(const LAS f32x4_t*)(x + 64); const float v = B[s * GL_STEP + 96 + vc];
            st = st * a + k * v; const f32x4_t pq = st * qv;
            const float o = sum8((pq[0] + pq[1]) + (pq[2] + pq[3]));
            if (kg == 0) OB[s * 64 + vc] = o * 0.17677669529663687f; }
        __syncthreads();
        {   const int s = tid >> 4, v0 = 4 * (tid & 15); const long long t = tb + (long long)c * SC_CH + s;
            const f32x4_t o = *(const LAS f32x4_t*)(OB + s * 64 + v0);
            const float ms = sum16s(o[0] * o[0] + o[1] * o[1] + o[2] * o[2] + o[3] * o[3]) * (1.0f / 64.0f), rs = rsqrtf(ms + 1e-6f);
            bf16_t* d = O + t * 1024 + 768 + h * 64 + v0; const uint2 g = *(const uint2*)d; const float4 n4 = *(const float4*)(ng + v0);
            uint2 w; w.x = pack2bf(o[0] * rs * n4.x * u2f(g.x << 16), o[1] * rs * n4.y * u2f(g.x & 0xffff0000u)); w.y = pack2bf(o[2] * rs * n4.z * u2f(g.y << 16), o[3] * rs * n4.w * u2f(g.y & 0xffff0000u)); *(uint2*)d = w; }
        if (c + 1 < nch) GL_SSTORE((c + 1) & 1);
        __syncthreads();
    }
}
__device__ __forceinline__ void ph_scans(const Params& p, int l, int wv, LAS unsigned char* lds, int gC, int gG) {
    const int nchain = (int)(p.B * 4);
    for (int it = gC; it < 2 * nchain; it += gG) { if (it < nchain) rwkv_chain(p, l, it, wv, lds); else gla_chain(p, l, it - nchain, wv, lds); }
}
#endif
#ifdef CPU_EMU
struct Ctx { long long gtid, gsz, gw, nw; int lane, G, c; };
#define GEMM(A, lda, Bt, ldb, K, S, E) gemm_cpu(A, lda, Bt, ldb, K, S, E)
#define GEMMK(A, lda, Bt, ldb, K, S, E, ks) gemm_cpu(A, lda, Bt, ldb, K, S, E, ks)
#define GRID_BARRIER() do { } while (0)
#else
struct Ctx { LAS unsigned char* lds; XcdBarrier bar; int wv; };
#define GEMM(A, lda, Bt, ldb, K, S, E) gemm_phase(cx.wv, cx.lds, A, lda, Bt, ldb, K, S, E)
#define GEMMK(A, lda, Bt, ldb, K, S, E, ks) gemm_phase(cx.wv, cx.lds, A, lda, Bt, ldb, K, S, E, ks)
#define GRID_BARRIER() xcd_barrier(cx.bar)
#endif
constexpr int N_PHASES = 56;
#ifndef PROBE_CONV
#define PROBE_CONV 1
#endif
#ifndef PROBE_PREP
#define PROBE_PREP 1
#endif
#ifndef PROBE_GEMM
#define PROBE_GEMM 1
#endif
#ifndef PROBE_CMP
#define PROBE_CMP 1
#endif

template <int KIND> DEVI void run_program(const Params& p, const Ctx& cx, int pb, int pe) {
    int ph = 0;
#define T p.T
#define DFF p.DFF
#ifdef CPU_EMU
    const long long gsz = cx.gsz, nw = cx.nw; const int gG = cx.G, gC = cx.c;
#else
#define gsz ((long long)gridDim.x * 512)
#define nw ((long long)gridDim.x * 8)
#define gG ((int)gridDim.x)
#define gC ((int)blockIdx.x)
#endif
#define H WSP(bf16_t, p.oH)
#define P WSP(bf16_t, p.oP)
#define O WSP(bf16_t, p.oO)
#define BO WSP(bf16_t, p.oBO)
#define MG WSP(bf16_t, p.oMG)
#define CQ WSP(bf16_t, p.oCQ)
#define CAO WSP(bf16_t, p.oCAO)
#define MEMN WSP(bf16_t, p.oMEMN)
#define ACT WSP(bf16_t, p.oACT)
#define WFFN WSP(bf16_t, p.oWFFN)
#ifdef CPU_EMU
#define OPAQUE_V(x) do { } while (0)
#define PH_IDX long long gtid = cx.gtid, gw = cx.gw; int lane = cx.lane
#else
#define OPAQUE_V(x) asm volatile("" : "+v"(x))
#define PH_IDX unsigned tx_ = (unsigned)(cx.wv * 64 + mk_lane()); OPAQUE_V(tx_); long long gtid = (long long)blockIdx.x * 512 + tx_, gw = (long long)(tx_ >> 6) * gridDim.x + blockIdx.x; int lane = tx_ & 63
#endif
#define PH_BEGIN(k) if (ph >= pb && ph < pe) { if constexpr (KIND < 0 || KIND == (k)) { PH_IDX; OPAQUE_V(gtid); OPAQUE_V(gw); OPAQUE_V(lane); (void)gtid; (void)gw; (void)lane;
#define PH_END   } if (ph + 1 < pe) GRID_BARRIER(); } ++ph;
    PH_BEGIN(0)
        for (int rep_ = 0; rep_ < PROBE_CONV; ++rep_) { ph_convert_layer(p, 0, gtid, gsz); ph_convert_layer(p, 1, gtid, gsz); ph_convert_ffn(p, gtid, gsz); ph_convert_cmp(p, gtid, gsz); } ph_rope(p, gtid, gsz);
        ph_rmsnorm(p, p.in[I_MEM], p.B * 256, p.in[I_MEM_NORM], MEMN, 0, nullptr, gw, nw, lane);
        ph_rmsnorm(p, p.in[I_X], T, p.in[I_NORM_MIX], H, 1, p.out, gw, nw, lane);
    PH_END
    PH_BEGIN(1)
        { SchedPlain S; S.init(p.B * 256, 1024, 1024, 1024, gG, gC); EpStore E{WSP(bf16_t, p.oKV), 1024, 1.0f}; GEMM(MEMN, 1024, WSP(bf16_t, p.oWKV), 1024, 1024, S, E); }
    PH_END
    for (int l = 0; l < 2; ++l) {
#define W WSP(bf16_t, p.oWL[l])
        PH_BEGIN(1) for (int rep_ = 0; rep_ < PROBE_GEMM; ++rep_) { SchedPlain S; S.init(T, 3072, 1024, 1024, gG, gC); EpStore E{P, 3072, 1.0f}; GEMM(H, 1024, W + W_IN, 1024, 1024, S, E); } PH_END
        PH_BEGIN(2) ph_rope_apply(p, gtid, gsz); { SchedCmp S; S.init(T / 16, gG, gC); EpUV E{WSP(bf16_t, p.oUV)}; GEMMK(P, 16LL * PW, WSP(bf16_t, p.oW1T) + (long long)l * 2 * 256 * 1024, 1024, 1024, S, E, (long long)PW); }
            ph_pool(p, l, gtid, gsz); ph_gla_prep(p, l, gtid, gsz);
#ifdef CPU_EMU
            { static bf16_t wl_[160 * 256]; rwkv_fill_wl(p, l, wl_, 0, 1); ph_rwkv_prep(p, l, wl_, gtid, gsz); }
#else
            { LDSQ bf16_t* wl_ = (LDSQ bf16_t*)cx.lds; rwkv_fill_wl(p, l, wl_, (int)tx_, 512); __syncthreads(); ph_rwkv_prep(p, l, wl_, gtid, gsz); }
#endif
#if PROBE_PREP == 2
            ph_pool(p, l, gtid, gsz);
#elif PROBE_PREP == 3
            ph_pool(p, l, gtid, gsz); ph_gla_prep(p, l, gtid, gsz);
#endif
 PH_END
        PH_BEGIN(3) ph_compress2(p, l, gtid, gsz); PH_END
#ifdef CPU_EMU
        PH_BEGIN(4) ph_rwkv_scan(p, l, gw, nw, lane); ph_gla_scan(p, l, (gw + nw - (p.B * 4) % nw) % nw, nw, lane); ph_cmp_attn(p, gtid, gsz); PH_END
#else
        PH_BEGIN(4) ph_scans(p, l, cx.wv, cx.lds, gC, gG); ph_cmp_attn_mfma(p, cx.wv, cx.lds, gC, gG); PH_END
#endif
#ifdef CPU_EMU
        PH_BEGIN(5) ph_selwin(p, gtid, gsz); PH_END
#else
        PH_BEGIN(5) ph_selwin_mfma(p, cx.wv, cx.lds, gC, gG); PH_END
#endif
        for (int q = 0; q < 4; ++q) { const long long r0 = q * (T / 4);
            PH_BEGIN(6) { SchedBranch S; S.init(T / 4, gG, gC); EpStore E{BO, 4096, 1.0f}; GEMM(O + r0 * 1024, 1024, W + W_B, 256, 256, S, E); } PH_END
            PH_BEGIN(7) { SchedGate S; S.init(T / 4, gG, gC); EpGate E{BO, p.in[I_B_GATE] + l * 4096, MG, r0}; GEMM(H + r0 * 1024, 1024, W + W_G, 1024, 1024, S, E); } PH_END }
        PH_BEGIN(8) { SchedPlain S; S.init(T, 1024, 1024, 1024, gG, gC); EpResid E{p.out}; GEMM(MG, 1024, W + W_O, 1024, 1024, S, E); } PH_END
        PH_BEGIN(9) ph_rmsnorm(p, p.out, T, p.in[I_NORM_CA] + l * 1024, H, 0, nullptr, gw, nw, lane); PH_END
        PH_BEGIN(1) { SchedPlain S; S.init(T, 256, 1024, 1024, gG, gC); EpStore E{CQ, 256, 0.125f}; GEMM(H, 1024, W + W_CQ, 1024, 1024, S, E); } PH_END
#ifdef CPU_EMU
        PH_BEGIN(10) ph_ca_attn(p, l, gtid, gsz); PH_END
#else
        PH_BEGIN(10) ph_ca_attn_mfma(p, l, cx.wv, cx.lds, gC, gG); PH_END
#endif
        PH_BEGIN(8) { SchedPlain S; S.init(T, 1024, 256, 256, gG, gC); EpResid E{p.out}; GEMM(CAO, 256, W + W_CO, 256, 256, S, E); } PH_END
        PH_BEGIN(9) ph_rmsnorm(p, p.out, T, p.in[I_NORM_FFN] + l * 1024, H, l == 1 ? 2 : 0, nullptr, gw, nw, lane); if (l == 1) for (int rep_ = 0; rep_ < PROBE_CONV; ++rep_) ph_convert_moe(p, gtid, gsz); PH_END
        if (l == 0) {
            PH_BEGIN(11) { SchedPlain S; S.init(T, 2 * DFF, 1024, 1024, gG, gC); EpSwiglu E{ACT, DFF, 0}; GEMM(H, 1024, WFFN, 1024, 1024, S, E); } PH_END
            PH_BEGIN(8) { SchedPlain S; S.init(T, 1024, DFF, DFF, gG, gC); EpResid E{p.out}; GEMM(ACT, DFF, WFFN + 2 * DFF * 1024, DFF, DFF, S, E); } PH_END
            PH_BEGIN(9) ph_rmsnorm(p, p.out, T, p.in[I_NORM_MIX] + 1024, H, 0, nullptr, gw, nw, lane); PH_END
        } else {
            PH_BEGIN(12) ph_moe_count(p, gtid, gsz); PH_END
            PH_BEGIN(12) ph_moe_offsets(p, gtid, gsz); PH_END
            PH_BEGIN(12) ph_moe_assign(p, gtid, gsz); PH_END
            PH_BEGIN(12) ph_moe_gather(p, gtid, gsz); PH_END
#define HS WSP(bf16_t, p.oHS)
#define ACTC WSP(bf16_t, p.oACTC)
#define MW WSP(bf16_t, p.oMOEW)
#define MC WSP(int, p.oMOEC)
            const int ct = (int)((p.NR / 256 + 3) / 4);
            for (int q = 0; q < 4; ++q) {
                PH_BEGIN(13) { SchedMoe S; const int nt_ = MC[16 + 8] / 256; S.t0 = q * ct; S.t1 = (q + 1) * ct < nt_ ? (q + 1) * ct : nt_; if (S.t1 < S.t0) S.t1 = S.t0; S.nN = (int)(2 * DFF / 256); S.G = gG; S.c = gC; S.lda = 1024; S.ldb = 1024; S.per_e = 3 * 1024 * DFF * 2;
#pragma unroll
                    for (int e = 0; e < 9; ++e) S.base[e] = MC[16 + e];
                    EpSwiglu E{ACTC, DFF, (long long)S.t0 * 256}; GEMM(HS, 1024, MW, 1024, 1024, S, E); } PH_END
                PH_BEGIN(14) { SchedMoe S; const int nt_ = MC[16 + 8] / 256; S.t0 = q * ct; S.t1 = (q + 1) * ct < nt_ ? (q + 1) * ct : nt_; if (S.t1 < S.t0) S.t1 = S.t0; S.nN = 4; S.G = gG; S.c = gC; S.lda = DFF; S.ldb = DFF; S.per_e = 3 * 1024 * DFF * 2;
#pragma unroll
                    for (int e = 0; e < 9; ++e) S.base[e] = MC[16 + e];
                    EpMoeDown E{WSP(bf16_t, p.oY), WSP(float, p.oROWW)}; GEMM(ACTC - (long long)S.t0 * 256 * DFF, DFF, MW + 2 * DFF * 1024, DFF, DFF, S, E); } PH_END }
            PH_BEGIN(15) ph_final(p, gw, nw, lane); PH_END
        }
    }
#undef PH_BEGIN
#undef PH_END
#undef H
#undef P
#undef O
#undef BO
#undef MG
#undef CQ
#undef CAO
#undef MEMN
#undef ACT
#undef WFFN
#undef T
#undef DFF
#undef W
#undef HS
#undef ACTC
#undef MW
#undef MC
#ifndef CPU_EMU
#undef gsz
#undef nw
#undef gG
#undef gC
#endif
}

#ifndef CPU_EMU
template <int KIND> __global__ __launch_bounds__(512, 2) void mk_fwd(Params p, int pb, int pe) {
    extern __shared__ __attribute__((aligned(16))) unsigned char shm[];
    Ctx cx; cx.lds = (LAS unsigned char*)shm;
    volatile LAS unsigned* xbw = (volatile LAS unsigned*)(cx.lds + STAGE_BYTES);
    if (threadIdx.x == 0) { xbw[0] = 0u; xbw[1] = 0u; xbw[2] = 0u; xbw[3] = 0u; }
    __syncthreads();
    cx.wv = __builtin_amdgcn_readfirstlane((int)(threadIdx.x >> 6));
    cx.bar = xcd_barrier_post((unsigned*)(p.ws + p.oBAR), xbw, cx.wv);
    run_program<KIND>(p, cx, pb, pe);
}
#ifndef MK_ONE
#define MK_ONE 1
#endif
#if !MK_ONE
static const int kPhaseKind[N_PHASES] = { 0, 1,
    1, 2, 3, 4, 5, 6, 7, 6, 7, 6, 7, 6, 7, 8, 9, 1, 10, 8, 9, 11, 8, 9,
    1, 2, 3, 4, 5, 6, 7, 6, 7, 6, 7, 6, 7, 8, 9, 1, 10, 8, 9, 12, 12, 12, 12, 13, 14, 13, 14, 13, 14, 13, 14, 15 };
#endif
typedef void (*mk_fn)(Params, int, int);
extern "C" void kernel_launch(void* const* d_in, const int* in_sizes, int n_in, void* d_out, int out_size, void* d_ws, size_t ws_size, hipStream_t stream) {
    (void)in_sizes; (void)n_in; (void)out_size;
    Params p; memset(&p, 0, sizeof(p));
    for (int i = 0; i < N_INPUTS; ++i) p.in[i] = (const float*)d_in[i];
    p.out = (float*)d_out; p.ws = (unsigned char*)d_ws;
    make_layout(p, 32, 2048, 2816);
    for (int j = 0; j < 8; ++j) p.inv_freq[j] = (float)pow(500000.0, -(double)(2 * j) / 16.0);
    if ((size_t)p.wsNeed > ws_size) { fprintf(stderr, "workspace too small: need %lld have %zu\n", p.wsNeed, ws_size); return; }
    const size_t lds_bytes = STAGE_BYTES + 16;
#if MK_ONE
    static const mk_fn fns[1] = { mk_fwd<-1> }; const int nf = 1;
#else
    static const mk_fn fns[16] = { mk_fwd<0>, mk_fwd<1>, mk_fwd<2>, mk_fwd<3>, mk_fwd<4>, mk_fwd<5>, mk_fwd<6>, mk_fwd<7>, mk_fwd<8>, mk_fwd<9>, mk_fwd<10>, mk_fwd<11>, mk_fwd<12>, mk_fwd<13>, mk_fwd<14>, mk_fwd<15> }; const int nf = 16;
#endif
    static int grid = 0;
    if (!grid) { int dev = 0, cus = 0; (void)hipGetDevice(&dev); (void)hipDeviceGetAttribute(&cus, hipDeviceAttributeMultiprocessorCount, dev);
        for (int k = 0; k < nf; ++k) (void)hipFuncSetAttribute((const void*)fns[k], hipFuncAttributeMaxDynamicSharedMemorySize, (int)lds_bytes);
        int per_cu = 0; (void)hipOccupancyMaxActiveBlocksPerMultiprocessor(&per_cu, (const void*)fns[0], 512, lds_bytes); (void)hipGetLastError();
        grid = cus > 0 ? cus : 256; }
    (void)hipMemsetAsync(p.ws + p.oBAR, 0, 16384 + 4096, stream);
#if MK_ONE
    hipLaunchKernelGGL(fns[0], dim3(grid), dim3(512), lds_bytes, stream, p, 0, N_PHASES);
#else
    for (int ph = 0; ph < N_PHASES; ++ph) hipLaunchKernelGGL(fns[kPhaseKind[ph]], dim3(grid), dim3(512), lds_bytes, stream, p, ph, ph + 1);
#endif
}
#endif
```

```cpp
#ifndef CPU_EMU
#include <hip/hip_runtime.h>
#include <cstdio>
#include <cstdint>
#include <cstring>
#define DEVI __device__ __forceinline__
#define DEVM __device__ __forceinline__
#else
#include <cmath>
#include <cstdio>
#include <cstdint>
#include <cstring>
#include <cstdlib>
#define DEVI static inline
#define DEVM inline
struct uint4 { unsigned x, y, z, w; };
#endif

typedef unsigned short bf16_t;
#ifdef CPU_EMU
static inline float u2f(unsigned u) { float f; memcpy(&f, &u, 4); return f; }
static inline unsigned f2u(float f) { unsigned u; memcpy(&u, &f, 4); return u; }
#else
DEVI float u2f(unsigned u) { return __uint_as_float(u); }
DEVI unsigned f2u(float f) { return __float_as_uint(f); }
#endif
DEVI float bf2f(bf16_t b) { return u2f(((unsigned)b) << 16); }
DEVI bf16_t f2bf(float f) { unsigned u = f2u(f); u += 0x7FFFu + ((u >> 16) & 1u); return (bf16_t)(u >> 16); }
DEVI float sigmoidf_(float x) { return 1.0f / (1.0f + expf(-x)); }
DEVI float siluf_(float x) { return x / (1.0f + expf(-x)); }
DEVI float softplusf_(float x) { return x > 20.f ? x : log1pf(expf(x)); }
DEVI float gelu_tanhf_(float x) { return 0.5f * x * (1.0f + tanhf(0.7978845608028654f * (x + 0.044715f * x * x * x))); }

DEVI void st8(bf16_t* dst, const float* v) {
#ifndef CPU_EMU
    uint4 w; w.x = (unsigned)f2bf(v[0]) | ((unsigned)f2bf(v[1]) << 16); w.y = (unsigned)f2bf(v[2]) | ((unsigned)f2bf(v[3]) << 16); w.z = (unsigned)f2bf(v[4]) | ((unsigned)f2bf(v[5]) << 16); w.w = (unsigned)f2bf(v[6]) | ((unsigned)f2bf(v[7]) << 16);
    *(uint4*)dst = w;
#else
    for (int j = 0; j < 8; ++j) dst[j] = f2bf(v[j]);
#endif
}
DEVI void ld8(const bf16_t* src, float* v) {
#ifndef CPU_EMU
    const uint4 w = *(const uint4*)src; v[0] = u2f(w.x << 16); v[1] = u2f(w.x & 0xffff0000u); v[2] = u2f(w.y << 16); v[3] = u2f(w.y & 0xffff0000u); v[4] = u2f(w.z << 16); v[5] = u2f(w.z & 0xffff0000u); v[6] = u2f(w.w << 16); v[7] = u2f(w.w & 0xffff0000u);
#else
    for (int j = 0; j < 8; ++j) v[j] = bf2f(src[j]);
#endif
}
#ifdef CPU_EMU
#define SCHED_FENCE() do { } while (0)
#define LDSQ
DEVI void ld8l(const bf16_t* src, float* v) { ld8(src, v); }
#else
#define SCHED_FENCE() __builtin_amdgcn_sched_barrier(0)
#define LDSQ __attribute__((address_space(3)))
typedef unsigned u32x4l_t __attribute__((ext_vector_type(4)));
DEVI void ld8l(const LDSQ bf16_t* src, float* v) { const u32x4l_t w = *(const LDSQ u32x4l_t*)src; v[0] = u2f(w[0] << 16); v[1] = u2f(w[0] & 0xffff0000u); v[2] = u2f(w[1] << 16); v[3] = u2f(w[1] & 0xffff0000u);
    v[4] = u2f(w[2] << 16); v[5] = u2f(w[2] & 0xffff0000u); v[6] = u2f(w[3] << 16); v[7] = u2f(w[3] & 0xffff0000u); }
#endif
constexpr int DM = 1024;
constexpr int PW = 3072;
constexpr int INW = 2972;
constexpr int C_Q = 0, C_KC = 256, C_VC = 384, C_KS = 512, C_VS = 640, C_KW = 768, C_VW = 896, C_NG = 1024;
constexpr int C_POOL = 1040;
constexpr int C_RW = 1296;
constexpr int C_GLA = 2192;
constexpr int C_VRES = 2976;
constexpr int NCMPH = 128;

enum { I_X = 0, I_MEM, I_POS, I_NORM_MIX, I_W_IN, I_CMP_PE, I_CMP_W1, I_CMP_W2, I_POOL_W, I_POOL_SCALE, I_RW_MU, I_RW_W0, I_RW_W2, I_RW_A0, I_RW_A2, I_RW_G2,
       I_RW_V0, I_RW_V1, I_RW_V2, I_RW_KK, I_RW_KA, I_RW_RK, I_RW_LN, I_GLA_A2, I_GLA_AB, I_GLA_NORM, I_W_GATE, I_B_GATE, I_W_BRANCH, I_W_OUT, I_NORM_CA, I_MEM_NORM,
       I_CA_Q, I_CA_KV, I_CA_O, I_NORM_FFN, I_FFN_G, I_FFN_U, I_FFN_D, I_MOE_R, I_MOE_G, I_MOE_U, I_MOE_D, I_NORM_FINAL, N_INPUTS };

struct Params {
    const float* in[N_INPUTS];
    float* out;
    unsigned char* ws;
    long long B, S, T, DFF, NC, NR;
    float inv_freq[8];
    long long oBAR, oMOEC, oROPE, oKCMP, oVCMP, oUV, oW1T, oCB, oSELM, oKV, oTOKE, oTOKW, oTOKS, oR2T, oROWW, oCCNT, oCOFF;
    long long oWL[2], oWKV, oWFFN, oVF, oH, oP, oO, oBO, oMG, oRWW, oRWX, oGA, oCQ, oCAO, oMEMN, oACT, oY, oHS, oMOEW, oACTC, wsNeed;
};
constexpr long long W_IN = 0, W_G = W_IN + 3072LL * 1024, W_B = W_G + 4096LL * 1024, W_O = W_B + 4LL * 1024 * 256, W_CQ = W_O + 1024LL * 1024, W_CKV = W_CQ + 256LL * 1024,
                    W_CO = W_CKV + 512LL * 1024, W_LAYER = W_CO + 1024LL * 256;

static inline long long al256(long long x) { return (x + 255) & ~255LL; }
static inline void make_layout(Params& p, long long B, long long S, long long DFF) {
    p.B = B; p.S = S; p.T = B * S; p.DFF = DFF; p.NC = (S - 32) / 16 + 1; p.NR = 2 * p.T + 2048;
    const long long T = p.T;
    long long o = 0;
    auto take = [&](long long bytes) { long long r = o; o = al256(o + bytes); return r; };
    p.oBAR = take(16384); p.oMOEC = take(4096);
    p.oROPE = take(T * 16 * 4);
    p.oKCMP = take(B * p.NC * 128 * 4); p.oVCMP = take(B * p.NC * 128 * 4); p.oUV = take((T / 16) * 4 * 256 * 2); p.oW1T = take(2LL * 2 * 256 * 1024 * 2); p.oCB = take(2 * 2 * 128 * 4);
    p.oSELM = take(T * 2 * 4);
    p.oKV = take(2 * B * 256 * 512 * 2);
    p.oTOKE = take(T * 2 * 4); p.oTOKW = take(T * 2 * 4); p.oTOKS = take(T * 2 * 4); p.oR2T = take(p.NR * 4); p.oROWW = take(p.NR * 4);
    p.oWL[0] = take(W_LAYER * 2); p.oWL[1] = take(W_LAYER * 2); p.oWKV = take(2LL * 512 * 1024 * 2); p.oWFFN = take(3 * 1024 * DFF * 2);
    p.oVF = take(T * 256 * 2);
    p.oH = take(T * 1024 * 2);
    p.oP = take(T * 3072 * 2);
    p.oO = take(T * 1024 * 2);
    p.oBO = take(T * 2048);
    p.oMG = take(T * 2048);
    long long end_main = o;
    p.oRWW = p.oBO;
    p.oRWX = p.oRWW + T * 1024;
    p.oGA = p.oRWX + T * 2560;
    p.oCQ = p.oP; p.oCAO = p.oP + T * 512;
    p.oCCNT = p.oKCMP; p.oCOFF = p.oVCMP;
    p.oMEMN = p.oBO;
    p.oACT = p.oP;
    p.oY = p.oVF; long long q = al256(p.oY + p.NR * 2048);
    p.oHS = q; q = al256(q + p.NR * 2048);
    p.oMOEW = q; q = al256(q + 8LL * 3 * 1024 * DFF * 2);
    const long long ntmax = p.NR / 256, ct = ntmax >= 512 ? 128 : (ntmax + 3) / 4;
    p.oACTC = q; q = al256(q + ct * 256 * DFF * 2);
    p.wsNeed = q > end_main ? q : end_main;
}
#define WSP(T_, off) ((T_*)(p.ws + (off)))

DEVI void cvt_tile8(bf16_t* dst, long long K, const float* src0, long long ld) {
    float v[8][8];
#pragma unroll
    for (int kk = 0; kk < 8; ++kk) {
#pragma unroll
        for (int nn = 0; nn < 8; ++nn) v[kk][nn] = src0[kk * ld + nn]; }
#pragma unroll
    for (int nn = 0; nn < 8; ++nn) { float o[8];
#pragma unroll
        for (int kk = 0; kk < 8; ++kk) o[kk] = v[kk][nn];
        st8(dst + nn * K, o); }
}
DEVI void cvt_T(bf16_t* dst, const float* src, long long K, long long N, long long Npad, long long ld, long long gtid, long long gsz) {
    (void)Npad; const long long tk = K >> 6, tiles = (N >> 6) * tk;
    for (long long i = gtid; i < tiles * 64; i += gsz) { const long long tile = i >> 6; const int li = (int)(i & 63), kl = li >> 3, nl = li & 7; const long long n0 = (tile / tk) * 64 + 8 * nl, k0 = (tile % tk) * 64 + 8 * kl;
        cvt_tile8(dst + n0 * K + k0, K, src + k0 * ld + n0, ld); }
}
DEVI void cvt_GU(bf16_t* dst, const float* wg, const float* wu, long long DFF, long long gtid, long long gsz) {
    const long long tiles = (2 * DFF >> 6) * 16;
    for (long long i = gtid; i < tiles * 64; i += gsz) { const long long tile = i >> 6; const int li = (int)(i & 63), kl = li >> 3, nl = li & 7; const long long rr0 = (tile >> 4) * 64 + 8 * nl, k0 = (tile & 15) * 64 + 8 * kl;
        const long long t = rr0 >> 8, w = rr0 & 255; const float* src = (w < 128 ? wg : wu) + k0 * DFF + t * 128 + (w & 127);
        cvt_tile8(dst + rr0 * 1024 + k0, 1024, src, DFF); }
}
DEVI void ph_convert_layer(const Params& p, int l, long long gtid, long long gsz) {
    bf16_t* W = WSP(bf16_t, p.oWL[l]);
    for (long long i = gtid; i < 48LL * 16 * 64; i += gsz) { const long long tile = i >> 6; const int li = (int)(i & 63), kl = li >> 3, nl = li & 7; const long long n0 = (tile >> 4) * 64 + 8 * nl, k0 = (tile & 15) * 64 + 8 * kl;
#pragma unroll
        for (int nn = 0; nn < 8; ++nn) { const long long n = n0 + nn; float o[8];
#pragma unroll
            for (int kk = 0; kk < 8; ++kk) { const long long k = k0 + kk; float v = 0.f;
                if (n < 1036) v = p.in[I_W_IN][((long long)l * 1024 + k) * INW + n];
                else if (n >= C_POOL && n < C_VRES) v = p.in[I_W_IN][((long long)l * 1024 + k) * INW + n - 4];
                else if (n >= C_VRES && n < C_VRES + 32 && l == 1) v = p.in[I_RW_V1][k * 32 + (n - C_VRES)];
                o[kk] = v; }
            st8(W + W_IN + n * 1024 + k0, o); } }
    for (int i = 0; i < 4; ++i) cvt_T(W + W_G + (long long)i * 1024 * 1024, p.in[I_W_GATE] + ((long long)l * 4 + i) * 1024 * 1024, 1024, 1024, 1024, 1024, gtid, gsz);
    for (int i = 0; i < 4; ++i) cvt_T(W + W_B + (long long)i * 1024 * 256, p.in[I_W_BRANCH] + ((long long)l * 4 + i) * 256 * 1024, 256, 1024, 1024, 1024, gtid, gsz);
    cvt_T(W + W_O, p.in[I_W_OUT] + (long long)l * 1024 * 1024, 1024, 1024, 1024, 1024, gtid, gsz);
    cvt_T(W + W_CQ, p.in[I_CA_Q] + (long long)l * 1024 * 256, 1024, 256, 256, 256, gtid, gsz);
    cvt_T(WSP(bf16_t, p.oWKV) + (long long)l * 512 * 1024, p.in[I_CA_KV] + (long long)l * 1024 * 512, 1024, 512, 512, 512, gtid, gsz);
    cvt_T(W + W_CO, p.in[I_CA_O] + (long long)l * 256 * 1024, 256, 1024, 1024, 1024, gtid, gsz);
}
DEVI void ph_convert_ffn(const Params& p, long long gtid, long long gsz) {
    bf16_t* W = WSP(bf16_t, p.oWFFN);
    cvt_GU(W, p.in[I_FFN_G], p.in[I_FFN_U], p.DFF, gtid, gsz);
    cvt_T(W + 2 * p.DFF * 1024, p.in[I_FFN_D], p.DFF, 1024, 1024, 1024, gtid, gsz);
}
DEVI void ph_convert_moe(const Params& p, long long gtid, long long gsz) {
    const long long DFF = p.DFF, per = 3 * 1024 * DFF;
    for (int e = 0; e < 8; ++e) { bf16_t* W = WSP(bf16_t, p.oMOEW) + e * per;
        cvt_GU(W, p.in[I_MOE_G] + (long long)e * 1024 * DFF, p.in[I_MOE_U] + (long long)e * 1024 * DFF, DFF, gtid, gsz);
        cvt_T(W + 2 * DFF * 1024, p.in[I_MOE_D] + (long long)e * DFF * 1024, DFF, 1024, 1024, 1024, gtid, gsz); }
}
DEVI void ph_rope(const Params& p, long long gtid, long long gsz) {
    const int* pos = (const int*)p.in[I_POS]; float* R = WSP(float, p.oROPE);
    for (long long i = gtid; i < p.T * 8; i += gsz) { const long long t = i >> 3; const int j = (int)(i & 7);
        const float ang = (float)pos[t] * p.inv_freq[j];
        double a = (double)ang; a -= 6.283185307179586476925 * floor(a * 0.15915494309189533577 + 0.5);
        const float ar = (float)a; R[t * 16 + j] = cosf(ar); R[t * 16 + 8 + j] = sinf(ar); }
}
DEVI void ph_rope_apply(const Params& p, long long gtid, long long gsz) {
    bf16_t* P = WSP(bf16_t, p.oP); const float* R = WSP(float, p.oROPE);
    for (long long i = gtid; i < p.T * 8; i += gsz) { const long long t = i >> 3; const int w = (int)(i & 7);
        const int col = w < 4 ? C_Q + w * 64 : (w < 6 ? C_KS + (w - 4) * 64 : C_KW + (w - 6) * 64);
        bf16_t* x = P + t * PW + col; const float* r = R + t * 16; const float sc = w < 4 ? 0.125f : 1.0f;
        float a[8], b[8], c[8], s[8], o1[8], o2[8]; ld8(x, a); ld8(x + 8, b);
#pragma unroll
        for (int j = 0; j < 8; ++j) { c[j] = r[j]; s[j] = r[8 + j]; }
#pragma unroll
        for (int j = 0; j < 8; ++j) { o1[j] = (a[j] * c[j] - b[j] * s[j]) * sc; o2[j] = (b[j] * c[j] + a[j] * s[j]) * sc; }
        st8(x, o1); st8(x + 8, o2);
        if (w < 4) {
#pragma unroll
            for (int q8 = 2; q8 < 8; ++q8) { float f[8]; ld8(x + 8 * q8, f);
#pragma unroll
                for (int j = 0; j < 8; ++j) f[j] *= 0.125f;
                st8(x + 8 * q8, f); } } }
}
DEVI void ph_compress2(const Params& p, int l, long long gtid, long long gsz) {
    const bf16_t* UV = WSP(bf16_t, p.oUV); const float* CB = WSP(float, p.oCB) + l * 256; const float* w2 = p.in[I_CMP_W2] + (long long)l * 2 * 128 * 64; const float* R = WSP(float, p.oROPE);
    float* KC = WSP(float, p.oKCMP); float* VC = WSP(float, p.oVCMP);
    const long long n_items = p.B * p.NC * 2 * 2 * 8, hb = p.S / 16;
    for (long long i = gtid; i < n_items; i += gsz) { const int d8 = (int)(i & 7), j = (int)((i >> 3) & 1), g = (int)((i >> 4) & 1); const long long bn = i >> 5, n = bn % p.NC, b = bn / p.NC;
        const bf16_t* u = UV + ((b * hb + n) * 4 + (2 * j + g)) * 256; const bf16_t* vv = u + 4 * 256 + 128; const float* w = w2 + (long long)j * 128 * 64; const float* cb = CB + j * 128;
        float a[8];
#pragma unroll
        for (int m = 0; m < 8; ++m) a[m] = 0.f;
        for (int f = 0; f < 128; ++f) { const float hv = gelu_tanhf_(bf2f(u[f]) + bf2f(vv[f]) + cb[f]);
#pragma unroll
            for (int m = 0; m < 8; ++m) a[m] += hv * w[f * 64 + d8 + 8 * m]; }
        if (j == 0) { const float* r = R + (b * p.S + n * 16 + 31) * 16; const float x0 = a[0], x1 = a[1], cs = r[d8], sn = r[8 + d8]; a[0] = x0 * cs - x1 * sn; a[1] = x1 * cs + x0 * sn; }
        float* dst = (j == 0 ? KC : VC) + (bn * 2 + g) * 64;
#pragma unroll
        for (int m = 0; m < 8; ++m) dst[d8 + 8 * m] = a[m]; }
}
DEVI void ph_convert_cmp(const Params& p, long long gtid, long long gsz) {
    bf16_t* W1T = WSP(bf16_t, p.oW1T); float* CB = WSP(float, p.oCB);
    for (long long i = gtid; i < 2LL * 2 * 256 * 1024; i += gsz) { const int k = (int)(i & 1023), n = (int)((i >> 10) & 255); const long long lj = i >> 18; const int half = n >> 7, f = n & 127, tap = k >> 6, d = k & 63;
        W1T[i] = f2bf(p.in[I_CMP_W1][((lj * 32 + half * 16 + tap) * 64 + d) * 128 + f]); }
    for (long long i = gtid; i < 2 * 2 * 128; i += gsz) { const int f = (int)(i & 127); const long long lj = i >> 7; float a = 0.f;
        for (int k = 0; k < 2048; ++k) a += p.in[I_CMP_PE][lj * 2048 + k] * p.in[I_CMP_W1][(lj * 2048 + k) * 128 + f];
        CB[i] = a; }
}
template <int WIN> DEVI void pool_item(const Params& p, int l, int g, long long t, int dq) {
    const bf16_t* P = WSP(bf16_t, p.oP); bf16_t* O = WSP(bf16_t, p.oO);
    const float* w = p.in[I_POOL_W] + (long long)l * 4 * 64 * 64 + g * 64 * 64 + dq * 16; const float* ps = p.in[I_POOL_SCALE] + (long long)l * 256 + g * 64 + dq * 16;
    const long long s = t % p.S; const int cnt = (int)(s + 1 < WIN ? s + 1 : WIN); const float inv = 1.0f / (float)cnt;
    float a[16];
#pragma unroll
    for (int d = 0; d < 16; ++d) a[d] = 0.f;
#pragma nounroll
    for (int c8 = 0; c8 < 8; ++c8) { float dv[8], f0[8];
        ld8(P + t * PW + C_POOL + g * 64 + 8 * c8, f0);
#pragma unroll
        for (int j = 0; j < 8; ++j) dv[j] = f0[j];
#pragma unroll
        for (int k = 1; k < WIN; ++k) { float f[8];
            if (k < cnt) ld8(P + (t - k) * PW + C_POOL + g * 64 + 8 * c8, f); else {
#pragma unroll
                for (int j = 0; j < 8; ++j) f[j] = 0.f; }
#pragma unroll
            for (int j = 0; j < 8; ++j) dv[j] += f[j]; }
#pragma unroll
        for (int j = 0; j < 8; ++j) { dv[j] = dv[j] * inv - f0[j];
#pragma unroll
            for (int d = 0; d < 16; ++d) a[d] += dv[j] * w[(8 * c8 + j) * 64 + d]; } }
#pragma unroll
    for (int d = 0; d < 16; ++d) a[d] *= ps[d];
    st8(O + t * 1024 + 256 + g * 64 + dq * 16, a); st8(O + t * 1024 + 256 + g * 64 + dq * 16 + 8, a + 8);
}
DEVI void ph_pool(const Params& p, int l, long long gtid, long long gsz) {
    for (long long i = gtid; i < p.T * 16; i += gsz) { const int g = (int)(i / (p.T * 4)); const long long rem = i % (p.T * 4), t = rem >> 2; const int dq = (int)(rem & 3);
        if (g == 0) pool_item<2>(p, l, 0, t, dq); else if (g == 1) pool_item<4>(p, l, 1, t, dq); else if (g == 2) pool_item<8>(p, l, 2, t, dq); else pool_item<16>(p, l, 3, t, dq); }
}
DEVI void st16bf(bf16_t* dst, const float (&v)[16]) { st8(dst, v); st8(dst + 8, v + 8); }
DEVI float pick8v(float a0, float a1, float a2, float a3, float a4, float a5, float a6, float a7, int i) {
    float r = a0; r = (i == 1) ? a1 : r; r = (i == 2) ? a2 : r; r = (i == 3) ? a3 : r; r = (i == 4) ? a4 : r; r = (i == 5) ? a5 : r; r = (i == 6) ? a6 : r; r = (i == 7) ? a7 : r; return r; }
#define pick8(a, i) pick8v((a)[0], (a)[1], (a)[2], (a)[3], (a)[4], (a)[5], (a)[6], (a)[7], (i))
DEVI void lerp8(const bf16_t* x, const bf16_t* xp, const float* mu, bool first, float* out) {
    float a[8], b[8]; ld8(x, a);
    if (first) {
#pragma unroll
        for (int j = 0; j < 8; ++j) b[j] = 0.f; } else ld8(xp, b);
#pragma unroll
    for (int j = 0; j < 8; ++j) out[j] = a[j] + (b[j] - a[j]) * mu[j];
}
DEVI void rwkv_fill_wl(const Params& p, int l, LDSQ bf16_t* wl, int tid, int nthr) {
    const float* w2 = p.in[I_RW_W2] + l * 32 * 256; const float* a2 = p.in[I_RW_A2] + l * 32 * 256; const float* g2 = p.in[I_RW_G2] + l * 64 * 256; const float* v2 = p.in[I_RW_V2];
    for (int i = tid; i < 160 * 256; i += nthr) { const int r = i >> 8, c = i & 255; float v;
        if (r < 32) v = w2[r * 256 + c]; else if (r < 64) v = a2[(r - 32) * 256 + c]; else if (r < 96) v = (l == 1) ? v2[(r - 64) * 256 + c] : 0.f; else v = g2[(r - 96) * 256 + c];
        wl[i] = f2bf(v); }
}
DEVI void ph_rwkv_prep(const Params& p, int l, const LDSQ bf16_t* wl, long long gtid, long long gsz) {
    const bf16_t* P = WSP(bf16_t, p.oP); float* RWW = WSP(float, p.oRWW); bf16_t* RWX = WSP(bf16_t, p.oRWX); bf16_t* O = WSP(bf16_t, p.oO); bf16_t* VF = WSP(bf16_t, p.oVF);
    const float* mu = p.in[I_RW_MU] + l * 896; const float* w0 = p.in[I_RW_W0] + l * 256; const float* a0 = p.in[I_RW_A0] + l * 256;
    const float* kkw = p.in[I_RW_KK] + l * 256; const float* kaw = p.in[I_RW_KA] + l * 256; const float* v0 = p.in[I_RW_V0];
    for (long long i = gtid; i < p.T * 16; i += gsz) { const long long t = i >> 4; const int h = (int)((i >> 2) & 3), cc = (int)(i & 3); const bool first = (t % p.S) == 0;
        const bf16_t* x = P + t * PW + C_RW; const bf16_t* xp = x - PW; const int c0 = h * 64 + cc * 16;
        float nn = 0.f;
#pragma nounroll
        for (int q8 = 0; q8 < 8; ++q8) { float kq[8]; lerp8(x + 256 + h * 64 + 8 * q8, xp + 256 + h * 64 + 8 * q8, mu + 256 + h * 64 + 8 * q8, first, kq);
#pragma unroll
            for (int j = 0; j < 8; ++j) { const float e = kq[j] * kkw[h * 64 + 8 * q8 + j]; nn += e * e; } }
        const float rn = 1.0f / fmaxf(sqrtf(nn), 1e-12f);
        float zw[16], za[16], zg[16], zv[16];
#pragma unroll
        for (int u = 0; u < 16; ++u) { zw[u] = w0[c0 + u]; za[u] = a0[c0 + u]; zg[u] = 0.f; zv[u] = (l == 1) ? v0[c0 + u] : 0.f; }
#pragma nounroll
        for (int j8 = 0; j8 < 4; ++j8) { float tw[8], ad[8], hv[8]; lerp8(x + 768 + 8 * j8, xp + 768 + 8 * j8, mu + 768 + 8 * j8, first, tw); lerp8(x + 800 + 8 * j8, xp + 800 + 8 * j8, mu + 800 + 8 * j8, first, ad);
            if (l == 1) ld8(P + t * PW + C_VRES + 8 * j8, hv); else {
#pragma unroll
                for (int jj = 0; jj < 8; ++jj) hv[jj] = 0.f; }
#pragma nounroll
            for (int jj = 0; jj < 8; ++jj) { const int j = 8 * j8 + jj; const float twv = tanhf(pick8(tw, jj)), adv = pick8(ad, jj), hvv = pick8(hv, jj); float ww[16], wa[16], wv[16];
                ld8l(wl + j * 256 + c0, ww); ld8l(wl + j * 256 + c0 + 8, ww + 8); ld8l(wl + (32 + j) * 256 + c0, wa); ld8l(wl + (32 + j) * 256 + c0 + 8, wa + 8);
                if (l == 1) { ld8l(wl + (64 + j) * 256 + c0, wv); ld8l(wl + (64 + j) * 256 + c0 + 8, wv + 8); }
#pragma unroll
                for (int u = 0; u < 16; ++u) { zw[u] += twv * ww[u]; za[u] += adv * wa[u]; if (l == 1) zv[u] += hvv * wv[u]; }
                SCHED_FENCE(); } }
#pragma nounroll
        for (int j8 = 0; j8 < 8; ++j8) { float gd[8]; lerp8(x + 832 + 8 * j8, xp + 832 + 8 * j8, mu + 832 + 8 * j8, first, gd);
#pragma nounroll
            for (int jj = 0; jj < 8; ++jj) { const int j = 8 * j8 + jj; const float sg = sigmoidf_(pick8(gd, jj)); float wg[16]; ld8l(wl + (96 + j) * 256 + c0, wg); ld8l(wl + (96 + j) * 256 + c0 + 8, wg + 8);
#pragma unroll
                for (int u = 0; u < 16; ++u) zg[u] += sg * wg[u];
                SCHED_FENCE(); } }
        st16bf(O + t * 1024 + 512 + c0, zg);
#pragma unroll
        for (int hf = 0; hf < 2; ++hf) { const int cb = c0 + 8 * hf; float r8[8], k8[8], v8[8], vf8[8], kk8[8], b8[8], d8[8];
            lerp8(x + cb, xp + cb, mu + cb, first, r8); lerp8(x + 256 + cb, xp + 256 + cb, mu + 256 + cb, first, k8); lerp8(x + 512 + cb, xp + 512 + cb, mu + 512 + cb, first, v8);
            if (l == 1) ld8(VF + t * 256 + cb, vf8);
#pragma unroll
            for (int u = 0; u < 8; ++u) { const int c = cb + u, uu = 8 * hf + u;
                const float wlog = -softplusf_(-zw[uu]) - 0.5f, dec = expf(-expf(wlog)), a = sigmoidf_(za[uu]);
                const float k = k8[u]; float v = v8[u];
                if (l == 1) v = v + (vf8[u] - v) * sigmoidf_(zv[uu]);
                const float kk = k * kkw[c] * rn;
                d8[u] = dec; k8[u] = k * (1.0f + (a - 1.0f) * kaw[c]); v8[u] = v; kk8[u] = kk; b8[u] = kk * a; }
            float* ww = RWW + t * 256 + cb;
#pragma unroll
            for (int u = 0; u < 8; ++u) ww[u] = d8[u];
            bf16_t* rx = RWX + t * 1280 + cb;
            st8(rx, r8); st8(rx + 256, k8); st8(rx + 512, v8); st8(rx + 768, kk8); st8(rx + 1024, b8);
            if (l == 0) st8(VF + t * 256 + cb, v8);
            SCHED_FENCE(); } }
}
DEVI float rwkv_row_step(float (&st)[64], const float* w, const bf16_t* r, const bf16_t* k, const bf16_t* kk, const bf16_t* b, float v) {
    float skk = 0.f;
#pragma unroll
    for (int c = 0; c < 64; ++c) skk += st[c] * bf2f(kk[c]);
    float y = 0.f;
#pragma unroll
    for (int c = 0; c < 64; ++c) { st[c] = st[c] * w[c] - skk * bf2f(b[c]) + v * bf2f(k[c]); y += st[c] * bf2f(r[c]); }
    return y;
}
DEVI void ph_gla_prep(const Params& p, int l, long long gtid, long long gsz) {
    const bf16_t* P = WSP(bf16_t, p.oP); float* GA = WSP(float, p.oGA); bf16_t* O = WSP(bf16_t, p.oO);
    const float* a2 = p.in[I_GLA_A2] + l * 16 * 128; const float* ab = p.in[I_GLA_AB] + l * 128;
    for (long long i = gtid; i < p.T * 128; i += gsz) { const long long t = i >> 7; const int c = (int)(i & 127); const bf16_t* ad = P + t * PW + C_GLA + 512;
        float z = ab[c];
        for (int j = 0; j < 16; ++j) z += bf2f(ad[j]) * a2[j * 128 + c];
        GA[i] = expf(-softplusf_(-z) * 0.0625f);
        const bf16_t* og = P + t * PW + C_GLA + 528; O[t * 1024 + 768 + c] = f2bf(siluf_(bf2f(og[c]))); O[t * 1024 + 768 + 128 + c] = f2bf(siluf_(bf2f(og[128 + c]))); }
}
DEVI float gla_col_step(float (&st)[32], const float* a, const bf16_t* q, const bf16_t* k, float v) {
    float o = 0.f;
#pragma unroll
    for (int c = 0; c < 32; ++c) { st[c] = st[c] * a[c] + bf2f(k[c]) * v; o += st[c] * bf2f(q[c]); }
    return o * 0.17677669529663687f;
}
DEVI void ph_cmp_attn(const Params& p, long long gtid, long long gsz) {
    const bf16_t* P = WSP(bf16_t, p.oP); const float* KC = WSP(float, p.oKCMP); const float* VC = WSP(float, p.oVCMP); unsigned* SELM = WSP(unsigned, p.oSELM); bf16_t* O = WSP(bf16_t, p.oO);
    for (long long i = gtid; i < p.T * 2; i += gsz) { const long long t = i >> 1, b = t / p.S, s = t % p.S; const int g = (int)(i & 1);
        const int nv = s >= 31 ? (int)((s - 31) / 16 + 1) : 0;
        const int cur = (int)(s >> 6);
        const float* kc = KC + (b * p.NC * 2 + g) * 64; const float* vc = VC + (b * p.NC * 2 + g) * 64;
        float q0[64], q1[64];
        { const bf16_t* q = P + t * PW + C_Q + (2 * g) * 64;
#pragma unroll
          for (int d = 0; d < 64; ++d) { q0[d] = bf2f(q[d]); q1[d] = bf2f(q[64 + d]); } }
        float m0 = -3e38f, m1 = -3e38f;
        for (int n = 0; n < nv; ++n) { const float* k = kc + n * 128; float s0 = 0.f, s1 = 0.f;
#pragma unroll
            for (int d = 0; d < 64; ++d) { s0 += q0[d] * k[d]; s1 += q1[d] * k[d]; }
            m0 = fmaxf(m0, s0); m1 = fmaxf(m1, s1); }
        float z0 = 0.f, z1 = 0.f;
        for (int n = 0; n < nv; ++n) { const float* k = kc + n * 128; float s0 = 0.f, s1 = 0.f;
#pragma unroll
            for (int d = 0; d < 64; ++d) { s0 += q0[d] * k[d]; s1 += q1[d] * k[d]; }
            z0 += expf(s0 - m0); z1 += expf(s1 - m1); }
        const float iz0 = nv ? 1.0f / z0 : 0.f, iz1 = nv ? 1.0f / z1 : 0.f;
        unsigned mask;
        if (cur < 8) mask = (2u << cur) - 1u;
        else {
            float tv0 = -3e38f, tv1 = -3e38f, tv2 = -3e38f, tv3 = -3e38f, tv4 = -3e38f; int ti0 = 0, ti1 = 0, ti2 = 0, ti3 = 0, ti4 = 0;
            float carry = 0.f;
            for (int j = 0; j <= cur - 2; ++j) { float imp = carry;
                for (int mm = 0; mm < 4; ++mm) { const int n = 4 * j + mm; float pn = 0.f;
                    if (n < nv) { const float* k = kc + n * 128; float s0 = 0.f, s1 = 0.f;
#pragma unroll
                        for (int d = 0; d < 64; ++d) { s0 += q0[d] * k[d]; s1 += q1[d] * k[d]; }
                        pn = expf(s0 - m0) * iz0 + expf(s1 - m1) * iz1; }
                    if (mm < 3) imp += pn; else { imp += 0.5f * pn; carry = 0.5f * pn; } }
                if (j >= 1) {
                    float v = imp; int id = j;
                    if (v > tv0) { float tf = tv0; tv0 = v; v = tf; int tt = ti0; ti0 = id; id = tt; }
                    if (v > tv1) { float tf = tv1; tv1 = v; v = tf; int tt = ti1; ti1 = id; id = tt; }
                    if (v > tv2) { float tf = tv2; tv2 = v; v = tf; int tt = ti2; ti2 = id; id = tt; }
                    if (v > tv3) { float tf = tv3; tv3 = v; v = tf; int tt = ti3; ti3 = id; id = tt; }
                    if (v > tv4) { tv4 = v; ti4 = id; } } }
            mask = 1u | (1u << cur) | (1u << (cur - 1)) | (1u << ti0) | (1u << ti1) | (1u << ti2) | (1u << ti3) | (1u << ti4);
        }
        SELM[i] = mask;
        for (int r = 0; r < 2; ++r) { const int hd = 2 * g + r; const float mr = r ? m1 : m0, izr = r ? iz1 : iz0;
            float o[64], qq[64];
            { const bf16_t* q = P + t * PW + C_Q + hd * 64;
#pragma unroll
              for (int d = 0; d < 64; ++d) { o[d] = 0.f; qq[d] = bf2f(q[d]); } }
            for (int n = 0; n < nv; ++n) { const float* k = kc + n * 128; const float* v = vc + n * 128; float sc = 0.f;
#pragma unroll
                for (int d = 0; d < 64; ++d) sc += qq[d] * k[d];
                const float pr = expf(sc - mr) * izr;
#pragma unroll
                for (int d = 0; d < 64; ++d) o[d] += pr * v[d]; }
            const float g0 = sigmoidf_(bf2f(P[t * PW + C_NG + hd * 3 + 0]));
#pragma unroll
            for (int d = 0; d < 64; ++d) O[t * 1024 + hd * 64 + d] = f2bf(g0 * o[d]); } }
}
DEVI void ph_selwin(const Params& p, long long gtid, long long gsz) {
    const bf16_t* P = WSP(bf16_t, p.oP); const unsigned* SELM = WSP(unsigned, p.oSELM); bf16_t* O = WSP(bf16_t, p.oO);
    for (long long i = gtid; i < p.T * 8; i += gsz) { const long long t = i >> 3, b = t / p.S, s = t % p.S; const int hd = (int)((i >> 1) & 3), g = hd >> 1, d0 = (int)(i & 1) * 32;
        unsigned qp[32]; float o[32];
        { const bf16_t* qq = P + t * PW + C_Q + hd * 64;
#pragma unroll
          for (int d = 0; d < 32; ++d) qp[d] = (unsigned)qq[2 * d] | ((unsigned)qq[2 * d + 1] << 16); }
        for (int pass = 0; pass < 2; ++pass) {
            const int ck = pass ? C_KW : C_KS, cv = pass ? C_VW : C_VS; const unsigned mask = SELM[t * 2 + g];
            float m = -3e38f, z = 0.f;
#pragma unroll
            for (int d = 0; d < 32; ++d) o[d] = 0.f;
            const long long lo = pass ? (s - 511 > 0 ? s - 511 : 0) : 0;
            for (long long kp = lo; kp <= s; ++kp) {
                if (!pass && !((mask >> (kp >> 6)) & 1u)) { kp |= 63; continue; }
                const bf16_t* k = P + (b * p.S + kp) * PW + ck + g * 64; const bf16_t* v = P + (b * p.S + kp) * PW + cv + g * 64 + d0; float sc = 0.f;
#pragma unroll
                for (int d = 0; d < 32; ++d) sc += u2f(qp[d] << 16) * bf2f(k[2 * d]) + u2f(qp[d] & 0xffff0000u) * bf2f(k[2 * d + 1]);
                if (sc > m) { const float f = expf(m - sc); z *= f;
#pragma unroll
                    for (int d = 0; d < 32; ++d) o[d] *= f;
                    m = sc; }
                const float pr = expf(sc - m); z += pr;
#pragma unroll
                for (int d = 0; d < 32; ++d) o[d] += pr * bf2f(v[d]); }
            const float gt = sigmoidf_(bf2f(P[t * PW + C_NG + hd * 3 + 1 + pass])) / z;
#pragma unroll
            for (int d = 0; d < 32; ++d) { bf16_t* od = O + t * 1024 + hd * 64 + d0 + d; *od = f2bf(bf2f(*od) + gt * o[d]); } } }
}
DEVI void ph_ca_attn(const Params& p, int l, long long gtid, long long gsz) {
    const bf16_t* CQ = WSP(bf16_t, p.oCQ); const bf16_t* KV = WSP(bf16_t, p.oKV) + (long long)l * 512; bf16_t* AO = WSP(bf16_t, p.oCAO);
    for (long long i = gtid; i < p.T * 4; i += gsz) { const long long t = i >> 2, b = t / p.S; const int hd = (int)(i & 3);
        float q[64], o[64];
#pragma unroll
        for (int d = 0; d < 64; ++d) { q[d] = bf2f(CQ[t * 256 + hd * 64 + d]); o[d] = 0.f; }
        float m = -3e38f, z = 0.f;
        for (int kp = 0; kp < 256; ++kp) { const bf16_t* k = KV + (b * 256 + kp) * 1024 + hd * 64; const bf16_t* v = k + 256; float sc = 0.f;
#pragma unroll
            for (int d = 0; d < 64; ++d) sc += q[d] * bf2f(k[d]);
            if (sc > m) { const float f = expf(m - sc); z *= f;
#pragma unroll
                for (int d = 0; d < 64; ++d) o[d] *= f;
                m = sc; }
            const float pr = expf(sc - m); z += pr;
#pragma unroll
            for (int d = 0; d < 64; ++d) o[d] += pr * bf2f(v[d]); }
        const float iz = 1.0f / z;
#pragma unroll
        for (int d = 0; d < 64; ++d) AO[t * 256 + hd * 64 + d] = f2bf(o[d] * iz); }
}
DEVI void ph_moe_count(const Params& p, long long gtid, long long gsz) {
    const int* TE = WSP(int, p.oTOKE); int* CC = WSP(int, p.oCCNT); int* R2T = WSP(int, p.oR2T);
    for (long long i = gtid; i < (p.T / 64) * 8; i += gsz) { const long long c = i >> 3; const int sub = (int)(i & 7); int cnt[8] = {0, 0, 0, 0, 0, 0, 0, 0};
#pragma unroll
        for (int j = 0; j < 16; ++j) { const int e = TE[c * 128 + sub * 16 + j];
#pragma unroll
            for (int q = 0; q < 8; ++q) cnt[q] += (e == q); }
#pragma unroll
        for (int q = 0; q < 8; ++q) CC[i * 8 + q] = cnt[q]; }
    for (long long i = gtid; i < p.NR; i += gsz) R2T[i] = -1;
}
DEVI void ph_moe_offsets(const Params& p, long long gtid, long long gsz) {
    const int* CC = WSP(int, p.oCCNT); int* CO = WSP(int, p.oCOFF); int* MC = WSP(int, p.oMOEC);
    const long long n = (p.T / 64) * 8;
    for (long long i = gtid; i < n * 8; i += gsz) { const long long sc = i >> 3; const int e = (int)(i & 7); int s0 = 0, s1 = 0, s2 = 0, s3 = 0; long long k = 0;
        for (; k + 4 <= sc; k += 4) { s0 += CC[k * 8 + e]; s1 += CC[(k + 1) * 8 + e]; s2 += CC[(k + 2) * 8 + e]; s3 += CC[(k + 3) * 8 + e]; }
        for (; k < sc; ++k) s0 += CC[k * 8 + e];
        const int off = (s0 + s1) + (s2 + s3); CO[i] = off; if (sc == n - 1) MC[e] = off + CC[i]; }
}
DEVI void moe_bases(const Params& p, int (&base)[9]) { const int* MC = WSP(int, p.oMOEC); int run = 0;
#pragma unroll
    for (int e = 0; e < 8; ++e) { base[e] = run; run += (MC[e] + 255) & ~255; } base[8] = run; }
DEVI void ph_moe_assign(const Params& p, long long gtid, long long gsz) {
    const int* TE = WSP(int, p.oTOKE); const float* TW = WSP(float, p.oTOKW); const int* CO = WSP(int, p.oCOFF); int* TS = WSP(int, p.oTOKS); int* R2T = WSP(int, p.oR2T); float* RW = WSP(float, p.oROWW);
    int base[9]; moe_bases(p, base);
    if (gtid == 0) { int* MC = WSP(int, p.oMOEC);
#pragma unroll
        for (int e = 0; e < 9; ++e) MC[16 + e] = base[e]; }
    for (long long i = gtid; i < (p.T / 64) * 8; i += gsz) { int run[8];
#pragma unroll
        for (int q = 0; q < 8; ++q) run[q] = base[q] + CO[i * 8 + q];
#pragma unroll
        for (int j = 0; j < 16; ++j) { const int e = TE[i * 16 + j]; int slot = 0;
#pragma unroll
            for (int q = 0; q < 8; ++q) if (e == q) { slot = run[q]; run[q] += 1; }
            TS[i * 16 + j] = slot; R2T[slot] = (int)(i * 8 + (j >> 1)); RW[slot] = TW[i * 16 + j]; } }
}
DEVI void ph_moe_gather(const Params& p, long long gtid, long long gsz) {
    const int* R2T = WSP(int, p.oR2T); const int* MC = WSP(int, p.oMOEC); const uint4* H = WSP(uint4, p.oH); uint4* HS = WSP(uint4, p.oHS);
    const long long rows = MC[16 + 8];
    for (long long i = gtid; i < rows * 128; i += gsz) { const long long r = i >> 7; const int j = (int)(i & 127); const int t = R2T[r];
        uint4 v; v.x = v.y = v.z = v.w = 0u; if (t >= 0) v = H[(long long)t * 128 + j]; HS[i] = v; }
}
struct Unit { int pm, pn, aux, pad; long long aoff, boff; };
constexpr int NXCD = 8, WGM = 8;
DEVI void tile_order(long long L, int nM, int nN, int& pm, int& pn) {
    const int nwg = nM * nN; int wgid = (int)L; { const int q = nwg / NXCD, r = nwg % NXCD, xcd = wgid % NXCD, off = wgid / NXCD; wgid = (xcd < r ? xcd * (q + 1) : r * (q + 1) + (xcd - r) * q) + off; }
    const int nig = WGM * nN, gid = wgid / nig, fm = gid * WGM, gsz = (nM - fm) < WGM ? (nM - fm) : WGM;
    pm = fm + ((wgid % nig) % gsz); pn = (wgid % nig) / gsz;
}
struct SchedPlain {
    int nM, nN, G, c; long long lda, ldb;
    DEVM void init(long long M, long long N, long long lda_, long long ldb_, int G_, int c_) { nM = (int)(M / 256); nN = (int)(N / 256); lda = lda_; ldb = ldb_; G = G_; c = c_; }
    DEVM bool next(int i, Unit& u) const { const long long L = (long long)i * G + c; if (L >= (long long)nM * nN) return false; tile_order(L, nM, nN, u.pm, u.pn); u.aux = 0; u.pad = 0;
        u.aoff = (long long)u.pm * 256 * lda * 2; u.boff = (long long)u.pn * 256 * ldb * 2; return true; }
    DEVM void a_ready(const Unit&) const {}
    DEVM void done(const Unit&) const {}
};
struct SchedBranch {
    int nM, G, c;
    DEVM void init(long long M, int G_, int c_) { nM = (int)(M / 256); G = G_; c = c_; }
    DEVM bool next(int i, Unit& u) const { const long long L = (long long)i * G + c; if (L >= (long long)nM * 16) return false; tile_order(L, nM, 16, u.pm, u.pn); u.aux = u.pn >> 2; u.pad = 0;
        u.aoff = (long long)u.pm * 256 * 1024 * 2 + (long long)u.aux * 256 * 2; u.boff = (long long)u.pn * 256 * 256 * 2; return true; }
    DEVM void a_ready(const Unit&) const {}
    DEVM void done(const Unit&) const {}
};
struct SchedGate {
    int nM, G, c;
    DEVM void init(long long M, int G_, int c_) { nM = (int)(M / 256); G = G_; c = c_; }
    DEVM bool next(int i, Unit& u) const { const long long tile = (long long)(i >> 2) * G + c; if (tile >= (long long)nM * 4) return false; tile_order(tile, nM, 4, u.pm, u.pn); u.aux = i & 3; u.pad = 0;
        u.aoff = (long long)u.pm * 256 * 1024 * 2; u.boff = (long long)(u.aux * 4 + u.pn) * 256 * 1024 * 2; return true; }
    DEVM void a_ready(const Unit&) const {}
    DEVM void done(const Unit&) const {}
};
struct SchedMoe {
    int t0, t1, nN, G, c; long long lda, ldb, per_e; int base[9];
    DEVM bool next(int i, Unit& u) const { const long long L = (long long)i * G + c; if (L >= (long long)(t1 - t0) * nN) return false; u.pm = t0 + (int)(L / nN); u.pn = (int)(L % nN); u.pad = 0;
        int e = 0;
#pragma unroll
        for (int q = 1; q < 8; ++q) e += (u.pm * 256 >= base[q]) ? 1 : 0;
        u.aux = e; u.aoff = (long long)u.pm * 256 * lda * 2; u.boff = (long long)e * per_e + (long long)u.pn * 256 * ldb * 2; return true; }
    DEVM void a_ready(const Unit&) const {}
    DEVM void done(const Unit&) const {}
};
struct SchedCmp {
    int nM, G, c;
    DEVM void init(long long rows, int G_, int c_) { nM = (int)(rows / 256); G = G_; c = c_; }
    DEVM bool next(int i, Unit& u) const { const long long L = (long long)i * G + c; if (L >= (long long)nM * 4) return false; const int combo = (int)(L / nM); u.pm = (int)(L % nM); u.pn = 0; u.aux = combo; u.pad = 0;
        u.aoff = (long long)u.pm * 256 * 16 * PW * 2 + (long long)(((combo >> 1) ? C_VC : C_KC) + (combo & 1) * 64) * 2; u.boff = (long long)(combo >> 1) * 256 * 1024 * 2; return true; }
    DEVM void a_ready(const Unit&) const {}
    DEVM void done(const Unit&) const {}
};
struct EpStore {
    bf16_t* O; long long ldo; float scale;
    DEVM void apply(const Unit& u, long long row, int c8, const float* lo, const float* hi) const { float a[8], b[8];
#pragma unroll
        for (int j = 0; j < 8; ++j) { a[j] = lo[j] * scale; b[j] = hi[j] * scale; }
        bf16_t* d = O + row * ldo + u.pn * 256 + c8; st8(d, a); st8(d + 128, b); }
};
struct EpUV {
    bf16_t* UV;
    DEVM void apply(const Unit& u, long long row, int c8, const float* lo, const float* hi) const { bf16_t* d = UV + (row * 4 + u.aux) * 256 + c8; st8(d, lo); st8(d + 128, hi); }
};
struct EpGate {
    const bf16_t* BO; const float* bias; bf16_t* MG; long long row0;
    DEVM void apply(const Unit& u, long long row, int c8, const float* lo, const float* hi) const {
#pragma unroll
        for (int hh = 0; hh < 2; ++hh) { const float* v = hh ? hi : lo; const int c = u.pn * 256 + hh * 128 + c8, n = u.aux * 1024 + c; float bo[8], mg[8], r[8]; ld8(BO + row * 4096 + n, bo);
            bf16_t* m = MG + (row0 + row) * 1024 + c;
            if (u.aux) ld8(m, mg);
#pragma unroll
            for (int j = 0; j < 8; ++j) { r[j] = sigmoidf_(v[j] + bias[n + j]) * bo[j]; if (u.aux) r[j] += mg[j]; }
            st8(m, r); } }
};
struct EpResid {
    float* X;
    DEVM void apply(const Unit& u, long long row, int c8, const float* lo, const float* hi) const { float* x = X + row * 1024 + u.pn * 256 + c8;
#ifndef CPU_EMU
        float4 a = *(float4*)x, b = *(float4*)(x + 4), c = *(float4*)(x + 128), d = *(float4*)(x + 132);
        a.x += lo[0]; a.y += lo[1]; a.z += lo[2]; a.w += lo[3]; b.x += lo[4]; b.y += lo[5]; b.z += lo[6]; b.w += lo[7];
        c.x += hi[0]; c.y += hi[1]; c.z += hi[2]; c.w += hi[3]; d.x += hi[4]; d.y += hi[5]; d.z += hi[6]; d.w += hi[7];
        *(float4*)x = a; *(float4*)(x + 4) = b; *(float4*)(x + 128) = c; *(float4*)(x + 132) = d;
#else
        for (int j = 0; j < 8; ++j) { x[j] += lo[j]; x[128 + j] += hi[j]; }
#endif
    }
};
struct EpSwiglu {
    bf16_t* ACT; long long ldo; long long row0;
    DEVM void apply(const Unit& u, long long row, int c8, const float* lo, const float* hi) const { float r[8];
#pragma unroll
        for (int j = 0; j < 8; ++j) r[j] = siluf_(lo[j]) * hi[j];
        st8(ACT + (row - row0) * ldo + u.pn * 128 + c8, r); }
};
struct EpMoeDown {
    bf16_t* Y; const float* roww;
    DEVM void apply(const Unit& u, long long row, int c8, const float* lo, const float* hi) const { const float w = roww[row]; float a[8], b[8];
#pragma unroll
        for (int j = 0; j < 8; ++j) { a[j] = lo[j] * w; b[j] = hi[j] * w; }
        bf16_t* d = Y + row * 1024 + u.pn * 256 + c8; st8(d, a); st8(d + 128, b); }
};

#ifdef CPU_EMU
template <class Sched, class Epi> static void gemm_cpu(const bf16_t* A, long long lda, const bf16_t* Bt, long long ldb, long long K, const Sched& S, const Epi& E, long long kstepA = 64) {
    Unit u;
    for (int i = 0; S.next(i, u); ++i) {
        const bf16_t* a0 = (const bf16_t*)((const char*)A + u.aoff); const bf16_t* b0 = (const bf16_t*)((const char*)Bt + u.boff);
#pragma omp parallel for
        for (int r = 0; r < 256; ++r) { float arow[4096]; for (long long k = 0; k < K; ++k) arow[k] = bf2f(a0[r * lda + (k >> 6) * kstepA + (k & 63)]);
            for (int c8 = 0; c8 < 128; c8 += 8) { float lo[8], hi[8];
                for (int j = 0; j < 8; ++j) { const bf16_t* bl = b0 + (c8 + j) * ldb; const bf16_t* bh = b0 + (128 + c8 + j) * ldb; float s0 = 0.f, s1 = 0.f;
                    for (long long k = 0; k < K; ++k) { s0 += arow[k] * bf2f(bl[k]); s1 += arow[k] * bf2f(bh[k]); } lo[j] = s0; hi[j] = s1; }
                E.apply(u, (long long)u.pm * 256 + r, c8, lo, hi); } } }
}
#endif

#ifndef CPU_EMU
DEVI float wave_sum(float v) {
#pragma unroll
    for (int o = 32; o > 0; o >>= 1) v += __shfl_xor(v, o);
    return v; }
DEVI void row_load(const float* src, float (&v)[16], int lane) {
#pragma unroll
    for (int j = 0; j < 4; ++j) { const float4 f = *(const float4*)(src + j * 256 + lane * 4); v[4 * j] = f.x; v[4 * j + 1] = f.y; v[4 * j + 2] = f.z; v[4 * j + 3] = f.w; } }
DEVI void row_store_bf16(bf16_t* dst, const float (&v)[16], int lane) {
#pragma unroll
    for (int j = 0; j < 4; ++j) { uint2 w; w.x = (unsigned)f2bf(v[4 * j]) | ((unsigned)f2bf(v[4 * j + 1]) << 16); w.y = (unsigned)f2bf(v[4 * j + 2]) | ((unsigned)f2bf(v[4 * j + 3]) << 16); *(uint2*)(dst + j * 256 + lane * 4) = w; } }
#endif
DEVI void ph_rmsnorm(const Params& p, const float* src, long long rows, const float* gain, bf16_t* dst, int mode, float* xcopy, long long gw, long long nw, int lane) {
    const float* router = p.in[I_MOE_R]; int* TE = WSP(int, p.oTOKE); float* TW = WSP(float, p.oTOKW);
#ifndef CPU_EMU
    for (long long r = gw; r < rows; r += nw) { float v[16], g[16]; row_load(src + r * 1024, v, lane); row_load(gain, g, lane);
        float ss = 0.f;
#pragma unroll
        for (int j = 0; j < 16; ++j) ss += v[j] * v[j];
        ss = wave_sum(ss); const float rs = rsqrtf(ss * (1.0f / 1024.0f) + 1e-6f);
        if (mode == 1) {
#pragma unroll
            for (int j = 0; j < 4; ++j) *(float4*)(xcopy + r * 1024 + j * 256 + lane * 4) = make_float4(v[4 * j], v[4 * j + 1], v[4 * j + 2], v[4 * j + 3]); }
#pragma unroll
        for (int j = 0; j < 16; ++j) v[j] = v[j] * rs * g[j];
        row_store_bf16(dst + r * 1024, v, lane);
        if (mode == 2) { float lg[8];
#pragma unroll
            for (int e = 0; e < 8; ++e) { float a = 0.f;
#pragma unroll
                for (int j = 0; j < 16; ++j) a += v[j] * router[(long long)((j >> 2) * 256 + lane * 4 + (j & 3)) * 8 + e];
                lg[e] = wave_sum(a); }
            int i0 = 0; float v0 = lg[0];
#pragma unroll
            for (int e = 1; e < 8; ++e) if (lg[e] > v0) { v0 = lg[e]; i0 = e; }
            int i1 = -1; float v1 = -3e38f;
#pragma unroll
            for (int e = 0; e < 8; ++e) if (e != i0 && lg[e] > v1) { v1 = lg[e]; i1 = e; }
            const float w0 = 1.0f / (1.0f + expf(v1 - v0));
            if (lane == 0) { TE[r * 2] = i0; TE[r * 2 + 1] = i1; TW[r * 2] = w0; TW[r * 2 + 1] = 1.0f - w0; } } }
#else
    (void)lane;
    for (long long r = gw; r < rows; r += nw) { const float* x = src + r * 1024; float ss = 0.f; for (int c = 0; c < 1024; ++c) ss += x[c] * x[c];
        const float rs = 1.0f / sqrtf(ss / 1024.0f + 1e-6f); float hv[1024];
        for (int c = 0; c < 1024; ++c) { hv[c] = x[c] * rs * gain[c]; dst[r * 1024 + c] = f2bf(hv[c]); if (mode == 1) xcopy[r * 1024 + c] = x[c]; }
        if (mode == 2) { float lg[8]; for (int e = 0; e < 8; ++e) { float a = 0.f; for (int c = 0; c < 1024; ++c) a += hv[c] * router[c * 8 + e]; lg[e] = a; }
            int i0 = 0; float v0 = lg[0]; for (int e = 1; e < 8; ++e) if (lg[e] > v0) { v0 = lg[e]; i0 = e; }
            int i1 = -1; float v1 = -3e38f; for (int e = 0; e < 8; ++e) if (e != i0 && lg[e] > v1) { v1 = lg[e]; i1 = e; }
            const float w0 = 1.0f / (1.0f + expf(v1 - v0)); TE[r * 2] = i0; TE[r * 2 + 1] = i1; TW[r * 2] = w0; TW[r * 2 + 1] = 1.0f - w0; } }
#endif
}
DEVI void ph_final(const Params& p, long long gw, long long nw, int lane) {
    const int* TS = WSP(int, p.oTOKS); const bf16_t* Y = WSP(bf16_t, p.oY); const float* gain = p.in[I_NORM_FINAL]; float* X = p.out;
#ifndef CPU_EMU
    for (long long r = gw; r < p.T; r += nw) { float v[16], g[16]; row_load(X + r * 1024, v, lane); row_load(gain, g, lane);
        const bf16_t* y0 = Y + (long long)TS[r * 2] * 1024; const bf16_t* y1 = Y + (long long)TS[r * 2 + 1] * 1024;
#pragma unroll
        for (int j = 0; j < 4; ++j) { const uint2 a = *(const uint2*)(y0 + j * 256 + lane * 4), b = *(const uint2*)(y1 + j * 256 + lane * 4);
            v[4 * j] += u2f(a.x << 16) + u2f(b.x << 16); v[4 * j + 1] += u2f(a.x & 0xffff0000u) + u2f(b.x & 0xffff0000u); v[4 * j + 2] += u2f(a.y << 16) + u2f(b.y << 16); v[4 * j + 3] += u2f(a.y & 0xffff0000u) + u2f(b.y & 0xffff0000u); }
        float ss = 0.f;
#pragma unroll
        for (int j = 0; j < 16; ++j) ss += v[j] * v[j];
        ss = wave_sum(ss); const float rs = rsqrtf(ss * (1.0f / 1024.0f) + 1e-6f);
#pragma unroll
        for (int j = 0; j < 4; ++j) *(float4*)(X + r * 1024 + j * 256 + lane * 4) = make_float4(v[4 * j] * rs * g[4 * j], v[4 * j + 1] * rs * g[4 * j + 1], v[4 * j + 2] * rs * g[4 * j + 2], v[4 * j + 3] * rs * g[4 * j + 3]); }
#else
    (void)lane;
    for (long long r = gw; r < p.T; r += nw) { float v[1024]; float ss = 0.f; const bf16_t* y0 = Y + (long long)TS[r * 2] * 1024; const bf16_t* y1 = Y + (long long)TS[r * 2 + 1] * 1024;
        for (int c = 0; c < 1024; ++c) { v[c] = X[r * 1024 + c] + bf2f(y0[c]) + bf2f(y1[c]); ss += v[c] * v[c]; }
        const float rs = 1.0f / sqrtf(ss / 1024.0f + 1e-6f); for (int c = 0; c < 1024; ++c) X[r * 1024 + c] = v[c] * rs * gain[c]; }
#endif
}
DEVI void ph_rwkv_scan(const Params& p, int l, long long gw, long long nw, int lane) {
    const float* RWW = WSP(float, p.oRWW); const bf16_t* RWX = WSP(bf16_t, p.oRWX); bf16_t* O = WSP(bf16_t, p.oO); const float* lng = p.in[I_RW_LN] + l * 256; const float* rkw = p.in[I_RW_RK] + l * 256; (void)rkw;
    for (long long ch = gw; ch < p.B * 4; ch += nw) { const long long b = ch >> 2; const int h = (int)(ch & 3);
#ifndef CPU_EMU
        float st[64];
#pragma unroll
        for (int c = 0; c < 64; ++c) st[c] = 0.f;
        for (long long s = 0; s < p.S; ++s) { const long long t = b * p.S + s; const bf16_t* rx = RWX + t * 1280 + h * 64; const float v = bf2f(rx[512 + lane]);
            const float y = rwkv_row_step(st, RWW + t * 256 + h * 64, rx, rx + 256, rx + 768, rx + 1024, v);
            const float mean = wave_sum(y) * (1.0f / 64.0f), dy = y - mean, var = wave_sum(dy * dy) * (1.0f / 64.0f);
            const float yn = dy * rsqrtf(var + 64e-5f) * lng[h * 64 + lane] + 0.f;
            bf16_t* o = O + t * 1024 + 512 + h * 64 + lane; *o = f2bf(yn * bf2f(*o)); }
#else
        (void)lane;
        static float st[64][64]; for (int v = 0; v < 64; ++v) for (int c = 0; c < 64; ++c) st[v][c] = 0.f;
        for (long long s = 0; s < p.S; ++s) { const long long t = b * p.S + s; const bf16_t* rx = RWX + t * 1280 + h * 64; float y[64], mean = 0.f, var = 0.f;
            for (int v = 0; v < 64; ++v) { y[v] = rwkv_row_step(st[v], RWW + t * 256 + h * 64, rx, rx + 256, rx + 768, rx + 1024, bf2f(rx[512 + v])); mean += y[v]; }
            mean /= 64.f; for (int v = 0; v < 64; ++v) var += (y[v] - mean) * (y[v] - mean); var /= 64.f;
            float rkv = 0.f; for (int cq = 0; cq < 64; ++cq) rkv += bf2f(rx[cq]) * bf2f(rx[256 + cq]) * rkw[h * 64 + cq];
            for (int v = 0; v < 64; ++v) { const float yn = (y[v] - mean) / sqrtf(var + 64e-5f) * lng[h * 64 + v] + rkv * bf2f(rx[512 + v]);
                bf16_t* o = O + t * 1024 + 512 + h * 64 + v; *o = f2bf(yn * bf2f(*o)); } }
#endif
    }
}
DEVI void ph_gla_scan(const Params& p, int l, long long gw, long long nw, int lane) {
    const bf16_t* P = WSP(bf16_t, p.oP); const float* GA = WSP(float, p.oGA); bf16_t* O = WSP(bf16_t, p.oO); const float* ng = p.in[I_GLA_NORM] + l * 64;
    for (long long ch = gw; ch < p.B * 4; ch += nw) { const long long b = ch >> 2; const int h = (int)(ch & 3);
#ifndef CPU_EMU
        float st[32];
#pragma unroll
        for (int c = 0; c < 32; ++c) st[c] = 0.f;
        for (long long s = 0; s < p.S; ++s) { const long long t = b * p.S + s; const bf16_t* x = P + t * PW + C_GLA;
            const float o = gla_col_step(st, GA + t * 128 + h * 32, x + h * 32, x + 128 + h * 32, bf2f(x[256 + h * 64 + lane]));
            const float ms = wave_sum(o * o) * (1.0f / 64.0f), on = o * rsqrtf(ms + 1e-6f) * ng[lane];
            bf16_t* d = O + t * 1024 + 768 + h * 64 + lane; *d = f2bf(on * bf2f(*d)); }
#else
        (void)lane;
        static float st[64][32]; for (int v = 0; v < 64; ++v) for (int c = 0; c < 32; ++c) st[v][c] = 0.f;
        for (long long s = 0; s < p.S; ++s) { const long long t = b * p.S + s; const bf16_t* x = P + t * PW + C_GLA; float o[64], ms = 0.f;
            for (int v = 0; v < 64; ++v) { o[v] = gla_col_step(st[v], GA + t * 128 + h * 32, x + h * 32, x + 128 + h * 32, bf2f(x[256 + h * 64 + v])); ms += o[v] * o[v]; }
            ms /= 64.f;
            for (int v = 0; v < 64; ++v) { bf16_t* d = O + t * 1024 + 768 + h * 64 + v; *d = f2bf(o[v] / sqrtf(ms + 1e-6f) * ng[v] * bf2f(*d)); } }
#endif
    }
}
#ifndef CPU_EMU
#define LAS __attribute__((address_space(3)))
__device__ __forceinline__ int mk_lane() { return (int)__builtin_amdgcn_mbcnt_hi(~0u, __builtin_amdgcn_mbcnt_lo(~0u, 0u)); }
typedef short bf16x8 __attribute__((ext_vector_type(8)));
typedef float f32x4 __attribute__((ext_vector_type(4)));
constexpr int HALF = 128, BK = 64, HTB = HALF * BK * 2, STAGE_BYTES = 8 * HTB;
__device__ __forceinline__ int lds_byte(int r, int c) { const int st = (r >> 4) * 2 + (c >> 5), rr = r & 15, cc = c & 31, ob = rr * 64 + cc * 2; return st * 1024 + (ob ^ (((ob >> 9) & 1) << 5)); }
__device__ __forceinline__ void stage_rc(int b, int& R, int& C) { const int st = b / 1024, sb = b % 1024, swz = sb ^ (((sb >> 9) & 1) << 5); R = (st >> 1) * 16 + swz / 64; C = (st & 1) * 32 + (swz % 64) / 2; }
__device__ __forceinline__ int perm32(int rho) { const int n = rho >> 4, i = rho & 15; return 8 * (i >> 2) + 4 * n + (i & 3); }

template <class Epi, class Sched>
__device__ __forceinline__ void gemm_phase(int wv, LAS unsigned char* lds, const bf16_t* A, long long lda, const bf16_t* Bt, long long ldb, long long K, const Sched& S, const Epi& E, long long kstepA_elems = 64) {
    int tid = wv * 64 + mk_lane(); asm volatile("" : "+v"(tid));
    const int wid = wv, lane = tid & 63, wr = wid >> 2, wc = wid & 3, fr = lane & 15, fq = lane >> 4;
    { unsigned long long a_ = (unsigned long long)A, b_ = (unsigned long long)Bt; unsigned alo = __builtin_amdgcn_readfirstlane((unsigned)a_), ahi = __builtin_amdgcn_readfirstlane((unsigned)(a_ >> 32)),
        blo = __builtin_amdgcn_readfirstlane((unsigned)b_), bhi = __builtin_amdgcn_readfirstlane((unsigned)(b_ >> 32));
      int lda_ = __builtin_amdgcn_readfirstlane((int)lda), ldb_ = __builtin_amdgcn_readfirstlane((int)ldb), k_ = __builtin_amdgcn_readfirstlane((int)K), ks_ = __builtin_amdgcn_readfirstlane((int)kstepA_elems);
      asm volatile("" : "+s"(alo), "+s"(ahi), "+s"(blo), "+s"(bhi), "+s"(lda_), "+s"(ldb_), "+s"(k_), "+s"(ks_)); kstepA_elems = ks_;
      A = (const bf16_t*)(((unsigned long long)ahi << 32) | alo); Bt = (const bf16_t*)(((unsigned long long)bhi << 32) | blo); lda = lda_; ldb = ldb_; K = k_; }
    const int nt = (int)(K / BK);
    unsigned voffA[2], voffB[2];
#pragma unroll
    for (int i = 0; i < 2; ++i) { int R, C; stage_rc(tid * 16 + i * 8192, R, C); const int Rb = (R & ~31) + perm32(R & 31);
        voffA[i] = (unsigned)(R * (int)lda + C) * 2u; voffB[i] = (unsigned)(Rb * (int)ldb + C) * 2u; }
    const size_t kstep = (size_t)(BK * 2), kstepA = (size_t)kstepA_elems * 2;
    const size_t hstepA = (size_t)HALF * lda * 2, hstepB = (size_t)HALF * ldb * 2;
    const unsigned ldsw = (unsigned)wid * 1024u;
    const int aoff = lds_byte(wr * 64 + fr, fq * 8), boff = lds_byte(wc * 32 + fr, fq * 8);
#define PG8_SA(b, h) (((b) * 2 + (h)) * HTB)
#define PG8_SB(b, h) ((4 + (b) * 2 + (h)) * HTB)
#define PG8_STAGE(bufoff, gbase, voff) do { _Pragma("unroll") for (int _i = 0; _i < 2; ++_i) \
        __builtin_amdgcn_global_load_lds((const unsigned*)((const char*)(gbase) + (voff)[_i]), (LAS unsigned*)(lds + (bufoff) + ldsw + _i * 8192), 16, 0, 0); } while (0)
#define PG8_LDA(dst, b, h) do { _Pragma("unroll") for (int m = 0; m < 4; ++m) _Pragma("unroll") for (int k = 0; k < 2; ++k) dst[m][k] = *(const LAS bf16x8*)(lds + PG8_SA(b, h) + aoff + m * 2048 + k * 1024); } while (0)
#define PG8_LDB(dst, b, h) do { _Pragma("unroll") for (int n = 0; n < 2; ++n) _Pragma("unroll") for (int k = 0; k < 2; ++k) dst[n][k] = *(const LAS bf16x8*)(lds + PG8_SB(b, h) + boff + n * 2048 + k * 1024); } while (0)
#define PG8_MMA(ai, bj, At, Bt_) do { __builtin_amdgcn_s_setprio(1); _Pragma("unroll") for (int m = 0; m < 4; ++m) _Pragma("unroll") for (int n = 0; n < 2; ++n) _Pragma("unroll") for (int k = 0; k < 2; ++k) \
        acc[ai][bj][m][n] = __builtin_amdgcn_mfma_f32_16x16x32_bf16(Bt_[n][k], At[m][k], acc[ai][bj][m][n], 0, 0, 0); __builtin_amdgcn_s_setprio(0); } while (0)
#define PG8_WAIT_V(n) asm volatile("s_waitcnt vmcnt(" #n ")" ::: "memory")
#define PG8_WAIT_L(n) asm volatile("s_waitcnt lgkmcnt(" #n ")" ::: "memory")
#define PG8_BAR __builtin_amdgcn_s_barrier()
#define PG8_SCHED __builtin_amdgcn_sched_barrier(0)
    Unit cur, nxt; int ui = 0;
    if (!S.next(0, cur)) return;
    f32x4 acc[2][2][4][2];
#pragma unroll
    for (int a = 0; a < 2; ++a)
#pragma unroll
        for (int b = 0; b < 2; ++b)
#pragma unroll
            for (int m = 0; m < 4; ++m)
#pragma unroll
                for (int n = 0; n < 2; ++n) acc[a][b][m][n] = (f32x4){0.f, 0.f, 0.f, 0.f};
    bf16x8 At[4][2], B0[2][2], B1[2][2];
    const char* cA = (const char*)A + cur.aoff; const char* cB = (const char*)Bt + cur.boff;
    S.a_ready(cur);
    PG8_STAGE(PG8_SB(0, 0), cB, voffB); PG8_STAGE(PG8_SA(0, 0), cA, voffA); PG8_STAGE(PG8_SB(0, 1), cB + hstepB, voffB); PG8_STAGE(PG8_SA(0, 1), cA + hstepA, voffA);
    if (wr == 1) PG8_BAR;
    PG8_WAIT_V(4); PG8_BAR;
    PG8_STAGE(PG8_SB(1, 0), cB + kstep, voffB); PG8_STAGE(PG8_SA(1, 0), cA + kstepA, voffA); PG8_STAGE(PG8_SB(1, 1), cB + hstepB + kstep, voffB);
    PG8_WAIT_V(6); PG8_BAR;
    for (;;) {
        const bool has_next = S.next(ui + 1, nxt);
        const char* nA = has_next ? (const char*)A + nxt.aoff : cA; const char* nB = has_next ? (const char*)Bt + nxt.boff : cB;
#pragma nounroll
        for (int t = 0; t < nt; t += 2) {
            const bool last = (t == nt - 2);
            const char* a1 = cA + (size_t)(t + 1) * kstepA;
            const char* a2 = last ? nA : cA + (size_t)(t + 2) * kstepA; const char* b2 = last ? nB : cB + (size_t)(t + 2) * kstep;
            const char* a3 = a2 + kstepA; const char* b3 = b2 + kstep;
            if (last && has_next) S.a_ready(nxt);
            PG8_LDB(B0, 0, 0); PG8_SCHED; PG8_LDA(At, 0, 0); PG8_STAGE(PG8_SA(1, 1), a1 + hstepA, voffA);
            PG8_WAIT_L(8); PG8_BAR; PG8_WAIT_L(0); PG8_MMA(0, 0, At, B0); PG8_BAR; PG8_SCHED;
            PG8_LDB(B1, 0, 1); PG8_STAGE(PG8_SB(0, 0), b2, voffB);
            PG8_BAR; PG8_WAIT_L(0); PG8_MMA(0, 1, At, B1); PG8_BAR;
            PG8_LDA(At, 0, 1); PG8_STAGE(PG8_SA(0, 0), a2, voffA);
            PG8_BAR; PG8_WAIT_L(0); PG8_MMA(1, 0, At, B0); PG8_BAR; PG8_SCHED;
            PG8_STAGE(PG8_SB(0, 1), b2 + hstepB, voffB);
            PG8_WAIT_V(6); PG8_BAR; PG8_MMA(1, 1, At, B1); PG8_BAR;
            PG8_LDB(B0, 1, 0); PG8_SCHED; PG8_LDA(At, 1, 0); PG8_STAGE(PG8_SA(0, 1), a2 + hstepA, voffA);
            PG8_WAIT_L(8); PG8_BAR; PG8_WAIT_L(0); PG8_MMA(0, 0, At, B0); PG8_BAR; PG8_SCHED;
            PG8_LDB(B1, 1, 1); PG8_STAGE(PG8_SB(1, 0), b3, voffB);
            PG8_BAR; PG8_WAIT_L(0); PG8_MMA(0, 1, At, B1); PG8_BAR;
            PG8_LDA(At, 1, 1); PG8_STAGE(PG8_SA(1, 0), a3, voffA);
            PG8_BAR; PG8_WAIT_L(0); PG8_MMA(1, 0, At, B0); PG8_BAR; PG8_SCHED;
            PG8_STAGE(PG8_SB(1, 1), b3 + hstepB, voffB);
            PG8_WAIT_V(6); PG8_BAR; PG8_MMA(1, 1, At, B1); PG8_BAR;
        }
#pragma unroll
        for (int ai = 0; ai < 2; ++ai)
#pragma unroll
            for (int m = 0; m < 4; ++m) { float lo[8], hi[8];
#pragma unroll
                for (int j = 0; j < 8; ++j) { lo[j] = acc[ai][0][m][j >> 2][j & 3]; hi[j] = acc[ai][1][m][j >> 2][j & 3]; }
                E.apply(cur, (long long)cur.pm * 256 + ai * HALF + wr * 64 + m * 16 + fr, wc * 32 + 8 * fq, lo, hi); PG8_SCHED; }
        S.done(cur);
        if (!has_next) break;
#pragma unroll
        for (int a = 0; a < 2; ++a)
#pragma unroll
            for (int b = 0; b < 2; ++b)
#pragma unroll
                for (int m = 0; m < 4; ++m)
#pragma unroll
                    for (int n = 0; n < 2; ++n) acc[a][b][m][n] = (f32x4){0.f, 0.f, 0.f, 0.f};
        cur = nxt; cA = nA; cB = nB; ++ui;
    }
    PG8_WAIT_V(0);
    if (wr == 0) PG8_BAR;
    PG8_BAR;
#undef PG8_SA
#undef PG8_SB
#undef PG8_STAGE
#undef PG8_LDA
#undef PG8_LDB
#undef PG8_MMA
#undef PG8_WAIT_V
#undef PG8_WAIT_L
#undef PG8_BAR
#undef PG8_SCHED
}

#define XB_TMO      128
#define XB_XCNT(j)  (256  + 64 * (j))
#define XB_XSUB(j)  (1280 + 64 * (j))
#define XB_XGEN(j)  (2304 + 64 * (j))
#define XB_TOP      3328
#define XB_TOPGEN   3392
#define XCD_BAR_WORDS 3456
#define XB_SPIN_CAP (1u << 18)
__device__ __forceinline__ unsigned xb_ld(unsigned* p)              { return __hip_atomic_load(p, __ATOMIC_RELAXED, __HIP_MEMORY_SCOPE_AGENT); }
__device__ __forceinline__ unsigned xb_add(unsigned* p, unsigned v) { return __hip_atomic_fetch_add(p, v, __ATOMIC_RELAXED, __HIP_MEMORY_SCOPE_AGENT); }
__device__ __forceinline__ unsigned xb_xcc_id() { return (unsigned)__builtin_amdgcn_s_getreg((3 << 11) | 20) & 0xFu; }
#define XB_SPIN(cond, bar) do { unsigned _sp = 0; while (cond) { __builtin_amdgcn_s_sleep(1); \
    if ((++_sp & 255u) == 0u) { if (xb_ld(&(bar)[XB_TMO])) break; if (_sp > XB_SPIN_CAP) { atomicAdd(&(bar)[XB_TMO], 1u); break; } } } } while (0)
struct XcdBarrier { unsigned* bar; unsigned x; volatile LAS unsigned* st; int wv; };
__device__ __forceinline__ XcdBarrier xcd_barrier_post(unsigned* bar, volatile LAS unsigned* st, int wv) {
    XcdBarrier b; b.bar = bar; b.x = xb_xcc_id(); b.st = st; b.wv = wv;
    if (wv == 0 && mk_lane() == 0) (void)xb_add(&bar[XB_XCNT(b.x)], 1u);
    return b;
}
__device__ __forceinline__ void xcd_barrier_complete(unsigned* bar, unsigned x, unsigned& nloc, unsigned& nx) {
    const unsigned G = gridDim.x * gridDim.y * gridDim.z;
    unsigned sum, cnt, mine, sp = 0u;
    for (;;) {
        sum = 0u; cnt = 0u; mine = 0u;
#pragma unroll
        for (unsigned j = 0; j < 16; ++j) { const unsigned c = xb_ld(&bar[XB_XCNT(j)]); sum += c; cnt += (c > 0u) ? 1u : 0u; mine = (j == x) ? c : mine; }
        if (sum == G) break;
        __builtin_amdgcn_s_sleep(1);
        if ((++sp & 255u) == 0u) { if (xb_ld(&bar[XB_TMO])) break; if (sp > XB_SPIN_CAP) { atomicAdd(&bar[XB_TMO], 1u); break; } }
    }
    nloc = mine > 0u ? mine : 1u; nx = cnt > 0u ? cnt : 1u;
}
__device__ __forceinline__ void xcd_barrier(const XcdBarrier& b) {
    asm volatile("s_waitcnt vmcnt(0)" ::: "memory");
    __syncthreads();
    if (b.wv == 0 && mk_lane() == 0) {
        unsigned* bar = b.bar;
        __builtin_amdgcn_s_waitcnt(0);
        unsigned nloc = b.st[0], nx = b.st[1];
        if (nloc == 0u) { xcd_barrier_complete(bar, b.x, nloc, nx); b.st[0] = nloc; b.st[1] = nx; }
        const unsigned old = xb_add(&bar[XB_XSUB(b.x)], 1u);
        const unsigned gen = old / nloc;
        if (old + 1u == (gen + 1u) * nloc) {
            __builtin_amdgcn_fence(__ATOMIC_RELEASE, "agent");
            asm volatile("s_waitcnt vmcnt(0)" ::: "memory");
            const unsigned og = xb_add(&bar[XB_TOP], 1u);
            const unsigned tg = og / nx;
            if (og + 1u == (tg + 1u) * nx) xb_add(&bar[XB_TOPGEN], 1u);
            else XB_SPIN(xb_ld(&bar[XB_TOPGEN]) == tg, bar);
            __builtin_amdgcn_fence(__ATOMIC_ACQUIRE, "agent");
            xb_add(&bar[XB_XGEN(b.x)], 1u);
            asm volatile("s_waitcnt vmcnt(0)" ::: "memory");
        } else {
            XB_SPIN(xb_ld(&bar[XB_XGEN(b.x)]) == gen, bar);
            __builtin_amdgcn_fence(__ATOMIC_ACQUIRE, "agent");
            asm volatile("s_waitcnt vmcnt(0)" ::: "memory");
        }
    }
    __syncthreads();
}
#endif
#ifndef CPU_EMU
typedef short bf16x8_t __attribute__((ext_vector_type(8)));
typedef short bf16x4_t __attribute__((ext_vector_type(4)));
typedef float f32x4_t __attribute__((ext_vector_type(4)));
typedef unsigned u32x4_t __attribute__((ext_vector_type(4)));
constexpr int AT_KS = 144, AT_VS = 136;
constexpr int AT_KBYTES = 64 * AT_KS, AT_VBYTES = 64 * AT_VS, AT_BUF = AT_KBYTES + AT_VBYTES;
struct AttnState { float m, l; f32x4_t o[4]; };
__device__ __forceinline__ void attn_init(AttnState& s) { s.m = -1e30f; s.l = 0.f;
#pragma unroll
    for (int d = 0; d < 4; ++d) s.o[d] = (f32x4_t){0.f, 0.f, 0.f, 0.f}; }
__device__ __forceinline__ unsigned pack2bf(float lo, float hi) { return (unsigned)f2bf(lo) | ((unsigned)f2bf(hi) << 16); }
template <class Valid> __device__ __forceinline__ void attn_tile(const LAS unsigned char* kt, const LAS unsigned char* vt, const bf16x8_t (&bq)[2], AttnState& st, int lane, const Valid& valid) {
    const int r = lane & 15, q = lane >> 4;
    f32x4_t s[4];
#pragma unroll
    for (int kb = 0; kb < 4; ++kb) { s[kb] = (f32x4_t){0.f, 0.f, 0.f, 0.f};
#pragma unroll
        for (int ks = 0; ks < 2; ++ks) { const bf16x8_t a = *(const LAS bf16x8_t*)(kt + (16 * kb + r) * AT_KS + (32 * ks + 8 * q) * 2); s[kb] = __builtin_amdgcn_mfma_f32_16x16x32_bf16(a, bq[ks], s[kb], 0, 0, 0); } }
    float mx = -1e30f;
#pragma unroll
    for (int kb = 0; kb < 4; ++kb)
#pragma unroll
        for (int j = 0; j < 4; ++j) { const float v = valid(kb, j) ? s[kb][j] * 1.44269504f : -1e30f; s[kb][j] = v; mx = fmaxf(mx, v); }
    mx = fmaxf(mx, __shfl_xor(mx, 16)); mx = fmaxf(mx, __shfl_xor(mx, 32));
    const float mn = fmaxf(st.m, mx), alpha = __builtin_amdgcn_exp2f(st.m - mn);
    float rs = 0.f;
#pragma unroll
    for (int kb = 0; kb < 4; ++kb)
#pragma unroll
        for (int j = 0; j < 4; ++j) { const float pv = s[kb][j] > -1e29f ? __builtin_amdgcn_exp2f(s[kb][j] - mn) : 0.f; s[kb][j] = pv; rs += pv; }
    rs += __shfl_xor(rs, 16); rs += __shfl_xor(rs, 32);
    st.l = st.l * alpha + rs; st.m = mn;
    bf16x8_t pb[2];
#pragma unroll
    for (int kk = 0; kk < 2; ++kk) { uint4 w; w.x = pack2bf(s[2 * kk][0], s[2 * kk][1]); w.y = pack2bf(s[2 * kk][2], s[2 * kk][3]); w.z = pack2bf(s[2 * kk + 1][0], s[2 * kk + 1][1]); w.w = pack2bf(s[2 * kk + 1][2], s[2 * kk + 1][3]);
        pb[kk] = __builtin_bit_cast(bf16x8_t, w); }
#pragma unroll
    for (int db = 0; db < 4; ++db) { st.o[db] = st.o[db] * alpha;
#pragma unroll
        for (int kk = 0; kk < 2; ++kk) { const LAS unsigned char* vp = vt + (16 * db + r) * AT_VS + (32 * kk + 4 * q) * 2;
            const bf16x4_t lo = *(const LAS bf16x4_t*)vp, hi = *(const LAS bf16x4_t*)(vp + 32);
            const bf16x8_t a = __builtin_shufflevector(lo, hi, 0, 1, 2, 3, 4, 5, 6, 7);
            st.o[db] = __builtin_amdgcn_mfma_f32_16x16x32_bf16(a, pb[kk], st.o[db], 0, 0, 0); } }
}
__device__ __forceinline__ void attn_stage_store(LAS unsigned char* buf, int tid, const uint4& kc, const uint4& vc) {
    const int key = tid >> 3, c = tid & 7;
    *(LAS u32x4_t*)(buf + key * AT_KS + c * 16) = (u32x4_t){kc.x, kc.y, kc.z, kc.w};
    LAS unsigned short* vt = (LAS unsigned short*)(buf + AT_KBYTES);
    const unsigned w[4] = {vc.x, vc.y, vc.z, vc.w};
#pragma unroll
    for (int i = 0; i < 4; ++i) { vt[((8 * c + 2 * i) * AT_VS) / 2 + key] = (unsigned short)(w[i] & 0xffffu); vt[((8 * c + 2 * i + 1) * AT_VS) / 2 + key] = (unsigned short)(w[i] >> 16); }
}
__device__ __forceinline__ void ph_selwin_mfma(const Params& p, int wv, LAS unsigned char* lds, int gC, int gG) {
    int tid = wv * 64 + mk_lane(); asm volatile("" : "+v"(tid));
    const int wid = tid >> 6, lane = tid & 63, r = lane & 15, q = lane >> 4;
    const bf16_t* P = WSP(bf16_t, p.oP); const unsigned* SELM = WSP(unsigned, p.oSELM); bf16_t* O = WSP(bf16_t, p.oO);
    const int nqb = (int)(p.S >> 6), units = (int)(p.B * 2) * nqb;
    for (int u = gC; u < units; u += gG) {
        const int cur = nqb - 1 - (u % nqb), bg = u / nqb, b = bg >> 1, g = bg & 1;
        const long long t0 = (long long)b * p.S + (long long)cur * 64;
        const int hd = 2 * g + (wid >> 2); const int tq = (wid & 3) * 16 + r; const long long tok = t0 + tq; const int sq = cur * 64 + tq;
        bf16x8_t bq[2];
#pragma unroll
        for (int ks = 0; ks < 2; ++ks) bq[ks] = *(const bf16x8_t*)(P + tok * PW + C_Q + hd * 64 + 32 * ks + 8 * q);
        unsigned un = SELM[(t0 + lane) * 2 + g];
#pragma unroll
        for (int o = 32; o > 0; o >>= 1) un |= __shfl_xor(un, o);
        un = __builtin_amdgcn_readfirstlane(un);
        const unsigned mymask = SELM[tok * 2 + g];
        const int wlo = cur - 8 > 0 ? cur - 8 : 0, nwin = cur - wlo + 1, nsel = __builtin_popcount(un), ntile = nwin + nsel;
        AttnState sw, ss; attn_init(sw); attn_init(ss);
        unsigned rem = un; int blk = wlo;
        uint4 kc, vc;
        { const long long kr = ((long long)b * p.S + (long long)blk * 64 + (tid >> 3)) * PW + g * 64 + (tid & 7) * 8; kc = *(const uint4*)(P + kr + C_KW); vc = *(const uint4*)(P + kr + C_VW); }
        attn_stage_store(lds, tid, kc, vc);
        __syncthreads();
        for (int i = 0; i < ntile; ++i) {
            const bool win = i < nwin; const int cb = blk;
            int nb = 0; bool nwinf = false; const bool has = i + 1 < ntile;
            if (has) { if (i + 1 < nwin) { nb = wlo + i + 1; nwinf = true; } else { nb = __builtin_ctz(rem); rem &= rem - 1; }
                const long long kr = ((long long)b * p.S + (long long)nb * 64 + (tid >> 3)) * PW + g * 64 + (tid & 7) * 8;
                kc = *(const uint4*)(P + kr + (nwinf ? C_KW : C_KS)); vc = *(const uint4*)(P + kr + (nwinf ? C_VW : C_VS)); }
            const LAS unsigned char* buf = lds + (i & 1) * AT_BUF;
            const int kbase = cb * 64 + 4 * q;
            if (win) attn_tile(buf, buf + AT_KBYTES, bq, sw, lane, [&](int kb, int j) { const int key = kbase + 16 * kb + j; return key <= sq && key > sq - 512; });
            else { const bool on = (mymask >> cb) & 1u; attn_tile(buf, buf + AT_KBYTES, bq, ss, lane, [&](int kb, int j) { const int key = kbase + 16 * kb + j; return on && key <= sq; }); }
            if (has) attn_stage_store(lds + ((i + 1) & 1) * AT_BUF, tid, kc, vc);
            blk = nb;
            __syncthreads();
        }
        const float g1 = sigmoidf_(bf2f(P[tok * PW + C_NG + hd * 3 + 1])) / ss.l, g2 = sigmoidf_(bf2f(P[tok * PW + C_NG + hd * 3 + 2])) / sw.l;
#pragma unroll
        for (int db = 0; db < 4; ++db) { bf16_t* od = O + tok * 1024 + hd * 64 + 16 * db + 4 * q; const uint2 pv = *(const uint2*)od;
            const float r0 = u2f(pv.x << 16) + g1 * ss.o[db][0] + g2 * sw.o[db][0], r1 = u2f(pv.x & 0xffff0000u) + g1 * ss.o[db][1] + g2 * sw.o[db][1];
            const float r2 = u2f(pv.y << 16) + g1 * ss.o[db][2] + g2 * sw.o[db][2], r3 = u2f(pv.y & 0xffff0000u) + g1 * ss.o[db][3] + g2 * sw.o[db][3];
            uint2 w; w.x = pack2bf(r0, r1); w.y = pack2bf(r2, r3); *(uint2*)od = w; }
    }
}
__device__ __forceinline__ void ph_ca_attn_mfma(const Params& p, int l, int wv, LAS unsigned char* lds, int gC, int gG) {
    int tid = wv * 64 + mk_lane(); asm volatile("" : "+v"(tid));
    const int wid = tid >> 6, lane = tid & 63, r = lane & 15, q = lane >> 4;
    const bf16_t* CQ = WSP(bf16_t, p.oCQ); const bf16_t* KV = WSP(bf16_t, p.oKV) + (long long)l * 512; bf16_t* AO = WSP(bf16_t, p.oCAO);
    const int nqb = (int)(p.S >> 7), units = (int)(p.B * 4) * nqb;
    for (int u = gC; u < units; u += gG) {
        const int qb = u % nqb, bh = u / nqb, b = bh >> 2, hd = bh & 3;
        const long long tok = (long long)b * p.S + (long long)qb * 128 + wid * 16 + r;
        bf16x8_t bq[2];
#pragma unroll
        for (int ks = 0; ks < 2; ++ks) bq[ks] = *(const bf16x8_t*)(CQ + tok * 256 + hd * 64 + 32 * ks + 8 * q);
        AttnState st; attn_init(st);
        uint4 kc, vc;
        { const long long kr = ((long long)b * 256 + (tid >> 3)) * 1024 + hd * 64 + (tid & 7) * 8; kc = *(const uint4*)(KV + kr); vc = *(const uint4*)(KV + kr + 256); }
        attn_stage_store(lds, tid, kc, vc);
        __syncthreads();
        for (int i = 0; i < 4; ++i) {
            if (i < 3) { const long long kr = ((long long)b * 256 + (i + 1) * 64 + (tid >> 3)) * 1024 + hd * 64 + (tid & 7) * 8; kc = *(const uint4*)(KV + kr); vc = *(const uint4*)(KV + kr + 256); }
            const LAS unsigned char* buf = lds + (i & 1) * AT_BUF;
            attn_tile(buf, buf + AT_KBYTES, bq, st, lane, [](int, int) { return true; });
            if (i < 3) attn_stage_store(lds + ((i + 1) & 1) * AT_BUF, tid, kc, vc);
            __syncthreads();
        }
        const float il = 1.0f / st.l;
#pragma unroll
        for (int db = 0; db < 4; ++db) { uint2 w; w.x = pack2bf(st.o[db][0] * il, st.o[db][1] * il); w.y = pack2bf(st.o[db][2] * il, st.o[db][3] * il); *(uint2*)(AO + tok * 256 + hd * 64 + 16 * db + 4 * q) = w; }
    }
}
#endif
#ifndef CPU_EMU
constexpr int CM_VS = 264;
constexpr int CM_KBYTES = 128 * AT_KS, CM_VBYTES = 64 * CM_VS;
__device__ __forceinline__ void ph_cmp_attn_mfma(const Params& p, int wv, LAS unsigned char* lds, int gC, int gG) {
    int tid = wv * 64 + mk_lane(); asm volatile("" : "+v"(tid));
    const int lane = tid & 63, r = lane & 15, q = lane >> 4;
    const bf16_t* P = WSP(bf16_t, p.oP); const float* KC = WSP(float, p.oKCMP); const float* VC = WSP(float, p.oVCMP); unsigned* SELM = WSP(unsigned, p.oSELM); bf16_t* O = WSP(bf16_t, p.oO);
    const int nqb = (int)(p.S >> 6), units = (int)(p.B * 2) * nqb, NCk = (int)p.NC;
    LAS unsigned char* kt = lds; LAS unsigned char* vt = lds + CM_KBYTES;
    for (int u = gC; u < units; u += gG) {
        const int cur = u % nqb, bg = u / nqb, b = bg >> 1, g = bg & 1;
        __syncthreads();
        {
            const int key = tid >> 2, d0 = 16 * (tid & 3); float kf[16], vf[16];
            if (key < NCk) { const float* ks = KC + (((long long)b * NCk + key) * 2 + g) * 64 + d0; const float* vs = VC + (((long long)b * NCk + key) * 2 + g) * 64 + d0;
#pragma unroll
                for (int i = 0; i < 4; ++i) { const float4 a = *(const float4*)(ks + 4 * i), c = *(const float4*)(vs + 4 * i); kf[4 * i] = a.x; kf[4 * i + 1] = a.y; kf[4 * i + 2] = a.z; kf[4 * i + 3] = a.w; vf[4 * i] = c.x; vf[4 * i + 1] = c.y; vf[4 * i + 2] = c.z; vf[4 * i + 3] = c.w; } }
            else {
#pragma unroll
                for (int i = 0; i < 16; ++i) { kf[i] = 0.f; vf[i] = 0.f; } }
            *(LAS u32x4_t*)(kt + key * AT_KS + d0 * 2) = (u32x4_t){pack2bf(kf[0], kf[1]), pack2bf(kf[2], kf[3]), pack2bf(kf[4], kf[5]), pack2bf(kf[6], kf[7])};
            *(LAS u32x4_t*)(kt + key * AT_KS + d0 * 2 + 16) = (u32x4_t){pack2bf(kf[8], kf[9]), pack2bf(kf[10], kf[11]), pack2bf(kf[12], kf[13]), pack2bf(kf[14], kf[15])};
            LAS unsigned short* v16 = (LAS unsigned short*)vt;
#pragma unroll
            for (int i = 0; i < 16; ++i) v16[((d0 + i) * CM_VS) / 2 + key] = f2bf(vf[i]); }
        __syncthreads();
        const int tl = 8 * wv + (r >> 1), hd = 2 * g + (r & 1); const long long tok = (long long)b * p.S + (long long)cur * 64 + tl; const int sq = cur * 64 + tl;
        bf16x8_t bq[2];
#pragma unroll
        for (int ks = 0; ks < 2; ++ks) bq[ks] = *(const bf16x8_t*)(P + tok * PW + C_Q + hd * 64 + 32 * ks + 8 * q);
        const int nv = sq >= 31 ? (sq - 31) / 16 + 1 : 0;
        f32x4_t s[8];
#pragma unroll
        for (int kb = 0; kb < 8; ++kb) { s[kb] = (f32x4_t){0.f, 0.f, 0.f, 0.f};
#pragma unroll
            for (int ks = 0; ks < 2; ++ks) { const bf16x8_t a = *(const LAS bf16x8_t*)(kt + (16 * kb + r) * AT_KS + (32 * ks + 8 * q) * 2); s[kb] = __builtin_amdgcn_mfma_f32_16x16x32_bf16(a, bq[ks], s[kb], 0, 0, 0); } }
        float mx = -1e30f;
#pragma unroll
        for (int kb = 0; kb < 8; ++kb)
#pragma unroll
            for (int j = 0; j < 4; ++j) { const bool ok = 16 * kb + 4 * q + j < nv; const float v = ok ? s[kb][j] * 1.44269504f : -1e30f; s[kb][j] = v; mx = fmaxf(mx, v); }
        mx = fmaxf(mx, __shfl_xor(mx, 16)); mx = fmaxf(mx, __shfl_xor(mx, 32));
        float sum = 0.f;
#pragma unroll
        for (int kb = 0; kb < 8; ++kb)
#pragma unroll
            for (int j = 0; j < 4; ++j) { const float pv = s[kb][j] > -1e29f ? __builtin_amdgcn_exp2f(s[kb][j] - mx) : 0.f; s[kb][j] = pv; sum += pv; }
        sum += __shfl_xor(sum, 16); sum += __shfl_xor(sum, 32);
        const float inv = nv > 0 ? 1.0f / sum : 0.f;
#pragma unroll
        for (int kb = 0; kb < 8; ++kb) s[kb] = s[kb] * inv;
        f32x4_t o[4];
#pragma unroll
        for (int db = 0; db < 4; ++db) o[db] = (f32x4_t){0.f, 0.f, 0.f, 0.f};
#pragma unroll
        for (int kk = 0; kk < 4; ++kk) { u32x4_t w = (u32x4_t){pack2bf(s[2 * kk][0], s[2 * kk][1]), pack2bf(s[2 * kk][2], s[2 * kk][3]), pack2bf(s[2 * kk + 1][0], s[2 * kk + 1][1]), pack2bf(s[2 * kk + 1][2], s[2 * kk + 1][3])};
            const bf16x8_t pb = __builtin_bit_cast(bf16x8_t, w);
#pragma unroll
            for (int db = 0; db < 4; ++db) { const LAS unsigned char* vp = vt + (16 * db + r) * CM_VS + (32 * kk + 4 * q) * 2;
                const bf16x4_t lo = *(const LAS bf16x4_t*)vp, hi = *(const LAS bf16x4_t*)(vp + 32);
                o[db] = __builtin_amdgcn_mfma_f32_16x16x32_bf16(__builtin_shufflevector(lo, hi, 0, 1, 2, 3, 4, 5, 6, 7), pb, o[db], 0, 0, 0); } }
        const float g0 = sigmoidf_(bf2f(P[tok * PW + C_NG + hd * 3]));
#pragma unroll
        for (int db = 0; db < 4; ++db) { uint2 w; w.x = pack2bf(g0 * o[db][0], g0 * o[db][1]); w.y = pack2bf(g0 * o[db][2], g0 * o[db][3]); *(uint2*)(O + tok * 1024 + hd * 64 + 16 * db + 4 * q) = w; }
        float imp[8], tcar[8];
#pragma unroll
        for (int kb = 0; kb < 8; ++kb) { imp[kb] = s[kb][0] + s[kb][1] + s[kb][2] + 0.5f * s[kb][3]; tcar[kb] = __shfl(0.5f * s[kb][3], (lane + 48) & 63); }
#pragma unroll
        for (int kb = 0; kb < 8; ++kb) { const float cin = q >= 1 ? tcar[kb] : (kb >= 1 ? tcar[kb >= 1 ? kb - 1 : 0] : 0.f); imp[kb] += cin; imp[kb] += __shfl_xor(imp[kb], 1); }
        unsigned mask;
        if (cur < 8) mask = (2u << cur) - 1u;
        else {
            mask = 1u | (1u << cur) | (1u << (cur - 1));
#pragma unroll
            for (int kb = 0; kb < 8; ++kb) { const int jj = 4 * kb + q; if (!(jj >= 1 && jj <= cur - 2)) imp[kb] = -3e38f; }
            for (int rd = 0; rd < 5; ++rd) { float bv = -3e38f; int bi = 1 << 20;
#pragma unroll
                for (int kb = 0; kb < 8; ++kb) if (imp[kb] > bv) { bv = imp[kb]; bi = 4 * kb + q; }
#pragma unroll
                for (int sh = 16; sh <= 32; sh <<= 1) { const float ov = __shfl_xor(bv, sh); const int oi = __shfl_xor(bi, sh); if (ov > bv || (ov == bv && oi < bi)) { bv = ov; bi = oi; } }
                mask |= 1u << bi;
#pragma unroll
                for (int kb = 0; kb < 8; ++kb) if (bi == 4 * kb + q) imp[kb] = -3e38f; }
        }
        if (q == 0 && (r & 1) == 0) SELM[tok * 2 + g] = mask;
    }
}
#endif
#ifndef CPU_EMU
typedef float f32x2_t __attribute__((ext_vector_type(2)));
template <int CTRL> __device__ __forceinline__ float dpp_mov(float x) { return __builtin_bit_cast(float, __builtin_amdgcn_update_dpp(0, __builtin_bit_cast(int, x), CTRL, 0xF, 0xF, true)); }
__device__ __forceinline__ float sum8(float x) { x += dpp_mov<0xB1>(x); x += dpp_mov<0x4E>(x); x += dpp_mov<0x141>(x); return x; }
__device__ __forceinline__ float sum16s(float x) { x += __shfl_xor(x, 1); x += __shfl_xor(x, 2); x += __shfl_xor(x, 4); x += __shfl_xor(x, 8); return x; }
constexpr int SC_CH = 32;
constexpr int RW_STEP = 384, RW_BUF = SC_CH * RW_STEP * 4;
constexpr int GL_STEP = 160, GL_BUF = SC_CH * GL_STEP * 4;
__device__ __forceinline__ void cvt8(const uint4& w, float (&f)[8]) { f[0] = u2f(w.x << 16); f[1] = u2f(w.x & 0xffff0000u); f[2] = u2f(w.y << 16); f[3] = u2f(w.y & 0xffff0000u); f[4] = u2f(w.z << 16); f[5] = u2f(w.z & 0xffff0000u); f[6] = u2f(w.w << 16); f[7] = u2f(w.w & 0xffff0000u); }

__device__ __forceinline__ void rwkv_chain(const Params& p, int l, int ch, int wv, LAS unsigned char* lds) {
    int tid = wv * 64 + mk_lane(); asm volatile("" : "+v"(tid));
    const int row = tid >> 3, cg = tid & 7; const long long b = ch >> 2; const int h = ch & 3;
    const float* RWW = WSP(float, p.oRWW); const bf16_t* RWX = WSP(bf16_t, p.oRWX); bf16_t* O = WSP(bf16_t, p.oO); const float* lng = p.in[I_RW_LN] + l * 256 + h * 64; const float* rkw = p.in[I_RW_RK] + l * 256 + h * 64;
    LAS float* YB = (LAS float*)(lds + 2 * RW_BUF);
    const long long tb = b * p.S; const int nch = (int)(p.S / SC_CH);
    float4 gw;
    uint4 gx0, gx1, gx2;
#define RW_GLOAD1(idx_, dst_) do { const int idx = (idx_); if (idx < 1280) { const int step = idx / 40, rem = idx % 40, vec = rem >> 3, c8 = rem & 7; dst_ = *(const uint4*)(RWX + (t0_ + step) * 1280 + vec * 256 + h * 64 + 8 * c8); } } while (0)
#define RW_GLOAD(c_) do { const long long t0_ = tb + (long long)(c_) * SC_CH; gw = *(const float4*)(RWW + (t0_ + (tid >> 4)) * 256 + h * 64 + 4 * (tid & 15)); RW_GLOAD1(tid, gx0); RW_GLOAD1(tid + 512, gx1); RW_GLOAD1(tid + 1024, gx2); } while (0)
#define RW_SSTORE1(idx_, src_) do { const int idx = (idx_); if (idx < 1280) { const int step = idx / 40, rem = idx % 40, vec = rem >> 3, c8 = rem & 7; \
        const int slot = vec == 0 ? 4 : (vec == 1 ? 3 : (vec == 2 ? 5 : (vec == 3 ? 1 : 2))); float f[8]; cvt8(src_, f); LAS float* d = B_ + step * RW_STEP + slot * 64 + 8 * c8; \
        *(LAS f32x4_t*)d = (f32x4_t){f[0], f[1], f[2], f[3]}; *(LAS f32x4_t*)(d + 4) = (f32x4_t){f[4], f[5], f[6], f[7]}; } } while (0)
#define RW_SSTORE(buf_) do { LAS float* B_ = (LAS float*)(lds + (buf_) * RW_BUF); *(LAS f32x4_t*)(B_ + (tid >> 4) * RW_STEP + 4 * (tid & 15)) = (f32x4_t){gw.x, gw.y, gw.z, gw.w}; \
        RW_SSTORE1(tid, gx0); RW_SSTORE1(tid + 512, gx1); RW_SSTORE1(tid + 1024, gx2); } while (0)
    f32x2_t st[4];
#pragma unroll
    for (int i = 0; i < 4; ++i) st[i] = (f32x2_t){0.f, 0.f};
    RW_GLOAD(0); RW_SSTORE(0); __syncthreads();
    for (int c = 0; c < nch; ++c) {
        if (c + 1 < nch) RW_GLOAD(c + 1);
        const LAS float* B = (const LAS float*)(lds + (c & 1) * RW_BUF);
        for (int s = 0; s < SC_CH; ++s) { const LAS float* x = B + s * RW_STEP + 8 * cg;
            f32x2_t w[4], kk[4], bb[4], k[4], r[4];
#pragma unroll
            for (int i = 0; i < 2; ++i) { const f32x4_t a0 = *(const LAS f32x4_t*)(x + 4 * i), a1 = *(const LAS f32x4_t*)(x + 64 + 4 * i), a2 = *(const LAS f32x4_t*)(x + 128 + 4 * i), a3 = *(const LAS f32x4_t*)(x + 192 + 4 * i), a4 = *(const LAS f32x4_t*)(x + 256 + 4 * i);
                w[2 * i] = (f32x2_t){a0[0], a0[1]}; w[2 * i + 1] = (f32x2_t){a0[2], a0[3]}; kk[2 * i] = (f32x2_t){a1[0], a1[1]}; kk[2 * i + 1] = (f32x2_t){a1[2], a1[3]};
                bb[2 * i] = (f32x2_t){a2[0], a2[1]}; bb[2 * i + 1] = (f32x2_t){a2[2], a2[3]}; k[2 * i] = (f32x2_t){a3[0], a3[1]}; k[2 * i + 1] = (f32x2_t){a3[2], a3[3]};
                r[2 * i] = (f32x2_t){a4[0], a4[1]}; r[2 * i + 1] = (f32x2_t){a4[2], a4[3]}; }
            const float v = B[s * RW_STEP + 320 + row];
            f32x2_t a = st[0] * kk[0] + st[1] * kk[1]; a += st[2] * kk[2] + st[3] * kk[3];
            const float skk = sum8(a[0] + a[1]);
            f32x2_t y2 = (f32x2_t){0.f, 0.f};
#pragma unroll
            for (int i = 0; i < 4; ++i) { st[i] = st[i] * w[i] - bb[i] * skk + k[i] * v; y2 += st[i] * r[i]; }
            const float y = sum8(y2[0] + y2[1]);
            if (cg == 0) YB[s * 64 + row] = y; }
        __syncthreads();
        {
            const int s = tid >> 4, v0 = 4 * (tid & 15); const long long t = tb + (long long)c * SC_CH + s;
            const f32x4_t y = *(const LAS f32x4_t*)(YB + s * 64 + v0); const f32x4_t vv = *(const LAS f32x4_t*)(B + s * RW_STEP + 320 + v0);
            const float mean = sum16s(y[0] + y[1] + y[2] + y[3]) * (1.0f / 64.0f);
            const float d0 = y[0] - mean, d1 = y[1] - mean, d2 = y[2] - mean, d3 = y[3] - mean;
            const float var = sum16s(d0 * d0 + d1 * d1 + d2 * d2 + d3 * d3) * (1.0f / 64.0f), rstd = rsqrtf(var + 64e-5f);
            const f32x4_t rr = *(const LAS f32x4_t*)(B + s * RW_STEP + 256 + v0), kq = *(const LAS f32x4_t*)(B + s * RW_STEP + 192 + v0); const float4 rw4 = *(const float4*)(rkw + v0);
            const float rk = sum16s(rr[0] * kq[0] * rw4.x + rr[1] * kq[1] * rw4.y + rr[2] * kq[2] * rw4.z + rr[3] * kq[3] * rw4.w);
            bf16_t* o = O + t * 1024 + 512 + h * 64 + v0; const uint2 g = *(const uint2*)o; const float4 ln = *(const float4*)(lng + v0);
            const float r0 = (d0 * rstd * ln.x + rk * vv[0]) * u2f(g.x << 16), r1 = (d1 * rstd * ln.y + rk * vv[1]) * u2f(g.x & 0xffff0000u);
            const float r2 = (d2 * rstd * ln.z + rk * vv[2]) * u2f(g.y << 16), r3 = (d3 * rstd * ln.w + rk * vv[3]) * u2f(g.y & 0xffff0000u);
            uint2 w; w.x = pack2bf(r0, r1); w.y = pack2bf(r2, r3); *(uint2*)o = w; }
        if (c + 1 < nch) RW_SSTORE((c + 1) & 1);
        __syncthreads();
    }
}
__device__ __forceinline__ void gla_chain(const Params& p, int l, int ch, int wv, LAS unsigned char* lds) {
    int tid = wv * 64 + mk_lane(); asm volatile("" : "+v"(tid));
    const int vc = tid >> 3, kg = tid & 7; const long long b = ch >> 2; const int h = ch & 3;
    const bf16_t* P = WSP(bf16_t, p.oP); const float* GA = WSP(float, p.oGA); bf16_t* O = WSP(bf16_t, p.oO); const float* ng = p.in[I_GLA_NORM] + l * 64;
    LAS float* OB = (LAS float*)(lds + 2 * GL_BUF);
    const long long tb = b * p.S; const int nch = (int)(p.S / SC_CH);
    float4 ga; uint4 g1, g2;
#define GL_GLOAD(c_) do { const long long t0_ = tb + (long long)(c_) * SC_CH; \
        if (tid < 256) { const int step = tid >> 3, c4 = tid & 7; ga = *(const float4*)(GA + (t0_ + step) * 128 + h * 32 + 4 * c4); g1 = *(const uint4*)(P + (t0_ + step) * PW + C_GLA + 256 + h * 64 + 8 * c4); } \
        else { const int idx = tid - 256, step = idx >> 3, vec = (idx >> 2) & 1, c8 = idx & 3; g2 = *(const uint4*)(P + (t0_ + step) * PW + C_GLA + vec * 128 + h * 32 + 8 * c8); } } while (0)
#define GL_SSTORE(buf_) do { LAS float* B_ = (LAS float*)(lds + (buf_) * GL_BUF); float f[8]; \
        if (tid < 256) { const int step = tid >> 3, c4 = tid & 7; *(LAS f32x4_t*)(B_ + step * GL_STEP + 4 * c4) = (f32x4_t){ga.x, ga.y, ga.z, ga.w}; \
            cvt8(g1, f); LAS float* d = B_ + step * GL_STEP + 96 + 8 * c4; *(LAS f32x4_t*)d = (f32x4_t){f[0], f[1], f[2], f[3]}; *(LAS f32x4_t*)(d + 4) = (f32x4_t){f[4], f[5], f[6], f[7]}; } \
        else { const int idx = tid - 256, step = idx >> 3, vec = (idx >> 2) & 1, c8 = idx & 3; \
            cvt8(g2, f); LAS float* d = B_ + step * GL_STEP + (vec == 0 ? 64 : 32) + 8 * c8; *(LAS f32x4_t*)d = (f32x4_t){f[0], f[1], f[2], f[3]}; *(LAS f32x4_t*)(d + 4) = (f32x4_t){f[4], f[5], f[6], f[7]}; } } while (0)
    f32x4_t st = (f32x4_t){0.f, 0.f, 0.f, 0.f};
    GL_GLOAD(0); GL_SSTORE(0); __syncthreads();
    for (int c = 0; c < nch; ++c) {
        if (c + 1 < nch) GL_GLOAD(c + 1);
        const LAS float* B = (const LAS float*)(lds + (c & 1) * GL_BUF);
        for (int s = 0; s < SC_CH; ++s) { const LAS float* x = B + s * GL_STEP + 4 * kg;
            const f32x4_t a = *(const LAS f32x4_t*)x, k = *(const LAS f32x4_t*)(x + 32), qv = *(const LAS f32x4_t*)(x + 64); const float v = B[s * GL_STEP + 96 + vc];
            st = st * a + k * v; const f32x4_t pq = st * qv;
            const float o = sum8((pq[0] + pq[1]) + (pq[2] + pq[3]));
            if (kg == 0) OB[s * 64 + vc] = o * 0.17677669529663687f; }
        __syncthreads();
        {   const int s = tid >> 4, v0 = 4 * (tid & 15); const long long t = tb + (long long)c * SC_CH + s;
            const f32x4_t o = *(const LAS f32x4_t*)(OB + s * 64 + v0);
            const float ms = sum16s(o[0] * o[0] + o[1] * o[1] + o[2] * o[2] + o[3] * o[3]) * (1.0f / 64.0f), rs = rsqrtf(ms + 1e-6f);
            bf16_t* d = O + t * 1024 + 768 + h * 64 + v0; const uint2 g = *(const uint2*)d; const float4 n4 = *(const float4*)(ng + v0);
            uint2 w; w.x = pack2bf(o[0] * rs * n4.x * u2f(g.x << 16), o[1] * rs * n4.y * u2f(g.x & 0xffff0000u)); w.y = pack2bf(o[2] * rs * n4.z * u2f(g.y << 16), o[3] * rs * n4.w * u2f(g.y & 0xffff0000u)); *(uint2*)d = w; }
        if (c + 1 < nch) GL_SSTORE((c + 1) & 1);
        __syncthreads();
    }
}
__device__ __forceinline__ void ph_scans(const Params& p, int l, int wv, LAS unsigned char* lds, int gC, int gG) {
    const int nchain = (int)(p.B * 4);
    for (int it = gC; it < 2 * nchain; it += gG) { if (it < nchain) rwkv_chain(p, l, it, wv, lds); else gla_chain(p, l, it - nchain, wv, lds); }
}
#endif
#ifdef CPU_EMU
struct Ctx { long long gtid, gsz, gw, nw; int lane, G, c; };
#define GEMM(A, lda, Bt, ldb, K, S, E) gemm_cpu(A, lda, Bt, ldb, K, S, E)
#define GEMMK(A, lda, Bt, ldb, K, S, E, ks) gemm_cpu(A, lda, Bt, ldb, K, S, E, ks)
#define GRID_BARRIER() do { } while (0)
#else
struct Ctx { LAS unsigned char* lds; XcdBarrier bar; int wv; };
#define GEMM(A, lda, Bt, ldb, K, S, E) gemm_phase(cx.wv, cx.lds, A, lda, Bt, ldb, K, S, E)
#define GEMMK(A, lda, Bt, ldb, K, S, E, ks) gemm_phase(cx.wv, cx.lds, A, lda, Bt, ldb, K, S, E, ks)
#define GRID_BARRIER() xcd_barrier(cx.bar)
#endif
constexpr int N_PHASES = 58;
#ifndef PROBE_CONV
#define PROBE_CONV 1
#endif
#ifndef PROBE_PREP
#define PROBE_PREP 1
#endif
#ifndef PROBE_GEMM
#define PROBE_GEMM 1
#endif
#ifndef PROBE_CMP
#define PROBE_CMP 1
#endif
#ifndef PROBE_CA
#define PROBE_CA 1
#endif
#ifndef PROBE_MOE
#define PROBE_MOE 1
#endif
#ifndef PROBE_RMS
#define PROBE_RMS 1
#endif
#ifndef PROBE_BAR
#define PROBE_BAR 0
#endif

template <int KIND> DEVI void run_program(const Params& p, const Ctx& cx, int pb, int pe) {
    int ph = 0;
#define T p.T
#define DFF p.DFF
#ifdef CPU_EMU
    const long long gsz = cx.gsz, nw = cx.nw; const int gG = cx.G, gC = cx.c;
#else
#define gsz ((long long)gridDim.x * 512)
#define nw ((long long)gridDim.x * 8)
#define gG ((int)gridDim.x)
#define gC ((int)blockIdx.x)
#endif
#define H WSP(bf16_t, p.oH)
#define P WSP(bf16_t, p.oP)
#define O WSP(bf16_t, p.oO)
#define BO WSP(bf16_t, p.oBO)
#define MG WSP(bf16_t, p.oMG)
#define CQ WSP(bf16_t, p.oCQ)
#define CAO WSP(bf16_t, p.oCAO)
#define MEMN WSP(bf16_t, p.oMEMN)
#define ACT WSP(bf16_t, p.oACT)
#define WFFN WSP(bf16_t, p.oWFFN)
#ifdef CPU_EMU
#define OPAQUE_V(x) do { } while (0)
#define PH_IDX long long gtid = cx.gtid, gw = cx.gw; int lane = cx.lane
#else
#define OPAQUE_V(x) asm volatile("" : "+v"(x))
#define PH_IDX unsigned tx_ = (unsigned)(cx.wv * 64 + mk_lane()); OPAQUE_V(tx_); long long gtid = (long long)blockIdx.x * 512 + tx_, gw = (long long)(tx_ >> 6) * gridDim.x + blockIdx.x; int lane = tx_ & 63
#endif
#define PH_BEGIN(k) if (ph >= pb && ph < pe) { if constexpr (KIND < 0 || KIND == (k)) { PH_IDX; OPAQUE_V(gtid); OPAQUE_V(gw); OPAQUE_V(lane); (void)gtid; (void)gw; (void)lane;
#define PH_END   } if (ph + 1 < pe) GRID_BARRIER(); } ++ph;
    PH_BEGIN(0)
        for (int rep_ = 0; rep_ < PROBE_CONV; ++rep_) { ph_convert_layer(p, 0, gtid, gsz); ph_convert_layer(p, 1, gtid, gsz); ph_convert_ffn(p, gtid, gsz); ph_convert_cmp(p, gtid, gsz); } ph_rope(p, gtid, gsz);
        ph_rmsnorm(p, p.in[I_MEM], p.B * 256, p.in[I_MEM_NORM], MEMN, 0, nullptr, gw, nw, lane);
        ph_rmsnorm(p, p.in[I_X], T, p.in[I_NORM_MIX], H, 1, p.out, gw, nw, lane);
    PH_END
    PH_BEGIN(1)
        { SchedPlain S; S.init(p.B * 256, 1024, 1024, 1024, gG, gC); EpStore E{WSP(bf16_t, p.oKV), 1024, 1.0f}; GEMM(MEMN, 1024, WSP(bf16_t, p.oWKV), 1024, 1024, S, E); }
    PH_END
    for (int l = 0; l < 2; ++l) {
#define W WSP(bf16_t, p.oWL[l])
        PH_BEGIN(1) for (int rep_ = 0; rep_ < PROBE_GEMM; ++rep_) { SchedPlain S; S.init(T, 3072, 1024, 1024, gG, gC); EpStore E{P, 3072, 1.0f}; GEMM(H, 1024, W + W_IN, 1024, 1024, S, E); } PH_END
        PH_BEGIN(2) ph_rope_apply(p, gtid, gsz); { SchedCmp S; S.init(T / 16, gG, gC); EpUV E{WSP(bf16_t, p.oUV)}; GEMMK(P, 16LL * PW, WSP(bf16_t, p.oW1T) + (long long)l * 2 * 256 * 1024, 1024, 1024, S, E, (long long)PW); }
            ph_pool(p, l, gtid, gsz); ph_gla_prep(p, l, gtid, gsz);
#ifdef CPU_EMU
            { static bf16_t wl_[160 * 256]; rwkv_fill_wl(p, l, wl_, 0, 1); ph_rwkv_prep(p, l, wl_, gtid, gsz); }
#else
            { LDSQ bf16_t* wl_ = (LDSQ bf16_t*)cx.lds; rwkv_fill_wl(p, l, wl_, (int)tx_, 512); __syncthreads(); ph_rwkv_prep(p, l, wl_, gtid, gsz); }
#endif
#if PROBE_PREP == 2
            ph_pool(p, l, gtid, gsz);
#elif PROBE_PREP == 3
            ph_pool(p, l, gtid, gsz); ph_gla_prep(p, l, gtid, gsz);
#endif
 PH_END
        PH_BEGIN(3) ph_compress2(p, l, gtid, gsz); for (int rep_ = 0; rep_ < PROBE_BAR; ++rep_) GRID_BARRIER(); PH_END
#ifdef CPU_EMU
        PH_BEGIN(4) ph_rwkv_scan(p, l, gw, nw, lane); ph_gla_scan(p, l, (gw + nw - (p.B * 4) % nw) % nw, nw, lane); ph_cmp_attn(p, gtid, gsz); PH_END
#else
        PH_BEGIN(4) ph_scans(p, l, cx.wv, cx.lds, gC, gG); ph_cmp_attn_mfma(p, cx.wv, cx.lds, gC, gG); PH_END
#endif
#ifdef CPU_EMU
        PH_BEGIN(5) ph_selwin(p, gtid, gsz); PH_END
#else
        PH_BEGIN(5) ph_selwin_mfma(p, cx.wv, cx.lds, gC, gG); PH_END
#endif
        for (int q = 0; q < 4; ++q) { const long long r0 = q * (T / 4);
            PH_BEGIN(6) { SchedBranch S; S.init(T / 4, gG, gC); EpStore E{BO, 4096, 1.0f}; GEMM(O + r0 * 1024, 1024, W + W_B, 256, 256, S, E); } PH_END
            PH_BEGIN(7) { SchedGate S; S.init(T / 4, gG, gC); EpGate E{BO, p.in[I_B_GATE] + l * 4096, MG, r0}; GEMM(H + r0 * 1024, 1024, W + W_G, 1024, 1024, S, E); } PH_END }
        PH_BEGIN(8) { SchedPlain S; S.init(T, 1024, 1024, 1024, gG, gC); EpResid E{p.out}; GEMM(MG, 1024, W + W_O, 1024, 1024, S, E); } PH_END
        PH_BEGIN(9) for (int rep_ = 0; rep_ < PROBE_RMS; ++rep_) ph_rmsnorm(p, p.out, T, p.in[I_NORM_CA] + l * 1024, H, 0, nullptr, gw, nw, lane); PH_END
        PH_BEGIN(1) { SchedPlain S; S.init(T, 256, 1024, 1024, gG, gC); EpStore E{CQ, 256, 0.125f}; GEMM(H, 1024, W + W_CQ, 1024, 1024, S, E); } PH_END
#ifdef CPU_EMU
        PH_BEGIN(10) ph_ca_attn(p, l, gtid, gsz); PH_END
#else
        PH_BEGIN(10) for (int rep_ = 0; rep_ < PROBE_CA; ++rep_) ph_ca_attn_mfma(p, l, cx.wv, cx.lds, gC, gG); PH_END
#endif
        PH_BEGIN(8) { SchedPlain S; S.init(T, 1024, 256, 256, gG, gC); EpResid E{p.out}; GEMM(CAO, 256, W + W_CO, 256, 256, S, E); } PH_END
        PH_BEGIN(9) ph_rmsnorm(p, p.out, T, p.in[I_NORM_FFN] + l * 1024, H, l == 1 ? 2 : 0, nullptr, gw, nw, lane); if (l == 1) for (int rep_ = 0; rep_ < PROBE_CONV; ++rep_) ph_convert_moe(p, gtid, gsz); PH_END
        if (l == 0) {
            PH_BEGIN(11) { SchedPlain S; S.init(T, 2 * DFF, 1024, 1024, gG, gC); EpSwiglu E{ACT, DFF, 0}; GEMM(H, 1024, WFFN, 1024, 1024, S, E); } PH_END
            PH_BEGIN(8) { SchedPlain S; S.init(T, 1024, DFF, DFF, gG, gC); EpResid E{p.out}; GEMM(ACT, DFF, WFFN + 2 * DFF * 1024, DFF, DFF, S, E); } PH_END
            PH_BEGIN(9) ph_rmsnorm(p, p.out, T, p.in[I_NORM_MIX] + 1024, H, 0, nullptr, gw, nw, lane); PH_END
        } else {
            PH_BEGIN(12) for (int rep_ = 0; rep_ < PROBE_MOE; ++rep_) ph_moe_count(p, gtid, gsz); PH_END
            PH_BEGIN(12) for (int rep_ = 0; rep_ < PROBE_MOE; ++rep_) ph_moe_offsets(p, gtid, gsz); PH_END
            PH_BEGIN(12) for (int rep_ = 0; rep_ < PROBE_MOE; ++rep_) ph_moe_assign(p, gtid, gsz); PH_END
            PH_BEGIN(12) for (int rep_ = 0; rep_ < PROBE_MOE; ++rep_) ph_moe_gather(p, gtid, gsz); PH_END
#define HS WSP(bf16_t, p.oHS)
#define ACTC WSP(bf16_t, p.oACTC)
#define MW WSP(bf16_t, p.oMOEW)
#define MC WSP(int, p.oMOEC)
            const int ct = (p.NR / 256) >= 512 ? 128 : (int)((p.NR / 256 + 3) / 4);
            for (int q = 0; q < 5; ++q) {
                PH_BEGIN(13) { SchedMoe S; const int nt_ = MC[16 + 8] / 256; S.t0 = q * ct; S.t1 = (q + 1) * ct < nt_ ? (q + 1) * ct : nt_; if (S.t1 < S.t0) S.t1 = S.t0; S.nN = (int)(2 * DFF / 256); S.G = gG; S.c = gC; S.lda = 1024; S.ldb = 1024; S.per_e = 3 * 1024 * DFF * 2;
#pragma unroll
                    for (int e = 0; e < 9; ++e) S.base[e] = MC[16 + e];
                    EpSwiglu E{ACTC, DFF, (long long)S.t0 * 256}; GEMM(HS, 1024, MW, 1024, 1024, S, E); } PH_END
                PH_BEGIN(14) { SchedMoe S; const int nt_ = MC[16 + 8] / 256; S.t0 = q * ct; S.t1 = (q + 1) * ct < nt_ ? (q + 1) * ct : nt_; if (S.t1 < S.t0) S.t1 = S.t0; S.nN = 4; S.G = gG; S.c = gC; S.lda = DFF; S.ldb = DFF; S.per_e = 3 * 1024 * DFF * 2;
#pragma unroll
                    for (int e = 0; e < 9; ++e) S.base[e] = MC[16 + e];
                    EpMoeDown E{WSP(bf16_t, p.oY), WSP(float, p.oROWW)}; GEMM(ACTC - (long long)S.t0 * 256 * DFF, DFF, MW + 2 * DFF * 1024, DFF, DFF, S, E); } PH_END }
            PH_BEGIN(15) ph_final(p, gw, nw, lane); PH_END
        }
    }
#undef PH_BEGIN
#undef PH_END
#undef H
#undef P
#undef O
#undef BO
#undef MG
#undef CQ
#undef CAO
#undef MEMN
#undef ACT
#undef WFFN
#undef T
#undef DFF
#undef W
#undef HS
#undef ACTC
#undef MW
#undef MC
#ifndef CPU_EMU
#undef gsz
#undef nw
#undef gG
#undef gC
#endif
}

#ifndef CPU_EMU
template <int KIND> __global__ __launch_bounds__(512, 2) void mk_fwd(Params p, int pb, int pe) {
    extern __shared__ __attribute__((aligned(16))) unsigned char shm[];
    Ctx cx; cx.lds = (LAS unsigned char*)shm;
    volatile LAS unsigned* xbw = (volatile LAS unsigned*)(cx.lds + STAGE_BYTES);
    if (threadIdx.x == 0) { xbw[0] = 0u; xbw[1] = 0u; xbw[2] = 0u; xbw[3] = 0u; }
    __syncthreads();
    cx.wv = __builtin_amdgcn_readfirstlane((int)(threadIdx.x >> 6));
    cx.bar = xcd_barrier_post((unsigned*)(p.ws + p.oBAR), xbw, cx.wv);
    run_program<KIND>(p, cx, pb, pe);
}
#ifndef MK_ONE
#define MK_ONE 1
#endif
#if !MK_ONE
static const int kPhaseKind[N_PHASES] = { 0, 1,
    1, 2, 3, 4, 5, 6, 7, 6, 7, 6, 7, 6, 7, 8, 9, 1, 10, 8, 9, 11, 8, 9,
    1, 2, 3, 4, 5, 6, 7, 6, 7, 6, 7, 6, 7, 8, 9, 1, 10, 8, 9, 12, 12, 12, 12, 13, 14, 13, 14, 13, 14, 13, 14, 13, 14, 15 };
#endif
typedef void (*mk_fn)(Params, int, int);
extern "C" void kernel_launch(void* const* d_in, const int* in_sizes, int n_in, void* d_out, int out_size, void* d_ws, size_t ws_size, hipStream_t stream) {
    (void)in_sizes; (void)n_in; (void)out_size;
    Params p; memset(&p, 0, sizeof(p));
    for (int i = 0; i < N_INPUTS; ++i) p.in[i] = (const float*)d_in[i];
    p.out = (float*)d_out; p.ws = (unsigned char*)d_ws;
    make_layout(p, 32, 2048, 2816);
    for (int j = 0; j < 8; ++j) p.inv_freq[j] = (float)pow(500000.0, -(double)(2 * j) / 16.0);
    if ((size_t)p.wsNeed > ws_size) { fprintf(stderr, "workspace too small: need %lld have %zu\n", p.wsNeed, ws_size); return; }
    const size_t lds_bytes = STAGE_BYTES + 16;
#if MK_ONE
    static const mk_fn fns[1] = { mk_fwd<-1> }; const int nf = 1;
#else
    static const mk_fn fns[16] = { mk_fwd<0>, mk_fwd<1>, mk_fwd<2>, mk_fwd<3>, mk_fwd<4>, mk_fwd<5>, mk_fwd<6>, mk_fwd<7>, mk_fwd<8>, mk_fwd<9>, mk_fwd<10>, mk_fwd<11>, mk_fwd<12>, mk_fwd<13>, mk_fwd<14>, mk_fwd<15> }; const int nf = 16;
#endif
    static int grid = 0;
    if (!grid) { int dev = 0, cus = 0; (void)hipGetDevice(&dev); (void)hipDeviceGetAttribute(&cus, hipDeviceAttributeMultiprocessorCount, dev);
        for (int k = 0; k < nf; ++k) (void)hipFuncSetAttribute((const void*)fns[k], hipFuncAttributeMaxDynamicSharedMemorySize, (int)lds_bytes);
        int per_cu = 0; (void)hipOccupancyMaxActiveBlocksPerMultiprocessor(&per_cu, (const void*)fns[0], 512, lds_bytes); (void)hipGetLastError();
        grid = cus > 0 ? cus : 256; }
    (void)hipMemsetAsync(p.ws + p.oBAR, 0, 16384 + 4096, stream);
#if MK_ONE
    hipLaunchKernelGGL(fns[0], dim3(grid), dim3(512), lds_bytes, stream, p, 0, N_PHASES);
#else
    for (int ph = 0; ph < N_PHASES; ++ph) hipLaunchKernelGGL(fns[kPhaseKind[ph]], dim3(grid), dim3(512), lds_bytes, stream, p, ph, ph + 1);
#endif
}
#endif
```

```cpp
#ifndef CPU_EMU
#include <hip/hip_runtime.h>
#include <cstdio>
#include <cstdint>
#include <cstring>
#define DEVI __device__ __forceinline__
#define DEVM __device__ __forceinline__
#else
#include <cmath>
#include <cstdio>
#include <cstdint>
#include <cstring>
#include <cstdlib>
#define DEVI static inline
#define DEVM inline
struct uint4 { unsigned x, y, z, w; }; struct uint2 { unsigned x, y; };
struct float4 { float x, y, z, w; };
#endif

typedef unsigned short bf16_t;
#ifdef CPU_EMU
static inline float u2f(unsigned u) { float f; memcpy(&f, &u, 4); return f; }
static inline unsigned f2u(float f) { unsigned u; memcpy(&u, &f, 4); return u; }
#else
DEVI float u2f(unsigned u) { return __uint_as_float(u); }
DEVI unsigned f2u(float f) { return __float_as_uint(f); }
#endif
DEVI float bf2f(bf16_t b) { return u2f(((unsigned)b) << 16); }
DEVI bf16_t f2bf(float f) { unsigned u = f2u(f); u += 0x7FFFu + ((u >> 16) & 1u); return (bf16_t)(u >> 16); }
#ifdef CPU_EMU
DEVI unsigned pk2bf(float lo, float hi) { return (unsigned)f2bf(lo) | ((unsigned)f2bf(hi) << 16); }
#else
DEVI unsigned pk2bf(float lo, float hi) { unsigned r; asm("v_cvt_pk_bf16_f32 %0, %1, %2" : "=v"(r) : "v"(lo), "v"(hi)); return r; }
#endif
#ifdef CPU_EMU
DEVI float sigmoidf_(float x) { return 1.0f / (1.0f + expf(-x)); }
DEVI float siluf_(float x) { return x / (1.0f + expf(-x)); }
#else
DEVI float sigmoidf_(float x) { return __builtin_amdgcn_rcpf(1.0f + __builtin_amdgcn_exp2f(-1.44269504f * x)); }
DEVI float siluf_(float x) { return x * __builtin_amdgcn_rcpf(1.0f + __builtin_amdgcn_exp2f(-1.44269504f * x)); }
#endif
#ifdef CPU_EMU
DEVI float expf_(float x) { return expf(x); }
DEVI float tanhf_(float x) { return tanhf(x); }
DEVI float softplusf_(float x) { return x > 20.f ? x : log1pf(expf(x)); }
#else
DEVI float expf_(float x) { return __builtin_amdgcn_exp2f(1.44269504f * x); }
DEVI float tanhf_(float x) { const float xc = fminf(fmaxf(x, -15.f), 15.f); return 1.0f - 2.0f * __builtin_amdgcn_rcpf(1.0f + __builtin_amdgcn_exp2f(2.88539008f * xc)); }
DEVI float softplusf_(float x) { return x > 20.f ? x : 0.69314718f * __builtin_amdgcn_logf(1.0f + __builtin_amdgcn_exp2f(1.44269504f * x)); }
#endif
DEVI float gelu_tanhf_(float x) { return 0.5f * x * (1.0f + tanhf_(0.7978845608028654f * (x + 0.044715f * x * x * x))); }

DEVI void st8(bf16_t* dst, const float* v) {
#ifndef CPU_EMU
    uint4 w; w.x = pk2bf(v[0], v[1]); w.y = pk2bf(v[2], v[3]); w.z = pk2bf(v[4], v[5]); w.w = pk2bf(v[6], v[7]);
    *(uint4*)dst = w;
#else
    for (int j = 0; j < 8; ++j) dst[j] = f2bf(v[j]);
#endif
}
DEVI void ld8(const bf16_t* src, float* v) {
#ifndef CPU_EMU
    const uint4 w = *(const uint4*)src; v[0] = u2f(w.x << 16); v[1] = u2f(w.x & 0xffff0000u); v[2] = u2f(w.y << 16); v[3] = u2f(w.y & 0xffff0000u); v[4] = u2f(w.z << 16); v[5] = u2f(w.z & 0xffff0000u); v[6] = u2f(w.w << 16); v[7] = u2f(w.w & 0xffff0000u);
#else
    for (int j = 0; j < 8; ++j) v[j] = bf2f(src[j]);
#endif
}
#ifdef CPU_EMU
#define QSCALE 0.125f
#define SCHED_FENCE() do { } while (0)
#define LDSQ
DEVI void ld8l(const bf16_t* src, float* v) { ld8(src, v); }
#else
#define QSCALE 0.18033688f
#define SCHED_FENCE() __builtin_amdgcn_sched_barrier(0)
#define LDSQ __attribute__((address_space(3)))
typedef unsigned u32x4l_t __attribute__((ext_vector_type(4)));
typedef float f32x4l_t __attribute__((ext_vector_type(4)));
DEVI void ld8l(const LDSQ bf16_t* src, float* v) { const u32x4l_t w = *(const LDSQ u32x4l_t*)src; v[0] = u2f(w[0] << 16); v[1] = u2f(w[0] & 0xffff0000u); v[2] = u2f(w[1] << 16); v[3] = u2f(w[1] & 0xffff0000u);
    v[4] = u2f(w[2] << 16); v[5] = u2f(w[2] & 0xffff0000u); v[6] = u2f(w[3] << 16); v[7] = u2f(w[3] & 0xffff0000u); }
#endif
#ifdef CPU_EMU
DEVI float dot2bf(unsigned a, unsigned b, float acc) { return acc + u2f(a << 16) * u2f(b << 16) + u2f(a & 0xffff0000u) * u2f(b & 0xffff0000u); }
#else
typedef __bf16 bf16x2_t __attribute__((ext_vector_type(2)));
DEVI float dot2bf(unsigned a, unsigned b, float acc) { return __builtin_amdgcn_fdot2_f32_bf16(__builtin_bit_cast(bf16x2_t, a), __builtin_bit_cast(bf16x2_t, b), acc, false); }
#endif
constexpr int DM = 1024;
constexpr int PW = 3072;
constexpr int INW = 2972;
constexpr int C_Q = 0, C_KC = 256, C_VC = 384, C_KS = 512, C_VS = 640, C_KW = 768, C_VW = 896, C_NG = 1024;
constexpr int C_POOL = 1040;
constexpr int C_RW = 1296;
constexpr int C_GLA = 2192;
constexpr int C_VRES = 2976;
constexpr int NCMPH = 128;

enum { I_X = 0, I_MEM, I_POS, I_NORM_MIX, I_W_IN, I_CMP_PE, I_CMP_W1, I_CMP_W2, I_POOL_W, I_POOL_SCALE, I_RW_MU, I_RW_W0, I_RW_W2, I_RW_A0, I_RW_A2, I_RW_G2,
       I_RW_V0, I_RW_V1, I_RW_V2, I_RW_KK, I_RW_KA, I_RW_RK, I_RW_LN, I_GLA_A2, I_GLA_AB, I_GLA_NORM, I_W_GATE, I_B_GATE, I_W_BRANCH, I_W_OUT, I_NORM_CA, I_MEM_NORM,
       I_CA_Q, I_CA_KV, I_CA_O, I_NORM_FFN, I_FFN_G, I_FFN_U, I_FFN_D, I_MOE_R, I_MOE_G, I_MOE_U, I_MOE_D, I_NORM_FINAL, N_INPUTS };

struct Params {
    const float* in[N_INPUTS];
    float* out;
    unsigned char* ws;
    long long B, S, T, DFF, NC, NR;
    float inv_freq[8];
    long long oBAR, oMOEC, oROPE, oKCMP, oVCMP, oUV, oW1T, oCB, oSELM, oKV, oTOKE, oTOKW, oTOKS, oR2T, oROWW, oCCNT, oCOFF;
    long long oWL[2], oWKV, oWFFN, oVF, oH, oP, oO, oBO, oMG, oRWW, oRWX, oGA, oCQ, oCAO, oMEMN, oACT, oY, oHS, oMOEW, oACTC, oRSA, oRSB, wsNeed;
};
constexpr long long W_IN = 0, W_G = W_IN + 3072LL * 1024, W_B = W_G + 4096LL * 1024, W_O = W_B + 4LL * 1024 * 256, W_CQ = W_O + 1024LL * 1024, W_CKV = W_CQ + 256LL * 1024,
                    W_CO = W_CKV + 512LL * 1024, W_LAYER = W_CO + 1024LL * 256;

static inline long long al256(long long x) { return (x + 255) & ~255LL; }
static inline void make_layout(Params& p, long long B, long long S, long long DFF) {
    p.B = B; p.S = S; p.T = B * S; p.DFF = DFF; p.NC = (S - 32) / 16 + 1; p.NR = 2 * p.T + 2048;
    const long long T = p.T;
    long long o = 0;
    auto take = [&](long long bytes) { long long r = o; o = al256(o + bytes); return r; };
    p.oBAR = take(16384); p.oMOEC = take(4096);
    p.oROPE = take(T * 16 * 4);
    p.oKCMP = take(B * 2 * 128 * 64 * 2); p.oVCMP = take(B * 2 * 128 * 64 * 2);        p.oUV = take((T / 16) * 4 * 256 * 2); p.oW1T = take(2LL * 2 * 256 * 1024 * 2); p.oCB = take(2 * 2 * 128 * 4);
    p.oSELM = take(T * 2 * 4);
    p.oKV = take(2 * B * 256 * 512 * 2);
    p.oTOKE = take(T * 2 * 4); p.oTOKW = take(T * 2 * 4); p.oTOKS = take(T * 2 * 4); p.oR2T = take(p.NR * 4); p.oROWW = take(p.NR * 4);
    p.oWL[0] = take(W_LAYER * 2); p.oWL[1] = take(W_LAYER * 2); p.oWKV = take(2LL * 512 * 1024 * 2); p.oWFFN = take(3 * 1024 * DFF * 2);
    p.oVF = take(T * 256 * 2);
    p.oH = take(T * 1024 * 2);
    p.oP = take(T * 3072 * 2);
    p.oO = take(T * 1024 * 2);
    p.oBO = take(T * 2048);
    p.oMG = take(T * 2048);
    long long end_main = o;
    p.oRWW = p.oBO;
    p.oRWX = p.oRWW + T * 1024;
    p.oGA = p.oRWX + T * 2560;
    p.oCQ = p.oP; p.oCAO = p.oP + T * 512;
    p.oRSA = p.oR2T; p.oRSB = p.oROWW;
    p.oCCNT = p.oKCMP; p.oCOFF = p.oVCMP;
    p.oMEMN = p.oBO;
    p.oACT = p.oP;
    long long q = p.oP;
    p.oMOEW = q; q = al256(q + 8LL * 3 * 1024 * DFF * 2);
    const long long ntmax = p.NR / 256, ct = ntmax >= 512 ? 256 : (ntmax + 2) / 3;
    p.oACTC = q; q = al256(q + ct * 256 * DFF * 2);
    p.oY = q; q = al256(q + p.NR * 2048);
    p.oHS = 0;
    p.wsNeed = q > end_main ? q : end_main;
}
#define WSP(T_, off) ((T_*)(p.ws + (off)))

DEVI void cvt_tile8(bf16_t* dst, long long K, const float* src0, long long ld, const float* gk = nullptr, float sc = 1.0f) {
    float v[8][8];
#pragma unroll
    for (int kk = 0; kk < 8; ++kk) { const float gg = (gk ? gk[kk] : 1.0f) * sc;
#pragma unroll
        for (int nn = 0; nn < 8; ++nn) v[kk][nn] = src0[kk * ld + nn] * gg; }
#pragma unroll
    for (int nn = 0; nn < 8; ++nn) { float o[8];
#pragma unroll
        for (int kk = 0; kk < 8; ++kk) o[kk] = v[kk][nn];
        st8(dst + nn * K, o); }
}
DEVI void cvt_T(bf16_t* dst, const float* src, long long K, long long N, long long Npad, long long ld, long long gtid, long long gsz, const float* gain = nullptr) {
    (void)Npad; const long long tk = K >> 6, tiles = (N >> 6) * tk;
    for (long long i = gtid; i < tiles * 64; i += gsz) { const long long tile = i >> 6; const int li = (int)(i & 63), kl = li >> 3, nl = li & 7; const long long n0 = (tile / tk) * 64 + 8 * nl, k0 = (tile % tk) * 64 + 8 * kl;
        cvt_tile8(dst + n0 * K + k0, K, src + k0 * ld + n0, ld, gain ? gain + k0 : nullptr); }
}
DEVI void cvt_gate(bf16_t* dst, const float* wg, long long gtid, long long gsz, const float* gain = nullptr) {
    const long long tiles = (4096 >> 6) * 16;
    for (long long i = gtid; i < tiles * 64; i += gsz) { const long long tile = i >> 6; const int li = (int)(i & 63), kl = li >> 3, nl = li & 7; const long long n0 = (tile >> 4) * 64 + 8 * nl, k0 = (tile & 15) * 64 + 8 * kl;
        const long long q = n0 >> 8; const int w = (int)(n0 & 255), bj = w >> 7, c8 = w & 127; const float* sa = wg + (long long)(2 * bj) * 1024 * 1024 + k0 * 1024 + 64 * q + (c8 >> 1); const float* sb = sa + 1024 * 1024;
        float v[8][8];
#pragma unroll
        for (int kk = 0; kk < 8; ++kk) { const float gg = gain ? gain[k0 + kk] : 1.0f;
#pragma unroll
            for (int nn = 0; nn < 4; ++nn) { v[kk][nn] = sa[kk * 1024 + nn] * gg; v[kk][4 + nn] = sb[kk * 1024 + nn] * gg; } }
#pragma unroll
        for (int nn = 0; nn < 8; ++nn) { float o[8];
#pragma unroll
            for (int kk = 0; kk < 8; ++kk) o[kk] = v[kk][nn];
            st8(dst + (n0 + nn) * 1024 + k0, o); } }
}
DEVI void cvt_GU(bf16_t* dst, const float* wg, const float* wu, long long DFF, long long gtid, long long gsz, const float* gain = nullptr) {
    const long long tiles = (2 * DFF >> 6) * 16;
    for (long long i = gtid; i < tiles * 64; i += gsz) { const long long tile = i >> 6; const int li = (int)(i & 63), kl = li >> 3, nl = li & 7; const long long rr0 = (tile >> 4) * 64 + 8 * nl, k0 = (tile & 15) * 64 + 8 * kl;
        const long long t = rr0 >> 8, w = rr0 & 255; const float* src = (w < 128 ? wg : wu) + k0 * DFF + t * 128 + (w & 127);
        cvt_tile8(dst + rr0 * 1024 + k0, 1024, src, DFF, gain ? gain + k0 : nullptr); }
}
DEVI long long rot_gtid(long long gtid, long long gsz, long long& off, long long n) { long long r = gtid - off % gsz; if (r < 0) r += gsz; off += n; return r; }
DEVI void ph_convert_layer(const Params& p, int l, long long gtid, long long gsz, long long& off) {
    bf16_t* W = WSP(bf16_t, p.oWL[l]);
    for (long long i = rot_gtid(gtid, gsz, off, 48LL * 16 * 64); i < 48LL * 16 * 64; i += gsz) { const long long tile = i >> 6; const int li = (int)(i & 63), kl = li >> 3, nl = li & 7; const long long n0 = (tile >> 4) * 64 + 8 * nl, k0 = (tile & 15) * 64 + 8 * kl;
        const float* gk = l == 1 ? p.in[I_NORM_MIX] + 1024 + k0 : nullptr; const float* wsrc = p.in[I_W_IN] + ((long long)l * 1024 + k0) * INW;
        if (n0 + 8 <= 1036) cvt_tile8(W + W_IN + n0 * 1024 + k0, 1024, wsrc + n0, INW, gk, n0 < C_Q + 256 ? QSCALE : 1.0f);
        else if (n0 >= C_POOL && n0 + 8 <= C_VRES) cvt_tile8(W + W_IN + n0 * 1024 + k0, 1024, wsrc + n0 - 4, INW, gk);
        else {
#pragma unroll
            for (int nn = 0; nn < 8; ++nn) { const long long n = n0 + nn; float o[8];
#pragma unroll
                for (int kk = 0; kk < 8; ++kk) { const long long k = k0 + kk; float v = 0.f;
                    if (n < 1036) v = p.in[I_W_IN][((long long)l * 1024 + k) * INW + n];
                    else if (n >= C_POOL && n < C_VRES) v = p.in[I_W_IN][((long long)l * 1024 + k) * INW + n - 4];
                    else if (n >= C_VRES && n < C_VRES + 32 && l == 1) v = p.in[I_RW_V1][k * 32 + (n - C_VRES)];
                    o[kk] = l == 1 ? v * p.in[I_NORM_MIX][1024 + k] : v; }
                st8(W + W_IN + n * 1024 + k0, o); } } }
    cvt_gate(W + W_G, p.in[I_W_GATE] + (long long)l * 4 * 1024 * 1024, rot_gtid(gtid, gsz, off, 65536), gsz, l == 1 ? p.in[I_NORM_MIX] + 1024 : nullptr);
    for (int i = 0; i < 4; ++i) cvt_T(W + W_B + (long long)i * 1024 * 256, p.in[I_W_BRANCH] + ((long long)l * 4 + i) * 256 * 1024, 256, 1024, 1024, 1024, rot_gtid(gtid, gsz, off, 4096), gsz);
    cvt_T(W + W_O, p.in[I_W_OUT] + (long long)l * 1024 * 1024, 1024, 1024, 1024, 1024, rot_gtid(gtid, gsz, off, 16384), gsz);
    cvt_T(W + W_CQ, p.in[I_CA_Q] + (long long)l * 1024 * 256, 1024, 256, 256, 256, rot_gtid(gtid, gsz, off, 4096), gsz, p.in[I_NORM_CA] + l * 1024);
    cvt_T(WSP(bf16_t, p.oWKV) + (long long)l * 512 * 1024, p.in[I_CA_KV] + (long long)l * 1024 * 512, 1024, 512, 512, 512, rot_gtid(gtid, gsz, off, 8192), gsz);
    cvt_T(W + W_CO, p.in[I_CA_O] + (long long)l * 256 * 1024, 256, 1024, 1024, 1024, rot_gtid(gtid, gsz, off, 4096), gsz);
}
DEVI void ph_convert_ffn(const Params& p, long long gtid, long long gsz, long long& off) {
    bf16_t* W = WSP(bf16_t, p.oWFFN);
    cvt_GU(W, p.in[I_FFN_G], p.in[I_FFN_U], p.DFF, rot_gtid(gtid, gsz, off, (2 * p.DFF >> 6) * 16 * 64), gsz, p.in[I_NORM_FFN]);
    cvt_T(W + 2 * p.DFF * 1024, p.in[I_FFN_D], p.DFF, 1024, 1024, 1024, rot_gtid(gtid, gsz, off, (p.DFF >> 6) * 16 * 64), gsz);
}
DEVI void ph_convert_moe(const Params& p, long long gtid, long long gsz) {
    const long long DFF = p.DFF, per = 3 * 1024 * DFF;
    long long off = 0;
    for (int e = 0; e < 8; ++e) { bf16_t* W = WSP(bf16_t, p.oMOEW) + e * per;
        cvt_GU(W, p.in[I_MOE_G] + (long long)e * 1024 * DFF, p.in[I_MOE_U] + (long long)e * 1024 * DFF, DFF, rot_gtid(gtid, gsz, off, (2 * DFF >> 6) * 16 * 64), gsz);
        cvt_T(W + 2 * DFF * 1024, p.in[I_MOE_D] + (long long)e * DFF * 1024, DFF, 1024, 1024, 1024, rot_gtid(gtid, gsz, off, (DFF >> 6) * 16 * 64), gsz); }
}
DEVI void ph_rope(const Params& p, long long gtid, long long gsz) {
    const int* pos = (const int*)p.in[I_POS]; float* R = WSP(float, p.oROPE);
    for (long long i = gtid; i < p.T * 8; i += gsz) { const long long t = i >> 3; const int j = (int)(i & 7);
        const float ang = (float)pos[t] * p.inv_freq[j];
        double a = (double)ang; a -= 6.283185307179586476925 * floor(a * 0.15915494309189533577 + 0.5);
        const float ar = (float)a; R[t * 16 + j] = cosf(ar); R[t * 16 + 8 + j] = sinf(ar); }
}
DEVI void ph_rope_apply(const Params& p, long long gtid, long long gsz) {
    bf16_t* P = WSP(bf16_t, p.oP); const float* R = WSP(float, p.oROPE);
    for (long long i = gtid; i < p.T * 8; i += gsz) { const long long t = i >> 3; const int w = (int)(i & 7);
        const int col = w < 4 ? C_Q + w * 64 : (w < 6 ? C_KS + (w - 4) * 64 : C_KW + (w - 6) * 64);
        bf16_t* x = P + t * PW + col; const float* r = R + t * 16;
        float a[8], b[8], c[8], s[8], o1[8], o2[8]; ld8(x, a); ld8(x + 8, b);
#pragma unroll
        for (int j = 0; j < 8; ++j) { c[j] = r[j]; s[j] = r[8 + j]; }
#pragma unroll
        for (int j = 0; j < 8; ++j) { o1[j] = a[j] * c[j] - b[j] * s[j]; o2[j] = b[j] * c[j] + a[j] * s[j]; }
        st8(x, o1); st8(x + 8, o2); }
}
DEVI void ph_compress2(const Params& p, int l, long long gtid, long long gsz) {
    const bf16_t* UV = WSP(bf16_t, p.oUV); const float* CB = WSP(float, p.oCB) + l * 256; const float* w2 = p.in[I_CMP_W2] + (long long)l * 2 * 128 * 64; const float* R = WSP(float, p.oROPE);
    bf16_t* KC = WSP(bf16_t, p.oKCMP); bf16_t* VC = WSP(bf16_t, p.oVCMP);
    const long long n_items = p.B * p.NC * 2 * 2 * 8, hb = p.S / 16;
    for (long long i = gtid; i < p.B * 2 * (128 - p.NC) * 64; i += gsz) { const long long bgi = i / ((128 - p.NC) * 64), rem = i % ((128 - p.NC) * 64); KC[(bgi * 128 + p.NC) * 64 + rem] = 0; VC[(bgi * 128 + p.NC) * 64 + rem] = 0; }
    for (long long i = gtid; i < n_items; i += gsz) { const int d8 = (int)(i & 7), j = (int)((i >> 3) & 1), g = (int)((i >> 4) & 1); const long long bn = i >> 5, n = bn % p.NC, b = bn / p.NC;
        const bf16_t* u = UV + ((b * hb + n) * 4 + (2 * j + g)) * 256; const bf16_t* vv = u + 4 * 256 + 128; const float* w = w2 + (long long)j * 128 * 64; const float* cb = CB + j * 128;
        float a[8];
#pragma unroll
        for (int m = 0; m < 8; ++m) a[m] = 0.f;
        for (int f = 0; f < 128; ++f) { const float hv = gelu_tanhf_(bf2f(u[f]) + bf2f(vv[f]) + cb[f]);
#pragma unroll
            for (int m = 0; m < 8; ++m) a[m] += hv * w[f * 64 + d8 + 8 * m]; }
        if (j == 0) { const float* r = R + (b * p.S + n * 16 + 31) * 16; const float x0 = a[0], x1 = a[1], cs = r[d8], sn = r[8 + d8]; a[0] = x0 * cs - x1 * sn; a[1] = x1 * cs + x0 * sn; }
        bf16_t* dst = (j == 0 ? KC : VC) + (((b * 2 + g) * 128) + n) * 64;
#pragma unroll
        for (int m = 0; m < 8; ++m) dst[d8 + 8 * m] = f2bf(a[m]); }
}
#ifndef CPU_EMU
DEVI float wave_sum(float v);
#endif
DEVI void ph_convert_cmp(const Params& p, long long gtid, long long gsz) {
    bf16_t* W1T = WSP(bf16_t, p.oW1T); float* CB = WSP(float, p.oCB);
#pragma unroll 8
    for (long long i = gtid; i < 2LL * 2 * 256 * 1024; i += gsz) { const int k = (int)(i & 1023), n = (int)((i >> 10) & 255); const long long lj = i >> 18; const int half = n >> 7, f = n & 127, tap = k >> 6, d = k & 63;
        W1T[i] = f2bf(p.in[I_CMP_W1][((lj * 32 + half * 16 + tap) * 64 + d) * 128 + f]); }
#ifdef CPU_EMU
    for (long long i = gtid; i < 2 * 2 * 128; i += gsz) { const int f = (int)(i & 127); const long long lj = i >> 7; float a = 0.f;
        for (int k = 0; k < 2048; ++k) a += p.in[I_CMP_PE][lj * 2048 + k] * p.in[I_CMP_W1][(lj * 2048 + k) * 128 + f];
        CB[i] = a; }
#else
    {   const long long gw_ = gtid >> 6, nw_ = gsz >> 6; const int ln = (int)(gtid & 63);
        for (long long i = gw_; i < 2 * 2 * 128; i += nw_) { const int f = (int)(i & 127); const long long lj = i >> 7; float a = 0.f;
#pragma unroll 8
            for (int k = ln; k < 2048; k += 64) a += p.in[I_CMP_PE][lj * 2048 + k] * p.in[I_CMP_W1][(lj * 2048 + k) * 128 + f];
            a = wave_sum(a); if (ln == 0) CB[i] = a; } }
#endif
}
DEVI void pool_fill_w(const Params& p, int l, LDSQ float* wl, int tid, int nthr) { const float* pw = p.in[I_POOL_W] + (long long)l * 4 * 64 * 64; for (int i = tid; i < 4 * 64 * 64; i += nthr) wl[i] = pw[i]; }
template <int WIN> DEVI void pool_item(const Params& p, int l, const LDSQ float* wl, int g, long long t, int hf) {
    const bf16_t* P = WSP(bf16_t, p.oP); bf16_t* O = WSP(bf16_t, p.oO);
    const LDSQ float* w = wl + g * 64 * 64 + hf * 32; const float* ps = p.in[I_POOL_SCALE] + (long long)l * 256 + g * 64 + hf * 32;
    const long long s = t % p.S; const int cnt = (int)(s + 1 < WIN ? s + 1 : WIN); const float inv = 1.0f / (float)cnt;
    float a[32];
#pragma unroll
    for (int d = 0; d < 32; ++d) a[d] = 0.f;
#pragma nounroll
    for (int c8 = 0; c8 < 8; ++c8) { float dv[8], f0[8];
        ld8(P + t * PW + C_POOL + g * 64 + 8 * c8, f0);
#pragma unroll
        for (int j = 0; j < 8; ++j) dv[j] = f0[j];
#pragma unroll
        for (int k = 1; k < WIN; ++k) { float f[8];
            if (k < cnt) ld8(P + (t - k) * PW + C_POOL + g * 64 + 8 * c8, f); else {
#pragma unroll
                for (int j = 0; j < 8; ++j) f[j] = 0.f; }
#pragma unroll
            for (int j = 0; j < 8; ++j) dv[j] += f[j]; }
#pragma unroll
        for (int j = 0; j < 8; ++j) { const float x = dv[j] * inv - f0[j]; const LDSQ float* wr = w + (8 * c8 + j) * 64;
#pragma unroll
            for (int d = 0; d < 32; ++d) a[d] += x * wr[d];
            if (j & 1) SCHED_FENCE(); } }
#pragma unroll
    for (int d8 = 0; d8 < 4; ++d8) { float o[8];
#pragma unroll
        for (int j = 0; j < 8; ++j) o[j] = a[8 * d8 + j] * ps[8 * d8 + j];
        st8(O + t * 1024 + 256 + g * 64 + hf * 32 + 8 * d8, o); }
}
DEVI void ph_pool(const Params& p, int l, const LDSQ float* wl, long long gtid, long long gsz) {
    for (long long i = gtid; i < p.T * 8; i += gsz) { const int g = (int)(i / (p.T * 2)); const long long rem = i % (p.T * 2), t = rem >> 1; const int hf = (int)(rem & 1);
        if (g == 0) pool_item<2>(p, l, wl, 0, t, hf); else if (g == 1) pool_item<4>(p, l, wl, 1, t, hf); else if (g == 2) pool_item<8>(p, l, wl, 2, t, hf); else pool_item<16>(p, l, wl, 3, t, hf); }
}
DEVI void st16bf(bf16_t* dst, const float (&v)[16]) { st8(dst, v); st8(dst + 8, v + 8); }
DEVI float pick8v(float a0, float a1, float a2, float a3, float a4, float a5, float a6, float a7, int i) {
    float r = a0; r = (i == 1) ? a1 : r; r = (i == 2) ? a2 : r; r = (i == 3) ? a3 : r; r = (i == 4) ? a4 : r; r = (i == 5) ? a5 : r; r = (i == 6) ? a6 : r; r = (i == 7) ? a7 : r; return r; }
#define pick8(a, i) pick8v((a)[0], (a)[1], (a)[2], (a)[3], (a)[4], (a)[5], (a)[6], (a)[7], (i))
DEVI void lerp8(const bf16_t* x, const bf16_t* xp, const float* mu, bool first, float* out) {
    float a[8], b[8]; ld8(x, a);
    if (first) {
#pragma unroll
        for (int j = 0; j < 8; ++j) b[j] = 0.f; } else ld8(xp, b);
#pragma unroll
    for (int j = 0; j < 8; ++j) out[j] = a[j] + (b[j] - a[j]) * mu[j];
}
DEVI float rwkv_wrow(const Params& p, int l, int r, int c) {
    if (r < 32) return p.in[I_RW_W2][l * 32 * 256 + r * 256 + c]; if (r < 64) return p.in[I_RW_A2][l * 32 * 256 + (r - 32) * 256 + c];
    if (r < 96) return (l == 1) ? p.in[I_RW_V2][(r - 64) * 256 + c] : 0.f; return p.in[I_RW_G2][l * 64 * 256 + (r - 96) * 256 + c]; }
DEVI void rwkv_fill_wl(const Params& p, int l, LDSQ unsigned* wl, int tid, int nthr) {
    for (int i = tid; i < 80 * 256; i += nthr) { const int jp = i >> 8, c = i & 255; wl[i] = (unsigned)f2bf(rwkv_wrow(p, l, 2 * jp, c)) | ((unsigned)f2bf(rwkv_wrow(p, l, 2 * jp + 1, c)) << 16); }
}
DEVI float rwkv_feat(const Params& p, int l, long long t, int j) {
    const bf16_t* P = WSP(bf16_t, p.oP); const float* mu = p.in[I_RW_MU] + l * 896; const bool first = (t % p.S) == 0; const bf16_t* x = P + t * PW + C_RW; const bf16_t* xp = x - PW;
    if (j >= 64 && j < 96) return (l == 1) ? bf2f(P[t * PW + C_VRES + (j - 64)]) : 0.f;
    const int c = j < 32 ? 768 + j : (j < 64 ? 800 + (j - 32) : 832 + (j - 96)); const float a = bf2f(x[c]), bb = first ? 0.f : bf2f(xp[c]); const float lv = a + (bb - a) * mu[c];
    return j < 32 ? tanhf_(lv) : (j < 64 ? lv : sigmoidf_(lv));
}
DEVI void rwkv_prep_step1(const Params& p, int l, LDSQ unsigned* FP, LDSQ float* KN, long long tile, int tid) {
    const bf16_t* P = WSP(bf16_t, p.oP); const float* mu = p.in[I_RW_MU] + l * 896; const float* kkw = p.in[I_RW_KK] + l * 256;
    for (int idx = tid; idx < 32 * 80; idx += 512) { const int tt = idx / 80, jp = idx % 80; const long long t = tile * 32 + tt;
        FP[idx] = pk2bf(rwkv_feat(p, l, t, 2 * jp), rwkv_feat(p, l, t, 2 * jp + 1)); }
    if (tid < 128) { const int tt = tid >> 2, h = tid & 3; const long long t = tile * 32 + tt; const bool first = (t % p.S) == 0; const bf16_t* x = P + t * PW + C_RW; const bf16_t* xp = x - PW; float nn = 0.f;
#pragma unroll 4
        for (int q8 = 0; q8 < 8; ++q8) { float kq[8]; lerp8(x + 256 + h * 64 + 8 * q8, xp + 256 + h * 64 + 8 * q8, mu + 256 + h * 64 + 8 * q8, first, kq);
#pragma unroll
            for (int j = 0; j < 8; ++j) { const float e = kq[j] * kkw[h * 64 + 8 * q8 + j]; nn += e * e; } }
        KN[tid] = 1.0f / fmaxf(sqrtf(nn), 1e-12f); }
}
#ifndef CPU_EMU
DEVI void rwkv_fill_wl_gpu(const Params& p, int l, LDSQ unsigned* wl, int tid) {
    asm volatile("" : "+v"(tid));
    const float* w2 = p.in[I_RW_W2] + l * 32 * 256; const float* a2 = p.in[I_RW_A2] + l * 32 * 256; const float* v2 = p.in[I_RW_V2]; const float* g2 = p.in[I_RW_G2] + l * 64 * 256; const int c = tid & 255, j0 = tid >> 8;
#pragma nounroll
    for (int k0 = 0; k0 < 40; k0 += 8) { float lo[8], hi[8];
#pragma unroll
        for (int k = 0; k < 8; ++k) { const int jp = 2 * (k0 + k) + j0, r = 2 * jp; const bool zero = (r >= 64 && r < 96 && l == 0);
            const float* src = r < 32 ? w2 + r * 256 : (r < 64 ? a2 + (r - 32) * 256 : (r < 96 ? (zero ? w2 : v2 + (r - 64) * 256) : g2 + (r - 96) * 256));
            const float x0 = src[c], x1 = src[256 + c]; lo[k] = zero ? 0.f : x0; hi[k] = zero ? 0.f : x1; }
#pragma unroll
        for (int k = 0; k < 8; ++k) wl[(2 * (k0 + k) + j0) * 256 + c] = pk2bf(lo[k], hi[k]); }
}
DEVI void rwkv_prep_step1_gpu(const Params& p, int l, LDSQ unsigned* FP, LDSQ float* KN, long long tile, int tid) {
    const bf16_t* P = WSP(bf16_t, p.oP); const float* mu = p.in[I_RW_MU] + l * 896; const float* kkw = p.in[I_RW_KK] + l * 256;
    asm volatile("" : "+v"(tid));
    const bool tile_first = ((int)(tile * 32) % (int)p.S) == 0;
    unsigned av[5], bv[5]; float m0[5], m1[5];
#pragma unroll
    for (int it = 0; it < 5; ++it) { const int idx = tid + 512 * it, tt = idx / 80, j = 2 * (idx % 80); const long long t = tile * 32 + tt; const bool first = tile_first && tt == 0, vres = (j >= 64 && j < 96);
        const int c = j < 32 ? 768 + j : (j < 64 ? 800 + (j - 32) : (j < 96 ? 768 : 832 + (j - 96)));
        const bf16_t* pa = vres ? P + t * PW + C_VRES + (j - 64) : P + t * PW + C_RW + c; const bf16_t* pb = (first || vres) ? pa : pa - PW;
        av[it] = *(const unsigned*)pa; bv[it] = *(const unsigned*)pb; m0[it] = mu[c]; m1[it] = mu[c + 1]; }
#pragma unroll
    for (int it = 0; it < 5; ++it) { const int idx = tid + 512 * it, tt = idx / 80, j = 2 * (idx % 80); const bool first = tile_first && tt == 0, vres = (j >= 64 && j < 96);
        const float a0 = u2f(av[it] << 16), a1 = u2f(av[it] & 0xffff0000u), b0 = first ? 0.f : u2f(bv[it] << 16), b1 = first ? 0.f : u2f(bv[it] & 0xffff0000u);
        const float l0 = a0 + (b0 - a0) * m0[it], l1 = a1 + (b1 - a1) * m1[it];
        float o0, o1;
        if (vres) { o0 = (l == 1) ? a0 : 0.f; o1 = (l == 1) ? a1 : 0.f; } else if (j < 32) { o0 = tanhf_(l0); o1 = tanhf_(l1); } else if (j < 64) { o0 = l0; o1 = l1; } else { o0 = sigmoidf_(l0); o1 = sigmoidf_(l1); }
        FP[idx] = pk2bf(o0, o1); }
    if (tid < 128) { const int tt = tid >> 2, h = tid & 3; const long long t = tile * 32 + tt; const bool first = tile_first && tt == 0; const bf16_t* x = P + t * PW + C_RW; const bf16_t* xp = x - PW; float nn = 0.f;
#pragma unroll 4
        for (int q8 = 0; q8 < 8; ++q8) { float kq[8]; lerp8(x + 256 + h * 64 + 8 * q8, xp + 256 + h * 64 + 8 * q8, mu + 256 + h * 64 + 8 * q8, first, kq);
#pragma unroll
            for (int jj = 0; jj < 8; ++jj) { const float e = kq[jj] * kkw[h * 64 + 8 * q8 + jj]; nn += e * e; } }
        KN[tid] = 1.0f / fmaxf(sqrtf(nn), 1e-12f); }
}
#endif
DEVI void ld4u(const LDSQ unsigned* src, unsigned* v) {
#ifdef CPU_EMU
    v[0] = src[0]; v[1] = src[1]; v[2] = src[2]; v[3] = src[3];
#else
    const u32x4l_t w = *(const LDSQ u32x4l_t*)src; v[0] = w[0]; v[1] = w[1]; v[2] = w[2]; v[3] = w[3];
#endif
}
DEVI void rwkv_prep_step2(const Params& p, int l, const LDSQ unsigned* wl, const LDSQ unsigned* FP, const LDSQ float* KN, long long tile, int tid, const LDSQ float* Z = nullptr) {
    const bf16_t* P = WSP(bf16_t, p.oP); float* RWW = WSP(float, p.oRWW); bf16_t* RWX = WSP(bf16_t, p.oRWX); bf16_t* O = WSP(bf16_t, p.oO); bf16_t* VF = WSP(bf16_t, p.oVF);
    const float* mu = p.in[I_RW_MU] + l * 896; const float* w0 = p.in[I_RW_W0] + l * 256; const float* a0 = p.in[I_RW_A0] + l * 256;
    const float* kkw = p.in[I_RW_KK] + l * 256; const float* kaw = p.in[I_RW_KA] + l * 256; const float* v0 = p.in[I_RW_V0];
    const int tt = tid >> 4, h = (tid >> 2) & 3, cc = tid & 3; const long long t = tile * 32 + tt; const bool first = ((int)t % (int)p.S) == 0;
    const bf16_t* x = P + t * PW + C_RW; const bf16_t* xp = x - PW; const int c0 = h * 64 + cc * 16; const LDSQ unsigned* f = FP + tt * 80;
    const float rn = KN[tt * 4 + h];
    float zw[16], za[16], zg[16], zv[16];
#pragma unroll
    for (int u = 0; u < 16; ++u) { zw[u] = w0[c0 + u]; za[u] = a0[c0 + u]; zg[u] = 0.f; zv[u] = (l == 1) ? v0[c0 + u] : 0.f; }
#ifndef CPU_EMU
    (void)wl; (void)f;
#pragma unroll
    for (int q4 = 0; q4 < 4; ++q4) { const f32x4l_t a_ = *(const LDSQ f32x4l_t*)(Z + (0 * 32 + tt) * 256 + c0 + 4 * q4), b_ = *(const LDSQ f32x4l_t*)(Z + (1 * 32 + tt) * 256 + c0 + 4 * q4), d_ = *(const LDSQ f32x4l_t*)(Z + (3 * 32 + tt) * 256 + c0 + 4 * q4);
#pragma unroll
        for (int u = 0; u < 4; ++u) { zw[4 * q4 + u] += a_[u]; za[4 * q4 + u] += b_[u]; zg[4 * q4 + u] += d_[u]; }
        if (l == 1) { const f32x4l_t c_ = *(const LDSQ f32x4l_t*)(Z + (2 * 32 + tt) * 256 + c0 + 4 * q4);
#pragma unroll
            for (int u = 0; u < 4; ++u) zv[4 * q4 + u] += c_[u]; } }
#else
#pragma unroll 2
    for (int jp = 0; jp < 16; ++jp) { const unsigned fw = f[jp], fa = f[16 + jp], fv = f[32 + jp]; unsigned ww[16], wa[16], wv[16];
#pragma unroll
        for (int q4 = 0; q4 < 4; ++q4) { ld4u(wl + jp * 256 + c0 + 4 * q4, ww + 4 * q4); ld4u(wl + (16 + jp) * 256 + c0 + 4 * q4, wa + 4 * q4); if (l == 1) ld4u(wl + (32 + jp) * 256 + c0 + 4 * q4, wv + 4 * q4); }
#pragma unroll
        for (int u = 0; u < 16; ++u) { zw[u] = dot2bf(fw, ww[u], zw[u]); za[u] = dot2bf(fa, wa[u], za[u]); if (l == 1) zv[u] = dot2bf(fv, wv[u], zv[u]); } }
#pragma unroll 4
    for (int jp = 0; jp < 32; ++jp) { const unsigned fg = f[48 + jp]; unsigned wg[16];
#pragma unroll
        for (int q4 = 0; q4 < 4; ++q4) ld4u(wl + (48 + jp) * 256 + c0 + 4 * q4, wg + 4 * q4);
#pragma unroll
        for (int u = 0; u < 16; ++u) zg[u] = dot2bf(fg, wg[u], zg[u]); }
#endif
    st16bf(O + t * 1024 + 512 + c0, zg);
#pragma unroll
    for (int hf = 0; hf < 2; ++hf) { const int cb = c0 + 8 * hf; float r8[8], k8[8], v8[8], vf8[8], kk8[8], b8[8], d8[8];
        lerp8(x + cb, xp + cb, mu + cb, first, r8); lerp8(x + 256 + cb, xp + 256 + cb, mu + 256 + cb, first, k8); lerp8(x + 512 + cb, xp + 512 + cb, mu + 512 + cb, first, v8);
        if (l == 1) ld8(VF + t * 256 + cb, vf8);
#pragma unroll
        for (int u = 0; u < 8; ++u) { const int c = cb + u, uu = 8 * hf + u;
            const float wlog = -softplusf_(-zw[uu]) - 0.5f, dec = expf_(-expf_(wlog)), a = sigmoidf_(za[uu]);
            const float k = k8[u]; float v = v8[u];
            if (l == 1) v = v + (vf8[u] - v) * sigmoidf_(zv[uu]);
            const float kk = k * kkw[c] * rn;
            d8[u] = dec; k8[u] = k * (1.0f + (a - 1.0f) * kaw[c]); v8[u] = v; kk8[u] = kk; b8[u] = kk * a; }
        float* ww = RWW + t * 256 + cb;
#pragma unroll
        for (int u = 0; u < 8; ++u) ww[u] = d8[u];
        bf16_t* rx = RWX + t * 1280 + cb;
        st8(rx, r8); st8(rx + 256, k8); st8(rx + 512, v8); st8(rx + 768, kk8); st8(rx + 1024, b8);
        if (l == 0) st8(VF + t * 256 + cb, v8);
        SCHED_FENCE(); }
}
DEVI float rwkv_row_step(float (&st)[64], const float* w, const bf16_t* r, const bf16_t* k, const bf16_t* kk, const bf16_t* b, float v) {
    float skk = 0.f;
#pragma unroll
    for (int c = 0; c < 64; ++c) skk += st[c] * bf2f(kk[c]);
    float y = 0.f;
#pragma unroll
    for (int c = 0; c < 64; ++c) { st[c] = st[c] * w[c] - skk * bf2f(b[c]) + v * bf2f(k[c]); y += st[c] * bf2f(r[c]); }
    return y;
}
DEVI void ph_gla_prep(const Params& p, int l, long long gtid, long long gsz) {
    const bf16_t* P = WSP(bf16_t, p.oP); float* GA = WSP(float, p.oGA); bf16_t* O = WSP(bf16_t, p.oO);
    const float* a2 = p.in[I_GLA_A2] + l * 16 * 128; const float* ab = p.in[I_GLA_AB] + l * 128;
    for (long long i = gtid; i < p.T * 16; i += gsz) { const long long t = i >> 4; const int c0 = (int)(i & 15) * 8; const bf16_t* ad = P + t * PW + C_GLA + 512;
        float adv[16], z[8]; ld8(ad, adv); ld8(ad + 8, adv + 8);
#pragma unroll
        for (int u = 0; u < 8; ++u) z[u] = ab[c0 + u];
#pragma unroll
        for (int j = 0; j < 16; ++j) {
#pragma unroll
            for (int u = 0; u < 8; ++u) z[u] += adv[j] * a2[j * 128 + c0 + u]; }
#pragma unroll
        for (int u = 0; u < 8; ++u) GA[t * 128 + c0 + u] = expf_(-softplusf_(-z[u]) * 0.0625f);
        const bf16_t* og = P + t * PW + C_GLA + 528 + 2 * c0; float g[16]; ld8(og, g); ld8(og + 8, g + 8);
#pragma unroll
        for (int u = 0; u < 16; ++u) g[u] = siluf_(g[u]);
        st8(O + t * 1024 + 768 + 2 * c0, g); st8(O + t * 1024 + 768 + 2 * c0 + 8, g + 8); }
}
DEVI float gla_col_step(float (&st)[32], const float* a, const bf16_t* q, const bf16_t* k, float v) {
    float o = 0.f;
#pragma unroll
    for (int c = 0; c < 32; ++c) { st[c] = st[c] * a[c] + bf2f(k[c]) * v; o += st[c] * bf2f(q[c]); }
    return o * 0.17677669529663687f;
}
DEVI void ph_cmp_attn(const Params& p, long long gtid, long long gsz) {
    const bf16_t* P = WSP(bf16_t, p.oP); const bf16_t* KCb = WSP(bf16_t, p.oKCMP); const bf16_t* VCb = WSP(bf16_t, p.oVCMP); unsigned* SELM = WSP(unsigned, p.oSELM); bf16_t* O = WSP(bf16_t, p.oO);
    static float KCf[128 * 64], VCf[128 * 64]; long long cached = -1;
    for (long long i = gtid; i < p.T * 2; i += gsz) { const long long t = i >> 1, b = t / p.S, s = t % p.S; const int g = (int)(i & 1);
        const int nv = s >= 31 ? (int)((s - 31) / 16 + 1) : 0;
        const int cur = (int)(s >> 6);
        if (cached != b * 2 + g) { cached = b * 2 + g; for (int e = 0; e < 128 * 64; ++e) { KCf[e] = bf2f(KCb[cached * 128 * 64 + e]); VCf[e] = bf2f(VCb[cached * 128 * 64 + e]); } }
        const float* kc = KCf; const float* vc = VCf;
        float q0[64], q1[64];
        { const bf16_t* q = P + t * PW + C_Q + (2 * g) * 64;
#pragma unroll
          for (int d = 0; d < 64; ++d) { q0[d] = bf2f(q[d]); q1[d] = bf2f(q[64 + d]); } }
        float m0 = -3e38f, m1 = -3e38f;
        for (int n = 0; n < nv; ++n) { const float* k = kc + n * 64; float s0 = 0.f, s1 = 0.f;
#pragma unroll
            for (int d = 0; d < 64; ++d) { s0 += q0[d] * k[d]; s1 += q1[d] * k[d]; }
            m0 = fmaxf(m0, s0); m1 = fmaxf(m1, s1); }
        float z0 = 0.f, z1 = 0.f;
        for (int n = 0; n < nv; ++n) { const float* k = kc + n * 64; float s0 = 0.f, s1 = 0.f;
#pragma unroll
            for (int d = 0; d < 64; ++d) { s0 += q0[d] * k[d]; s1 += q1[d] * k[d]; }
            z0 += expf(s0 - m0); z1 += expf(s1 - m1); }
        const float iz0 = nv ? 1.0f / z0 : 0.f, iz1 = nv ? 1.0f / z1 : 0.f;
        unsigned mask;
        if (cur < 8) mask = (2u << cur) - 1u;
        else {
            float tv0 = -3e38f, tv1 = -3e38f, tv2 = -3e38f, tv3 = -3e38f, tv4 = -3e38f; int ti0 = 0, ti1 = 0, ti2 = 0, ti3 = 0, ti4 = 0;
            float carry = 0.f;
            for (int j = 0; j <= cur - 2; ++j) { float imp = carry;
                for (int mm = 0; mm < 4; ++mm) { const int n = 4 * j + mm; float pn = 0.f;
                    if (n < nv) { const float* k = kc + n * 64; float s0 = 0.f, s1 = 0.f;
#pragma unroll
                        for (int d = 0; d < 64; ++d) { s0 += q0[d] * k[d]; s1 += q1[d] * k[d]; }
                        pn = expf(s0 - m0) * iz0 + expf(s1 - m1) * iz1; }
                    if (mm < 3) imp += pn; else { imp += 0.5f * pn; carry = 0.5f * pn; } }
                if (j >= 1) {
                    float v = imp; int id = j;
                    if (v > tv0) { float tf = tv0; tv0 = v; v = tf; int tt = ti0; ti0 = id; id = tt; }
                    if (v > tv1) { float tf = tv1; tv1 = v; v = tf; int tt = ti1; ti1 = id; id = tt; }
                    if (v > tv2) { float tf = tv2; tv2 = v; v = tf; int tt = ti2; ti2 = id; id = tt; }
                    if (v > tv3) { float tf = tv3; tv3 = v; v = tf; int tt = ti3; ti3 = id; id = tt; }
                    if (v > tv4) { tv4 = v; ti4 = id; } } }
            mask = 1u | (1u << cur) | (1u << (cur - 1)) | (1u << ti0) | (1u << ti1) | (1u << ti2) | (1u << ti3) | (1u << ti4);
        }
        SELM[i] = mask;
        for (int r = 0; r < 2; ++r) { const int hd = 2 * g + r; const float mr = r ? m1 : m0, izr = r ? iz1 : iz0;
            float o[64], qq[64];
            { const bf16_t* q = P + t * PW + C_Q + hd * 64;
#pragma unroll
              for (int d = 0; d < 64; ++d) { o[d] = 0.f; qq[d] = bf2f(q[d]); } }
            for (int n = 0; n < nv; ++n) { const float* k = kc + n * 64; const float* v = vc + n * 64; float sc = 0.f;
#pragma unroll
                for (int d = 0; d < 64; ++d) sc += qq[d] * k[d];
                const float pr = expf(sc - mr) * izr;
#pragma unroll
                for (int d = 0; d < 64; ++d) o[d] += pr * v[d]; }
            const float g0 = sigmoidf_(bf2f(P[t * PW + C_NG + hd * 3 + 0]));
#pragma unroll
            for (int d = 0; d < 64; ++d) O[t * 1024 + hd * 64 + d] = f2bf(g0 * o[d]); } }
}
DEVI void ph_selwin(const Params& p, long long gtid, long long gsz) {
    const bf16_t* P = WSP(bf16_t, p.oP); const unsigned* SELM = WSP(unsigned, p.oSELM); bf16_t* O = WSP(bf16_t, p.oO);
    for (long long i = gtid; i < p.T * 8; i += gsz) { const long long t = i >> 3, b = t / p.S, s = t % p.S; const int hd = (int)((i >> 1) & 3), g = hd >> 1, d0 = (int)(i & 1) * 32;
        unsigned qp[32]; float o[32];
        { const bf16_t* qq = P + t * PW + C_Q + hd * 64;
#pragma unroll
          for (int d = 0; d < 32; ++d) qp[d] = (unsigned)qq[2 * d] | ((unsigned)qq[2 * d + 1] << 16); }
        for (int pass = 0; pass < 2; ++pass) {
            const int ck = pass ? C_KW : C_KS, cv = pass ? C_VW : C_VS; const unsigned mask = SELM[t * 2 + g];
            float m = -3e38f, z = 0.f;
#pragma unroll
            for (int d = 0; d < 32; ++d) o[d] = 0.f;
            const long long lo = pass ? (s - 511 > 0 ? s - 511 : 0) : 0;
            for (long long kp = lo; kp <= s; ++kp) {
                if (!pass && !((mask >> (kp >> 6)) & 1u)) { kp |= 63; continue; }
                const bf16_t* k = P + (b * p.S + kp) * PW + ck + g * 64; const bf16_t* v = P + (b * p.S + kp) * PW + cv + g * 64 + d0; float sc = 0.f;
#pragma unroll
                for (int d = 0; d < 32; ++d) sc += u2f(qp[d] << 16) * bf2f(k[2 * d]) + u2f(qp[d] & 0xffff0000u) * bf2f(k[2 * d + 1]);
                if (sc > m) { const float f = expf(m - sc); z *= f;
#pragma unroll
                    for (int d = 0; d < 32; ++d) o[d] *= f;
                    m = sc; }
                const float pr = expf(sc - m); z += pr;
#pragma unroll
                for (int d = 0; d < 32; ++d) o[d] += pr * bf2f(v[d]); }
            const float gt = sigmoidf_(bf2f(P[t * PW + C_NG + hd * 3 + 1 + pass])) / z;
#pragma unroll
            for (int d = 0; d < 32; ++d) { bf16_t* od = O + t * 1024 + hd * 64 + d0 + d; *od = f2bf(bf2f(*od) + gt * o[d]); } } }
}
DEVI void ph_ca_attn(const Params& p, int l, long long gtid, long long gsz) {
    const bf16_t* CQ = WSP(bf16_t, p.oCQ); const bf16_t* KV = WSP(bf16_t, p.oKV) + (long long)l * 512; bf16_t* AO = WSP(bf16_t, p.oCAO);
    for (long long i = gtid; i < p.T * 4; i += gsz) { const long long t = i >> 2, b = t / p.S; const int hd = (int)(i & 3);
        float q[64], o[64];
#pragma unroll
        for (int d = 0; d < 64; ++d) { q[d] = bf2f(CQ[t * 256 + hd * 64 + d]); o[d] = 0.f; }
        float m = -3e38f, z = 0.f;
        for (int kp = 0; kp < 256; ++kp) { const bf16_t* k = KV + (b * 256 + kp) * 1024 + hd * 64; const bf16_t* v = k + 256; float sc = 0.f;
#pragma unroll
            for (int d = 0; d < 64; ++d) sc += q[d] * bf2f(k[d]);
            if (sc > m) { const float f = expf(m - sc); z *= f;
#pragma unroll
                for (int d = 0; d < 64; ++d) o[d] *= f;
                m = sc; }
            const float pr = expf(sc - m); z += pr;
#pragma unroll
            for (int d = 0; d < 64; ++d) o[d] += pr * bf2f(v[d]); }
        const float iz = 1.0f / z;
#pragma unroll
        for (int d = 0; d < 64; ++d) AO[t * 256 + hd * 64 + d] = f2bf(o[d] * iz); }
}
DEVI void moe_count_range(const Params& p, long long c0, long long nchunk, int tid, int nthr) {
    const int* TE = WSP(int, p.oTOKE); int* CC = WSP(int, p.oCCNT); int* CT = CC + (p.T / 64) * 64;
    for (long long c = c0 + tid; c < c0 + nchunk; c += nthr) { int tot[8] = {0, 0, 0, 0, 0, 0, 0, 0};
        for (int sub = 0; sub < 8; ++sub) { int cnt[8] = {0, 0, 0, 0, 0, 0, 0, 0};
#pragma unroll
            for (int j = 0; j < 16; ++j) { const int e = TE[c * 128 + sub * 16 + j];
#pragma unroll
                for (int q = 0; q < 8; ++q) cnt[q] += (e == q); }
#pragma unroll
            for (int q = 0; q < 8; ++q) { CC[(c * 8 + sub) * 8 + q] = cnt[q]; tot[q] += cnt[q]; } }
#pragma unroll
        for (int q = 0; q < 8; ++q) CT[c * 8 + q] = tot[q]; }
}
DEVI void ph_moe_count(const Params& p, long long gtid, long long gsz) {
    const int* TE = WSP(int, p.oTOKE); int* CC = WSP(int, p.oCCNT); int* CT = CC + (p.T / 64) * 64; int* R2T = WSP(int, p.oR2T);
    for (long long c = gtid; c < p.T / 64; c += gsz) { int tot[8] = {0, 0, 0, 0, 0, 0, 0, 0};
        for (int sub = 0; sub < 8; ++sub) { int cnt[8] = {0, 0, 0, 0, 0, 0, 0, 0};
#pragma unroll
            for (int j = 0; j < 16; ++j) { const int e = TE[c * 128 + sub * 16 + j];
#pragma unroll
                for (int q = 0; q < 8; ++q) cnt[q] += (e == q); }
#pragma unroll
            for (int q = 0; q < 8; ++q) { CC[(c * 8 + sub) * 8 + q] = cnt[q]; tot[q] += cnt[q]; } }
#pragma unroll
        for (int q = 0; q < 8; ++q) CT[c * 8 + q] = tot[q]; }
    for (long long i = gtid; i < p.NR; i += gsz) R2T[i] = -1;
}
DEVI void ph_moe_offsets(const Params& p, long long gw, long long nw, int lane) {
    const int* CC = WSP(int, p.oCCNT); const int* CT = CC + (p.T / 64) * 64; int* CO = WSP(int, p.oCOFF); int* MC = WSP(int, p.oMOEC);
    const long long n = p.T / 64;
    for (long long i = gw; i < n * 8; i += nw) { const long long c = i >> 3; const int e = (int)(i & 7); int off = 0;
#ifdef CPU_EMU
        (void)lane; for (long long k = 0; k < c; ++k) off += CT[k * 8 + e];
#else
        for (long long k = lane; k < c; k += 64) off += CT[k * 8 + e];
#pragma unroll
        for (int o = 32; o > 0; o >>= 1) off += __shfl_xor(off, o);
        if (lane == 0)
#endif
        {
#pragma unroll
            for (int sub = 0; sub < 8; ++sub) { CO[(c * 8 + sub) * 8 + e] = off; off += CC[(c * 8 + sub) * 8 + e]; }
            if (c == n - 1) MC[e] = off; } }
}
DEVI void moe_bases(const Params& p, int (&base)[9]) { const int* MC = WSP(int, p.oMOEC); int run = 0;
#pragma unroll
    for (int e = 0; e < 8; ++e) { base[e] = run; run += (MC[e] + 255) & ~255; } base[8] = run; }
DEVI void ph_moe_assign(const Params& p, long long gtid, long long gsz) {
    const int* TE = WSP(int, p.oTOKE); const float* TW = WSP(float, p.oTOKW); const int* CO = WSP(int, p.oCOFF); int* TS = WSP(int, p.oTOKS); int* R2T = WSP(int, p.oR2T); float* RW = WSP(float, p.oROWW);
    int base[9]; moe_bases(p, base);
    if (gtid == 0) { int* MC = WSP(int, p.oMOEC);
#pragma unroll
        for (int e = 0; e < 9; ++e) MC[16 + e] = base[e]; }
    for (long long i = gtid; i < (p.T / 64) * 8; i += gsz) { int run[8];
#pragma unroll
        for (int q = 0; q < 8; ++q) run[q] = base[q] + CO[i * 8 + q];
#pragma unroll
        for (int j = 0; j < 16; ++j) { const int e = TE[i * 16 + j]; int slot = 0;
#pragma unroll
            for (int q = 0; q < 8; ++q) if (e == q) { slot = run[q]; run[q] += 1; }
            TS[i * 16 + j] = slot; R2T[slot] = (int)(i * 8 + (j >> 1)); RW[slot] = TW[i * 16 + j]; } }
}
DEVI void ph_moe_gather(const Params& p, long long gtid, long long gsz) {
    const int* R2T = WSP(int, p.oR2T); const int* MC = WSP(int, p.oMOEC); const uint4* H = WSP(uint4, p.oH); uint4* HS = WSP(uint4, p.oHS);
    const long long rows = MC[16 + 8];
    for (long long i = gtid; i < rows * 128; i += gsz) { const long long r = i >> 7; const int j = (int)(i & 127); const int t = R2T[r];
        uint4 v; v.x = v.y = v.z = v.w = 0u; if (t >= 0) v = H[(long long)t * 128 + j]; HS[i] = v; }
}
struct Unit { int pm, pn, aux, pad; long long aoff, boff; };
constexpr int NXCD = 8, WGM = 8;
DEVI void tile_order(long long L, int nM, int nN, int& pm, int& pn) {
    const int nwg = nM * nN; int wgid = (int)L; { const int q = nwg / NXCD, r = nwg % NXCD, xcd = wgid % NXCD, off = wgid / NXCD; wgid = (xcd < r ? xcd * (q + 1) : r * (q + 1) + (xcd - r) * q) + off; }
    const int nig = WGM * nN, gid = wgid / nig, fm = gid * WGM, gsz = (nM - fm) < WGM ? (nM - fm) : WGM;
    pm = fm + ((wgid % nig) % gsz); pn = (wgid % nig) / gsz;
}
struct SchedPlain {
    int nM, nN, G, c; long long lda, ldb;
    DEVM void init(long long M, long long N, long long lda_, long long ldb_, int G_, int c_) { nM = (int)(M / 256); nN = (int)(N / 256); lda = lda_; ldb = ldb_; G = G_; c = c_; }
    DEVM bool next(int i, Unit& u) const { const long long L = (long long)i * G + c; if (L >= (long long)nM * nN) return false; tile_order(L, nM, nN, u.pm, u.pn); u.aux = 0; u.pad = 0;
        u.aoff = (long long)u.pm * 256 * lda * 2; u.boff = (long long)u.pn * 256 * ldb * 2; return true; }
    DEVM void a_ready(const Unit&) const {}
    DEVM void done(const Unit&) const {}
};
struct SchedBranch {
    int nM, G, c;
    DEVM void init(long long M, int G_, int c_) { nM = (int)(M / 256); G = G_; c = c_; }
    DEVM bool next(int i, Unit& u) const { const long long L = (long long)i * G + c; if (L >= (long long)nM * 16) return false; tile_order(L, nM, 16, u.pm, u.pn); u.aux = u.pn >> 2; u.pad = 0;
        u.aoff = (long long)u.pm * 256 * 1024 * 2 + (long long)u.aux * 256 * 2; u.boff = (long long)u.pn * 256 * 256 * 2; return true; }
    DEVM void a_ready(const Unit&) const {}
    DEVM void done(const Unit&) const {}
};
struct SchedGate {
    int nM, G, c;
    DEVM void init(long long M, int G_, int c_) { nM = (int)(M / 256); G = G_; c = c_; }
    DEVM bool next(int i, Unit& u) const { const long long tile = (long long)(i >> 2) * G + c; if (tile >= (long long)nM * 4) return false; tile_order(tile, nM, 4, u.pm, u.pn); u.aux = i & 3; u.pad = 0;
        u.aoff = (long long)u.pm * 256 * 1024 * 2; u.boff = (long long)(u.aux * 4 + u.pn) * 256 * 1024 * 2; return true; }
    DEVM void a_ready(const Unit&) const {}
    DEVM void done(const Unit&) const {}
};
struct SchedMoe {
    int t0, t1, nN, G, c; long long lda, ldb, per_e; const int* base;
    DEVM bool next(int i, Unit& u) const { const long long L = (long long)i * G + c; if (L >= (long long)(t1 - t0) * nN) return false; { int pr, pc; tile_order(L, t1 - t0, nN, pr, pc); u.pm = t0 + pr; u.pn = pc; } u.pad = 0;
        int e = 0;
#pragma unroll
        for (int q = 1; q < 8; ++q) e += (u.pm * 256 >= base[q]) ? 1 : 0;
#ifndef CPU_EMU
        e = __builtin_amdgcn_readfirstlane(e);
#endif
        u.aux = e; u.aoff = (long long)u.pm * 256 * lda * 2; u.boff = (long long)e * per_e + (long long)u.pn * 256 * ldb * 2; return true; }
    DEVM void a_ready(const Unit&) const {}
    DEVM void done(const Unit&) const {}
};
struct SchedCmp {
    int nM, G, c;
    DEVM void init(long long rows, int G_, int c_) { nM = (int)(rows / 256); G = G_; c = c_; }
    DEVM bool next(int i, Unit& u) const { const long long L = (long long)i * G + c; if (L >= (long long)nM * 4) return false; const int combo = (int)(L / nM); u.pm = (int)(L % nM); u.pn = 0; u.aux = combo; u.pad = 0;
        u.aoff = (long long)u.pm * 256 * 16 * PW * 2 + (long long)(((combo >> 1) ? C_VC : C_KC) + (combo & 1) * 64) * 2; u.boff = (long long)(combo >> 1) * 256 * 1024 * 2; return true; }
    DEVM void a_ready(const Unit&) const {}
    DEVM void done(const Unit&) const {}
};
#ifndef CPU_EMU
__device__ __forceinline__ int mk_lane_() { return (int)__builtin_amdgcn_mbcnt_hi(~0u, __builtin_amdgcn_mbcnt_lo(~0u, 0u)); }
#endif
struct PreNone {};
struct PreRow { float r; };
typedef unsigned long long rs_t;
#ifdef CPU_EMU
DEVI float rs_of(const rs_t* rss, long long row) { return rss ? 1.0f / sqrtf((float)((double)rss[row] * (1.0 / 16777216.0)) * (1.0f / 1024.0f) + 1e-6f) : 1.0f; }
#else
DEVI float rs_of(const rs_t* rss, long long row) { return rss ? __builtin_amdgcn_rsqf((float)((double)rss[row] * (1.0 / 16777216.0)) * (1.0f / 1024.0f) + 1e-6f) : 1.0f; }
#endif
struct EpStore {
    typedef PreRow Pre; static constexpr int ROWS = 2;
    bf16_t* O; long long ldo; float scale; const rs_t* rss; bf16_t* O2; long long split;
    DEVM void pre(const Unit&, long long row, int, Pre& pr) const { pr.r = rs_of(rss, row) * scale; }
    DEVM void apply(const Unit& u, long long row, int c8, const float* lo, const float* hi, const Pre& pr) const { float a[8], b[8];
#pragma unroll
        for (int j = 0; j < 8; ++j) { a[j] = lo[j] * pr.r; b[j] = hi[j] * pr.r; }
        bf16_t* d = ((O2 && row >= split) ? O2 + (row - split) * ldo : O + row * ldo) + u.pn * 256 + c8; st8(d, a); st8(d + 128, b); }
};
struct EpUV {
    typedef PreNone Pre; static constexpr int ROWS = 2;
    bf16_t* UV;
    DEVM void pre(const Unit&, long long, int, Pre&) const {}
    DEVM void apply(const Unit& u, long long row, int c8, const float* lo, const float* hi, const Pre&) const { bf16_t* d = UV + (row * 4 + u.aux) * 256 + c8; st8(d, lo); st8(d + 128, hi); }
};
struct PreGate { uint2 bo[4]; float r; };
DEVI void cvt8u(const uint4& w, float* v) { v[0] = u2f(w.x << 16); v[1] = u2f(w.x & 0xffff0000u); v[2] = u2f(w.y << 16); v[3] = u2f(w.y & 0xffff0000u); v[4] = u2f(w.z << 16); v[5] = u2f(w.z & 0xffff0000u); v[6] = u2f(w.w << 16); v[7] = u2f(w.w & 0xffff0000u); }
struct EpGate {
    typedef PreGate Pre; static constexpr int ROWS = 4;
    const bf16_t* BO; const float* bias; bf16_t* MG; long long row0; const rs_t* rss; const bf16_t* BO2; long long split;
    DEVM void pre(const Unit& u, long long row, int c8, Pre& pr) const { pr.r = rs_of(rss, row0 + row); const bf16_t* b = ((BO2 && row >= split) ? BO2 + (row - split) * 4096 : BO + row * 4096) + u.pn * 64 + (c8 >> 1);
#pragma unroll
        for (int i = 0; i < 4; ++i) pr.bo[i] = *(const uint2*)(b + i * 1024); }
    DEVM void apply(const Unit& u, long long row, int c8, const float* lo, const float* hi, const Pre& pr) const { const int c = u.pn * 64 + (c8 >> 1); float r[4] = {0.f, 0.f, 0.f, 0.f};
#pragma unroll
        for (int i = 0; i < 4; ++i) { const float* v = (i < 2 ? lo : hi) + 4 * (i & 1); const float* bi = bias + i * 1024 + c;
            const float bo[4] = {u2f(pr.bo[i].x << 16), u2f(pr.bo[i].x & 0xffff0000u), u2f(pr.bo[i].y << 16), u2f(pr.bo[i].y & 0xffff0000u)};
#pragma unroll
            for (int j = 0; j < 4; ++j) r[j] += sigmoidf_(v[j] * pr.r + bi[j]) * bo[j]; }
        uint2 w; w.x = pk2bf(r[0], r[1]); w.y = pk2bf(r[2], r[3]); *(uint2*)(MG + (row0 + row) * 1024 + c) = w; }
};
struct PreResid { float4 v[4]; };
struct EpResid {
    typedef PreResid Pre; static constexpr int ROWS = 2;
    const float* XS; const bf16_t* XB; bf16_t* HB; rs_t* RS;
    DEVM void pre(const Unit& u, long long row, int c8, Pre& pr) const {
        if (XS) { const float* x = XS + row * 1024 + u.pn * 256 + c8; pr.v[0] = *(const float4*)x; pr.v[1] = *(const float4*)(x + 4); pr.v[2] = *(const float4*)(x + 128); pr.v[3] = *(const float4*)(x + 132); }
        else { const bf16_t* x = XB + row * 1024 + u.pn * 256 + c8; const uint4 a = *(const uint4*)x, b = *(const uint4*)(x + 128);
            pr.v[0].x = u2f(a.x); pr.v[0].y = u2f(a.y); pr.v[0].z = u2f(a.z); pr.v[0].w = u2f(a.w); pr.v[1].x = u2f(b.x); pr.v[1].y = u2f(b.y); pr.v[1].z = u2f(b.z); pr.v[1].w = u2f(b.w); } }
    DEVM void apply(const Unit& u, long long row, int c8, const float* lo, const float* hi, const Pre& pr) const {
        float4 a, b, c, d;
        if (XS) { a = pr.v[0]; b = pr.v[1]; c = pr.v[2]; d = pr.v[3]; }
        else { const unsigned a0 = f2u(pr.v[0].x), a1 = f2u(pr.v[0].y), a2 = f2u(pr.v[0].z), a3 = f2u(pr.v[0].w), b0 = f2u(pr.v[1].x), b1 = f2u(pr.v[1].y), b2 = f2u(pr.v[1].z), b3 = f2u(pr.v[1].w);
            a.x = u2f(a0 << 16); a.y = u2f(a0 & 0xffff0000u); a.z = u2f(a1 << 16); a.w = u2f(a1 & 0xffff0000u); b.x = u2f(a2 << 16); b.y = u2f(a2 & 0xffff0000u); b.z = u2f(a3 << 16); b.w = u2f(a3 & 0xffff0000u);
            c.x = u2f(b0 << 16); c.y = u2f(b0 & 0xffff0000u); c.z = u2f(b1 << 16); c.w = u2f(b1 & 0xffff0000u); d.x = u2f(b2 << 16); d.y = u2f(b2 & 0xffff0000u); d.z = u2f(b3 << 16); d.w = u2f(b3 & 0xffff0000u); }
        a.x += lo[0]; a.y += lo[1]; a.z += lo[2]; a.w += lo[3]; b.x += lo[4]; b.y += lo[5]; b.z += lo[6]; b.w += lo[7];
        c.x += hi[0]; c.y += hi[1]; c.z += hi[2]; c.w += hi[3]; d.x += hi[4]; d.y += hi[5]; d.z += hi[6]; d.w += hi[7];
        { const float n0[8] = {a.x, a.y, a.z, a.w, b.x, b.y, b.z, b.w}, n1[8] = {c.x, c.y, c.z, c.w, d.x, d.y, d.z, d.w}; bf16_t* h = HB + row * 1024 + u.pn * 256 + c8; st8(h, n0); st8(h + 128, n1); }
        if (RS) {
            float ss = (a.x * a.x + a.y * a.y + a.z * a.z + a.w * a.w) + (b.x * b.x + b.y * b.y + b.z * b.z + b.w * b.w) + (c.x * c.x + c.y * c.y + c.z * c.z + c.w * c.w) + (d.x * d.x + d.y * d.y + d.z * d.z + d.w * d.w);
#ifdef CPU_EMU
            RS[row] += (rs_t)((double)ss * 16777216.0 + 0.5);
#else
            ss += __shfl_xor(ss, 16); ss += __shfl_xor(ss, 32);
            if ((mk_lane_() >> 4) == 0) atomicAdd(RS + row, (rs_t)((double)ss * 16777216.0 + 0.5));
#endif
        } }
};
struct EpSwiglu {
    typedef PreRow Pre; static constexpr int ROWS = 2;
    bf16_t* ACT; long long ldo; long long row0; const rs_t* rss;
    DEVM void pre(const Unit&, long long row, int, Pre& pr) const { pr.r = rs_of(rss, row); }
    DEVM void apply(const Unit& u, long long row, int c8, const float* lo, const float* hi, const Pre& pr) const { float r[8];
#pragma unroll
        for (int j = 0; j < 8; ++j) r[j] = siluf_(lo[j] * pr.r) * (hi[j] * pr.r);
        st8(ACT + (row - row0) * ldo + u.pn * 128 + c8, r); }
};
struct EpMoeDown {
    struct Pre { float w; }; static constexpr int ROWS = 2;
    bf16_t* Y; const float* roww;
    DEVM void pre(const Unit&, long long row, int, Pre& pr) const { pr.w = roww[row]; }
    DEVM void apply(const Unit& u, long long row, int c8, const float* lo, const float* hi, const Pre& pr) const { const float w = pr.w; float a[8], b[8];
#pragma unroll
        for (int j = 0; j < 8; ++j) { a[j] = lo[j] * w; b[j] = hi[j] * w; }
        bf16_t* d = Y + row * 1024 + u.pn * 256 + c8; st8(d, a); st8(d + 128, b); }
};

#ifdef CPU_EMU
template <class Sched, class Epi> static void gemm_cpu(const bf16_t* A, long long lda, const bf16_t* Bt, long long ldb, long long K, const Sched& S, const Epi& E, long long kstepA = 64, const int* gidx = nullptr) {
    Unit u;
    for (int i = 0; S.next(i, u); ++i) {
        const bf16_t* a0 = (const bf16_t*)((const char*)A + u.aoff); const bf16_t* b0 = (const bf16_t*)((const char*)Bt + u.boff);
#pragma omp parallel for
        for (int r = 0; r < 256; ++r) { float arow[4096]; const bf16_t* ar = a0 + r * lda; if (gidx) { const unsigned tk = (unsigned)gidx[(long long)u.pm * 256 + r] & 0xffffu; ar = A + (long long)tk * lda; }
            for (long long k = 0; k < K; ++k) arow[k] = bf2f(ar[(k >> 6) * kstepA + (k & 63)]);
            for (int c8 = 0; c8 < 128; c8 += 8) { float lo[8], hi[8];
                for (int j = 0; j < 8; ++j) { const bf16_t* bl = b0 + (c8 + j) * ldb; const bf16_t* bh = b0 + (128 + c8 + j) * ldb; float s0 = 0.f, s1 = 0.f;
                    for (long long k = 0; k < K; ++k) { s0 += arow[k] * bf2f(bl[k]); s1 += arow[k] * bf2f(bh[k]); } lo[j] = s0; hi[j] = s1; }
                typename Epi::Pre pr; E.pre(u, (long long)u.pm * 256 + r, c8, pr); E.apply(u, (long long)u.pm * 256 + r, c8, lo, hi, pr); } } }
}
#endif

#ifndef CPU_EMU
DEVI float wave_sum(float v) {
    v += __builtin_bit_cast(float, __builtin_amdgcn_update_dpp(0, __builtin_bit_cast(int, v), 0xB1, 0xF, 0xF, true)); v += __builtin_bit_cast(float, __builtin_amdgcn_update_dpp(0, __builtin_bit_cast(int, v), 0x4E, 0xF, 0xF, true));
    v += __builtin_bit_cast(float, __builtin_amdgcn_update_dpp(0, __builtin_bit_cast(int, v), 0x141, 0xF, 0xF, true)); v += __builtin_bit_cast(float, __builtin_amdgcn_update_dpp(0, __builtin_bit_cast(int, v), 0x140, 0xF, 0xF, true));
    float a = v, b = v; asm("s_nop 1\n\tv_permlane16_swap_b32 %0, %1" : "+v"(a), "+v"(b)); a = a + b; b = a;
    asm("s_nop 1\n\tv_permlane32_swap_b32 %0, %1" : "+v"(a), "+v"(b)); return a + b; }
DEVI void row_load(const float* src, float (&v)[16], int lane) {
#pragma unroll
    for (int j = 0; j < 4; ++j) { const float4 f = *(const float4*)(src + j * 256 + lane * 4); v[4 * j] = f.x; v[4 * j + 1] = f.y; v[4 * j + 2] = f.z; v[4 * j + 3] = f.w; } }
DEVI void row_load_bf16(const bf16_t* src, float (&v)[16], int lane) {
#pragma unroll
    for (int j = 0; j < 4; ++j) { const uint2 w = *(const uint2*)(src + j * 256 + lane * 4); v[4 * j] = u2f(w.x << 16); v[4 * j + 1] = u2f(w.x & 0xffff0000u); v[4 * j + 2] = u2f(w.y << 16); v[4 * j + 3] = u2f(w.y & 0xffff0000u); } }
DEVI void row_store_bf16(bf16_t* dst, const float (&v)[16], int lane) {
#pragma unroll
    for (int j = 0; j < 4; ++j) { uint2 w; w.x = pk2bf(v[4 * j], v[4 * j + 1]); w.y = pk2bf(v[4 * j + 2], v[4 * j + 3]); *(uint2*)(dst + j * 256 + lane * 4) = w; } }
#endif
DEVI void ph_rmsnorm(const Params& p, const float* src, long long rows, const float* gain, bf16_t* dst, int mode, float* xcopy, long long gw, long long nw, int lane, long long row0 = 0, const bf16_t* srcb = nullptr) {
    const float* router = p.in[I_MOE_R]; int* TE = WSP(int, p.oTOKE) + row0 * 2; float* TW = WSP(float, p.oTOKW) + row0 * 2;
#ifndef CPU_EMU
    for (long long r = gw; r < rows; r += nw) { float v[16], g[16]; if (srcb) row_load_bf16(srcb + r * 1024, v, lane); else row_load(src + r * 1024, v, lane); row_load(gain, g, lane);
        float ss = 0.f;
#pragma unroll
        for (int j = 0; j < 16; ++j) ss += v[j] * v[j];
        ss = wave_sum(ss); const float rs = rsqrtf(ss * (1.0f / 1024.0f) + 1e-6f);
        if (mode == 1) {
#pragma unroll
            for (int j = 0; j < 4; ++j) *(float4*)(xcopy + r * 1024 + j * 256 + lane * 4) = make_float4(v[4 * j], v[4 * j + 1], v[4 * j + 2], v[4 * j + 3]); }
#pragma unroll
        for (int j = 0; j < 16; ++j) v[j] = v[j] * rs * g[j];
        row_store_bf16(dst + r * 1024, v, lane);
        if (mode == 2) { float lg[8];
#pragma unroll
            for (int e = 0; e < 8; ++e) { float a = 0.f;
#pragma unroll
                for (int j = 0; j < 16; ++j) a += v[j] * router[(long long)((j >> 2) * 256 + lane * 4 + (j & 3)) * 8 + e];
                lg[e] = wave_sum(a); }
            int i0 = 0; float v0 = lg[0];
#pragma unroll
            for (int e = 1; e < 8; ++e) if (lg[e] > v0) { v0 = lg[e]; i0 = e; }
            int i1 = -1; float v1 = -3e38f;
#pragma unroll
            for (int e = 0; e < 8; ++e) if (e != i0 && lg[e] > v1) { v1 = lg[e]; i1 = e; }
            const float w0 = 1.0f / (1.0f + expf(v1 - v0));
            if (lane == 0) { TE[r * 2] = i0; TE[r * 2 + 1] = i1; TW[r * 2] = w0; TW[r * 2 + 1] = 1.0f - w0; } } }
#else
    (void)lane;
    for (long long r = gw; r < rows; r += nw) { float xb_[1024]; if (srcb) for (int c = 0; c < 1024; ++c) xb_[c] = bf2f(srcb[r * 1024 + c]); const float* x = srcb ? xb_ : src + r * 1024; float ss = 0.f; for (int c = 0; c < 1024; ++c) ss += x[c] * x[c];
        const float rs = 1.0f / sqrtf(ss / 1024.0f + 1e-6f); float hv[1024];
        for (int c = 0; c < 1024; ++c) { hv[c] = x[c] * rs * gain[c]; dst[r * 1024 + c] = f2bf(hv[c]); if (mode == 1) xcopy[r * 1024 + c] = x[c]; }
        if (mode == 2) { float lg[8]; for (int e = 0; e < 8; ++e) { float a = 0.f; for (int c = 0; c < 1024; ++c) a += hv[c] * router[c * 8 + e]; lg[e] = a; }
            int i0 = 0; float v0 = lg[0]; for (int e = 1; e < 8; ++e) if (lg[e] > v0) { v0 = lg[e]; i0 = e; }
            int i1 = -1; float v1 = -3e38f; for (int e = 0; e < 8; ++e) if (e != i0 && lg[e] > v1) { v1 = lg[e]; i1 = e; }
            const float w0 = 1.0f / (1.0f + expf(v1 - v0)); TE[r * 2] = i0; TE[r * 2 + 1] = i1; TW[r * 2] = w0; TW[r * 2 + 1] = 1.0f - w0; } }
#endif
}
DEVI void ph_final(const Params& p, long long gw, long long nw, int lane) {
    const int* TS = WSP(int, p.oTOKS); const bf16_t* Y = WSP(bf16_t, p.oY); const float* gain = p.in[I_NORM_FINAL]; float* X = p.out; const bf16_t* XB = WSP(bf16_t, p.oH);
#ifndef CPU_EMU
    float g[16]; row_load(gain, g, lane);
    uint2 cx[4], ca[4], cb[4]; int sn0 = 0, sn1 = 0;
#define FN_LOAD(r_, s0_, s1_, dx, da, db) do { const bf16_t* y0 = Y + (long long)(s0_) * 1024; const bf16_t* y1 = Y + (long long)(s1_) * 1024; \
        _Pragma("unroll") for (int j = 0; j < 4; ++j) { dx[j] = *(const uint2*)(XB + (r_) * 1024 + j * 256 + lane * 4); da[j] = *(const uint2*)(y0 + j * 256 + lane * 4); db[j] = *(const uint2*)(y1 + j * 256 + lane * 4); } } while (0)
    if (gw < p.T) { const int s0 = TS[gw * 2], s1 = TS[gw * 2 + 1]; FN_LOAD(gw, s0, s1, cx, ca, cb); if (gw + nw < p.T) { sn0 = TS[(gw + nw) * 2]; sn1 = TS[(gw + nw) * 2 + 1]; } }
    for (long long r = gw; r < p.T; r += nw) { float v[16]; uint2 nx[4], na[4], nb[4]; int snn0 = 0, snn1 = 0;
        if (r + nw < p.T) FN_LOAD(r + nw, sn0, sn1, nx, na, nb);
        if (r + 2 * nw < p.T) { snn0 = TS[(r + 2 * nw) * 2]; snn1 = TS[(r + 2 * nw) * 2 + 1]; }
#pragma unroll
        for (int j = 0; j < 4; ++j) { const uint2 x = cx[j], a = ca[j], b = cb[j];
            v[4 * j] = u2f(x.x << 16) + u2f(a.x << 16) + u2f(b.x << 16); v[4 * j + 1] = u2f(x.x & 0xffff0000u) + u2f(a.x & 0xffff0000u) + u2f(b.x & 0xffff0000u);
            v[4 * j + 2] = u2f(x.y << 16) + u2f(a.y << 16) + u2f(b.y << 16); v[4 * j + 3] = u2f(x.y & 0xffff0000u) + u2f(a.y & 0xffff0000u) + u2f(b.y & 0xffff0000u); }
#pragma unroll
        for (int j = 0; j < 4; ++j) { cx[j] = nx[j]; ca[j] = na[j]; cb[j] = nb[j]; }
        sn0 = snn0; sn1 = snn1;
        float ss = 0.f;
#pragma unroll
        for (int j = 0; j < 16; ++j) ss += v[j] * v[j];
        ss = wave_sum(ss); const float rs = rsqrtf(ss * (1.0f / 1024.0f) + 1e-6f);
#pragma unroll
        for (int j = 0; j < 4; ++j) *(float4*)(X + r * 1024 + j * 256 + lane * 4) = make_float4(v[4 * j] * rs * g[4 * j], v[4 * j + 1] * rs * g[4 * j + 1], v[4 * j + 2] * rs * g[4 * j + 2], v[4 * j + 3] * rs * g[4 * j + 3]); }
#undef FN_LOAD
#else
    (void)lane;
    for (long long r = gw; r < p.T; r += nw) { float v[1024]; float ss = 0.f; const bf16_t* y0 = Y + (long long)TS[r * 2] * 1024; const bf16_t* y1 = Y + (long long)TS[r * 2 + 1] * 1024;
        for (int c = 0; c < 1024; ++c) { v[c] = bf2f(XB[r * 1024 + c]) + bf2f(y0[c]) + bf2f(y1[c]); ss += v[c] * v[c]; }
        const float rs = 1.0f / sqrtf(ss / 1024.0f + 1e-6f); for (int c = 0; c < 1024; ++c) X[r * 1024 + c] = v[c] * rs * gain[c]; }
#endif
}
DEVI void ph_rwkv_scan(const Params& p, int l, long long gw, long long nw, int lane) {
    const float* RWW = WSP(float, p.oRWW); const bf16_t* RWX = WSP(bf16_t, p.oRWX); bf16_t* O = WSP(bf16_t, p.oO); const float* lng = p.in[I_RW_LN] + l * 256; const float* rkw = p.in[I_RW_RK] + l * 256; (void)rkw;
    for (long long ch = gw; ch < p.B * 4; ch += nw) { const long long b = ch >> 2; const int h = (int)(ch & 3);
#ifndef CPU_EMU
        float st[64];
#pragma unroll
        for (int c = 0; c < 64; ++c) st[c] = 0.f;
        for (long long s = 0; s < p.S; ++s) { const long long t = b * p.S + s; const bf16_t* rx = RWX + t * 1280 + h * 64; const float v = bf2f(rx[512 + lane]);
            const float y = rwkv_row_step(st, RWW + t * 256 + h * 64, rx, rx + 256, rx + 768, rx + 1024, v);
            const float mean = wave_sum(y) * (1.0f / 64.0f), dy = y - mean, var = wave_sum(dy * dy) * (1.0f / 64.0f);
            const float yn = dy * rsqrtf(var + 64e-5f) * lng[h * 64 + lane] + 0.f;
            bf16_t* o = O + t * 1024 + 512 + h * 64 + lane; *o = f2bf(yn * bf2f(*o)); }
#else
        (void)lane;
        static float st[64][64]; for (int v = 0; v < 64; ++v) for (int c = 0; c < 64; ++c) st[v][c] = 0.f;
        for (long long s = 0; s < p.S; ++s) { const long long t = b * p.S + s; const bf16_t* rx = RWX + t * 1280 + h * 64; float y[64], mean = 0.f, var = 0.f;
            for (int v = 0; v < 64; ++v) { y[v] = rwkv_row_step(st[v], RWW + t * 256 + h * 64, rx, rx + 256, rx + 768, rx + 1024, bf2f(rx[512 + v])); mean += y[v]; }
            mean /= 64.f; for (int v = 0; v < 64; ++v) var += (y[v] - mean) * (y[v] - mean); var /= 64.f;
            float rkv = 0.f; for (int cq = 0; cq < 64; ++cq) rkv += bf2f(rx[cq]) * bf2f(rx[256 + cq]) * rkw[h * 64 + cq];
            for (int v = 0; v < 64; ++v) { const float yn = (y[v] - mean) / sqrtf(var + 64e-5f) * lng[h * 64 + v] + rkv * bf2f(rx[512 + v]);
                bf16_t* o = O + t * 1024 + 512 + h * 64 + v; *o = f2bf(yn * bf2f(*o)); } }
#endif
    }
}
DEVI void ph_gla_scan(const Params& p, int l, long long gw, long long nw, int lane) {
    const bf16_t* P = WSP(bf16_t, p.oP); const float* GA = WSP(float, p.oGA); bf16_t* O = WSP(bf16_t, p.oO); const float* ng = p.in[I_GLA_NORM] + l * 64;
    for (long long ch = gw; ch < p.B * 4; ch += nw) { const long long b = ch >> 2; const int h = (int)(ch & 3);
#ifndef CPU_EMU
        float st[32];
#pragma unroll
        for (int c = 0; c < 32; ++c) st[c] = 0.f;
        for (long long s = 0; s < p.S; ++s) { const long long t = b * p.S + s; const bf16_t* x = P + t * PW + C_GLA;
            const float o = gla_col_step(st, GA + t * 128 + h * 32, x + h * 32, x + 128 + h * 32, bf2f(x[256 + h * 64 + lane]));
            const float ms = wave_sum(o * o) * (1.0f / 64.0f), on = o * rsqrtf(ms + 1e-6f) * ng[lane];
            bf16_t* d = O + t * 1024 + 768 + h * 64 + lane; *d = f2bf(on * bf2f(*d)); }
#else
        (void)lane;
        static float st[64][32]; for (int v = 0; v < 64; ++v) for (int c = 0; c < 32; ++c) st[v][c] = 0.f;
        for (long long s = 0; s < p.S; ++s) { const long long t = b * p.S + s; const bf16_t* x = P + t * PW + C_GLA; float o[64], ms = 0.f;
            for (int v = 0; v < 64; ++v) { o[v] = gla_col_step(st[v], GA + t * 128 + h * 32, x + h * 32, x + 128 + h * 32, bf2f(x[256 + h * 64 + v])); ms += o[v] * o[v]; }
            ms /= 64.f;
            for (int v = 0; v < 64; ++v) { bf16_t* d = O + t * 1024 + 768 + h * 64 + v; *d = f2bf(o[v] / sqrtf(ms + 1e-6f) * ng[v] * bf2f(*d)); } }
#endif
    }
}
#ifndef CPU_EMU
#define LAS __attribute__((address_space(3)))
__device__ __forceinline__ int mk_lane() { int l_ = (int)__builtin_amdgcn_mbcnt_hi(~0u, __builtin_amdgcn_mbcnt_lo(~0u, 0u)); asm volatile("" : "+v"(l_)); return l_; }
typedef short bf16x8 __attribute__((ext_vector_type(8)));
typedef float f32x4 __attribute__((ext_vector_type(4)));
constexpr int HALF = 128, BK = 64, HTB = HALF * BK * 2, STAGE_BYTES = 8 * HTB, GIDX_OFF = STAGE_BYTES + 64, GIDX_BYTES = 8192, LDS_TOTAL = 163840, XBW_OFF = LDS_TOTAL - 64, DEAL_SLOT_OFF = LDS_TOTAL - 128;
__device__ __forceinline__ int lds_byte(int r, int c) { const int st = (r >> 4) * 2 + (c >> 5), rr = r & 15, cc = c & 31, ob = rr * 64 + cc * 2; return st * 1024 + (ob ^ (((ob >> 9) & 1) << 5)); }
__device__ __forceinline__ void stage_rc(int b, int& R, int& C) { const int st = b / 1024, sb = b % 1024, swz = sb ^ (((sb >> 9) & 1) << 5); R = (st >> 1) * 16 + swz / 64; C = (st & 1) * 32 + (swz % 64) / 2; }
__device__ __forceinline__ int perm32(int rho) { const int n = rho >> 4, i = rho & 15; return 8 * (i >> 2) + 4 * n + (i & 3); }

template <class Epi, class Sched, bool GATHER = false>
__device__ __forceinline__ void gemm_phase(int wv, LAS unsigned char* lds, const bf16_t* A, long long lda, const bf16_t* Bt, long long ldb, long long K, const Sched& S, const Epi& E, long long kstepA_elems = 64, const int* gidx = nullptr) {
    int tid = wv * 64 + mk_lane(); asm volatile("" : "+v"(tid));
    const int wid = wv, lane = tid & 63, wr = wid >> 2, wc = wid & 3, fr = lane & 15, fq = lane >> 4;
    { unsigned long long a_ = (unsigned long long)A, b_ = (unsigned long long)Bt; unsigned alo = __builtin_amdgcn_readfirstlane((unsigned)a_), ahi = __builtin_amdgcn_readfirstlane((unsigned)(a_ >> 32)),
        blo = __builtin_amdgcn_readfirstlane((unsigned)b_), bhi = __builtin_amdgcn_readfirstlane((unsigned)(b_ >> 32));
      int lda_ = __builtin_amdgcn_readfirstlane((int)lda), ldb_ = __builtin_amdgcn_readfirstlane((int)ldb), k_ = __builtin_amdgcn_readfirstlane((int)K), ks_ = __builtin_amdgcn_readfirstlane((int)kstepA_elems);
      asm volatile("" : "+s"(alo), "+s"(ahi), "+s"(blo), "+s"(bhi), "+s"(lda_), "+s"(ldb_), "+s"(k_), "+s"(ks_)); kstepA_elems = ks_;
      A = (const bf16_t*)(((unsigned long long)ahi << 32) | alo); Bt = (const bf16_t*)(((unsigned long long)bhi << 32) | blo); lda = lda_; ldb = ldb_; K = k_; }
    const int nt = (int)(K / BK);
    unsigned voffA[2], voffB[2];
#define PG8_GRC(i_, R_, C2_) int R_, Cc_##i_; stage_rc(tid * 16 + (i_) * 8192, R_, Cc_##i_); const unsigned C2_ = (unsigned)Cc_##i_ * 2u
#pragma unroll
    for (int i = 0; i < 2; ++i) { int R, C; stage_rc(tid * 16 + i * 8192, R, C); const int Rb = (R & ~31) + perm32(R & 31);
        voffA[i] = (unsigned)(R * (int)lda + C) * 2u; voffB[i] = (unsigned)(Rb * (int)ldb + C) * 2u; }
    const size_t kstep = (size_t)(BK * 2), kstepA = (size_t)kstepA_elems * 2;
    const size_t hstepA = (size_t)HALF * lda * 2, hstepB = (size_t)HALF * ldb * 2;
    const unsigned ldsw = (unsigned)wid * 1024u;
    const int aoff = lds_byte(wr * 64 + fr, fq * 8), boff = lds_byte(wc * 32 + fr, fq * 8);
#define PG8_SA(b, h) (((b) * 2 + (h)) * HTB)
#define PG8_SB(b, h) ((4 + (b) * 2 + (h)) * HTB)
#define PG8_STAGE(bufoff, gbase, voff) do { _Pragma("unroll") for (int _i = 0; _i < 2; ++_i) \
        __builtin_amdgcn_global_load_lds((const unsigned*)((const char*)(gbase) + (voff)[_i]), (LAS unsigned*)(lds + (bufoff) + ldsw + _i * 8192), 16, 0, 0); } while (0)
#define PG8_STAGE_A(bufoff, plainbase, kbytes, g0, g1) do { if constexpr (GATHER) { const char* gb_ = (const char*)A + (kbytes); \
        __builtin_amdgcn_global_load_lds((const unsigned*)(gb_ + (g0)), (LAS unsigned*)(lds + (bufoff) + ldsw), 16, 0, 0); __builtin_amdgcn_global_load_lds((const unsigned*)(gb_ + (g1)), (LAS unsigned*)(lds + (bufoff) + ldsw + 8192), 16, 0, 0); } \
        else PG8_STAGE(bufoff, plainbase, voffA); } while (0)
#define PG8_GOFF(dst, u_) do { if constexpr (GATHER) { PG8_GRC(0, r0_, c0_); PG8_GRC(1, r1_, c1_); _Pragma("unroll") for (int h_ = 0; h_ < 2; ++h_) { unsigned tk_ = (unsigned)gidx[(long long)(u_).pm * 256 + h_ * 128 + r0_] & 0xffffu; dst[h_][0] = tk_ * (unsigned)((int)lda * 2) + c0_; \
        tk_ = (unsigned)gidx[(long long)(u_).pm * 256 + h_ * 128 + r1_] & 0xffffu; dst[h_][1] = tk_ * (unsigned)((int)lda * 2) + c1_; } } } while (0)
#define PG8_LDA(dst, b, h) do { _Pragma("unroll") for (int m = 0; m < 4; ++m) _Pragma("unroll") for (int k = 0; k < 2; ++k) dst[m][k] = *(const LAS bf16x8*)(lds + PG8_SA(b, h) + aoff + m * 2048 + k * 1024); } while (0)
#define PG8_LDB(dst, b, h) do { _Pragma("unroll") for (int n = 0; n < 2; ++n) _Pragma("unroll") for (int k = 0; k < 2; ++k) dst[n][k] = *(const LAS bf16x8*)(lds + PG8_SB(b, h) + boff + n * 2048 + k * 1024); } while (0)
#define PG8_MMA(ai, bj, At, Bt_) do { __builtin_amdgcn_s_setprio(1); _Pragma("unroll") for (int m = 0; m < 4; ++m) _Pragma("unroll") for (int n = 0; n < 2; ++n) _Pragma("unroll") for (int k = 0; k < 2; ++k) \
        acc[ai][bj][m][n] = __builtin_amdgcn_mfma_f32_16x16x32_bf16(Bt_[n][k], At[m][k], acc[ai][bj][m][n], 0, 0, 0); __builtin_amdgcn_s_setprio(0); } while (0)
#define PG8_WAIT_V(n) asm volatile("s_waitcnt vmcnt(" #n ")" ::: "memory")
#define PG8_WAIT_L(n) asm volatile("s_waitcnt lgkmcnt(" #n ")" ::: "memory")
#define PG8_BAR __builtin_amdgcn_s_barrier()
#define PG8_SCHED __builtin_amdgcn_sched_barrier(0)
    Unit cur, nxt; int ui = 0;
    if (!S.next(0, cur)) return;
    f32x4 acc[2][2][4][2];
#pragma unroll
    for (int a = 0; a < 2; ++a)
#pragma unroll
        for (int b = 0; b < 2; ++b)
#pragma unroll
            for (int m = 0; m < 4; ++m)
#pragma unroll
                for (int n = 0; n < 2; ++n) acc[a][b][m][n] = (f32x4){0.f, 0.f, 0.f, 0.f};
    bf16x8 At[4][2], B0[2][2], B1[2][2];
    const char* cA = (const char*)A + cur.aoff; const char* cB = (const char*)Bt + cur.boff;
    S.a_ready(cur);
    unsigned gC_[2][2] = {{0u, 0u}, {0u, 0u}};
    PG8_GOFF(gC_, cur);
    PG8_STAGE(PG8_SB(0, 0), cB, voffB); PG8_STAGE_A(PG8_SA(0, 0), cA, 0, gC_[0][0], gC_[0][1]); PG8_STAGE(PG8_SB(0, 1), cB + hstepB, voffB); PG8_STAGE_A(PG8_SA(0, 1), cA + hstepA, 0, gC_[1][0], gC_[1][1]);
    if (wr == 1) PG8_BAR;
    PG8_WAIT_V(4); PG8_BAR;
    PG8_STAGE(PG8_SB(1, 0), cB + kstep, voffB); PG8_STAGE_A(PG8_SA(1, 0), cA + kstepA, kstepA, gC_[0][0], gC_[0][1]); PG8_STAGE(PG8_SB(1, 1), cB + hstepB + kstep, voffB);
    PG8_WAIT_V(6); PG8_BAR;
    for (;;) {
        const bool has_next = S.next(ui + 1, nxt);
        const char* nA = has_next ? (const char*)A + nxt.aoff : cA; const char* nB = has_next ? (const char*)Bt + nxt.boff : cB;
#pragma nounroll
        for (int t = 0; t < nt; t += 2) {
            const bool last = (t == nt - 2);
            if constexpr (GATHER) {
                if (t == 0 && has_next) {
                    PG8_GRC(0, r0_, c0_); PG8_GRC(1, r1_, c1_); (void)c0_; (void)c1_;
#pragma unroll
                    for (int h_ = 0; h_ < 2; ++h_) { const int* ip0_ = gidx + (long long)nxt.pm * 256 + h_ * 128 + r0_; const int* ip1_ = gidx + (long long)nxt.pm * 256 + h_ * 128 + r1_;
                        __builtin_amdgcn_global_load_lds((const unsigned*)ip0_, (LAS unsigned*)(lds + GIDX_OFF + (h_ * 2 + 0) * 2048 + wid * 256), 4, 0, 0);
                        __builtin_amdgcn_global_load_lds((const unsigned*)ip1_, (LAS unsigned*)(lds + GIDX_OFF + (h_ * 2 + 1) * 2048 + wid * 256), 4, 0, 0); } }
            }
            const size_t k1_ = (size_t)(t + 1) * kstepA, k2_ = last ? 0 : (size_t)(t + 2) * kstepA, k3_ = k2_ + kstepA;
            const char* a1 = cA + (size_t)(t + 1) * kstepA;
            const char* a2 = last ? nA : cA + (size_t)(t + 2) * kstepA; const char* b2 = last ? nB : cB + (size_t)(t + 2) * kstep;
            const char* a3 = a2 + kstepA; const char* b3 = b2 + kstep;
            if (last && has_next) S.a_ready(nxt);
            PG8_LDB(B0, 0, 0); PG8_SCHED; PG8_LDA(At, 0, 0); PG8_STAGE_A(PG8_SA(1, 1), a1 + hstepA, k1_, gC_[1][0], gC_[1][1]);
            if constexpr (GATHER) { if (last && has_next) {
                PG8_GRC(0, r0_, c0_); PG8_GRC(1, r1_, c1_); (void)r0_; (void)r1_;
#pragma unroll
                for (int h_ = 0; h_ < 2; ++h_) { unsigned i0_, i1_; const unsigned ad_ = (unsigned)(size_t)(lds + GIDX_OFF + h_ * 4096) + (unsigned)tid * 4u;
                    asm volatile("ds_read_b32 %0, %2\n\tds_read_b32 %1, %2 offset:2048\n\ts_waitcnt lgkmcnt(0)" : "=&v"(i0_), "=&v"(i1_) : "v"(ad_) : "memory");
                    gC_[h_][0] = (i0_ & 0xffffu) * (unsigned)((int)lda * 2) + c0_; gC_[h_][1] = (i1_ & 0xffffu) * (unsigned)((int)lda * 2) + c1_; } } }
            PG8_WAIT_L(8); PG8_BAR; PG8_WAIT_L(0); PG8_MMA(0, 0, At, B0); PG8_BAR; PG8_SCHED;
            PG8_LDB(B1, 0, 1); PG8_STAGE(PG8_SB(0, 0), b2, voffB);
            PG8_BAR; PG8_WAIT_L(0); PG8_MMA(0, 1, At, B1); PG8_BAR;
            PG8_LDA(At, 0, 1); PG8_STAGE_A(PG8_SA(0, 0), a2, k2_, gC_[0][0], gC_[0][1]);
            PG8_BAR; PG8_WAIT_L(0); PG8_MMA(1, 0, At, B0); PG8_BAR; PG8_SCHED;
            PG8_STAGE(PG8_SB(0, 1), b2 + hstepB, voffB);
            PG8_WAIT_V(6); PG8_BAR; PG8_MMA(1, 1, At, B1); PG8_BAR;
            PG8_LDB(B0, 1, 0); PG8_SCHED; PG8_LDA(At, 1, 0); PG8_STAGE_A(PG8_SA(0, 1), a2 + hstepA, k2_, gC_[1][0], gC_[1][1]);
            PG8_WAIT_L(8); PG8_BAR; PG8_WAIT_L(0); PG8_MMA(0, 0, At, B0); PG8_BAR; PG8_SCHED;
            PG8_LDB(B1, 1, 1); PG8_STAGE(PG8_SB(1, 0), b3, voffB);
            PG8_BAR; PG8_WAIT_L(0); PG8_MMA(0, 1, At, B1); PG8_BAR;
            PG8_LDA(At, 1, 1); PG8_STAGE_A(PG8_SA(1, 0), a3, k3_, gC_[0][0], gC_[0][1]);
            PG8_BAR; PG8_WAIT_L(0); PG8_MMA(1, 0, At, B0); PG8_BAR; PG8_SCHED;
            PG8_STAGE(PG8_SB(1, 1), b3 + hstepB, voffB);
            PG8_WAIT_V(6); PG8_BAR; PG8_MMA(1, 1, At, B1); PG8_BAR;
        }
        const int el_ = mk_lane(), efr = el_ & 15, efq = el_ >> 4;
#pragma unroll
        for (int ai = 0; ai < 2; ++ai)
#pragma unroll
            for (int mh = 0; mh < 4 / Epi::ROWS; ++mh) { typename Epi::Pre pr[Epi::ROWS];
#pragma unroll
                for (int m2 = 0; m2 < Epi::ROWS; ++m2) E.pre(cur, (long long)cur.pm * 256 + ai * HALF + wr * 64 + (Epi::ROWS * mh + m2) * 16 + efr, wc * 32 + 8 * efq, pr[m2]);
                PG8_SCHED;
#pragma unroll
                for (int m2 = 0; m2 < Epi::ROWS; ++m2) { const int m = Epi::ROWS * mh + m2; float lo[8], hi[8];
#pragma unroll
                    for (int j = 0; j < 8; ++j) { lo[j] = acc[ai][0][m][j >> 2][j & 3]; hi[j] = acc[ai][1][m][j >> 2][j & 3]; }
                    E.apply(cur, (long long)cur.pm * 256 + ai * HALF + wr * 64 + m * 16 + efr, wc * 32 + 8 * efq, lo, hi, pr[m2]); }
                PG8_SCHED; }
        S.done(cur);
        if (!has_next) break;
#pragma unroll
        for (int a = 0; a < 2; ++a)
#pragma unroll
            for (int b = 0; b < 2; ++b)
#pragma unroll
                for (int m = 0; m < 4; ++m)
#pragma unroll
                    for (int n = 0; n < 2; ++n) acc[a][b][m][n] = (f32x4){0.f, 0.f, 0.f, 0.f};
        cur = nxt; cA = nA; cB = nB; ++ui;
    }
    PG8_WAIT_V(0);
    if (wr == 0) PG8_BAR;
    PG8_BAR;
#undef PG8_SA
#undef PG8_SB
#undef PG8_STAGE
#undef PG8_LDA
#undef PG8_STAGE_A
#undef PG8_GRC
#undef PG8_GOFF
#undef PG8_LDB
#undef PG8_MMA
#undef PG8_WAIT_V
#undef PG8_WAIT_L
#undef PG8_BAR
#undef PG8_SCHED
}

#define XB_TMO      128
#define XB_XCNT(j)  (256  + 64 * (j))
#define XB_XSUB(j)  (1280 + 64 * (j))
#define XB_XGEN(j)  (2304 + 64 * (j))
#define XB_TOP      3328
#define XB_TOPGEN   3392
#define XCD_BAR_WORDS 3456
#define XB_SPIN_CAP (1u << 18)
__device__ __forceinline__ unsigned xb_ld(unsigned* p)              { return __hip_atomic_load(p, __ATOMIC_RELAXED, __HIP_MEMORY_SCOPE_AGENT); }
__device__ __forceinline__ unsigned xb_add(unsigned* p, unsigned v) { return __hip_atomic_fetch_add(p, v, __ATOMIC_RELAXED, __HIP_MEMORY_SCOPE_AGENT); }
__device__ __forceinline__ unsigned xb_xcc_id() { return (unsigned)__builtin_amdgcn_s_getreg((3 << 11) | 20) & 0xFu; }
#define XB_SPIN(cond, bar) do { unsigned _sp = 0; while (cond) { __builtin_amdgcn_s_sleep(1); \
    if ((++_sp & 255u) == 0u) { if (xb_ld(&(bar)[XB_TMO])) break; if (_sp > XB_SPIN_CAP) { atomicAdd(&(bar)[XB_TMO], 1u); break; } } } } while (0)
struct XcdBarrier { unsigned* bar; unsigned x; volatile LAS unsigned* st; int wv; };
__device__ __forceinline__ XcdBarrier xcd_barrier_post(unsigned* bar, volatile LAS unsigned* st, int wv) {
    XcdBarrier b; b.bar = bar; b.x = xb_xcc_id(); b.st = st; b.wv = wv;
    if (wv == 0 && mk_lane() == 0) (void)xb_add(&bar[XB_XCNT(b.x)], 1u);
    return b;
}
__device__ __forceinline__ void xcd_barrier_complete(unsigned* bar, unsigned x, unsigned& nloc, unsigned& nx) {
    const unsigned G = gridDim.x * gridDim.y * gridDim.z;
    unsigned sum, cnt, mine, sp = 0u;
    for (;;) {
        sum = 0u; cnt = 0u; mine = 0u;
#pragma unroll
        for (unsigned j = 0; j < 16; ++j) { const unsigned c = xb_ld(&bar[XB_XCNT(j)]); sum += c; cnt += (c > 0u) ? 1u : 0u; mine = (j == x) ? c : mine; }
        if (sum == G) break;
        __builtin_amdgcn_s_sleep(1);
        if ((++sp & 255u) == 0u) { if (xb_ld(&bar[XB_TMO])) break; if (sp > XB_SPIN_CAP) { atomicAdd(&bar[XB_TMO], 1u); break; } }
    }
    nloc = mine > 0u ? mine : 1u; nx = cnt > 0u ? cnt : 1u;
}
__device__ __forceinline__ void xcd_barrier(const XcdBarrier& b) {
    asm volatile("s_waitcnt vmcnt(0)" ::: "memory");
    __syncthreads();
    if (b.wv == 0 && mk_lane() == 0) {
        unsigned* bar = b.bar;
        __builtin_amdgcn_s_waitcnt(0);
        unsigned nloc = b.st[0], nx = b.st[1];
        if (nloc == 0u) { xcd_barrier_complete(bar, b.x, nloc, nx); b.st[0] = nloc; b.st[1] = nx; }
        const unsigned old = xb_add(&bar[XB_XSUB(b.x)], 1u);
        const unsigned gen = old / nloc;
        if (old + 1u == (gen + 1u) * nloc) {
            __builtin_amdgcn_fence(__ATOMIC_RELEASE, "agent");
            asm volatile("s_waitcnt vmcnt(0)" ::: "memory");
            const unsigned og = xb_add(&bar[XB_TOP], 1u);
            const unsigned tg = og / nx;
            if (og + 1u == (tg + 1u) * nx) xb_add(&bar[XB_TOPGEN], 1u);
            else XB_SPIN(xb_ld(&bar[XB_TOPGEN]) == tg, bar);
            __builtin_amdgcn_fence(__ATOMIC_ACQUIRE, "agent");
            xb_add(&bar[XB_XGEN(b.x)], 1u);
            asm volatile("s_waitcnt vmcnt(0)" ::: "memory");
        } else {
            XB_SPIN(xb_ld(&bar[XB_XGEN(b.x)]) == gen, bar);
            __builtin_amdgcn_fence(__ATOMIC_ACQUIRE, "agent");
            asm volatile("s_waitcnt vmcnt(0)" ::: "memory");
        }
    }
    __syncthreads();
}
#endif
#ifndef CPU_EMU
typedef short bf16x8_t __attribute__((ext_vector_type(8)));
typedef short bf16x4_t __attribute__((ext_vector_type(4)));
typedef float f32x4_t __attribute__((ext_vector_type(4)));
typedef unsigned u32x4_t __attribute__((ext_vector_type(4)));
constexpr int AT_KS = 144, AT_VS = 136;
constexpr int AT_KBYTES = 64 * AT_KS, AT_VBYTES = 64 * AT_KS, AT_BUF = AT_KBYTES + AT_VBYTES;
typedef unsigned u32x2_t __attribute__((ext_vector_type(2)));
__device__ __forceinline__ float quad4_max(float x) { float a = x, b = x;
    asm volatile("s_nop 1\n\tv_permlane16_swap_b32 %0, %1" : "+v"(a), "+v"(b)); a = fmaxf(a, b); b = a;
    asm volatile("s_nop 1\n\tv_permlane32_swap_b32 %0, %1" : "+v"(a), "+v"(b)); return fmaxf(a, b); }
__device__ __forceinline__ float quad4_sum(float x) { float a = x, b = x;
    asm volatile("s_nop 1\n\tv_permlane16_swap_b32 %0, %1" : "+v"(a), "+v"(b)); a = a + b; b = a;
    asm volatile("s_nop 1\n\tv_permlane32_swap_b32 %0, %1" : "+v"(a), "+v"(b)); return a + b; }
__device__ __forceinline__ float dpp_mov1(float x) { return __builtin_bit_cast(float, __builtin_amdgcn_update_dpp(0, __builtin_bit_cast(int, x), 0xB1, 0xF, 0xF, true)); }
struct AttnState { float m, l; f32x4_t o[4]; };
__device__ __forceinline__ void attn_init(AttnState& s) { s.m = -1e30f; s.l = 0.f;
#pragma unroll
    for (int d = 0; d < 4; ++d) s.o[d] = (f32x4_t){0.f, 0.f, 0.f, 0.f}; }
__device__ __forceinline__ unsigned pack2bf(float lo, float hi) { return pk2bf(lo, hi); }
template <bool MASKED, class Valid> __device__ __forceinline__ void attn_tile(const LAS unsigned char* kt, const LAS unsigned char* vt, const bf16x8_t (&bq)[2], AttnState& st, int lane, const Valid& valid) {
    const int r = lane & 15, q = lane >> 4;
    f32x4_t s[4];
    {
        bf16x8_t k00, k01, k10, k11, k20, k21, k30, k31; const unsigned ka = (unsigned)(size_t)kt + (unsigned)(r * AT_KS + 16 * q);
        asm volatile("ds_read_b128 %0, %8\n\tds_read_b128 %1, %8 offset:64\n\tds_read_b128 %2, %8 offset:2304\n\tds_read_b128 %3, %8 offset:2368\n\t"
                     "ds_read_b128 %4, %8 offset:4608\n\tds_read_b128 %5, %8 offset:4672\n\tds_read_b128 %6, %8 offset:6912\n\tds_read_b128 %7, %8 offset:6976\n\ts_waitcnt lgkmcnt(0)"
                     : "=&v"(k00), "=&v"(k01), "=&v"(k10), "=&v"(k11), "=&v"(k20), "=&v"(k21), "=&v"(k30), "=&v"(k31) : "v"(ka) : "memory");
        const f32x4_t z4 = (f32x4_t){0.f, 0.f, 0.f, 0.f};
        s[0] = __builtin_amdgcn_mfma_f32_16x16x32_bf16(k00, bq[0], z4, 0, 0, 0); s[1] = __builtin_amdgcn_mfma_f32_16x16x32_bf16(k10, bq[0], z4, 0, 0, 0);
        s[2] = __builtin_amdgcn_mfma_f32_16x16x32_bf16(k20, bq[0], z4, 0, 0, 0); s[3] = __builtin_amdgcn_mfma_f32_16x16x32_bf16(k30, bq[0], z4, 0, 0, 0);
        s[0] = __builtin_amdgcn_mfma_f32_16x16x32_bf16(k01, bq[1], s[0], 0, 0, 0); s[1] = __builtin_amdgcn_mfma_f32_16x16x32_bf16(k11, bq[1], s[1], 0, 0, 0);
        s[2] = __builtin_amdgcn_mfma_f32_16x16x32_bf16(k21, bq[1], s[2], 0, 0, 0); s[3] = __builtin_amdgcn_mfma_f32_16x16x32_bf16(k31, bq[1], s[3], 0, 0, 0); }
    float mx = -1e30f;
#pragma unroll
    for (int kb = 0; kb < 4; ++kb)
#pragma unroll
        for (int j = 0; j < 4; ++j) { const float v = (!MASKED || valid(kb, j)) ? s[kb][j] : -1e30f; s[kb][j] = v; mx = fmaxf(mx, v); }
    mx = quad4_max(mx);
    const float mn = fmaxf(st.m, mx), alpha = __builtin_amdgcn_exp2f(st.m - mn);
    float rs = 0.f;
#pragma unroll
    for (int kb = 0; kb < 4; ++kb)
#pragma unroll
        for (int j = 0; j < 4; ++j) { const float pv = (!MASKED || s[kb][j] > -1e29f) ? __builtin_amdgcn_exp2f(s[kb][j] - mn) : 0.f; s[kb][j] = pv; rs += pv; }
    rs = quad4_sum(rs);
    st.l = st.l * alpha + rs; st.m = mn;
    bf16x8_t pb[2];
#pragma unroll
    for (int kk = 0; kk < 2; ++kk) { uint4 w; w.x = pack2bf(s[2 * kk][0], s[2 * kk][1]); w.y = pack2bf(s[2 * kk][2], s[2 * kk][3]); w.z = pack2bf(s[2 * kk + 1][0], s[2 * kk + 1][1]); w.w = pack2bf(s[2 * kk + 1][2], s[2 * kk + 1][3]);
        pb[kk] = __builtin_bit_cast(bf16x8_t, w); }
    const unsigned vb = (unsigned)(size_t)vt + (unsigned)((4 * q + (r >> 2)) * AT_KS + 8 * (r & 3));
#pragma unroll
    for (int db = 0; db < 4; ++db) st.o[db] = st.o[db] * alpha;
#pragma unroll
    for (int kk = 0; kk < 2; ++kk) { bf16x4_t l0, l1, l2, l3, h0, h1, h2, h3; const unsigned va = vb + (unsigned)(kk * 32 * AT_KS);
        asm volatile("ds_read_b64_tr_b16 %0, %8\n\tds_read_b64_tr_b16 %1, %8 offset:32\n\tds_read_b64_tr_b16 %2, %8 offset:64\n\tds_read_b64_tr_b16 %3, %8 offset:96\n\t"
                     "ds_read_b64_tr_b16 %4, %8 offset:2304\n\tds_read_b64_tr_b16 %5, %8 offset:2336\n\tds_read_b64_tr_b16 %6, %8 offset:2368\n\tds_read_b64_tr_b16 %7, %8 offset:2400\n\ts_waitcnt lgkmcnt(0)"
                     : "=&v"(l0), "=&v"(l1), "=&v"(l2), "=&v"(l3), "=&v"(h0), "=&v"(h1), "=&v"(h2), "=&v"(h3) : "v"(va) : "memory");
        st.o[0] = __builtin_amdgcn_mfma_f32_16x16x32_bf16(__builtin_shufflevector(l0, h0, 0, 1, 2, 3, 4, 5, 6, 7), pb[kk], st.o[0], 0, 0, 0);
        st.o[1] = __builtin_amdgcn_mfma_f32_16x16x32_bf16(__builtin_shufflevector(l1, h1, 0, 1, 2, 3, 4, 5, 6, 7), pb[kk], st.o[1], 0, 0, 0);
        st.o[2] = __builtin_amdgcn_mfma_f32_16x16x32_bf16(__builtin_shufflevector(l2, h2, 0, 1, 2, 3, 4, 5, 6, 7), pb[kk], st.o[2], 0, 0, 0);
        st.o[3] = __builtin_amdgcn_mfma_f32_16x16x32_bf16(__builtin_shufflevector(l3, h3, 0, 1, 2, 3, 4, 5, 6, 7), pb[kk], st.o[3], 0, 0, 0); }
}
__device__ __forceinline__ void attn_stage_store(LAS unsigned char* buf, int tid, const uint4& kc, const uint4& vc) {
    const int key = tid >> 3, c = tid & 7;
    *(LAS u32x4_t*)(buf + key * AT_KS + c * 16) = (u32x4_t){kc.x, kc.y, kc.z, kc.w};
    *(LAS u32x4_t*)(buf + AT_KBYTES + key * AT_KS + c * 16) = (u32x4_t){vc.x, vc.y, vc.z, vc.w};
}
__device__ __forceinline__ int next_unit(unsigned* ctr, volatile LAS unsigned* slot, int tid) {
    __syncthreads();
    if (tid == 0) *slot = __hip_atomic_fetch_add(ctr, 1u, __ATOMIC_RELAXED, __HIP_MEMORY_SCOPE_AGENT);
    __syncthreads();
    return (int)*slot;
}
__device__ __forceinline__ void selwin_unit(const Params& p, int cur, int bg, int wv, LAS unsigned char* lds) {
    int tid = wv * 64 + mk_lane(); asm volatile("" : "+v"(tid));
    const int wid = tid >> 6, lane = tid & 63, r = lane & 15, q = lane >> 4;
    const bf16_t* P = WSP(bf16_t, p.oP); const unsigned* SELM = WSP(unsigned, p.oSELM); bf16_t* O = WSP(bf16_t, p.oO);
    const int nqb = (int)(p.S >> 6), units = (int)(p.B * 2) * nqb;
    (void)units;
    {   const int b = bg >> 1, g = bg & 1;
        const long long t0 = (long long)b * p.S + (long long)cur * 64;
        const int hd = 2 * g + (wid >> 2); const int tq = (wid & 3) * 16 + r; const long long tok = t0 + tq; const int sq = cur * 64 + tq;
        bf16x8_t bq[2];
#pragma unroll
        for (int ks = 0; ks < 2; ++ks) bq[ks] = *(const bf16x8_t*)(P + tok * PW + C_Q + hd * 64 + 32 * ks + 8 * q);
        uint2 pvp[4];
#pragma unroll
        for (int db = 0; db < 4; ++db) pvp[db] = *(const uint2*)(O + tok * 1024 + hd * 64 + 16 * db + 4 * q);
        const bf16_t gl1 = P[tok * PW + C_NG + hd * 3 + 1], gl2 = P[tok * PW + C_NG + hd * 3 + 2];
        unsigned un = SELM[(t0 + lane) * 2 + g];
#pragma unroll
        for (int o = 32; o > 0; o >>= 1) un |= __shfl_xor(un, o);
        un = __builtin_amdgcn_readfirstlane(un);
        const unsigned mymask = SELM[tok * 2 + g];
        const int wlo = cur - 8 > 0 ? cur - 8 : 0, nwin = cur - wlo + 1, nsel = __builtin_popcount(un), ntile = nwin + nsel;
        AttnState sw, ss; attn_init(sw); attn_init(ss);
        int pf = 0; unsigned prem = un;
#define SW_FETCH(kc_, vc_, blk_, win_) do { blk_ = 0; win_ = false; if (pf < ntile) { if (pf < nwin) { blk_ = wlo + pf; win_ = true; } else { blk_ = __builtin_ctz(prem); prem &= prem - 1; } ++pf; \
            const long long kr_ = ((long long)b * p.S + (long long)blk_ * 64 + (tid >> 3)) * PW + g * 64 + (tid & 7) * 8; kc_ = *(const uint4*)(P + kr_ + (win_ ? C_KW : C_KS)); vc_ = *(const uint4*)(P + kr_ + (win_ ? C_VW : C_VS)); } } while (0)
#define SW_COMPUTE(buf_, cb_, win_) do { const LAS unsigned char* bf_ = (buf_); const int cbk = (cb_), kbase = cbk * 64 + 4 * q; \
            if (win_) { if (cbk == cur || cbk == cur - 8) attn_tile<true>(bf_, bf_ + AT_KBYTES, bq, sw, lane, [&](int kb, int j) { const int key = kbase + 16 * kb + j; return key <= sq && key > sq - 512; }); \
                        else attn_tile<false>(bf_, bf_ + AT_KBYTES, bq, sw, lane, [](int, int) { return true; }); } \
            else { const bool on = (mymask >> cbk) & 1u; \
                if (__builtin_amdgcn_ballot_w64(on) != 0ull) { \
                    if (cbk == cur) attn_tile<true>(bf_, bf_ + AT_KBYTES, bq, ss, lane, [&](int kb, int j) { const int key = kbase + 16 * kb + j; return on && key <= sq; }); \
                    else attn_tile<true>(bf_, bf_ + AT_KBYTES, bq, ss, lane, [&](int, int) { return on; }); } } } while (0)
        uint4 kA, vA, kB, vB; int cb, nb, b2, b3; bool cw, nw_, w2, w3;
        SW_FETCH(kA, vA, cb, cw);
        attn_stage_store(lds, tid, kA, vA);
        SW_FETCH(kA, vA, nb, nw_);
        __syncthreads();
        for (int i = 0; i < ntile; i += 2) {
            SW_FETCH(kB, vB, b2, w2);
            SW_COMPUTE(lds, cb, cw);
            if (i + 1 < ntile) attn_stage_store(lds + AT_BUF, tid, kA, vA);
            __syncthreads();
            if (i + 1 >= ntile) break;
            SW_FETCH(kA, vA, b3, w3);
            SW_COMPUTE(lds + AT_BUF, nb, nw_);
            if (i + 2 < ntile) attn_stage_store(lds, tid, kB, vB);
            __syncthreads();
            cb = b2; cw = w2; nb = b3; nw_ = w3;
        }
#undef SW_FETCH
#undef SW_COMPUTE
        const float g1 = sigmoidf_(bf2f(gl1)) / ss.l, g2 = sigmoidf_(bf2f(gl2)) / sw.l;
#pragma unroll
        for (int db = 0; db < 4; ++db) { bf16_t* od = O + tok * 1024 + hd * 64 + 16 * db + 4 * q; const uint2 pv = pvp[db];
            const float r0 = u2f(pv.x << 16) + g1 * ss.o[db][0] + g2 * sw.o[db][0], r1 = u2f(pv.x & 0xffff0000u) + g1 * ss.o[db][1] + g2 * sw.o[db][1];
            const float r2 = u2f(pv.y << 16) + g1 * ss.o[db][2] + g2 * sw.o[db][2], r3 = u2f(pv.y & 0xffff0000u) + g1 * ss.o[db][3] + g2 * sw.o[db][3];
            uint2 w; w.x = pack2bf(r0, r1); w.y = pack2bf(r2, r3); *(uint2*)od = w; }
    }
}
__device__ __forceinline__ void ph_ca_attn_mfma(const Params& p, int l, int wv, LAS unsigned char* lds, int gC, int gG) {
    int tid = wv * 64 + mk_lane(); asm volatile("" : "+v"(tid));
    const int wid = tid >> 6, lane = tid & 63, r = lane & 15, q = lane >> 4;
    const bf16_t* CQ = WSP(bf16_t, p.oCQ); const bf16_t* KV = WSP(bf16_t, p.oKV) + (long long)l * 512; bf16_t* AO = WSP(bf16_t, p.oCAO);
    const int nqb = (int)(p.S >> 7), npair = (int)(p.B * 4), units = npair * nqb;
    const int per = (units + gG - 1) / gG, u0 = gC * per, u1 = (u0 + per < units) ? u0 + per : units;
    int staged = -1;
    for (int u = u0; u < u1; ++u) { const int qb = u % nqb, bh = u / nqb, b = bh >> 2, hd = bh & 3;
        if (bh != staged) { staged = bh; __syncthreads();
#pragma unroll
            for (int i = 0; i < 4; ++i) { const long long kr = ((long long)b * 256 + i * 64 + (tid >> 3)) * 1024 + hd * 64 + (tid & 7) * 8; const uint4 kc = *(const uint4*)(KV + kr), vc = *(const uint4*)(KV + kr + 256); attn_stage_store(lds + i * AT_BUF, tid, kc, vc); }
            __syncthreads(); }
        const long long tok = (long long)b * p.S + (long long)qb * 128 + wid * 16 + r;
        bf16x8_t bq[2];
#pragma unroll
        for (int ks = 0; ks < 2; ++ks) bq[ks] = *(const bf16x8_t*)(CQ + tok * 256 + hd * 64 + 32 * ks + 8 * q);
        AttnState st; attn_init(st);
#pragma unroll
        for (int i = 0; i < 4; ++i) { const LAS unsigned char* buf = lds + i * AT_BUF; attn_tile<false>(buf, buf + AT_KBYTES, bq, st, lane, [](int, int) { return true; }); }
        const float il = 1.0f / st.l;
#pragma unroll
        for (int db = 0; db < 4; ++db) { uint2 w; w.x = pack2bf(st.o[db][0] * il, st.o[db][1] * il); w.y = pack2bf(st.o[db][2] * il, st.o[db][3] * il); *(uint2*)(AO + tok * 256 + hd * 64 + 16 * db + 4 * q) = w; }
    }
}
#endif
#ifndef CPU_EMU
constexpr int CM_KBYTES = 128 * AT_KS, CM_VBYTES = 128 * AT_KS;
__device__ __forceinline__ void better2(float& v, int& i, float ov, int oi) { if (ov > v || (ov == v && oi < i)) { v = ov; i = oi; } }
__device__ __forceinline__ void cmp_unit(const Params& p, int cur, int bg, int wv, LAS unsigned char* lds) {
    int tid = wv * 64 + mk_lane(); asm volatile("" : "+v"(tid));
    const int lane = tid & 63, r = lane & 15, q = lane >> 4;
    const bf16_t* P = WSP(bf16_t, p.oP); const bf16_t* KCB = WSP(bf16_t, p.oKCMP); const bf16_t* VCB = WSP(bf16_t, p.oVCMP); unsigned* SELM = WSP(unsigned, p.oSELM); bf16_t* O = WSP(bf16_t, p.oO);
    LAS unsigned char* kt = lds; LAS unsigned char* vt = lds + CM_KBYTES;
    {   const int b = bg >> 1, g = bg & 1;
        {
#pragma unroll
            for (int i = 0; i < 2; ++i) { const int ch = tid + 512 * i, key = ch >> 3, c = ch & 7;
                const uint4 kc = *(const uint4*)(KCB + ((long long)bg * 128 + key) * 64 + c * 8), vc = *(const uint4*)(VCB + ((long long)bg * 128 + key) * 64 + c * 8);
                *(LAS u32x4_t*)(kt + key * AT_KS + c * 16) = (u32x4_t){kc.x, kc.y, kc.z, kc.w}; *(LAS u32x4_t*)(vt + key * AT_KS + c * 16) = (u32x4_t){vc.x, vc.y, vc.z, vc.w}; } }
        __syncthreads();
        const int tl = 8 * wv + (r >> 1), hd = 2 * g + (r & 1); const long long tok = (long long)b * p.S + (long long)cur * 64 + tl; const int sq = cur * 64 + tl;
        bf16x8_t bq[2];
#pragma unroll
        for (int ks = 0; ks < 2; ++ks) bq[ks] = *(const bf16x8_t*)(P + tok * PW + C_Q + hd * 64 + 32 * ks + 8 * q);
        const int nv = sq >= 31 ? (sq - 31) / 16 + 1 : 0;
        const int sqw = cur * 64 + 8 * wv + 7, nvw = sqw >= 31 ? (sqw - 31) / 16 + 1 : 0, nkb = (nvw + 15) >> 4;
        f32x4_t s[8];
#pragma unroll
        for (int kb = 0; kb < 8; ++kb) { s[kb] = (f32x4_t){0.f, 0.f, 0.f, 0.f};
            if (kb < nkb) {
#pragma unroll
                for (int ks = 0; ks < 2; ++ks) { const bf16x8_t a = *(const LAS bf16x8_t*)(kt + (16 * kb + r) * AT_KS + (32 * ks + 8 * q) * 2); s[kb] = __builtin_amdgcn_mfma_f32_16x16x32_bf16(a, bq[ks], s[kb], 0, 0, 0); } } }
        float mx = -1e30f;
#pragma unroll
        for (int kb = 0; kb < 8; ++kb)
#pragma unroll
            for (int j = 0; j < 4; ++j) { const bool ok = 16 * kb + 4 * q + j < nv; const float v = ok ? s[kb][j] : -1e30f; s[kb][j] = v; mx = fmaxf(mx, v); }
        mx = quad4_max(mx);
        float sum = 0.f;
#pragma unroll
        for (int kb = 0; kb < 8; ++kb)
#pragma unroll
            for (int j = 0; j < 4; ++j) { const float pv = s[kb][j] > -1e29f ? __builtin_amdgcn_exp2f(s[kb][j] - mx) : 0.f; s[kb][j] = pv; sum += pv; }
        sum = quad4_sum(sum);
        const float inv = nv > 0 ? 1.0f / sum : 0.f;
#pragma unroll
        for (int kb = 0; kb < 8; ++kb) s[kb] = s[kb] * inv;
        f32x4_t o[4];
#pragma unroll
        for (int db = 0; db < 4; ++db) o[db] = (f32x4_t){0.f, 0.f, 0.f, 0.f};
        const unsigned vb = (unsigned)(size_t)vt + (unsigned)((4 * q + (r >> 2)) * AT_KS + 8 * (r & 3));
#pragma unroll
        for (int kk = 0; kk < 4; ++kk) if (2 * kk < nkb) { u32x4_t w = (u32x4_t){pack2bf(s[2 * kk][0], s[2 * kk][1]), pack2bf(s[2 * kk][2], s[2 * kk][3]), pack2bf(s[2 * kk + 1][0], s[2 * kk + 1][1]), pack2bf(s[2 * kk + 1][2], s[2 * kk + 1][3])};
            const bf16x8_t pb = __builtin_bit_cast(bf16x8_t, w);
            bf16x4_t l0, l1, l2, l3, h0, h1, h2, h3; const unsigned va = vb + (unsigned)(kk * 32 * AT_KS);
            asm volatile("ds_read_b64_tr_b16 %0, %8\n\tds_read_b64_tr_b16 %1, %8 offset:32\n\tds_read_b64_tr_b16 %2, %8 offset:64\n\tds_read_b64_tr_b16 %3, %8 offset:96\n\t"
                         "ds_read_b64_tr_b16 %4, %8 offset:2304\n\tds_read_b64_tr_b16 %5, %8 offset:2336\n\tds_read_b64_tr_b16 %6, %8 offset:2368\n\tds_read_b64_tr_b16 %7, %8 offset:2400\n\ts_waitcnt lgkmcnt(0)"
                         : "=&v"(l0), "=&v"(l1), "=&v"(l2), "=&v"(l3), "=&v"(h0), "=&v"(h1), "=&v"(h2), "=&v"(h3) : "v"(va) : "memory");
            o[0] = __builtin_amdgcn_mfma_f32_16x16x32_bf16(__builtin_shufflevector(l0, h0, 0, 1, 2, 3, 4, 5, 6, 7), pb, o[0], 0, 0, 0);
            o[1] = __builtin_amdgcn_mfma_f32_16x16x32_bf16(__builtin_shufflevector(l1, h1, 0, 1, 2, 3, 4, 5, 6, 7), pb, o[1], 0, 0, 0);
            o[2] = __builtin_amdgcn_mfma_f32_16x16x32_bf16(__builtin_shufflevector(l2, h2, 0, 1, 2, 3, 4, 5, 6, 7), pb, o[2], 0, 0, 0);
            o[3] = __builtin_amdgcn_mfma_f32_16x16x32_bf16(__builtin_shufflevector(l3, h3, 0, 1, 2, 3, 4, 5, 6, 7), pb, o[3], 0, 0, 0); }
        const float g0 = sigmoidf_(bf2f(P[tok * PW + C_NG + hd * 3]));
#pragma unroll
        for (int db = 0; db < 4; ++db) { uint2 w; w.x = pack2bf(g0 * o[db][0], g0 * o[db][1]); w.y = pack2bf(g0 * o[db][2], g0 * o[db][3]); *(uint2*)(O + tok * 1024 + hd * 64 + 16 * db + 4 * q) = w; }
        unsigned mask;
        if (cur < 8) mask = (2u << cur) - 1u;
        else {
            float imp[8], tcar[8];
#pragma unroll
            for (int kb = 0; kb < 8; ++kb) { imp[kb] = s[kb][0] + s[kb][1] + s[kb][2] + 0.5f * s[kb][3]; tcar[kb] = __shfl(0.5f * s[kb][3], (lane + 48) & 63); }
#pragma unroll
            for (int kb = 0; kb < 8; ++kb) { const float cin = q >= 1 ? tcar[kb] : (kb >= 1 ? tcar[kb >= 1 ? kb - 1 : 0] : 0.f); imp[kb] += cin; imp[kb] += dpp_mov1(imp[kb]); }
            mask = 1u | (1u << cur) | (1u << (cur - 1));
#pragma unroll
            for (int kb = 0; kb < 8; ++kb) { const int jj = 4 * kb + q; if (!(jj >= 1 && jj <= cur - 2)) imp[kb] = -3e38f; }
            for (int rd = 0; rd < 5; ++rd) { float bv = -3e38f; int bi = 1 << 20;
#pragma unroll
                for (int kb = 0; kb < 8; ++kb) if (imp[kb] > bv) { bv = imp[kb]; bi = 4 * kb + q; }
                {
                    float av = bv, cv = bv; int ai = bi, ci = bi;
                    asm volatile("s_nop 1\n\tv_permlane16_swap_b32 %0, %1\n\tv_permlane16_swap_b32 %2, %3" : "+v"(av), "+v"(cv), "+v"(ai), "+v"(ci));
                    bv = av; bi = ai; better2(bv, bi, cv, ci); av = bv; cv = bv; ai = bi; ci = bi;
                    asm volatile("s_nop 1\n\tv_permlane32_swap_b32 %0, %1\n\tv_permlane32_swap_b32 %2, %3" : "+v"(av), "+v"(cv), "+v"(ai), "+v"(ci));
                    bv = av; bi = ai; better2(bv, bi, cv, ci); }
                mask |= 1u << bi;
#pragma unroll
                for (int kb = 0; kb < 8; ++kb) if (bi == 4 * kb + q) imp[kb] = -3e38f; }
        }
        if (q == 0 && (r & 1) == 0) SELM[tok * 2 + g] = mask;
    }
}
#endif
#ifndef CPU_EMU
typedef float f32x2_t __attribute__((ext_vector_type(2)));
template <int CTRL> __device__ __forceinline__ float dpp_mov(float x) { return __builtin_bit_cast(float, __builtin_amdgcn_update_dpp(0, __builtin_bit_cast(int, x), CTRL, 0xF, 0xF, true)); }
__device__ __forceinline__ float sum8(float x) { x += dpp_mov<0xB1>(x); x += dpp_mov<0x4E>(x); x += dpp_mov<0x141>(x); return x; }
__device__ __forceinline__ float sum16s(float x) { x += __shfl_xor(x, 1); x += __shfl_xor(x, 2); x += __shfl_xor(x, 4); x += __shfl_xor(x, 8); return x; }
constexpr int SC_CH = 32;
constexpr int RW_STEP = 384, RW_BUF = SC_CH * RW_STEP * 4;
constexpr int GL_STEP = 160, GL_BUF = SC_CH * GL_STEP * 4;
__device__ __forceinline__ void cvt8(const uint4& w, float (&f)[8]) { f[0] = u2f(w.x << 16); f[1] = u2f(w.x & 0xffff0000u); f[2] = u2f(w.y << 16); f[3] = u2f(w.y & 0xffff0000u); f[4] = u2f(w.z << 16); f[5] = u2f(w.z & 0xffff0000u); f[6] = u2f(w.w << 16); f[7] = u2f(w.w & 0xffff0000u); }

__device__ __forceinline__ void rwkv_chain(const Params& p, int l, int ch, int wv, LAS unsigned char* lds) {
    int tid = wv * 64 + mk_lane(); asm volatile("" : "+v"(tid));
    const int row = tid >> 3, cg = tid & 7; const long long b = ch >> 2; const int h = ch & 3;
    const float* RWW = WSP(float, p.oRWW); const bf16_t* RWX = WSP(bf16_t, p.oRWX); bf16_t* O = WSP(bf16_t, p.oO); const float* lng = p.in[I_RW_LN] + l * 256 + h * 64; const float* rkw = p.in[I_RW_RK] + l * 256 + h * 64;
    LAS float* YB = (LAS float*)(lds + 2 * RW_BUF);
    const long long tb = b * p.S; const int nch = (int)(p.S / SC_CH);
    float4 gw;
    uint4 gx0, gx1, gx2;
#define RW_GLOAD1(idx_, dst_) do { const int idx = (idx_); if (idx < 1280) { const int step = idx / 40, rem = idx % 40, vec = rem >> 3, c8 = rem & 7; dst_ = *(const uint4*)(RWX + (t0_ + step) * 1280 + vec * 256 + h * 64 + 8 * c8); } } while (0)
#define RW_GLOAD(c_) do { const long long t0_ = tb + (long long)(c_) * SC_CH; gw = *(const float4*)(RWW + (t0_ + (tid >> 4)) * 256 + h * 64 + 4 * (tid & 15)); RW_GLOAD1(tid, gx0); RW_GLOAD1(tid + 512, gx1); RW_GLOAD1(tid + 1024, gx2); } while (0)
#define RW_SSTORE1(idx_, src_) do { const int idx = (idx_); if (idx < 1280) { const int step = idx / 40, rem = idx % 40, vec = rem >> 3, c8 = rem & 7; \
        const int slot = vec == 0 ? 4 : (vec == 1 ? 3 : (vec == 2 ? 5 : (vec == 3 ? 1 : 2))); float f[8]; cvt8(src_, f); LAS float* d = B_ + step * RW_STEP + slot * 64 + 8 * c8; \
        *(LAS f32x4_t*)d = (f32x4_t){f[0], f[1], f[2], f[3]}; *(LAS f32x4_t*)(d + 4) = (f32x4_t){f[4], f[5], f[6], f[7]}; } } while (0)
#define RW_SSTORE(buf_) do { LAS float* B_ = (LAS float*)(lds + (buf_) * RW_BUF); *(LAS f32x4_t*)(B_ + (tid >> 4) * RW_STEP + 4 * (tid & 15)) = (f32x4_t){gw.x, gw.y, gw.z, gw.w}; \
        RW_SSTORE1(tid, gx0); RW_SSTORE1(tid + 512, gx1); RW_SSTORE1(tid + 1024, gx2); } while (0)
    f32x2_t st[4];
#pragma unroll
    for (int i = 0; i < 4; ++i) st[i] = (f32x2_t){0.f, 0.f};
    RW_GLOAD(0); RW_SSTORE(0); __syncthreads();
    for (int c = 0; c < nch; ++c) {
        if (c + 1 < nch) RW_GLOAD(c + 1);
        const LAS float* B = (const LAS float*)(lds + (c & 1) * RW_BUF);
        for (int s = 0; s < SC_CH; ++s) { const LAS float* x = B + s * RW_STEP + 8 * cg;
            f32x2_t w[4], kk[4], bb[4], k[4], r[4];
#pragma unroll
            for (int i = 0; i < 2; ++i) { const f32x4_t a0 = *(const LAS f32x4_t*)(x + 4 * i), a1 = *(const LAS f32x4_t*)(x + 64 + 4 * i), a2 = *(const LAS f32x4_t*)(x + 128 + 4 * i), a3 = *(const LAS f32x4_t*)(x + 192 + 4 * i), a4 = *(const LAS f32x4_t*)(x + 256 + 4 * i);
                w[2 * i] = (f32x2_t){a0[0], a0[1]}; w[2 * i + 1] = (f32x2_t){a0[2], a0[3]}; kk[2 * i] = (f32x2_t){a1[0], a1[1]}; kk[2 * i + 1] = (f32x2_t){a1[2], a1[3]};
                bb[2 * i] = (f32x2_t){a2[0], a2[1]}; bb[2 * i + 1] = (f32x2_t){a2[2], a2[3]}; k[2 * i] = (f32x2_t){a3[0], a3[1]}; k[2 * i + 1] = (f32x2_t){a3[2], a3[3]};
                r[2 * i] = (f32x2_t){a4[0], a4[1]}; r[2 * i + 1] = (f32x2_t){a4[2], a4[3]}; }
            const float v = B[s * RW_STEP + 320 + row];
            f32x2_t a = st[0] * kk[0] + st[1] * kk[1]; a += st[2] * kk[2] + st[3] * kk[3];
            const float skk = sum8(a[0] + a[1]);
            f32x2_t y2 = (f32x2_t){0.f, 0.f};
#pragma unroll
            for (int i = 0; i < 4; ++i) { st[i] = st[i] * w[i] - bb[i] * skk + k[i] * v; y2 += st[i] * r[i]; }
            const float y = sum8(y2[0] + y2[1]);
            if (cg == 0) YB[s * 64 + row] = y; }
        __syncthreads();
        {
            const int s = tid >> 4, v0 = 4 * (tid & 15); const long long t = tb + (long long)c * SC_CH + s;
            const f32x4_t y = *(const LAS f32x4_t*)(YB + s * 64 + v0); const f32x4_t vv = *(const LAS f32x4_t*)(B + s * RW_STEP + 320 + v0);
            const float mean = sum16s(y[0] + y[1] + y[2] + y[3]) * (1.0f / 64.0f);
            const float d0 = y[0] - mean, d1 = y[1] - mean, d2 = y[2] - mean, d3 = y[3] - mean;
            const float var = sum16s(d0 * d0 + d1 * d1 + d2 * d2 + d3 * d3) * (1.0f / 64.0f), rstd = rsqrtf(var + 64e-5f);
            const f32x4_t rr = *(const LAS f32x4_t*)(B + s * RW_STEP + 256 + v0), kq = *(const LAS f32x4_t*)(B + s * RW_STEP + 192 + v0); const float4 rw4 = *(const float4*)(rkw + v0);
            const float rk = sum16s(rr[0] * kq[0] * rw4.x + rr[1] * kq[1] * rw4.y + rr[2] * kq[2] * rw4.z + rr[3] * kq[3] * rw4.w);
            bf16_t* o = O + t * 1024 + 512 + h * 64 + v0; const uint2 g = *(const uint2*)o; const float4 ln = *(const float4*)(lng + v0);
            const float r0 = (d0 * rstd * ln.x + rk * vv[0]) * u2f(g.x << 16), r1 = (d1 * rstd * ln.y + rk * vv[1]) * u2f(g.x & 0xffff0000u);
            const float r2 = (d2 * rstd * ln.z + rk * vv[2]) * u2f(g.y << 16), r3 = (d3 * rstd * ln.w + rk * vv[3]) * u2f(g.y & 0xffff0000u);
            uint2 w; w.x = pack2bf(r0, r1); w.y = pack2bf(r2, r3); *(uint2*)o = w; }
        if (c + 1 < nch) RW_SSTORE((c + 1) & 1);
        __syncthreads();
    }
}
__device__ __forceinline__ void gla_chain(const Params& p, int l, int ch, int wv, LAS unsigned char* lds) {
    int tid = wv * 64 + mk_lane(); asm volatile("" : "+v"(tid));
    const int vc = tid >> 3, kg = tid & 7; const long long b = ch >> 2; const int h = ch & 3;
    const bf16_t* P = WSP(bf16_t, p.oP); const float* GA = WSP(float, p.oGA); bf16_t* O = WSP(bf16_t, p.oO); const float* ng = p.in[I_GLA_NORM] + l * 64;
    LAS float* OB = (LAS float*)(lds + 2 * GL_BUF);
    const long long tb = b * p.S; const int nch = (int)(p.S / SC_CH);
    float4 ga; uint4 g1, g2;
#define GL_GLOAD(c_) do { const long long t0_ = tb + (long long)(c_) * SC_CH; \
        if (tid < 256) { const int step = tid >> 3, c4 = tid & 7; ga = *(const float4*)(GA + (t0_ + step) * 128 + h * 32 + 4 * c4); g1 = *(const uint4*)(P + (t0_ + step) * PW + C_GLA + 256 + h * 64 + 8 * c4); } \
        else { const int idx = tid - 256, step = idx >> 3, vec = (idx >> 2) & 1, c8 = idx & 3; g2 = *(const uint4*)(P + (t0_ + step) * PW + C_GLA + vec * 128 + h * 32 + 8 * c8); } } while (0)
#define GL_SSTORE(buf_) do { LAS float* B_ = (LAS float*)(lds + (buf_) * GL_BUF); float f[8]; \
        if (tid < 256) { const int step = tid >> 3, c4 = tid & 7; *(LAS f32x4_t*)(B_ + step * GL_STEP + 4 * c4) = (f32x4_t){ga.x, ga.y, ga.z, ga.w}; \
            cvt8(g1, f); LAS float* d = B_ + step * GL_STEP + 96 + 8 * c4; *(LAS f32x4_t*)d = (f32x4_t){f[0], f[1], f[2], f[3]}; *(LAS f32x4_t*)(d + 4) = (f32x4_t){f[4], f[5], f[6], f[7]}; } \
        else { const int idx = tid - 256, step = idx >> 3, vec = (idx >> 2) & 1, c8 = idx & 3; \
            cvt8(g2, f); LAS float* d = B_ + step * GL_STEP + (vec == 0 ? 64 : 32) + 8 * c8; *(LAS f32x4_t*)d = (f32x4_t){f[0], f[1], f[2], f[3]}; *(LAS f32x4_t*)(d + 4) = (f32x4_t){f[4], f[5], f[6], f[7]}; } } while (0)
    f32x4_t st = (f32x4_t){0.f, 0.f, 0.f, 0.f};
    GL_GLOAD(0); GL_SSTORE(0); __syncthreads();
    for (int c = 0; c < nch; ++c) {
        if (c + 1 < nch) GL_GLOAD(c + 1);
        const LAS float* B = (const LAS float*)(lds + (c & 1) * GL_BUF);
        for (int s = 0; s < SC_CH; ++s) { const LAS float* x = B + s * GL_STEP + 4 * kg;
            const f32x4_t a = *(const LAS f32x4_t*)x, k = *(const LAS f32x4_t*)(x + 32), qv = *(const LAS f32x4_t*)(x + 64); const float v = B[s * GL_STEP + 96 + vc];
            st = st * a + k * v; const f32x4_t pq = st * qv;
            const float o = sum8((pq[0] + pq[1]) + (pq[2] + pq[3]));
            if (kg == 0) OB[s * 64 + vc] = o * 0.17677669529663687f; }
        __syncthreads();
        {   const int s = tid >> 4, v0 = 4 * (tid & 15); const long long t = tb + (long long)c * SC_CH + s;
            const f32x4_t o = *(const LAS f32x4_t*)(OB + s * 64 + v0);
            const float ms = sum16s(o[0] * o[0] + o[1] * o[1] + o[2] * o[2] + o[3] * o[3]) * (1.0f / 64.0f), rs = rsqrtf(ms + 1e-6f);
            bf16_t* d = O + t * 1024 + 768 + h * 64 + v0; const uint2 g = *(const uint2*)d; const float4 n4 = *(const float4*)(ng + v0);
            uint2 w; w.x = pack2bf(o[0] * rs * n4.x * u2f(g.x << 16), o[1] * rs * n4.y * u2f(g.x & 0xffff0000u)); w.y = pack2bf(o[2] * rs * n4.z * u2f(g.y << 16), o[3] * rs * n4.w * u2f(g.y & 0xffff0000u)); *(uint2*)d = w; }
        if (c + 1 < nch) GL_SSTORE((c + 1) & 1);
        __syncthreads();
    }
}
struct RwFrags { bf16x8_t w[2], a[2], v[2], g[2][2]; };
__device__ __forceinline__ void rwkv_load_frags(const LAS unsigned* wl, int wv, RwFrags& fr) {
    const int lane = mk_lane(), r = lane & 15, q = lane >> 4;
#pragma unroll
    for (int cb = 0; cb < 2; ++cb) { const LAS unsigned* c = wl + 32 * wv + 16 * cb + r;
#define RW_FRAG(dst, pbase) do { uint4 k_; k_.x = c[((pbase) + 4 * q) * 256]; k_.y = c[((pbase) + 4 * q + 1) * 256]; k_.z = c[((pbase) + 4 * q + 2) * 256]; k_.w = c[((pbase) + 4 * q + 3) * 256]; dst = __builtin_bit_cast(bf16x8_t, k_); } while (0)
        RW_FRAG(fr.w[cb], 0); RW_FRAG(fr.a[cb], 16); RW_FRAG(fr.v[cb], 32); RW_FRAG(fr.g[cb][0], 48); RW_FRAG(fr.g[cb][1], 64);
#undef RW_FRAG
    }
}
__device__ __forceinline__ void rwkv_lowrank_mfma(int l, const RwFrags& fr, const LAS unsigned* FP, LAS float* Z, int wv) {
    const int lane = mk_lane(), r = lane & 15, q = lane >> 4; const f32x4_t z4 = (f32x4_t){0.f, 0.f, 0.f, 0.f};
#pragma unroll
    for (int tb = 0; tb < 2; ++tb) { const LAS unsigned* f = FP + (16 * tb + r) * 80 + 4 * q;
        const bf16x8_t fw = __builtin_bit_cast(bf16x8_t, *(const LAS u32x4_t*)(f)), fa = __builtin_bit_cast(bf16x8_t, *(const LAS u32x4_t*)(f + 16)), fv = __builtin_bit_cast(bf16x8_t, *(const LAS u32x4_t*)(f + 32)),
                       fg0 = __builtin_bit_cast(bf16x8_t, *(const LAS u32x4_t*)(f + 48)), fg1 = __builtin_bit_cast(bf16x8_t, *(const LAS u32x4_t*)(f + 64));
#pragma unroll
        for (int cb = 0; cb < 2; ++cb) { LAS float* z = Z + (16 * tb + r) * 256 + 32 * wv + 16 * cb + 4 * q;
            *(LAS f32x4_t*)(z) = __builtin_amdgcn_mfma_f32_16x16x32_bf16(fr.w[cb], fw, z4, 0, 0, 0);
            *(LAS f32x4_t*)(z + 1 * 32 * 256) = __builtin_amdgcn_mfma_f32_16x16x32_bf16(fr.a[cb], fa, z4, 0, 0, 0);
            if (l == 1) *(LAS f32x4_t*)(z + 2 * 32 * 256) = __builtin_amdgcn_mfma_f32_16x16x32_bf16(fr.v[cb], fv, z4, 0, 0, 0);
            *(LAS f32x4_t*)(z + 3 * 32 * 256) = __builtin_amdgcn_mfma_f32_16x16x32_bf16(fr.g[cb][1], fg1, __builtin_amdgcn_mfma_f32_16x16x32_bf16(fr.g[cb][0], fg0, z4, 0, 0, 0), 0, 0, 0); } }
}
__device__ __forceinline__ void pool_gpu(const Params& p, int l, int wv, LAS unsigned char* lds, int gC, int gG) {
    int tid = wv * 64 + mk_lane(); asm volatile("" : "+v"(tid)); const int lane = tid & 63, r = lane & 15, q = lane >> 4;
    const bf16_t* P = WSP(bf16_t, p.oP); bf16_t* O = WSP(bf16_t, p.oO);
    LAS float* wl = (LAS float*)lds;
    __syncthreads(); pool_fill_w(p, l, wl, tid, 512); __syncthreads();
    const int g = wv & 3, WIN = 2 << g;
    bf16x8_t wa[4][2];
#pragma unroll
    for (int db = 0; db < 4; ++db)
#pragma unroll
        for (int ks = 0; ks < 2; ++ks) { const LAS float* w = wl + g * 4096 + (32 * ks + 8 * q) * 64 + 16 * db + r; uint4 pk;
            pk.x = pk2bf(w[0], w[64]); pk.y = pk2bf(w[128], w[192]); pk.z = pk2bf(w[256], w[320]); pk.w = pk2bf(w[384], w[448]); wa[db][ks] = __builtin_bit_cast(bf16x8_t, pk); }
    float ps[4][4];
#pragma unroll
    for (int db = 0; db < 4; ++db) { const float4 f = *(const float4*)(p.in[I_POOL_SCALE] + (long long)l * 256 + g * 64 + 16 * db + 4 * q); ps[db][0] = f.x; ps[db][1] = f.y; ps[db][2] = f.z; ps[db][3] = f.w; }
    const long long ntile = p.T >> 4;
    for (long long tile = (long long)gC * 2 + (wv >> 2); tile < ntile; tile += (long long)gG * 2) { const long long t = tile * 16 + r; const int s = (int)t % (int)p.S; const int cnt = s + 1 < WIN ? s + 1 : WIN; const float inv = 1.0f / (float)cnt;
        bf16x8_t xb[2];
#pragma unroll
        for (int ks = 0; ks < 2; ++ks) { const bf16_t* src = P + t * PW + C_POOL + g * 64 + 32 * ks + 8 * q; float f0[8], dv[8]; ld8(src, f0);
#pragma unroll
            for (int j = 0; j < 8; ++j) dv[j] = f0[j];
            for (int k = 1; k < WIN; ++k) if (k < cnt) { float f[8]; ld8(src - (long long)k * PW, f);
#pragma unroll
                for (int j = 0; j < 8; ++j) dv[j] += f[j]; }
            uint4 pk; pk.x = pk2bf(dv[0] * inv - f0[0], dv[1] * inv - f0[1]); pk.y = pk2bf(dv[2] * inv - f0[2], dv[3] * inv - f0[3]); pk.z = pk2bf(dv[4] * inv - f0[4], dv[5] * inv - f0[5]); pk.w = pk2bf(dv[6] * inv - f0[6], dv[7] * inv - f0[7]);
            xb[ks] = __builtin_bit_cast(bf16x8_t, pk); }
#pragma unroll
        for (int db = 0; db < 4; ++db) { f32x4_t acc = (f32x4_t){0.f, 0.f, 0.f, 0.f};
            acc = __builtin_amdgcn_mfma_f32_16x16x32_bf16(wa[db][0], xb[0], acc, 0, 0, 0); acc = __builtin_amdgcn_mfma_f32_16x16x32_bf16(wa[db][1], xb[1], acc, 0, 0, 0);
            uint2 w; w.x = pk2bf(acc[0] * ps[db][0], acc[1] * ps[db][1]); w.y = pk2bf(acc[2] * ps[db][2], acc[3] * ps[db][3]);
            *(uint2*)(O + t * 1024 + 256 + g * 64 + 16 * db + 4 * q) = w; } }
    __syncthreads();
}
__device__ __forceinline__ void compress2_gpu(const Params& p, int l, int wv, LAS unsigned char* lds, int gC, int gG) {
    int tid = wv * 64 + mk_lane(); asm volatile("" : "+v"(tid)); const int lane = tid & 63;
    const bf16_t* UV = WSP(bf16_t, p.oUV); const float* CB = WSP(float, p.oCB) + l * 256; const float* w2 = p.in[I_CMP_W2] + (long long)l * 2 * 128 * 64; const float* R = WSP(float, p.oROPE);
    bf16_t* KC = WSP(bf16_t, p.oKCMP); bf16_t* VC = WSP(bf16_t, p.oVCMP);
    const long long hb = p.S / 16, gtid = (long long)gC * 512 + tid, gsz = (long long)gG * 512;
    LAS float* WL = (LAS float*)lds;
    __syncthreads();
    for (int i = tid; i < 2 * 128 * 64; i += 512) WL[i] = w2[i];
    for (long long i = gtid; i < p.B * 2 * (128 - p.NC) * 64; i += gsz) { const long long bgi = i / ((128 - p.NC) * 64), rem = i % ((128 - p.NC) * 64); KC[(bgi * 128 + p.NC) * 64 + rem] = 0; VC[(bgi * 128 + p.NC) * 64 + rem] = 0; }
    __syncthreads();
    const long long rows = p.B * p.NC * 4;
    for (long long row = (long long)gC * 8 + wv; row < rows; row += (long long)gG * 8) { const int j = (int)(row & 1), g = (int)((row >> 1) & 1); const long long bn = row >> 2, n = bn % p.NC, b = bn / p.NC;
        const bf16_t* u = UV + ((b * hb + n) * 4 + (2 * j + g)) * 256; const bf16_t* vv = u + 4 * 256 + 128; const float* cb = CB + j * 128;
        const float hv0 = gelu_tanhf_(bf2f(u[lane]) + bf2f(vv[lane]) + cb[lane]), hv1 = gelu_tanhf_(bf2f(u[64 + lane]) + bf2f(vv[64 + lane]) + cb[64 + lane]);
        const LAS float* w = WL + j * 8192 + lane; float a = 0.f;
#pragma unroll 16
        for (int f = 0; f < 64; ++f) a += __builtin_bit_cast(float, __builtin_amdgcn_readlane(__builtin_bit_cast(int, hv0), f)) * w[f * 64];
#pragma unroll 16
        for (int f = 0; f < 64; ++f) a += __builtin_bit_cast(float, __builtin_amdgcn_readlane(__builtin_bit_cast(int, hv1), f)) * w[(64 + f) * 64];
        if (j == 0) { const float pa = dpp_mov<0x128>(a);
            if (lane < 16) { const float* r = R + (b * p.S + n * 16 + 31) * 16; const float cs = r[lane & 7], sn = r[8 + (lane & 7)]; a = lane < 8 ? a * cs - pa * sn : a * cs + pa * sn; } }
        bf16_t* dst = (j == 0 ? KC : VC) + (((b * 2 + g) * 128) + n) * 64;
        dst[lane] = f2bf(a); }
}
__device__ __forceinline__ float sum16d(float x) { x += dpp_mov<0xB1>(x); x += dpp_mov<0x4E>(x); x += dpp_mov<0x141>(x); x += dpp_mov<0x140>(x); return x; }
__device__ __forceinline__ void norm_router_256(const Params& p, int l, long long r0, int wv, LAS unsigned char* lds) {
    int tid = wv * 64 + mk_lane(); asm volatile("" : "+v"(tid)); const int lane = tid & 63;
    const float* router = p.in[I_MOE_R]; const float* gain = p.in[I_NORM_FFN] + l * 1024;
    const bf16_t* X = WSP(bf16_t, p.oH) + r0 * 1024; bf16_t* D = (bf16_t*)p.out + r0 * 1024; int* TE = WSP(int, p.oTOKE) + r0 * 2; float* TW = WSP(float, p.oTOKW) + r0 * 2;
    LAS float* WL = (LAS float*)lds;
    __syncthreads();
    for (int i = tid; i < 8192; i += 512) WL[(i & 7) * 1024 + (i >> 3)] = router[i];
    __syncthreads();
#pragma nounroll
    for (int it = 0; it < 8; ++it) { const int rb = wv * 32 + it * 4;
        float v[4][16];
#pragma unroll
        for (int r = 0; r < 4; ++r)
#pragma unroll
            for (int j = 0; j < 4; ++j) { const uint2 w = *(const uint2*)(X + (long long)(rb + r) * 1024 + j * 256 + lane * 4);
                v[r][4 * j] = u2f(w.x << 16); v[r][4 * j + 1] = u2f(w.x & 0xffff0000u); v[r][4 * j + 2] = u2f(w.y << 16); v[r][4 * j + 3] = u2f(w.y & 0xffff0000u); }
#pragma unroll
        for (int r = 0; r < 4; ++r) { float ss = v[r][0] * v[r][0];
#pragma unroll
            for (int j = 1; j < 16; ++j) ss += v[r][j] * v[r][j];
            ss = wave_sum(ss); const float rs = rsqrtf(ss * (1.0f / 1024.0f) + 1e-6f);
#pragma unroll
            for (int j = 0; j < 4; ++j) { const float4 f = *(const float4*)(gain + j * 256 + lane * 4);
                v[r][4 * j] *= rs * f.x; v[r][4 * j + 1] *= rs * f.y; v[r][4 * j + 2] *= rs * f.z; v[r][4 * j + 3] *= rs * f.w;
                uint2 w; w.x = pk2bf(v[r][4 * j], v[r][4 * j + 1]); w.y = pk2bf(v[r][4 * j + 2], v[r][4 * j + 3]); *(uint2*)(D + (long long)(rb + r) * 1024 + j * 256 + lane * 4) = w; } }
        float acc[32];
#pragma unroll
        for (int j = 0; j < 4; ++j)
#pragma unroll
            for (int e = 0; e < 8; ++e) { const f32x4_t w = *(const LAS f32x4_t*)(WL + e * 1024 + j * 256 + lane * 4);
#pragma unroll
                for (int r = 0; r < 4; ++r) { const float t = (v[r][4 * j] * w[0] + v[r][4 * j + 1] * w[1]) + (v[r][4 * j + 2] * w[2] + v[r][4 * j + 3] * w[3]); acc[r * 8 + e] = j == 0 ? t : acc[r * 8 + e] + t; } }
        float x16[16];
#pragma unroll
        for (int i = 0; i < 16; ++i) { float a = acc[i], b = acc[i + 16]; asm("s_nop 1\n\tv_permlane32_swap_b32 %0, %1" : "+v"(a), "+v"(b)); x16[i] = a + b; }
        const bool hi16 = (lane & 16) != 0; float lg[8];
#pragma unroll
        for (int i = 0; i < 8; ++i) { const float send = hi16 ? x16[i] : x16[i + 8], keep = hi16 ? x16[i + 8] : x16[i]; float a = send, b = send; asm("s_nop 1\n\tv_permlane16_swap_b32 %0, %1" : "+v"(a), "+v"(b));
            lg[i] = sum16d(keep + u2f(f2u(a) ^ f2u(b) ^ f2u(send))); }
        int i0 = 0; float v0 = lg[0];
#pragma unroll
        for (int e = 1; e < 8; ++e) if (lg[e] > v0) { v0 = lg[e]; i0 = e; }
        int i1 = -1; float v1 = -3e38f;
#pragma unroll
        for (int e = 0; e < 8; ++e) if (e != i0 && lg[e] > v1) { v1 = lg[e]; i1 = e; }
        const float w0 = 1.0f / (1.0f + expf(v1 - v0));
        if ((lane & 15) == 0) { const int rr = rb + (lane >> 4); TE[rr * 2] = i0; TE[rr * 2 + 1] = i1; TW[rr * 2] = w0; TW[rr * 2 + 1] = 1.0f - w0; } }
}
constexpr int PC_GL0 = 2 * RW_BUF + 8192, PC_OB = PC_GL0 + 2 * GL_BUF, PC_LDS = PC_OB + 8192;
__device__ __forceinline__ void pair_chain(const Params& p, int l, int ch, int wv, LAS unsigned char* lds) {
    int tid = wv * 64 + mk_lane(); asm volatile("" : "+v"(tid));
    const long long b = ch >> 2; const int h = ch & 3; const long long tb = b * p.S; const int nch = (int)(p.S / SC_CH);
    bf16_t* O = WSP(bf16_t, p.oO);
    if (wv < 4) {
        const int rp = tid >> 3, cg = tid & 7;
        const float* RWW = WSP(float, p.oRWW); const bf16_t* RWX = WSP(bf16_t, p.oRWX); const float* lng = p.in[I_RW_LN] + l * 256 + h * 64; const float* rkw = p.in[I_RW_RK] + l * 256 + h * 64;
        LAS float* YB = (LAS float*)(lds + 2 * RW_BUF);
        float4 gw0, gw1; uint4 gx0, gx1, gx2, gx3, gx4;
#define PR_GLOAD1(idx_, dst_) do { const int idx = (idx_); const int step = idx / 40, rem = idx % 40, vec = rem >> 3, c8 = rem & 7; dst_ = *(const uint4*)(RWX + (t0_ + step) * 1280 + vec * 256 + h * 64 + 8 * c8); } while (0)
#define PR_GLOAD(c_) do { const long long t0_ = tb + (long long)(c_) * SC_CH; gw0 = *(const float4*)(RWW + (t0_ + (tid >> 4)) * 256 + h * 64 + 4 * (tid & 15)); gw1 = *(const float4*)(RWW + (t0_ + 16 + (tid >> 4)) * 256 + h * 64 + 4 * (tid & 15)); \
            PR_GLOAD1(tid, gx0); PR_GLOAD1(tid + 256, gx1); PR_GLOAD1(tid + 512, gx2); PR_GLOAD1(tid + 768, gx3); PR_GLOAD1(tid + 1024, gx4); } while (0)
#define PR_SSTORE1(idx_, src_) do { const int idx = (idx_); const int step = idx / 40, rem = idx % 40, vec = rem >> 3, c8 = rem & 7; \
            const int slot = vec == 0 ? 4 : (vec == 1 ? 3 : (vec == 2 ? 5 : (vec == 3 ? 1 : 2))); float f[8]; cvt8(src_, f); LAS float* d = B_ + step * RW_STEP + slot * 64 + 8 * c8; \
            *(LAS f32x4_t*)d = (f32x4_t){f[0], f[1], f[2], f[3]}; *(LAS f32x4_t*)(d + 4) = (f32x4_t){f[4], f[5], f[6], f[7]}; } while (0)
#define PR_SSTORE(buf_) do { LAS float* B_ = (LAS float*)(lds + (buf_) * RW_BUF); *(LAS f32x4_t*)(B_ + (tid >> 4) * RW_STEP + 4 * (tid & 15)) = (f32x4_t){gw0.x, gw0.y, gw0.z, gw0.w}; \
            *(LAS f32x4_t*)(B_ + (16 + (tid >> 4)) * RW_STEP + 4 * (tid & 15)) = (f32x4_t){gw1.x, gw1.y, gw1.z, gw1.w}; \
            PR_SSTORE1(tid, gx0); PR_SSTORE1(tid + 256, gx1); PR_SSTORE1(tid + 512, gx2); PR_SSTORE1(tid + 768, gx3); PR_SSTORE1(tid + 1024, gx4); } while (0)
        f32x2_t s0[4], s1[4];
#pragma unroll
        for (int i = 0; i < 4; ++i) { s0[i] = (f32x2_t){0.f, 0.f}; s1[i] = (f32x2_t){0.f, 0.f}; }
        float lnw[8], rkv[8]; uint4 gpre;
        {   const float4 a0 = *(const float4*)(lng + 8 * (tid & 7)), a1 = *(const float4*)(lng + 8 * (tid & 7) + 4), b0 = *(const float4*)(rkw + 8 * (tid & 7)), b1 = *(const float4*)(rkw + 8 * (tid & 7) + 4);
            lnw[0] = a0.x; lnw[1] = a0.y; lnw[2] = a0.z; lnw[3] = a0.w; lnw[4] = a1.x; lnw[5] = a1.y; lnw[6] = a1.z; lnw[7] = a1.w; rkv[0] = b0.x; rkv[1] = b0.y; rkv[2] = b0.z; rkv[3] = b0.w; rkv[4] = b1.x; rkv[5] = b1.y; rkv[6] = b1.z; rkv[7] = b1.w; }
        PR_GLOAD(0); PR_SSTORE(0); __syncthreads();
        for (int c = 0; c < nch; ++c) {
            gpre = *(const uint4*)(O + (tb + (long long)c * SC_CH + (tid >> 3)) * 1024 + 512 + h * 64 + 8 * (tid & 7));
            if (c + 1 < nch) PR_GLOAD(c + 1);
            const LAS float* B = (const LAS float*)(lds + (c & 1) * RW_BUF);
#define PR_LD(R_, V_, s_) do { const LAS float* x = B + (s_) * RW_STEP + 8 * cg; \
                R_[0] = *(const LAS f32x4_t*)(x); R_[1] = *(const LAS f32x4_t*)(x + 64); R_[2] = *(const LAS f32x4_t*)(x + 128); R_[3] = *(const LAS f32x4_t*)(x + 192); R_[4] = *(const LAS f32x4_t*)(x + 256); \
                R_[5] = *(const LAS f32x4_t*)(x + 4); R_[6] = *(const LAS f32x4_t*)(x + 68); R_[7] = *(const LAS f32x4_t*)(x + 132); R_[8] = *(const LAS f32x4_t*)(x + 196); R_[9] = *(const LAS f32x4_t*)(x + 260); \
                V_ = *(const LAS f32x2_t*)(B + (s_) * RW_STEP + 320 + 2 * rp); } while (0)
#define PR_STEP(R_, V_, s_) do { f32x2_t w[4], kk[4], bb[4], k[4], r[4]; \
                _Pragma("unroll") for (int i = 0; i < 2; ++i) { const f32x4_t a0 = R_[5 * i], a1 = R_[5 * i + 1], a2 = R_[5 * i + 2], a3 = R_[5 * i + 3], a4 = R_[5 * i + 4]; \
                    w[2 * i] = (f32x2_t){a0[0], a0[1]}; w[2 * i + 1] = (f32x2_t){a0[2], a0[3]}; kk[2 * i] = (f32x2_t){a1[0], a1[1]}; kk[2 * i + 1] = (f32x2_t){a1[2], a1[3]}; \
                    bb[2 * i] = (f32x2_t){a2[0], a2[1]}; bb[2 * i + 1] = (f32x2_t){a2[2], a2[3]}; k[2 * i] = (f32x2_t){a3[0], a3[1]}; k[2 * i + 1] = (f32x2_t){a3[2], a3[3]}; \
                    r[2 * i] = (f32x2_t){a4[0], a4[1]}; r[2 * i + 1] = (f32x2_t){a4[2], a4[3]}; } \
                f32x2_t a = s0[0] * kk[0] + s0[1] * kk[1]; a += s0[2] * kk[2] + s0[3] * kk[3]; \
                f32x2_t c2 = s1[0] * kk[0] + s1[1] * kk[1]; c2 += s1[2] * kk[2] + s1[3] * kk[3]; \
                const float skk0 = sum8(a[0] + a[1]), skk1 = sum8(c2[0] + c2[1]); \
                f32x2_t y0 = (f32x2_t){0.f, 0.f}, y1 = (f32x2_t){0.f, 0.f}; \
                _Pragma("unroll") for (int i = 0; i < 4; ++i) { s0[i] = s0[i] * w[i] - bb[i] * skk0 + k[i] * V_[0]; y0 += s0[i] * r[i]; s1[i] = s1[i] * w[i] - bb[i] * skk1 + k[i] * V_[1]; y1 += s1[i] * r[i]; } \
                const float ya = sum8(y0[0] + y0[1]), yb = sum8(y1[0] + y1[1]); \
                if (cg == 0) *(LAS f32x2_t*)(YB + (s_) * 64 + 2 * rp) = (f32x2_t){ya, yb}; } while (0)
            {   f32x4_t RA[10], RB[10]; f32x2_t VA, VB;
                PR_LD(RA, VA, 0); __builtin_amdgcn_sched_barrier(0);
#pragma nounroll
                for (int s = 0; s < SC_CH; s += 2) {
                    PR_LD(RB, VB, s + 1); __builtin_amdgcn_sched_barrier(0);
                    PR_STEP(RA, VA, s); __builtin_amdgcn_sched_barrier(0);
                    { const int sn = s + 2 < SC_CH ? s + 2 : SC_CH - 1; PR_LD(RA, VA, sn); } __builtin_amdgcn_sched_barrier(0);
                    PR_STEP(RB, VB, s + 1); __builtin_amdgcn_sched_barrier(0); } }
#undef PR_LD
#undef PR_STEP
            __syncthreads();
            {
                const int s = tid >> 3, v0 = 8 * (tid & 7); const long long t = tb + (long long)c * SC_CH + s;
                float y[8], vv[8], rr[8], kq[8];
#pragma unroll
                for (int i = 0; i < 2; ++i) { const f32x4_t ty = *(const LAS f32x4_t*)(YB + s * 64 + v0 + 4 * i), tv = *(const LAS f32x4_t*)(B + s * RW_STEP + 320 + v0 + 4 * i), tr = *(const LAS f32x4_t*)(B + s * RW_STEP + 256 + v0 + 4 * i), tk = *(const LAS f32x4_t*)(B + s * RW_STEP + 192 + v0 + 4 * i);
#pragma unroll
                    for (int j = 0; j < 4; ++j) { y[4 * i + j] = ty[j]; vv[4 * i + j] = tv[j]; rr[4 * i + j] = tr[j]; kq[4 * i + j] = tk[j]; } }
                float sm = 0.f, rkp = 0.f;
#pragma unroll
                for (int j = 0; j < 8; ++j) { sm += y[j]; rkp += rr[j] * kq[j] * rkv[j]; }
                const float mean = sum8(sm) * (1.0f / 64.0f); float vs = 0.f;
#pragma unroll
                for (int j = 0; j < 8; ++j) { y[j] -= mean; vs += y[j] * y[j]; }
                const float rstd = rsqrtf(sum8(vs) * (1.0f / 64.0f) + 64e-5f), rk = sum8(rkp);
                bf16_t* o = O + t * 1024 + 512 + h * 64 + v0; float g[8], res[8]; cvt8(gpre, g);
#pragma unroll
                for (int j = 0; j < 8; ++j) res[j] = (y[j] * rstd * lnw[j] + rk * vv[j]) * g[j];
                st8(o, res); }
            if (c + 1 < nch) PR_SSTORE((c + 1) & 1);
            __syncthreads();
        }
#undef PR_GLOAD1
#undef PR_GLOAD
#undef PR_SSTORE1
#undef PR_SSTORE
    } else {
        const int t = tid - 256, vp = t >> 3, kg = t & 7;
        const bf16_t* P = WSP(bf16_t, p.oP); const float* GA = WSP(float, p.oGA); const float* ng = p.in[I_GLA_NORM] + l * 64;
        LAS float* OB = (LAS float*)(lds + PC_OB);
        float4 ga; uint4 g1, g2;
#define PG_GLOAD(c_) do { const long long t0_ = tb + (long long)(c_) * SC_CH; const int step = t >> 3; \
            ga = *(const float4*)(GA + (t0_ + step) * 128 + h * 32 + 4 * (t & 7)); g1 = *(const uint4*)(P + (t0_ + step) * PW + C_GLA + 256 + h * 64 + 8 * (t & 7)); \
            g2 = *(const uint4*)(P + (t0_ + step) * PW + C_GLA + ((t >> 2) & 1) * 128 + h * 32 + 8 * (t & 3)); } while (0)
#define PG_SSTORE(buf_) do { LAS float* B_ = (LAS float*)(lds + PC_GL0 + (buf_) * GL_BUF); float f[8]; const int step = t >> 3; \
            *(LAS f32x4_t*)(B_ + step * GL_STEP + 4 * (t & 7)) = (f32x4_t){ga.x, ga.y, ga.z, ga.w}; \
            cvt8(g1, f); { LAS float* d = B_ + step * GL_STEP + 96 + 8 * (t & 7); *(LAS f32x4_t*)d = (f32x4_t){f[0], f[1], f[2], f[3]}; *(LAS f32x4_t*)(d + 4) = (f32x4_t){f[4], f[5], f[6], f[7]}; } \
            cvt8(g2, f); { LAS float* d = B_ + step * GL_STEP + (((t >> 2) & 1) == 0 ? 64 : 32) + 8 * (t & 3); *(LAS f32x4_t*)d = (f32x4_t){f[0], f[1], f[2], f[3]}; *(LAS f32x4_t*)(d + 4) = (f32x4_t){f[4], f[5], f[6], f[7]}; } } while (0)
        f32x4_t q0 = (f32x4_t){0.f, 0.f, 0.f, 0.f}, q1 = q0;
        float ngw[8]; uint4 gpre;
        {   const float4 a0 = *(const float4*)(ng + 8 * (t & 7)), a1 = *(const float4*)(ng + 8 * (t & 7) + 4); ngw[0] = a0.x; ngw[1] = a0.y; ngw[2] = a0.z; ngw[3] = a0.w; ngw[4] = a1.x; ngw[5] = a1.y; ngw[6] = a1.z; ngw[7] = a1.w; }
        PG_GLOAD(0); PG_SSTORE(0); __syncthreads();
        for (int c = 0; c < nch; ++c) {
            gpre = *(const uint4*)(O + (tb + (long long)c * SC_CH + (t >> 3)) * 1024 + 768 + h * 64 + 8 * (t & 7));
            if (c + 1 < nch) PG_GLOAD(c + 1);
            const LAS float* B = (const LAS float*)(lds + PC_GL0 + (c & 1) * GL_BUF);
#define PG_LD(R_, V_, s_) do { const LAS float* x = B + (s_) * GL_STEP + 4 * kg; R_[0] = *(const LAS f32x4_t*)x; R_[1] = *(const LAS f32x4_t*)(x + 32); R_[2] = *(const LAS f32x4_t*)(x + 64); V_ = *(const LAS f32x2_t*)(B + (s_) * GL_STEP + 96 + 2 * vp); } while (0)
#define PG_STEP(R_, V_, s_) do { q0 = q0 * R_[0] + R_[1] * V_[0]; q1 = q1 * R_[0] + R_[1] * V_[1]; const f32x4_t p0 = q0 * R_[2], p1 = q1 * R_[2]; \
                const float o0 = sum8((p0[0] + p0[1]) + (p0[2] + p0[3])), o1 = sum8((p1[0] + p1[1]) + (p1[2] + p1[3])); \
                if (kg == 0) *(LAS f32x2_t*)(OB + (s_) * 64 + 2 * vp) = (f32x2_t){o0 * 0.17677669529663687f, o1 * 0.17677669529663687f}; } while (0)
            {   f32x4_t RA[3], RB[3]; f32x2_t VA, VB;
                PG_LD(RA, VA, 0); __builtin_amdgcn_sched_barrier(0);
#pragma nounroll
                for (int s = 0; s < SC_CH; s += 2) {
                    PG_LD(RB, VB, s + 1); __builtin_amdgcn_sched_barrier(0);
                    PG_STEP(RA, VA, s); __builtin_amdgcn_sched_barrier(0);
                    { const int sn = s + 2 < SC_CH ? s + 2 : SC_CH - 1; PG_LD(RA, VA, sn); } __builtin_amdgcn_sched_barrier(0);
                    PG_STEP(RB, VB, s + 1); __builtin_amdgcn_sched_barrier(0); } }
#undef PG_LD
#undef PG_STEP
            __syncthreads();
            {   const int s = t >> 3, v0 = 8 * (t & 7); const long long tt = tb + (long long)c * SC_CH + s; float o[8];
#pragma unroll
                for (int i = 0; i < 2; ++i) { const f32x4_t to = *(const LAS f32x4_t*)(OB + s * 64 + v0 + 4 * i);
#pragma unroll
                    for (int j = 0; j < 4; ++j) o[4 * i + j] = to[j]; }
                float ms = 0.f;
#pragma unroll
                for (int j = 0; j < 8; ++j) ms += o[j] * o[j];
                const float rs = rsqrtf(sum8(ms) * (1.0f / 64.0f) + 1e-6f);
                bf16_t* d = O + tt * 1024 + 768 + h * 64 + v0; float g[8], res[8]; cvt8(gpre, g);
#pragma unroll
                for (int j = 0; j < 8; ++j) res[j] = o[j] * rs * ngw[j] * g[j];
                st8(d, res); }
            if (c + 1 < nch) PG_SSTORE((c + 1) & 1);
            __syncthreads();
        }
#undef PG_GLOAD
#undef PG_SSTORE
    }
}
__device__ __forceinline__ void ph_scan_selwin(const Params& p, int l, int wv, LAS unsigned char* lds) {
    const int nchain = (int)(p.B * 4), nsel = (int)(p.B * 2) * (int)(p.S >> 6);
    unsigned* ctr = WSP(unsigned, p.oMOEC) + 64 + 2 * l; volatile LAS unsigned* slot = (volatile LAS unsigned*)(lds + DEAL_SLOT_OFF);
    const int tid = wv * 64 + mk_lane();
    for (;;) { const int u = next_unit(ctr, slot, tid); if (u >= nchain + nsel) break;
#ifdef PROBE_DEAL
#define PD_SPIN(bit, ...) do { const unsigned long long s0_ = wall_clock64(); __VA_ARGS__; if ((PROBE_DEAL >> (bit)) & 1) { __syncthreads(); const unsigned long long s1_ = wall_clock64(); while (wall_clock64() < s1_ + (s1_ - s0_)) __builtin_amdgcn_s_sleep(8); } } while (0)
#else
#define PD_SPIN(bit, ...) do { __VA_ARGS__; } while (0)
#endif
        if (u < nchain) PD_SPIN(2, pair_chain(p, l, u, wv, lds));
        else { const int v = u - nchain, nbg = (int)(p.B * 2), cur = (int)(p.S >> 6) - 1 - v / nbg, bg = v % nbg;
            PD_SPIN(0, cmp_unit(p, cur, bg, wv, lds));
            __syncthreads();
            PD_SPIN(1, selwin_unit(p, cur, bg, wv, lds)); } }
}
#endif
#ifdef CPU_EMU
struct Ctx { long long gtid, gsz, gw, nw; int lane, G, c; };
#define GEMM(A, lda, Bt, ldb, K, S, E) gemm_cpu(A, lda, Bt, ldb, K, S, E)
#define GEMMK(A, lda, Bt, ldb, K, S, E, ks) gemm_cpu(A, lda, Bt, ldb, K, S, E, ks)
#define GEMMG(A, lda, Bt, ldb, K, S, E, gi) gemm_cpu(A, lda, Bt, ldb, K, S, E, 64, gi)
#define GRID_BARRIER() do { } while (0)
#else
struct Ctx { LAS unsigned char* lds; int wv; };
#define GEMM(A, lda, Bt, ldb, K, S, E) gemm_phase(cx.wv, cx.lds, A, lda, Bt, ldb, K, S, E)
#define GEMMK(A, lda, Bt, ldb, K, S, E, ks) gemm_phase(cx.wv, cx.lds, A, lda, Bt, ldb, K, S, E, ks)
#define GEMMG(A, lda, Bt, ldb, K, S, E, gi) gemm_phase<decltype(E), decltype(S), true>(cx.wv, cx.lds, A, lda, Bt, ldb, K, S, E, 64, gi)
#define GRID_BARRIER() do { XcdBarrier b_; b_.bar = (unsigned*)(p.ws + p.oBAR); b_.x = xb_xcc_id(); b_.st = (volatile LAS unsigned*)(cx.lds + XBW_OFF); b_.wv = cx.wv; xcd_barrier(b_); } while (0)
#endif
constexpr int N_PHASES = 52;
#if !defined(CPU_EMU) && defined(PROBE_SUB)
#define SUBP(bit, ...) do { const unsigned long long s0_ = wall_clock64(); __VA_ARGS__; if ((PROBE_SUB >> (bit)) & 1) { const unsigned long long s1_ = wall_clock64(); while (wall_clock64() < s1_ + (s1_ - s0_)) __builtin_amdgcn_s_sleep(8); } } while (0)
#else
#define SUBP(bit, ...) do { __VA_ARGS__; } while (0)
#endif
#ifndef PROBE_CONV
#define PROBE_CONV 1
#endif
#ifndef PROBE_PREP
#define PROBE_PREP 1
#endif
#ifndef PROBE_GEMM
#define PROBE_GEMM 1
#endif
#ifndef PROBE_CMP
#define PROBE_CMP 1
#endif
#ifndef PROBE_CA
#define PROBE_CA 1
#endif
#ifndef PROBE_MOE
#define PROBE_MOE 1
#endif
#ifndef PROBE_RMS
#define PROBE_RMS 1
#endif
#ifndef PROBE_BAR
#define PROBE_BAR 0
#endif

template <int KIND> DEVI void run_program(const Params& p, const Ctx& cx, int pb, int pe) {
    int ph = 0;
#define T p.T
#define DFF p.DFF
#ifdef CPU_EMU
    const long long gsz = cx.gsz, nw = cx.nw; const int gG = cx.G, gC = cx.c;
#else
#define gsz ((long long)gridDim.x * 512)
#define nw ((long long)gridDim.x * 8)
#define gG ((int)gridDim.x)
#define gC ((int)blockIdx.x)
#endif
#define H WSP(bf16_t, p.oH)
#define HN ((bf16_t*)p.out)
#define P WSP(bf16_t, p.oP)
#define O WSP(bf16_t, p.oO)
#define BO WSP(bf16_t, p.oBO)
#define MG WSP(bf16_t, p.oMG)
#define CQ WSP(bf16_t, p.oCQ)
#define CAO WSP(bf16_t, p.oCAO)
#define MEMN WSP(bf16_t, p.oMEMN)
#define ACT WSP(bf16_t, p.oACT)
#define WFFN WSP(bf16_t, p.oWFFN)
#ifdef CPU_EMU
#define OPAQUE_V(x) do { } while (0)
#define PH_IDX long long gtid = cx.gtid, gw = cx.gw; int lane = cx.lane
#else
#define OPAQUE_V(x) asm volatile("" : "+v"(x))
#define PH_IDX unsigned tx_ = (unsigned)(cx.wv * 64 + mk_lane()); OPAQUE_V(tx_); long long gtid = (long long)blockIdx.x * 512 + tx_, gw = (long long)(tx_ >> 6) * gridDim.x + blockIdx.x; int lane = tx_ & 63
#endif
#if !defined(CPU_EMU) && defined(PROBE_MASK)
#define PH_T0(k) const int kind_ = (k); const unsigned long long t0_ = wall_clock64();
#else
#define PH_T0(k)
#endif
#define PH_BEGIN(k) if (ph >= pb && ph < pe) { if constexpr (KIND < 0 || KIND == (k)) { PH_T0(k) PH_IDX; OPAQUE_V(gtid); OPAQUE_V(gw); OPAQUE_V(lane); (void)gtid; (void)gw; (void)lane;
#if !defined(CPU_EMU) && defined(PROBE_MASK)
#define PH_END   if ((PROBE_MASK >> kind_) & 1) { const unsigned long long t1_ = wall_clock64(); while (wall_clock64() < t1_ + (t1_ - t0_)) __builtin_amdgcn_s_sleep(8); } } if (ph + 1 < pe) GRID_BARRIER(); } ++ph;
#else
#define PH_END   } if (ph + 1 < pe) GRID_BARRIER(); } ++ph;
#endif
    PH_BEGIN(0)
        { long long cvo_ = 0; ph_convert_layer(p, 0, gtid, gsz, cvo_); ph_convert_layer(p, 1, gtid, gsz, cvo_); ph_convert_ffn(p, gtid, gsz, cvo_); ph_convert_cmp(p, gtid, gsz); } ph_rope(p, gtid, gsz);
        ph_rmsnorm(p, p.in[I_MEM], p.B * 256, p.in[I_MEM_NORM], MEMN, 0, nullptr, gw, nw, lane);
        ph_rmsnorm(p, p.in[I_X], T, p.in[I_NORM_MIX], H, 0, nullptr, gw, nw, lane);
    PH_END
    ++ph;
    for (int l = 0; l < 2; ++l) {
#define W WSP(bf16_t, p.oWL[l])
        PH_BEGIN(1)
            if (l == 0) { SchedPlain S; S.init(p.B * 256, 1024, 1024, 1024, gG, gC); EpStore E{WSP(bf16_t, p.oKV), 1024, 1.0f, nullptr, nullptr, 0}; GEMM(MEMN, 1024, WSP(bf16_t, p.oWKV), 1024, 1024, S, E); }
            { SchedPlain S; S.init(T, 3072, 1024, 1024, gG, gC); EpStore E{P, 3072, 1.0f, l == 1 ? WSP(rs_t, p.oRSA) : nullptr, nullptr, 0}; GEMM(H, 1024, W + W_IN, 1024, 1024, S, E); } PH_END
        PH_BEGIN(2) if (l == 1) { rs_t* rs_ = WSP(rs_t, p.oRSB); for (long long i_ = gtid; i_ < T; i_ += gsz) rs_[i_] = 0ull; } SUBP(0, ph_rope_apply(p, gtid, gsz)); SUBP(1, { SchedCmp S; S.init(T / 16, gG, gC); EpUV E{WSP(bf16_t, p.oUV)}; GEMMK(P, 16LL * PW, WSP(bf16_t, p.oW1T) + (long long)l * 2 * 256 * 1024, 1024, 1024, S, E, (long long)PW); });
#ifdef CPU_EMU
            { static float pwl_[4 * 64 * 64]; pool_fill_w(p, l, pwl_, 0, 1); ph_pool(p, l, pwl_, gtid, gsz); } ph_gla_prep(p, l, gtid, gsz);
#else
            SUBP(2, pool_gpu(p, l, cx.wv, cx.lds, gC, gG)); SUBP(3, ph_gla_prep(p, l, gtid, gsz));
#endif
#ifdef CPU_EMU
            { static unsigned wl_[80 * 256]; static unsigned F_[32 * 80]; static float KN_[128]; rwkv_fill_wl(p, l, wl_, 0, 1);
              for (long long tile = 0; tile < T / 32; ++tile) { for (int q = 0; q < 512; ++q) rwkv_prep_step1(p, l, F_, KN_, tile, q); for (int q = 0; q < 512; ++q) rwkv_prep_step2(p, l, wl_, F_, KN_, tile, q); } }
#else
            SUBP(4, { LDSQ unsigned* wl_ = (LDSQ unsigned*)cx.lds; LDSQ unsigned* F_ = (LDSQ unsigned*)(cx.lds + 131072); LDSQ float* KN_ = (LDSQ float*)(F_ + 32 * 80); LDSQ float* Z_ = (LDSQ float*)cx.lds;
                __syncthreads(); rwkv_fill_wl_gpu(p, l, wl_, (int)tx_); __syncthreads(); RwFrags fr_; rwkv_load_frags(wl_, cx.wv, fr_);
                for (long long tile = gC; tile < T / 32; tile += gG) { __syncthreads(); rwkv_prep_step1_gpu(p, l, F_, KN_, tile, (int)tx_); __syncthreads(); rwkv_lowrank_mfma(l, fr_, F_, Z_, cx.wv); __syncthreads(); rwkv_prep_step2(p, l, wl_, F_, KN_, tile, (int)tx_, Z_); } });
#endif
#if PROBE_PREP == 2
            ph_pool(p, l, gtid, gsz);
#elif PROBE_PREP == 3
            ph_pool(p, l, gtid, gsz); ph_gla_prep(p, l, gtid, gsz);
#endif
 PH_END
#ifdef CPU_EMU
        PH_BEGIN(3) ph_compress2(p, l, gtid, gsz); PH_END
#else
        PH_BEGIN(3) compress2_gpu(p, l, cx.wv, cx.lds, gC, gG); PH_END
#endif
#ifdef CPU_EMU
        PH_BEGIN(4) ph_rwkv_scan(p, l, gw, nw, lane); ph_gla_scan(p, l, (gw + nw - (p.B * 4) % nw) % nw, nw, lane); ph_cmp_attn(p, gtid, gsz); PH_END
#else
        ++ph;
#endif
#ifdef CPU_EMU
        PH_BEGIN(5) ph_selwin(p, gtid, gsz); PH_END
#else
        PH_BEGIN(5) ph_scan_selwin(p, l, cx.wv, cx.lds); PH_END
#endif
        PH_BEGIN(6) { SchedBranch S; S.init(T, gG, gC); EpStore E{P, 4096, 1.0f, nullptr, BO, 3 * T / 4}; GEMM(O, 1024, W + W_B, 256, 256, S, E); } PH_END
        PH_BEGIN(7) { SchedPlain S; S.init(T, 4096, 1024, 1024, gG, gC); EpGate E{P, p.in[I_B_GATE] + l * 4096, MG, 0, l == 1 ? WSP(rs_t, p.oRSA) : nullptr, BO, 3 * T / 4}; GEMM(H, 1024, W + W_G, 1024, 1024, S, E); } PH_END
        ph += 6;
        PH_BEGIN(8) { SchedPlain S; S.init(T, 1024, 1024, 1024, gG, gC); EpResid E{l == 0 ? p.in[I_X] : nullptr, H, H, WSP(rs_t, l == 0 ? p.oRSA : p.oRSB)}; GEMM(MG, 1024, W + W_O, 1024, 1024, S, E); } PH_END
        ++ph;
        PH_BEGIN(1) { SchedPlain S; S.init(T, 256, 1024, 1024, gG, gC); EpStore E{CQ, 256, QSCALE, WSP(rs_t, l == 0 ? p.oRSA : p.oRSB), nullptr, 0}; GEMM(H, 1024, W + W_CQ, 1024, 1024, S, E); } PH_END
#ifdef CPU_EMU
        PH_BEGIN(10) if (l == 0) { rs_t* rs_ = WSP(rs_t, p.oRSA); for (long long i_ = gtid; i_ < T; i_ += gsz) rs_[i_] = 0ull; } ph_ca_attn(p, l, gtid, gsz); PH_END
#else
        PH_BEGIN(10) if (l == 0) { rs_t* rs_ = WSP(rs_t, p.oRSA); for (long long i_ = gtid; i_ < T; i_ += gsz) rs_[i_] = 0ull; } ph_ca_attn_mfma(p, l, cx.wv, cx.lds, gC, gG); PH_END
#endif
        PH_BEGIN(8) { SchedPlain S; S.init(T, 1024, 256, 256, gG, gC); EpResid E{nullptr, H, H, l == 0 ? WSP(rs_t, p.oRSB) : nullptr}; GEMM(CAO, 256, W + W_CO, 256, 256, S, E); } PH_END
        if (l == 1) { PH_BEGIN(9)
#ifdef CPU_EMU
            ph_rmsnorm(p, nullptr, T, p.in[I_NORM_FFN] + l * 1024, HN, 2, nullptr, gw, nw, lane, 0, H); moe_count_range(p, 0, T / 64, 0, 1);
#else
            for (long long r0_ = (long long)gC * 256; r0_ < T; r0_ += (long long)gG * 256) { const int wib_ = (int)(tx_ >> 6);
                (void)wib_; norm_router_256(p, l, r0_, cx.wv, cx.lds);
                asm volatile("s_waitcnt vmcnt(0)" ::: "memory"); __syncthreads(); __builtin_amdgcn_fence(__ATOMIC_ACQUIRE, "agent"); asm volatile("s_waitcnt vmcnt(0)" ::: "memory");
                moe_count_range(p, r0_ / 64, 4, (int)tx_, 512); }
#endif
            { int* R2T_ = WSP(int, p.oR2T); for (long long i_ = gtid; i_ < p.NR; i_ += gsz) R2T_[i_] = -1; }
            ph_convert_moe(p, gtid, gsz); PH_END }
        else ++ph;
        if (l == 0) {
            PH_BEGIN(11) { SchedPlain S; S.init(T, 2 * DFF, 1024, 1024, gG, gC); EpSwiglu E{ACT, DFF, 0, WSP(rs_t, p.oRSB)}; GEMM(H, 1024, WFFN, 1024, 1024, S, E); } PH_END
            PH_BEGIN(8) { SchedPlain S; S.init(T, 1024, DFF, DFF, gG, gC); EpResid E{nullptr, H, H, WSP(rs_t, p.oRSA)}; GEMM(ACT, DFF, WFFN + 2 * DFF * 1024, DFF, DFF, S, E); } PH_END
            ++ph;
        } else {
            PH_BEGIN(12) for (int rep_ = 0; rep_ < PROBE_MOE; ++rep_) ph_moe_offsets(p, gw, nw, lane); PH_END
            PH_BEGIN(12) for (int rep_ = 0; rep_ < PROBE_MOE; ++rep_) ph_moe_assign(p, gtid, gsz); PH_END
#define HS WSP(bf16_t, p.oHS)
#define ACTC WSP(bf16_t, p.oACTC)
#define MW WSP(bf16_t, p.oMOEW)
#define MC WSP(int, p.oMOEC)
            const int ct = (p.NR / 256) >= 512 ? 256 : (int)((p.NR / 256 + 2) / 3);
            for (int q = 0; q < 3; ++q) {
                PH_BEGIN(13) { SchedMoe S; const int nt_ = MC[16 + 8] / 256; S.t0 = q * ct; S.t1 = (q + 1) * ct < nt_ ? (q + 1) * ct : nt_; if (S.t1 < S.t0) S.t1 = S.t0; S.nN = (int)(2 * DFF / 256); S.G = gG; S.c = gC; S.lda = 1024; S.ldb = 1024; S.per_e = 3 * 1024 * DFF * 2;
                    S.base = MC + 16;
                    EpSwiglu E{ACTC, DFF, (long long)S.t0 * 256, nullptr}; GEMMG(HN, 1024, MW, 1024, 1024, S, E, WSP(int, p.oR2T)); } PH_END
                PH_BEGIN(14) { SchedMoe S; const int nt_ = MC[16 + 8] / 256; S.t0 = q * ct; S.t1 = (q + 1) * ct < nt_ ? (q + 1) * ct : nt_; if (S.t1 < S.t0) S.t1 = S.t0; S.nN = 4; S.G = gG; S.c = gC; S.lda = DFF; S.ldb = DFF; S.per_e = 3 * 1024 * DFF * 2;
                    S.base = MC + 16;
                    EpMoeDown E{WSP(bf16_t, p.oY), WSP(float, p.oROWW)}; GEMM(ACTC - (long long)S.t0 * 256 * DFF, DFF, MW + 2 * DFF * 1024, DFF, DFF, S, E); } PH_END }
            PH_BEGIN(15) ph_final(p, gw, nw, lane); PH_END
        }
    }
#undef PH_BEGIN
#undef PH_END
#undef H
#undef HN
#undef P
#undef O
#undef BO
#undef MG
#undef CQ
#undef CAO
#undef MEMN
#undef ACT
#undef WFFN
#undef T
#undef DFF
#undef W
#undef HS
#undef ACTC
#undef MW
#undef MC
#ifndef CPU_EMU
#undef gsz
#undef nw
#undef gG
#undef gC
#endif
}

#ifndef CPU_EMU
template <int KIND> __global__ __launch_bounds__(512, 2) void mk_fwd(Params p, int pb, int pe) {
    extern __shared__ __attribute__((aligned(16))) unsigned char shm[];
    Ctx cx; cx.lds = (LAS unsigned char*)shm;
    volatile LAS unsigned* xbw = (volatile LAS unsigned*)(cx.lds + XBW_OFF);
    if (threadIdx.x == 0) { xbw[0] = 0u; xbw[1] = 0u; xbw[2] = 0u; xbw[3] = 0u; }
    __syncthreads();
    cx.wv = __builtin_amdgcn_readfirstlane((int)(threadIdx.x >> 6));
    (void)xcd_barrier_post((unsigned*)(p.ws + p.oBAR), xbw, cx.wv);
    run_program<KIND>(p, cx, pb, pe);
}
#ifndef MK_ONE
#define MK_ONE 1
#endif
#if !MK_ONE
static const int kPhaseKind[N_PHASES] = { 0, 1,
    1, 2, 3, 4, 5, 6, 7, 6, 7, 6, 7, 6, 7, 8, 9, 1, 10, 8, 9, 11, 8, 9,
    1, 2, 3, 4, 5, 6, 7, 6, 7, 6, 7, 6, 7, 8, 9, 1, 10, 8, 9, 12, 12, 12, 12, 13, 14, 13, 14, 13, 14, 13, 14, 13, 14, 15 };
#endif
typedef void (*mk_fn)(Params, int, int);
extern "C" void kernel_launch(void* const* d_in, const int* in_sizes, int n_in, void* d_out, int out_size, void* d_ws, size_t ws_size, hipStream_t stream) {
    (void)in_sizes; (void)n_in; (void)out_size;
    Params p; memset(&p, 0, sizeof(p));
    for (int i = 0; i < N_INPUTS; ++i) p.in[i] = (const float*)d_in[i];
    p.out = (float*)d_out; p.ws = (unsigned char*)d_ws;
    make_layout(p, 32, 2048, 2816);
    for (int j = 0; j < 8; ++j) p.inv_freq[j] = (float)pow(500000.0, -(double)(2 * j) / 16.0);
    if ((size_t)p.wsNeed > ws_size) { fprintf(stderr, "workspace too small: need %lld have %zu\n", p.wsNeed, ws_size); return; }
    const size_t lds_bytes = LDS_TOTAL;
#if MK_ONE
    static const mk_fn fns[1] = { mk_fwd<-1> }; const int nf = 1;
#else
    static const mk_fn fns[16] = { mk_fwd<0>, mk_fwd<1>, mk_fwd<2>, mk_fwd<3>, mk_fwd<4>, mk_fwd<5>, mk_fwd<6>, mk_fwd<7>, mk_fwd<8>, mk_fwd<9>, mk_fwd<10>, mk_fwd<11>, mk_fwd<12>, mk_fwd<13>, mk_fwd<14>, mk_fwd<15> }; const int nf = 16;
#endif
    static int grid = 0;
    if (!grid) { int dev = 0, cus = 0; (void)hipGetDevice(&dev); (void)hipDeviceGetAttribute(&cus, hipDeviceAttributeMultiprocessorCount, dev);
        for (int k = 0; k < nf; ++k) (void)hipFuncSetAttribute((const void*)fns[k], hipFuncAttributeMaxDynamicSharedMemorySize, (int)lds_bytes);
        int per_cu = 0; (void)hipOccupancyMaxActiveBlocksPerMultiprocessor(&per_cu, (const void*)fns[0], 512, lds_bytes); (void)hipGetLastError();
        grid = cus > 0 ? cus : 256; }
    (void)hipMemsetAsync(p.ws + p.oBAR, 0, 16384 + 4096, stream);
    (void)hipMemsetAsync(p.ws + p.oRSA, 0, (size_t)p.T * 8, stream); (void)hipMemsetAsync(p.ws + p.oRSB, 0, (size_t)p.T * 8, stream);
#if MK_ONE
    hipLaunchKernelGGL(fns[0], dim3(grid), dim3(512), lds_bytes, stream, p, 0, N_PHASES);
#else
    for (int ph = 0; ph < N_PHASES; ++ph) hipLaunchKernelGGL(fns[kPhaseKind[ph]], dim3(grid), dim3(512), lds_bytes, stream, p, ph, ph + 1);
#endif
}
#endif
```

```cpp
#ifndef CPU_EMU
#include <hip/hip_runtime.h>
#include <cstdio>
#include <cstdint>
#include <cstring>
#define DEVI __device__ __forceinline__
#define DEVM __device__ __forceinline__
#else
#include <cmath>
#include <cstdio>
#include <cstdint>
#include <cstring>
#include <cstdlib>
#define DEVI static inline
#define DEVM inline
struct uint4 { unsigned x, y, z, w; }; struct uint2 { unsigned x, y; };
struct float4 { float x, y, z, w; };
#endif

typedef unsigned short bf16_t;
#ifdef CPU_EMU
static inline float u2f(unsigned u) { float f; memcpy(&f, &u, 4); return f; }
static inline unsigned f2u(float f) { unsigned u; memcpy(&u, &f, 4); return u; }
#else
DEVI float u2f(unsigned u) { return __uint_as_float(u); }
DEVI unsigned f2u(float f) { return __float_as_uint(f); }
#endif
DEVI float bf2f(bf16_t b) { return u2f(((unsigned)b) << 16); }
DEVI bf16_t f2bf(float f) { unsigned u = f2u(f); u += 0x7FFFu + ((u >> 16) & 1u); return (bf16_t)(u >> 16); }
#ifdef CPU_EMU
DEVI unsigned pk2bf(float lo, float hi) { return (unsigned)f2bf(lo) | ((unsigned)f2bf(hi) << 16); }
#else
DEVI unsigned pk2bf(float lo, float hi) { unsigned r; asm("v_cvt_pk_bf16_f32 %0, %1, %2" : "=v"(r) : "v"(lo), "v"(hi)); return r; }
#endif
#ifdef CPU_EMU
DEVI float sigmoidf_(float x) { return 1.0f / (1.0f + expf(-x)); }
DEVI float siluf_(float x) { return x / (1.0f + expf(-x)); }
#else
DEVI float sigmoidf_(float x) { return __builtin_amdgcn_rcpf(1.0f + __builtin_amdgcn_exp2f(-1.44269504f * x)); }
DEVI float siluf_(float x) { return x * __builtin_amdgcn_rcpf(1.0f + __builtin_amdgcn_exp2f(-1.44269504f * x)); }
#endif
#ifdef CPU_EMU
DEVI float expf_(float x) { return expf(x); }
DEVI float tanhf_(float x) { return tanhf(x); }
DEVI float softplusf_(float x) { return x > 20.f ? x : log1pf(expf(x)); }
#else
DEVI float expf_(float x) { return __builtin_amdgcn_exp2f(1.44269504f * x); }
DEVI float tanhf_(float x) { const float xc = fminf(fmaxf(x, -15.f), 15.f); return 1.0f - 2.0f * __builtin_amdgcn_rcpf(1.0f + __builtin_amdgcn_exp2f(2.88539008f * xc)); }
DEVI float softplusf_(float x) { return x > 20.f ? x : 0.69314718f * __builtin_amdgcn_logf(1.0f + __builtin_amdgcn_exp2f(1.44269504f * x)); }
#endif
DEVI float gelu_tanhf_(float x) { return 0.5f * x * (1.0f + tanhf_(0.7978845608028654f * (x + 0.044715f * x * x * x))); }

DEVI void st8(bf16_t* dst, const float* v) {
#ifndef CPU_EMU
    uint4 w; w.x = pk2bf(v[0], v[1]); w.y = pk2bf(v[2], v[3]); w.z = pk2bf(v[4], v[5]); w.w = pk2bf(v[6], v[7]);
    *(uint4*)dst = w;
#else
    for (int j = 0; j < 8; ++j) dst[j] = f2bf(v[j]);
#endif
}
DEVI void ld8(const bf16_t* src, float* v) {
#ifndef CPU_EMU
    const uint4 w = *(const uint4*)src; v[0] = u2f(w.x << 16); v[1] = u2f(w.x & 0xffff0000u); v[2] = u2f(w.y << 16); v[3] = u2f(w.y & 0xffff0000u); v[4] = u2f(w.z << 16); v[5] = u2f(w.z & 0xffff0000u); v[6] = u2f(w.w << 16); v[7] = u2f(w.w & 0xffff0000u);
#else
    for (int j = 0; j < 8; ++j) v[j] = bf2f(src[j]);
#endif
}
#ifdef CPU_EMU
#define QSCALE 0.125f
#define SCHED_FENCE() do { } while (0)
#define LDSQ
DEVI void ld8l(const bf16_t* src, float* v) { ld8(src, v); }
#else
#define QSCALE 0.18033688f
#define SCHED_FENCE() __builtin_amdgcn_sched_barrier(0)
#define LDSQ __attribute__((address_space(3)))
typedef unsigned u32x4l_t __attribute__((ext_vector_type(4)));
typedef float f32x4l_t __attribute__((ext_vector_type(4)));
DEVI void ld8l(const LDSQ bf16_t* src, float* v) { const u32x4l_t w = *(const LDSQ u32x4l_t*)src; v[0] = u2f(w[0] << 16); v[1] = u2f(w[0] & 0xffff0000u); v[2] = u2f(w[1] << 16); v[3] = u2f(w[1] & 0xffff0000u);
    v[4] = u2f(w[2] << 16); v[5] = u2f(w[2] & 0xffff0000u); v[6] = u2f(w[3] << 16); v[7] = u2f(w[3] & 0xffff0000u); }
#endif
#ifdef CPU_EMU
DEVI float dot2bf(unsigned a, unsigned b, float acc) { return acc + u2f(a << 16) * u2f(b << 16) + u2f(a & 0xffff0000u) * u2f(b & 0xffff0000u); }
#else
typedef __bf16 bf16x2_t __attribute__((ext_vector_type(2)));
DEVI float dot2bf(unsigned a, unsigned b, float acc) { return __builtin_amdgcn_fdot2_f32_bf16(__builtin_bit_cast(bf16x2_t, a), __builtin_bit_cast(bf16x2_t, b), acc, false); }
#endif
constexpr int DM = 1024;
constexpr int PW = 3072;
constexpr int INW = 2972;
constexpr int C_Q = 0, C_KC = 256, C_VC = 384, C_KS = 512, C_VS = 640, C_KW = 768, C_VW = 896, C_NG = 1024;
constexpr int C_POOL = 1040;
constexpr int C_RW = 1296;
constexpr int C_GLA = 2192;
constexpr int C_VRES = 2976;
constexpr int NCMPH = 128;

enum { I_X = 0, I_MEM, I_POS, I_NORM_MIX, I_W_IN, I_CMP_PE, I_CMP_W1, I_CMP_W2, I_POOL_W, I_POOL_SCALE, I_RW_MU, I_RW_W0, I_RW_W2, I_RW_A0, I_RW_A2, I_RW_G2,
       I_RW_V0, I_RW_V1, I_RW_V2, I_RW_KK, I_RW_KA, I_RW_RK, I_RW_LN, I_GLA_A2, I_GLA_AB, I_GLA_NORM, I_W_GATE, I_B_GATE, I_W_BRANCH, I_W_OUT, I_NORM_CA, I_MEM_NORM,
       I_CA_Q, I_CA_KV, I_CA_O, I_NORM_FFN, I_FFN_G, I_FFN_U, I_FFN_D, I_MOE_R, I_MOE_G, I_MOE_U, I_MOE_D, I_NORM_FINAL, N_INPUTS };

struct Params {
    const float* in[N_INPUTS];
    float* out;
    unsigned char* ws;
    long long B, S, T, DFF, NC, NR;
    float inv_freq[8];
    long long oBAR, oMOEC, oROPE, oKCMP, oVCMP, oUV, oW1T, oCB, oSELM, oKV, oTOKE, oTOKW, oTOKS, oR2T, oROWW, oCCNT, oCOFF;
    long long oWL[2], oWKV, oWFFN, oVF, oH, oP, oO, oBO, oMG, oRWW, oRWX, oGA, oCQ, oCAO, oMEMN, oACT, oY, oHS, oMOEW, oACTC, oRSA, oRSB, wsNeed;
};
constexpr long long W_IN = 0, W_G = W_IN + 3072LL * 1024, W_B = W_G + 4096LL * 1024, W_O = W_B + 4LL * 1024 * 256, W_CQ = W_O + 1024LL * 1024, W_CKV = W_CQ + 256LL * 1024,
                    W_CO = W_CKV + 512LL * 1024, W_LAYER = W_CO + 1024LL * 256;

static inline long long al256(long long x) { return (x + 255) & ~255LL; }
static inline void make_layout(Params& p, long long B, long long S, long long DFF) {
    p.B = B; p.S = S; p.T = B * S; p.DFF = DFF; p.NC = (S - 32) / 16 + 1; p.NR = 2 * p.T + 2048;
    const long long T = p.T;
    long long o = 0;
    auto take = [&](long long bytes) { long long r = o; o = al256(o + bytes); return r; };
    p.oBAR = take(16384); p.oMOEC = take(4096);
    p.oROPE = take(T * 16 * 4);
    p.oKCMP = take(B * 2 * 128 * 64 * 2); p.oVCMP = take(B * 2 * 128 * 64 * 2);        p.oUV = take((T / 16) * 4 * 256 * 2); p.oW1T = take(2LL * 2 * 256 * 1024 * 2); p.oCB = take(2 * 2 * 128 * 4);
    p.oSELM = take(T * 2 * 4);
    p.oKV = take(2 * B * 256 * 512 * 2);
    p.oTOKE = take(T * 2 * 4); p.oTOKW = take(T * 2 * 4); p.oTOKS = take(T * 2 * 4); p.oR2T = take(p.NR * 4); p.oROWW = take(p.NR * 4);
    p.oWL[0] = take(W_LAYER * 2); p.oWL[1] = take(W_LAYER * 2); p.oWKV = take(2LL * 512 * 1024 * 2); p.oWFFN = take(3 * 1024 * DFF * 2);
    p.oVF = take(T * 256 * 2);
    p.oH = take(T * 1024 * 2);
    p.oP = take(T * 3072 * 2);
    p.oO = take(T * 1024 * 2);
    p.oBO = take(T * 2048);
    p.oMG = take(T * 2048);
    long long end_main = o;
    p.oRWW = p.oBO;
    p.oRWX = p.oRWW + T * 1024;
    p.oGA = p.oRWX + T * 2560;
    p.oCQ = p.oP; p.oCAO = p.oP + T * 512;
    p.oRSA = p.oR2T; p.oRSB = p.oROWW;
    p.oCCNT = p.oKCMP; p.oCOFF = p.oVCMP;
    p.oMEMN = p.oBO;
    p.oACT = p.oP;
    long long q = p.oP;
    p.oMOEW = q; q = al256(q + 8LL * 3 * 1024 * DFF * 2);
    const long long ntmax = p.NR / 256, ct = ntmax >= 512 ? 256 : (ntmax + 2) / 3;
    p.oACTC = q; q = al256(q + ct * 256 * DFF * 2);
    p.oY = q; q = al256(q + p.NR * 2048);
    p.oHS = 0;
    p.wsNeed = q > end_main ? q : end_main;
}
#define WSP(T_, off) ((T_*)(p.ws + (off)))

DEVI void cvt_tile8(bf16_t* dst, long long K, const float* src0, long long ld, const float* gk = nullptr) {
    float v[8][8];
#pragma unroll
    for (int kk = 0; kk < 8; ++kk) { const float gg = gk ? gk[kk] : 1.0f;
#pragma unroll
        for (int nn = 0; nn < 8; ++nn) v[kk][nn] = src0[kk * ld + nn] * gg; }
#pragma unroll
    for (int nn = 0; nn < 8; ++nn) { float o[8];
#pragma unroll
        for (int kk = 0; kk < 8; ++kk) o[kk] = v[kk][nn];
        st8(dst + nn * K, o); }
}
DEVI void cvt_T(bf16_t* dst, const float* src, long long K, long long N, long long Npad, long long ld, long long gtid, long long gsz, const float* gain = nullptr) {
    (void)Npad; const long long tk = K >> 6, tiles = (N >> 6) * tk;
    for (long long i = gtid; i < tiles * 64; i += gsz) { const long long tile = i >> 6; const int li = (int)(i & 63), kl = li >> 3, nl = li & 7; const long long n0 = (tile / tk) * 64 + 8 * nl, k0 = (tile % tk) * 64 + 8 * kl;
        cvt_tile8(dst + n0 * K + k0, K, src + k0 * ld + n0, ld, gain ? gain + k0 : nullptr); }
}
DEVI void cvt_gate(bf16_t* dst, const float* wg, long long gtid, long long gsz, const float* gain = nullptr) {
    const long long tiles = (4096 >> 6) * 16;
    for (long long i = gtid; i < tiles * 64; i += gsz) { const long long tile = i >> 6; const int li = (int)(i & 63), kl = li >> 3, nl = li & 7; const long long n0 = (tile >> 4) * 64 + 8 * nl, k0 = (tile & 15) * 64 + 8 * kl;
        const long long q = n0 >> 8; const int w = (int)(n0 & 255), bj = w >> 7, c8 = w & 127; const float* sa = wg + (long long)(2 * bj) * 1024 * 1024 + k0 * 1024 + 64 * q + (c8 >> 1); const float* sb = sa + 1024 * 1024;
        float v[8][8];
#pragma unroll
        for (int kk = 0; kk < 8; ++kk) { const float gg = gain ? gain[k0 + kk] : 1.0f;
#pragma unroll
            for (int nn = 0; nn < 4; ++nn) { v[kk][nn] = sa[kk * 1024 + nn] * gg; v[kk][4 + nn] = sb[kk * 1024 + nn] * gg; } }
#pragma unroll
        for (int nn = 0; nn < 8; ++nn) { float o[8];
#pragma unroll
            for (int kk = 0; kk < 8; ++kk) o[kk] = v[kk][nn];
            st8(dst + (n0 + nn) * 1024 + k0, o); } }
}
DEVI void cvt_GU(bf16_t* dst, const float* wg, const float* wu, long long DFF, long long gtid, long long gsz, const float* gain = nullptr) {
    const long long tiles = (2 * DFF >> 6) * 16;
    for (long long i = gtid; i < tiles * 64; i += gsz) { const long long tile = i >> 6; const int li = (int)(i & 63), kl = li >> 3, nl = li & 7; const long long rr0 = (tile >> 4) * 64 + 8 * nl, k0 = (tile & 15) * 64 + 8 * kl;
        const long long t = rr0 >> 8, w = rr0 & 255; const float* src = (w < 128 ? wg : wu) + k0 * DFF + t * 128 + (w & 127);
        cvt_tile8(dst + rr0 * 1024 + k0, 1024, src, DFF, gain ? gain + k0 : nullptr); }
}
DEVI long long rot_gtid(long long gtid, long long gsz, long long& off, long long n) { long long r = gtid - off % gsz; if (r < 0) r += gsz; off += n; return r; }
DEVI void ph_convert_layer(const Params& p, int l, long long gtid, long long gsz, long long& off) {
    bf16_t* W = WSP(bf16_t, p.oWL[l]);
    for (long long i = rot_gtid(gtid, gsz, off, 48LL * 16 * 64); i < 48LL * 16 * 64; i += gsz) { const long long tile = i >> 6; const int li = (int)(i & 63), kl = li >> 3, nl = li & 7; const long long n0 = (tile >> 4) * 64 + 8 * nl, k0 = (tile & 15) * 64 + 8 * kl;
        const float* gk = l == 1 ? p.in[I_NORM_MIX] + 1024 + k0 : nullptr; const float* wsrc = p.in[I_W_IN] + ((long long)l * 1024 + k0) * INW;
        if (n0 + 8 <= 1036) cvt_tile8(W + W_IN + n0 * 1024 + k0, 1024, wsrc + n0, INW, gk);
        else if (n0 >= C_POOL && n0 + 8 <= C_VRES) cvt_tile8(W + W_IN + n0 * 1024 + k0, 1024, wsrc + n0 - 4, INW, gk);
        else {
#pragma unroll
            for (int nn = 0; nn < 8; ++nn) { const long long n = n0 + nn; float o[8];
#pragma unroll
                for (int kk = 0; kk < 8; ++kk) { const long long k = k0 + kk; float v = 0.f;
                    if (n < 1036) v = p.in[I_W_IN][((long long)l * 1024 + k) * INW + n];
                    else if (n >= C_POOL && n < C_VRES) v = p.in[I_W_IN][((long long)l * 1024 + k) * INW + n - 4];
                    else if (n >= C_VRES && n < C_VRES + 32 && l == 1) v = p.in[I_RW_V1][k * 32 + (n - C_VRES)];
                    o[kk] = l == 1 ? v * p.in[I_NORM_MIX][1024 + k] : v; }
                st8(W + W_IN + n * 1024 + k0, o); } } }
    cvt_gate(W + W_G, p.in[I_W_GATE] + (long long)l * 4 * 1024 * 1024, rot_gtid(gtid, gsz, off, 65536), gsz, l == 1 ? p.in[I_NORM_MIX] + 1024 : nullptr);
    for (int i = 0; i < 4; ++i) cvt_T(W + W_B + (long long)i * 1024 * 256, p.in[I_W_BRANCH] + ((long long)l * 4 + i) * 256 * 1024, 256, 1024, 1024, 1024, rot_gtid(gtid, gsz, off, 4096), gsz);
    cvt_T(W + W_O, p.in[I_W_OUT] + (long long)l * 1024 * 1024, 1024, 1024, 1024, 1024, rot_gtid(gtid, gsz, off, 16384), gsz);
    cvt_T(W + W_CQ, p.in[I_CA_Q] + (long long)l * 1024 * 256, 1024, 256, 256, 256, rot_gtid(gtid, gsz, off, 4096), gsz, p.in[I_NORM_CA] + l * 1024);
    cvt_T(WSP(bf16_t, p.oWKV) + (long long)l * 512 * 1024, p.in[I_CA_KV] + (long long)l * 1024 * 512, 1024, 512, 512, 512, rot_gtid(gtid, gsz, off, 8192), gsz);
    cvt_T(W + W_CO, p.in[I_CA_O] + (long long)l * 256 * 1024, 256, 1024, 1024, 1024, rot_gtid(gtid, gsz, off, 4096), gsz);
}
DEVI void ph_convert_ffn(const Params& p, long long gtid, long long gsz, long long& off) {
    bf16_t* W = WSP(bf16_t, p.oWFFN);
    cvt_GU(W, p.in[I_FFN_G], p.in[I_FFN_U], p.DFF, rot_gtid(gtid, gsz, off, (2 * p.DFF >> 6) * 16 * 64), gsz, p.in[I_NORM_FFN]);
    cvt_T(W + 2 * p.DFF * 1024, p.in[I_FFN_D], p.DFF, 1024, 1024, 1024, rot_gtid(gtid, gsz, off, (p.DFF >> 6) * 16 * 64), gsz);
}
DEVI void ph_convert_moe(const Params& p, long long gtid, long long gsz) {
    const long long DFF = p.DFF, per = 3 * 1024 * DFF;
    long long off = 0;
    for (int e = 0; e < 8; ++e) { bf16_t* W = WSP(bf16_t, p.oMOEW) + e * per;
        cvt_GU(W, p.in[I_MOE_G] + (long long)e * 1024 * DFF, p.in[I_MOE_U] + (long long)e * 1024 * DFF, DFF, rot_gtid(gtid, gsz, off, (2 * DFF >> 6) * 16 * 64), gsz);
        cvt_T(W + 2 * DFF * 1024, p.in[I_MOE_D] + (long long)e * DFF * 1024, DFF, 1024, 1024, 1024, rot_gtid(gtid, gsz, off, (DFF >> 6) * 16 * 64), gsz); }
}
DEVI void ph_rope(const Params& p, long long gtid, long long gsz) {
    const int* pos = (const int*)p.in[I_POS]; float* R = WSP(float, p.oROPE);
    for (long long i = gtid; i < p.T * 8; i += gsz) { const long long t = i >> 3; const int j = (int)(i & 7);
        const float ang = (float)pos[t] * p.inv_freq[j];
        double a = (double)ang; a -= 6.283185307179586476925 * floor(a * 0.15915494309189533577 + 0.5);
        const float ar = (float)a; R[t * 16 + j] = cosf(ar); R[t * 16 + 8 + j] = sinf(ar); }
}
DEVI void ph_rope_apply(const Params& p, long long gtid, long long gsz) {
    bf16_t* P = WSP(bf16_t, p.oP); const float* R = WSP(float, p.oROPE);
    for (long long i = gtid; i < p.T * 8; i += gsz) { const long long t = i >> 3; const int w = (int)(i & 7);
        const int col = w < 4 ? C_Q + w * 64 : (w < 6 ? C_KS + (w - 4) * 64 : C_KW + (w - 6) * 64);
        bf16_t* x = P + t * PW + col; const float* r = R + t * 16; const float sc = w < 4 ? QSCALE : 1.0f;
        float a[8], b[8], c[8], s[8], o1[8], o2[8]; ld8(x, a); ld8(x + 8, b);
#pragma unroll
        for (int j = 0; j < 8; ++j) { c[j] = r[j]; s[j] = r[8 + j]; }
#pragma unroll
        for (int j = 0; j < 8; ++j) { o1[j] = (a[j] * c[j] - b[j] * s[j]) * sc; o2[j] = (b[j] * c[j] + a[j] * s[j]) * sc; }
        st8(x, o1); st8(x + 8, o2);
        if (w < 4) {
#pragma unroll
            for (int q8 = 2; q8 < 8; ++q8) { float f[8]; ld8(x + 8 * q8, f);
#pragma unroll
                for (int j = 0; j < 8; ++j) f[j] *= QSCALE;
                st8(x + 8 * q8, f); } } }
}
DEVI void ph_compress2(const Params& p, int l, long long gtid, long long gsz) {
    const bf16_t* UV = WSP(bf16_t, p.oUV); const float* CB = WSP(float, p.oCB) + l * 256; const float* w2 = p.in[I_CMP_W2] + (long long)l * 2 * 128 * 64; const float* R = WSP(float, p.oROPE);
    bf16_t* KC = WSP(bf16_t, p.oKCMP); bf16_t* VC = WSP(bf16_t, p.oVCMP);
    const long long n_items = p.B * p.NC * 2 * 2 * 8, hb = p.S / 16;
    for (long long i = gtid; i < p.B * 2 * (128 - p.NC) * 64; i += gsz) { const long long bgi = i / ((128 - p.NC) * 64), rem = i % ((128 - p.NC) * 64); KC[(bgi * 128 + p.NC) * 64 + rem] = 0; VC[(bgi * 128 + p.NC) * 64 + rem] = 0; }
    for (long long i = gtid; i < n_items; i += gsz) { const int d8 = (int)(i & 7), j = (int)((i >> 3) & 1), g = (int)((i >> 4) & 1); const long long bn = i >> 5, n = bn % p.NC, b = bn / p.NC;
        const bf16_t* u = UV + ((b * hb + n) * 4 + (2 * j + g)) * 256; const bf16_t* vv = u + 4 * 256 + 128; const float* w = w2 + (long long)j * 128 * 64; const float* cb = CB + j * 128;
        float a[8];
#pragma unroll
        for (int m = 0; m < 8; ++m) a[m] = 0.f;
        for (int f = 0; f < 128; ++f) { const float hv = gelu_tanhf_(bf2f(u[f]) + bf2f(vv[f]) + cb[f]);
#pragma unroll
            for (int m = 0; m < 8; ++m) a[m] += hv * w[f * 64 + d8 + 8 * m]; }
        if (j == 0) { const float* r = R + (b * p.S + n * 16 + 31) * 16; const float x0 = a[0], x1 = a[1], cs = r[d8], sn = r[8 + d8]; a[0] = x0 * cs - x1 * sn; a[1] = x1 * cs + x0 * sn; }
        bf16_t* dst = (j == 0 ? KC : VC) + (((b * 2 + g) * 128) + n) * 64;
#pragma unroll
        for (int m = 0; m < 8; ++m) dst[d8 + 8 * m] = f2bf(a[m]); }
}
#ifndef CPU_EMU
DEVI float wave_sum(float v);
#endif
DEVI void ph_convert_cmp(const Params& p, long long gtid, long long gsz) {
    bf16_t* W1T = WSP(bf16_t, p.oW1T); float* CB = WSP(float, p.oCB);
    for (long long i = gtid; i < 2LL * 2 * 256 * 1024; i += gsz) { const int k = (int)(i & 1023), n = (int)((i >> 10) & 255); const long long lj = i >> 18; const int half = n >> 7, f = n & 127, tap = k >> 6, d = k & 63;
        W1T[i] = f2bf(p.in[I_CMP_W1][((lj * 32 + half * 16 + tap) * 64 + d) * 128 + f]); }
#ifdef CPU_EMU
    for (long long i = gtid; i < 2 * 2 * 128; i += gsz) { const int f = (int)(i & 127); const long long lj = i >> 7; float a = 0.f;
        for (int k = 0; k < 2048; ++k) a += p.in[I_CMP_PE][lj * 2048 + k] * p.in[I_CMP_W1][(lj * 2048 + k) * 128 + f];
        CB[i] = a; }
#else
    {   const long long gw_ = gtid >> 6, nw_ = gsz >> 6; const int ln = (int)(gtid & 63);
        for (long long i = gw_; i < 2 * 2 * 128; i += nw_) { const int f = (int)(i & 127); const long long lj = i >> 7; float a = 0.f;
#pragma unroll 8
            for (int k = ln; k < 2048; k += 64) a += p.in[I_CMP_PE][lj * 2048 + k] * p.in[I_CMP_W1][(lj * 2048 + k) * 128 + f];
            a = wave_sum(a); if (ln == 0) CB[i] = a; } }
#endif
}
DEVI void pool_fill_w(const Params& p, int l, LDSQ float* wl, int tid, int nthr) { const float* pw = p.in[I_POOL_W] + (long long)l * 4 * 64 * 64; for (int i = tid; i < 4 * 64 * 64; i += nthr) wl[i] = pw[i]; }
template <int WIN> DEVI void pool_item(const Params& p, int l, const LDSQ float* wl, int g, long long t, int hf) {
    const bf16_t* P = WSP(bf16_t, p.oP); bf16_t* O = WSP(bf16_t, p.oO);
    const LDSQ float* w = wl + g * 64 * 64 + hf * 32; const float* ps = p.in[I_POOL_SCALE] + (long long)l * 256 + g * 64 + hf * 32;
    const long long s = t % p.S; const int cnt = (int)(s + 1 < WIN ? s + 1 : WIN); const float inv = 1.0f / (float)cnt;
    float a[32];
#pragma unroll
    for (int d = 0; d < 32; ++d) a[d] = 0.f;
#pragma nounroll
    for (int c8 = 0; c8 < 8; ++c8) { float dv[8], f0[8];
        ld8(P + t * PW + C_POOL + g * 64 + 8 * c8, f0);
#pragma unroll
        for (int j = 0; j < 8; ++j) dv[j] = f0[j];
#pragma unroll
        for (int k = 1; k < WIN; ++k) { float f[8];
            if (k < cnt) ld8(P + (t - k) * PW + C_POOL + g * 64 + 8 * c8, f); else {
#pragma unroll
                for (int j = 0; j < 8; ++j) f[j] = 0.f; }
#pragma unroll
            for (int j = 0; j < 8; ++j) dv[j] += f[j]; }
#pragma unroll
        for (int j = 0; j < 8; ++j) { const float x = dv[j] * inv - f0[j]; const LDSQ float* wr = w + (8 * c8 + j) * 64;
#pragma unroll
            for (int d = 0; d < 32; ++d) a[d] += x * wr[d];
            if (j & 1) SCHED_FENCE(); } }
#pragma unroll
    for (int d8 = 0; d8 < 4; ++d8) { float o[8];
#pragma unroll
        for (int j = 0; j < 8; ++j) o[j] = a[8 * d8 + j] * ps[8 * d8 + j];
        st8(O + t * 1024 + 256 + g * 64 + hf * 32 + 8 * d8, o); }
}
DEVI void ph_pool(const Params& p, int l, const LDSQ float* wl, long long gtid, long long gsz) {
    for (long long i = gtid; i < p.T * 8; i += gsz) { const int g = (int)(i / (p.T * 2)); const long long rem = i % (p.T * 2), t = rem >> 1; const int hf = (int)(rem & 1);
        if (g == 0) pool_item<2>(p, l, wl, 0, t, hf); else if (g == 1) pool_item<4>(p, l, wl, 1, t, hf); else if (g == 2) pool_item<8>(p, l, wl, 2, t, hf); else pool_item<16>(p, l, wl, 3, t, hf); }
}
DEVI void st16bf(bf16_t* dst, const float (&v)[16]) { st8(dst, v); st8(dst + 8, v + 8); }
DEVI float pick8v(float a0, float a1, float a2, float a3, float a4, float a5, float a6, float a7, int i) {
    float r = a0; r = (i == 1) ? a1 : r; r = (i == 2) ? a2 : r; r = (i == 3) ? a3 : r; r = (i == 4) ? a4 : r; r = (i == 5) ? a5 : r; r = (i == 6) ? a6 : r; r = (i == 7) ? a7 : r; return r; }
#define pick8(a, i) pick8v((a)[0], (a)[1], (a)[2], (a)[3], (a)[4], (a)[5], (a)[6], (a)[7], (i))
DEVI void lerp8(const bf16_t* x, const bf16_t* xp, const float* mu, bool first, float* out) {
    float a[8], b[8]; ld8(x, a);
    if (first) {
#pragma unroll
        for (int j = 0; j < 8; ++j) b[j] = 0.f; } else ld8(xp, b);
#pragma unroll
    for (int j = 0; j < 8; ++j) out[j] = a[j] + (b[j] - a[j]) * mu[j];
}
DEVI float rwkv_wrow(const Params& p, int l, int r, int c) {
    if (r < 32) return p.in[I_RW_W2][l * 32 * 256 + r * 256 + c]; if (r < 64) return p.in[I_RW_A2][l * 32 * 256 + (r - 32) * 256 + c];
    if (r < 96) return (l == 1) ? p.in[I_RW_V2][(r - 64) * 256 + c] : 0.f; return p.in[I_RW_G2][l * 64 * 256 + (r - 96) * 256 + c]; }
DEVI void rwkv_fill_wl(const Params& p, int l, LDSQ unsigned* wl, int tid, int nthr) {
    for (int i = tid; i < 80 * 256; i += nthr) { const int jp = i >> 8, c = i & 255; wl[i] = (unsigned)f2bf(rwkv_wrow(p, l, 2 * jp, c)) | ((unsigned)f2bf(rwkv_wrow(p, l, 2 * jp + 1, c)) << 16); }
}
DEVI float rwkv_feat(const Params& p, int l, long long t, int j) {
    const bf16_t* P = WSP(bf16_t, p.oP); const float* mu = p.in[I_RW_MU] + l * 896; const bool first = (t % p.S) == 0; const bf16_t* x = P + t * PW + C_RW; const bf16_t* xp = x - PW;
    if (j >= 64 && j < 96) return (l == 1) ? bf2f(P[t * PW + C_VRES + (j - 64)]) : 0.f;
    const int c = j < 32 ? 768 + j : (j < 64 ? 800 + (j - 32) : 832 + (j - 96)); const float a = bf2f(x[c]), bb = first ? 0.f : bf2f(xp[c]); const float lv = a + (bb - a) * mu[c];
    return j < 32 ? tanhf_(lv) : (j < 64 ? lv : sigmoidf_(lv));
}
DEVI void rwkv_prep_step1(const Params& p, int l, LDSQ unsigned* FP, LDSQ float* KN, long long tile, int tid) {
    const bf16_t* P = WSP(bf16_t, p.oP); const float* mu = p.in[I_RW_MU] + l * 896; const float* kkw = p.in[I_RW_KK] + l * 256;
    for (int idx = tid; idx < 32 * 80; idx += 512) { const int tt = idx / 80, jp = idx % 80; const long long t = tile * 32 + tt;
        FP[idx] = pk2bf(rwkv_feat(p, l, t, 2 * jp), rwkv_feat(p, l, t, 2 * jp + 1)); }
    if (tid < 128) { const int tt = tid >> 2, h = tid & 3; const long long t = tile * 32 + tt; const bool first = (t % p.S) == 0; const bf16_t* x = P + t * PW + C_RW; const bf16_t* xp = x - PW; float nn = 0.f;
#pragma unroll 4
        for (int q8 = 0; q8 < 8; ++q8) { float kq[8]; lerp8(x + 256 + h * 64 + 8 * q8, xp + 256 + h * 64 + 8 * q8, mu + 256 + h * 64 + 8 * q8, first, kq);
#pragma unroll
            for (int j = 0; j < 8; ++j) { const float e = kq[j] * kkw[h * 64 + 8 * q8 + j]; nn += e * e; } }
        KN[tid] = 1.0f / fmaxf(sqrtf(nn), 1e-12f); }
}
#ifndef CPU_EMU
DEVI void rwkv_fill_wl_gpu(const Params& p, int l, LDSQ unsigned* wl, int tid) {
    asm volatile("" : "+v"(tid));
    const float* w2 = p.in[I_RW_W2] + l * 32 * 256; const float* a2 = p.in[I_RW_A2] + l * 32 * 256; const float* v2 = p.in[I_RW_V2]; const float* g2 = p.in[I_RW_G2] + l * 64 * 256; const int c = tid & 255, j0 = tid >> 8;
#pragma nounroll
    for (int k0 = 0; k0 < 40; k0 += 8) { float lo[8], hi[8];
#pragma unroll
        for (int k = 0; k < 8; ++k) { const int jp = 2 * (k0 + k) + j0, r = 2 * jp; const bool zero = (r >= 64 && r < 96 && l == 0);
            const float* src = r < 32 ? w2 + r * 256 : (r < 64 ? a2 + (r - 32) * 256 : (r < 96 ? (zero ? w2 : v2 + (r - 64) * 256) : g2 + (r - 96) * 256));
            const float x0 = src[c], x1 = src[256 + c]; lo[k] = zero ? 0.f : x0; hi[k] = zero ? 0.f : x1; }
#pragma unroll
        for (int k = 0; k < 8; ++k) wl[(2 * (k0 + k) + j0) * 256 + c] = pk2bf(lo[k], hi[k]); }
}
DEVI void rwkv_prep_step1_gpu(const Params& p, int l, LDSQ unsigned* FP, LDSQ float* KN, long long tile, int tid) {
    const bf16_t* P = WSP(bf16_t, p.oP); const float* mu = p.in[I_RW_MU] + l * 896; const float* kkw = p.in[I_RW_KK] + l * 256;
    asm volatile("" : "+v"(tid));
    const bool tile_first = ((tile * 32) % p.S) == 0;
    unsigned av[5], bv[5]; float m0[5], m1[5];
#pragma unroll
    for (int it = 0; it < 5; ++it) { const int idx = tid + 512 * it, tt = idx / 80, j = 2 * (idx % 80); const long long t = tile * 32 + tt; const bool first = tile_first && tt == 0, vres = (j >= 64 && j < 96);
        const int c = j < 32 ? 768 + j : (j < 64 ? 800 + (j - 32) : (j < 96 ? 768 : 832 + (j - 96)));
        const bf16_t* pa = vres ? P + t * PW + C_VRES + (j - 64) : P + t * PW + C_RW + c; const bf16_t* pb = (first || vres) ? pa : pa - PW;
        av[it] = *(const unsigned*)pa; bv[it] = *(const unsigned*)pb; m0[it] = mu[c]; m1[it] = mu[c + 1]; }
#pragma unroll
    for (int it = 0; it < 5; ++it) { const int idx = tid + 512 * it, tt = idx / 80, j = 2 * (idx % 80); const bool first = tile_first && tt == 0, vres = (j >= 64 && j < 96);
        const float a0 = u2f(av[it] << 16), a1 = u2f(av[it] & 0xffff0000u), b0 = first ? 0.f : u2f(bv[it] << 16), b1 = first ? 0.f : u2f(bv[it] & 0xffff0000u);
        const float l0 = a0 + (b0 - a0) * m0[it], l1 = a1 + (b1 - a1) * m1[it];
        float o0, o1;
        if (vres) { o0 = (l == 1) ? a0 : 0.f; o1 = (l == 1) ? a1 : 0.f; } else if (j < 32) { o0 = tanhf_(l0); o1 = tanhf_(l1); } else if (j < 64) { o0 = l0; o1 = l1; } else { o0 = sigmoidf_(l0); o1 = sigmoidf_(l1); }
        FP[idx] = pk2bf(o0, o1); }
    if (tid < 128) { const int tt = tid >> 2, h = tid & 3; const long long t = tile * 32 + tt; const bool first = tile_first && tt == 0; const bf16_t* x = P + t * PW + C_RW; const bf16_t* xp = x - PW; float nn = 0.f;
#pragma unroll 4
        for (int q8 = 0; q8 < 8; ++q8) { float kq[8]; lerp8(x + 256 + h * 64 + 8 * q8, xp + 256 + h * 64 + 8 * q8, mu + 256 + h * 64 + 8 * q8, first, kq);
#pragma unroll
            for (int jj = 0; jj < 8; ++jj) { const float e = kq[jj] * kkw[h * 64 + 8 * q8 + jj]; nn += e * e; } }
        KN[tid] = 1.0f / fmaxf(sqrtf(nn), 1e-12f); }
}
#endif
DEVI void ld4u(const LDSQ unsigned* src, unsigned* v) {
#ifdef CPU_EMU
    v[0] = src[0]; v[1] = src[1]; v[2] = src[2]; v[3] = src[3];
#else
    const u32x4l_t w = *(const LDSQ u32x4l_t*)src; v[0] = w[0]; v[1] = w[1]; v[2] = w[2]; v[3] = w[3];
#endif
}
DEVI void rwkv_prep_step2(const Params& p, int l, const LDSQ unsigned* wl, const LDSQ unsigned* FP, const LDSQ float* KN, long long tile, int tid, const LDSQ float* Z = nullptr) {
    const bf16_t* P = WSP(bf16_t, p.oP); float* RWW = WSP(float, p.oRWW); bf16_t* RWX = WSP(bf16_t, p.oRWX); bf16_t* O = WSP(bf16_t, p.oO); bf16_t* VF = WSP(bf16_t, p.oVF);
    const float* mu = p.in[I_RW_MU] + l * 896; const float* w0 = p.in[I_RW_W0] + l * 256; const float* a0 = p.in[I_RW_A0] + l * 256;
    const float* kkw = p.in[I_RW_KK] + l * 256; const float* kaw = p.in[I_RW_KA] + l * 256; const float* v0 = p.in[I_RW_V0];
    const int tt = tid >> 4, h = (tid >> 2) & 3, cc = tid & 3; const long long t = tile * 32 + tt; const bool first = (t % p.S) == 0;
    const bf16_t* x = P + t * PW + C_RW; const bf16_t* xp = x - PW; const int c0 = h * 64 + cc * 16; const LDSQ unsigned* f = FP + tt * 80;
    const float rn = KN[tt * 4 + h];
    float zw[16], za[16], zg[16], zv[16];
#pragma unroll
    for (int u = 0; u < 16; ++u) { zw[u] = w0[c0 + u]; za[u] = a0[c0 + u]; zg[u] = 0.f; zv[u] = (l == 1) ? v0[c0 + u] : 0.f; }
#ifndef CPU_EMU
    (void)wl; (void)f;
#pragma unroll
    for (int q4 = 0; q4 < 4; ++q4) { const f32x4l_t a_ = *(const LDSQ f32x4l_t*)(Z + (0 * 32 + tt) * 256 + c0 + 4 * q4), b_ = *(const LDSQ f32x4l_t*)(Z + (1 * 32 + tt) * 256 + c0 + 4 * q4), d_ = *(const LDSQ f32x4l_t*)(Z + (3 * 32 + tt) * 256 + c0 + 4 * q4);
#pragma unroll
        for (int u = 0; u < 4; ++u) { zw[4 * q4 + u] += a_[u]; za[4 * q4 + u] += b_[u]; zg[4 * q4 + u] += d_[u]; }
        if (l == 1) { const f32x4l_t c_ = *(const LDSQ f32x4l_t*)(Z + (2 * 32 + tt) * 256 + c0 + 4 * q4);
#pragma unroll
            for (int u = 0; u < 4; ++u) zv[4 * q4 + u] += c_[u]; } }
#else
#pragma unroll 2
    for (int jp = 0; jp < 16; ++jp) { const unsigned fw = f[jp], fa = f[16 + jp], fv = f[32 + jp]; unsigned ww[16], wa[16], wv[16];
#pragma unroll
        for (int q4 = 0; q4 < 4; ++q4) { ld4u(wl + jp * 256 + c0 + 4 * q4, ww + 4 * q4); ld4u(wl + (16 + jp) * 256 + c0 + 4 * q4, wa + 4 * q4); if (l == 1) ld4u(wl + (32 + jp) * 256 + c0 + 4 * q4, wv + 4 * q4); }
#pragma unroll
        for (int u = 0; u < 16; ++u) { zw[u] = dot2bf(fw, ww[u], zw[u]); za[u] = dot2bf(fa, wa[u], za[u]); if (l == 1) zv[u] = dot2bf(fv, wv[u], zv[u]); } }
#pragma unroll 4
    for (int jp = 0; jp < 32; ++jp) { const unsigned fg = f[48 + jp]; unsigned wg[16];
#pragma unroll
        for (int q4 = 0; q4 < 4; ++q4) ld4u(wl + (48 + jp) * 256 + c0 + 4 * q4, wg + 4 * q4);
#pragma unroll
        for (int u = 0; u < 16; ++u) zg[u] = dot2bf(fg, wg[u], zg[u]); }
#endif
    st16bf(O + t * 1024 + 512 + c0, zg);
#pragma unroll
    for (int hf = 0; hf < 2; ++hf) { const int cb = c0 + 8 * hf; float r8[8], k8[8], v8[8], vf8[8], kk8[8], b8[8], d8[8];
        lerp8(x + cb, xp + cb, mu + cb, first, r8); lerp8(x + 256 + cb, xp + 256 + cb, mu + 256 + cb, first, k8); lerp8(x + 512 + cb, xp + 512 + cb, mu + 512 + cb, first, v8);
        if (l == 1) ld8(VF + t * 256 + cb, vf8);
#pragma unroll
        for (int u = 0; u < 8; ++u) { const int c = cb + u, uu = 8 * hf + u;
            const float wlog = -softplusf_(-zw[uu]) - 0.5f, dec = expf_(-expf_(wlog)), a = sigmoidf_(za[uu]);
            const float k = k8[u]; float v = v8[u];
            if (l == 1) v = v + (vf8[u] - v) * sigmoidf_(zv[uu]);
            const float kk = k * kkw[c] * rn;
            d8[u] = dec; k8[u] = k * (1.0f + (a - 1.0f) * kaw[c]); v8[u] = v; kk8[u] = kk; b8[u] = kk * a; }
        float* ww = RWW + t * 256 + cb;
#pragma unroll
        for (int u = 0; u < 8; ++u) ww[u] = d8[u];
        bf16_t* rx = RWX + t * 1280 + cb;
        st8(rx, r8); st8(rx + 256, k8); st8(rx + 512, v8); st8(rx + 768, kk8); st8(rx + 1024, b8);
        if (l == 0) st8(VF + t * 256 + cb, v8);
        SCHED_FENCE(); }
}
#ifndef CPU_EMU
DEVI void dec8(const uint4& w, float* v) { v[0] = u2f(w.x << 16); v[1] = u2f(w.x & 0xffff0000u); v[2] = u2f(w.y << 16); v[3] = u2f(w.y & 0xffff0000u); v[4] = u2f(w.z << 16); v[5] = u2f(w.z & 0xffff0000u); v[6] = u2f(w.w << 16); v[7] = u2f(w.w & 0xffff0000u); }
DEVI void rwkv_fill_prm(const Params& p, int l, LDSQ float* PRM, int tid) {
    { const float* s_ = p.in[I_RW_MU] + l * 896; for (int i = tid; i < 768; i += 512) PRM[i] = s_[i]; }
    { const float* s_ = p.in[I_RW_W0] + l * 256; if (tid < 256) PRM[768 + tid] = s_[tid]; }
    { const float* s_ = p.in[I_RW_A0] + l * 256; if (tid < 256) PRM[1024 + tid] = s_[tid]; }
    { const float* s_ = p.in[I_RW_V0]; if (tid < 256) PRM[1280 + tid] = (l == 1) ? s_[tid] : 0.f; }
    { const float* s_ = p.in[I_RW_KK] + l * 256; if (tid < 256) PRM[1536 + tid] = s_[tid]; }
    { const float* s_ = p.in[I_RW_KA] + l * 256; if (tid < 256) PRM[1792 + tid] = s_[tid]; }
}
DEVI void rwkv_prep_step2_gpu(const Params& p, int l, const LDSQ float* PRM, const LDSQ float* KN, const LDSQ float* Z, long long tile, int tid) {
    asm volatile("" : "+v"(tid));
    const bf16_t* P = WSP(bf16_t, p.oP); float* RWW = WSP(float, p.oRWW); bf16_t* RWX = WSP(bf16_t, p.oRWX); bf16_t* O = WSP(bf16_t, p.oO); bf16_t* VF = WSP(bf16_t, p.oVF);
    const int tt = tid >> 4, h = (tid >> 2) & 3, cc = tid & 3; const long long t = tile * 32 + tt; const bool first = ((int)t % (int)p.S) == 0;
    const bf16_t* x = P + t * PW + C_RW; const bf16_t* xp = first ? x : x - PW; const int c0 = h * 64 + cc * 16;
    uint4 dx[2][3], dp[2][3], dv[2];
#pragma unroll
    for (int hf = 0; hf < 2; ++hf) { const int cb = c0 + 8 * hf;
#pragma unroll
        for (int s3 = 0; s3 < 3; ++s3) { dx[hf][s3] = *(const uint4*)(x + 256 * s3 + cb); dp[hf][s3] = *(const uint4*)(xp + 256 * s3 + cb); }
        dv[hf] = (l == 1) ? *(const uint4*)(VF + t * 256 + cb) : make_uint4(0u, 0u, 0u, 0u); }
    const float rn = KN[tt * 4 + h];
    float zw[16], za[16], zg[16], zv[16];
#pragma unroll
    for (int q4 = 0; q4 < 4; ++q4) { const f32x4l_t a_ = *(const LDSQ f32x4l_t*)(Z + (0 * 32 + tt) * 256 + c0 + 4 * q4), b_ = *(const LDSQ f32x4l_t*)(Z + (1 * 32 + tt) * 256 + c0 + 4 * q4), d_ = *(const LDSQ f32x4l_t*)(Z + (3 * 32 + tt) * 256 + c0 + 4 * q4);
        const f32x4l_t w0_ = *(const LDSQ f32x4l_t*)(PRM + 768 + c0 + 4 * q4), a0_ = *(const LDSQ f32x4l_t*)(PRM + 1024 + c0 + 4 * q4);
#pragma unroll
        for (int u = 0; u < 4; ++u) { zw[4 * q4 + u] = w0_[u] + a_[u]; za[4 * q4 + u] = a0_[u] + b_[u]; zg[4 * q4 + u] = d_[u]; zv[4 * q4 + u] = 0.f; }
        if (l == 1) { const f32x4l_t c_ = *(const LDSQ f32x4l_t*)(Z + (2 * 32 + tt) * 256 + c0 + 4 * q4), v0_ = *(const LDSQ f32x4l_t*)(PRM + 1280 + c0 + 4 * q4);
#pragma unroll
            for (int u = 0; u < 4; ++u) zv[4 * q4 + u] = v0_[u] + c_[u]; } }
    st16bf(O + t * 1024 + 512 + c0, zg);
#pragma unroll
    for (int hf = 0; hf < 2; ++hf) { const int cb = c0 + 8 * hf; float r8[8], k8[8], v8[8], vf8[8], kk8[8], b8[8], d8[8], xa[8], xb[8];
#define RW_LERP(s3, out) do { dec8(dx[hf][s3], xa); dec8(dp[hf][s3], xb); \
            const f32x4l_t m0_ = *(const LDSQ f32x4l_t*)(PRM + 256 * (s3) + cb), m1_ = *(const LDSQ f32x4l_t*)(PRM + 256 * (s3) + cb + 4); \
            const float mm_[8] = {m0_[0], m0_[1], m0_[2], m0_[3], m1_[0], m1_[1], m1_[2], m1_[3]}; \
            _Pragma("unroll") for (int j = 0; j < 8; ++j) { const float bj = first ? 0.f : xb[j]; out[j] = xa[j] + (bj - xa[j]) * mm_[j]; } } while (0)
        RW_LERP(0, r8); RW_LERP(1, k8); RW_LERP(2, v8);
#undef RW_LERP
        if (l == 1) dec8(dv[hf], vf8);
        const f32x4l_t kk0_ = *(const LDSQ f32x4l_t*)(PRM + 1536 + cb), kk1_ = *(const LDSQ f32x4l_t*)(PRM + 1536 + cb + 4), ka0_ = *(const LDSQ f32x4l_t*)(PRM + 1792 + cb), ka1_ = *(const LDSQ f32x4l_t*)(PRM + 1792 + cb + 4);
        const float kkv_[8] = {kk0_[0], kk0_[1], kk0_[2], kk0_[3], kk1_[0], kk1_[1], kk1_[2], kk1_[3]}, kav_[8] = {ka0_[0], ka0_[1], ka0_[2], ka0_[3], ka1_[0], ka1_[1], ka1_[2], ka1_[3]};
#pragma unroll
        for (int u = 0; u < 8; ++u) { const int uu = 8 * hf + u; const float kkwc = kkv_[u], kawc = kav_[u];
            const float wlog = -softplusf_(-zw[uu]) - 0.5f, dec = expf_(-expf_(wlog)), a = sigmoidf_(za[uu]);
            const float k = k8[u]; float v = v8[u];
            if (l == 1) v = v + (vf8[u] - v) * sigmoidf_(zv[uu]);
            const float kk = k * kkwc * rn;
            d8[u] = dec; k8[u] = k * (1.0f + (a - 1.0f) * kawc); v8[u] = v; kk8[u] = kk; b8[u] = kk * a; }
        float* ww = RWW + t * 256 + cb;
        *(float4*)ww = make_float4(d8[0], d8[1], d8[2], d8[3]); *(float4*)(ww + 4) = make_float4(d8[4], d8[5], d8[6], d8[7]);
        bf16_t* rx = RWX + t * 1280 + cb;
        st8(rx, r8); st8(rx + 256, k8); st8(rx + 512, v8); st8(rx + 768, kk8); st8(rx + 1024, b8);
        if (l == 0) st8(VF + t * 256 + cb, v8); }
}
#endif
DEVI float rwkv_row_step(float (&st)[64], const float* w, const bf16_t* r, const bf16_t* k, const bf16_t* kk, const bf16_t* b, float v) {
    float skk = 0.f;
#pragma unroll
    for (int c = 0; c < 64; ++c) skk += st[c] * bf2f(kk[c]);
    float y = 0.f;
#pragma unroll
    for (int c = 0; c < 64; ++c) { st[c] = st[c] * w[c] - skk * bf2f(b[c]) + v * bf2f(k[c]); y += st[c] * bf2f(r[c]); }
    return y;
}
DEVI void ph_gla_prep(const Params& p, int l, long long gtid, long long gsz) {
    const bf16_t* P = WSP(bf16_t, p.oP); float* GA = WSP(float, p.oGA); bf16_t* O = WSP(bf16_t, p.oO);
    const float* a2 = p.in[I_GLA_A2] + l * 16 * 128; const float* ab = p.in[I_GLA_AB] + l * 128;
    for (long long i = gtid; i < p.T * 16; i += gsz) { const long long t = i >> 4; const int c0 = (int)(i & 15) * 8; const bf16_t* ad = P + t * PW + C_GLA + 512;
        float adv[16], z[8]; ld8(ad, adv); ld8(ad + 8, adv + 8);
#pragma unroll
        for (int u = 0; u < 8; ++u) z[u] = ab[c0 + u];
#pragma unroll
        for (int j = 0; j < 16; ++j) {
#pragma unroll
            for (int u = 0; u < 8; ++u) z[u] += adv[j] * a2[j * 128 + c0 + u]; }
#pragma unroll
        for (int u = 0; u < 8; ++u) GA[t * 128 + c0 + u] = expf_(-softplusf_(-z[u]) * 0.0625f);
        const bf16_t* og = P + t * PW + C_GLA + 528 + 2 * c0; float g[16]; ld8(og, g); ld8(og + 8, g + 8);
#pragma unroll
        for (int u = 0; u < 16; ++u) g[u] = siluf_(g[u]);
        st8(O + t * 1024 + 768 + 2 * c0, g); st8(O + t * 1024 + 768 + 2 * c0 + 8, g + 8); }
}
DEVI float gla_col_step(float (&st)[32], const float* a, const bf16_t* q, const bf16_t* k, float v) {
    float o = 0.f;
#pragma unroll
    for (int c = 0; c < 32; ++c) { st[c] = st[c] * a[c] + bf2f(k[c]) * v; o += st[c] * bf2f(q[c]); }
    return o * 0.17677669529663687f;
}
DEVI void ph_cmp_attn(const Params& p, long long gtid, long long gsz) {
    const bf16_t* P = WSP(bf16_t, p.oP); const bf16_t* KCb = WSP(bf16_t, p.oKCMP); const bf16_t* VCb = WSP(bf16_t, p.oVCMP); unsigned* SELM = WSP(unsigned, p.oSELM); bf16_t* O = WSP(bf16_t, p.oO);
    static float KCf[128 * 64], VCf[128 * 64]; long long cached = -1;
    for (long long i = gtid; i < p.T * 2; i += gsz) { const long long t = i >> 1, b = t / p.S, s = t % p.S; const int g = (int)(i & 1);
        const int nv = s >= 31 ? (int)((s - 31) / 16 + 1) : 0;
        const int cur = (int)(s >> 6);
        if (cached != b * 2 + g) { cached = b * 2 + g; for (int e = 0; e < 128 * 64; ++e) { KCf[e] = bf2f(KCb[cached * 128 * 64 + e]); VCf[e] = bf2f(VCb[cached * 128 * 64 + e]); } }
        const float* kc = KCf; const float* vc = VCf;
        float q0[64], q1[64];
        { const bf16_t* q = P + t * PW + C_Q + (2 * g) * 64;
#pragma unroll
          for (int d = 0; d < 64; ++d) { q0[d] = bf2f(q[d]); q1[d] = bf2f(q[64 + d]); } }
        float m0 = -3e38f, m1 = -3e38f;
        for (int n = 0; n < nv; ++n) { const float* k = kc + n * 64; float s0 = 0.f, s1 = 0.f;
#pragma unroll
            for (int d = 0; d < 64; ++d) { s0 += q0[d] * k[d]; s1 += q1[d] * k[d]; }
            m0 = fmaxf(m0, s0); m1 = fmaxf(m1, s1); }
        float z0 = 0.f, z1 = 0.f;
        for (int n = 0; n < nv; ++n) { const float* k = kc + n * 64; float s0 = 0.f, s1 = 0.f;
#pragma unroll
            for (int d = 0; d < 64; ++d) { s0 += q0[d] * k[d]; s1 += q1[d] * k[d]; }
            z0 += expf(s0 - m0); z1 += expf(s1 - m1); }
        const float iz0 = nv ? 1.0f / z0 : 0.f, iz1 = nv ? 1.0f / z1 : 0.f;
        unsigned mask;
        if (cur < 8) mask = (2u << cur) - 1u;
        else {
            float tv0 = -3e38f, tv1 = -3e38f, tv2 = -3e38f, tv3 = -3e38f, tv4 = -3e38f; int ti0 = 0, ti1 = 0, ti2 = 0, ti3 = 0, ti4 = 0;
            float carry = 0.f;
            for (int j = 0; j <= cur - 2; ++j) { float imp = carry;
                for (int mm = 0; mm < 4; ++mm) { const int n = 4 * j + mm; float pn = 0.f;
                    if (n < nv) { const float* k = kc + n * 64; float s0 = 0.f, s1 = 0.f;
#pragma unroll
                        for (int d = 0; d < 64; ++d) { s0 += q0[d] * k[d]; s1 += q1[d] * k[d]; }
                        pn = expf(s0 - m0) * iz0 + expf(s1 - m1) * iz1; }
                    if (mm < 3) imp += pn; else { imp += 0.5f * pn; carry = 0.5f * pn; } }
                if (j >= 1) {
                    float v = imp; int id = j;
                    if (v > tv0) { float tf = tv0; tv0 = v; v = tf; int tt = ti0; ti0 = id; id = tt; }
                    if (v > tv1) { float tf = tv1; tv1 = v; v = tf; int tt = ti1; ti1 = id; id = tt; }
                    if (v > tv2) { float tf = tv2; tv2 = v; v = tf; int tt = ti2; ti2 = id; id = tt; }
                    if (v > tv3) { float tf = tv3; tv3 = v; v = tf; int tt = ti3; ti3 = id; id = tt; }
                    if (v > tv4) { tv4 = v; ti4 = id; } } }
            mask = 1u | (1u << cur) | (1u << (cur - 1)) | (1u << ti0) | (1u << ti1) | (1u << ti2) | (1u << ti3) | (1u << ti4);
        }
        SELM[i] = mask;
        for (int r = 0; r < 2; ++r) { const int hd = 2 * g + r; const float mr = r ? m1 : m0, izr = r ? iz1 : iz0;
            float o[64], qq[64];
            { const bf16_t* q = P + t * PW + C_Q + hd * 64;
#pragma unroll
              for (int d = 0; d < 64; ++d) { o[d] = 0.f; qq[d] = bf2f(q[d]); } }
            for (int n = 0; n < nv; ++n) { const float* k = kc + n * 64; const float* v = vc + n * 64; float sc = 0.f;
#pragma unroll
                for (int d = 0; d < 64; ++d) sc += qq[d] * k[d];
                const float pr = expf(sc - mr) * izr;
#pragma unroll
                for (int d = 0; d < 64; ++d) o[d] += pr * v[d]; }
            const float g0 = sigmoidf_(bf2f(P[t * PW + C_NG + hd * 3 + 0]));
#pragma unroll
            for (int d = 0; d < 64; ++d) O[t * 1024 + hd * 64 + d] = f2bf(g0 * o[d]); } }
}
DEVI void ph_selwin(const Params& p, long long gtid, long long gsz) {
    const bf16_t* P = WSP(bf16_t, p.oP); const unsigned* SELM = WSP(unsigned, p.oSELM); bf16_t* O = WSP(bf16_t, p.oO);
    for (long long i = gtid; i < p.T * 8; i += gsz) { const long long t = i >> 3, b = t / p.S, s = t % p.S; const int hd = (int)((i >> 1) & 3), g = hd >> 1, d0 = (int)(i & 1) * 32;
        unsigned qp[32]; float o[32];
        { const bf16_t* qq = P + t * PW + C_Q + hd * 64;
#pragma unroll
          for (int d = 0; d < 32; ++d) qp[d] = (unsigned)qq[2 * d] | ((unsigned)qq[2 * d + 1] << 16); }
        for (int pass = 0; pass < 2; ++pass) {
            const int ck = pass ? C_KW : C_KS, cv = pass ? C_VW : C_VS; const unsigned mask = SELM[t * 2 + g];
            float m = -3e38f, z = 0.f;
#pragma unroll
            for (int d = 0; d < 32; ++d) o[d] = 0.f;
            const long long lo = pass ? (s - 511 > 0 ? s - 511 : 0) : 0;
            for (long long kp = lo; kp <= s; ++kp) {
                if (!pass && !((mask >> (kp >> 6)) & 1u)) { kp |= 63; continue; }
                const bf16_t* k = P + (b * p.S + kp) * PW + ck + g * 64; const bf16_t* v = P + (b * p.S + kp) * PW + cv + g * 64 + d0; float sc = 0.f;
#pragma unroll
                for (int d = 0; d < 32; ++d) sc += u2f(qp[d] << 16) * bf2f(k[2 * d]) + u2f(qp[d] & 0xffff0000u) * bf2f(k[2 * d + 1]);
                if (sc > m) { const float f = expf(m - sc); z *= f;
#pragma unroll
                    for (int d = 0; d < 32; ++d) o[d] *= f;
                    m = sc; }
                const float pr = expf(sc - m); z += pr;
#pragma unroll
                for (int d = 0; d < 32; ++d) o[d] += pr * bf2f(v[d]); }
            const float gt = sigmoidf_(bf2f(P[t * PW + C_NG + hd * 3 + 1 + pass])) / z;
#pragma unroll
            for (int d = 0; d < 32; ++d) { bf16_t* od = O + t * 1024 + hd * 64 + d0 + d; *od = f2bf(bf2f(*od) + gt * o[d]); } } }
}
DEVI void ph_ca_attn(const Params& p, int l, long long gtid, long long gsz) {
    const bf16_t* CQ = WSP(bf16_t, p.oCQ); const bf16_t* KV = WSP(bf16_t, p.oKV) + (long long)l * 512; bf16_t* AO = WSP(bf16_t, p.oCAO);
    for (long long i = gtid; i < p.T * 4; i += gsz) { const long long t = i >> 2, b = t / p.S; const int hd = (int)(i & 3);
        float q[64], o[64];
#pragma unroll
        for (int d = 0; d < 64; ++d) { q[d] = bf2f(CQ[t * 256 + hd * 64 + d]); o[d] = 0.f; }
        float m = -3e38f, z = 0.f;
        for (int kp = 0; kp < 256; ++kp) { const bf16_t* k = KV + (b * 256 + kp) * 1024 + hd * 64; const bf16_t* v = k + 256; float sc = 0.f;
#pragma unroll
            for (int d = 0; d < 64; ++d) sc += q[d] * bf2f(k[d]);
            if (sc > m) { const float f = expf(m - sc); z *= f;
#pragma unroll
                for (int d = 0; d < 64; ++d) o[d] *= f;
                m = sc; }
            const float pr = expf(sc - m); z += pr;
#pragma unroll
            for (int d = 0; d < 64; ++d) o[d] += pr * bf2f(v[d]); }
        const float iz = 1.0f / z;
#pragma unroll
        for (int d = 0; d < 64; ++d) AO[t * 256 + hd * 64 + d] = f2bf(o[d] * iz); }
}
DEVI void moe_count_range(const Params& p, long long c0, long long nchunk, int tid, int nthr) {
    const int* TE = WSP(int, p.oTOKE); int* CC = WSP(int, p.oCCNT); int* CT = CC + (p.T / 64) * 64;
    for (long long c = c0 + tid; c < c0 + nchunk; c += nthr) { int tot[8] = {0, 0, 0, 0, 0, 0, 0, 0};
        for (int sub = 0; sub < 8; ++sub) { int cnt[8] = {0, 0, 0, 0, 0, 0, 0, 0};
#pragma unroll
            for (int j = 0; j < 16; ++j) { const int e = TE[c * 128 + sub * 16 + j];
#pragma unroll
                for (int q = 0; q < 8; ++q) cnt[q] += (e == q); }
#pragma unroll
            for (int q = 0; q < 8; ++q) { CC[(c * 8 + sub) * 8 + q] = cnt[q]; tot[q] += cnt[q]; } }
#pragma unroll
        for (int q = 0; q < 8; ++q) CT[c * 8 + q] = tot[q]; }
}
DEVI void ph_moe_count(const Params& p, long long gtid, long long gsz) {
    const int* TE = WSP(int, p.oTOKE); int* CC = WSP(int, p.oCCNT); int* CT = CC + (p.T / 64) * 64; int* R2T = WSP(int, p.oR2T);
    for (long long c = gtid; c < p.T / 64; c += gsz) { int tot[8] = {0, 0, 0, 0, 0, 0, 0, 0};
        for (int sub = 0; sub < 8; ++sub) { int cnt[8] = {0, 0, 0, 0, 0, 0, 0, 0};
#pragma unroll
            for (int j = 0; j < 16; ++j) { const int e = TE[c * 128 + sub * 16 + j];
#pragma unroll
                for (int q = 0; q < 8; ++q) cnt[q] += (e == q); }
#pragma unroll
            for (int q = 0; q < 8; ++q) { CC[(c * 8 + sub) * 8 + q] = cnt[q]; tot[q] += cnt[q]; } }
#pragma unroll
        for (int q = 0; q < 8; ++q) CT[c * 8 + q] = tot[q]; }
    for (long long i = gtid; i < p.NR; i += gsz) R2T[i] = -1;
}
DEVI void ph_moe_offsets(const Params& p, long long gw, long long nw, int lane) {
    const int* CC = WSP(int, p.oCCNT); const int* CT = CC + (p.T / 64) * 64; int* CO = WSP(int, p.oCOFF); int* MC = WSP(int, p.oMOEC);
    const long long n = p.T / 64;
    for (long long i = gw; i < n * 8; i += nw) { const long long c = i >> 3; const int e = (int)(i & 7); int off = 0;
#ifdef CPU_EMU
        (void)lane; for (long long k = 0; k < c; ++k) off += CT[k * 8 + e];
#else
        for (long long k = lane; k < c; k += 64) off += CT[k * 8 + e];
#pragma unroll
        for (int o = 32; o > 0; o >>= 1) off += __shfl_xor(off, o);
        if (lane == 0)
#endif
        {
#pragma unroll
            for (int sub = 0; sub < 8; ++sub) { CO[(c * 8 + sub) * 8 + e] = off; off += CC[(c * 8 + sub) * 8 + e]; }
            if (c == n - 1) MC[e] = off; } }
}
DEVI void moe_bases(const Params& p, int (&base)[9]) { const int* MC = WSP(int, p.oMOEC); int run = 0;
#pragma unroll
    for (int e = 0; e < 8; ++e) { base[e] = run; run += (MC[e] + 255) & ~255; } base[8] = run; }
DEVI void ph_moe_assign(const Params& p, long long gtid, long long gsz) {
    const int* TE = WSP(int, p.oTOKE); const float* TW = WSP(float, p.oTOKW); const int* CO = WSP(int, p.oCOFF); int* TS = WSP(int, p.oTOKS); int* R2T = WSP(int, p.oR2T); float* RW = WSP(float, p.oROWW);
    int base[9]; moe_bases(p, base);
    if (gtid == 0) { int* MC = WSP(int, p.oMOEC);
#pragma unroll
        for (int e = 0; e < 9; ++e) MC[16 + e] = base[e]; }
    for (long long i = gtid; i < (p.T / 64) * 8; i += gsz) { int run[8];
#pragma unroll
        for (int q = 0; q < 8; ++q) run[q] = base[q] + CO[i * 8 + q];
#pragma unroll
        for (int j = 0; j < 16; ++j) { const int e = TE[i * 16 + j]; int slot = 0;
#pragma unroll
            for (int q = 0; q < 8; ++q) if (e == q) { slot = run[q]; run[q] += 1; }
            TS[i * 16 + j] = slot; R2T[slot] = (int)(i * 8 + (j >> 1)); RW[slot] = TW[i * 16 + j]; } }
}
DEVI void ph_moe_gather(const Params& p, long long gtid, long long gsz) {
    const int* R2T = WSP(int, p.oR2T); const int* MC = WSP(int, p.oMOEC); const uint4* H = WSP(uint4, p.oH); uint4* HS = WSP(uint4, p.oHS);
    const long long rows = MC[16 + 8];
    for (long long i = gtid; i < rows * 128; i += gsz) { const long long r = i >> 7; const int j = (int)(i & 127); const int t = R2T[r];
        uint4 v; v.x = v.y = v.z = v.w = 0u; if (t >= 0) v = H[(long long)t * 128 + j]; HS[i] = v; }
}
struct Unit { int pm, pn, aux, pad; long long aoff, boff; };
constexpr int NXCD = 8, WGM = 8;
DEVI void tile_order(long long L, int nM, int nN, int& pm, int& pn) {
    const int nwg = nM * nN; int wgid = (int)L; { const int q = nwg / NXCD, r = nwg % NXCD, xcd = wgid % NXCD, off = wgid / NXCD; wgid = (xcd < r ? xcd * (q + 1) : r * (q + 1) + (xcd - r) * q) + off; }
    const int nig = WGM * nN, gid = wgid / nig, fm = gid * WGM, gsz = (nM - fm) < WGM ? (nM - fm) : WGM;
    pm = fm + ((wgid % nig) % gsz); pn = (wgid % nig) / gsz;
}
struct SchedPlain {
    int nM, nN, G, c; long long lda, ldb;
    DEVM void init(long long M, long long N, long long lda_, long long ldb_, int G_, int c_) { nM = (int)(M / 256); nN = (int)(N / 256); lda = lda_; ldb = ldb_; G = G_; c = c_; }
    DEVM bool next(int i, Unit& u) const { const long long L = (long long)i * G + c; if (L >= (long long)nM * nN) return false; tile_order(L, nM, nN, u.pm, u.pn); u.aux = 0; u.pad = 0;
        u.aoff = (long long)u.pm * 256 * lda * 2; u.boff = (long long)u.pn * 256 * ldb * 2; return true; }
    DEVM void a_ready(const Unit&) const {}
    DEVM void done(const Unit&) const {}
};
struct SchedBranch {
    int nM, G, c;
    DEVM void init(long long M, int G_, int c_) { nM = (int)(M / 256); G = G_; c = c_; }
    DEVM bool next(int i, Unit& u) const { const long long L = (long long)i * G + c; if (L >= (long long)nM * 16) return false; tile_order(L, nM, 16, u.pm, u.pn); u.aux = u.pn >> 2; u.pad = 0;
        u.aoff = (long long)u.pm * 256 * 1024 * 2 + (long long)u.aux * 256 * 2; u.boff = (long long)u.pn * 256 * 256 * 2; return true; }
    DEVM void a_ready(const Unit&) const {}
    DEVM void done(const Unit&) const {}
};
struct SchedGate {
    int nM, G, c;
    DEVM void init(long long M, int G_, int c_) { nM = (int)(M / 256); G = G_; c = c_; }
    DEVM bool next(int i, Unit& u) const { const long long tile = (long long)(i >> 2) * G + c; if (tile >= (long long)nM * 4) return false; tile_order(tile, nM, 4, u.pm, u.pn); u.aux = i & 3; u.pad = 0;
        u.aoff = (long long)u.pm * 256 * 1024 * 2; u.boff = (long long)(u.aux * 4 + u.pn) * 256 * 1024 * 2; return true; }
    DEVM void a_ready(const Unit&) const {}
    DEVM void done(const Unit&) const {}
};
struct SchedMoe {
    int t0, t1, nN, G, c; long long lda, ldb, per_e; const int* base;
    DEVM bool next(int i, Unit& u) const { const long long L = (long long)i * G + c; if (L >= (long long)(t1 - t0) * nN) return false; { int pr, pc; tile_order(L, t1 - t0, nN, pr, pc); u.pm = t0 + pr; u.pn = pc; } u.pad = 0;
        int e = 0;
#pragma unroll
        for (int q = 1; q < 8; ++q) e += (u.pm * 256 >= base[q]) ? 1 : 0;
#ifndef CPU_EMU
        e = __builtin_amdgcn_readfirstlane(e);
#endif
        u.aux = e; u.aoff = (long long)u.pm * 256 * lda * 2; u.boff = (long long)e * per_e + (long long)u.pn * 256 * ldb * 2; return true; }
    DEVM void a_ready(const Unit&) const {}
    DEVM void done(const Unit&) const {}
};
struct SchedCmp {
    int nM, G, c;
    DEVM void init(long long rows, int G_, int c_) { nM = (int)(rows / 256); G = G_; c = c_; }
    DEVM bool next(int i, Unit& u) const { const long long L = (long long)i * G + c; if (L >= (long long)nM * 4) return false; const int combo = (int)(L / nM); u.pm = (int)(L % nM); u.pn = 0; u.aux = combo; u.pad = 0;
        u.aoff = (long long)u.pm * 256 * 16 * PW * 2 + (long long)(((combo >> 1) ? C_VC : C_KC) + (combo & 1) * 64) * 2; u.boff = (long long)(combo >> 1) * 256 * 1024 * 2; return true; }
    DEVM void a_ready(const Unit&) const {}
    DEVM void done(const Unit&) const {}
};
#ifndef CPU_EMU
__device__ __forceinline__ int mk_lane_() { return (int)__builtin_amdgcn_mbcnt_hi(~0u, __builtin_amdgcn_mbcnt_lo(~0u, 0u)); }
#endif
struct PreNone {};
struct PreRow { float r; };
typedef unsigned long long rs_t;
#ifdef CPU_EMU
DEVI float rs_of(const rs_t* rss, long long row) { return rss ? 1.0f / sqrtf((float)((double)rss[row] * (1.0 / 16777216.0)) * (1.0f / 1024.0f) + 1e-6f) : 1.0f; }
#else
DEVI float rs_of(const rs_t* rss, long long row) { return rss ? __builtin_amdgcn_rsqf((float)((double)rss[row] * (1.0 / 16777216.0)) * (1.0f / 1024.0f) + 1e-6f) : 1.0f; }
#endif
struct EpStore {
    typedef PreRow Pre; static constexpr int ROWS = 2;
    bf16_t* O; long long ldo; float scale; const rs_t* rss; bf16_t* O2; long long split;
    DEVM void pre(const Unit&, long long row, int, Pre& pr) const { pr.r = rs_of(rss, row) * scale; }
    DEVM void apply(const Unit& u, long long row, int c8, const float* lo, const float* hi, const Pre& pr) const { float a[8], b[8];
#pragma unroll
        for (int j = 0; j < 8; ++j) { a[j] = lo[j] * pr.r; b[j] = hi[j] * pr.r; }
        bf16_t* d = ((O2 && row >= split) ? O2 + (row - split) * ldo : O + row * ldo) + u.pn * 256 + c8; st8(d, a); st8(d + 128, b); }
};
struct EpUV {
    typedef PreNone Pre; static constexpr int ROWS = 2;
    bf16_t* UV;
    DEVM void pre(const Unit&, long long, int, Pre&) const {}
    DEVM void apply(const Unit& u, long long row, int c8, const float* lo, const float* hi, const Pre&) const { bf16_t* d = UV + (row * 4 + u.aux) * 256 + c8; st8(d, lo); st8(d + 128, hi); }
};
struct PreGate { uint2 bo[4]; float r; };
DEVI void cvt8u(const uint4& w, float* v) { v[0] = u2f(w.x << 16); v[1] = u2f(w.x & 0xffff0000u); v[2] = u2f(w.y << 16); v[3] = u2f(w.y & 0xffff0000u); v[4] = u2f(w.z << 16); v[5] = u2f(w.z & 0xffff0000u); v[6] = u2f(w.w << 16); v[7] = u2f(w.w & 0xffff0000u); }
struct EpGate {
    typedef PreGate Pre; static constexpr int ROWS = 4;
    const bf16_t* BO; const float* bias; bf16_t* MG; long long row0; const rs_t* rss; const bf16_t* BO2; long long split;
    DEVM void pre(const Unit& u, long long row, int c8, Pre& pr) const { pr.r = rs_of(rss, row0 + row); const bf16_t* b = ((BO2 && row >= split) ? BO2 + (row - split) * 4096 : BO + row * 4096) + u.pn * 64 + (c8 >> 1);
#pragma unroll
        for (int i = 0; i < 4; ++i) pr.bo[i] = *(const uint2*)(b + i * 1024); }
    DEVM void apply(const Unit& u, long long row, int c8, const float* lo, const float* hi, const Pre& pr) const { const int c = u.pn * 64 + (c8 >> 1); float r[4] = {0.f, 0.f, 0.f, 0.f};
#pragma unroll
        for (int i = 0; i < 4; ++i) { const float* v = (i < 2 ? lo : hi) + 4 * (i & 1); const float* bi = bias + i * 1024 + c;
            const float bo[4] = {u2f(pr.bo[i].x << 16), u2f(pr.bo[i].x & 0xffff0000u), u2f(pr.bo[i].y << 16), u2f(pr.bo[i].y & 0xffff0000u)};
#pragma unroll
            for (int j = 0; j < 4; ++j) r[j] += sigmoidf_(v[j] * pr.r + bi[j]) * bo[j]; }
        uint2 w; w.x = pk2bf(r[0], r[1]); w.y = pk2bf(r[2], r[3]); *(uint2*)(MG + (row0 + row) * 1024 + c) = w; }
};
struct PreResid { float4 v[4]; };
struct EpResid {
    typedef PreResid Pre; static constexpr int ROWS = 2;
    const float* XS; const bf16_t* XB; bf16_t* HB; rs_t* RS;
    DEVM void pre(const Unit& u, long long row, int c8, Pre& pr) const {
        if (XS) { const float* x = XS + row * 1024 + u.pn * 256 + c8; pr.v[0] = *(const float4*)x; pr.v[1] = *(const float4*)(x + 4); pr.v[2] = *(const float4*)(x + 128); pr.v[3] = *(const float4*)(x + 132); }
        else { const bf16_t* x = XB + row * 1024 + u.pn * 256 + c8; const uint4 a = *(const uint4*)x, b = *(const uint4*)(x + 128);
            pr.v[0].x = u2f(a.x); pr.v[0].y = u2f(a.y); pr.v[0].z = u2f(a.z); pr.v[0].w = u2f(a.w); pr.v[1].x = u2f(b.x); pr.v[1].y = u2f(b.y); pr.v[1].z = u2f(b.z); pr.v[1].w = u2f(b.w); } }
    DEVM void apply(const Unit& u, long long row, int c8, const float* lo, const float* hi, const Pre& pr) const {
        float4 a, b, c, d;
        if (XS) { a = pr.v[0]; b = pr.v[1]; c = pr.v[2]; d = pr.v[3]; }
        else { const unsigned a0 = f2u(pr.v[0].x), a1 = f2u(pr.v[0].y), a2 = f2u(pr.v[0].z), a3 = f2u(pr.v[0].w), b0 = f2u(pr.v[1].x), b1 = f2u(pr.v[1].y), b2 = f2u(pr.v[1].z), b3 = f2u(pr.v[1].w);
            a.x = u2f(a0 << 16); a.y = u2f(a0 & 0xffff0000u); a.z = u2f(a1 << 16); a.w = u2f(a1 & 0xffff0000u); b.x = u2f(a2 << 16); b.y = u2f(a2 & 0xffff0000u); b.z = u2f(a3 << 16); b.w = u2f(a3 & 0xffff0000u);
            c.x = u2f(b0 << 16); c.y = u2f(b0 & 0xffff0000u); c.z = u2f(b1 << 16); c.w = u2f(b1 & 0xffff0000u); d.x = u2f(b2 << 16); d.y = u2f(b2 & 0xffff0000u); d.z = u2f(b3 << 16); d.w = u2f(b3 & 0xffff0000u); }
        a.x += lo[0]; a.y += lo[1]; a.z += lo[2]; a.w += lo[3]; b.x += lo[4]; b.y += lo[5]; b.z += lo[6]; b.w += lo[7];
        c.x += hi[0]; c.y += hi[1]; c.z += hi[2]; c.w += hi[3]; d.x += hi[4]; d.y += hi[5]; d.z += hi[6]; d.w += hi[7];
        { const float n0[8] = {a.x, a.y, a.z, a.w, b.x, b.y, b.z, b.w}, n1[8] = {c.x, c.y, c.z, c.w, d.x, d.y, d.z, d.w}; bf16_t* h = HB + row * 1024 + u.pn * 256 + c8; st8(h, n0); st8(h + 128, n1); }
        if (RS) {
            float ss = (a.x * a.x + a.y * a.y + a.z * a.z + a.w * a.w) + (b.x * b.x + b.y * b.y + b.z * b.z + b.w * b.w) + (c.x * c.x + c.y * c.y + c.z * c.z + c.w * c.w) + (d.x * d.x + d.y * d.y + d.z * d.z + d.w * d.w);
#ifdef CPU_EMU
            RS[row] += (rs_t)((double)ss * 16777216.0 + 0.5);
#else
            ss += __shfl_xor(ss, 16); ss += __shfl_xor(ss, 32);
            if ((mk_lane_() >> 4) == 0) atomicAdd(RS + row, (rs_t)((double)ss * 16777216.0 + 0.5));
#endif
        } }
};
struct EpSwiglu {
    typedef PreRow Pre; static constexpr int ROWS = 2;
    bf16_t* ACT; long long ldo; long long row0; const rs_t* rss;
    DEVM void pre(const Unit&, long long row, int, Pre& pr) const { pr.r = rs_of(rss, row); }
    DEVM void apply(const Unit& u, long long row, int c8, const float* lo, const float* hi, const Pre& pr) const { float r[8];
#pragma unroll
        for (int j = 0; j < 8; ++j) r[j] = siluf_(lo[j] * pr.r) * (hi[j] * pr.r);
        st8(ACT + (row - row0) * ldo + u.pn * 128 + c8, r); }
};
struct EpMoeDown {
    struct Pre { float w; }; static constexpr int ROWS = 2;
    bf16_t* Y; const float* roww;
    DEVM void pre(const Unit&, long long row, int, Pre& pr) const { pr.w = roww[row]; }
    DEVM void apply(const Unit& u, long long row, int c8, const float* lo, const float* hi, const Pre& pr) const { const float w = pr.w; float a[8], b[8];
#pragma unroll
        for (int j = 0; j < 8; ++j) { a[j] = lo[j] * w; b[j] = hi[j] * w; }
        bf16_t* d = Y + row * 1024 + u.pn * 256 + c8; st8(d, a); st8(d + 128, b); }
};

#ifdef CPU_EMU
template <class Sched, class Epi> static void gemm_cpu(const bf16_t* A, long long lda, const bf16_t* Bt, long long ldb, long long K, const Sched& S, const Epi& E, long long kstepA = 64, const int* gidx = nullptr) {
    Unit u;
    for (int i = 0; S.next(i, u); ++i) {
        const bf16_t* a0 = (const bf16_t*)((const char*)A + u.aoff); const bf16_t* b0 = (const bf16_t*)((const char*)Bt + u.boff);
#pragma omp parallel for
        for (int r = 0; r < 256; ++r) { float arow[4096]; const bf16_t* ar = a0 + r * lda; if (gidx) { const unsigned tk = (unsigned)gidx[(long long)u.pm * 256 + r] & 0xffffu; ar = A + (long long)tk * lda; }
            for (long long k = 0; k < K; ++k) arow[k] = bf2f(ar[(k >> 6) * kstepA + (k & 63)]);
            for (int c8 = 0; c8 < 128; c8 += 8) { float lo[8], hi[8];
                for (int j = 0; j < 8; ++j) { const bf16_t* bl = b0 + (c8 + j) * ldb; const bf16_t* bh = b0 + (128 + c8 + j) * ldb; float s0 = 0.f, s1 = 0.f;
                    for (long long k = 0; k < K; ++k) { s0 += arow[k] * bf2f(bl[k]); s1 += arow[k] * bf2f(bh[k]); } lo[j] = s0; hi[j] = s1; }
                typename Epi::Pre pr; E.pre(u, (long long)u.pm * 256 + r, c8, pr); E.apply(u, (long long)u.pm * 256 + r, c8, lo, hi, pr); } } }
}
#endif

#ifndef CPU_EMU
DEVI float wave_sum(float v) {
    v += __builtin_bit_cast(float, __builtin_amdgcn_update_dpp(0, __builtin_bit_cast(int, v), 0xB1, 0xF, 0xF, true)); v += __builtin_bit_cast(float, __builtin_amdgcn_update_dpp(0, __builtin_bit_cast(int, v), 0x4E, 0xF, 0xF, true));
    v += __builtin_bit_cast(float, __builtin_amdgcn_update_dpp(0, __builtin_bit_cast(int, v), 0x141, 0xF, 0xF, true)); v += __builtin_bit_cast(float, __builtin_amdgcn_update_dpp(0, __builtin_bit_cast(int, v), 0x140, 0xF, 0xF, true));
    float a = v, b = v; asm("s_nop 1\n\tv_permlane16_swap_b32 %0, %1" : "+v"(a), "+v"(b)); a = a + b; b = a;
    asm("s_nop 1\n\tv_permlane32_swap_b32 %0, %1" : "+v"(a), "+v"(b)); return a + b; }
DEVI void row_load(const float* src, float (&v)[16], int lane) {
#pragma unroll
    for (int j = 0; j < 4; ++j) { const float4 f = *(const float4*)(src + j * 256 + lane * 4); v[4 * j] = f.x; v[4 * j + 1] = f.y; v[4 * j + 2] = f.z; v[4 * j + 3] = f.w; } }
DEVI void row_load_bf16(const bf16_t* src, float (&v)[16], int lane) {
#pragma unroll
    for (int j = 0; j < 4; ++j) { const uint2 w = *(const uint2*)(src + j * 256 + lane * 4); v[4 * j] = u2f(w.x << 16); v[4 * j + 1] = u2f(w.x & 0xffff0000u); v[4 * j + 2] = u2f(w.y << 16); v[4 * j + 3] = u2f(w.y & 0xffff0000u); } }
DEVI void row_store_bf16(bf16_t* dst, const float (&v)[16], int lane) {
#pragma unroll
    for (int j = 0; j < 4; ++j) { uint2 w; w.x = pk2bf(v[4 * j], v[4 * j + 1]); w.y = pk2bf(v[4 * j + 2], v[4 * j + 3]); *(uint2*)(dst + j * 256 + lane * 4) = w; } }
#endif
DEVI void ph_rmsnorm(const Params& p, const float* src, long long rows, const float* gain, bf16_t* dst, int mode, float* xcopy, long long gw, long long nw, int lane, long long row0 = 0, const bf16_t* srcb = nullptr) {
    const float* router = p.in[I_MOE_R]; int* TE = WSP(int, p.oTOKE) + row0 * 2; float* TW = WSP(float, p.oTOKW) + row0 * 2;
#ifndef CPU_EMU
    for (long long r = gw; r < rows; r += nw) { float v[16], g[16]; if (srcb) row_load_bf16(srcb + r * 1024, v, lane); else row_load(src + r * 1024, v, lane); row_load(gain, g, lane);
        float ss = 0.f;
#pragma unroll
        for (int j = 0; j < 16; ++j) ss += v[j] * v[j];
        ss = wave_sum(ss); const float rs = rsqrtf(ss * (1.0f / 1024.0f) + 1e-6f);
        if (mode == 1) {
#pragma unroll
            for (int j = 0; j < 4; ++j) *(float4*)(xcopy + r * 1024 + j * 256 + lane * 4) = make_float4(v[4 * j], v[4 * j + 1], v[4 * j + 2], v[4 * j + 3]); }
#pragma unroll
        for (int j = 0; j < 16; ++j) v[j] = v[j] * rs * g[j];
        row_store_bf16(dst + r * 1024, v, lane);
        if (mode == 2) { float lg[8];
#pragma unroll
            for (int e = 0; e < 8; ++e) { float a = 0.f;
#pragma unroll
                for (int j = 0; j < 16; ++j) a += v[j] * router[(long long)((j >> 2) * 256 + lane * 4 + (j & 3)) * 8 + e];
                lg[e] = wave_sum(a); }
            int i0 = 0; float v0 = lg[0];
#pragma unroll
            for (int e = 1; e < 8; ++e) if (lg[e] > v0) { v0 = lg[e]; i0 = e; }
            int i1 = -1; float v1 = -3e38f;
#pragma unroll
            for (int e = 0; e < 8; ++e) if (e != i0 && lg[e] > v1) { v1 = lg[e]; i1 = e; }
            const float w0 = 1.0f / (1.0f + expf(v1 - v0));
            if (lane == 0) { TE[r * 2] = i0; TE[r * 2 + 1] = i1; TW[r * 2] = w0; TW[r * 2 + 1] = 1.0f - w0; } } }
#else
    (void)lane;
    for (long long r = gw; r < rows; r += nw) { float xb_[1024]; if (srcb) for (int c = 0; c < 1024; ++c) xb_[c] = bf2f(srcb[r * 1024 + c]); const float* x = srcb ? xb_ : src + r * 1024; float ss = 0.f; for (int c = 0; c < 1024; ++c) ss += x[c] * x[c];
        const float rs = 1.0f / sqrtf(ss / 1024.0f + 1e-6f); float hv[1024];
        for (int c = 0; c < 1024; ++c) { hv[c] = x[c] * rs * gain[c]; dst[r * 1024 + c] = f2bf(hv[c]); if (mode == 1) xcopy[r * 1024 + c] = x[c]; }
        if (mode == 2) { float lg[8]; for (int e = 0; e < 8; ++e) { float a = 0.f; for (int c = 0; c < 1024; ++c) a += hv[c] * router[c * 8 + e]; lg[e] = a; }
            int i0 = 0; float v0 = lg[0]; for (int e = 1; e < 8; ++e) if (lg[e] > v0) { v0 = lg[e]; i0 = e; }
            int i1 = -1; float v1 = -3e38f; for (int e = 0; e < 8; ++e) if (e != i0 && lg[e] > v1) { v1 = lg[e]; i1 = e; }
            const float w0 = 1.0f / (1.0f + expf(v1 - v0)); TE[r * 2] = i0; TE[r * 2 + 1] = i1; TW[r * 2] = w0; TW[r * 2 + 1] = 1.0f - w0; } }
#endif
}
DEVI void ph_final(const Params& p, long long gw, long long nw, int lane) {
    const int* TS = WSP(int, p.oTOKS); const bf16_t* Y = WSP(bf16_t, p.oY); const float* gain = p.in[I_NORM_FINAL]; float* X = p.out; const bf16_t* XB = WSP(bf16_t, p.oH);
#ifndef CPU_EMU
    float g[16]; row_load(gain, g, lane);
    uint2 cx[4], ca[4], cb[4]; int sn0 = 0, sn1 = 0;
#define FN_LOAD(r_, s0_, s1_, dx, da, db) do { const bf16_t* y0 = Y + (long long)(s0_) * 1024; const bf16_t* y1 = Y + (long long)(s1_) * 1024; \
        _Pragma("unroll") for (int j = 0; j < 4; ++j) { dx[j] = *(const uint2*)(XB + (r_) * 1024 + j * 256 + lane * 4); da[j] = *(const uint2*)(y0 + j * 256 + lane * 4); db[j] = *(const uint2*)(y1 + j * 256 + lane * 4); } } while (0)
    if (gw < p.T) { const int s0 = TS[gw * 2], s1 = TS[gw * 2 + 1]; FN_LOAD(gw, s0, s1, cx, ca, cb); if (gw + nw < p.T) { sn0 = TS[(gw + nw) * 2]; sn1 = TS[(gw + nw) * 2 + 1]; } }
    for (long long r = gw; r < p.T; r += nw) { float v[16]; uint2 nx[4], na[4], nb[4]; int snn0 = 0, snn1 = 0;
        if (r + nw < p.T) FN_LOAD(r + nw, sn0, sn1, nx, na, nb);
        if (r + 2 * nw < p.T) { snn0 = TS[(r + 2 * nw) * 2]; snn1 = TS[(r + 2 * nw) * 2 + 1]; }
#pragma unroll
        for (int j = 0; j < 4; ++j) { const uint2 x = cx[j], a = ca[j], b = cb[j];
            v[4 * j] = u2f(x.x << 16) + u2f(a.x << 16) + u2f(b.x << 16); v[4 * j + 1] = u2f(x.x & 0xffff0000u) + u2f(a.x & 0xffff0000u) + u2f(b.x & 0xffff0000u);
            v[4 * j + 2] = u2f(x.y << 16) + u2f(a.y << 16) + u2f(b.y << 16); v[4 * j + 3] = u2f(x.y & 0xffff0000u) + u2f(a.y & 0xffff0000u) + u2f(b.y & 0xffff0000u); }
#pragma unroll
        for (int j = 0; j < 4; ++j) { cx[j] = nx[j]; ca[j] = na[j]; cb[j] = nb[j]; }
        sn0 = snn0; sn1 = snn1;
        float ss = 0.f;
#pragma unroll
        for (int j = 0; j < 16; ++j) ss += v[j] * v[j];
        ss = wave_sum(ss); const float rs = rsqrtf(ss * (1.0f / 1024.0f) + 1e-6f);
#pragma unroll
        for (int j = 0; j < 4; ++j) *(float4*)(X + r * 1024 + j * 256 + lane * 4) = make_float4(v[4 * j] * rs * g[4 * j], v[4 * j + 1] * rs * g[4 * j + 1], v[4 * j + 2] * rs * g[4 * j + 2], v[4 * j + 3] * rs * g[4 * j + 3]); }
#undef FN_LOAD
#else
    (void)lane;
    for (long long r = gw; r < p.T; r += nw) { float v[1024]; float ss = 0.f; const bf16_t* y0 = Y + (long long)TS[r * 2] * 1024; const bf16_t* y1 = Y + (long long)TS[r * 2 + 1] * 1024;
        for (int c = 0; c < 1024; ++c) { v[c] = bf2f(XB[r * 1024 + c]) + bf2f(y0[c]) + bf2f(y1[c]); ss += v[c] * v[c]; }
        const float rs = 1.0f / sqrtf(ss / 1024.0f + 1e-6f); for (int c = 0; c < 1024; ++c) X[r * 1024 + c] = v[c] * rs * gain[c]; }
#endif
}
DEVI void ph_rwkv_scan(const Params& p, int l, long long gw, long long nw, int lane) {
    const float* RWW = WSP(float, p.oRWW); const bf16_t* RWX = WSP(bf16_t, p.oRWX); bf16_t* O = WSP(bf16_t, p.oO); const float* lng = p.in[I_RW_LN] + l * 256; const float* rkw = p.in[I_RW_RK] + l * 256; (void)rkw;
    for (long long ch = gw; ch < p.B * 4; ch += nw) { const long long b = ch >> 2; const int h = (int)(ch & 3);
#ifndef CPU_EMU
        float st[64];
#pragma unroll
        for (int c = 0; c < 64; ++c) st[c] = 0.f;
        for (long long s = 0; s < p.S; ++s) { const long long t = b * p.S + s; const bf16_t* rx = RWX + t * 1280 + h * 64; const float v = bf2f(rx[512 + lane]);
            const float y = rwkv_row_step(st, RWW + t * 256 + h * 64, rx, rx + 256, rx + 768, rx + 1024, v);
            const float mean = wave_sum(y) * (1.0f / 64.0f), dy = y - mean, var = wave_sum(dy * dy) * (1.0f / 64.0f);
            const float yn = dy * rsqrtf(var + 64e-5f) * lng[h * 64 + lane] + 0.f;
            bf16_t* o = O + t * 1024 + 512 + h * 64 + lane; *o = f2bf(yn * bf2f(*o)); }
#else
        (void)lane;
        static float st[64][64]; for (int v = 0; v < 64; ++v) for (int c = 0; c < 64; ++c) st[v][c] = 0.f;
        for (long long s = 0; s < p.S; ++s) { const long long t = b * p.S + s; const bf16_t* rx = RWX + t * 1280 + h * 64; float y[64], mean = 0.f, var = 0.f;
            for (int v = 0; v < 64; ++v) { y[v] = rwkv_row_step(st[v], RWW + t * 256 + h * 64, rx, rx + 256, rx + 768, rx + 1024, bf2f(rx[512 + v])); mean += y[v]; }
            mean /= 64.f; for (int v = 0; v < 64; ++v) var += (y[v] - mean) * (y[v] - mean); var /= 64.f;
            float rkv = 0.f; for (int cq = 0; cq < 64; ++cq) rkv += bf2f(rx[cq]) * bf2f(rx[256 + cq]) * rkw[h * 64 + cq];
            for (int v = 0; v < 64; ++v) { const float yn = (y[v] - mean) / sqrtf(var + 64e-5f) * lng[h * 64 + v] + rkv * bf2f(rx[512 + v]);
                bf16_t* o = O + t * 1024 + 512 + h * 64 + v; *o = f2bf(yn * bf2f(*o)); } }
#endif
    }
}
DEVI void ph_gla_scan(const Params& p, int l, long long gw, long long nw, int lane) {
    const bf16_t* P = WSP(bf16_t, p.oP); const float* GA = WSP(float, p.oGA); bf16_t* O = WSP(bf16_t, p.oO); const float* ng = p.in[I_GLA_NORM] + l * 64;
    for (long long ch = gw; ch < p.B * 4; ch += nw) { const long long b = ch >> 2; const int h = (int)(ch & 3);
#ifndef CPU_EMU
        float st[32];
#pragma unroll
        for (int c = 0; c < 32; ++c) st[c] = 0.f;
        for (long long s = 0; s < p.S; ++s) { const long long t = b * p.S + s; const bf16_t* x = P + t * PW + C_GLA;
            const float o = gla_col_step(st, GA + t * 128 + h * 32, x + h * 32, x + 128 + h * 32, bf2f(x[256 + h * 64 + lane]));
            const float ms = wave_sum(o * o) * (1.0f / 64.0f), on = o * rsqrtf(ms + 1e-6f) * ng[lane];
            bf16_t* d = O + t * 1024 + 768 + h * 64 + lane; *d = f2bf(on * bf2f(*d)); }
#else
        (void)lane;
        static float st[64][32]; for (int v = 0; v < 64; ++v) for (int c = 0; c < 32; ++c) st[v][c] = 0.f;
        for (long long s = 0; s < p.S; ++s) { const long long t = b * p.S + s; const bf16_t* x = P + t * PW + C_GLA; float o[64], ms = 0.f;
            for (int v = 0; v < 64; ++v) { o[v] = gla_col_step(st[v], GA + t * 128 + h * 32, x + h * 32, x + 128 + h * 32, bf2f(x[256 + h * 64 + v])); ms += o[v] * o[v]; }
            ms /= 64.f;
            for (int v = 0; v < 64; ++v) { bf16_t* d = O + t * 1024 + 768 + h * 64 + v; *d = f2bf(o[v] / sqrtf(ms + 1e-6f) * ng[v] * bf2f(*d)); } }
#endif
    }
}
#ifndef CPU_EMU
#define LAS __attribute__((address_space(3)))
__device__ __forceinline__ int mk_lane() { int l_ = (int)__builtin_amdgcn_mbcnt_hi(~0u, __builtin_amdgcn_mbcnt_lo(~0u, 0u)); asm volatile("" : "+v"(l_)); return l_; }
typedef short bf16x8 __attribute__((ext_vector_type(8)));
typedef float f32x4 __attribute__((ext_vector_type(4)));
constexpr int HALF = 128, BK = 64, HTB = HALF * BK * 2, STAGE_BYTES = 8 * HTB, GIDX_OFF = STAGE_BYTES + 64, GIDX_BYTES = 8192, LDS_TOTAL = 163840, XBW_OFF = LDS_TOTAL - 64, DEAL_SLOT_OFF = LDS_TOTAL - 128;
__device__ __forceinline__ int lds_byte(int r, int c) { const int st = (r >> 4) * 2 + (c >> 5), rr = r & 15, cc = c & 31, ob = rr * 64 + cc * 2; return st * 1024 + (ob ^ (((ob >> 9) & 1) << 5)); }
__device__ __forceinline__ void stage_rc(int b, int& R, int& C) { const int st = b / 1024, sb = b % 1024, swz = sb ^ (((sb >> 9) & 1) << 5); R = (st >> 1) * 16 + swz / 64; C = (st & 1) * 32 + (swz % 64) / 2; }
__device__ __forceinline__ int perm32(int rho) { const int n = rho >> 4, i = rho & 15; return 8 * (i >> 2) + 4 * n + (i & 3); }

template <class Epi, class Sched, bool GATHER = false>
__device__ __forceinline__ void gemm_phase(int wv, LAS unsigned char* lds, const bf16_t* A, long long lda, const bf16_t* Bt, long long ldb, long long K, const Sched& S, const Epi& E, long long kstepA_elems = 64, const int* gidx = nullptr) {
    int tid = wv * 64 + mk_lane(); asm volatile("" : "+v"(tid));
    const int wid = wv, lane = tid & 63, wr = wid >> 2, wc = wid & 3, fr = lane & 15, fq = lane >> 4;
    { unsigned long long a_ = (unsigned long long)A, b_ = (unsigned long long)Bt; unsigned alo = __builtin_amdgcn_readfirstlane((unsigned)a_), ahi = __builtin_amdgcn_readfirstlane((unsigned)(a_ >> 32)),
        blo = __builtin_amdgcn_readfirstlane((unsigned)b_), bhi = __builtin_amdgcn_readfirstlane((unsigned)(b_ >> 32));
      int lda_ = __builtin_amdgcn_readfirstlane((int)lda), ldb_ = __builtin_amdgcn_readfirstlane((int)ldb), k_ = __builtin_amdgcn_readfirstlane((int)K), ks_ = __builtin_amdgcn_readfirstlane((int)kstepA_elems);
      asm volatile("" : "+s"(alo), "+s"(ahi), "+s"(blo), "+s"(bhi), "+s"(lda_), "+s"(ldb_), "+s"(k_), "+s"(ks_)); kstepA_elems = ks_;
      A = (const bf16_t*)(((unsigned long long)ahi << 32) | alo); Bt = (const bf16_t*)(((unsigned long long)bhi << 32) | blo); lda = lda_; ldb = ldb_; K = k_; }
    const int nt = (int)(K / BK);
    unsigned voffA[2], voffB[2];
#define PG8_GRC(i_, R_, C2_) int R_, Cc_##i_; stage_rc(tid * 16 + (i_) * 8192, R_, Cc_##i_); const unsigned C2_ = (unsigned)Cc_##i_ * 2u
#pragma unroll
    for (int i = 0; i < 2; ++i) { int R, C; stage_rc(tid * 16 + i * 8192, R, C); const int Rb = (R & ~31) + perm32(R & 31);
        voffA[i] = (unsigned)(R * (int)lda + C) * 2u; voffB[i] = (unsigned)(Rb * (int)ldb + C) * 2u; }
    const size_t kstep = (size_t)(BK * 2), kstepA = (size_t)kstepA_elems * 2;
    const size_t hstepA = (size_t)HALF * lda * 2, hstepB = (size_t)HALF * ldb * 2;
    const unsigned ldsw = (unsigned)wid * 1024u;
    const int aoff = lds_byte(wr * 64 + fr, fq * 8), boff = lds_byte(wc * 32 + fr, fq * 8);
#define PG8_SA(b, h) (((b) * 2 + (h)) * HTB)
#define PG8_SB(b, h) ((4 + (b) * 2 + (h)) * HTB)
#define PG8_STAGE(bufoff, gbase, voff) do { _Pragma("unroll") for (int _i = 0; _i < 2; ++_i) \
        __builtin_amdgcn_global_load_lds((const unsigned*)((const char*)(gbase) + (voff)[_i]), (LAS unsigned*)(lds + (bufoff) + ldsw + _i * 8192), 16, 0, 0); } while (0)
#define PG8_STAGE_A(bufoff, plainbase, kbytes, g0, g1) do { if constexpr (GATHER) { const char* gb_ = (const char*)A + (kbytes); \
        __builtin_amdgcn_global_load_lds((const unsigned*)(gb_ + (g0)), (LAS unsigned*)(lds + (bufoff) + ldsw), 16, 0, 0); __builtin_amdgcn_global_load_lds((const unsigned*)(gb_ + (g1)), (LAS unsigned*)(lds + (bufoff) + ldsw + 8192), 16, 0, 0); } \
        else PG8_STAGE(bufoff, plainbase, voffA); } while (0)
#define PG8_GOFF(dst, u_) do { if constexpr (GATHER) { PG8_GRC(0, r0_, c0_); PG8_GRC(1, r1_, c1_); _Pragma("unroll") for (int h_ = 0; h_ < 2; ++h_) { unsigned tk_ = (unsigned)gidx[(long long)(u_).pm * 256 + h_ * 128 + r0_] & 0xffffu; dst[h_][0] = tk_ * (unsigned)((int)lda * 2) + c0_; \
        tk_ = (unsigned)gidx[(long long)(u_).pm * 256 + h_ * 128 + r1_] & 0xffffu; dst[h_][1] = tk_ * (unsigned)((int)lda * 2) + c1_; } } } while (0)
#define PG8_LDA(dst, b, h) do { _Pragma("unroll") for (int m = 0; m < 4; ++m) _Pragma("unroll") for (int k = 0; k < 2; ++k) dst[m][k] = *(const LAS bf16x8*)(lds + PG8_SA(b, h) + aoff + m * 2048 + k * 1024); } while (0)
#define PG8_LDB(dst, b, h) do { _Pragma("unroll") for (int n = 0; n < 2; ++n) _Pragma("unroll") for (int k = 0; k < 2; ++k) dst[n][k] = *(const LAS bf16x8*)(lds + PG8_SB(b, h) + boff + n * 2048 + k * 1024); } while (0)
#define PG8_MMA(ai, bj, At, Bt_) do { __builtin_amdgcn_s_setprio(1); _Pragma("unroll") for (int m = 0; m < 4; ++m) _Pragma("unroll") for (int n = 0; n < 2; ++n) _Pragma("unroll") for (int k = 0; k < 2; ++k) \
        acc[ai][bj][m][n] = __builtin_amdgcn_mfma_f32_16x16x32_bf16(Bt_[n][k], At[m][k], acc[ai][bj][m][n], 0, 0, 0); __builtin_amdgcn_s_setprio(0); } while (0)
#define PG8_WAIT_V(n) asm volatile("s_waitcnt vmcnt(" #n ")" ::: "memory")
#define PG8_WAIT_L(n) asm volatile("s_waitcnt lgkmcnt(" #n ")" ::: "memory")
#define PG8_BAR __builtin_amdgcn_s_barrier()
#define PG8_SCHED __builtin_amdgcn_sched_barrier(0)
    Unit cur, nxt; int ui = 0;
    if (!S.next(0, cur)) return;
    f32x4 acc[2][2][4][2];
#pragma unroll
    for (int a = 0; a < 2; ++a)
#pragma unroll
        for (int b = 0; b < 2; ++b)
#pragma unroll
            for (int m = 0; m < 4; ++m)
#pragma unroll
                for (int n = 0; n < 2; ++n) acc[a][b][m][n] = (f32x4){0.f, 0.f, 0.f, 0.f};
    bf16x8 At[4][2], B0[2][2], B1[2][2];
    const char* cA = (const char*)A + cur.aoff; const char* cB = (const char*)Bt + cur.boff;
    S.a_ready(cur);
    unsigned gC_[2][2] = {{0u, 0u}, {0u, 0u}};
    PG8_GOFF(gC_, cur);
    PG8_STAGE(PG8_SB(0, 0), cB, voffB); PG8_STAGE_A(PG8_SA(0, 0), cA, 0, gC_[0][0], gC_[0][1]); PG8_STAGE(PG8_SB(0, 1), cB + hstepB, voffB); PG8_STAGE_A(PG8_SA(0, 1), cA + hstepA, 0, gC_[1][0], gC_[1][1]);
    if (wr == 1) PG8_BAR;
    PG8_WAIT_V(4); PG8_BAR;
    PG8_STAGE(PG8_SB(1, 0), cB + kstep, voffB); PG8_STAGE_A(PG8_SA(1, 0), cA + kstepA, kstepA, gC_[0][0], gC_[0][1]); PG8_STAGE(PG8_SB(1, 1), cB + hstepB + kstep, voffB);
    PG8_WAIT_V(6); PG8_BAR;
    for (;;) {
        const bool has_next = S.next(ui + 1, nxt);
        const char* nA = has_next ? (const char*)A + nxt.aoff : cA; const char* nB = has_next ? (const char*)Bt + nxt.boff : cB;
#pragma nounroll
        for (int t = 0; t < nt; t += 2) {
            const bool last = (t == nt - 2);
            if constexpr (GATHER) {
                if (t == 0 && has_next) {
                    PG8_GRC(0, r0_, c0_); PG8_GRC(1, r1_, c1_); (void)c0_; (void)c1_;
#pragma unroll
                    for (int h_ = 0; h_ < 2; ++h_) { const int* ip0_ = gidx + (long long)nxt.pm * 256 + h_ * 128 + r0_; const int* ip1_ = gidx + (long long)nxt.pm * 256 + h_ * 128 + r1_;
                        __builtin_amdgcn_global_load_lds((const unsigned*)ip0_, (LAS unsigned*)(lds + GIDX_OFF + (h_ * 2 + 0) * 2048 + wid * 256), 4, 0, 0);
                        __builtin_amdgcn_global_load_lds((const unsigned*)ip1_, (LAS unsigned*)(lds + GIDX_OFF + (h_ * 2 + 1) * 2048 + wid * 256), 4, 0, 0); } }
            }
            const size_t k1_ = (size_t)(t + 1) * kstepA, k2_ = last ? 0 : (size_t)(t + 2) * kstepA, k3_ = k2_ + kstepA;
            const char* a1 = cA + (size_t)(t + 1) * kstepA;
            const char* a2 = last ? nA : cA + (size_t)(t + 2) * kstepA; const char* b2 = last ? nB : cB + (size_t)(t + 2) * kstep;
            const char* a3 = a2 + kstepA; const char* b3 = b2 + kstep;
            if (last && has_next) S.a_ready(nxt);
            PG8_LDB(B0, 0, 0); PG8_SCHED; PG8_LDA(At, 0, 0); PG8_STAGE_A(PG8_SA(1, 1), a1 + hstepA, k1_, gC_[1][0], gC_[1][1]);
            if constexpr (GATHER) { if (last && has_next) {
                PG8_GRC(0, r0_, c0_); PG8_GRC(1, r1_, c1_); (void)r0_; (void)r1_;
#pragma unroll
                for (int h_ = 0; h_ < 2; ++h_) { unsigned i0_, i1_; const unsigned ad_ = (unsigned)(size_t)(lds + GIDX_OFF + h_ * 4096) + (unsigned)tid * 4u;
                    asm volatile("ds_read_b32 %0, %2\n\tds_read_b32 %1, %2 offset:2048\n\ts_waitcnt lgkmcnt(0)" : "=&v"(i0_), "=&v"(i1_) : "v"(ad_) : "memory");
                    gC_[h_][0] = (i0_ & 0xffffu) * (unsigned)((int)lda * 2) + c0_; gC_[h_][1] = (i1_ & 0xffffu) * (unsigned)((int)lda * 2) + c1_; } } }
            PG8_WAIT_L(8); PG8_BAR; PG8_WAIT_L(0); PG8_MMA(0, 0, At, B0); PG8_BAR; PG8_SCHED;
            PG8_LDB(B1, 0, 1); PG8_STAGE(PG8_SB(0, 0), b2, voffB);
            PG8_BAR; PG8_WAIT_L(0); PG8_MMA(0, 1, At, B1); PG8_BAR;
            PG8_LDA(At, 0, 1); PG8_STAGE_A(PG8_SA(0, 0), a2, k2_, gC_[0][0], gC_[0][1]);
            PG8_BAR; PG8_WAIT_L(0); PG8_MMA(1, 0, At, B0); PG8_BAR; PG8_SCHED;
            PG8_STAGE(PG8_SB(0, 1), b2 + hstepB, voffB);
            PG8_WAIT_V(6); PG8_BAR; PG8_MMA(1, 1, At, B1); PG8_BAR;
            PG8_LDB(B0, 1, 0); PG8_SCHED; PG8_LDA(At, 1, 0); PG8_STAGE_A(PG8_SA(0, 1), a2 + hstepA, k2_, gC_[1][0], gC_[1][1]);
            PG8_WAIT_L(8); PG8_BAR; PG8_WAIT_L(0); PG8_MMA(0, 0, At, B0); PG8_BAR; PG8_SCHED;
            PG8_LDB(B1, 1, 1); PG8_STAGE(PG8_SB(1, 0), b3, voffB);
            PG8_BAR; PG8_WAIT_L(0); PG8_MMA(0, 1, At, B1); PG8_BAR;
            PG8_LDA(At, 1, 1); PG8_STAGE_A(PG8_SA(1, 0), a3, k3_, gC_[0][0], gC_[0][1]);
            PG8_BAR; PG8_WAIT_L(0); PG8_MMA(1, 0, At, B0); PG8_BAR; PG8_SCHED;
            PG8_STAGE(PG8_SB(1, 1), b3 + hstepB, voffB);
            PG8_WAIT_V(6); PG8_BAR; PG8_MMA(1, 1, At, B1); PG8_BAR;
        }
        const int el_ = mk_lane(), efr = el_ & 15, efq = el_ >> 4;
#pragma unroll
        for (int ai = 0; ai < 2; ++ai)
#pragma unroll
            for (int mh = 0; mh < 4 / Epi::ROWS; ++mh) { typename Epi::Pre pr[Epi::ROWS];
#pragma unroll
                for (int m2 = 0; m2 < Epi::ROWS; ++m2) E.pre(cur, (long long)cur.pm * 256 + ai * HALF + wr * 64 + (Epi::ROWS * mh + m2) * 16 + efr, wc * 32 + 8 * efq, pr[m2]);
                PG8_SCHED;
#pragma unroll
                for (int m2 = 0; m2 < Epi::ROWS; ++m2) { const int m = Epi::ROWS * mh + m2; float lo[8], hi[8];
#pragma unroll
                    for (int j = 0; j < 8; ++j) { lo[j] = acc[ai][0][m][j >> 2][j & 3]; hi[j] = acc[ai][1][m][j >> 2][j & 3]; }
                    E.apply(cur, (long long)cur.pm * 256 + ai * HALF + wr * 64 + m * 16 + efr, wc * 32 + 8 * efq, lo, hi, pr[m2]); }
                PG8_SCHED; }
        S.done(cur);
        if (!has_next) break;
#pragma unroll
        for (int a = 0; a < 2; ++a)
#pragma unroll
            for (int b = 0; b < 2; ++b)
#pragma unroll
                for (int m = 0; m < 4; ++m)
#pragma unroll
                    for (int n = 0; n < 2; ++n) acc[a][b][m][n] = (f32x4){0.f, 0.f, 0.f, 0.f};
        cur = nxt; cA = nA; cB = nB; ++ui;
    }
    PG8_WAIT_V(0);
    if (wr == 0) PG8_BAR;
    PG8_BAR;
#undef PG8_SA
#undef PG8_SB
#undef PG8_STAGE
#undef PG8_LDA
#undef PG8_STAGE_A
#undef PG8_GRC
#undef PG8_GOFF
#undef PG8_LDB
#undef PG8_MMA
#undef PG8_WAIT_V
#undef PG8_WAIT_L
#undef PG8_BAR
#undef PG8_SCHED
}

#define XB_TMO      128
#define XB_XCNT(j)  (256  + 64 * (j))
#define XB_XSUB(j)  (1280 + 64 * (j))
#define XB_XGEN(j)  (2304 + 64 * (j))
#define XB_TOP      3328
#define XB_TOPGEN   3392
#define XCD_BAR_WORDS 3456
#define XB_SPIN_CAP (1u << 18)
__device__ __forceinline__ unsigned xb_ld(unsigned* p)              { return __hip_atomic_load(p, __ATOMIC_RELAXED, __HIP_MEMORY_SCOPE_AGENT); }
__device__ __forceinline__ unsigned xb_add(unsigned* p, unsigned v) { return __hip_atomic_fetch_add(p, v, __ATOMIC_RELAXED, __HIP_MEMORY_SCOPE_AGENT); }
__device__ __forceinline__ unsigned xb_xcc_id() { return (unsigned)__builtin_amdgcn_s_getreg((3 << 11) | 20) & 0xFu; }
#define XB_SPIN(cond, bar) do { unsigned _sp = 0; while (cond) { __builtin_amdgcn_s_sleep(1); \
    if ((++_sp & 255u) == 0u) { if (xb_ld(&(bar)[XB_TMO])) break; if (_sp > XB_SPIN_CAP) { atomicAdd(&(bar)[XB_TMO], 1u); break; } } } } while (0)
struct XcdBarrier { unsigned* bar; unsigned x; volatile LAS unsigned* st; int wv; };
__device__ __forceinline__ XcdBarrier xcd_barrier_post(unsigned* bar, volatile LAS unsigned* st, int wv) {
    XcdBarrier b; b.bar = bar; b.x = xb_xcc_id(); b.st = st; b.wv = wv;
    if (wv == 0 && mk_lane() == 0) (void)xb_add(&bar[XB_XCNT(b.x)], 1u);
    return b;
}
__device__ __forceinline__ void xcd_barrier_complete(unsigned* bar, unsigned x, unsigned& nloc, unsigned& nx) {
    const unsigned G = gridDim.x * gridDim.y * gridDim.z;
    unsigned sum, cnt, mine, sp = 0u;
    for (;;) {
        sum = 0u; cnt = 0u; mine = 0u;
#pragma unroll
        for (unsigned j = 0; j < 16; ++j) { const unsigned c = xb_ld(&bar[XB_XCNT(j)]); sum += c; cnt += (c > 0u) ? 1u : 0u; mine = (j == x) ? c : mine; }
        if (sum == G) break;
        __builtin_amdgcn_s_sleep(1);
        if ((++sp & 255u) == 0u) { if (xb_ld(&bar[XB_TMO])) break; if (sp > XB_SPIN_CAP) { atomicAdd(&bar[XB_TMO], 1u); break; } }
    }
    nloc = mine > 0u ? mine : 1u; nx = cnt > 0u ? cnt : 1u;
}
__device__ __forceinline__ void xcd_barrier(const XcdBarrier& b) {
    asm volatile("s_waitcnt vmcnt(0)" ::: "memory");
    __syncthreads();
    if (b.wv == 0 && mk_lane() == 0) {
        unsigned* bar = b.bar;
        __builtin_amdgcn_s_waitcnt(0);
        unsigned nloc = b.st[0], nx = b.st[1];
        if (nloc == 0u) { xcd_barrier_complete(bar, b.x, nloc, nx); b.st[0] = nloc; b.st[1] = nx; }
        const unsigned old = xb_add(&bar[XB_XSUB(b.x)], 1u);
        const unsigned gen = old / nloc;
        if (old + 1u == (gen + 1u) * nloc) {
            __builtin_amdgcn_fence(__ATOMIC_RELEASE, "agent");
            asm volatile("s_waitcnt vmcnt(0)" ::: "memory");
            const unsigned og = xb_add(&bar[XB_TOP], 1u);
            const unsigned tg = og / nx;
            if (og + 1u == (tg + 1u) * nx) xb_add(&bar[XB_TOPGEN], 1u);
            else XB_SPIN(xb_ld(&bar[XB_TOPGEN]) == tg, bar);
            __builtin_amdgcn_fence(__ATOMIC_ACQUIRE, "agent");
            xb_add(&bar[XB_XGEN(b.x)], 1u);
            asm volatile("s_waitcnt vmcnt(0)" ::: "memory");
        } else {
            XB_SPIN(xb_ld(&bar[XB_XGEN(b.x)]) == gen, bar);
            __builtin_amdgcn_fence(__ATOMIC_ACQUIRE, "agent");
            asm volatile("s_waitcnt vmcnt(0)" ::: "memory");
        }
    }
    __syncthreads();
}
#endif
#ifndef CPU_EMU
typedef short bf16x8_t __attribute__((ext_vector_type(8)));
typedef short bf16x4_t __attribute__((ext_vector_type(4)));
typedef float f32x4_t __attribute__((ext_vector_type(4)));
typedef unsigned u32x4_t __attribute__((ext_vector_type(4)));
constexpr int AT_KS = 144, AT_VS = 136;
constexpr int AT_KBYTES = 64 * AT_KS, AT_VBYTES = 64 * AT_KS, AT_BUF = AT_KBYTES + AT_VBYTES;
typedef unsigned u32x2_t __attribute__((ext_vector_type(2)));
__device__ __forceinline__ float quad4_max(float x) { float a = x, b = x;
    asm volatile("s_nop 1\n\tv_permlane16_swap_b32 %0, %1" : "+v"(a), "+v"(b)); a = fmaxf(a, b); b = a;
    asm volatile("s_nop 1\n\tv_permlane32_swap_b32 %0, %1" : "+v"(a), "+v"(b)); return fmaxf(a, b); }
__device__ __forceinline__ float quad4_sum(float x) { float a = x, b = x;
    asm volatile("s_nop 1\n\tv_permlane16_swap_b32 %0, %1" : "+v"(a), "+v"(b)); a = a + b; b = a;
    asm volatile("s_nop 1\n\tv_permlane32_swap_b32 %0, %1" : "+v"(a), "+v"(b)); return a + b; }
__device__ __forceinline__ float dpp_mov1(float x) { return __builtin_bit_cast(float, __builtin_amdgcn_update_dpp(0, __builtin_bit_cast(int, x), 0xB1, 0xF, 0xF, true)); }
struct AttnState { float m, l; f32x4_t o[4]; };
__device__ __forceinline__ void attn_init(AttnState& s) { s.m = -1e30f; s.l = 0.f;
#pragma unroll
    for (int d = 0; d < 4; ++d) s.o[d] = (f32x4_t){0.f, 0.f, 0.f, 0.f}; }
__device__ __forceinline__ unsigned pack2bf(float lo, float hi) { return pk2bf(lo, hi); }
template <bool MASKED, class Valid> __device__ __forceinline__ void attn_tile(const LAS unsigned char* kt, const LAS unsigned char* vt, const bf16x8_t (&bq)[2], AttnState& st, int lane, const Valid& valid) {
    const int r = lane & 15, q = lane >> 4;
    f32x4_t s[4];
    {
        bf16x8_t k00, k01, k10, k11, k20, k21, k30, k31; const unsigned ka = (unsigned)(size_t)kt + (unsigned)(r * AT_KS + 16 * q);
        asm volatile("ds_read_b128 %0, %8\n\tds_read_b128 %1, %8 offset:64\n\tds_read_b128 %2, %8 offset:2304\n\tds_read_b128 %3, %8 offset:2368\n\t"
                     "ds_read_b128 %4, %8 offset:4608\n\tds_read_b128 %5, %8 offset:4672\n\tds_read_b128 %6, %8 offset:6912\n\tds_read_b128 %7, %8 offset:6976\n\ts_waitcnt lgkmcnt(0)"
                     : "=&v"(k00), "=&v"(k01), "=&v"(k10), "=&v"(k11), "=&v"(k20), "=&v"(k21), "=&v"(k30), "=&v"(k31) : "v"(ka) : "memory");
        const f32x4_t z4 = (f32x4_t){0.f, 0.f, 0.f, 0.f};
        s[0] = __builtin_amdgcn_mfma_f32_16x16x32_bf16(k00, bq[0], z4, 0, 0, 0); s[1] = __builtin_amdgcn_mfma_f32_16x16x32_bf16(k10, bq[0], z4, 0, 0, 0);
        s[2] = __builtin_amdgcn_mfma_f32_16x16x32_bf16(k20, bq[0], z4, 0, 0, 0); s[3] = __builtin_amdgcn_mfma_f32_16x16x32_bf16(k30, bq[0], z4, 0, 0, 0);
        s[0] = __builtin_amdgcn_mfma_f32_16x16x32_bf16(k01, bq[1], s[0], 0, 0, 0); s[1] = __builtin_amdgcn_mfma_f32_16x16x32_bf16(k11, bq[1], s[1], 0, 0, 0);
        s[2] = __builtin_amdgcn_mfma_f32_16x16x32_bf16(k21, bq[1], s[2], 0, 0, 0); s[3] = __builtin_amdgcn_mfma_f32_16x16x32_bf16(k31, bq[1], s[3], 0, 0, 0); }
    float mx = -1e30f;
#pragma unroll
    for (int kb = 0; kb < 4; ++kb)
#pragma unroll
        for (int j = 0; j < 4; ++j) { const float v = (!MASKED || valid(kb, j)) ? s[kb][j] : -1e30f; s[kb][j] = v; mx = fmaxf(mx, v); }
    mx = quad4_max(mx);
    const float mn = fmaxf(st.m, mx), alpha = __builtin_amdgcn_exp2f(st.m - mn);
    float rs = 0.f;
#pragma unroll
    for (int kb = 0; kb < 4; ++kb)
#pragma unroll
        for (int j = 0; j < 4; ++j) { const float pv = (!MASKED || s[kb][j] > -1e29f) ? __builtin_amdgcn_exp2f(s[kb][j] - mn) : 0.f; s[kb][j] = pv; rs += pv; }
    rs = quad4_sum(rs);
    st.l = st.l * alpha + rs; st.m = mn;
    bf16x8_t pb[2];
#pragma unroll
    for (int kk = 0; kk < 2; ++kk) { uint4 w; w.x = pack2bf(s[2 * kk][0], s[2 * kk][1]); w.y = pack2bf(s[2 * kk][2], s[2 * kk][3]); w.z = pack2bf(s[2 * kk + 1][0], s[2 * kk + 1][1]); w.w = pack2bf(s[2 * kk + 1][2], s[2 * kk + 1][3]);
        pb[kk] = __builtin_bit_cast(bf16x8_t, w); }
    const unsigned vb = (unsigned)(size_t)vt + (unsigned)((4 * q + (r >> 2)) * AT_KS + 8 * (r & 3));
#pragma unroll
    for (int db = 0; db < 4; ++db) st.o[db] = st.o[db] * alpha;
#pragma unroll
    for (int kk = 0; kk < 2; ++kk) { bf16x4_t l0, l1, l2, l3, h0, h1, h2, h3; const unsigned va = vb + (unsigned)(kk * 32 * AT_KS);
        asm volatile("ds_read_b64_tr_b16 %0, %8\n\tds_read_b64_tr_b16 %1, %8 offset:32\n\tds_read_b64_tr_b16 %2, %8 offset:64\n\tds_read_b64_tr_b16 %3, %8 offset:96\n\t"
                     "ds_read_b64_tr_b16 %4, %8 offset:2304\n\tds_read_b64_tr_b16 %5, %8 offset:2336\n\tds_read_b64_tr_b16 %6, %8 offset:2368\n\tds_read_b64_tr_b16 %7, %8 offset:2400\n\ts_waitcnt lgkmcnt(0)"
                     : "=&v"(l0), "=&v"(l1), "=&v"(l2), "=&v"(l3), "=&v"(h0), "=&v"(h1), "=&v"(h2), "=&v"(h3) : "v"(va) : "memory");
        st.o[0] = __builtin_amdgcn_mfma_f32_16x16x32_bf16(__builtin_shufflevector(l0, h0, 0, 1, 2, 3, 4, 5, 6, 7), pb[kk], st.o[0], 0, 0, 0);
        st.o[1] = __builtin_amdgcn_mfma_f32_16x16x32_bf16(__builtin_shufflevector(l1, h1, 0, 1, 2, 3, 4, 5, 6, 7), pb[kk], st.o[1], 0, 0, 0);
        st.o[2] = __builtin_amdgcn_mfma_f32_16x16x32_bf16(__builtin_shufflevector(l2, h2, 0, 1, 2, 3, 4, 5, 6, 7), pb[kk], st.o[2], 0, 0, 0);
        st.o[3] = __builtin_amdgcn_mfma_f32_16x16x32_bf16(__builtin_shufflevector(l3, h3, 0, 1, 2, 3, 4, 5, 6, 7), pb[kk], st.o[3], 0, 0, 0); }
}
__device__ __forceinline__ void attn_stage_store(LAS unsigned char* buf, int tid, const uint4& kc, const uint4& vc) {
    const int key = tid >> 3, c = tid & 7;
    *(LAS u32x4_t*)(buf + key * AT_KS + c * 16) = (u32x4_t){kc.x, kc.y, kc.z, kc.w};
    *(LAS u32x4_t*)(buf + AT_KBYTES + key * AT_KS + c * 16) = (u32x4_t){vc.x, vc.y, vc.z, vc.w};
}
__device__ __forceinline__ int next_unit(unsigned* ctr, volatile LAS unsigned* slot, int tid) {
    __syncthreads();
    if (tid == 0) *slot = __hip_atomic_fetch_add(ctr, 1u, __ATOMIC_RELAXED, __HIP_MEMORY_SCOPE_AGENT);
    __syncthreads();
    return (int)*slot;
}
__device__ __forceinline__ void selwin_unit(const Params& p, int cur, int bg, int wv, LAS unsigned char* lds) {
    int tid = wv * 64 + mk_lane(); asm volatile("" : "+v"(tid));
    const int wid = tid >> 6, lane = tid & 63, r = lane & 15, q = lane >> 4;
    const bf16_t* P = WSP(bf16_t, p.oP); const unsigned* SELM = WSP(unsigned, p.oSELM); bf16_t* O = WSP(bf16_t, p.oO);
    const int nqb = (int)(p.S >> 6), units = (int)(p.B * 2) * nqb;
    (void)units;
    {   const int b = bg >> 1, g = bg & 1;
        const long long t0 = (long long)b * p.S + (long long)cur * 64;
        const int hd = 2 * g + (wid >> 2); const int tq = (wid & 3) * 16 + r; const long long tok = t0 + tq; const int sq = cur * 64 + tq;
        bf16x8_t bq[2];
#pragma unroll
        for (int ks = 0; ks < 2; ++ks) bq[ks] = *(const bf16x8_t*)(P + tok * PW + C_Q + hd * 64 + 32 * ks + 8 * q);
        uint2 pvp[4];
#pragma unroll
        for (int db = 0; db < 4; ++db) pvp[db] = *(const uint2*)(O + tok * 1024 + hd * 64 + 16 * db + 4 * q);
        const bf16_t gl1 = P[tok * PW + C_NG + hd * 3 + 1], gl2 = P[tok * PW + C_NG + hd * 3 + 2];
        unsigned un = SELM[(t0 + lane) * 2 + g];
#pragma unroll
        for (int o = 32; o > 0; o >>= 1) un |= __shfl_xor(un, o);
        un = __builtin_amdgcn_readfirstlane(un);
        const unsigned mymask = SELM[tok * 2 + g];
        const int wlo = cur - 8 > 0 ? cur - 8 : 0, nwin = cur - wlo + 1, nsel = __builtin_popcount(un), ntile = nwin + nsel;
        AttnState sw, ss; attn_init(sw); attn_init(ss);
        int pf = 0; unsigned prem = un;
#define SW_FETCH(kc_, vc_, blk_, win_) do { blk_ = 0; win_ = false; if (pf < ntile) { if (pf < nwin) { blk_ = wlo + pf; win_ = true; } else { blk_ = __builtin_ctz(prem); prem &= prem - 1; } ++pf; \
            const long long kr_ = ((long long)b * p.S + (long long)blk_ * 64 + (tid >> 3)) * PW + g * 64 + (tid & 7) * 8; kc_ = *(const uint4*)(P + kr_ + (win_ ? C_KW : C_KS)); vc_ = *(const uint4*)(P + kr_ + (win_ ? C_VW : C_VS)); } } while (0)
#define SW_COMPUTE(buf_, cb_, win_) do { const LAS unsigned char* bf_ = (buf_); const int cbk = (cb_), kbase = cbk * 64 + 4 * q; \
            if (win_) { if (cbk == cur || cbk == cur - 8) attn_tile<true>(bf_, bf_ + AT_KBYTES, bq, sw, lane, [&](int kb, int j) { const int key = kbase + 16 * kb + j; return key <= sq && key > sq - 512; }); \
                        else attn_tile<false>(bf_, bf_ + AT_KBYTES, bq, sw, lane, [](int, int) { return true; }); } \
            else { const bool on = (mymask >> cbk) & 1u; \
                if (__builtin_amdgcn_ballot_w64(on) != 0ull) { \
                    if (cbk == cur) attn_tile<true>(bf_, bf_ + AT_KBYTES, bq, ss, lane, [&](int kb, int j) { const int key = kbase + 16 * kb + j; return on && key <= sq; }); \
                    else attn_tile<true>(bf_, bf_ + AT_KBYTES, bq, ss, lane, [&](int, int) { return on; }); } } } while (0)
        uint4 kA, vA, kB, vB; int cb, nb, b2, b3; bool cw, nw_, w2, w3;
        SW_FETCH(kA, vA, cb, cw);
        attn_stage_store(lds, tid, kA, vA);
        SW_FETCH(kA, vA, nb, nw_);
        __syncthreads();
        for (int i = 0; i < ntile; i += 2) {
            SW_FETCH(kB, vB, b2, w2);
            SW_COMPUTE(lds, cb, cw);
            if (i + 1 < ntile) attn_stage_store(lds + AT_BUF, tid, kA, vA);
            __syncthreads();
            if (i + 1 >= ntile) break;
            SW_FETCH(kA, vA, b3, w3);
            SW_COMPUTE(lds + AT_BUF, nb, nw_);
            if (i + 2 < ntile) attn_stage_store(lds, tid, kB, vB);
            __syncthreads();
            cb = b2; cw = w2; nb = b3; nw_ = w3;
        }
#undef SW_FETCH
#undef SW_COMPUTE
        const float g1 = sigmoidf_(bf2f(gl1)) / ss.l, g2 = sigmoidf_(bf2f(gl2)) / sw.l;
#pragma unroll
        for (int db = 0; db < 4; ++db) { bf16_t* od = O + tok * 1024 + hd * 64 + 16 * db + 4 * q; const uint2 pv = pvp[db];
            const float r0 = u2f(pv.x << 16) + g1 * ss.o[db][0] + g2 * sw.o[db][0], r1 = u2f(pv.x & 0xffff0000u) + g1 * ss.o[db][1] + g2 * sw.o[db][1];
            const float r2 = u2f(pv.y << 16) + g1 * ss.o[db][2] + g2 * sw.o[db][2], r3 = u2f(pv.y & 0xffff0000u) + g1 * ss.o[db][3] + g2 * sw.o[db][3];
            uint2 w; w.x = pack2bf(r0, r1); w.y = pack2bf(r2, r3); *(uint2*)od = w; }
    }
}
__device__ __forceinline__ void ph_ca_attn_mfma(const Params& p, int l, int wv, LAS unsigned char* lds, int gC, int gG) {
    int tid = wv * 64 + mk_lane(); asm volatile("" : "+v"(tid));
    const int wid = tid >> 6, lane = tid & 63, r = lane & 15, q = lane >> 4;
    const bf16_t* CQ = WSP(bf16_t, p.oCQ); const bf16_t* KV = WSP(bf16_t, p.oKV) + (long long)l * 512; bf16_t* AO = WSP(bf16_t, p.oCAO);
    const int nqb = (int)(p.S >> 7), npair = (int)(p.B * 4), units = npair * nqb;
    const int per = (units + gG - 1) / gG, u0 = gC * per, u1 = (u0 + per < units) ? u0 + per : units;
    int staged = -1;
    for (int u = u0; u < u1; ++u) { const int qb = u % nqb, bh = u / nqb, b = bh >> 2, hd = bh & 3;
        if (bh != staged) { staged = bh; __syncthreads();
#pragma unroll
            for (int i = 0; i < 4; ++i) { const long long kr = ((long long)b * 256 + i * 64 + (tid >> 3)) * 1024 + hd * 64 + (tid & 7) * 8; const uint4 kc = *(const uint4*)(KV + kr), vc = *(const uint4*)(KV + kr + 256); attn_stage_store(lds + i * AT_BUF, tid, kc, vc); }
            __syncthreads(); }
        const long long tok = (long long)b * p.S + (long long)qb * 128 + wid * 16 + r;
        bf16x8_t bq[2];
#pragma unroll
        for (int ks = 0; ks < 2; ++ks) bq[ks] = *(const bf16x8_t*)(CQ + tok * 256 + hd * 64 + 32 * ks + 8 * q);
        AttnState st; attn_init(st);
#pragma unroll
        for (int i = 0; i < 4; ++i) { const LAS unsigned char* buf = lds + i * AT_BUF; attn_tile<false>(buf, buf + AT_KBYTES, bq, st, lane, [](int, int) { return true; }); }
        const float il = 1.0f / st.l;
#pragma unroll
        for (int db = 0; db < 4; ++db) { uint2 w; w.x = pack2bf(st.o[db][0] * il, st.o[db][1] * il); w.y = pack2bf(st.o[db][2] * il, st.o[db][3] * il); *(uint2*)(AO + tok * 256 + hd * 64 + 16 * db + 4 * q) = w; }
    }
}
#endif
#ifndef CPU_EMU
constexpr int CM_KBYTES = 128 * AT_KS, CM_VBYTES = 128 * AT_KS;
__device__ __forceinline__ void better2(float& v, int& i, float ov, int oi) { if (ov > v || (ov == v && oi < i)) { v = ov; i = oi; } }
__device__ __forceinline__ void cmp_unit(const Params& p, int cur, int bg, int wv, LAS unsigned char* lds) {
    int tid = wv * 64 + mk_lane(); asm volatile("" : "+v"(tid));
    const int lane = tid & 63, r = lane & 15, q = lane >> 4;
    const bf16_t* P = WSP(bf16_t, p.oP); const bf16_t* KCB = WSP(bf16_t, p.oKCMP); const bf16_t* VCB = WSP(bf16_t, p.oVCMP); unsigned* SELM = WSP(unsigned, p.oSELM); bf16_t* O = WSP(bf16_t, p.oO);
    LAS unsigned char* kt = lds; LAS unsigned char* vt = lds + CM_KBYTES;
    {   const int b = bg >> 1, g = bg & 1;
        {
#pragma unroll
            for (int i = 0; i < 2; ++i) { const int ch = tid + 512 * i, key = ch >> 3, c = ch & 7;
                const uint4 kc = *(const uint4*)(KCB + ((long long)bg * 128 + key) * 64 + c * 8), vc = *(const uint4*)(VCB + ((long long)bg * 128 + key) * 64 + c * 8);
                *(LAS u32x4_t*)(kt + key * AT_KS + c * 16) = (u32x4_t){kc.x, kc.y, kc.z, kc.w}; *(LAS u32x4_t*)(vt + key * AT_KS + c * 16) = (u32x4_t){vc.x, vc.y, vc.z, vc.w}; } }
        __syncthreads();
        const int tl = 8 * wv + (r >> 1), hd = 2 * g + (r & 1); const long long tok = (long long)b * p.S + (long long)cur * 64 + tl; const int sq = cur * 64 + tl;
        bf16x8_t bq[2];
#pragma unroll
        for (int ks = 0; ks < 2; ++ks) bq[ks] = *(const bf16x8_t*)(P + tok * PW + C_Q + hd * 64 + 32 * ks + 8 * q);
        const int nv = sq >= 31 ? (sq - 31) / 16 + 1 : 0;
        const int sqw = cur * 64 + 8 * wv + 7, nvw = sqw >= 31 ? (sqw - 31) / 16 + 1 : 0, nkb = (nvw + 15) >> 4;
        f32x4_t s[8];
#pragma unroll
        for (int kb = 0; kb < 8; ++kb) { s[kb] = (f32x4_t){0.f, 0.f, 0.f, 0.f};
            if (kb < nkb) {
#pragma unroll
                for (int ks = 0; ks < 2; ++ks) { const bf16x8_t a = *(const LAS bf16x8_t*)(kt + (16 * kb + r) * AT_KS + (32 * ks + 8 * q) * 2); s[kb] = __builtin_amdgcn_mfma_f32_16x16x32_bf16(a, bq[ks], s[kb], 0, 0, 0); } } }
        float mx = -1e30f;
#pragma unroll
        for (int kb = 0; kb < 8; ++kb)
#pragma unroll
            for (int j = 0; j < 4; ++j) { const bool ok = 16 * kb + 4 * q + j < nv; const float v = ok ? s[kb][j] : -1e30f; s[kb][j] = v; mx = fmaxf(mx, v); }
        mx = quad4_max(mx);
        float sum = 0.f;
#pragma unroll
        for (int kb = 0; kb < 8; ++kb)
#pragma unroll
            for (int j = 0; j < 4; ++j) { const float pv = s[kb][j] > -1e29f ? __builtin_amdgcn_exp2f(s[kb][j] - mx) : 0.f; s[kb][j] = pv; sum += pv; }
        sum = quad4_sum(sum);
        const float inv = nv > 0 ? 1.0f / sum : 0.f;
#pragma unroll
        for (int kb = 0; kb < 8; ++kb) s[kb] = s[kb] * inv;
        f32x4_t o[4];
#pragma unroll
        for (int db = 0; db < 4; ++db) o[db] = (f32x4_t){0.f, 0.f, 0.f, 0.f};
        const unsigned vb = (unsigned)(size_t)vt + (unsigned)((4 * q + (r >> 2)) * AT_KS + 8 * (r & 3));
#pragma unroll
        for (int kk = 0; kk < 4; ++kk) if (2 * kk < nkb) { u32x4_t w = (u32x4_t){pack2bf(s[2 * kk][0], s[2 * kk][1]), pack2bf(s[2 * kk][2], s[2 * kk][3]), pack2bf(s[2 * kk + 1][0], s[2 * kk + 1][1]), pack2bf(s[2 * kk + 1][2], s[2 * kk + 1][3])};
            const bf16x8_t pb = __builtin_bit_cast(bf16x8_t, w);
            bf16x4_t l0, l1, l2, l3, h0, h1, h2, h3; const unsigned va = vb + (unsigned)(kk * 32 * AT_KS);
            asm volatile("ds_read_b64_tr_b16 %0, %8\n\tds_read_b64_tr_b16 %1, %8 offset:32\n\tds_read_b64_tr_b16 %2, %8 offset:64\n\tds_read_b64_tr_b16 %3, %8 offset:96\n\t"
                         "ds_read_b64_tr_b16 %4, %8 offset:2304\n\tds_read_b64_tr_b16 %5, %8 offset:2336\n\tds_read_b64_tr_b16 %6, %8 offset:2368\n\tds_read_b64_tr_b16 %7, %8 offset:2400\n\ts_waitcnt lgkmcnt(0)"
                         : "=&v"(l0), "=&v"(l1), "=&v"(l2), "=&v"(l3), "=&v"(h0), "=&v"(h1), "=&v"(h2), "=&v"(h3) : "v"(va) : "memory");
            o[0] = __builtin_amdgcn_mfma_f32_16x16x32_bf16(__builtin_shufflevector(l0, h0, 0, 1, 2, 3, 4, 5, 6, 7), pb, o[0], 0, 0, 0);
            o[1] = __builtin_amdgcn_mfma_f32_16x16x32_bf16(__builtin_shufflevector(l1, h1, 0, 1, 2, 3, 4, 5, 6, 7), pb, o[1], 0, 0, 0);
            o[2] = __builtin_amdgcn_mfma_f32_16x16x32_bf16(__builtin_shufflevector(l2, h2, 0, 1, 2, 3, 4, 5, 6, 7), pb, o[2], 0, 0, 0);
            o[3] = __builtin_amdgcn_mfma_f32_16x16x32_bf16(__builtin_shufflevector(l3, h3, 0, 1, 2, 3, 4, 5, 6, 7), pb, o[3], 0, 0, 0); }
        const float g0 = sigmoidf_(bf2f(P[tok * PW + C_NG + hd * 3]));
#pragma unroll
        for (int db = 0; db < 4; ++db) { uint2 w; w.x = pack2bf(g0 * o[db][0], g0 * o[db][1]); w.y = pack2bf(g0 * o[db][2], g0 * o[db][3]); *(uint2*)(O + tok * 1024 + hd * 64 + 16 * db + 4 * q) = w; }
        unsigned mask;
        if (cur < 8) mask = (2u << cur) - 1u;
        else {
            float imp[8], tcar[8];
#pragma unroll
            for (int kb = 0; kb < 8; ++kb) { imp[kb] = s[kb][0] + s[kb][1] + s[kb][2] + 0.5f * s[kb][3]; tcar[kb] = __shfl(0.5f * s[kb][3], (lane + 48) & 63); }
#pragma unroll
            for (int kb = 0; kb < 8; ++kb) { const float cin = q >= 1 ? tcar[kb] : (kb >= 1 ? tcar[kb >= 1 ? kb - 1 : 0] : 0.f); imp[kb] += cin; imp[kb] += dpp_mov1(imp[kb]); }
            mask = 1u | (1u << cur) | (1u << (cur - 1));
#pragma unroll
            for (int kb = 0; kb < 8; ++kb) { const int jj = 4 * kb + q; if (!(jj >= 1 && jj <= cur - 2)) imp[kb] = -3e38f; }
            for (int rd = 0; rd < 5; ++rd) { float bv = -3e38f; int bi = 1 << 20;
#pragma unroll
                for (int kb = 0; kb < 8; ++kb) if (imp[kb] > bv) { bv = imp[kb]; bi = 4 * kb + q; }
                {
                    float av = bv, cv = bv; int ai = bi, ci = bi;
                    asm volatile("s_nop 1\n\tv_permlane16_swap_b32 %0, %1\n\tv_permlane16_swap_b32 %2, %3" : "+v"(av), "+v"(cv), "+v"(ai), "+v"(ci));
                    bv = av; bi = ai; better2(bv, bi, cv, ci); av = bv; cv = bv; ai = bi; ci = bi;
                    asm volatile("s_nop 1\n\tv_permlane32_swap_b32 %0, %1\n\tv_permlane32_swap_b32 %2, %3" : "+v"(av), "+v"(cv), "+v"(ai), "+v"(ci));
                    bv = av; bi = ai; better2(bv, bi, cv, ci); }
                mask |= 1u << bi;
#pragma unroll
                for (int kb = 0; kb < 8; ++kb) if (bi == 4 * kb + q) imp[kb] = -3e38f; }
        }
        if (q == 0 && (r & 1) == 0) SELM[tok * 2 + g] = mask;
    }
}
#endif
#ifndef CPU_EMU
typedef float f32x2_t __attribute__((ext_vector_type(2)));
template <int CTRL> __device__ __forceinline__ float dpp_mov(float x) { return __builtin_bit_cast(float, __builtin_amdgcn_update_dpp(0, __builtin_bit_cast(int, x), CTRL, 0xF, 0xF, true)); }
__device__ __forceinline__ float sum8(float x) { x += dpp_mov<0xB1>(x); x += dpp_mov<0x4E>(x); x += dpp_mov<0x141>(x); return x; }
__device__ __forceinline__ float sum16s(float x) { x += __shfl_xor(x, 1); x += __shfl_xor(x, 2); x += __shfl_xor(x, 4); x += __shfl_xor(x, 8); return x; }
constexpr int SC_CH = 32;
constexpr int RW_STEP = 384, RW_BUF = SC_CH * RW_STEP * 4;
constexpr int GL_STEP = 160, GL_BUF = SC_CH * GL_STEP * 4;
__device__ __forceinline__ void cvt8(const uint4& w, float (&f)[8]) { f[0] = u2f(w.x << 16); f[1] = u2f(w.x & 0xffff0000u); f[2] = u2f(w.y << 16); f[3] = u2f(w.y & 0xffff0000u); f[4] = u2f(w.z << 16); f[5] = u2f(w.z & 0xffff0000u); f[6] = u2f(w.w << 16); f[7] = u2f(w.w & 0xffff0000u); }

__device__ __forceinline__ void rwkv_chain(const Params& p, int l, int ch, int wv, LAS unsigned char* lds) {
    int tid = wv * 64 + mk_lane(); asm volatile("" : "+v"(tid));
    const int row = tid >> 3, cg = tid & 7; const long long b = ch >> 2; const int h = ch & 3;
    const float* RWW = WSP(float, p.oRWW); const bf16_t* RWX = WSP(bf16_t, p.oRWX); bf16_t* O = WSP(bf16_t, p.oO); const float* lng = p.in[I_RW_LN] + l * 256 + h * 64; const float* rkw = p.in[I_RW_RK] + l * 256 + h * 64;
    LAS float* YB = (LAS float*)(lds + 2 * RW_BUF);
    const long long tb = b * p.S; const int nch = (int)(p.S / SC_CH);
    float4 gw;
    uint4 gx0, gx1, gx2;
#define RW_GLOAD1(idx_, dst_) do { const int idx = (idx_); if (idx < 1280) { const int step = idx / 40, rem = idx % 40, vec = rem >> 3, c8 = rem & 7; dst_ = *(const uint4*)(RWX + (t0_ + step) * 1280 + vec * 256 + h * 64 + 8 * c8); } } while (0)
#define RW_GLOAD(c_) do { const long long t0_ = tb + (long long)(c_) * SC_CH; gw = *(const float4*)(RWW + (t0_ + (tid >> 4)) * 256 + h * 64 + 4 * (tid & 15)); RW_GLOAD1(tid, gx0); RW_GLOAD1(tid + 512, gx1); RW_GLOAD1(tid + 1024, gx2); } while (0)
#define RW_SSTORE1(idx_, src_) do { const int idx = (idx_); if (idx < 1280) { const int step = idx / 40, rem = idx % 40, vec = rem >> 3, c8 = rem & 7; \
        const int slot = vec == 0 ? 4 : (vec == 1 ? 3 : (vec == 2 ? 5 : (vec == 3 ? 1 : 2))); float f[8]; cvt8(src_, f); LAS float* d = B_ + step * RW_STEP + slot * 64 + 8 * c8; \
        *(LAS f32x4_t*)d = (f32x4_t){f[0], f[1], f[2], f[3]}; *(LAS f32x4_t*)(d + 4) = (f32x4_t){f[4], f[5], f[6], f[7]}; } } while (0)
#define RW_SSTORE(buf_) do { LAS float* B_ = (LAS float*)(lds + (buf_) * RW_BUF); *(LAS f32x4_t*)(B_ + (tid >> 4) * RW_STEP + 4 * (tid & 15)) = (f32x4_t){gw.x, gw.y, gw.z, gw.w}; \
        RW_SSTORE1(tid, gx0); RW_SSTORE1(tid + 512, gx1); RW_SSTORE1(tid + 1024, gx2); } while (0)
    f32x2_t st[4];
#pragma unroll
    for (int i = 0; i < 4; ++i) st[i] = (f32x2_t){0.f, 0.f};
    RW_GLOAD(0); RW_SSTORE(0); __syncthreads();
    for (int c = 0; c < nch; ++c) {
        if (c + 1 < nch) RW_GLOAD(c + 1);
        const LAS float* B = (const LAS float*)(lds + (c & 1) * RW_BUF);
        for (int s = 0; s < SC_CH; ++s) { const LAS float* x = B + s * RW_STEP + 8 * cg;
            f32x2_t w[4], kk[4], bb[4], k[4], r[4];
#pragma unroll
            for (int i = 0; i < 2; ++i) { const f32x4_t a0 = *(const LAS f32x4_t*)(x + 4 * i), a1 = *(const LAS f32x4_t*)(x + 64 + 4 * i), a2 = *(const LAS f32x4_t*)(x + 128 + 4 * i), a3 = *(const LAS f32x4_t*)(x + 192 + 4 * i), a4 = *(const LAS f32x4_t*)(x + 256 + 4 * i);
                w[2 * i] = (f32x2_t){a0[0], a0[1]}; w[2 * i + 1] = (f32x2_t){a0[2], a0[3]}; kk[2 * i] = (f32x2_t){a1[0], a1[1]}; kk[2 * i + 1] = (f32x2_t){a1[2], a1[3]};
                bb[2 * i] = (f32x2_t){a2[0], a2[1]}; bb[2 * i + 1] = (f32x2_t){a2[2], a2[3]}; k[2 * i] = (f32x2_t){a3[0], a3[1]}; k[2 * i + 1] = (f32x2_t){a3[2], a3[3]};
                r[2 * i] = (f32x2_t){a4[0], a4[1]}; r[2 * i + 1] = (f32x2_t){a4[2], a4[3]}; }
            const float v = B[s * RW_STEP + 320 + row];
            f32x2_t a = st[0] * kk[0] + st[1] * kk[1]; a += st[2] * kk[2] + st[3] * kk[3];
            const float skk = sum8(a[0] + a[1]);
            f32x2_t y2 = (f32x2_t){0.f, 0.f};
#pragma unroll
            for (int i = 0; i < 4; ++i) { st[i] = st[i] * w[i] - bb[i] * skk + k[i] * v; y2 += st[i] * r[i]; }
            const float y = sum8(y2[0] + y2[1]);
            if (cg == 0) YB[s * 64 + row] = y; }
        __syncthreads();
        {
            const int s = tid >> 4, v0 = 4 * (tid & 15); const long long t = tb + (long long)c * SC_CH + s;
            const f32x4_t y = *(const LAS f32x4_t*)(YB + s * 64 + v0); const f32x4_t vv = *(const LAS f32x4_t*)(B + s * RW_STEP + 320 + v0);
            const float mean = sum16s(y[0] + y[1] + y[2] + y[3]) * (1.0f / 64.0f);
            const float d0 = y[0] - mean, d1 = y[1] - mean, d2 = y[2] - mean, d3 = y[3] - mean;
            const float var = sum16s(d0 * d0 + d1 * d1 + d2 * d2 + d3 * d3) * (1.0f / 64.0f), rstd = rsqrtf(var + 64e-5f);
            const f32x4_t rr = *(const LAS f32x4_t*)(B + s * RW_STEP + 256 + v0), kq = *(const LAS f32x4_t*)(B + s * RW_STEP + 192 + v0); const float4 rw4 = *(const float4*)(rkw + v0);
            const float rk = sum16s(rr[0] * kq[0] * rw4.x + rr[1] * kq[1] * rw4.y + rr[2] * kq[2] * rw4.z + rr[3] * kq[3] * rw4.w);
            bf16_t* o = O + t * 1024 + 512 + h * 64 + v0; const uint2 g = *(const uint2*)o; const float4 ln = *(const float4*)(lng + v0);
            const float r0 = (d0 * rstd * ln.x + rk * vv[0]) * u2f(g.x << 16), r1 = (d1 * rstd * ln.y + rk * vv[1]) * u2f(g.x & 0xffff0000u);
            const float r2 = (d2 * rstd * ln.z + rk * vv[2]) * u2f(g.y << 16), r3 = (d3 * rstd * ln.w + rk * vv[3]) * u2f(g.y & 0xffff0000u);
            uint2 w; w.x = pack2bf(r0, r1); w.y = pack2bf(r2, r3); *(uint2*)o = w; }
        if (c + 1 < nch) RW_SSTORE((c + 1) & 1);
        __syncthreads();
    }
}
__device__ __forceinline__ void gla_chain(const Params& p, int l, int ch, int wv, LAS unsigned char* lds) {
    int tid = wv * 64 + mk_lane(); asm volatile("" : "+v"(tid));
    const int vc = tid >> 3, kg = tid & 7; const long long b = ch >> 2; const int h = ch & 3;
    const bf16_t* P = WSP(bf16_t, p.oP); const float* GA = WSP(float, p.oGA); bf16_t* O = WSP(bf16_t, p.oO); const float* ng = p.in[I_GLA_NORM] + l * 64;
    LAS float* OB = (LAS float*)(lds + 2 * GL_BUF);
    const long long tb = b * p.S; const int nch = (int)(p.S / SC_CH);
    float4 ga; uint4 g1, g2;
#define GL_GLOAD(c_) do { const long long t0_ = tb + (long long)(c_) * SC_CH; \
        if (tid < 256) { const int step = tid >> 3, c4 = tid & 7; ga = *(const float4*)(GA + (t0_ + step) * 128 + h * 32 + 4 * c4); g1 = *(const uint4*)(P + (t0_ + step) * PW + C_GLA + 256 + h * 64 + 8 * c4); } \
        else { const int idx = tid - 256, step = idx >> 3, vec = (idx >> 2) & 1, c8 = idx & 3; g2 = *(const uint4*)(P + (t0_ + step) * PW + C_GLA + vec * 128 + h * 32 + 8 * c8); } } while (0)
#define GL_SSTORE(buf_) do { LAS float* B_ = (LAS float*)(lds + (buf_) * GL_BUF); float f[8]; \
        if (tid < 256) { const int step = tid >> 3, c4 = tid & 7; *(LAS f32x4_t*)(B_ + step * GL_STEP + 4 * c4) = (f32x4_t){ga.x, ga.y, ga.z, ga.w}; \
            cvt8(g1, f); LAS float* d = B_ + step * GL_STEP + 96 + 8 * c4; *(LAS f32x4_t*)d = (f32x4_t){f[0], f[1], f[2], f[3]}; *(LAS f32x4_t*)(d + 4) = (f32x4_t){f[4], f[5], f[6], f[7]}; } \
        else { const int idx = tid - 256, step = idx >> 3, vec = (idx >> 2) & 1, c8 = idx & 3; \
            cvt8(g2, f); LAS float* d = B_ + step * GL_STEP + (vec == 0 ? 64 : 32) + 8 * c8; *(LAS f32x4_t*)d = (f32x4_t){f[0], f[1], f[2], f[3]}; *(LAS f32x4_t*)(d + 4) = (f32x4_t){f[4], f[5], f[6], f[7]}; } } while (0)
    f32x4_t st = (f32x4_t){0.f, 0.f, 0.f, 0.f};
    GL_GLOAD(0); GL_SSTORE(0); __syncthreads();
    for (int c = 0; c < nch; ++c) {
        if (c + 1 < nch) GL_GLOAD(c + 1);
        const LAS float* B = (const LAS float*)(lds + (c & 1) * GL_BUF);
        for (int s = 0; s < SC_CH; ++s) { const LAS float* x = B + s * GL_STEP + 4 * kg;
            const f32x4_t a = *(const LAS f32x4_t*)x, k = *(const LAS f32x4_t*)(x + 32), qv = *(const LAS f32x4_t*)(x + 64); const float v = B[s * GL_STEP + 96 + vc];
            st = st * a + k * v; const f32x4_t pq = st * qv;
            const float o = sum8((pq[0] + pq[1]) + (pq[2] + pq[3]));
            if (kg == 0) OB[s * 64 + vc] = o * 0.17677669529663687f; }
        __syncthreads();
        {   const int s = tid >> 4, v0 = 4 * (tid & 15); const long long t = tb + (long long)c * SC_CH + s;
            const f32x4_t o = *(const LAS f32x4_t*)(OB + s * 64 + v0);
            const float ms = sum16s(o[0] * o[0] + o[1] * o[1] + o[2] * o[2] + o[3] * o[3]) * (1.0f / 64.0f), rs = rsqrtf(ms + 1e-6f);
            bf16_t* d = O + t * 1024 + 768 + h * 64 + v0; const uint2 g = *(const uint2*)d; const float4 n4 = *(const float4*)(ng + v0);
            uint2 w; w.x = pack2bf(o[0] * rs * n4.x * u2f(g.x << 16), o[1] * rs * n4.y * u2f(g.x & 0xffff0000u)); w.y = pack2bf(o[2] * rs * n4.z * u2f(g.y << 16), o[3] * rs * n4.w * u2f(g.y & 0xffff0000u)); *(uint2*)d = w; }
        if (c + 1 < nch) GL_SSTORE((c + 1) & 1);
        __syncthreads();
    }
}
struct RwFrags { bf16x8_t w[2], a[2], v[2], g[2][2]; };
__device__ __forceinline__ void rwkv_load_frags(const LAS unsigned* wl, int wv, RwFrags& fr) {
    const int lane = mk_lane(), r = lane & 15, q = lane >> 4;
#pragma unroll
    for (int cb = 0; cb < 2; ++cb) { const LAS unsigned* c = wl + 32 * wv + 16 * cb + r;
#define RW_FRAG(dst, pbase) do { uint4 k_; k_.x = c[((pbase) + 4 * q) * 256]; k_.y = c[((pbase) + 4 * q + 1) * 256]; k_.z = c[((pbase) + 4 * q + 2) * 256]; k_.w = c[((pbase) + 4 * q + 3) * 256]; dst = __builtin_bit_cast(bf16x8_t, k_); } while (0)
        RW_FRAG(fr.w[cb], 0); RW_FRAG(fr.a[cb], 16); RW_FRAG(fr.v[cb], 32); RW_FRAG(fr.g[cb][0], 48); RW_FRAG(fr.g[cb][1], 64);
#undef RW_FRAG
    }
}
__device__ __forceinline__ void rwkv_lowrank_mfma(int l, const RwFrags& fr, const LAS unsigned* FP, LAS float* Z, int wv) {
    const int lane = mk_lane(), r = lane & 15, q = lane >> 4; const f32x4_t z4 = (f32x4_t){0.f, 0.f, 0.f, 0.f};
#pragma unroll
    for (int tb = 0; tb < 2; ++tb) { const LAS unsigned* f = FP + (16 * tb + r) * 80 + 4 * q;
        const bf16x8_t fw = __builtin_bit_cast(bf16x8_t, *(const LAS u32x4_t*)(f)), fa = __builtin_bit_cast(bf16x8_t, *(const LAS u32x4_t*)(f + 16)), fv = __builtin_bit_cast(bf16x8_t, *(const LAS u32x4_t*)(f + 32)),
                       fg0 = __builtin_bit_cast(bf16x8_t, *(const LAS u32x4_t*)(f + 48)), fg1 = __builtin_bit_cast(bf16x8_t, *(const LAS u32x4_t*)(f + 64));
#pragma unroll
        for (int cb = 0; cb < 2; ++cb) { LAS float* z = Z + (16 * tb + r) * 256 + 32 * wv + 16 * cb + 4 * q;
            *(LAS f32x4_t*)(z) = __builtin_amdgcn_mfma_f32_16x16x32_bf16(fr.w[cb], fw, z4, 0, 0, 0);
            *(LAS f32x4_t*)(z + 1 * 32 * 256) = __builtin_amdgcn_mfma_f32_16x16x32_bf16(fr.a[cb], fa, z4, 0, 0, 0);
            if (l == 1) *(LAS f32x4_t*)(z + 2 * 32 * 256) = __builtin_amdgcn_mfma_f32_16x16x32_bf16(fr.v[cb], fv, z4, 0, 0, 0);
            *(LAS f32x4_t*)(z + 3 * 32 * 256) = __builtin_amdgcn_mfma_f32_16x16x32_bf16(fr.g[cb][1], fg1, __builtin_amdgcn_mfma_f32_16x16x32_bf16(fr.g[cb][0], fg0, z4, 0, 0, 0), 0, 0, 0); } }
}
__device__ __forceinline__ void pool_gpu(const Params& p, int l, int wv, LAS unsigned char* lds, int gC, int gG) {
    int tid = wv * 64 + mk_lane(); asm volatile("" : "+v"(tid)); const int lane = tid & 63, r = lane & 15, q = lane >> 4;
    const bf16_t* P = WSP(bf16_t, p.oP); bf16_t* O = WSP(bf16_t, p.oO);
    LAS float* wl = (LAS float*)lds;
    __syncthreads(); pool_fill_w(p, l, wl, tid, 512); __syncthreads();
    const int g = wv & 3, WIN = 2 << g;
    bf16x8_t wa[4][2];
#pragma unroll
    for (int db = 0; db < 4; ++db)
#pragma unroll
        for (int ks = 0; ks < 2; ++ks) { const LAS float* w = wl + g * 4096 + (32 * ks + 8 * q) * 64 + 16 * db + r; uint4 pk;
            pk.x = pk2bf(w[0], w[64]); pk.y = pk2bf(w[128], w[192]); pk.z = pk2bf(w[256], w[320]); pk.w = pk2bf(w[384], w[448]); wa[db][ks] = __builtin_bit_cast(bf16x8_t, pk); }
    float ps[4][4];
#pragma unroll
    for (int db = 0; db < 4; ++db) { const float4 f = *(const float4*)(p.in[I_POOL_SCALE] + (long long)l * 256 + g * 64 + 16 * db + 4 * q); ps[db][0] = f.x; ps[db][1] = f.y; ps[db][2] = f.z; ps[db][3] = f.w; }
    const long long ntile = p.T >> 4;
    for (long long tile = (long long)gC * 2 + (wv >> 2); tile < ntile; tile += (long long)gG * 2) { const long long t = tile * 16 + r; const long long s = t % p.S; const int cnt = (int)(s + 1 < WIN ? s + 1 : WIN); const float inv = 1.0f / (float)cnt;
        bf16x8_t xb[2];
#pragma unroll
        for (int ks = 0; ks < 2; ++ks) { const bf16_t* src = P + t * PW + C_POOL + g * 64 + 32 * ks + 8 * q; float f0[8], dv[8]; ld8(src, f0);
#pragma unroll
            for (int j = 0; j < 8; ++j) dv[j] = f0[j];
            for (int k = 1; k < WIN; ++k) if (k < cnt) { float f[8]; ld8(src - (long long)k * PW, f);
#pragma unroll
                for (int j = 0; j < 8; ++j) dv[j] += f[j]; }
            uint4 pk; pk.x = pk2bf(dv[0] * inv - f0[0], dv[1] * inv - f0[1]); pk.y = pk2bf(dv[2] * inv - f0[2], dv[3] * inv - f0[3]); pk.z = pk2bf(dv[4] * inv - f0[4], dv[5] * inv - f0[5]); pk.w = pk2bf(dv[6] * inv - f0[6], dv[7] * inv - f0[7]);
            xb[ks] = __builtin_bit_cast(bf16x8_t, pk); }
#pragma unroll
        for (int db = 0; db < 4; ++db) { f32x4_t acc = (f32x4_t){0.f, 0.f, 0.f, 0.f};
            acc = __builtin_amdgcn_mfma_f32_16x16x32_bf16(wa[db][0], xb[0], acc, 0, 0, 0); acc = __builtin_amdgcn_mfma_f32_16x16x32_bf16(wa[db][1], xb[1], acc, 0, 0, 0);
            uint2 w; w.x = pk2bf(acc[0] * ps[db][0], acc[1] * ps[db][1]); w.y = pk2bf(acc[2] * ps[db][2], acc[3] * ps[db][3]);
            *(uint2*)(O + t * 1024 + 256 + g * 64 + 16 * db + 4 * q) = w; } }
    __syncthreads();
}
__device__ __forceinline__ void compress2_gpu(const Params& p, int l, int wv, LAS unsigned char* lds, int gC, int gG) {
    int tid = wv * 64 + mk_lane(); asm volatile("" : "+v"(tid)); const int lane = tid & 63;
    const bf16_t* UV = WSP(bf16_t, p.oUV); const float* CB = WSP(float, p.oCB) + l * 256; const float* w2 = p.in[I_CMP_W2] + (long long)l * 2 * 128 * 64; const float* R = WSP(float, p.oROPE);
    bf16_t* KC = WSP(bf16_t, p.oKCMP); bf16_t* VC = WSP(bf16_t, p.oVCMP);
    const long long hb = p.S / 16, gtid = (long long)gC * 512 + tid, gsz = (long long)gG * 512;
    LAS float* WL = (LAS float*)lds;
    __syncthreads();
    for (int i = tid; i < 2 * 128 * 64; i += 512) WL[i] = w2[i];
    for (long long i = gtid; i < p.B * 2 * (128 - p.NC) * 64; i += gsz) { const long long bgi = i / ((128 - p.NC) * 64), rem = i % ((128 - p.NC) * 64); KC[(bgi * 128 + p.NC) * 64 + rem] = 0; VC[(bgi * 128 + p.NC) * 64 + rem] = 0; }
    __syncthreads();
    const long long rows = p.B * p.NC * 4;
    for (long long row = (long long)gC * 8 + wv; row < rows; row += (long long)gG * 8) { const int j = (int)(row & 1), g = (int)((row >> 1) & 1); const long long bn = row >> 2, n = bn % p.NC, b = bn / p.NC;
        const bf16_t* u = UV + ((b * hb + n) * 4 + (2 * j + g)) * 256; const bf16_t* vv = u + 4 * 256 + 128; const float* cb = CB + j * 128;
        const float hv0 = gelu_tanhf_(bf2f(u[lane]) + bf2f(vv[lane]) + cb[lane]), hv1 = gelu_tanhf_(bf2f(u[64 + lane]) + bf2f(vv[64 + lane]) + cb[64 + lane]);
        const LAS float* w = WL + j * 8192 + lane; float a = 0.f;
#pragma unroll 16
        for (int f = 0; f < 64; ++f) a += __builtin_bit_cast(float, __builtin_amdgcn_readlane(__builtin_bit_cast(int, hv0), f)) * w[f * 64];
#pragma unroll 16
        for (int f = 0; f < 64; ++f) a += __builtin_bit_cast(float, __builtin_amdgcn_readlane(__builtin_bit_cast(int, hv1), f)) * w[(64 + f) * 64];
        if (j == 0) { const float pa = dpp_mov<0x128>(a);
            if (lane < 16) { const float* r = R + (b * p.S + n * 16 + 31) * 16; const float cs = r[lane & 7], sn = r[8 + (lane & 7)]; a = lane < 8 ? a * cs - pa * sn : a * cs + pa * sn; } }
        bf16_t* dst = (j == 0 ? KC : VC) + (((b * 2 + g) * 128) + n) * 64;
        dst[lane] = f2bf(a); }
}
__device__ __forceinline__ float sum16d(float x) { x += dpp_mov<0xB1>(x); x += dpp_mov<0x4E>(x); x += dpp_mov<0x141>(x); x += dpp_mov<0x140>(x); return x; }
__device__ __forceinline__ void norm_router_256(const Params& p, int l, long long r0, int wv, LAS unsigned char* lds) {
    int tid = wv * 64 + mk_lane(); asm volatile("" : "+v"(tid)); const int lane = tid & 63;
    const float* router = p.in[I_MOE_R]; const float* gain = p.in[I_NORM_FFN] + l * 1024;
    const bf16_t* X = WSP(bf16_t, p.oH) + r0 * 1024; bf16_t* D = (bf16_t*)p.out + r0 * 1024; int* TE = WSP(int, p.oTOKE) + r0 * 2; float* TW = WSP(float, p.oTOKW) + r0 * 2;
    LAS float* WL = (LAS float*)lds;
    __syncthreads();
    for (int i = tid; i < 8192; i += 512) WL[(i & 7) * 1024 + (i >> 3)] = router[i];
    __syncthreads();
#pragma nounroll
    for (int it = 0; it < 8; ++it) { const int rb = wv * 32 + it * 4;
        float v[4][16];
#pragma unroll
        for (int r = 0; r < 4; ++r)
#pragma unroll
            for (int j = 0; j < 4; ++j) { const uint2 w = *(const uint2*)(X + (long long)(rb + r) * 1024 + j * 256 + lane * 4);
                v[r][4 * j] = u2f(w.x << 16); v[r][4 * j + 1] = u2f(w.x & 0xffff0000u); v[r][4 * j + 2] = u2f(w.y << 16); v[r][4 * j + 3] = u2f(w.y & 0xffff0000u); }
#pragma unroll
        for (int r = 0; r < 4; ++r) { float ss = v[r][0] * v[r][0];
#pragma unroll
            for (int j = 1; j < 16; ++j) ss += v[r][j] * v[r][j];
            ss = wave_sum(ss); const float rs = rsqrtf(ss * (1.0f / 1024.0f) + 1e-6f);
#pragma unroll
            for (int j = 0; j < 4; ++j) { const float4 f = *(const float4*)(gain + j * 256 + lane * 4);
                v[r][4 * j] *= rs * f.x; v[r][4 * j + 1] *= rs * f.y; v[r][4 * j + 2] *= rs * f.z; v[r][4 * j + 3] *= rs * f.w;
                uint2 w; w.x = pk2bf(v[r][4 * j], v[r][4 * j + 1]); w.y = pk2bf(v[r][4 * j + 2], v[r][4 * j + 3]); *(uint2*)(D + (long long)(rb + r) * 1024 + j * 256 + lane * 4) = w; } }
        float acc[32];
#pragma unroll
        for (int j = 0; j < 4; ++j)
#pragma unroll
            for (int e = 0; e < 8; ++e) { const f32x4_t w = *(const LAS f32x4_t*)(WL + e * 1024 + j * 256 + lane * 4);
#pragma unroll
                for (int r = 0; r < 4; ++r) { const float t = (v[r][4 * j] * w[0] + v[r][4 * j + 1] * w[1]) + (v[r][4 * j + 2] * w[2] + v[r][4 * j + 3] * w[3]); acc[r * 8 + e] = j == 0 ? t : acc[r * 8 + e] + t; } }
        float x16[16];
#pragma unroll
        for (int i = 0; i < 16; ++i) { float a = acc[i], b = acc[i + 16]; asm("s_nop 1\n\tv_permlane32_swap_b32 %0, %1" : "+v"(a), "+v"(b)); x16[i] = a + b; }
        const bool hi16 = (lane & 16) != 0; float lg[8];
#pragma unroll
        for (int i = 0; i < 8; ++i) { const float send = hi16 ? x16[i] : x16[i + 8], keep = hi16 ? x16[i + 8] : x16[i]; float a = send, b = send; asm("s_nop 1\n\tv_permlane16_swap_b32 %0, %1" : "+v"(a), "+v"(b));
            lg[i] = sum16d(keep + u2f(f2u(a) ^ f2u(b) ^ f2u(send))); }
        int i0 = 0; float v0 = lg[0];
#pragma unroll
        for (int e = 1; e < 8; ++e) if (lg[e] > v0) { v0 = lg[e]; i0 = e; }
        int i1 = -1; float v1 = -3e38f;
#pragma unroll
        for (int e = 0; e < 8; ++e) if (e != i0 && lg[e] > v1) { v1 = lg[e]; i1 = e; }
        const float w0 = 1.0f / (1.0f + expf(v1 - v0));
        if ((lane & 15) == 0) { const int rr = rb + (lane >> 4); TE[rr * 2] = i0; TE[rr * 2 + 1] = i1; TW[rr * 2] = w0; TW[rr * 2 + 1] = 1.0f - w0; } }
}
constexpr int PC_GL0 = 2 * RW_BUF + 8192, PC_OB = PC_GL0 + 2 * GL_BUF, PC_LDS = PC_OB + 8192;
__device__ __forceinline__ void pair_chain(const Params& p, int l, int ch, int wv, LAS unsigned char* lds) {
    int tid = wv * 64 + mk_lane(); asm volatile("" : "+v"(tid));
    const long long b = ch >> 2; const int h = ch & 3; const long long tb = b * p.S; const int nch = (int)(p.S / SC_CH);
    bf16_t* O = WSP(bf16_t, p.oO);
    if (wv < 4) {
        const int rp = tid >> 3, cg = tid & 7;
        const float* RWW = WSP(float, p.oRWW); const bf16_t* RWX = WSP(bf16_t, p.oRWX); const float* lng = p.in[I_RW_LN] + l * 256 + h * 64; const float* rkw = p.in[I_RW_RK] + l * 256 + h * 64;
        LAS float* YB = (LAS float*)(lds + 2 * RW_BUF);
        float4 gw0, gw1; uint4 gx0, gx1, gx2, gx3, gx4;
#define PR_GLOAD1(idx_, dst_) do { const int idx = (idx_); const int step = idx / 40, rem = idx % 40, vec = rem >> 3, c8 = rem & 7; dst_ = *(const uint4*)(RWX + (t0_ + step) * 1280 + vec * 256 + h * 64 + 8 * c8); } while (0)
#define PR_GLOAD(c_) do { const long long t0_ = tb + (long long)(c_) * SC_CH; gw0 = *(const float4*)(RWW + (t0_ + (tid >> 4)) * 256 + h * 64 + 4 * (tid & 15)); gw1 = *(const float4*)(RWW + (t0_ + 16 + (tid >> 4)) * 256 + h * 64 + 4 * (tid & 15)); \
            PR_GLOAD1(tid, gx0); PR_GLOAD1(tid + 256, gx1); PR_GLOAD1(tid + 512, gx2); PR_GLOAD1(tid + 768, gx3); PR_GLOAD1(tid + 1024, gx4); } while (0)
#define PR_SSTORE1(idx_, src_) do { const int idx = (idx_); const int step = idx / 40, rem = idx % 40, vec = rem >> 3, c8 = rem & 7; \
            const int slot = vec == 0 ? 4 : (vec == 1 ? 3 : (vec == 2 ? 5 : (vec == 3 ? 1 : 2))); float f[8]; cvt8(src_, f); LAS float* d = B_ + step * RW_STEP + slot * 64 + 8 * c8; \
            *(LAS f32x4_t*)d = (f32x4_t){f[0], f[1], f[2], f[3]}; *(LAS f32x4_t*)(d + 4) = (f32x4_t){f[4], f[5], f[6], f[7]}; } while (0)
#define PR_SSTORE(buf_) do { LAS float* B_ = (LAS float*)(lds + (buf_) * RW_BUF); *(LAS f32x4_t*)(B_ + (tid >> 4) * RW_STEP + 4 * (tid & 15)) = (f32x4_t){gw0.x, gw0.y, gw0.z, gw0.w}; \
            *(LAS f32x4_t*)(B_ + (16 + (tid >> 4)) * RW_STEP + 4 * (tid & 15)) = (f32x4_t){gw1.x, gw1.y, gw1.z, gw1.w}; \
            PR_SSTORE1(tid, gx0); PR_SSTORE1(tid + 256, gx1); PR_SSTORE1(tid + 512, gx2); PR_SSTORE1(tid + 768, gx3); PR_SSTORE1(tid + 1024, gx4); } while (0)
        f32x2_t s0[4], s1[4];
#pragma unroll
        for (int i = 0; i < 4; ++i) { s0[i] = (f32x2_t){0.f, 0.f}; s1[i] = (f32x2_t){0.f, 0.f}; }
        float lnw[8], rkv[8]; uint4 gpre;
        {   const float4 a0 = *(const float4*)(lng + 8 * (tid & 7)), a1 = *(const float4*)(lng + 8 * (tid & 7) + 4), b0 = *(const float4*)(rkw + 8 * (tid & 7)), b1 = *(const float4*)(rkw + 8 * (tid & 7) + 4);
            lnw[0] = a0.x; lnw[1] = a0.y; lnw[2] = a0.z; lnw[3] = a0.w; lnw[4] = a1.x; lnw[5] = a1.y; lnw[6] = a1.z; lnw[7] = a1.w; rkv[0] = b0.x; rkv[1] = b0.y; rkv[2] = b0.z; rkv[3] = b0.w; rkv[4] = b1.x; rkv[5] = b1.y; rkv[6] = b1.z; rkv[7] = b1.w; }
        PR_GLOAD(0); PR_SSTORE(0); __syncthreads();
        for (int c = 0; c < nch; ++c) {
            gpre = *(const uint4*)(O + (tb + (long long)c * SC_CH + (tid >> 3)) * 1024 + 512 + h * 64 + 8 * (tid & 7));
            if (c + 1 < nch) PR_GLOAD(c + 1);
            const LAS float* B = (const LAS float*)(lds + (c & 1) * RW_BUF);
#define PR_LD(R_, V_, s_) do { const LAS float* x = B + (s_) * RW_STEP + 8 * cg; \
                R_[0] = *(const LAS f32x4_t*)(x); R_[1] = *(const LAS f32x4_t*)(x + 64); R_[2] = *(const LAS f32x4_t*)(x + 128); R_[3] = *(const LAS f32x4_t*)(x + 192); R_[4] = *(const LAS f32x4_t*)(x + 256); \
                R_[5] = *(const LAS f32x4_t*)(x + 4); R_[6] = *(const LAS f32x4_t*)(x + 68); R_[7] = *(const LAS f32x4_t*)(x + 132); R_[8] = *(const LAS f32x4_t*)(x + 196); R_[9] = *(const LAS f32x4_t*)(x + 260); \
                V_ = *(const LAS f32x2_t*)(B + (s_) * RW_STEP + 320 + 2 * rp); } while (0)
#define PR_STEP(R_, V_, s_) do { f32x2_t w[4], kk[4], bb[4], k[4], r[4]; \
                _Pragma("unroll") for (int i = 0; i < 2; ++i) { const f32x4_t a0 = R_[5 * i], a1 = R_[5 * i + 1], a2 = R_[5 * i + 2], a3 = R_[5 * i + 3], a4 = R_[5 * i + 4]; \
                    w[2 * i] = (f32x2_t){a0[0], a0[1]}; w[2 * i + 1] = (f32x2_t){a0[2], a0[3]}; kk[2 * i] = (f32x2_t){a1[0], a1[1]}; kk[2 * i + 1] = (f32x2_t){a1[2], a1[3]}; \
                    bb[2 * i] = (f32x2_t){a2[0], a2[1]}; bb[2 * i + 1] = (f32x2_t){a2[2], a2[3]}; k[2 * i] = (f32x2_t){a3[0], a3[1]}; k[2 * i + 1] = (f32x2_t){a3[2], a3[3]}; \
                    r[2 * i] = (f32x2_t){a4[0], a4[1]}; r[2 * i + 1] = (f32x2_t){a4[2], a4[3]}; } \
                f32x2_t a = s0[0] * kk[0] + s0[1] * kk[1]; a += s0[2] * kk[2] + s0[3] * kk[3]; \
                f32x2_t c2 = s1[0] * kk[0] + s1[1] * kk[1]; c2 += s1[2] * kk[2] + s1[3] * kk[3]; \
                const float skk0 = sum8(a[0] + a[1]), skk1 = sum8(c2[0] + c2[1]); \
                f32x2_t y0 = (f32x2_t){0.f, 0.f}, y1 = (f32x2_t){0.f, 0.f}; \
                _Pragma("unroll") for (int i = 0; i < 4; ++i) { s0[i] = s0[i] * w[i] - bb[i] * skk0 + k[i] * V_[0]; y0 += s0[i] * r[i]; s1[i] = s1[i] * w[i] - bb[i] * skk1 + k[i] * V_[1]; y1 += s1[i] * r[i]; } \
                const float ya = sum8(y0[0] + y0[1]), yb = sum8(y1[0] + y1[1]); \
                if (cg == 0) *(LAS f32x2_t*)(YB + (s_) * 64 + 2 * rp) = (f32x2_t){ya, yb}; } while (0)
            {   f32x4_t RA[10], RB[10]; f32x2_t VA, VB;
                PR_LD(RA, VA, 0); __builtin_amdgcn_sched_barrier(0);
#pragma nounroll
                for (int s = 0; s < SC_CH; s += 2) {
                    PR_LD(RB, VB, s + 1); __builtin_amdgcn_sched_barrier(0);
                    PR_STEP(RA, VA, s); __builtin_amdgcn_sched_barrier(0);
                    { const int sn = s + 2 < SC_CH ? s + 2 : SC_CH - 1; PR_LD(RA, VA, sn); } __builtin_amdgcn_sched_barrier(0);
                    PR_STEP(RB, VB, s + 1); __builtin_amdgcn_sched_barrier(0); } }
#undef PR_LD
#undef PR_STEP
            __syncthreads();
            {
                const int s = tid >> 3, v0 = 8 * (tid & 7); const long long t = tb + (long long)c * SC_CH + s;
                float y[8], vv[8], rr[8], kq[8];
#pragma unroll
                for (int i = 0; i < 2; ++i) { const f32x4_t ty = *(const LAS f32x4_t*)(YB + s * 64 + v0 + 4 * i), tv = *(const LAS f32x4_t*)(B + s * RW_STEP + 320 + v0 + 4 * i), tr = *(const LAS f32x4_t*)(B + s * RW_STEP + 256 + v0 + 4 * i), tk = *(const LAS f32x4_t*)(B + s * RW_STEP + 192 + v0 + 4 * i);
#pragma unroll
                    for (int j = 0; j < 4; ++j) { y[4 * i + j] = ty[j]; vv[4 * i + j] = tv[j]; rr[4 * i + j] = tr[j]; kq[4 * i + j] = tk[j]; } }
                float sm = 0.f, rkp = 0.f;
#pragma unroll
                for (int j = 0; j < 8; ++j) { sm += y[j]; rkp += rr[j] * kq[j] * rkv[j]; }
                const float mean = sum8(sm) * (1.0f / 64.0f); float vs = 0.f;
#pragma unroll
                for (int j = 0; j < 8; ++j) { y[j] -= mean; vs += y[j] * y[j]; }
                const float rstd = rsqrtf(sum8(vs) * (1.0f / 64.0f) + 64e-5f), rk = sum8(rkp);
                bf16_t* o = O + t * 1024 + 512 + h * 64 + v0; float g[8], res[8]; cvt8(gpre, g);
#pragma unroll
                for (int j = 0; j < 8; ++j) res[j] = (y[j] * rstd * lnw[j] + rk * vv[j]) * g[j];
                st8(o, res); }
            if (c + 1 < nch) PR_SSTORE((c + 1) & 1);
            __syncthreads();
        }
#undef PR_GLOAD1
#undef PR_GLOAD
#undef PR_SSTORE1
#undef PR_SSTORE
    } else {
        const int t = tid - 256, vp = t >> 3, kg = t & 7;
        const bf16_t* P = WSP(bf16_t, p.oP); const float* GA = WSP(float, p.oGA); const float* ng = p.in[I_GLA_NORM] + l * 64;
        LAS float* OB = (LAS float*)(lds + PC_OB);
        float4 ga; uint4 g1, g2;
#define PG_GLOAD(c_) do { const long long t0_ = tb + (long long)(c_) * SC_CH; const int step = t >> 3; \
            ga = *(const float4*)(GA + (t0_ + step) * 128 + h * 32 + 4 * (t & 7)); g1 = *(const uint4*)(P + (t0_ + step) * PW + C_GLA + 256 + h * 64 + 8 * (t & 7)); \
            g2 = *(const uint4*)(P + (t0_ + step) * PW + C_GLA + ((t >> 2) & 1) * 128 + h * 32 + 8 * (t & 3)); } while (0)
#define PG_SSTORE(buf_) do { LAS float* B_ = (LAS float*)(lds + PC_GL0 + (buf_) * GL_BUF); float f[8]; const int step = t >> 3; \
            *(LAS f32x4_t*)(B_ + step * GL_STEP + 4 * (t & 7)) = (f32x4_t){ga.x, ga.y, ga.z, ga.w}; \
            cvt8(g1, f); { LAS float* d = B_ + step * GL_STEP + 96 + 8 * (t & 7); *(LAS f32x4_t*)d = (f32x4_t){f[0], f[1], f[2], f[3]}; *(LAS f32x4_t*)(d + 4) = (f32x4_t){f[4], f[5], f[6], f[7]}; } \
            cvt8(g2, f); { LAS float* d = B_ + step * GL_STEP + (((t >> 2) & 1) == 0 ? 64 : 32) + 8 * (t & 3); *(LAS f32x4_t*)d = (f32x4_t){f[0], f[1], f[2], f[3]}; *(LAS f32x4_t*)(d + 4) = (f32x4_t){f[4], f[5], f[6], f[7]}; } } while (0)
        f32x4_t q0 = (f32x4_t){0.f, 0.f, 0.f, 0.f}, q1 = q0;
        float ngw[8]; uint4 gpre;
        {   const float4 a0 = *(const float4*)(ng + 8 * (t & 7)), a1 = *(const float4*)(ng + 8 * (t & 7) + 4); ngw[0] = a0.x; ngw[1] = a0.y; ngw[2] = a0.z; ngw[3] = a0.w; ngw[4] = a1.x; ngw[5] = a1.y; ngw[6] = a1.z; ngw[7] = a1.w; }
        PG_GLOAD(0); PG_SSTORE(0); __syncthreads();
        for (int c = 0; c < nch; ++c) {
            gpre = *(const uint4*)(O + (tb + (long long)c * SC_CH + (t >> 3)) * 1024 + 768 + h * 64 + 8 * (t & 7));
            if (c + 1 < nch) PG_GLOAD(c + 1);
            const LAS float* B = (const LAS float*)(lds + PC_GL0 + (c & 1) * GL_BUF);
#define PG_LD(R_, V_, s_) do { const LAS float* x = B + (s_) * GL_STEP + 4 * kg; R_[0] = *(const LAS f32x4_t*)x; R_[1] = *(const LAS f32x4_t*)(x + 32); R_[2] = *(const LAS f32x4_t*)(x + 64); V_ = *(const LAS f32x2_t*)(B + (s_) * GL_STEP + 96 + 2 * vp); } while (0)
#define PG_STEP(R_, V_, s_) do { q0 = q0 * R_[0] + R_[1] * V_[0]; q1 = q1 * R_[0] + R_[1] * V_[1]; const f32x4_t p0 = q0 * R_[2], p1 = q1 * R_[2]; \
                const float o0 = sum8((p0[0] + p0[1]) + (p0[2] + p0[3])), o1 = sum8((p1[0] + p1[1]) + (p1[2] + p1[3])); \
                if (kg == 0) *(LAS f32x2_t*)(OB + (s_) * 64 + 2 * vp) = (f32x2_t){o0 * 0.17677669529663687f, o1 * 0.17677669529663687f}; } while (0)
            {   f32x4_t RA[3], RB[3]; f32x2_t VA, VB;
                PG_LD(RA, VA, 0); __builtin_amdgcn_sched_barrier(0);
#pragma nounroll
                for (int s = 0; s < SC_CH; s += 2) {
                    PG_LD(RB, VB, s + 1); __builtin_amdgcn_sched_barrier(0);
                    PG_STEP(RA, VA, s); __builtin_amdgcn_sched_barrier(0);
                    { const int sn = s + 2 < SC_CH ? s + 2 : SC_CH - 1; PG_LD(RA, VA, sn); } __builtin_amdgcn_sched_barrier(0);
                    PG_STEP(RB, VB, s + 1); __builtin_amdgcn_sched_barrier(0); } }
#undef PG_LD
#undef PG_STEP
            __syncthreads();
            {   const int s = t >> 3, v0 = 8 * (t & 7); const long long tt = tb + (long long)c * SC_CH + s; float o[8];
#pragma unroll
                for (int i = 0; i < 2; ++i) { const f32x4_t to = *(const LAS f32x4_t*)(OB + s * 64 + v0 + 4 * i);
#pragma unroll
                    for (int j = 0; j < 4; ++j) o[4 * i + j] = to[j]; }
                float ms = 0.f;
#pragma unroll
                for (int j = 0; j < 8; ++j) ms += o[j] * o[j];
                const float rs = rsqrtf(sum8(ms) * (1.0f / 64.0f) + 1e-6f);
                bf16_t* d = O + tt * 1024 + 768 + h * 64 + v0; float g[8], res[8]; cvt8(gpre, g);
#pragma unroll
                for (int j = 0; j < 8; ++j) res[j] = o[j] * rs * ngw[j] * g[j];
                st8(d, res); }
            if (c + 1 < nch) PG_SSTORE((c + 1) & 1);
            __syncthreads();
        }
#undef PG_GLOAD
#undef PG_SSTORE
    }
}
__device__ __forceinline__ void ph_scan_selwin(const Params& p, int l, int wv, LAS unsigned char* lds) {
    const int nchain = (int)(p.B * 4), nsel = (int)(p.B * 2) * (int)(p.S >> 6);
    unsigned* ctr = WSP(unsigned, p.oMOEC) + 64 + 2 * l; volatile LAS unsigned* slot = (volatile LAS unsigned*)(lds + DEAL_SLOT_OFF);
    const int tid = wv * 64 + mk_lane();
    for (;;) { const int u = next_unit(ctr, slot, tid); if (u >= nchain + nsel) break;
#ifdef PROBE_DEAL
#define PD_SPIN(bit, ...) do { const unsigned long long s0_ = wall_clock64(); __VA_ARGS__; if ((PROBE_DEAL >> (bit)) & 1) { __syncthreads(); const unsigned long long s1_ = wall_clock64(); while (wall_clock64() < s1_ + (s1_ - s0_)) __builtin_amdgcn_s_sleep(8); } } while (0)
#else
#define PD_SPIN(bit, ...) do { __VA_ARGS__; } while (0)
#endif
        if (u < nchain) PD_SPIN(2, pair_chain(p, l, u, wv, lds));
        else { const int v = u - nchain, nbg = (int)(p.B * 2), cur = (int)(p.S >> 6) - 1 - v / nbg, bg = v % nbg;
            PD_SPIN(0, cmp_unit(p, cur, bg, wv, lds));
            __syncthreads();
            PD_SPIN(1, selwin_unit(p, cur, bg, wv, lds)); } }
}
#endif
#ifdef CPU_EMU
struct Ctx { long long gtid, gsz, gw, nw; int lane, G, c; };
#define GEMM(A, lda, Bt, ldb, K, S, E) gemm_cpu(A, lda, Bt, ldb, K, S, E)
#define GEMMK(A, lda, Bt, ldb, K, S, E, ks) gemm_cpu(A, lda, Bt, ldb, K, S, E, ks)
#define GEMMG(A, lda, Bt, ldb, K, S, E, gi) gemm_cpu(A, lda, Bt, ldb, K, S, E, 64, gi)
#define GRID_BARRIER() do { } while (0)
#else
struct Ctx { LAS unsigned char* lds; int wv; };
#define GEMM(A, lda, Bt, ldb, K, S, E) gemm_phase(cx.wv, cx.lds, A, lda, Bt, ldb, K, S, E)
#define GEMMK(A, lda, Bt, ldb, K, S, E, ks) gemm_phase(cx.wv, cx.lds, A, lda, Bt, ldb, K, S, E, ks)
#define GEMMG(A, lda, Bt, ldb, K, S, E, gi) gemm_phase<decltype(E), decltype(S), true>(cx.wv, cx.lds, A, lda, Bt, ldb, K, S, E, 64, gi)
#define GRID_BARRIER() do { XcdBarrier b_; b_.bar = (unsigned*)(p.ws + p.oBAR); b_.x = xb_xcc_id(); b_.st = (volatile LAS unsigned*)(cx.lds + XBW_OFF); b_.wv = cx.wv; xcd_barrier(b_); } while (0)
#endif
constexpr int N_PHASES = 52;
#if !defined(CPU_EMU) && defined(PROBE_SUB)
#define SUBP(bit, ...) do { const unsigned long long s0_ = wall_clock64(); __VA_ARGS__; if ((PROBE_SUB >> (bit)) & 1) { const unsigned long long s1_ = wall_clock64(); while (wall_clock64() < s1_ + (s1_ - s0_)) __builtin_amdgcn_s_sleep(8); } } while (0)
#else
#define SUBP(bit, ...) do { __VA_ARGS__; } while (0)
#endif
#ifndef PROBE_CONV
#define PROBE_CONV 1
#endif
#ifndef PROBE_PREP
#define PROBE_PREP 1
#endif
#ifndef PROBE_GEMM
#define PROBE_GEMM 1
#endif
#ifndef PROBE_CMP
#define PROBE_CMP 1
#endif
#ifndef PROBE_CA
#define PROBE_CA 1
#endif
#ifndef PROBE_MOE
#define PROBE_MOE 1
#endif
#ifndef PROBE_RMS
#define PROBE_RMS 1
#endif
#ifndef PROBE_BAR
#define PROBE_BAR 0
#endif

template <int KIND> DEVI void run_program(const Params& p, const Ctx& cx, int pb, int pe) {
    int ph = 0;
#define T p.T
#define DFF p.DFF
#ifdef CPU_EMU
    const long long gsz = cx.gsz, nw = cx.nw; const int gG = cx.G, gC = cx.c;
#else
#define gsz ((long long)gridDim.x * 512)
#define nw ((long long)gridDim.x * 8)
#define gG ((int)gridDim.x)
#define gC ((int)blockIdx.x)
#endif
#define H WSP(bf16_t, p.oH)
#define HN ((bf16_t*)p.out)
#define P WSP(bf16_t, p.oP)
#define O WSP(bf16_t, p.oO)
#define BO WSP(bf16_t, p.oBO)
#define MG WSP(bf16_t, p.oMG)
#define CQ WSP(bf16_t, p.oCQ)
#define CAO WSP(bf16_t, p.oCAO)
#define MEMN WSP(bf16_t, p.oMEMN)
#define ACT WSP(bf16_t, p.oACT)
#define WFFN WSP(bf16_t, p.oWFFN)
#ifdef CPU_EMU
#define OPAQUE_V(x) do { } while (0)
#define PH_IDX long long gtid = cx.gtid, gw = cx.gw; int lane = cx.lane
#else
#define OPAQUE_V(x) asm volatile("" : "+v"(x))
#define PH_IDX unsigned tx_ = (unsigned)(cx.wv * 64 + mk_lane()); OPAQUE_V(tx_); long long gtid = (long long)blockIdx.x * 512 + tx_, gw = (long long)(tx_ >> 6) * gridDim.x + blockIdx.x; int lane = tx_ & 63
#endif
#if !defined(CPU_EMU) && defined(PROBE_MASK)
#define PH_T0(k) const int kind_ = (k); const unsigned long long t0_ = wall_clock64();
#else
#define PH_T0(k)
#endif
#define PH_BEGIN(k) if (ph >= pb && ph < pe) { if constexpr (KIND < 0 || KIND == (k)) { PH_T0(k) PH_IDX; OPAQUE_V(gtid); OPAQUE_V(gw); OPAQUE_V(lane); (void)gtid; (void)gw; (void)lane;
#if !defined(CPU_EMU) && defined(PROBE_MASK)
#define PH_END   if ((PROBE_MASK >> kind_) & 1) { const unsigned long long t1_ = wall_clock64(); while (wall_clock64() < t1_ + (t1_ - t0_)) __builtin_amdgcn_s_sleep(8); } } if (ph + 1 < pe) GRID_BARRIER(); } ++ph;
#else
#define PH_END   } if (ph + 1 < pe) GRID_BARRIER(); } ++ph;
#endif
    PH_BEGIN(0)
        { long long cvo_ = 0; ph_convert_layer(p, 0, gtid, gsz, cvo_); ph_convert_layer(p, 1, gtid, gsz, cvo_); ph_convert_ffn(p, gtid, gsz, cvo_); ph_convert_cmp(p, gtid, gsz); } ph_rope(p, gtid, gsz);
        ph_rmsnorm(p, p.in[I_MEM], p.B * 256, p.in[I_MEM_NORM], MEMN, 0, nullptr, gw, nw, lane);
        ph_rmsnorm(p, p.in[I_X], T, p.in[I_NORM_MIX], H, 0, nullptr, gw, nw, lane);
    PH_END
    ++ph;
    for (int l = 0; l < 2; ++l) {
#define W WSP(bf16_t, p.oWL[l])
        PH_BEGIN(1)
            if (l == 0) { SchedPlain S; S.init(p.B * 256, 1024, 1024, 1024, gG, gC); EpStore E{WSP(bf16_t, p.oKV), 1024, 1.0f, nullptr, nullptr, 0}; GEMM(MEMN, 1024, WSP(bf16_t, p.oWKV), 1024, 1024, S, E); }
            { SchedPlain S; S.init(T, 3072, 1024, 1024, gG, gC); EpStore E{P, 3072, 1.0f, l == 1 ? WSP(rs_t, p.oRSA) : nullptr, nullptr, 0}; GEMM(H, 1024, W + W_IN, 1024, 1024, S, E); } PH_END
        PH_BEGIN(2) if (l == 1) { rs_t* rs_ = WSP(rs_t, p.oRSB); for (long long i_ = gtid; i_ < T; i_ += gsz) rs_[i_] = 0ull; } SUBP(0, ph_rope_apply(p, gtid, gsz)); SUBP(1, { SchedCmp S; S.init(T / 16, gG, gC); EpUV E{WSP(bf16_t, p.oUV)}; GEMMK(P, 16LL * PW, WSP(bf16_t, p.oW1T) + (long long)l * 2 * 256 * 1024, 1024, 1024, S, E, (long long)PW); });
#ifdef CPU_EMU
            { static float pwl_[4 * 64 * 64]; pool_fill_w(p, l, pwl_, 0, 1); ph_pool(p, l, pwl_, gtid, gsz); } ph_gla_prep(p, l, gtid, gsz);
#else
            SUBP(2, pool_gpu(p, l, cx.wv, cx.lds, gC, gG)); SUBP(3, ph_gla_prep(p, l, gtid, gsz));
#endif
#ifdef CPU_EMU
            { static unsigned wl_[80 * 256]; static unsigned F_[32 * 80]; static float KN_[128]; rwkv_fill_wl(p, l, wl_, 0, 1);
              for (long long tile = 0; tile < T / 32; ++tile) { for (int q = 0; q < 512; ++q) rwkv_prep_step1(p, l, F_, KN_, tile, q); for (int q = 0; q < 512; ++q) rwkv_prep_step2(p, l, wl_, F_, KN_, tile, q); } }
#else
            SUBP(4, { LDSQ unsigned* wl_ = (LDSQ unsigned*)cx.lds; LDSQ unsigned* F_ = (LDSQ unsigned*)(cx.lds + 131072); LDSQ float* KN_ = (LDSQ float*)(F_ + 32 * 80); LDSQ float* PRM_ = KN_ + 128; LDSQ float* Z_ = (LDSQ float*)cx.lds;
                __syncthreads(); rwkv_fill_wl_gpu(p, l, wl_, (int)tx_); rwkv_fill_prm(p, l, PRM_, (int)tx_); __syncthreads(); RwFrags fr_; rwkv_load_frags(wl_, cx.wv, fr_);
                for (long long tile = gC; tile < T / 32; tile += gG) { __syncthreads(); rwkv_prep_step1_gpu(p, l, F_, KN_, tile, (int)tx_); __syncthreads(); rwkv_lowrank_mfma(l, fr_, F_, Z_, cx.wv); __syncthreads(); rwkv_prep_step2_gpu(p, l, PRM_, KN_, Z_, tile, (int)tx_); } });
#endif
#if PROBE_PREP == 2
            ph_pool(p, l, gtid, gsz);
#elif PROBE_PREP == 3
            ph_pool(p, l, gtid, gsz); ph_gla_prep(p, l, gtid, gsz);
#endif
 PH_END
#ifdef CPU_EMU
        PH_BEGIN(3) ph_compress2(p, l, gtid, gsz); PH_END
#else
        PH_BEGIN(3) compress2_gpu(p, l, cx.wv, cx.lds, gC, gG); PH_END
#endif
#ifdef CPU_EMU
        PH_BEGIN(4) ph_rwkv_scan(p, l, gw, nw, lane); ph_gla_scan(p, l, (gw + nw - (p.B * 4) % nw) % nw, nw, lane); ph_cmp_attn(p, gtid, gsz); PH_END
#else
        ++ph;
#endif
#ifdef CPU_EMU
        PH_BEGIN(5) ph_selwin(p, gtid, gsz); PH_END
#else
        PH_BEGIN(5) ph_scan_selwin(p, l, cx.wv, cx.lds); PH_END
#endif
        PH_BEGIN(6) { SchedBranch S; S.init(T, gG, gC); EpStore E{P, 4096, 1.0f, nullptr, BO, 3 * T / 4}; GEMM(O, 1024, W + W_B, 256, 256, S, E); } PH_END
        PH_BEGIN(7) { SchedPlain S; S.init(T, 4096, 1024, 1024, gG, gC); EpGate E{P, p.in[I_B_GATE] + l * 4096, MG, 0, l == 1 ? WSP(rs_t, p.oRSA) : nullptr, BO, 3 * T / 4}; GEMM(H, 1024, W + W_G, 1024, 1024, S, E); } PH_END
        ph += 6;
        PH_BEGIN(8) { SchedPlain S; S.init(T, 1024, 1024, 1024, gG, gC); EpResid E{l == 0 ? p.in[I_X] : nullptr, H, H, WSP(rs_t, l == 0 ? p.oRSA : p.oRSB)}; GEMM(MG, 1024, W + W_O, 1024, 1024, S, E); } PH_END
        ++ph;
        PH_BEGIN(1) { SchedPlain S; S.init(T, 256, 1024, 1024, gG, gC); EpStore E{CQ, 256, QSCALE, WSP(rs_t, l == 0 ? p.oRSA : p.oRSB), nullptr, 0}; GEMM(H, 1024, W + W_CQ, 1024, 1024, S, E); } PH_END
#ifdef CPU_EMU
        PH_BEGIN(10) if (l == 0) { rs_t* rs_ = WSP(rs_t, p.oRSA); for (long long i_ = gtid; i_ < T; i_ += gsz) rs_[i_] = 0ull; } ph_ca_attn(p, l, gtid, gsz); PH_END
#else
        PH_BEGIN(10) if (l == 0) { rs_t* rs_ = WSP(rs_t, p.oRSA); for (long long i_ = gtid; i_ < T; i_ += gsz) rs_[i_] = 0ull; } ph_ca_attn_mfma(p, l, cx.wv, cx.lds, gC, gG); PH_END
#endif
        PH_BEGIN(8) { SchedPlain S; S.init(T, 1024, 256, 256, gG, gC); EpResid E{nullptr, H, H, l == 0 ? WSP(rs_t, p.oRSB) : nullptr}; GEMM(CAO, 256, W + W_CO, 256, 256, S, E); } PH_END
        if (l == 1) { PH_BEGIN(9)
#ifdef CPU_EMU
            ph_rmsnorm(p, nullptr, T, p.in[I_NORM_FFN] + l * 1024, HN, 2, nullptr, gw, nw, lane, 0, H); moe_count_range(p, 0, T / 64, 0, 1);
#else
            for (long long r0_ = (long long)gC * 256; r0_ < T; r0_ += (long long)gG * 256) { const int wib_ = (int)(tx_ >> 6);
                (void)wib_; norm_router_256(p, l, r0_, cx.wv, cx.lds);
                asm volatile("s_waitcnt vmcnt(0)" ::: "memory"); __syncthreads(); __builtin_amdgcn_fence(__ATOMIC_ACQUIRE, "agent"); asm volatile("s_waitcnt vmcnt(0)" ::: "memory");
                moe_count_range(p, r0_ / 64, 4, (int)tx_, 512); }
#endif
            { int* R2T_ = WSP(int, p.oR2T); for (long long i_ = gtid; i_ < p.NR; i_ += gsz) R2T_[i_] = -1; }
            ph_convert_moe(p, gtid, gsz); PH_END }
        else ++ph;
        if (l == 0) {
            PH_BEGIN(11) { SchedPlain S; S.init(T, 2 * DFF, 1024, 1024, gG, gC); EpSwiglu E{ACT, DFF, 0, WSP(rs_t, p.oRSB)}; GEMM(H, 1024, WFFN, 1024, 1024, S, E); } PH_END
            PH_BEGIN(8) { SchedPlain S; S.init(T, 1024, DFF, DFF, gG, gC); EpResid E{nullptr, H, H, WSP(rs_t, p.oRSA)}; GEMM(ACT, DFF, WFFN + 2 * DFF * 1024, DFF, DFF, S, E); } PH_END
            ++ph;
        } else {
            PH_BEGIN(12) for (int rep_ = 0; rep_ < PROBE_MOE; ++rep_) ph_moe_offsets(p, gw, nw, lane); PH_END
            PH_BEGIN(12) for (int rep_ = 0; rep_ < PROBE_MOE; ++rep_) ph_moe_assign(p, gtid, gsz); PH_END
#define HS WSP(bf16_t, p.oHS)
#define ACTC WSP(bf16_t, p.oACTC)
#define MW WSP(bf16_t, p.oMOEW)
#define MC WSP(int, p.oMOEC)
            const int ct = (p.NR / 256) >= 512 ? 256 : (int)((p.NR / 256 + 2) / 3);
            for (int q = 0; q < 3; ++q) {
                PH_BEGIN(13) { SchedMoe S; const int nt_ = MC[16 + 8] / 256; S.t0 = q * ct; S.t1 = (q + 1) * ct < nt_ ? (q + 1) * ct : nt_; if (S.t1 < S.t0) S.t1 = S.t0; S.nN = (int)(2 * DFF / 256); S.G = gG; S.c = gC; S.lda = 1024; S.ldb = 1024; S.per_e = 3 * 1024 * DFF * 2;
                    S.base = MC + 16;
                    EpSwiglu E{ACTC, DFF, (long long)S.t0 * 256, nullptr}; GEMMG(HN, 1024, MW, 1024, 1024, S, E, WSP(int, p.oR2T)); } PH_END
                PH_BEGIN(14) { SchedMoe S; const int nt_ = MC[16 + 8] / 256; S.t0 = q * ct; S.t1 = (q + 1) * ct < nt_ ? (q + 1) * ct : nt_; if (S.t1 < S.t0) S.t1 = S.t0; S.nN = 4; S.G = gG; S.c = gC; S.lda = DFF; S.ldb = DFF; S.per_e = 3 * 1024 * DFF * 2;
                    S.base = MC + 16;
                    EpMoeDown E{WSP(bf16_t, p.oY), WSP(float, p.oROWW)}; GEMM(ACTC - (long long)S.t0 * 256 * DFF, DFF, MW + 2 * DFF * 1024, DFF, DFF, S, E); } PH_END }
            PH_BEGIN(15) ph_final(p, gw, nw, lane); PH_END
        }
    }
#undef PH_BEGIN
#undef PH_END
#undef H
#undef HN
#undef P
#undef O
#undef BO
#undef MG
#undef CQ
#undef CAO
#undef MEMN
#undef ACT
#undef WFFN
#undef T
#undef DFF
#undef W
#undef HS
#undef ACTC
#undef MW
#undef MC
#ifndef CPU_EMU
#undef gsz
#undef nw
#undef gG
#undef gC
#endif
}

#ifndef CPU_EMU
template <int KIND> __global__ __launch_bounds__(512, 2) void mk_fwd(Params p, int pb, int pe) {
    extern __shared__ __attribute__((aligned(16))) unsigned char shm[];
    Ctx cx; cx.lds = (LAS unsigned char*)shm;
    volatile LAS unsigned* xbw = (volatile LAS unsigned*)(cx.lds + XBW_OFF);
    if (threadIdx.x == 0) { xbw[0] = 0u; xbw[1] = 0u; xbw[2] = 0u; xbw[3] = 0u; }
    __syncthreads();
    cx.wv = __builtin_amdgcn_readfirstlane((int)(threadIdx.x >> 6));
    (void)xcd_barrier_post((unsigned*)(p.ws + p.oBAR), xbw, cx.wv);
    run_program<KIND>(p, cx, pb, pe);
}
#ifndef MK_ONE
#define MK_ONE 1
#endif
#if !MK_ONE
static const int kPhaseKind[N_PHASES] = { 0, 1,
    1, 2, 3, 4, 5, 6, 7, 6, 7, 6, 7, 6, 7, 8, 9, 1, 10, 8, 9, 11, 8, 9,
    1, 2, 3, 4, 5, 6, 7, 6, 7, 6, 7, 6, 7, 8, 9, 1, 10, 8, 9, 12, 12, 12, 12, 13, 14, 13, 14, 13, 14, 13, 14, 13, 14, 15 };
#endif
typedef void (*mk_fn)(Params, int, int);
extern "C" void kernel_launch(void* const* d_in, const int* in_sizes, int n_in, void* d_out, int out_size, void* d_ws, size_t ws_size, hipStream_t stream) {
    (void)in_sizes; (void)n_in; (void)out_size;
    Params p; memset(&p, 0, sizeof(p));
    for (int i = 0; i < N_INPUTS; ++i) p.in[i] = (const float*)d_in[i];
    p.out = (float*)d_out; p.ws = (unsigned char*)d_ws;
    make_layout(p, 32, 2048, 2816);
    for (int j = 0; j < 8; ++j) p.inv_freq[j] = (float)pow(500000.0, -(double)(2 * j) / 16.0);
    if ((size_t)p.wsNeed > ws_size) { fprintf(stderr, "workspace too small: need %lld have %zu\n", p.wsNeed, ws_size); return; }
    const size_t lds_bytes = LDS_TOTAL;
#if MK_ONE
    static const mk_fn fns[1] = { mk_fwd<-1> }; const int nf = 1;
#else
    static const mk_fn fns[16] = { mk_fwd<0>, mk_fwd<1>, mk_fwd<2>, mk_fwd<3>, mk_fwd<4>, mk_fwd<5>, mk_fwd<6>, mk_fwd<7>, mk_fwd<8>, mk_fwd<9>, mk_fwd<10>, mk_fwd<11>, mk_fwd<12>, mk_fwd<13>, mk_fwd<14>, mk_fwd<15> }; const int nf = 16;
#endif
    static int grid = 0;
    if (!grid) { int dev = 0, cus = 0; (void)hipGetDevice(&dev); (void)hipDeviceGetAttribute(&cus, hipDeviceAttributeMultiprocessorCount, dev);
        for (int k = 0; k < nf; ++k) (void)hipFuncSetAttribute((const void*)fns[k], hipFuncAttributeMaxDynamicSharedMemorySize, (int)lds_bytes);
        int per_cu = 0; (void)hipOccupancyMaxActiveBlocksPerMultiprocessor(&per_cu, (const void*)fns[0], 512, lds_bytes); (void)hipGetLastError();
        grid = cus > 0 ? cus : 256; }
    (void)hipMemsetAsync(p.ws + p.oBAR, 0, 16384 + 4096, stream);
    (void)hipMemsetAsync(p.ws + p.oRSA, 0, (size_t)p.T * 8, stream); (void)hipMemsetAsync(p.ws + p.oRSB, 0, (size_t)p.T * 8, stream);
#if MK_ONE
    hipLaunchKernelGGL(fns[0], dim3(grid), dim3(512), lds_bytes, stream, p, 0, N_PHASES);
#else
    for (int ph = 0; ph < N_PHASES; ++ph) hipLaunchKernelGGL(fns[kPhaseKind[ph]], dim3(grid), dim3(512), lds_bytes, stream, p, ph, ph + 1);
#endif
}
#endif
```

```cpp
#ifndef CPU_EMU
#include <hip/hip_runtime.h>
#include <cstdio>
#include <cstdint>
#include <cstring>
#define DEVI __device__ __forceinline__
#define DEVM __device__ __forceinline__
#else
#include <cmath>
#include <cstdio>
#include <cstdint>
#include <cstring>
#include <cstdlib>
#define DEVI static inline
#define DEVM inline
struct uint4 { unsigned x, y, z, w; }; struct uint2 { unsigned x, y; };
struct float4 { float x, y, z, w; };
#endif

typedef unsigned short bf16_t;
#ifdef CPU_EMU
static inline float u2f(unsigned u) { float f; memcpy(&f, &u, 4); return f; }
static inline unsigned f2u(float f) { unsigned u; memcpy(&u, &f, 4); return u; }
#else
DEVI float u2f(unsigned u) { return __uint_as_float(u); }
DEVI unsigned f2u(float f) { return __float_as_uint(f); }
#endif
DEVI float bf2f(bf16_t b) { return u2f(((unsigned)b) << 16); }
DEVI bf16_t f2bf(float f) { unsigned u = f2u(f); u += 0x7FFFu + ((u >> 16) & 1u); return (bf16_t)(u >> 16); }
#ifdef CPU_EMU
DEVI unsigned pk2bf(float lo, float hi) { return (unsigned)f2bf(lo) | ((unsigned)f2bf(hi) << 16); }
#else
DEVI unsigned pk2bf(float lo, float hi) { unsigned r; asm("v_cvt_pk_bf16_f32 %0, %1, %2" : "=v"(r) : "v"(lo), "v"(hi)); return r; }
#endif
#ifdef CPU_EMU
DEVI float sigmoidf_(float x) { return 1.0f / (1.0f + expf(-x)); }
DEVI float siluf_(float x) { return x / (1.0f + expf(-x)); }
#else
DEVI float sigmoidf_(float x) { return __builtin_amdgcn_rcpf(1.0f + __builtin_amdgcn_exp2f(-1.44269504f * x)); }
DEVI float siluf_(float x) { return x * __builtin_amdgcn_rcpf(1.0f + __builtin_amdgcn_exp2f(-1.44269504f * x)); }
#endif
#ifdef CPU_EMU
DEVI float expf_(float x) { return expf(x); }
DEVI float tanhf_(float x) { return tanhf(x); }
DEVI float softplusf_(float x) { return x > 20.f ? x : log1pf(expf(x)); }
#else
DEVI float expf_(float x) { return __builtin_amdgcn_exp2f(1.44269504f * x); }
DEVI float tanhf_(float x) { const float xc = fminf(fmaxf(x, -15.f), 15.f); return 1.0f - 2.0f * __builtin_amdgcn_rcpf(1.0f + __builtin_amdgcn_exp2f(2.88539008f * xc)); }
DEVI float softplusf_(float x) { return x > 20.f ? x : 0.69314718f * __builtin_amdgcn_logf(1.0f + __builtin_amdgcn_exp2f(1.44269504f * x)); }
#endif
DEVI float gelu_tanhf_(float x) { return 0.5f * x * (1.0f + tanhf_(0.7978845608028654f * (x + 0.044715f * x * x * x))); }

DEVI void st8(bf16_t* dst, const float* v) {
#ifndef CPU_EMU
    uint4 w; w.x = pk2bf(v[0], v[1]); w.y = pk2bf(v[2], v[3]); w.z = pk2bf(v[4], v[5]); w.w = pk2bf(v[6], v[7]);
    *(uint4*)dst = w;
#else
    for (int j = 0; j < 8; ++j) dst[j] = f2bf(v[j]);
#endif
}
DEVI void ld8(const bf16_t* src, float* v) {
#ifndef CPU_EMU
    const uint4 w = *(const uint4*)src; v[0] = u2f(w.x << 16); v[1] = u2f(w.x & 0xffff0000u); v[2] = u2f(w.y << 16); v[3] = u2f(w.y & 0xffff0000u); v[4] = u2f(w.z << 16); v[5] = u2f(w.z & 0xffff0000u); v[6] = u2f(w.w << 16); v[7] = u2f(w.w & 0xffff0000u);
#else
    for (int j = 0; j < 8; ++j) v[j] = bf2f(src[j]);
#endif
}
#ifdef CPU_EMU
#define QSCALE 0.125f
#define SCHED_FENCE() do { } while (0)
#define LDSQ
DEVI void ld8l(const bf16_t* src, float* v) { ld8(src, v); }
#else
#define QSCALE 0.18033688f
#define SCHED_FENCE() __builtin_amdgcn_sched_barrier(0)
#define LDSQ __attribute__((address_space(3)))
typedef unsigned u32x4l_t __attribute__((ext_vector_type(4)));
typedef float f32x4l_t __attribute__((ext_vector_type(4)));
DEVI void ld8l(const LDSQ bf16_t* src, float* v) { const u32x4l_t w = *(const LDSQ u32x4l_t*)src; v[0] = u2f(w[0] << 16); v[1] = u2f(w[0] & 0xffff0000u); v[2] = u2f(w[1] << 16); v[3] = u2f(w[1] & 0xffff0000u);
    v[4] = u2f(w[2] << 16); v[5] = u2f(w[2] & 0xffff0000u); v[6] = u2f(w[3] << 16); v[7] = u2f(w[3] & 0xffff0000u); }
#endif
#ifdef CPU_EMU
DEVI float dot2bf(unsigned a, unsigned b, float acc) { return acc + u2f(a << 16) * u2f(b << 16) + u2f(a & 0xffff0000u) * u2f(b & 0xffff0000u); }
#else
typedef __bf16 bf16x2_t __attribute__((ext_vector_type(2)));
DEVI float dot2bf(unsigned a, unsigned b, float acc) { return __builtin_amdgcn_fdot2_f32_bf16(__builtin_bit_cast(bf16x2_t, a), __builtin_bit_cast(bf16x2_t, b), acc, false); }
#endif
constexpr int DM = 1024;
constexpr int PW = 3072;
constexpr int INW = 2972;
constexpr int C_Q = 0, C_KC = 256, C_VC = 384, C_KS = 512, C_VS = 640, C_KW = 768, C_VW = 896, C_NG = 1024;
constexpr int C_POOL = 1040;
constexpr int C_RW = 1296;
constexpr int C_GLA = 2192;
constexpr int C_VRES = 2976;
constexpr int NCMPH = 128;

enum { I_X = 0, I_MEM, I_POS, I_NORM_MIX, I_W_IN, I_CMP_PE, I_CMP_W1, I_CMP_W2, I_POOL_W, I_POOL_SCALE, I_RW_MU, I_RW_W0, I_RW_W2, I_RW_A0, I_RW_A2, I_RW_G2,
       I_RW_V0, I_RW_V1, I_RW_V2, I_RW_KK, I_RW_KA, I_RW_RK, I_RW_LN, I_GLA_A2, I_GLA_AB, I_GLA_NORM, I_W_GATE, I_B_GATE, I_W_BRANCH, I_W_OUT, I_NORM_CA, I_MEM_NORM,
       I_CA_Q, I_CA_KV, I_CA_O, I_NORM_FFN, I_FFN_G, I_FFN_U, I_FFN_D, I_MOE_R, I_MOE_G, I_MOE_U, I_MOE_D, I_NORM_FINAL, N_INPUTS };

struct Params {
    const float* in[N_INPUTS];
    float* out;
    unsigned char* ws;
    long long B, S, T, DFF, NC, NR;
    float inv_freq[8];
    long long oBAR, oMOEC, oROPE, oKCMP, oVCMP, oUV, oW1T, oCB, oSELM, oKV, oTOKE, oTOKW, oTOKS, oR2T, oROWW, oCCNT, oCOFF;
    long long oWL[2], oWKV, oWFFN, oVF, oH, oP, oO, oBO, oMG, oRWW, oRWX, oGA, oCQ, oCAO, oMEMN, oACT, oY, oHS, oMOEW, oACTC, oRSA, oRSB, wsNeed;
};
constexpr long long W_IN = 0, W_G = W_IN + 3072LL * 1024, W_B = W_G + 4096LL * 1024, W_O = W_B + 4LL * 1024 * 256, W_CQ = W_O + 1024LL * 1024, W_CKV = W_CQ + 256LL * 1024,
                    W_CO = W_CKV + 512LL * 1024, W_LAYER = W_CO + 1024LL * 256;

static inline long long al256(long long x) { return (x + 255) & ~255LL; }
static inline void make_layout(Params& p, long long B, long long S, long long DFF) {
    p.B = B; p.S = S; p.T = B * S; p.DFF = DFF; p.NC = (S - 32) / 16 + 1; p.NR = 2 * p.T + 2048;
    const long long T = p.T;
    long long o = 0;
    auto take = [&](long long bytes) { long long r = o; o = al256(o + bytes); return r; };
    p.oBAR = take(16384); p.oMOEC = take(4096);
    p.oROPE = take(T * 16 * 4);
    p.oKCMP = take(B * 2 * 128 * 64 * 2); p.oVCMP = take(B * 2 * 128 * 64 * 2);        p.oUV = take((T / 16) * 4 * 256 * 2); p.oW1T = take(2LL * 2 * 256 * 1024 * 2); p.oCB = take(2 * 2 * 128 * 4);
    p.oSELM = take(T * 2 * 4);
    p.oKV = take(2 * B * 256 * 512 * 2);
    p.oTOKE = take(T * 2 * 4); p.oTOKW = take(T * 2 * 4); p.oTOKS = take(T * 2 * 4); p.oR2T = take(p.NR * 4); p.oROWW = take(p.NR * 4);
    p.oWL[0] = take(W_LAYER * 2); p.oWL[1] = take(W_LAYER * 2); p.oWKV = take(2LL * 512 * 1024 * 2); p.oWFFN = take(3 * 1024 * DFF * 2);
    p.oVF = take(T * 256 * 2);
    p.oH = take(T * 1024 * 2);
    p.oP = take(T * 3072 * 2);
    p.oO = take(T * 1024 * 2);
    p.oBO = take(T * 2048);
    p.oMG = take(T * 2048);
    long long end_main = o;
    p.oRWW = p.oBO;
    p.oRWX = p.oRWW + T * 1024;
    p.oGA = p.oRWX + T * 2560;
    p.oCQ = p.oP; p.oCAO = p.oP + T * 512;
    p.oRSA = p.oR2T; p.oRSB = p.oROWW;
    p.oCCNT = p.oKCMP; p.oCOFF = p.oVCMP;
    p.oMEMN = p.oBO;
    p.oACT = p.oP;
    long long q = p.oP;
    p.oMOEW = q; q = al256(q + 8LL * 3 * 1024 * DFF * 2);
    const long long ntmax = p.NR / 256, ct = ntmax >= 512 ? 256 : (ntmax + 2) / 3;
    p.oACTC = q; q = al256(q + ct * 256 * DFF * 2);
    p.oY = q; q = al256(q + p.NR * 2048);
    p.oHS = 0;
    p.wsNeed = q > end_main ? q : end_main;
}
#define WSP(T_, off) ((T_*)(p.ws + (off)))

DEVI void cvt_tile8(bf16_t* dst, long long K, const float* src0, long long ld, const float* gk = nullptr) {
    float v[8][8];
#pragma unroll
    for (int kk = 0; kk < 8; ++kk) { const float gg = gk ? gk[kk] : 1.0f;
#pragma unroll
        for (int nn = 0; nn < 8; ++nn) v[kk][nn] = src0[kk * ld + nn] * gg; }
#pragma unroll
    for (int nn = 0; nn < 8; ++nn) { float o[8];
#pragma unroll
        for (int kk = 0; kk < 8; ++kk) o[kk] = v[kk][nn];
        st8(dst + nn * K, o); }
}
DEVI void cvt_T(bf16_t* dst, const float* src, long long K, long long N, long long Npad, long long ld, long long gtid, long long gsz, const float* gain = nullptr) {
    (void)Npad; const long long tk = K >> 6, tiles = (N >> 6) * tk;
    for (long long i = gtid; i < tiles * 64; i += gsz) { const long long tile = i >> 6; const int li = (int)(i & 63), kl = li >> 3, nl = li & 7; const long long n0 = (tile / tk) * 64 + 8 * nl, k0 = (tile % tk) * 64 + 8 * kl;
        cvt_tile8(dst + n0 * K + k0, K, src + k0 * ld + n0, ld, gain ? gain + k0 : nullptr); }
}
DEVI void cvt_gate(bf16_t* dst, const float* wg, long long gtid, long long gsz, const float* gain = nullptr) {
    const long long tiles = (4096 >> 6) * 16;
    for (long long i = gtid; i < tiles * 64; i += gsz) { const long long tile = i >> 6; const int li = (int)(i & 63), kl = li >> 3, nl = li & 7; const long long n0 = (tile >> 4) * 64 + 8 * nl, k0 = (tile & 15) * 64 + 8 * kl;
        const long long q = n0 >> 8; const int w = (int)(n0 & 255), bj = w >> 7, c8 = w & 127; const float* sa = wg + (long long)(2 * bj) * 1024 * 1024 + k0 * 1024 + 64 * q + (c8 >> 1); const float* sb = sa + 1024 * 1024;
        float v[8][8];
#pragma unroll
        for (int kk = 0; kk < 8; ++kk) { const float gg = gain ? gain[k0 + kk] : 1.0f;
#pragma unroll
            for (int nn = 0; nn < 4; ++nn) { v[kk][nn] = sa[kk * 1024 + nn] * gg; v[kk][4 + nn] = sb[kk * 1024 + nn] * gg; } }
#pragma unroll
        for (int nn = 0; nn < 8; ++nn) { float o[8];
#pragma unroll
            for (int kk = 0; kk < 8; ++kk) o[kk] = v[kk][nn];
            st8(dst + (n0 + nn) * 1024 + k0, o); } }
}
DEVI void cvt_GU(bf16_t* dst, const float* wg, const float* wu, long long DFF, long long gtid, long long gsz, const float* gain = nullptr) {
    const long long tiles = (2 * DFF >> 6) * 16;
    for (long long i = gtid; i < tiles * 64; i += gsz) { const long long tile = i >> 6; const int li = (int)(i & 63), kl = li >> 3, nl = li & 7; const long long rr0 = (tile >> 4) * 64 + 8 * nl, k0 = (tile & 15) * 64 + 8 * kl;
        const long long t = rr0 >> 8, w = rr0 & 255; const float* src = (w < 128 ? wg : wu) + k0 * DFF + t * 128 + (w & 127);
        cvt_tile8(dst + rr0 * 1024 + k0, 1024, src, DFF, gain ? gain + k0 : nullptr); }
}
DEVI long long rot_gtid(long long gtid, long long gsz, long long& off, long long n) { long long r = gtid - off % gsz; if (r < 0) r += gsz; off += n; return r; }
DEVI void ph_convert_layer(const Params& p, int l, long long gtid, long long gsz, long long& off) {
    bf16_t* W = WSP(bf16_t, p.oWL[l]);
    for (long long i = rot_gtid(gtid, gsz, off, 48LL * 16 * 64); i < 48LL * 16 * 64; i += gsz) { const long long tile = i >> 6; const int li = (int)(i & 63), kl = li >> 3, nl = li & 7; const long long n0 = (tile >> 4) * 64 + 8 * nl, k0 = (tile & 15) * 64 + 8 * kl;
        const float* gk = l == 1 ? p.in[I_NORM_MIX] + 1024 + k0 : nullptr; const float* wsrc = p.in[I_W_IN] + ((long long)l * 1024 + k0) * INW;
        if (n0 + 8 <= 1036) cvt_tile8(W + W_IN + n0 * 1024 + k0, 1024, wsrc + n0, INW, gk);
        else if (n0 >= C_POOL && n0 + 8 <= C_VRES) cvt_tile8(W + W_IN + n0 * 1024 + k0, 1024, wsrc + n0 - 4, INW, gk);
        else {
#pragma unroll
            for (int nn = 0; nn < 8; ++nn) { const long long n = n0 + nn; float o[8];
#pragma unroll
                for (int kk = 0; kk < 8; ++kk) { const long long k = k0 + kk; float v = 0.f;
                    if (n < 1036) v = p.in[I_W_IN][((long long)l * 1024 + k) * INW + n];
                    else if (n >= C_POOL && n < C_VRES) v = p.in[I_W_IN][((long long)l * 1024 + k) * INW + n - 4];
                    else if (n >= C_VRES && n < C_VRES + 32 && l == 1) v = p.in[I_RW_V1][k * 32 + (n - C_VRES)];
                    o[kk] = l == 1 ? v * p.in[I_NORM_MIX][1024 + k] : v; }
                st8(W + W_IN + n * 1024 + k0, o); } } }
    cvt_gate(W + W_G, p.in[I_W_GATE] + (long long)l * 4 * 1024 * 1024, rot_gtid(gtid, gsz, off, 65536), gsz, l == 1 ? p.in[I_NORM_MIX] + 1024 : nullptr);
    for (int i = 0; i < 4; ++i) cvt_T(W + W_B + (long long)i * 1024 * 256, p.in[I_W_BRANCH] + ((long long)l * 4 + i) * 256 * 1024, 256, 1024, 1024, 1024, rot_gtid(gtid, gsz, off, 4096), gsz);
    cvt_T(W + W_O, p.in[I_W_OUT] + (long long)l * 1024 * 1024, 1024, 1024, 1024, 1024, rot_gtid(gtid, gsz, off, 16384), gsz);
    cvt_T(W + W_CQ, p.in[I_CA_Q] + (long long)l * 1024 * 256, 1024, 256, 256, 256, rot_gtid(gtid, gsz, off, 4096), gsz, p.in[I_NORM_CA] + l * 1024);
    cvt_T(WSP(bf16_t, p.oWKV) + (long long)l * 512 * 1024, p.in[I_CA_KV] + (long long)l * 1024 * 512, 1024, 512, 512, 512, rot_gtid(gtid, gsz, off, 8192), gsz);
    cvt_T(W + W_CO, p.in[I_CA_O] + (long long)l * 256 * 1024, 256, 1024, 1024, 1024, rot_gtid(gtid, gsz, off, 4096), gsz);
}
DEVI void ph_convert_ffn(const Params& p, long long gtid, long long gsz, long long& off) {
    bf16_t* W = WSP(bf16_t, p.oWFFN);
    cvt_GU(W, p.in[I_FFN_G], p.in[I_FFN_U], p.DFF, rot_gtid(gtid, gsz, off, (2 * p.DFF >> 6) * 16 * 64), gsz, p.in[I_NORM_FFN]);
    cvt_T(W + 2 * p.DFF * 1024, p.in[I_FFN_D], p.DFF, 1024, 1024, 1024, rot_gtid(gtid, gsz, off, (p.DFF >> 6) * 16 * 64), gsz);
}
DEVI void ph_convert_moe(const Params& p, long long gtid, long long gsz) {
    const long long DFF = p.DFF, per = 3 * 1024 * DFF;
    long long off = 0;
    for (int e = 0; e < 8; ++e) { bf16_t* W = WSP(bf16_t, p.oMOEW) + e * per;
        cvt_GU(W, p.in[I_MOE_G] + (long long)e * 1024 * DFF, p.in[I_MOE_U] + (long long)e * 1024 * DFF, DFF, rot_gtid(gtid, gsz, off, (2 * DFF >> 6) * 16 * 64), gsz);
        cvt_T(W + 2 * DFF * 1024, p.in[I_MOE_D] + (long long)e * DFF * 1024, DFF, 1024, 1024, 1024, rot_gtid(gtid, gsz, off, (DFF >> 6) * 16 * 64), gsz); }
}
DEVI void ph_rope(const Params& p, long long gtid, long long gsz) {
    const int* pos = (const int*)p.in[I_POS]; float* R = WSP(float, p.oROPE);
    for (long long i = gtid; i < p.T * 8; i += gsz) { const long long t = i >> 3; const int j = (int)(i & 7);
        const float ang = (float)pos[t] * p.inv_freq[j];
        double a = (double)ang; a -= 6.283185307179586476925 * floor(a * 0.15915494309189533577 + 0.5);
        const float ar = (float)a; R[t * 16 + j] = cosf(ar); R[t * 16 + 8 + j] = sinf(ar); }
}
DEVI void ph_rope_apply(const Params& p, long long gtid, long long gsz) {
    bf16_t* P = WSP(bf16_t, p.oP); const float* R = WSP(float, p.oROPE);
    for (long long i = gtid; i < p.T * 8; i += gsz) { const long long t = i >> 3; const int w = (int)(i & 7);
        const int col = w < 4 ? C_Q + w * 64 : (w < 6 ? C_KS + (w - 4) * 64 : C_KW + (w - 6) * 64);
        bf16_t* x = P + t * PW + col; const float* r = R + t * 16; const float sc = w < 4 ? QSCALE : 1.0f;
        float a[8], b[8], c[8], s[8], o1[8], o2[8]; ld8(x, a); ld8(x + 8, b);
#pragma unroll
        for (int j = 0; j < 8; ++j) { c[j] = r[j]; s[j] = r[8 + j]; }
#pragma unroll
        for (int j = 0; j < 8; ++j) { o1[j] = (a[j] * c[j] - b[j] * s[j]) * sc; o2[j] = (b[j] * c[j] + a[j] * s[j]) * sc; }
        st8(x, o1); st8(x + 8, o2);
        if (w < 4) {
#pragma unroll
            for (int q8 = 2; q8 < 8; ++q8) { float f[8]; ld8(x + 8 * q8, f);
#pragma unroll
                for (int j = 0; j < 8; ++j) f[j] *= QSCALE;
                st8(x + 8 * q8, f); } } }
}
DEVI void ph_compress2(const Params& p, int l, long long gtid, long long gsz) {
    const bf16_t* UV = WSP(bf16_t, p.oUV); const float* CB = WSP(float, p.oCB) + l * 256; const float* w2 = p.in[I_CMP_W2] + (long long)l * 2 * 128 * 64; const float* R = WSP(float, p.oROPE);
    bf16_t* KC = WSP(bf16_t, p.oKCMP); bf16_t* VC = WSP(bf16_t, p.oVCMP);
    const long long n_items = p.B * p.NC * 2 * 2 * 8, hb = p.S / 16;
    for (long long i = gtid; i < p.B * 2 * (128 - p.NC) * 64; i += gsz) { const long long bgi = i / ((128 - p.NC) * 64), rem = i % ((128 - p.NC) * 64); KC[(bgi * 128 + p.NC) * 64 + rem] = 0; VC[(bgi * 128 + p.NC) * 64 + rem] = 0; }
    for (long long i = gtid; i < n_items; i += gsz) { const int d8 = (int)(i & 7), j = (int)((i >> 3) & 1), g = (int)((i >> 4) & 1); const long long bn = i >> 5, n = bn % p.NC, b = bn / p.NC;
        const bf16_t* u = UV + ((b * hb + n) * 4 + (2 * j + g)) * 256; const bf16_t* vv = u + 4 * 256 + 128; const float* w = w2 + (long long)j * 128 * 64; const float* cb = CB + j * 128;
        float a[8];
#pragma unroll
        for (int m = 0; m < 8; ++m) a[m] = 0.f;
        for (int f = 0; f < 128; ++f) { const float hv = gelu_tanhf_(bf2f(u[f]) + bf2f(vv[f]) + cb[f]);
#pragma unroll
            for (int m = 0; m < 8; ++m) a[m] += hv * w[f * 64 + d8 + 8 * m]; }
        if (j == 0) { const float* r = R + (b * p.S + n * 16 + 31) * 16; const float x0 = a[0], x1 = a[1], cs = r[d8], sn = r[8 + d8]; a[0] = x0 * cs - x1 * sn; a[1] = x1 * cs + x0 * sn; }
        bf16_t* dst = (j == 0 ? KC : VC) + (((b * 2 + g) * 128) + n) * 64;
#pragma unroll
        for (int m = 0; m < 8; ++m) dst[d8 + 8 * m] = f2bf(a[m]); }
}
#ifndef CPU_EMU
DEVI float wave_sum(float v);
#endif
DEVI void ph_convert_cmp(const Params& p, long long gtid, long long gsz) {
    bf16_t* W1T = WSP(bf16_t, p.oW1T); float* CB = WSP(float, p.oCB);
    for (long long i = gtid; i < 2LL * 2 * 256 * 1024; i += gsz) { const int k = (int)(i & 1023), n = (int)((i >> 10) & 255); const long long lj = i >> 18; const int half = n >> 7, f = n & 127, tap = k >> 6, d = k & 63;
        W1T[i] = f2bf(p.in[I_CMP_W1][((lj * 32 + half * 16 + tap) * 64 + d) * 128 + f]); }
#ifdef CPU_EMU
    for (long long i = gtid; i < 2 * 2 * 128; i += gsz) { const int f = (int)(i & 127); const long long lj = i >> 7; float a = 0.f;
        for (int k = 0; k < 2048; ++k) a += p.in[I_CMP_PE][lj * 2048 + k] * p.in[I_CMP_W1][(lj * 2048 + k) * 128 + f];
        CB[i] = a; }
#else
    {   const long long gw_ = gtid >> 6, nw_ = gsz >> 6; const int ln = (int)(gtid & 63);
        for (long long i = gw_; i < 2 * 2 * 128; i += nw_) { const int f = (int)(i & 127); const long long lj = i >> 7; float a = 0.f;
#pragma unroll 8
            for (int k = ln; k < 2048; k += 64) a += p.in[I_CMP_PE][lj * 2048 + k] * p.in[I_CMP_W1][(lj * 2048 + k) * 128 + f];
            a = wave_sum(a); if (ln == 0) CB[i] = a; } }
#endif
}
DEVI void pool_fill_w(const Params& p, int l, LDSQ float* wl, int tid, int nthr) { const float* pw = p.in[I_POOL_W] + (long long)l * 4 * 64 * 64; for (int i = tid; i < 4 * 64 * 64; i += nthr) wl[i] = pw[i]; }
template <int WIN> DEVI void pool_item(const Params& p, int l, const LDSQ float* wl, int g, long long t, int hf) {
    const bf16_t* P = WSP(bf16_t, p.oP); bf16_t* O = WSP(bf16_t, p.oO);
    const LDSQ float* w = wl + g * 64 * 64 + hf * 32; const float* ps = p.in[I_POOL_SCALE] + (long long)l * 256 + g * 64 + hf * 32;
    const long long s = t % p.S; const int cnt = (int)(s + 1 < WIN ? s + 1 : WIN); const float inv = 1.0f / (float)cnt;
    float a[32];
#pragma unroll
    for (int d = 0; d < 32; ++d) a[d] = 0.f;
#pragma nounroll
    for (int c8 = 0; c8 < 8; ++c8) { float dv[8], f0[8];
        ld8(P + t * PW + C_POOL + g * 64 + 8 * c8, f0);
#pragma unroll
        for (int j = 0; j < 8; ++j) dv[j] = f0[j];
#pragma unroll
        for (int k = 1; k < WIN; ++k) { float f[8];
            if (k < cnt) ld8(P + (t - k) * PW + C_POOL + g * 64 + 8 * c8, f); else {
#pragma unroll
                for (int j = 0; j < 8; ++j) f[j] = 0.f; }
#pragma unroll
            for (int j = 0; j < 8; ++j) dv[j] += f[j]; }
#pragma unroll
        for (int j = 0; j < 8; ++j) { const float x = dv[j] * inv - f0[j]; const LDSQ float* wr = w + (8 * c8 + j) * 64;
#pragma unroll
            for (int d = 0; d < 32; ++d) a[d] += x * wr[d];
            if (j & 1) SCHED_FENCE(); } }
#pragma unroll
    for (int d8 = 0; d8 < 4; ++d8) { float o[8];
#pragma unroll
        for (int j = 0; j < 8; ++j) o[j] = a[8 * d8 + j] * ps[8 * d8 + j];
        st8(O + t * 1024 + 256 + g * 64 + hf * 32 + 8 * d8, o); }
}
DEVI void ph_pool(const Params& p, int l, const LDSQ float* wl, long long gtid, long long gsz) {
    for (long long i = gtid; i < p.T * 8; i += gsz) { const int g = (int)(i / (p.T * 2)); const long long rem = i % (p.T * 2), t = rem >> 1; const int hf = (int)(rem & 1);
        if (g == 0) pool_item<2>(p, l, wl, 0, t, hf); else if (g == 1) pool_item<4>(p, l, wl, 1, t, hf); else if (g == 2) pool_item<8>(p, l, wl, 2, t, hf); else pool_item<16>(p, l, wl, 3, t, hf); }
}
DEVI void st16bf(bf16_t* dst, const float (&v)[16]) { st8(dst, v); st8(dst + 8, v + 8); }
DEVI float pick8v(float a0, float a1, float a2, float a3, float a4, float a5, float a6, float a7, int i) {
    float r = a0; r = (i == 1) ? a1 : r; r = (i == 2) ? a2 : r; r = (i == 3) ? a3 : r; r = (i == 4) ? a4 : r; r = (i == 5) ? a5 : r; r = (i == 6) ? a6 : r; r = (i == 7) ? a7 : r; return r; }
#define pick8(a, i) pick8v((a)[0], (a)[1], (a)[2], (a)[3], (a)[4], (a)[5], (a)[6], (a)[7], (i))
DEVI void lerp8(const bf16_t* x, const bf16_t* xp, const float* mu, bool first, float* out) {
    float a[8], b[8]; ld8(x, a);
    if (first) {
#pragma unroll
        for (int j = 0; j < 8; ++j) b[j] = 0.f; } else ld8(xp, b);
#pragma unroll
    for (int j = 0; j < 8; ++j) out[j] = a[j] + (b[j] - a[j]) * mu[j];
}
DEVI float rwkv_wrow(const Params& p, int l, int r, int c) {
    if (r < 32) return p.in[I_RW_W2][l * 32 * 256 + r * 256 + c]; if (r < 64) return p.in[I_RW_A2][l * 32 * 256 + (r - 32) * 256 + c];
    if (r < 96) return (l == 1) ? p.in[I_RW_V2][(r - 64) * 256 + c] : 0.f; return p.in[I_RW_G2][l * 64 * 256 + (r - 96) * 256 + c]; }
DEVI void rwkv_fill_wl(const Params& p, int l, LDSQ unsigned* wl, int tid, int nthr) {
    for (int i = tid; i < 80 * 256; i += nthr) { const int jp = i >> 8, c = i & 255; wl[i] = (unsigned)f2bf(rwkv_wrow(p, l, 2 * jp, c)) | ((unsigned)f2bf(rwkv_wrow(p, l, 2 * jp + 1, c)) << 16); }
}
DEVI float rwkv_feat(const Params& p, int l, long long t, int j) {
    const bf16_t* P = WSP(bf16_t, p.oP); const float* mu = p.in[I_RW_MU] + l * 896; const bool first = (t % p.S) == 0; const bf16_t* x = P + t * PW + C_RW; const bf16_t* xp = x - PW;
    if (j >= 64 && j < 96) return (l == 1) ? bf2f(P[t * PW + C_VRES + (j - 64)]) : 0.f;
    const int c = j < 32 ? 768 + j : (j < 64 ? 800 + (j - 32) : 832 + (j - 96)); const float a = bf2f(x[c]), bb = first ? 0.f : bf2f(xp[c]); const float lv = a + (bb - a) * mu[c];
    return j < 32 ? tanhf_(lv) : (j < 64 ? lv : sigmoidf_(lv));
}
DEVI void rwkv_prep_step1(const Params& p, int l, LDSQ unsigned* FP, LDSQ float* KN, long long tile, int tid) {
    const bf16_t* P = WSP(bf16_t, p.oP); const float* mu = p.in[I_RW_MU] + l * 896; const float* kkw = p.in[I_RW_KK] + l * 256;
    for (int idx = tid; idx < 32 * 80; idx += 512) { const int tt = idx / 80, jp = idx % 80; const long long t = tile * 32 + tt;
        FP[idx] = pk2bf(rwkv_feat(p, l, t, 2 * jp), rwkv_feat(p, l, t, 2 * jp + 1)); }
    if (tid < 128) { const int tt = tid >> 2, h = tid & 3; const long long t = tile * 32 + tt; const bool first = (t % p.S) == 0; const bf16_t* x = P + t * PW + C_RW; const bf16_t* xp = x - PW; float nn = 0.f;
#pragma unroll 4
        for (int q8 = 0; q8 < 8; ++q8) { float kq[8]; lerp8(x + 256 + h * 64 + 8 * q8, xp + 256 + h * 64 + 8 * q8, mu + 256 + h * 64 + 8 * q8, first, kq);
#pragma unroll
            for (int j = 0; j < 8; ++j) { const float e = kq[j] * kkw[h * 64 + 8 * q8 + j]; nn += e * e; } }
        KN[tid] = 1.0f / fmaxf(sqrtf(nn), 1e-12f); }
}
#ifndef CPU_EMU
DEVI void rwkv_fill_wl_gpu(const Params& p, int l, LDSQ unsigned* wl, int tid) {
    asm volatile("" : "+v"(tid));
    const float* w2 = p.in[I_RW_W2] + l * 32 * 256; const float* a2 = p.in[I_RW_A2] + l * 32 * 256; const float* v2 = p.in[I_RW_V2]; const float* g2 = p.in[I_RW_G2] + l * 64 * 256; const int c = tid & 255, j0 = tid >> 8;
#pragma nounroll
    for (int k0 = 0; k0 < 40; k0 += 8) { float lo[8], hi[8];
#pragma unroll
        for (int k = 0; k < 8; ++k) { const int jp = 2 * (k0 + k) + j0, r = 2 * jp; const bool zero = (r >= 64 && r < 96 && l == 0);
            const float* src = r < 32 ? w2 + r * 256 : (r < 64 ? a2 + (r - 32) * 256 : (r < 96 ? (zero ? w2 : v2 + (r - 64) * 256) : g2 + (r - 96) * 256));
            const float x0 = src[c], x1 = src[256 + c]; lo[k] = zero ? 0.f : x0; hi[k] = zero ? 0.f : x1; }
#pragma unroll
        for (int k = 0; k < 8; ++k) wl[(2 * (k0 + k) + j0) * 256 + c] = pk2bf(lo[k], hi[k]); }
}
DEVI void rwkv_prep_step1_gpu(const Params& p, int l, LDSQ unsigned* FP, LDSQ float* KN, long long tile, int tid) {
    const bf16_t* P = WSP(bf16_t, p.oP); const float* mu = p.in[I_RW_MU] + l * 896; const float* kkw = p.in[I_RW_KK] + l * 256;
    asm volatile("" : "+v"(tid));
    const bool tile_first = ((tile * 32) % p.S) == 0;
    unsigned av[5], bv[5]; float m0[5], m1[5];
#pragma unroll
    for (int it = 0; it < 5; ++it) { const int idx = tid + 512 * it, tt = idx / 80, j = 2 * (idx % 80); const long long t = tile * 32 + tt; const bool first = tile_first && tt == 0, vres = (j >= 64 && j < 96);
        const int c = j < 32 ? 768 + j : (j < 64 ? 800 + (j - 32) : (j < 96 ? 768 : 832 + (j - 96)));
        const bf16_t* pa = vres ? P + t * PW + C_VRES + (j - 64) : P + t * PW + C_RW + c; const bf16_t* pb = (first || vres) ? pa : pa - PW;
        av[it] = *(const unsigned*)pa; bv[it] = *(const unsigned*)pb; m0[it] = mu[c]; m1[it] = mu[c + 1]; }
#pragma unroll
    for (int it = 0; it < 5; ++it) { const int idx = tid + 512 * it, tt = idx / 80, j = 2 * (idx % 80); const bool first = tile_first && tt == 0, vres = (j >= 64 && j < 96);
        const float a0 = u2f(av[it] << 16), a1 = u2f(av[it] & 0xffff0000u), b0 = first ? 0.f : u2f(bv[it] << 16), b1 = first ? 0.f : u2f(bv[it] & 0xffff0000u);
        const float l0 = a0 + (b0 - a0) * m0[it], l1 = a1 + (b1 - a1) * m1[it];
        float o0, o1;
        if (vres) { o0 = (l == 1) ? a0 : 0.f; o1 = (l == 1) ? a1 : 0.f; } else if (j < 32) { o0 = tanhf_(l0); o1 = tanhf_(l1); } else if (j < 64) { o0 = l0; o1 = l1; } else { o0 = sigmoidf_(l0); o1 = sigmoidf_(l1); }
        FP[idx] = pk2bf(o0, o1); }
    (void)KN; (void)kkw;
}
#endif
DEVI void ld4u(const LDSQ unsigned* src, unsigned* v) {
#ifdef CPU_EMU
    v[0] = src[0]; v[1] = src[1]; v[2] = src[2]; v[3] = src[3];
#else
    const u32x4l_t w = *(const LDSQ u32x4l_t*)src; v[0] = w[0]; v[1] = w[1]; v[2] = w[2]; v[3] = w[3];
#endif
}
DEVI void rwkv_prep_step2(const Params& p, int l, const LDSQ unsigned* wl, const LDSQ unsigned* FP, const LDSQ float* KN, long long tile, int tid, const LDSQ float* Z = nullptr) {
    const bf16_t* P = WSP(bf16_t, p.oP); float* RWW = WSP(float, p.oRWW); bf16_t* RWX = WSP(bf16_t, p.oRWX); bf16_t* O = WSP(bf16_t, p.oO); bf16_t* VF = WSP(bf16_t, p.oVF);
    const float* mu = p.in[I_RW_MU] + l * 896; const float* w0 = p.in[I_RW_W0] + l * 256; const float* a0 = p.in[I_RW_A0] + l * 256;
    const float* kkw = p.in[I_RW_KK] + l * 256; const float* kaw = p.in[I_RW_KA] + l * 256; const float* v0 = p.in[I_RW_V0];
    const int tt = tid >> 4, h = (tid >> 2) & 3, cc = tid & 3; const long long t = tile * 32 + tt; const bool first = (t % p.S) == 0;
    const bf16_t* x = P + t * PW + C_RW; const bf16_t* xp = x - PW; const int c0 = h * 64 + cc * 16; const LDSQ unsigned* f = FP + tt * 80;
    const float rn = KN[tt * 4 + h];
    float zw[16], za[16], zg[16], zv[16];
#pragma unroll
    for (int u = 0; u < 16; ++u) { zw[u] = w0[c0 + u]; za[u] = a0[c0 + u]; zg[u] = 0.f; zv[u] = (l == 1) ? v0[c0 + u] : 0.f; }
#ifndef CPU_EMU
    (void)wl; (void)f;
#pragma unroll
    for (int q4 = 0; q4 < 4; ++q4) { const f32x4l_t a_ = *(const LDSQ f32x4l_t*)(Z + (0 * 32 + tt) * 256 + c0 + 4 * q4), b_ = *(const LDSQ f32x4l_t*)(Z + (1 * 32 + tt) * 256 + c0 + 4 * q4), d_ = *(const LDSQ f32x4l_t*)(Z + (3 * 32 + tt) * 256 + c0 + 4 * q4);
#pragma unroll
        for (int u = 0; u < 4; ++u) { zw[4 * q4 + u] += a_[u]; za[4 * q4 + u] += b_[u]; zg[4 * q4 + u] += d_[u]; }
        if (l == 1) { const f32x4l_t c_ = *(const LDSQ f32x4l_t*)(Z + (2 * 32 + tt) * 256 + c0 + 4 * q4);
#pragma unroll
            for (int u = 0; u < 4; ++u) zv[4 * q4 + u] += c_[u]; } }
#else
#pragma unroll 2
    for (int jp = 0; jp < 16; ++jp) { const unsigned fw = f[jp], fa = f[16 + jp], fv = f[32 + jp]; unsigned ww[16], wa[16], wv[16];
#pragma unroll
        for (int q4 = 0; q4 < 4; ++q4) { ld4u(wl + jp * 256 + c0 + 4 * q4, ww + 4 * q4); ld4u(wl + (16 + jp) * 256 + c0 + 4 * q4, wa + 4 * q4); if (l == 1) ld4u(wl + (32 + jp) * 256 + c0 + 4 * q4, wv + 4 * q4); }
#pragma unroll
        for (int u = 0; u < 16; ++u) { zw[u] = dot2bf(fw, ww[u], zw[u]); za[u] = dot2bf(fa, wa[u], za[u]); if (l == 1) zv[u] = dot2bf(fv, wv[u], zv[u]); } }
#pragma unroll 4
    for (int jp = 0; jp < 32; ++jp) { const unsigned fg = f[48 + jp]; unsigned wg[16];
#pragma unroll
        for (int q4 = 0; q4 < 4; ++q4) ld4u(wl + (48 + jp) * 256 + c0 + 4 * q4, wg + 4 * q4);
#pragma unroll
        for (int u = 0; u < 16; ++u) zg[u] = dot2bf(fg, wg[u], zg[u]); }
#endif
    st16bf(O + t * 1024 + 512 + c0, zg);
#pragma unroll
    for (int hf = 0; hf < 2; ++hf) { const int cb = c0 + 8 * hf; float r8[8], k8[8], v8[8], vf8[8], kk8[8], b8[8], d8[8];
        lerp8(x + cb, xp + cb, mu + cb, first, r8); lerp8(x + 256 + cb, xp + 256 + cb, mu + 256 + cb, first, k8); lerp8(x + 512 + cb, xp + 512 + cb, mu + 512 + cb, first, v8);
        if (l == 1) ld8(VF + t * 256 + cb, vf8);
#pragma unroll
        for (int u = 0; u < 8; ++u) { const int c = cb + u, uu = 8 * hf + u;
            const float wlog = -softplusf_(-zw[uu]) - 0.5f, dec = expf_(-expf_(wlog)), a = sigmoidf_(za[uu]);
            const float k = k8[u]; float v = v8[u];
            if (l == 1) v = v + (vf8[u] - v) * sigmoidf_(zv[uu]);
            const float kk = k * kkw[c] * rn;
            d8[u] = dec; k8[u] = k * (1.0f + (a - 1.0f) * kaw[c]); v8[u] = v; kk8[u] = kk; b8[u] = kk * a; }
        float* ww = RWW + t * 256 + cb;
#pragma unroll
        for (int u = 0; u < 8; ++u) ww[u] = d8[u];
        bf16_t* rx = RWX + t * 1280 + cb;
        st8(rx, r8); st8(rx + 256, k8); st8(rx + 512, v8); st8(rx + 768, kk8); st8(rx + 1024, b8);
        if (l == 0) st8(VF + t * 256 + cb, v8);
        SCHED_FENCE(); }
}
#ifndef CPU_EMU
DEVI void dec8(const uint4& w, float* v) { v[0] = u2f(w.x << 16); v[1] = u2f(w.x & 0xffff0000u); v[2] = u2f(w.y << 16); v[3] = u2f(w.y & 0xffff0000u); v[4] = u2f(w.z << 16); v[5] = u2f(w.z & 0xffff0000u); v[6] = u2f(w.w << 16); v[7] = u2f(w.w & 0xffff0000u); }
DEVI void rwkv_fill_prm(const Params& p, int l, LDSQ float* PRM, int tid) {
    { const float* s_ = p.in[I_RW_MU] + l * 896; for (int i = tid; i < 768; i += 512) PRM[i] = s_[i]; }
    { const float* s_ = p.in[I_RW_W0] + l * 256; if (tid < 256) PRM[768 + tid] = s_[tid]; }
    { const float* s_ = p.in[I_RW_A0] + l * 256; if (tid < 256) PRM[1024 + tid] = s_[tid]; }
    { const float* s_ = p.in[I_RW_V0]; if (tid < 256) PRM[1280 + tid] = (l == 1) ? s_[tid] : 0.f; }
    { const float* s_ = p.in[I_RW_KK] + l * 256; if (tid < 256) PRM[1536 + tid] = s_[tid]; }
    { const float* s_ = p.in[I_RW_KA] + l * 256; if (tid < 256) PRM[1792 + tid] = s_[tid]; }
}
DEVI void rwkv_prep_step2_gpu(const Params& p, int l, const LDSQ float* PRM, const LDSQ float* KN, const LDSQ float* Z, long long tile, int tid) {
    asm volatile("" : "+v"(tid));
    const bf16_t* P = WSP(bf16_t, p.oP); float* RWW = WSP(float, p.oRWW); bf16_t* RWX = WSP(bf16_t, p.oRWX); bf16_t* O = WSP(bf16_t, p.oO); bf16_t* VF = WSP(bf16_t, p.oVF);
    const int tt = tid >> 4, h = (tid >> 2) & 3, cc = tid & 3; const long long t = tile * 32 + tt; const bool first = ((int)t % (int)p.S) == 0;
    const bf16_t* x = P + t * PW + C_RW; const bf16_t* xp = first ? x : x - PW; const int c0 = h * 64 + cc * 16;
    uint4 dx[2][3], dp[2][3], dv[2];
#pragma unroll
    for (int hf = 0; hf < 2; ++hf) { const int cb = c0 + 8 * hf;
#pragma unroll
        for (int s3 = 0; s3 < 3; ++s3) { dx[hf][s3] = *(const uint4*)(x + 256 * s3 + cb); dp[hf][s3] = *(const uint4*)(xp + 256 * s3 + cb); }
        dv[hf] = (l == 1) ? *(const uint4*)(VF + t * 256 + cb) : make_uint4(0u, 0u, 0u, 0u); }
    (void)KN;
    float zw[16], za[16], zg[16], zv[16];
#pragma unroll
    for (int q4 = 0; q4 < 4; ++q4) { const f32x4l_t a_ = *(const LDSQ f32x4l_t*)(Z + (0 * 32 + tt) * 256 + c0 + 4 * q4), b_ = *(const LDSQ f32x4l_t*)(Z + (1 * 32 + tt) * 256 + c0 + 4 * q4), d_ = *(const LDSQ f32x4l_t*)(Z + (3 * 32 + tt) * 256 + c0 + 4 * q4);
        const f32x4l_t w0_ = *(const LDSQ f32x4l_t*)(PRM + 768 + c0 + 4 * q4), a0_ = *(const LDSQ f32x4l_t*)(PRM + 1024 + c0 + 4 * q4);
#pragma unroll
        for (int u = 0; u < 4; ++u) { zw[4 * q4 + u] = w0_[u] + a_[u]; za[4 * q4 + u] = a0_[u] + b_[u]; zg[4 * q4 + u] = d_[u]; zv[4 * q4 + u] = 0.f; }
        if (l == 1) { const f32x4l_t c_ = *(const LDSQ f32x4l_t*)(Z + (2 * 32 + tt) * 256 + c0 + 4 * q4), v0_ = *(const LDSQ f32x4l_t*)(PRM + 1280 + c0 + 4 * q4);
#pragma unroll
            for (int u = 0; u < 4; ++u) zv[4 * q4 + u] = v0_[u] + c_[u]; } }
    st16bf(O + t * 1024 + 512 + c0, zg);
    float kh[2][8], rn;
    {   float nn = 0.f;
#pragma unroll
        for (int hf = 0; hf < 2; ++hf) { const int cb = c0 + 8 * hf; float xa[8], xb[8]; dec8(dx[hf][1], xa); dec8(dp[hf][1], xb);
            const f32x4l_t m0_ = *(const LDSQ f32x4l_t*)(PRM + 256 + cb), m1_ = *(const LDSQ f32x4l_t*)(PRM + 256 + cb + 4), k0_ = *(const LDSQ f32x4l_t*)(PRM + 1536 + cb), k1_ = *(const LDSQ f32x4l_t*)(PRM + 1536 + cb + 4);
            const float mm_[8] = {m0_[0], m0_[1], m0_[2], m0_[3], m1_[0], m1_[1], m1_[2], m1_[3]}, kw_[8] = {k0_[0], k0_[1], k0_[2], k0_[3], k1_[0], k1_[1], k1_[2], k1_[3]};
#pragma unroll
            for (int j = 0; j < 8; ++j) { const float bj = first ? 0.f : xb[j]; const float kv = xa[j] + (bj - xa[j]) * mm_[j]; kh[hf][j] = kv; const float e = kv * kw_[j]; nn += e * e; } }
        nn += __builtin_bit_cast(float, __builtin_amdgcn_update_dpp(0, __builtin_bit_cast(int, nn), 0xB1, 0xF, 0xF, true)); nn += __builtin_bit_cast(float, __builtin_amdgcn_update_dpp(0, __builtin_bit_cast(int, nn), 0x4E, 0xF, 0xF, true));
        rn = 1.0f / fmaxf(sqrtf(nn), 1e-12f); }
#pragma unroll
    for (int hf = 0; hf < 2; ++hf) { const int cb = c0 + 8 * hf; float r8[8], k8[8], v8[8], vf8[8], kk8[8], b8[8], d8[8], xa[8], xb[8];
#define RW_LERP(s3, out) do { dec8(dx[hf][s3], xa); dec8(dp[hf][s3], xb); \
            const f32x4l_t m0_ = *(const LDSQ f32x4l_t*)(PRM + 256 * (s3) + cb), m1_ = *(const LDSQ f32x4l_t*)(PRM + 256 * (s3) + cb + 4); \
            const float mm_[8] = {m0_[0], m0_[1], m0_[2], m0_[3], m1_[0], m1_[1], m1_[2], m1_[3]}; \
            _Pragma("unroll") for (int j = 0; j < 8; ++j) { const float bj = first ? 0.f : xb[j]; out[j] = xa[j] + (bj - xa[j]) * mm_[j]; } } while (0)
        RW_LERP(0, r8); RW_LERP(2, v8);
#pragma unroll
        for (int j = 0; j < 8; ++j) k8[j] = kh[hf][j];
#undef RW_LERP
        if (l == 1) dec8(dv[hf], vf8);
        const f32x4l_t kk0_ = *(const LDSQ f32x4l_t*)(PRM + 1536 + cb), kk1_ = *(const LDSQ f32x4l_t*)(PRM + 1536 + cb + 4), ka0_ = *(const LDSQ f32x4l_t*)(PRM + 1792 + cb), ka1_ = *(const LDSQ f32x4l_t*)(PRM + 1792 + cb + 4);
        const float kkv_[8] = {kk0_[0], kk0_[1], kk0_[2], kk0_[3], kk1_[0], kk1_[1], kk1_[2], kk1_[3]}, kav_[8] = {ka0_[0], ka0_[1], ka0_[2], ka0_[3], ka1_[0], ka1_[1], ka1_[2], ka1_[3]};
#pragma unroll
        for (int u = 0; u < 8; ++u) { const int uu = 8 * hf + u; const float kkwc = kkv_[u], kawc = kav_[u];
            const float wlog = -softplusf_(-zw[uu]) - 0.5f, dec = expf_(-expf_(wlog)), a = sigmoidf_(za[uu]);
            const float k = k8[u]; float v = v8[u];
            if (l == 1) v = v + (vf8[u] - v) * sigmoidf_(zv[uu]);
            const float kk = k * kkwc * rn;
            d8[u] = dec; k8[u] = k * (1.0f + (a - 1.0f) * kawc); v8[u] = v; kk8[u] = kk; b8[u] = kk * a; }
        float* ww = RWW + t * 256 + cb;
        *(float4*)ww = make_float4(d8[0], d8[1], d8[2], d8[3]); *(float4*)(ww + 4) = make_float4(d8[4], d8[5], d8[6], d8[7]);
        bf16_t* rx = RWX + t * 1280 + cb;
        st8(rx, r8); st8(rx + 256, k8); st8(rx + 512, v8); st8(rx + 768, kk8); st8(rx + 1024, b8);
        if (l == 0) st8(VF + t * 256 + cb, v8); }
}
#endif
DEVI float rwkv_row_step(float (&st)[64], const float* w, const bf16_t* r, const bf16_t* k, const bf16_t* kk, const bf16_t* b, float v) {
    float skk = 0.f;
#pragma unroll
    for (int c = 0; c < 64; ++c) skk += st[c] * bf2f(kk[c]);
    float y = 0.f;
#pragma unroll
    for (int c = 0; c < 64; ++c) { st[c] = st[c] * w[c] - skk * bf2f(b[c]) + v * bf2f(k[c]); y += st[c] * bf2f(r[c]); }
    return y;
}
DEVI void ph_gla_prep(const Params& p, int l, long long gtid, long long gsz) {
    const bf16_t* P = WSP(bf16_t, p.oP); float* GA = WSP(float, p.oGA); bf16_t* O = WSP(bf16_t, p.oO);
    const float* a2 = p.in[I_GLA_A2] + l * 16 * 128; const float* ab = p.in[I_GLA_AB] + l * 128;
    for (long long i = gtid; i < p.T * 16; i += gsz) { const long long t = i >> 4; const int c0 = (int)(i & 15) * 8; const bf16_t* ad = P + t * PW + C_GLA + 512;
        float adv[16], z[8]; ld8(ad, adv); ld8(ad + 8, adv + 8);
#pragma unroll
        for (int u = 0; u < 8; ++u) z[u] = ab[c0 + u];
#pragma unroll
        for (int j = 0; j < 16; ++j) {
#pragma unroll
            for (int u = 0; u < 8; ++u) z[u] += adv[j] * a2[j * 128 + c0 + u]; }
#pragma unroll
        for (int u = 0; u < 8; ++u) GA[t * 128 + c0 + u] = expf_(-softplusf_(-z[u]) * 0.0625f);
        const bf16_t* og = P + t * PW + C_GLA + 528 + 2 * c0; float g[16]; ld8(og, g); ld8(og + 8, g + 8);
#pragma unroll
        for (int u = 0; u < 16; ++u) g[u] = siluf_(g[u]);
        st8(O + t * 1024 + 768 + 2 * c0, g); st8(O + t * 1024 + 768 + 2 * c0 + 8, g + 8); }
}
DEVI float gla_col_step(float (&st)[32], const float* a, const bf16_t* q, const bf16_t* k, float v) {
    float o = 0.f;
#pragma unroll
    for (int c = 0; c < 32; ++c) { st[c] = st[c] * a[c] + bf2f(k[c]) * v; o += st[c] * bf2f(q[c]); }
    return o * 0.17677669529663687f;
}
DEVI void ph_cmp_attn(const Params& p, long long gtid, long long gsz) {
    const bf16_t* P = WSP(bf16_t, p.oP); const bf16_t* KCb = WSP(bf16_t, p.oKCMP); const bf16_t* VCb = WSP(bf16_t, p.oVCMP); unsigned* SELM = WSP(unsigned, p.oSELM); bf16_t* O = WSP(bf16_t, p.oO);
    static float KCf[128 * 64], VCf[128 * 64]; long long cached = -1;
    for (long long i = gtid; i < p.T * 2; i += gsz) { const long long t = i >> 1, b = t / p.S, s = t % p.S; const int g = (int)(i & 1);
        const int nv = s >= 31 ? (int)((s - 31) / 16 + 1) : 0;
        const int cur = (int)(s >> 6);
        if (cached != b * 2 + g) { cached = b * 2 + g; for (int e = 0; e < 128 * 64; ++e) { KCf[e] = bf2f(KCb[cached * 128 * 64 + e]); VCf[e] = bf2f(VCb[cached * 128 * 64 + e]); } }
        const float* kc = KCf; const float* vc = VCf;
        float q0[64], q1[64];
        { const bf16_t* q = P + t * PW + C_Q + (2 * g) * 64;
#pragma unroll
          for (int d = 0; d < 64; ++d) { q0[d] = bf2f(q[d]); q1[d] = bf2f(q[64 + d]); } }
        float m0 = -3e38f, m1 = -3e38f;
        for (int n = 0; n < nv; ++n) { const float* k = kc + n * 64; float s0 = 0.f, s1 = 0.f;
#pragma unroll
            for (int d = 0; d < 64; ++d) { s0 += q0[d] * k[d]; s1 += q1[d] * k[d]; }
            m0 = fmaxf(m0, s0); m1 = fmaxf(m1, s1); }
        float z0 = 0.f, z1 = 0.f;
        for (int n = 0; n < nv; ++n) { const float* k = kc + n * 64; float s0 = 0.f, s1 = 0.f;
#pragma unroll
            for (int d = 0; d < 64; ++d) { s0 += q0[d] * k[d]; s1 += q1[d] * k[d]; }
            z0 += expf(s0 - m0); z1 += expf(s1 - m1); }
        const float iz0 = nv ? 1.0f / z0 : 0.f, iz1 = nv ? 1.0f / z1 : 0.f;
        unsigned mask;
        if (cur < 8) mask = (2u << cur) - 1u;
        else {
            float tv0 = -3e38f, tv1 = -3e38f, tv2 = -3e38f, tv3 = -3e38f, tv4 = -3e38f; int ti0 = 0, ti1 = 0, ti2 = 0, ti3 = 0, ti4 = 0;
            float carry = 0.f;
            for (int j = 0; j <= cur - 2; ++j) { float imp = carry;
                for (int mm = 0; mm < 4; ++mm) { const int n = 4 * j + mm; float pn = 0.f;
                    if (n < nv) { const float* k = kc + n * 64; float s0 = 0.f, s1 = 0.f;
#pragma unroll
                        for (int d = 0; d < 64; ++d) { s0 += q0[d] * k[d]; s1 += q1[d] * k[d]; }
                        pn = expf(s0 - m0) * iz0 + expf(s1 - m1) * iz1; }
                    if (mm < 3) imp += pn; else { imp += 0.5f * pn; carry = 0.5f * pn; } }
                if (j >= 1) {
                    float v = imp; int id = j;
                    if (v > tv0) { float tf = tv0; tv0 = v; v = tf; int tt = ti0; ti0 = id; id = tt; }
                    if (v > tv1) { float tf = tv1; tv1 = v; v = tf; int tt = ti1; ti1 = id; id = tt; }
                    if (v > tv2) { float tf = tv2; tv2 = v; v = tf; int tt = ti2; ti2 = id; id = tt; }
                    if (v > tv3) { float tf = tv3; tv3 = v; v = tf; int tt = ti3; ti3 = id; id = tt; }
                    if (v > tv4) { tv4 = v; ti4 = id; } } }
            mask = 1u | (1u << cur) | (1u << (cur - 1)) | (1u << ti0) | (1u << ti1) | (1u << ti2) | (1u << ti3) | (1u << ti4);
        }
        SELM[i] = mask;
        for (int r = 0; r < 2; ++r) { const int hd = 2 * g + r; const float mr = r ? m1 : m0, izr = r ? iz1 : iz0;
            float o[64], qq[64];
            { const bf16_t* q = P + t * PW + C_Q + hd * 64;
#pragma unroll
              for (int d = 0; d < 64; ++d) { o[d] = 0.f; qq[d] = bf2f(q[d]); } }
            for (int n = 0; n < nv; ++n) { const float* k = kc + n * 64; const float* v = vc + n * 64; float sc = 0.f;
#pragma unroll
                for (int d = 0; d < 64; ++d) sc += qq[d] * k[d];
                const float pr = expf(sc - mr) * izr;
#pragma unroll
                for (int d = 0; d < 64; ++d) o[d] += pr * v[d]; }
            const float g0 = sigmoidf_(bf2f(P[t * PW + C_NG + hd * 3 + 0]));
#pragma unroll
            for (int d = 0; d < 64; ++d) O[t * 1024 + hd * 64 + d] = f2bf(g0 * o[d]); } }
}
DEVI void ph_selwin(const Params& p, long long gtid, long long gsz) {
    const bf16_t* P = WSP(bf16_t, p.oP); const unsigned* SELM = WSP(unsigned, p.oSELM); bf16_t* O = WSP(bf16_t, p.oO);
    for (long long i = gtid; i < p.T * 8; i += gsz) { const long long t = i >> 3, b = t / p.S, s = t % p.S; const int hd = (int)((i >> 1) & 3), g = hd >> 1, d0 = (int)(i & 1) * 32;
        unsigned qp[32]; float o[32];
        { const bf16_t* qq = P + t * PW + C_Q + hd * 64;
#pragma unroll
          for (int d = 0; d < 32; ++d) qp[d] = (unsigned)qq[2 * d] | ((unsigned)qq[2 * d + 1] << 16); }
        for (int pass = 0; pass < 2; ++pass) {
            const int ck = pass ? C_KW : C_KS, cv = pass ? C_VW : C_VS; const unsigned mask = SELM[t * 2 + g];
            float m = -3e38f, z = 0.f;
#pragma unroll
            for (int d = 0; d < 32; ++d) o[d] = 0.f;
            const long long lo = pass ? (s - 511 > 0 ? s - 511 : 0) : 0;
            for (long long kp = lo; kp <= s; ++kp) {
                if (!pass && !((mask >> (kp >> 6)) & 1u)) { kp |= 63; continue; }
                const bf16_t* k = P + (b * p.S + kp) * PW + ck + g * 64; const bf16_t* v = P + (b * p.S + kp) * PW + cv + g * 64 + d0; float sc = 0.f;
#pragma unroll
                for (int d = 0; d < 32; ++d) sc += u2f(qp[d] << 16) * bf2f(k[2 * d]) + u2f(qp[d] & 0xffff0000u) * bf2f(k[2 * d + 1]);
                if (sc > m) { const float f = expf(m - sc); z *= f;
#pragma unroll
                    for (int d = 0; d < 32; ++d) o[d] *= f;
                    m = sc; }
                const float pr = expf(sc - m); z += pr;
#pragma unroll
                for (int d = 0; d < 32; ++d) o[d] += pr * bf2f(v[d]); }
            const float gt = sigmoidf_(bf2f(P[t * PW + C_NG + hd * 3 + 1 + pass])) / z;
#pragma unroll
            for (int d = 0; d < 32; ++d) { bf16_t* od = O + t * 1024 + hd * 64 + d0 + d; *od = f2bf(bf2f(*od) + gt * o[d]); } } }
}
DEVI void ph_ca_attn(const Params& p, int l, long long gtid, long long gsz) {
    const bf16_t* CQ = WSP(bf16_t, p.oCQ); const bf16_t* KV = WSP(bf16_t, p.oKV) + (long long)l * 512; bf16_t* AO = WSP(bf16_t, p.oCAO);
    for (long long i = gtid; i < p.T * 4; i += gsz) { const long long t = i >> 2, b = t / p.S; const int hd = (int)(i & 3);
        float q[64], o[64];
#pragma unroll
        for (int d = 0; d < 64; ++d) { q[d] = bf2f(CQ[t * 256 + hd * 64 + d]); o[d] = 0.f; }
        float m = -3e38f, z = 0.f;
        for (int kp = 0; kp < 256; ++kp) { const bf16_t* k = KV + (b * 256 + kp) * 1024 + hd * 64; const bf16_t* v = k + 256; float sc = 0.f;
#pragma unroll
            for (int d = 0; d < 64; ++d) sc += q[d] * bf2f(k[d]);
            if (sc > m) { const float f = expf(m - sc); z *= f;
#pragma unroll
                for (int d = 0; d < 64; ++d) o[d] *= f;
                m = sc; }
            const float pr = expf(sc - m); z += pr;
#pragma unroll
            for (int d = 0; d < 64; ++d) o[d] += pr * bf2f(v[d]); }
        const float iz = 1.0f / z;
#pragma unroll
        for (int d = 0; d < 64; ++d) AO[t * 256 + hd * 64 + d] = f2bf(o[d] * iz); }
}
DEVI void moe_count_range(const Params& p, long long c0, long long nchunk, int tid, int nthr) {
    const int* TE = WSP(int, p.oTOKE); int* CC = WSP(int, p.oCCNT); int* CT = CC + (p.T / 64) * 64;
    for (long long c = c0 + tid; c < c0 + nchunk; c += nthr) { int tot[8] = {0, 0, 0, 0, 0, 0, 0, 0};
        for (int sub = 0; sub < 8; ++sub) { int cnt[8] = {0, 0, 0, 0, 0, 0, 0, 0};
#pragma unroll
            for (int j = 0; j < 16; ++j) { const int e = TE[c * 128 + sub * 16 + j];
#pragma unroll
                for (int q = 0; q < 8; ++q) cnt[q] += (e == q); }
#pragma unroll
            for (int q = 0; q < 8; ++q) { CC[(c * 8 + sub) * 8 + q] = cnt[q]; tot[q] += cnt[q]; } }
#pragma unroll
        for (int q = 0; q < 8; ++q) CT[c * 8 + q] = tot[q]; }
}
DEVI void ph_moe_count(const Params& p, long long gtid, long long gsz) {
    const int* TE = WSP(int, p.oTOKE); int* CC = WSP(int, p.oCCNT); int* CT = CC + (p.T / 64) * 64; int* R2T = WSP(int, p.oR2T);
    for (long long c = gtid; c < p.T / 64; c += gsz) { int tot[8] = {0, 0, 0, 0, 0, 0, 0, 0};
        for (int sub = 0; sub < 8; ++sub) { int cnt[8] = {0, 0, 0, 0, 0, 0, 0, 0};
#pragma unroll
            for (int j = 0; j < 16; ++j) { const int e = TE[c * 128 + sub * 16 + j];
#pragma unroll
                for (int q = 0; q < 8; ++q) cnt[q] += (e == q); }
#pragma unroll
            for (int q = 0; q < 8; ++q) { CC[(c * 8 + sub) * 8 + q] = cnt[q]; tot[q] += cnt[q]; } }
#pragma unroll
        for (int q = 0; q < 8; ++q) CT[c * 8 + q] = tot[q]; }
    for (long long i = gtid; i < p.NR; i += gsz) R2T[i] = -1;
}
DEVI void ph_moe_offsets(const Params& p, long long gw, long long nw, int lane) {
    const int* CC = WSP(int, p.oCCNT); const int* CT = CC + (p.T / 64) * 64; int* CO = WSP(int, p.oCOFF); int* MC = WSP(int, p.oMOEC);
    const long long n = p.T / 64;
    for (long long i = gw; i < n * 8; i += nw) { const long long c = i >> 3; const int e = (int)(i & 7); int off = 0;
#ifdef CPU_EMU
        (void)lane; for (long long k = 0; k < c; ++k) off += CT[k * 8 + e];
#else
        for (long long k = lane; k < c; k += 64) off += CT[k * 8 + e];
#pragma unroll
        for (int o = 32; o > 0; o >>= 1) off += __shfl_xor(off, o);
        if (lane == 0)
#endif
        {
#pragma unroll
            for (int sub = 0; sub < 8; ++sub) { CO[(c * 8 + sub) * 8 + e] = off; off += CC[(c * 8 + sub) * 8 + e]; }
            if (c == n - 1) MC[e] = off; } }
}
DEVI void moe_bases(const Params& p, int (&base)[9]) { const int* MC = WSP(int, p.oMOEC); int run = 0;
#pragma unroll
    for (int e = 0; e < 8; ++e) { base[e] = run; run += (MC[e] + 255) & ~255; } base[8] = run; }
DEVI void ph_moe_assign(const Params& p, long long gtid, long long gsz) {
    const int* TE = WSP(int, p.oTOKE); const float* TW = WSP(float, p.oTOKW); const int* CO = WSP(int, p.oCOFF); int* TS = WSP(int, p.oTOKS); int* R2T = WSP(int, p.oR2T); float* RW = WSP(float, p.oROWW);
    int base[9]; moe_bases(p, base);
    if (gtid == 0) { int* MC = WSP(int, p.oMOEC);
#pragma unroll
        for (int e = 0; e < 9; ++e) MC[16 + e] = base[e]; }
    for (long long i = gtid; i < (p.T / 64) * 8; i += gsz) { int run[8];
#pragma unroll
        for (int q = 0; q < 8; ++q) run[q] = base[q] + CO[i * 8 + q];
#pragma unroll
        for (int j = 0; j < 16; ++j) { const int e = TE[i * 16 + j]; int slot = 0;
#pragma unroll
            for (int q = 0; q < 8; ++q) if (e == q) { slot = run[q]; run[q] += 1; }
            TS[i * 16 + j] = slot; R2T[slot] = (int)(i * 8 + (j >> 1)); RW[slot] = TW[i * 16 + j]; } }
}
DEVI void ph_moe_gather(const Params& p, long long gtid, long long gsz) {
    const int* R2T = WSP(int, p.oR2T); const int* MC = WSP(int, p.oMOEC); const uint4* H = WSP(uint4, p.oH); uint4* HS = WSP(uint4, p.oHS);
    const long long rows = MC[16 + 8];
    for (long long i = gtid; i < rows * 128; i += gsz) { const long long r = i >> 7; const int j = (int)(i & 127); const int t = R2T[r];
        uint4 v; v.x = v.y = v.z = v.w = 0u; if (t >= 0) v = H[(long long)t * 128 + j]; HS[i] = v; }
}
struct Unit { int pm, pn, aux, pad; long long aoff, boff; };
constexpr int NXCD = 8, WGM = 8;
DEVI void tile_order(long long L, int nM, int nN, int& pm, int& pn) {
    const int nwg = nM * nN; int wgid = (int)L; { const int q = nwg / NXCD, r = nwg % NXCD, xcd = wgid % NXCD, off = wgid / NXCD; wgid = (xcd < r ? xcd * (q + 1) : r * (q + 1) + (xcd - r) * q) + off; }
    const int nig = WGM * nN, gid = wgid / nig, fm = gid * WGM, gsz = (nM - fm) < WGM ? (nM - fm) : WGM;
    pm = fm + ((wgid % nig) % gsz); pn = (wgid % nig) / gsz;
}
struct SchedPlain {
    int nM, nN, G, c; long long lda, ldb;
    DEVM void init(long long M, long long N, long long lda_, long long ldb_, int G_, int c_) { nM = (int)(M / 256); nN = (int)(N / 256); lda = lda_; ldb = ldb_; G = G_; c = c_; }
    DEVM bool next(int i, Unit& u) const { const long long L = (long long)i * G + c; if (L >= (long long)nM * nN) return false; tile_order(L, nM, nN, u.pm, u.pn); u.aux = 0; u.pad = 0;
        u.aoff = (long long)u.pm * 256 * lda * 2; u.boff = (long long)u.pn * 256 * ldb * 2; return true; }
    DEVM void a_ready(const Unit&) const {}
    DEVM void done(const Unit&) const {}
};
struct SchedBranch {
    int nM, G, c;
    DEVM void init(long long M, int G_, int c_) { nM = (int)(M / 256); G = G_; c = c_; }
    DEVM bool next(int i, Unit& u) const { const long long L = (long long)i * G + c; if (L >= (long long)nM * 16) return false; tile_order(L, nM, 16, u.pm, u.pn); u.aux = u.pn >> 2; u.pad = 0;
        u.aoff = (long long)u.pm * 256 * 1024 * 2 + (long long)u.aux * 256 * 2; u.boff = (long long)u.pn * 256 * 256 * 2; return true; }
    DEVM void a_ready(const Unit&) const {}
    DEVM void done(const Unit&) const {}
};
struct SchedGate {
    int nM, G, c;
    DEVM void init(long long M, int G_, int c_) { nM = (int)(M / 256); G = G_; c = c_; }
    DEVM bool next(int i, Unit& u) const { const long long tile = (long long)(i >> 2) * G + c; if (tile >= (long long)nM * 4) return false; tile_order(tile, nM, 4, u.pm, u.pn); u.aux = i & 3; u.pad = 0;
        u.aoff = (long long)u.pm * 256 * 1024 * 2; u.boff = (long long)(u.aux * 4 + u.pn) * 256 * 1024 * 2; return true; }
    DEVM void a_ready(const Unit&) const {}
    DEVM void done(const Unit&) const {}
};
struct SchedMoe {
    int t0, t1, nN, G, c; long long lda, ldb, per_e; const int* base;
    DEVM bool next(int i, Unit& u) const { const long long L = (long long)i * G + c; if (L >= (long long)(t1 - t0) * nN) return false; { int pr, pc; tile_order(L, t1 - t0, nN, pr, pc); u.pm = t0 + pr; u.pn = pc; } u.pad = 0;
        int e = 0;
#pragma unroll
        for (int q = 1; q < 8; ++q) e += (u.pm * 256 >= base[q]) ? 1 : 0;
#ifndef CPU_EMU
        e = __builtin_amdgcn_readfirstlane(e);
#endif
        u.aux = e; u.aoff = (long long)u.pm * 256 * lda * 2; u.boff = (long long)e * per_e + (long long)u.pn * 256 * ldb * 2; return true; }
    DEVM void a_ready(const Unit&) const {}
    DEVM void done(const Unit&) const {}
};
struct SchedCmp {
    int nM, G, c;
    DEVM void init(long long rows, int G_, int c_) { nM = (int)(rows / 256); G = G_; c = c_; }
    DEVM bool next(int i, Unit& u) const { const long long L = (long long)i * G + c; if (L >= (long long)nM * 4) return false; const int combo = (int)(L / nM); u.pm = (int)(L % nM); u.pn = 0; u.aux = combo; u.pad = 0;
        u.aoff = (long long)u.pm * 256 * 16 * PW * 2 + (long long)(((combo >> 1) ? C_VC : C_KC) + (combo & 1) * 64) * 2; u.boff = (long long)(combo >> 1) * 256 * 1024 * 2; return true; }
    DEVM void a_ready(const Unit&) const {}
    DEVM void done(const Unit&) const {}
};
#ifndef CPU_EMU
__device__ __forceinline__ int mk_lane_() { return (int)__builtin_amdgcn_mbcnt_hi(~0u, __builtin_amdgcn_mbcnt_lo(~0u, 0u)); }
#endif
struct PreNone {};
struct PreRow { float r; };
typedef unsigned long long rs_t;
#ifdef CPU_EMU
DEVI float rs_of(const rs_t* rss, long long row) { return rss ? 1.0f / sqrtf((float)((double)rss[row] * (1.0 / 16777216.0)) * (1.0f / 1024.0f) + 1e-6f) : 1.0f; }
#else
DEVI float rs_of(const rs_t* rss, long long row) { return rss ? __builtin_amdgcn_rsqf((float)((double)rss[row] * (1.0 / 16777216.0)) * (1.0f / 1024.0f) + 1e-6f) : 1.0f; }
#endif
struct EpStore {
    typedef PreRow Pre; static constexpr int ROWS = 2;
    bf16_t* O; long long ldo; float scale; const rs_t* rss; bf16_t* O2; long long split;
    DEVM void pre(const Unit&, long long row, int, Pre& pr) const { pr.r = rs_of(rss, row) * scale; }
    DEVM void apply(const Unit& u, long long row, int c8, const float* lo, const float* hi, const Pre& pr) const { float a[8], b[8];
#pragma unroll
        for (int j = 0; j < 8; ++j) { a[j] = lo[j] * pr.r; b[j] = hi[j] * pr.r; }
        bf16_t* d = ((O2 && row >= split) ? O2 + (row - split) * ldo : O + row * ldo) + u.pn * 256 + c8; st8(d, a); st8(d + 128, b); }
};
struct EpUV {
    typedef PreNone Pre; static constexpr int ROWS = 2;
    bf16_t* UV;
    DEVM void pre(const Unit&, long long, int, Pre&) const {}
    DEVM void apply(const Unit& u, long long row, int c8, const float* lo, const float* hi, const Pre&) const { bf16_t* d = UV + (row * 4 + u.aux) * 256 + c8; st8(d, lo); st8(d + 128, hi); }
};
struct PreGate { uint2 bo[4]; float r; };
DEVI void cvt8u(const uint4& w, float* v) { v[0] = u2f(w.x << 16); v[1] = u2f(w.x & 0xffff0000u); v[2] = u2f(w.y << 16); v[3] = u2f(w.y & 0xffff0000u); v[4] = u2f(w.z << 16); v[5] = u2f(w.z & 0xffff0000u); v[6] = u2f(w.w << 16); v[7] = u2f(w.w & 0xffff0000u); }
struct EpGate {
    typedef PreGate Pre; static constexpr int ROWS = 4;
    const bf16_t* BO; const float* bias; bf16_t* MG; long long row0; const rs_t* rss; const bf16_t* BO2; long long split;
    DEVM void pre(const Unit& u, long long row, int c8, Pre& pr) const { pr.r = rs_of(rss, row0 + row); const bf16_t* b = ((BO2 && row >= split) ? BO2 + (row - split) * 4096 : BO + row * 4096) + u.pn * 64 + (c8 >> 1);
#pragma unroll
        for (int i = 0; i < 4; ++i) pr.bo[i] = *(const uint2*)(b + i * 1024); }
    DEVM void apply(const Unit& u, long long row, int c8, const float* lo, const float* hi, const Pre& pr) const { const int c = u.pn * 64 + (c8 >> 1); float r[4] = {0.f, 0.f, 0.f, 0.f};
#pragma unroll
        for (int i = 0; i < 4; ++i) { const float* v = (i < 2 ? lo : hi) + 4 * (i & 1); const float* bi = bias + i * 1024 + c;
            const float bo[4] = {u2f(pr.bo[i].x << 16), u2f(pr.bo[i].x & 0xffff0000u), u2f(pr.bo[i].y << 16), u2f(pr.bo[i].y & 0xffff0000u)};
#pragma unroll
            for (int j = 0; j < 4; ++j) r[j] += sigmoidf_(v[j] * pr.r + bi[j]) * bo[j]; }
        uint2 w; w.x = pk2bf(r[0], r[1]); w.y = pk2bf(r[2], r[3]); *(uint2*)(MG + (row0 + row) * 1024 + c) = w; }
};
struct PreResid { float4 v[4]; };
struct EpResid {
    typedef PreResid Pre; static constexpr int ROWS = 2;
    const float* XS; const bf16_t* XB; bf16_t* HB; rs_t* RS;
    DEVM void pre(const Unit& u, long long row, int c8, Pre& pr) const {
        if (XS) { const float* x = XS + row * 1024 + u.pn * 256 + c8; pr.v[0] = *(const float4*)x; pr.v[1] = *(const float4*)(x + 4); pr.v[2] = *(const float4*)(x + 128); pr.v[3] = *(const float4*)(x + 132); }
        else { const bf16_t* x = XB + row * 1024 + u.pn * 256 + c8; const uint4 a = *(const uint4*)x, b = *(const uint4*)(x + 128);
            pr.v[0].x = u2f(a.x); pr.v[0].y = u2f(a.y); pr.v[0].z = u2f(a.z); pr.v[0].w = u2f(a.w); pr.v[1].x = u2f(b.x); pr.v[1].y = u2f(b.y); pr.v[1].z = u2f(b.z); pr.v[1].w = u2f(b.w); } }
    DEVM void apply(const Unit& u, long long row, int c8, const float* lo, const float* hi, const Pre& pr) const {
        float4 a, b, c, d;
        if (XS) { a = pr.v[0]; b = pr.v[1]; c = pr.v[2]; d = pr.v[3]; }
        else { const unsigned a0 = f2u(pr.v[0].x), a1 = f2u(pr.v[0].y), a2 = f2u(pr.v[0].z), a3 = f2u(pr.v[0].w), b0 = f2u(pr.v[1].x), b1 = f2u(pr.v[1].y), b2 = f2u(pr.v[1].z), b3 = f2u(pr.v[1].w);
            a.x = u2f(a0 << 16); a.y = u2f(a0 & 0xffff0000u); a.z = u2f(a1 << 16); a.w = u2f(a1 & 0xffff0000u); b.x = u2f(a2 << 16); b.y = u2f(a2 & 0xffff0000u); b.z = u2f(a3 << 16); b.w = u2f(a3 & 0xffff0000u);
            c.x = u2f(b0 << 16); c.y = u2f(b0 & 0xffff0000u); c.z = u2f(b1 << 16); c.w = u2f(b1 & 0xffff0000u); d.x = u2f(b2 << 16); d.y = u2f(b2 & 0xffff0000u); d.z = u2f(b3 << 16); d.w = u2f(b3 & 0xffff0000u); }
        a.x += lo[0]; a.y += lo[1]; a.z += lo[2]; a.w += lo[3]; b.x += lo[4]; b.y += lo[5]; b.z += lo[6]; b.w += lo[7];
        c.x += hi[0]; c.y += hi[1]; c.z += hi[2]; c.w += hi[3]; d.x += hi[4]; d.y += hi[5]; d.z += hi[6]; d.w += hi[7];
        { const float n0[8] = {a.x, a.y, a.z, a.w, b.x, b.y, b.z, b.w}, n1[8] = {c.x, c.y, c.z, c.w, d.x, d.y, d.z, d.w}; bf16_t* h = HB + row * 1024 + u.pn * 256 + c8; st8(h, n0); st8(h + 128, n1); }
        if (RS) {
            float ss = (a.x * a.x + a.y * a.y + a.z * a.z + a.w * a.w) + (b.x * b.x + b.y * b.y + b.z * b.z + b.w * b.w) + (c.x * c.x + c.y * c.y + c.z * c.z + c.w * c.w) + (d.x * d.x + d.y * d.y + d.z * d.z + d.w * d.w);
#ifdef CPU_EMU
            RS[row] += (rs_t)((double)ss * 16777216.0 + 0.5);
#else
            ss += __shfl_xor(ss, 16); ss += __shfl_xor(ss, 32);
            if ((mk_lane_() >> 4) == 0) atomicAdd(RS + row, (rs_t)((double)ss * 16777216.0 + 0.5));
#endif
        } }
};
struct EpSwiglu {
    typedef PreRow Pre; static constexpr int ROWS = 2;
    bf16_t* ACT; long long ldo; long long row0; const rs_t* rss;
    DEVM void pre(const Unit&, long long row, int, Pre& pr) const { pr.r = rs_of(rss, row); }
    DEVM void apply(const Unit& u, long long row, int c8, const float* lo, const float* hi, const Pre& pr) const { float r[8];
#pragma unroll
        for (int j = 0; j < 8; ++j) r[j] = siluf_(lo[j] * pr.r) * (hi[j] * pr.r);
        st8(ACT + (row - row0) * ldo + u.pn * 128 + c8, r); }
};
struct EpMoeDown {
    struct Pre { float w; }; static constexpr int ROWS = 2;
    bf16_t* Y; const float* roww;
    DEVM void pre(const Unit&, long long row, int, Pre& pr) const { pr.w = roww[row]; }
    DEVM void apply(const Unit& u, long long row, int c8, const float* lo, const float* hi, const Pre& pr) const { const float w = pr.w; float a[8], b[8];
#pragma unroll
        for (int j = 0; j < 8; ++j) { a[j] = lo[j] * w; b[j] = hi[j] * w; }
        bf16_t* d = Y + row * 1024 + u.pn * 256 + c8; st8(d, a); st8(d + 128, b); }
};

#ifdef CPU_EMU
template <class Sched, class Epi> static void gemm_cpu(const bf16_t* A, long long lda, const bf16_t* Bt, long long ldb, long long K, const Sched& S, const Epi& E, long long kstepA = 64, const int* gidx = nullptr) {
    Unit u;
    for (int i = 0; S.next(i, u); ++i) {
        const bf16_t* a0 = (const bf16_t*)((const char*)A + u.aoff); const bf16_t* b0 = (const bf16_t*)((const char*)Bt + u.boff);
#pragma omp parallel for
        for (int r = 0; r < 256; ++r) { float arow[4096]; const bf16_t* ar = a0 + r * lda; if (gidx) { const unsigned tk = (unsigned)gidx[(long long)u.pm * 256 + r] & 0xffffu; ar = A + (long long)tk * lda; }
            for (long long k = 0; k < K; ++k) arow[k] = bf2f(ar[(k >> 6) * kstepA + (k & 63)]);
            for (int c8 = 0; c8 < 128; c8 += 8) { float lo[8], hi[8];
                for (int j = 0; j < 8; ++j) { const bf16_t* bl = b0 + (c8 + j) * ldb; const bf16_t* bh = b0 + (128 + c8 + j) * ldb; float s0 = 0.f, s1 = 0.f;
                    for (long long k = 0; k < K; ++k) { s0 += arow[k] * bf2f(bl[k]); s1 += arow[k] * bf2f(bh[k]); } lo[j] = s0; hi[j] = s1; }
                typename Epi::Pre pr; E.pre(u, (long long)u.pm * 256 + r, c8, pr); E.apply(u, (long long)u.pm * 256 + r, c8, lo, hi, pr); } } }
}
#endif

#ifndef CPU_EMU
DEVI float wave_sum(float v) {
    v += __builtin_bit_cast(float, __builtin_amdgcn_update_dpp(0, __builtin_bit_cast(int, v), 0xB1, 0xF, 0xF, true)); v += __builtin_bit_cast(float, __builtin_amdgcn_update_dpp(0, __builtin_bit_cast(int, v), 0x4E, 0xF, 0xF, true));
    v += __builtin_bit_cast(float, __builtin_amdgcn_update_dpp(0, __builtin_bit_cast(int, v), 0x141, 0xF, 0xF, true)); v += __builtin_bit_cast(float, __builtin_amdgcn_update_dpp(0, __builtin_bit_cast(int, v), 0x140, 0xF, 0xF, true));
    float a = v, b = v; asm("s_nop 1\n\tv_permlane16_swap_b32 %0, %1" : "+v"(a), "+v"(b)); a = a + b; b = a;
    asm("s_nop 1\n\tv_permlane32_swap_b32 %0, %1" : "+v"(a), "+v"(b)); return a + b; }
DEVI void row_load(const float* src, float (&v)[16], int lane) {
#pragma unroll
    for (int j = 0; j < 4; ++j) { const float4 f = *(const float4*)(src + j * 256 + lane * 4); v[4 * j] = f.x; v[4 * j + 1] = f.y; v[4 * j + 2] = f.z; v[4 * j + 3] = f.w; } }
DEVI void row_load_bf16(const bf16_t* src, float (&v)[16], int lane) {
#pragma unroll
    for (int j = 0; j < 4; ++j) { const uint2 w = *(const uint2*)(src + j * 256 + lane * 4); v[4 * j] = u2f(w.x << 16); v[4 * j + 1] = u2f(w.x & 0xffff0000u); v[4 * j + 2] = u2f(w.y << 16); v[4 * j + 3] = u2f(w.y & 0xffff0000u); } }
DEVI void row_store_bf16(bf16_t* dst, const float (&v)[16], int lane) {
#pragma unroll
    for (int j = 0; j < 4; ++j) { uint2 w; w.x = pk2bf(v[4 * j], v[4 * j + 1]); w.y = pk2bf(v[4 * j + 2], v[4 * j + 3]); *(uint2*)(dst + j * 256 + lane * 4) = w; } }
#endif
DEVI void ph_rmsnorm(const Params& p, const float* src, long long rows, const float* gain, bf16_t* dst, int mode, float* xcopy, long long gw, long long nw, int lane, long long row0 = 0, const bf16_t* srcb = nullptr) {
    const float* router = p.in[I_MOE_R]; int* TE = WSP(int, p.oTOKE) + row0 * 2; float* TW = WSP(float, p.oTOKW) + row0 * 2;
#ifndef CPU_EMU
    for (long long r = gw; r < rows; r += nw) { float v[16], g[16]; if (srcb) row_load_bf16(srcb + r * 1024, v, lane); else row_load(src + r * 1024, v, lane); row_load(gain, g, lane);
        float ss = 0.f;
#pragma unroll
        for (int j = 0; j < 16; ++j) ss += v[j] * v[j];
        ss = wave_sum(ss); const float rs = rsqrtf(ss * (1.0f / 1024.0f) + 1e-6f);
        if (mode == 1) {
#pragma unroll
            for (int j = 0; j < 4; ++j) *(float4*)(xcopy + r * 1024 + j * 256 + lane * 4) = make_float4(v[4 * j], v[4 * j + 1], v[4 * j + 2], v[4 * j + 3]); }
#pragma unroll
        for (int j = 0; j < 16; ++j) v[j] = v[j] * rs * g[j];
        row_store_bf16(dst + r * 1024, v, lane);
        if (mode == 2) { float lg[8];
#pragma unroll
            for (int e = 0; e < 8; ++e) { float a = 0.f;
#pragma unroll
                for (int j = 0; j < 16; ++j) a += v[j] * router[(long long)((j >> 2) * 256 + lane * 4 + (j & 3)) * 8 + e];
                lg[e] = wave_sum(a); }
            int i0 = 0; float v0 = lg[0];
#pragma unroll
            for (int e = 1; e < 8; ++e) if (lg[e] > v0) { v0 = lg[e]; i0 = e; }
            int i1 = -1; float v1 = -3e38f;
#pragma unroll
            for (int e = 0; e < 8; ++e) if (e != i0 && lg[e] > v1) { v1 = lg[e]; i1 = e; }
            const float w0 = 1.0f / (1.0f + expf(v1 - v0));
            if (lane == 0) { TE[r * 2] = i0; TE[r * 2 + 1] = i1; TW[r * 2] = w0; TW[r * 2 + 1] = 1.0f - w0; } } }
#else
    (void)lane;
    for (long long r = gw; r < rows; r += nw) { float xb_[1024]; if (srcb) for (int c = 0; c < 1024; ++c) xb_[c] = bf2f(srcb[r * 1024 + c]); const float* x = srcb ? xb_ : src + r * 1024; float ss = 0.f; for (int c = 0; c < 1024; ++c) ss += x[c] * x[c];
        const float rs = 1.0f / sqrtf(ss / 1024.0f + 1e-6f); float hv[1024];
        for (int c = 0; c < 1024; ++c) { hv[c] = x[c] * rs * gain[c]; dst[r * 1024 + c] = f2bf(hv[c]); if (mode == 1) xcopy[r * 1024 + c] = x[c]; }
        if (mode == 2) { float lg[8]; for (int e = 0; e < 8; ++e) { float a = 0.f; for (int c = 0; c < 1024; ++c) a += hv[c] * router[c * 8 + e]; lg[e] = a; }
            int i0 = 0; float v0 = lg[0]; for (int e = 1; e < 8; ++e) if (lg[e] > v0) { v0 = lg[e]; i0 = e; }
            int i1 = -1; float v1 = -3e38f; for (int e = 0; e < 8; ++e) if (e != i0 && lg[e] > v1) { v1 = lg[e]; i1 = e; }
            const float w0 = 1.0f / (1.0f + expf(v1 - v0)); TE[r * 2] = i0; TE[r * 2 + 1] = i1; TW[r * 2] = w0; TW[r * 2 + 1] = 1.0f - w0; } }
#endif
}
DEVI void ph_final(const Params& p, long long gw, long long nw, int lane) {
    const int* TS = WSP(int, p.oTOKS); const bf16_t* Y = WSP(bf16_t, p.oY); const float* gain = p.in[I_NORM_FINAL]; float* X = p.out; const bf16_t* XB = WSP(bf16_t, p.oH);
#ifndef CPU_EMU
    float g[16]; row_load(gain, g, lane);
    uint2 cx[4], ca[4], cb[4]; int sn0 = 0, sn1 = 0;
#define FN_LOAD(r_, s0_, s1_, dx, da, db) do { const bf16_t* y0 = Y + (long long)(s0_) * 1024; const bf16_t* y1 = Y + (long long)(s1_) * 1024; \
        _Pragma("unroll") for (int j = 0; j < 4; ++j) { dx[j] = *(const uint2*)(XB + (r_) * 1024 + j * 256 + lane * 4); da[j] = *(const uint2*)(y0 + j * 256 + lane * 4); db[j] = *(const uint2*)(y1 + j * 256 + lane * 4); } } while (0)
    if (gw < p.T) { const int s0 = TS[gw * 2], s1 = TS[gw * 2 + 1]; FN_LOAD(gw, s0, s1, cx, ca, cb); if (gw + nw < p.T) { sn0 = TS[(gw + nw) * 2]; sn1 = TS[(gw + nw) * 2 + 1]; } }
    for (long long r = gw; r < p.T; r += nw) { float v[16]; uint2 nx[4], na[4], nb[4]; int snn0 = 0, snn1 = 0;
        if (r + nw < p.T) FN_LOAD(r + nw, sn0, sn1, nx, na, nb);
        if (r + 2 * nw < p.T) { snn0 = TS[(r + 2 * nw) * 2]; snn1 = TS[(r + 2 * nw) * 2 + 1]; }
#pragma unroll
        for (int j = 0; j < 4; ++j) { const uint2 x = cx[j], a = ca[j], b = cb[j];
            v[4 * j] = u2f(x.x << 16) + u2f(a.x << 16) + u2f(b.x << 16); v[4 * j + 1] = u2f(x.x & 0xffff0000u) + u2f(a.x & 0xffff0000u) + u2f(b.x & 0xffff0000u);
            v[4 * j + 2] = u2f(x.y << 16) + u2f(a.y << 16) + u2f(b.y << 16); v[4 * j + 3] = u2f(x.y & 0xffff0000u) + u2f(a.y & 0xffff0000u) + u2f(b.y & 0xffff0000u); }
#pragma unroll
        for (int j = 0; j < 4; ++j) { cx[j] = nx[j]; ca[j] = na[j]; cb[j] = nb[j]; }
        sn0 = snn0; sn1 = snn1;
        float ss = 0.f;
#pragma unroll
        for (int j = 0; j < 16; ++j) ss += v[j] * v[j];
        ss = wave_sum(ss); const float rs = rsqrtf(ss * (1.0f / 1024.0f) + 1e-6f);
#pragma unroll
        for (int j = 0; j < 4; ++j) *(float4*)(X + r * 1024 + j * 256 + lane * 4) = make_float4(v[4 * j] * rs * g[4 * j], v[4 * j + 1] * rs * g[4 * j + 1], v[4 * j + 2] * rs * g[4 * j + 2], v[4 * j + 3] * rs * g[4 * j + 3]); }
#undef FN_LOAD
#else
    (void)lane;
    for (long long r = gw; r < p.T; r += nw) { float v[1024]; float ss = 0.f; const bf16_t* y0 = Y + (long long)TS[r * 2] * 1024; const bf16_t* y1 = Y + (long long)TS[r * 2 + 1] * 1024;
        for (int c = 0; c < 1024; ++c) { v[c] = bf2f(XB[r * 1024 + c]) + bf2f(y0[c]) + bf2f(y1[c]); ss += v[c] * v[c]; }
        const float rs = 1.0f / sqrtf(ss / 1024.0f + 1e-6f); for (int c = 0; c < 1024; ++c) X[r * 1024 + c] = v[c] * rs * gain[c]; }
#endif
}
DEVI void ph_rwkv_scan(const Params& p, int l, long long gw, long long nw, int lane) {
    const float* RWW = WSP(float, p.oRWW); const bf16_t* RWX = WSP(bf16_t, p.oRWX); bf16_t* O = WSP(bf16_t, p.oO); const float* lng = p.in[I_RW_LN] + l * 256; const float* rkw = p.in[I_RW_RK] + l * 256; (void)rkw;
    for (long long ch = gw; ch < p.B * 4; ch += nw) { const long long b = ch >> 2; const int h = (int)(ch & 3);
#ifndef CPU_EMU
        float st[64];
#pragma unroll
        for (int c = 0; c < 64; ++c) st[c] = 0.f;
        for (long long s = 0; s < p.S; ++s) { const long long t = b * p.S + s; const bf16_t* rx = RWX + t * 1280 + h * 64; const float v = bf2f(rx[512 + lane]);
            const float y = rwkv_row_step(st, RWW + t * 256 + h * 64, rx, rx + 256, rx + 768, rx + 1024, v);
            const float mean = wave_sum(y) * (1.0f / 64.0f), dy = y - mean, var = wave_sum(dy * dy) * (1.0f / 64.0f);
            const float yn = dy * rsqrtf(var + 64e-5f) * lng[h * 64 + lane] + 0.f;
            bf16_t* o = O + t * 1024 + 512 + h * 64 + lane; *o = f2bf(yn * bf2f(*o)); }
#else
        (void)lane;
        static float st[64][64]; for (int v = 0; v < 64; ++v) for (int c = 0; c < 64; ++c) st[v][c] = 0.f;
        for (long long s = 0; s < p.S; ++s) { const long long t = b * p.S + s; const bf16_t* rx = RWX + t * 1280 + h * 64; float y[64], mean = 0.f, var = 0.f;
            for (int v = 0; v < 64; ++v) { y[v] = rwkv_row_step(st[v], RWW + t * 256 + h * 64, rx, rx + 256, rx + 768, rx + 1024, bf2f(rx[512 + v])); mean += y[v]; }
            mean /= 64.f; for (int v = 0; v < 64; ++v) var += (y[v] - mean) * (y[v] - mean); var /= 64.f;
            float rkv = 0.f; for (int cq = 0; cq < 64; ++cq) rkv += bf2f(rx[cq]) * bf2f(rx[256 + cq]) * rkw[h * 64 + cq];
            for (int v = 0; v < 64; ++v) { const float yn = (y[v] - mean) / sqrtf(var + 64e-5f) * lng[h * 64 + v] + rkv * bf2f(rx[512 + v]);
                bf16_t* o = O + t * 1024 + 512 + h * 64 + v; *o = f2bf(yn * bf2f(*o)); } }
#endif
    }
}
DEVI void ph_gla_scan(const Params& p, int l, long long gw, long long nw, int lane) {
    const bf16_t* P = WSP(bf16_t, p.oP); const float* GA = WSP(float, p.oGA); bf16_t* O = WSP(bf16_t, p.oO); const float* ng = p.in[I_GLA_NORM] + l * 64;
    for (long long ch = gw; ch < p.B * 4; ch += nw) { const long long b = ch >> 2; const int h = (int)(ch & 3);
#ifndef CPU_EMU
        float st[32];
#pragma unroll
        for (int c = 0; c < 32; ++c) st[c] = 0.f;
        for (long long s = 0; s < p.S; ++s) { const long long t = b * p.S + s; const bf16_t* x = P + t * PW + C_GLA;
            const float o = gla_col_step(st, GA + t * 128 + h * 32, x + h * 32, x + 128 + h * 32, bf2f(x[256 + h * 64 + lane]));
            const float ms = wave_sum(o * o) * (1.0f / 64.0f), on = o * rsqrtf(ms + 1e-6f) * ng[lane];
            bf16_t* d = O + t * 1024 + 768 + h * 64 + lane; *d = f2bf(on * bf2f(*d)); }
#else
        (void)lane;
        static float st[64][32]; for (int v = 0; v < 64; ++v) for (int c = 0; c < 32; ++c) st[v][c] = 0.f;
        for (long long s = 0; s < p.S; ++s) { const long long t = b * p.S + s; const bf16_t* x = P + t * PW + C_GLA; float o[64], ms = 0.f;
            for (int v = 0; v < 64; ++v) { o[v] = gla_col_step(st[v], GA + t * 128 + h * 32, x + h * 32, x + 128 + h * 32, bf2f(x[256 + h * 64 + v])); ms += o[v] * o[v]; }
            ms /= 64.f;
            for (int v = 0; v < 64; ++v) { bf16_t* d = O + t * 1024 + 768 + h * 64 + v; *d = f2bf(o[v] / sqrtf(ms + 1e-6f) * ng[v] * bf2f(*d)); } }
#endif
    }
}
#ifndef CPU_EMU
#define LAS __attribute__((address_space(3)))
__device__ __forceinline__ int mk_lane() { int l_ = (int)__builtin_amdgcn_mbcnt_hi(~0u, __builtin_amdgcn_mbcnt_lo(~0u, 0u)); asm volatile("" : "+v"(l_)); return l_; }
typedef short bf16x8 __attribute__((ext_vector_type(8)));
typedef float f32x4 __attribute__((ext_vector_type(4)));
constexpr int HALF = 128, BK = 64, HTB = HALF * BK * 2, STAGE_BYTES = 8 * HTB, GIDX_OFF = STAGE_BYTES + 64, GIDX_BYTES = 8192, LDS_TOTAL = 163840, XBW_OFF = LDS_TOTAL - 64, DEAL_SLOT_OFF = LDS_TOTAL - 128;
__device__ __forceinline__ int lds_byte(int r, int c) { const int st = (r >> 4) * 2 + (c >> 5), rr = r & 15, cc = c & 31, ob = rr * 64 + cc * 2; return st * 1024 + (ob ^ (((ob >> 9) & 1) << 5)); }
__device__ __forceinline__ void stage_rc(int b, int& R, int& C) { const int st = b / 1024, sb = b % 1024, swz = sb ^ (((sb >> 9) & 1) << 5); R = (st >> 1) * 16 + swz / 64; C = (st & 1) * 32 + (swz % 64) / 2; }
__device__ __forceinline__ int perm32(int rho) { const int n = rho >> 4, i = rho & 15; return 8 * (i >> 2) + 4 * n + (i & 3); }

template <class Epi, class Sched, bool GATHER = false>
__device__ __forceinline__ void gemm_phase(int wv, LAS unsigned char* lds, const bf16_t* A, long long lda, const bf16_t* Bt, long long ldb, long long K, const Sched& S, const Epi& E, long long kstepA_elems = 64, const int* gidx = nullptr) {
    int tid = wv * 64 + mk_lane(); asm volatile("" : "+v"(tid));
    const int wid = wv, lane = tid & 63, wr = wid >> 2, wc = wid & 3, fr = lane & 15, fq = lane >> 4;
    { unsigned long long a_ = (unsigned long long)A, b_ = (unsigned long long)Bt; unsigned alo = __builtin_amdgcn_readfirstlane((unsigned)a_), ahi = __builtin_amdgcn_readfirstlane((unsigned)(a_ >> 32)),
        blo = __builtin_amdgcn_readfirstlane((unsigned)b_), bhi = __builtin_amdgcn_readfirstlane((unsigned)(b_ >> 32));
      int lda_ = __builtin_amdgcn_readfirstlane((int)lda), ldb_ = __builtin_amdgcn_readfirstlane((int)ldb), k_ = __builtin_amdgcn_readfirstlane((int)K), ks_ = __builtin_amdgcn_readfirstlane((int)kstepA_elems);
      asm volatile("" : "+s"(alo), "+s"(ahi), "+s"(blo), "+s"(bhi), "+s"(lda_), "+s"(ldb_), "+s"(k_), "+s"(ks_)); kstepA_elems = ks_;
      A = (const bf16_t*)(((unsigned long long)ahi << 32) | alo); Bt = (const bf16_t*)(((unsigned long long)bhi << 32) | blo); lda = lda_; ldb = ldb_; K = k_; }
    const int nt = (int)(K / BK);
    unsigned voffA[2], voffB[2];
#define PG8_GRC(i_, R_, C2_) int R_, Cc_##i_; stage_rc(tid * 16 + (i_) * 8192, R_, Cc_##i_); const unsigned C2_ = (unsigned)Cc_##i_ * 2u
#pragma unroll
    for (int i = 0; i < 2; ++i) { int R, C; stage_rc(tid * 16 + i * 8192, R, C); const int Rb = (R & ~31) + perm32(R & 31);
        voffA[i] = (unsigned)(R * (int)lda + C) * 2u; voffB[i] = (unsigned)(Rb * (int)ldb + C) * 2u; }
    const size_t kstep = (size_t)(BK * 2), kstepA = (size_t)kstepA_elems * 2;
    const size_t hstepA = (size_t)HALF * lda * 2, hstepB = (size_t)HALF * ldb * 2;
    const unsigned ldsw = (unsigned)wid * 1024u;
    const int aoff = lds_byte(wr * 64 + fr, fq * 8), boff = lds_byte(wc * 32 + fr, fq * 8);
#define PG8_SA(b, h) (((b) * 2 + (h)) * HTB)
#define PG8_SB(b, h) ((4 + (b) * 2 + (h)) * HTB)
#define PG8_STAGE(bufoff, gbase, voff) do { _Pragma("unroll") for (int _i = 0; _i < 2; ++_i) \
        __builtin_amdgcn_global_load_lds((const unsigned*)((const char*)(gbase) + (voff)[_i]), (LAS unsigned*)(lds + (bufoff) + ldsw + _i * 8192), 16, 0, 0); } while (0)
#define PG8_STAGE_A(bufoff, plainbase, kbytes, g0, g1) do { if constexpr (GATHER) { const char* gb_ = (const char*)A + (kbytes); \
        __builtin_amdgcn_global_load_lds((const unsigned*)(gb_ + (g0)), (LAS unsigned*)(lds + (bufoff) + ldsw), 16, 0, 0); __builtin_amdgcn_global_load_lds((const unsigned*)(gb_ + (g1)), (LAS unsigned*)(lds + (bufoff) + ldsw + 8192), 16, 0, 0); } \
        else PG8_STAGE(bufoff, plainbase, voffA); } while (0)
#define PG8_GOFF(dst, u_) do { if constexpr (GATHER) { PG8_GRC(0, r0_, c0_); PG8_GRC(1, r1_, c1_); _Pragma("unroll") for (int h_ = 0; h_ < 2; ++h_) { unsigned tk_ = (unsigned)gidx[(long long)(u_).pm * 256 + h_ * 128 + r0_] & 0xffffu; dst[h_][0] = tk_ * (unsigned)((int)lda * 2) + c0_; \
        tk_ = (unsigned)gidx[(long long)(u_).pm * 256 + h_ * 128 + r1_] & 0xffffu; dst[h_][1] = tk_ * (unsigned)((int)lda * 2) + c1_; } } } while (0)
#define PG8_LDA(dst, b, h) do { _Pragma("unroll") for (int m = 0; m < 4; ++m) _Pragma("unroll") for (int k = 0; k < 2; ++k) dst[m][k] = *(const LAS bf16x8*)(lds + PG8_SA(b, h) + aoff + m * 2048 + k * 1024); } while (0)
#define PG8_LDB(dst, b, h) do { _Pragma("unroll") for (int n = 0; n < 2; ++n) _Pragma("unroll") for (int k = 0; k < 2; ++k) dst[n][k] = *(const LAS bf16x8*)(lds + PG8_SB(b, h) + boff + n * 2048 + k * 1024); } while (0)
#define PG8_MMA(ai, bj, At, Bt_) do { __builtin_amdgcn_s_setprio(1); _Pragma("unroll") for (int m = 0; m < 4; ++m) _Pragma("unroll") for (int n = 0; n < 2; ++n) _Pragma("unroll") for (int k = 0; k < 2; ++k) \
        acc[ai][bj][m][n] = __builtin_amdgcn_mfma_f32_16x16x32_bf16(Bt_[n][k], At[m][k], acc[ai][bj][m][n], 0, 0, 0); __builtin_amdgcn_s_setprio(0); } while (0)
#define PG8_WAIT_V(n) asm volatile("s_waitcnt vmcnt(" #n ")" ::: "memory")
#define PG8_WAIT_L(n) asm volatile("s_waitcnt lgkmcnt(" #n ")" ::: "memory")
#define PG8_BAR __builtin_amdgcn_s_barrier()
#define PG8_SCHED __builtin_amdgcn_sched_barrier(0)
    Unit cur, nxt; int ui = 0;
    if (!S.next(0, cur)) return;
    f32x4 acc[2][2][4][2];
#pragma unroll
    for (int a = 0; a < 2; ++a)
#pragma unroll
        for (int b = 0; b < 2; ++b)
#pragma unroll
            for (int m = 0; m < 4; ++m)
#pragma unroll
                for (int n = 0; n < 2; ++n) acc[a][b][m][n] = (f32x4){0.f, 0.f, 0.f, 0.f};
    bf16x8 At[4][2], B0[2][2], B1[2][2];
    const char* cA = (const char*)A + cur.aoff; const char* cB = (const char*)Bt + cur.boff;
    S.a_ready(cur);
    unsigned gC_[2][2] = {{0u, 0u}, {0u, 0u}};
    PG8_GOFF(gC_, cur);
    PG8_STAGE(PG8_SB(0, 0), cB, voffB); PG8_STAGE_A(PG8_SA(0, 0), cA, 0, gC_[0][0], gC_[0][1]); PG8_STAGE(PG8_SB(0, 1), cB + hstepB, voffB); PG8_STAGE_A(PG8_SA(0, 1), cA + hstepA, 0, gC_[1][0], gC_[1][1]);
    if (wr == 1) PG8_BAR;
    PG8_WAIT_V(4); PG8_BAR;
    PG8_STAGE(PG8_SB(1, 0), cB + kstep, voffB); PG8_STAGE_A(PG8_SA(1, 0), cA + kstepA, kstepA, gC_[0][0], gC_[0][1]); PG8_STAGE(PG8_SB(1, 1), cB + hstepB + kstep, voffB);
    PG8_WAIT_V(6); PG8_BAR;
    for (;;) {
        const bool has_next = S.next(ui + 1, nxt);
        const char* nA = has_next ? (const char*)A + nxt.aoff : cA; const char* nB = has_next ? (const char*)Bt + nxt.boff : cB;
#pragma nounroll
        for (int t = 0; t < nt; t += 2) {
            const bool last = (t == nt - 2);
            if constexpr (GATHER) {
                if (t == 0 && has_next) {
                    PG8_GRC(0, r0_, c0_); PG8_GRC(1, r1_, c1_); (void)c0_; (void)c1_;
#pragma unroll
                    for (int h_ = 0; h_ < 2; ++h_) { const int* ip0_ = gidx + (long long)nxt.pm * 256 + h_ * 128 + r0_; const int* ip1_ = gidx + (long long)nxt.pm * 256 + h_ * 128 + r1_;
                        __builtin_amdgcn_global_load_lds((const unsigned*)ip0_, (LAS unsigned*)(lds + GIDX_OFF + (h_ * 2 + 0) * 2048 + wid * 256), 4, 0, 0);
                        __builtin_amdgcn_global_load_lds((const unsigned*)ip1_, (LAS unsigned*)(lds + GIDX_OFF + (h_ * 2 + 1) * 2048 + wid * 256), 4, 0, 0); } }
            }
            const size_t k1_ = (size_t)(t + 1) * kstepA, k2_ = last ? 0 : (size_t)(t + 2) * kstepA, k3_ = k2_ + kstepA;
            const char* a1 = cA + (size_t)(t + 1) * kstepA;
            const char* a2 = last ? nA : cA + (size_t)(t + 2) * kstepA; const char* b2 = last ? nB : cB + (size_t)(t + 2) * kstep;
            const char* a3 = a2 + kstepA; const char* b3 = b2 + kstep;
            if (last && has_next) S.a_ready(nxt);
            PG8_LDB(B0, 0, 0); PG8_SCHED; PG8_LDA(At, 0, 0); PG8_STAGE_A(PG8_SA(1, 1), a1 + hstepA, k1_, gC_[1][0], gC_[1][1]);
            if constexpr (GATHER) { if (last && has_next) {
                PG8_GRC(0, r0_, c0_); PG8_GRC(1, r1_, c1_); (void)r0_; (void)r1_;
#pragma unroll
                for (int h_ = 0; h_ < 2; ++h_) { unsigned i0_, i1_; const unsigned ad_ = (unsigned)(size_t)(lds + GIDX_OFF + h_ * 4096) + (unsigned)tid * 4u;
                    asm volatile("ds_read_b32 %0, %2\n\tds_read_b32 %1, %2 offset:2048\n\ts_waitcnt lgkmcnt(0)" : "=&v"(i0_), "=&v"(i1_) : "v"(ad_) : "memory");
                    gC_[h_][0] = (i0_ & 0xffffu) * (unsigned)((int)lda * 2) + c0_; gC_[h_][1] = (i1_ & 0xffffu) * (unsigned)((int)lda * 2) + c1_; } } }
            PG8_WAIT_L(8); PG8_BAR; PG8_WAIT_L(0); PG8_MMA(0, 0, At, B0); PG8_BAR; PG8_SCHED;
            PG8_LDB(B1, 0, 1); PG8_STAGE(PG8_SB(0, 0), b2, voffB);
            PG8_BAR; PG8_WAIT_L(0); PG8_MMA(0, 1, At, B1); PG8_BAR;
            PG8_LDA(At, 0, 1); PG8_STAGE_A(PG8_SA(0, 0), a2, k2_, gC_[0][0], gC_[0][1]);
            PG8_BAR; PG8_WAIT_L(0); PG8_MMA(1, 0, At, B0); PG8_BAR; PG8_SCHED;
            PG8_STAGE(PG8_SB(0, 1), b2 + hstepB, voffB);
            PG8_WAIT_V(6); PG8_BAR; PG8_MMA(1, 1, At, B1); PG8_BAR;
            PG8_LDB(B0, 1, 0); PG8_SCHED; PG8_LDA(At, 1, 0); PG8_STAGE_A(PG8_SA(0, 1), a2 + hstepA, k2_, gC_[1][0], gC_[1][1]);
            PG8_WAIT_L(8); PG8_BAR; PG8_WAIT_L(0); PG8_MMA(0, 0, At, B0); PG8_BAR; PG8_SCHED;
            PG8_LDB(B1, 1, 1); PG8_STAGE(PG8_SB(1, 0), b3, voffB);
            PG8_BAR; PG8_WAIT_L(0); PG8_MMA(0, 1, At, B1); PG8_BAR;
            PG8_LDA(At, 1, 1); PG8_STAGE_A(PG8_SA(1, 0), a3, k3_, gC_[0][0], gC_[0][1]);
            PG8_BAR; PG8_WAIT_L(0); PG8_MMA(1, 0, At, B0); PG8_BAR; PG8_SCHED;
            PG8_STAGE(PG8_SB(1, 1), b3 + hstepB, voffB);
            PG8_WAIT_V(6); PG8_BAR; PG8_MMA(1, 1, At, B1); PG8_BAR;
        }
        const int el_ = mk_lane(), efr = el_ & 15, efq = el_ >> 4;
#pragma unroll
        for (int ai = 0; ai < 2; ++ai)
#pragma unroll
            for (int mh = 0; mh < 4 / Epi::ROWS; ++mh) { typename Epi::Pre pr[Epi::ROWS];
#pragma unroll
                for (int m2 = 0; m2 < Epi::ROWS; ++m2) E.pre(cur, (long long)cur.pm * 256 + ai * HALF + wr * 64 + (Epi::ROWS * mh + m2) * 16 + efr, wc * 32 + 8 * efq, pr[m2]);
                PG8_SCHED;
#pragma unroll
                for (int m2 = 0; m2 < Epi::ROWS; ++m2) { const int m = Epi::ROWS * mh + m2; float lo[8], hi[8];
#pragma unroll
                    for (int j = 0; j < 8; ++j) { lo[j] = acc[ai][0][m][j >> 2][j & 3]; hi[j] = acc[ai][1][m][j >> 2][j & 3]; }
                    E.apply(cur, (long long)cur.pm * 256 + ai * HALF + wr * 64 + m * 16 + efr, wc * 32 + 8 * efq, lo, hi, pr[m2]); }
                PG8_SCHED; }
        S.done(cur);
        if (!has_next) break;
#pragma unroll
        for (int a = 0; a < 2; ++a)
#pragma unroll
            for (int b = 0; b < 2; ++b)
#pragma unroll
                for (int m = 0; m < 4; ++m)
#pragma unroll
                    for (int n = 0; n < 2; ++n) acc[a][b][m][n] = (f32x4){0.f, 0.f, 0.f, 0.f};
        cur = nxt; cA = nA; cB = nB; ++ui;
    }
    PG8_WAIT_V(0);
    if (wr == 0) PG8_BAR;
    PG8_BAR;
#undef PG8_SA
#undef PG8_SB
#undef PG8_STAGE
#undef PG8_LDA
#undef PG8_STAGE_A
#undef PG8_GRC
#undef PG8_GOFF
#undef PG8_LDB
#undef PG8_MMA
#undef PG8_WAIT_V
#undef PG8_WAIT_L
#undef PG8_BAR
#undef PG8_SCHED
}

#define XB_TMO      128
#define XB_XCNT(j)  (256  + 64 * (j))
#define XB_XSUB(j)  (1280 + 64 * (j))
#define XB_XGEN(j)  (2304 + 64 * (j))
#define XB_TOP      3328
#define XB_TOPGEN   3392
#define XCD_BAR_WORDS 3456
#define XB_SPIN_CAP (1u << 18)
__device__ __forceinline__ unsigned xb_ld(unsigned* p)              { return __hip_atomic_load(p, __ATOMIC_RELAXED, __HIP_MEMORY_SCOPE_AGENT); }
__device__ __forceinline__ unsigned xb_add(unsigned* p, unsigned v) { return __hip_atomic_fetch_add(p, v, __ATOMIC_RELAXED, __HIP_MEMORY_SCOPE_AGENT); }
__device__ __forceinline__ unsigned xb_xcc_id() { return (unsigned)__builtin_amdgcn_s_getreg((3 << 11) | 20) & 0xFu; }
#define XB_SPIN(cond, bar) do { unsigned _sp = 0; while (cond) { __builtin_amdgcn_s_sleep(1); \
    if ((++_sp & 255u) == 0u) { if (xb_ld(&(bar)[XB_TMO])) break; if (_sp > XB_SPIN_CAP) { atomicAdd(&(bar)[XB_TMO], 1u); break; } } } } while (0)
struct XcdBarrier { unsigned* bar; unsigned x; volatile LAS unsigned* st; int wv; };
__device__ __forceinline__ XcdBarrier xcd_barrier_post(unsigned* bar, volatile LAS unsigned* st, int wv) {
    XcdBarrier b; b.bar = bar; b.x = xb_xcc_id(); b.st = st; b.wv = wv;
    if (wv == 0 && mk_lane() == 0) (void)xb_add(&bar[XB_XCNT(b.x)], 1u);
    return b;
}
__device__ __forceinline__ void xcd_barrier_complete(unsigned* bar, unsigned x, unsigned& nloc, unsigned& nx) {
    const unsigned G = gridDim.x * gridDim.y * gridDim.z;
    unsigned sum, cnt, mine, sp = 0u;
    for (;;) {
        sum = 0u; cnt = 0u; mine = 0u;
#pragma unroll
        for (unsigned j = 0; j < 16; ++j) { const unsigned c = xb_ld(&bar[XB_XCNT(j)]); sum += c; cnt += (c > 0u) ? 1u : 0u; mine = (j == x) ? c : mine; }
        if (sum == G) break;
        __builtin_amdgcn_s_sleep(1);
        if ((++sp & 255u) == 0u) { if (xb_ld(&bar[XB_TMO])) break; if (sp > XB_SPIN_CAP) { atomicAdd(&bar[XB_TMO], 1u); break; } }
    }
    nloc = mine > 0u ? mine : 1u; nx = cnt > 0u ? cnt : 1u;
}
__device__ __forceinline__ void xcd_barrier(const XcdBarrier& b) {
    asm volatile("s_waitcnt vmcnt(0)" ::: "memory");
    __syncthreads();
    if (b.wv == 0 && mk_lane() == 0) {
        unsigned* bar = b.bar;
        __builtin_amdgcn_s_waitcnt(0);
        unsigned nloc = b.st[0], nx = b.st[1];
        if (nloc == 0u) { xcd_barrier_complete(bar, b.x, nloc, nx); b.st[0] = nloc; b.st[1] = nx; }
        const unsigned old = xb_add(&bar[XB_XSUB(b.x)], 1u);
        const unsigned gen = old / nloc;
        if (old + 1u == (gen + 1u) * nloc) {
            __builtin_amdgcn_fence(__ATOMIC_RELEASE, "agent");
            asm volatile("s_waitcnt vmcnt(0)" ::: "memory");
            const unsigned og = xb_add(&bar[XB_TOP], 1u);
            const unsigned tg = og / nx;
            if (og + 1u == (tg + 1u) * nx) xb_add(&bar[XB_TOPGEN], 1u);
            else XB_SPIN(xb_ld(&bar[XB_TOPGEN]) == tg, bar);
            __builtin_amdgcn_fence(__ATOMIC_ACQUIRE, "agent");
            xb_add(&bar[XB_XGEN(b.x)], 1u);
            asm volatile("s_waitcnt vmcnt(0)" ::: "memory");
        } else {
            XB_SPIN(xb_ld(&bar[XB_XGEN(b.x)]) == gen, bar);
            __builtin_amdgcn_fence(__ATOMIC_ACQUIRE, "agent");
            asm volatile("s_waitcnt vmcnt(0)" ::: "memory");
        }
    }
    __syncthreads();
}
#endif
#ifndef CPU_EMU
typedef short bf16x8_t __attribute__((ext_vector_type(8)));
typedef short bf16x4_t __attribute__((ext_vector_type(4)));
typedef float f32x4_t __attribute__((ext_vector_type(4)));
typedef unsigned u32x4_t __attribute__((ext_vector_type(4)));
constexpr int SELM_LDS_OFF = 163200;
constexpr int AT_KS = 144, AT_VS = 136;
constexpr int AT_KBYTES = 64 * AT_KS, AT_VBYTES = 64 * AT_KS, AT_BUF = AT_KBYTES + AT_VBYTES;
typedef unsigned u32x2_t __attribute__((ext_vector_type(2)));
__device__ __forceinline__ float quad4_max(float x) { float a = x, b = x;
    asm volatile("s_nop 1\n\tv_permlane16_swap_b32 %0, %1" : "+v"(a), "+v"(b)); a = fmaxf(a, b); b = a;
    asm volatile("s_nop 1\n\tv_permlane32_swap_b32 %0, %1" : "+v"(a), "+v"(b)); return fmaxf(a, b); }
__device__ __forceinline__ float quad4_sum(float x) { float a = x, b = x;
    asm volatile("s_nop 1\n\tv_permlane16_swap_b32 %0, %1" : "+v"(a), "+v"(b)); a = a + b; b = a;
    asm volatile("s_nop 1\n\tv_permlane32_swap_b32 %0, %1" : "+v"(a), "+v"(b)); return a + b; }
__device__ __forceinline__ float dpp_mov1(float x) { return __builtin_bit_cast(float, __builtin_amdgcn_update_dpp(0, __builtin_bit_cast(int, x), 0xB1, 0xF, 0xF, true)); }
struct AttnState { float m, l; f32x4_t o[4]; };
__device__ __forceinline__ void attn_init(AttnState& s) { s.m = -1e30f; s.l = 0.f;
#pragma unroll
    for (int d = 0; d < 4; ++d) s.o[d] = (f32x4_t){0.f, 0.f, 0.f, 0.f}; }
__device__ __forceinline__ unsigned pack2bf(float lo, float hi) { return pk2bf(lo, hi); }
template <bool MASKED, class Valid> __device__ __forceinline__ void attn_tile(const LAS unsigned char* kt, const LAS unsigned char* vt, const bf16x8_t (&bq)[2], AttnState& st, int lane, const Valid& valid) {
    const int r = lane & 15, q = lane >> 4;
    f32x4_t s[4];
    {
        bf16x8_t k00, k01, k10, k11, k20, k21, k30, k31; const unsigned ka = (unsigned)(size_t)kt + (unsigned)(r * AT_KS + 16 * q);
        asm volatile("ds_read_b128 %0, %8\n\tds_read_b128 %1, %8 offset:64\n\tds_read_b128 %2, %8 offset:2304\n\tds_read_b128 %3, %8 offset:2368\n\t"
                     "ds_read_b128 %4, %8 offset:4608\n\tds_read_b128 %5, %8 offset:4672\n\tds_read_b128 %6, %8 offset:6912\n\tds_read_b128 %7, %8 offset:6976\n\ts_waitcnt lgkmcnt(0)"
                     : "=&v"(k00), "=&v"(k01), "=&v"(k10), "=&v"(k11), "=&v"(k20), "=&v"(k21), "=&v"(k30), "=&v"(k31) : "v"(ka) : "memory");
        const f32x4_t z4 = (f32x4_t){0.f, 0.f, 0.f, 0.f};
        s[0] = __builtin_amdgcn_mfma_f32_16x16x32_bf16(k00, bq[0], z4, 0, 0, 0); s[1] = __builtin_amdgcn_mfma_f32_16x16x32_bf16(k10, bq[0], z4, 0, 0, 0);
        s[2] = __builtin_amdgcn_mfma_f32_16x16x32_bf16(k20, bq[0], z4, 0, 0, 0); s[3] = __builtin_amdgcn_mfma_f32_16x16x32_bf16(k30, bq[0], z4, 0, 0, 0);
        s[0] = __builtin_amdgcn_mfma_f32_16x16x32_bf16(k01, bq[1], s[0], 0, 0, 0); s[1] = __builtin_amdgcn_mfma_f32_16x16x32_bf16(k11, bq[1], s[1], 0, 0, 0);
        s[2] = __builtin_amdgcn_mfma_f32_16x16x32_bf16(k21, bq[1], s[2], 0, 0, 0); s[3] = __builtin_amdgcn_mfma_f32_16x16x32_bf16(k31, bq[1], s[3], 0, 0, 0); }
    float mx = -1e30f;
#pragma unroll
    for (int kb = 0; kb < 4; ++kb)
#pragma unroll
        for (int j = 0; j < 4; ++j) { const float v = (!MASKED || valid(kb, j)) ? s[kb][j] : -1e30f; s[kb][j] = v; mx = fmaxf(mx, v); }
    mx = quad4_max(mx);
    const float mn = fmaxf(st.m, mx); const bool grow = __builtin_amdgcn_ballot_w64(mx > st.m) != 0ull;
    float alpha = 1.0f; if (grow) alpha = __builtin_amdgcn_exp2f(st.m - mn);
    float rs = 0.f;
#pragma unroll
    for (int kb = 0; kb < 4; ++kb)
#pragma unroll
        for (int j = 0; j < 4; ++j) { const float pv = (!MASKED || s[kb][j] > -1e29f) ? __builtin_amdgcn_exp2f(s[kb][j] - mn) : 0.f; s[kb][j] = pv; rs += pv; }
    rs = quad4_sum(rs);
    st.l = st.l * alpha + rs; st.m = mn;
    bf16x8_t pb[2];
#pragma unroll
    for (int kk = 0; kk < 2; ++kk) { uint4 w; w.x = pack2bf(s[2 * kk][0], s[2 * kk][1]); w.y = pack2bf(s[2 * kk][2], s[2 * kk][3]); w.z = pack2bf(s[2 * kk + 1][0], s[2 * kk + 1][1]); w.w = pack2bf(s[2 * kk + 1][2], s[2 * kk + 1][3]);
        pb[kk] = __builtin_bit_cast(bf16x8_t, w); }
    const unsigned vb = (unsigned)(size_t)vt + (unsigned)((4 * q + (r >> 2)) * AT_KS + 8 * (r & 3));
    if (grow) {
#pragma unroll
        for (int db = 0; db < 4; ++db) st.o[db] = st.o[db] * alpha; }
#pragma unroll
    for (int kk = 0; kk < 2; ++kk) { bf16x4_t l0, l1, l2, l3, h0, h1, h2, h3; const unsigned va = vb + (unsigned)(kk * 32 * AT_KS);
        asm volatile("ds_read_b64_tr_b16 %0, %8\n\tds_read_b64_tr_b16 %1, %8 offset:32\n\tds_read_b64_tr_b16 %2, %8 offset:64\n\tds_read_b64_tr_b16 %3, %8 offset:96\n\t"
                     "ds_read_b64_tr_b16 %4, %8 offset:2304\n\tds_read_b64_tr_b16 %5, %8 offset:2336\n\tds_read_b64_tr_b16 %6, %8 offset:2368\n\tds_read_b64_tr_b16 %7, %8 offset:2400\n\ts_waitcnt lgkmcnt(0)"
                     : "=&v"(l0), "=&v"(l1), "=&v"(l2), "=&v"(l3), "=&v"(h0), "=&v"(h1), "=&v"(h2), "=&v"(h3) : "v"(va) : "memory");
        st.o[0] = __builtin_amdgcn_mfma_f32_16x16x32_bf16(__builtin_shufflevector(l0, h0, 0, 1, 2, 3, 4, 5, 6, 7), pb[kk], st.o[0], 0, 0, 0);
        st.o[1] = __builtin_amdgcn_mfma_f32_16x16x32_bf16(__builtin_shufflevector(l1, h1, 0, 1, 2, 3, 4, 5, 6, 7), pb[kk], st.o[1], 0, 0, 0);
        st.o[2] = __builtin_amdgcn_mfma_f32_16x16x32_bf16(__builtin_shufflevector(l2, h2, 0, 1, 2, 3, 4, 5, 6, 7), pb[kk], st.o[2], 0, 0, 0);
        st.o[3] = __builtin_amdgcn_mfma_f32_16x16x32_bf16(__builtin_shufflevector(l3, h3, 0, 1, 2, 3, 4, 5, 6, 7), pb[kk], st.o[3], 0, 0, 0); }
}
__device__ __forceinline__ void attn_stage_store(LAS unsigned char* buf, int tid, const uint4& kc, const uint4& vc) {
    const int key = tid >> 3, c = tid & 7;
    *(LAS u32x4_t*)(buf + key * AT_KS + c * 16) = (u32x4_t){kc.x, kc.y, kc.z, kc.w};
    *(LAS u32x4_t*)(buf + AT_KBYTES + key * AT_KS + c * 16) = (u32x4_t){vc.x, vc.y, vc.z, vc.w};
}
__device__ __forceinline__ int next_unit(unsigned* ctr, volatile LAS unsigned* slot, int tid) {
    __syncthreads();
    if (tid == 0) *slot = __hip_atomic_fetch_add(ctr, 1u, __ATOMIC_RELAXED, __HIP_MEMORY_SCOPE_AGENT);
    __syncthreads();
    return (int)*slot;
}
__device__ __forceinline__ void selwin_unit(const Params& p, int cur, int bg, int wv, LAS unsigned char* lds) {
    int tid = wv * 64 + mk_lane(); asm volatile("" : "+v"(tid));
    const int wid = tid >> 6, lane = tid & 63, r = lane & 15, q = lane >> 4;
    const bf16_t* P = WSP(bf16_t, p.oP); const unsigned* SELM = WSP(unsigned, p.oSELM); bf16_t* O = WSP(bf16_t, p.oO);
    const int nqb = (int)(p.S >> 6), units = (int)(p.B * 2) * nqb;
    (void)units;
    {   const int b = bg >> 1, g = bg & 1;
        const long long t0 = (long long)b * p.S + (long long)cur * 64;
        const int hd = 2 * g + (wid >> 2); const int tq = (wid & 3) * 16 + r; const long long tok = t0 + tq; const int sq = cur * 64 + tq;
        bf16x8_t bq[2];
#pragma unroll
        for (int ks = 0; ks < 2; ++ks) bq[ks] = *(const bf16x8_t*)(P + tok * PW + C_Q + hd * 64 + 32 * ks + 8 * q);
        uint2 pvp[4];
#pragma unroll
        for (int db = 0; db < 4; ++db) pvp[db] = *(const uint2*)(O + tok * 1024 + hd * 64 + 16 * db + 4 * q);
        const bf16_t gl1 = P[tok * PW + C_NG + hd * 3 + 1], gl2 = P[tok * PW + C_NG + hd * 3 + 2];
        const volatile LAS unsigned* sm_ = (const volatile LAS unsigned*)(lds + SELM_LDS_OFF);
        unsigned un = sm_[lane];
#pragma unroll
        for (int o = 32; o > 0; o >>= 1) un |= __shfl_xor(un, o);
        un = __builtin_amdgcn_readfirstlane(un);
        const unsigned mymask = sm_[tq];
        const int wlo = cur - 8 > 0 ? cur - 8 : 0, nwin = cur - wlo + 1, nsel = __builtin_popcount(un), ntile = nwin + nsel;
        AttnState sw, ss; attn_init(sw); attn_init(ss);
        int pf = 0; unsigned prem = un;
#define SW_FETCH(kc_, vc_, blk_, win_) do { blk_ = 0; win_ = false; if (pf < ntile) { if (pf < nwin) { blk_ = wlo + pf; win_ = true; } else { blk_ = __builtin_ctz(prem); prem &= prem - 1; } ++pf; \
            const long long kr_ = ((long long)b * p.S + (long long)blk_ * 64 + (tid >> 3)) * PW + g * 64 + (tid & 7) * 8; kc_ = *(const uint4*)(P + kr_ + (win_ ? C_KW : C_KS)); vc_ = *(const uint4*)(P + kr_ + (win_ ? C_VW : C_VS)); } } while (0)
#define SW_COMPUTE(buf_, cb_, win_) do { const LAS unsigned char* bf_ = (buf_); const int cbk = (cb_), kbase = cbk * 64 + 4 * q; \
            if (win_) { if (cbk == cur || cbk == cur - 8) attn_tile<true>(bf_, bf_ + AT_KBYTES, bq, sw, lane, [&](int kb, int j) { const int key = kbase + 16 * kb + j; return key <= sq && key > sq - 512; }); \
                        else attn_tile<false>(bf_, bf_ + AT_KBYTES, bq, sw, lane, [](int, int) { return true; }); } \
            else { const bool on = (mymask >> cbk) & 1u; \
                const unsigned long long bal_ = __builtin_amdgcn_ballot_w64(on); \
                if (bal_ != 0ull) { \
                    if (cbk == cur) attn_tile<true>(bf_, bf_ + AT_KBYTES, bq, ss, lane, [&](int kb, int j) { const int key = kbase + 16 * kb + j; return on && key <= sq; }); \
                    else if (bal_ == ~0ull) attn_tile<false>(bf_, bf_ + AT_KBYTES, bq, ss, lane, [](int, int) { return true; });        \
                    else attn_tile<true>(bf_, bf_ + AT_KBYTES, bq, ss, lane, [&](int, int) { return on; }); } } } while (0)
        uint4 kA, vA, kB, vB; int cb, nb, b2, b3; bool cw, nw_, w2, w3;
        SW_FETCH(kA, vA, cb, cw);
        attn_stage_store(lds, tid, kA, vA);
        SW_FETCH(kA, vA, nb, nw_);
        __syncthreads();
        for (int i = 0; i < ntile; i += 2) {
            SW_FETCH(kB, vB, b2, w2);
            SW_COMPUTE(lds, cb, cw);
            if (i + 1 < ntile) attn_stage_store(lds + AT_BUF, tid, kA, vA);
            __syncthreads();
            if (i + 1 >= ntile) break;
            SW_FETCH(kA, vA, b3, w3);
            SW_COMPUTE(lds + AT_BUF, nb, nw_);
            if (i + 2 < ntile) attn_stage_store(lds, tid, kB, vB);
            __syncthreads();
            cb = b2; cw = w2; nb = b3; nw_ = w3;
        }
#undef SW_FETCH
#undef SW_COMPUTE
        const float g1 = sigmoidf_(bf2f(gl1)) / ss.l, g2 = sigmoidf_(bf2f(gl2)) / sw.l;
#pragma unroll
        for (int db = 0; db < 4; ++db) { bf16_t* od = O + tok * 1024 + hd * 64 + 16 * db + 4 * q; const uint2 pv = pvp[db];
            const float r0 = u2f(pv.x << 16) + g1 * ss.o[db][0] + g2 * sw.o[db][0], r1 = u2f(pv.x & 0xffff0000u) + g1 * ss.o[db][1] + g2 * sw.o[db][1];
            const float r2 = u2f(pv.y << 16) + g1 * ss.o[db][2] + g2 * sw.o[db][2], r3 = u2f(pv.y & 0xffff0000u) + g1 * ss.o[db][3] + g2 * sw.o[db][3];
            uint2 w; w.x = pack2bf(r0, r1); w.y = pack2bf(r2, r3); *(uint2*)od = w; }
    }
}
__device__ __forceinline__ void ph_ca_attn_mfma(const Params& p, int l, int wv, LAS unsigned char* lds, int gC, int gG) {
    int tid = wv * 64 + mk_lane(); asm volatile("" : "+v"(tid));
    const int wid = tid >> 6, lane = tid & 63, r = lane & 15, q = lane >> 4;
    const bf16_t* CQ = WSP(bf16_t, p.oCQ); const bf16_t* KV = WSP(bf16_t, p.oKV) + (long long)l * 512; bf16_t* AO = WSP(bf16_t, p.oCAO);
    const int nqb = (int)(p.S >> 7), npair = (int)(p.B * 4), units = npair * nqb;
    const int per = (units + gG - 1) / gG, u0 = gC * per, u1 = (u0 + per < units) ? u0 + per : units;
    int staged = -1;
    for (int u = u0; u < u1; ++u) { const int qb = u % nqb, bh = u / nqb, b = bh >> 2, hd = bh & 3;
        if (bh != staged) { staged = bh; __syncthreads();
#pragma unroll
            for (int i = 0; i < 4; ++i) { const long long kr = ((long long)b * 256 + i * 64 + (tid >> 3)) * 1024 + hd * 64 + (tid & 7) * 8; const uint4 kc = *(const uint4*)(KV + kr), vc = *(const uint4*)(KV + kr + 256); attn_stage_store(lds + i * AT_BUF, tid, kc, vc); }
            __syncthreads(); }
        const long long tok = (long long)b * p.S + (long long)qb * 128 + wid * 16 + r;
        bf16x8_t bq[2];
#pragma unroll
        for (int ks = 0; ks < 2; ++ks) bq[ks] = *(const bf16x8_t*)(CQ + tok * 256 + hd * 64 + 32 * ks + 8 * q);
        AttnState st; attn_init(st);
#pragma unroll
        for (int i = 0; i < 4; ++i) { const LAS unsigned char* buf = lds + i * AT_BUF; attn_tile<false>(buf, buf + AT_KBYTES, bq, st, lane, [](int, int) { return true; }); }
        const float il = 1.0f / st.l;
#pragma unroll
        for (int db = 0; db < 4; ++db) { uint2 w; w.x = pack2bf(st.o[db][0] * il, st.o[db][1] * il); w.y = pack2bf(st.o[db][2] * il, st.o[db][3] * il); *(uint2*)(AO + tok * 256 + hd * 64 + 16 * db + 4 * q) = w; }
    }
}
#endif
#ifndef CPU_EMU
constexpr int CM_KBYTES = 128 * AT_KS, CM_VBYTES = 128 * AT_KS;
__device__ __forceinline__ void better2(float& v, int& i, float ov, int oi) { if (ov > v || (ov == v && oi < i)) { v = ov; i = oi; } }
__device__ __forceinline__ void cmp_unit(const Params& p, int cur, int bg, int wv, LAS unsigned char* lds) {
    int tid = wv * 64 + mk_lane(); asm volatile("" : "+v"(tid));
    const int lane = tid & 63, r = lane & 15, q = lane >> 4;
    const bf16_t* P = WSP(bf16_t, p.oP); const bf16_t* KCB = WSP(bf16_t, p.oKCMP); const bf16_t* VCB = WSP(bf16_t, p.oVCMP); unsigned* SELM = WSP(unsigned, p.oSELM); bf16_t* O = WSP(bf16_t, p.oO);
    LAS unsigned char* kt = lds; LAS unsigned char* vt = lds + CM_KBYTES;
    {   const int b = bg >> 1, g = bg & 1;
        {
#pragma unroll
            for (int i = 0; i < 2; ++i) { const int ch = tid + 512 * i, key = ch >> 3, c = ch & 7;
                const uint4 kc = *(const uint4*)(KCB + ((long long)bg * 128 + key) * 64 + c * 8), vc = *(const uint4*)(VCB + ((long long)bg * 128 + key) * 64 + c * 8);
                *(LAS u32x4_t*)(kt + key * AT_KS + c * 16) = (u32x4_t){kc.x, kc.y, kc.z, kc.w}; *(LAS u32x4_t*)(vt + key * AT_KS + c * 16) = (u32x4_t){vc.x, vc.y, vc.z, vc.w}; } }
        __syncthreads();
        const int tl = 8 * wv + (r >> 1), hd = 2 * g + (r & 1); const long long tok = (long long)b * p.S + (long long)cur * 64 + tl; const int sq = cur * 64 + tl;
        bf16x8_t bq[2];
#pragma unroll
        for (int ks = 0; ks < 2; ++ks) bq[ks] = *(const bf16x8_t*)(P + tok * PW + C_Q + hd * 64 + 32 * ks + 8 * q);
        const int nv = sq >= 31 ? (sq - 31) / 16 + 1 : 0;
        const int sqw = cur * 64 + 8 * wv + 7, nvw = sqw >= 31 ? (sqw - 31) / 16 + 1 : 0, nkb = (nvw + 15) >> 4;
        f32x4_t s[8];
#pragma unroll
        for (int kb = 0; kb < 8; ++kb) { s[kb] = (f32x4_t){0.f, 0.f, 0.f, 0.f};
            if (kb < nkb) {
#pragma unroll
                for (int ks = 0; ks < 2; ++ks) { const bf16x8_t a = *(const LAS bf16x8_t*)(kt + (16 * kb + r) * AT_KS + (32 * ks + 8 * q) * 2); s[kb] = __builtin_amdgcn_mfma_f32_16x16x32_bf16(a, bq[ks], s[kb], 0, 0, 0); } } }
        float mx = -1e30f;
#pragma unroll
        for (int kb = 0; kb < 8; ++kb)
#pragma unroll
            for (int j = 0; j < 4; ++j) { const bool ok = 16 * kb + 4 * q + j < nv; const float v = ok ? s[kb][j] : -1e30f; s[kb][j] = v; mx = fmaxf(mx, v); }
        mx = quad4_max(mx);
        float sum = 0.f;
#pragma unroll
        for (int kb = 0; kb < 8; ++kb)
#pragma unroll
            for (int j = 0; j < 4; ++j) { const float pv = s[kb][j] > -1e29f ? __builtin_amdgcn_exp2f(s[kb][j] - mx) : 0.f; s[kb][j] = pv; sum += pv; }
        sum = quad4_sum(sum);
        const float inv = nv > 0 ? 1.0f / sum : 0.f;
#pragma unroll
        for (int kb = 0; kb < 8; ++kb) s[kb] = s[kb] * inv;
        f32x4_t o[4];
#pragma unroll
        for (int db = 0; db < 4; ++db) o[db] = (f32x4_t){0.f, 0.f, 0.f, 0.f};
        const unsigned vb = (unsigned)(size_t)vt + (unsigned)((4 * q + (r >> 2)) * AT_KS + 8 * (r & 3));
#pragma unroll
        for (int kk = 0; kk < 4; ++kk) if (2 * kk < nkb) { u32x4_t w = (u32x4_t){pack2bf(s[2 * kk][0], s[2 * kk][1]), pack2bf(s[2 * kk][2], s[2 * kk][3]), pack2bf(s[2 * kk + 1][0], s[2 * kk + 1][1]), pack2bf(s[2 * kk + 1][2], s[2 * kk + 1][3])};
            const bf16x8_t pb = __builtin_bit_cast(bf16x8_t, w);
            bf16x4_t l0, l1, l2, l3, h0, h1, h2, h3; const unsigned va = vb + (unsigned)(kk * 32 * AT_KS);
            asm volatile("ds_read_b64_tr_b16 %0, %8\n\tds_read_b64_tr_b16 %1, %8 offset:32\n\tds_read_b64_tr_b16 %2, %8 offset:64\n\tds_read_b64_tr_b16 %3, %8 offset:96\n\t"
                         "ds_read_b64_tr_b16 %4, %8 offset:2304\n\tds_read_b64_tr_b16 %5, %8 offset:2336\n\tds_read_b64_tr_b16 %6, %8 offset:2368\n\tds_read_b64_tr_b16 %7, %8 offset:2400\n\ts_waitcnt lgkmcnt(0)"
                         : "=&v"(l0), "=&v"(l1), "=&v"(l2), "=&v"(l3), "=&v"(h0), "=&v"(h1), "=&v"(h2), "=&v"(h3) : "v"(va) : "memory");
            o[0] = __builtin_amdgcn_mfma_f32_16x16x32_bf16(__builtin_shufflevector(l0, h0, 0, 1, 2, 3, 4, 5, 6, 7), pb, o[0], 0, 0, 0);
            o[1] = __builtin_amdgcn_mfma_f32_16x16x32_bf16(__builtin_shufflevector(l1, h1, 0, 1, 2, 3, 4, 5, 6, 7), pb, o[1], 0, 0, 0);
            o[2] = __builtin_amdgcn_mfma_f32_16x16x32_bf16(__builtin_shufflevector(l2, h2, 0, 1, 2, 3, 4, 5, 6, 7), pb, o[2], 0, 0, 0);
            o[3] = __builtin_amdgcn_mfma_f32_16x16x32_bf16(__builtin_shufflevector(l3, h3, 0, 1, 2, 3, 4, 5, 6, 7), pb, o[3], 0, 0, 0); }
        const float g0 = sigmoidf_(bf2f(P[tok * PW + C_NG + hd * 3]));
#pragma unroll
        for (int db = 0; db < 4; ++db) { uint2 w; w.x = pack2bf(g0 * o[db][0], g0 * o[db][1]); w.y = pack2bf(g0 * o[db][2], g0 * o[db][3]); *(uint2*)(O + tok * 1024 + hd * 64 + 16 * db + 4 * q) = w; }
        unsigned mask;
        if (cur < 8) mask = (2u << cur) - 1u;
        else {
            float imp[8], tcar[8];
#pragma unroll
            for (int kb = 0; kb < 8; ++kb) { imp[kb] = s[kb][0] + s[kb][1] + s[kb][2] + 0.5f * s[kb][3]; tcar[kb] = __shfl(0.5f * s[kb][3], (lane + 48) & 63); }
#pragma unroll
            for (int kb = 0; kb < 8; ++kb) { const float cin = q >= 1 ? tcar[kb] : (kb >= 1 ? tcar[kb >= 1 ? kb - 1 : 0] : 0.f); imp[kb] += cin; imp[kb] += dpp_mov1(imp[kb]); }
            mask = 1u | (1u << cur) | (1u << (cur - 1));
#pragma unroll
            for (int kb = 0; kb < 8; ++kb) { const int jj = 4 * kb + q; if (!(jj >= 1 && jj <= cur - 2)) imp[kb] = -3e38f; }
            for (int rd = 0; rd < 5; ++rd) { float bv = -3e38f; int bi = 1 << 20;
#pragma unroll
                for (int kb = 0; kb < 8; ++kb) if (imp[kb] > bv) { bv = imp[kb]; bi = 4 * kb + q; }
                {
                    float av = bv, cv = bv; int ai = bi, ci = bi;
                    asm volatile("s_nop 1\n\tv_permlane16_swap_b32 %0, %1\n\tv_permlane16_swap_b32 %2, %3" : "+v"(av), "+v"(cv), "+v"(ai), "+v"(ci));
                    bv = av; bi = ai; better2(bv, bi, cv, ci); av = bv; cv = bv; ai = bi; ci = bi;
                    asm volatile("s_nop 1\n\tv_permlane32_swap_b32 %0, %1\n\tv_permlane32_swap_b32 %2, %3" : "+v"(av), "+v"(cv), "+v"(ai), "+v"(ci));
                    bv = av; bi = ai; better2(bv, bi, cv, ci); }
                mask |= 1u << bi;
#pragma unroll
                for (int kb = 0; kb < 8; ++kb) if (bi == 4 * kb + q) imp[kb] = -3e38f; }
        }
        if (q == 0 && (r & 1) == 0) { SELM[tok * 2 + g] = mask; ((volatile LAS unsigned*)(lds + SELM_LDS_OFF))[tl] = mask; }
    }
}
#endif
#ifndef CPU_EMU
typedef float f32x2_t __attribute__((ext_vector_type(2)));
template <int CTRL> __device__ __forceinline__ float dpp_mov(float x) { return __builtin_bit_cast(float, __builtin_amdgcn_update_dpp(0, __builtin_bit_cast(int, x), CTRL, 0xF, 0xF, true)); }
__device__ __forceinline__ float sum8(float x) { x += dpp_mov<0xB1>(x); x += dpp_mov<0x4E>(x); x += dpp_mov<0x141>(x); return x; }
__device__ __forceinline__ float sum16s(float x) { x += __shfl_xor(x, 1); x += __shfl_xor(x, 2); x += __shfl_xor(x, 4); x += __shfl_xor(x, 8); return x; }
constexpr int SC_CH = 32;
constexpr int RW_STEP = 384, RW_BUF = SC_CH * RW_STEP * 4;
constexpr int GL_STEP = 160, GL_BUF = SC_CH * GL_STEP * 4;
__device__ __forceinline__ void cvt8(const uint4& w, float (&f)[8]) { f[0] = u2f(w.x << 16); f[1] = u2f(w.x & 0xffff0000u); f[2] = u2f(w.y << 16); f[3] = u2f(w.y & 0xffff0000u); f[4] = u2f(w.z << 16); f[5] = u2f(w.z & 0xffff0000u); f[6] = u2f(w.w << 16); f[7] = u2f(w.w & 0xffff0000u); }

__device__ __forceinline__ void rwkv_chain(const Params& p, int l, int ch, int wv, LAS unsigned char* lds) {
    int tid = wv * 64 + mk_lane(); asm volatile("" : "+v"(tid));
    const int row = tid >> 3, cg = tid & 7; const long long b = ch >> 2; const int h = ch & 3;
    const float* RWW = WSP(float, p.oRWW); const bf16_t* RWX = WSP(bf16_t, p.oRWX); bf16_t* O = WSP(bf16_t, p.oO); const float* lng = p.in[I_RW_LN] + l * 256 + h * 64; const float* rkw = p.in[I_RW_RK] + l * 256 + h * 64;
    LAS float* YB = (LAS float*)(lds + 2 * RW_BUF);
    const long long tb = b * p.S; const int nch = (int)(p.S / SC_CH);
    float4 gw;
    uint4 gx0, gx1, gx2;
#define RW_GLOAD1(idx_, dst_) do { const int idx = (idx_); if (idx < 1280) { const int step = idx / 40, rem = idx % 40, vec = rem >> 3, c8 = rem & 7; dst_ = *(const uint4*)(RWX + (t0_ + step) * 1280 + vec * 256 + h * 64 + 8 * c8); } } while (0)
#define RW_GLOAD(c_) do { const long long t0_ = tb + (long long)(c_) * SC_CH; gw = *(const float4*)(RWW + (t0_ + (tid >> 4)) * 256 + h * 64 + 4 * (tid & 15)); RW_GLOAD1(tid, gx0); RW_GLOAD1(tid + 512, gx1); RW_GLOAD1(tid + 1024, gx2); } while (0)
#define RW_SSTORE1(idx_, src_) do { const int idx = (idx_); if (idx < 1280) { const int step = idx / 40, rem = idx % 40, vec = rem >> 3, c8 = rem & 7; \
        const int slot = vec == 0 ? 4 : (vec == 1 ? 3 : (vec == 2 ? 5 : (vec == 3 ? 1 : 2))); float f[8]; cvt8(src_, f); LAS float* d = B_ + step * RW_STEP + slot * 64 + 8 * c8; \
        *(LAS f32x4_t*)d = (f32x4_t){f[0], f[1], f[2], f[3]}; *(LAS f32x4_t*)(d + 4) = (f32x4_t){f[4], f[5], f[6], f[7]}; } } while (0)
#define RW_SSTORE(buf_) do { LAS float* B_ = (LAS float*)(lds + (buf_) * RW_BUF); *(LAS f32x4_t*)(B_ + (tid >> 4) * RW_STEP + 4 * (tid & 15)) = (f32x4_t){gw.x, gw.y, gw.z, gw.w}; \
        RW_SSTORE1(tid, gx0); RW_SSTORE1(tid + 512, gx1); RW_SSTORE1(tid + 1024, gx2); } while (0)
    f32x2_t st[4];
#pragma unroll
    for (int i = 0; i < 4; ++i) st[i] = (f32x2_t){0.f, 0.f};
    RW_GLOAD(0); RW_SSTORE(0); __syncthreads();
    for (int c = 0; c < nch; ++c) {
        if (c + 1 < nch) RW_GLOAD(c + 1);
        const LAS float* B = (const LAS float*)(lds + (c & 1) * RW_BUF);
        for (int s = 0; s < SC_CH; ++s) { const LAS float* x = B + s * RW_STEP + 8 * cg;
            f32x2_t w[4], kk[4], bb[4], k[4], r[4];
#pragma unroll
            for (int i = 0; i < 2; ++i) { const f32x4_t a0 = *(const LAS f32x4_t*)(x + 4 * i), a1 = *(const LAS f32x4_t*)(x + 64 + 4 * i), a2 = *(const LAS f32x4_t*)(x + 128 + 4 * i), a3 = *(const LAS f32x4_t*)(x + 192 + 4 * i), a4 = *(const LAS f32x4_t*)(x + 256 + 4 * i);
                w[2 * i] = (f32x2_t){a0[0], a0[1]}; w[2 * i + 1] = (f32x2_t){a0[2], a0[3]}; kk[2 * i] = (f32x2_t){a1[0], a1[1]}; kk[2 * i + 1] = (f32x2_t){a1[2], a1[3]};
                bb[2 * i] = (f32x2_t){a2[0], a2[1]}; bb[2 * i + 1] = (f32x2_t){a2[2], a2[3]}; k[2 * i] = (f32x2_t){a3[0], a3[1]}; k[2 * i + 1] = (f32x2_t){a3[2], a3[3]};
                r[2 * i] = (f32x2_t){a4[0], a4[1]}; r[2 * i + 1] = (f32x2_t){a4[2], a4[3]}; }
            const float v = B[s * RW_STEP + 320 + row];
            f32x2_t a = st[0] * kk[0] + st[1] * kk[1]; a += st[2] * kk[2] + st[3] * kk[3];
            const float skk = sum8(a[0] + a[1]);
            f32x2_t y2 = (f32x2_t){0.f, 0.f};
#pragma unroll
            for (int i = 0; i < 4; ++i) { st[i] = st[i] * w[i] - bb[i] * skk + k[i] * v; y2 += st[i] * r[i]; }
            const float y = sum8(y2[0] + y2[1]);
            if (cg == 0) YB[s * 64 + row] = y; }
        __syncthreads();
        {
            const int s = tid >> 4, v0 = 4 * (tid & 15); const long long t = tb + (long long)c * SC_CH + s;
            const f32x4_t y = *(const LAS f32x4_t*)(YB + s * 64 + v0); const f32x4_t vv = *(const LAS f32x4_t*)(B + s * RW_STEP + 320 + v0);
            const float mean = sum16s(y[0] + y[1] + y[2] + y[3]) * (1.0f / 64.0f);
            const float d0 = y[0] - mean, d1 = y[1] - mean, d2 = y[2] - mean, d3 = y[3] - mean;
            const float var = sum16s(d0 * d0 + d1 * d1 + d2 * d2 + d3 * d3) * (1.0f / 64.0f), rstd = rsqrtf(var + 64e-5f);
            const f32x4_t rr = *(const LAS f32x4_t*)(B + s * RW_STEP + 256 + v0), kq = *(const LAS f32x4_t*)(B + s * RW_STEP + 192 + v0); const float4 rw4 = *(const float4*)(rkw + v0);
            const float rk = sum16s(rr[0] * kq[0] * rw4.x + rr[1] * kq[1] * rw4.y + rr[2] * kq[2] * rw4.z + rr[3] * kq[3] * rw4.w);
            bf16_t* o = O + t * 1024 + 512 + h * 64 + v0; const uint2 g = *(const uint2*)o; const float4 ln = *(const float4*)(lng + v0);
            const float r0 = (d0 * rstd * ln.x + rk * vv[0]) * u2f(g.x << 16), r1 = (d1 * rstd * ln.y + rk * vv[1]) * u2f(g.x & 0xffff0000u);
            const float r2 = (d2 * rstd * ln.z + rk * vv[2]) * u2f(g.y << 16), r3 = (d3 * rstd * ln.w + rk * vv[3]) * u2f(g.y & 0xffff0000u);
            uint2 w; w.x = pack2bf(r0, r1); w.y = pack2bf(r2, r3); *(uint2*)o = w; }
        if (c + 1 < nch) RW_SSTORE((c + 1) & 1);
        __syncthreads();
    }
}
__device__ __forceinline__ void gla_chain(const Params& p, int l, int ch, int wv, LAS unsigned char* lds) {
    int tid = wv * 64 + mk_lane(); asm volatile("" : "+v"(tid));
    const int vc = tid >> 3, kg = tid & 7; const long long b = ch >> 2; const int h = ch & 3;
    const bf16_t* P = WSP(bf16_t, p.oP); const float* GA = WSP(float, p.oGA); bf16_t* O = WSP(bf16_t, p.oO); const float* ng = p.in[I_GLA_NORM] + l * 64;
    LAS float* OB = (LAS float*)(lds + 2 * GL_BUF);
    const long long tb = b * p.S; const int nch = (int)(p.S / SC_CH);
    float4 ga; uint4 g1, g2;
#define GL_GLOAD(c_) do { const long long t0_ = tb + (long long)(c_) * SC_CH; \
        if (tid < 256) { const int step = tid >> 3, c4 = tid & 7; ga = *(const float4*)(GA + (t0_ + step) * 128 + h * 32 + 4 * c4); g1 = *(const uint4*)(P + (t0_ + step) * PW + C_GLA + 256 + h * 64 + 8 * c4); } \
        else { const int idx = tid - 256, step = idx >> 3, vec = (idx >> 2) & 1, c8 = idx & 3; g2 = *(const uint4*)(P + (t0_ + step) * PW + C_GLA + vec * 128 + h * 32 + 8 * c8); } } while (0)
#define GL_SSTORE(buf_) do { LAS float* B_ = (LAS float*)(lds + (buf_) * GL_BUF); float f[8]; \
        if (tid < 256) { const int step = tid >> 3, c4 = tid & 7; *(LAS f32x4_t*)(B_ + step * GL_STEP + 4 * c4) = (f32x4_t){ga.x, ga.y, ga.z, ga.w}; \
            cvt8(g1, f); LAS float* d = B_ + step * GL_STEP + 96 + 8 * c4; *(LAS f32x4_t*)d = (f32x4_t){f[0], f[1], f[2], f[3]}; *(LAS f32x4_t*)(d + 4) = (f32x4_t){f[4], f[5], f[6], f[7]}; } \
        else { const int idx = tid - 256, step = idx >> 3, vec = (idx >> 2) & 1, c8 = idx & 3; \
            cvt8(g2, f); LAS float* d = B_ + step * GL_STEP + (vec == 0 ? 64 : 32) + 8 * c8; *(LAS f32x4_t*)d = (f32x4_t){f[0], f[1], f[2], f[3]}; *(LAS f32x4_t*)(d + 4) = (f32x4_t){f[4], f[5], f[6], f[7]}; } } while (0)
    f32x4_t st = (f32x4_t){0.f, 0.f, 0.f, 0.f};
    GL_GLOAD(0); GL_SSTORE(0); __syncthreads();
    for (int c = 0; c < nch; ++c) {
        if (c + 1 < nch) GL_GLOAD(c + 1);
        const LAS float* B = (const LAS float*)(lds + (c & 1) * GL_BUF);
        for (int s = 0; s < SC_CH; ++s) { const LAS float* x = B + s * GL_STEP + 4 * kg;
            const f32x4_t a = *(const LAS f32x4_t*)x, k = *(const LAS f32x4_t*)(x + 32), qv = *(const LAS f32x4_t*)(x + 64); const float v = B[s * GL_STEP + 96 + vc];
            st = st * a + k * v; const f32x4_t pq = st * qv;
            const float o = sum8((pq[0] + pq[1]) + (pq[2] + pq[3]));
            if (kg == 0) OB[s * 64 + vc] = o * 0.17677669529663687f; }
        __syncthreads();
        {   const int s = tid >> 4, v0 = 4 * (tid & 15); const long long t = tb + (long long)c * SC_CH + s;
            const f32x4_t o = *(const LAS f32x4_t*)(OB + s * 64 + v0);
            const float ms = sum16s(o[0] * o[0] + o[1] * o[1] + o[2] * o[2] + o[3] * o[3]) * (1.0f / 64.0f), rs = rsqrtf(ms + 1e-6f);
            bf16_t* d = O + t * 1024 + 768 + h * 64 + v0; const uint2 g = *(const uint2*)d; const float4 n4 = *(const float4*)(ng + v0);
            uint2 w; w.x = pack2bf(o[0] * rs * n4.x * u2f(g.x << 16), o[1] * rs * n4.y * u2f(g.x & 0xffff0000u)); w.y = pack2bf(o[2] * rs * n4.z * u2f(g.y << 16), o[3] * rs * n4.w * u2f(g.y & 0xffff0000u)); *(uint2*)d = w; }
        if (c + 1 < nch) GL_SSTORE((c + 1) & 1);
        __syncthreads();
    }
}
struct RwFrags { bf16x8_t w[2], a[2], v[2], g[2][2]; };
__device__ __forceinline__ void rwkv_load_frags(const LAS unsigned* wl, int wv, RwFrags& fr) {
    const int lane = mk_lane(), r = lane & 15, q = lane >> 4;
#pragma unroll
    for (int cb = 0; cb < 2; ++cb) { const LAS unsigned* c = wl + 32 * wv + 16 * cb + r;
#define RW_FRAG(dst, pbase) do { uint4 k_; k_.x = c[((pbase) + 4 * q) * 256]; k_.y = c[((pbase) + 4 * q + 1) * 256]; k_.z = c[((pbase) + 4 * q + 2) * 256]; k_.w = c[((pbase) + 4 * q + 3) * 256]; dst = __builtin_bit_cast(bf16x8_t, k_); } while (0)
        RW_FRAG(fr.w[cb], 0); RW_FRAG(fr.a[cb], 16); RW_FRAG(fr.v[cb], 32); RW_FRAG(fr.g[cb][0], 48); RW_FRAG(fr.g[cb][1], 64);
#undef RW_FRAG
    }
}
__device__ __forceinline__ void rwkv_lowrank_mfma(int l, const RwFrags& fr, const LAS unsigned* FP, LAS float* Z, int wv) {
    const int lane = mk_lane(), r = lane & 15, q = lane >> 4; const f32x4_t z4 = (f32x4_t){0.f, 0.f, 0.f, 0.f};
#pragma unroll
    for (int tb = 0; tb < 2; ++tb) { const LAS unsigned* f = FP + (16 * tb + r) * 80 + 4 * q;
        const bf16x8_t fw = __builtin_bit_cast(bf16x8_t, *(const LAS u32x4_t*)(f)), fa = __builtin_bit_cast(bf16x8_t, *(const LAS u32x4_t*)(f + 16)), fv = __builtin_bit_cast(bf16x8_t, *(const LAS u32x4_t*)(f + 32)),
                       fg0 = __builtin_bit_cast(bf16x8_t, *(const LAS u32x4_t*)(f + 48)), fg1 = __builtin_bit_cast(bf16x8_t, *(const LAS u32x4_t*)(f + 64));
#pragma unroll
        for (int cb = 0; cb < 2; ++cb) { LAS float* z = Z + (16 * tb + r) * 256 + 32 * wv + 16 * cb + 4 * q;
            *(LAS f32x4_t*)(z) = __builtin_amdgcn_mfma_f32_16x16x32_bf16(fr.w[cb], fw, z4, 0, 0, 0);
            *(LAS f32x4_t*)(z + 1 * 32 * 256) = __builtin_amdgcn_mfma_f32_16x16x32_bf16(fr.a[cb], fa, z4, 0, 0, 0);
            if (l == 1) *(LAS f32x4_t*)(z + 2 * 32 * 256) = __builtin_amdgcn_mfma_f32_16x16x32_bf16(fr.v[cb], fv, z4, 0, 0, 0);
            *(LAS f32x4_t*)(z + 3 * 32 * 256) = __builtin_amdgcn_mfma_f32_16x16x32_bf16(fr.g[cb][1], fg1, __builtin_amdgcn_mfma_f32_16x16x32_bf16(fr.g[cb][0], fg0, z4, 0, 0, 0), 0, 0, 0); } }
}
__device__ __forceinline__ void pool_gpu(const Params& p, int l, int wv, LAS unsigned char* lds, int gC, int gG) {
    int tid = wv * 64 + mk_lane(); asm volatile("" : "+v"(tid)); const int lane = tid & 63, r = lane & 15, q = lane >> 4;
    const bf16_t* P = WSP(bf16_t, p.oP); bf16_t* O = WSP(bf16_t, p.oO);
    LAS float* wl = (LAS float*)lds;
    __syncthreads(); pool_fill_w(p, l, wl, tid, 512); __syncthreads();
    const int g = wv < 4 ? 3 : (wv < 6 ? 2 : (wv == 6 ? 1 : 0)), ntw = wv < 4 ? 2 : (wv < 6 ? 4 : 8), toff = wv < 4 ? 2 * wv : (wv < 6 ? 4 * (wv - 4) : 0), WIN = 2 << g;
    bf16x8_t wa[4][2];
#pragma unroll
    for (int db = 0; db < 4; ++db)
#pragma unroll
        for (int ks = 0; ks < 2; ++ks) { const LAS float* w = wl + g * 4096 + (32 * ks + 8 * q) * 64 + 16 * db + r; uint4 pk;
            pk.x = pk2bf(w[0], w[64]); pk.y = pk2bf(w[128], w[192]); pk.z = pk2bf(w[256], w[320]); pk.w = pk2bf(w[384], w[448]); wa[db][ks] = __builtin_bit_cast(bf16x8_t, pk); }
    float ps[4][4];
#pragma unroll
    for (int db = 0; db < 4; ++db) { const float4 f = *(const float4*)(p.in[I_POOL_SCALE] + (long long)l * 256 + g * 64 + 16 * db + 4 * q); ps[db][0] = f.x; ps[db][1] = f.y; ps[db][2] = f.z; ps[db][3] = f.w; }
    const long long ntile = p.T >> 4;
    for (long long tb8 = (long long)gC * 8; tb8 < ntile; tb8 += (long long)gG * 8) for (int kt = 0; kt < ntw; ++kt) { const long long tile = tb8 + toff + kt; if (tile >= ntile) break; const long long t = tile * 16 + r; const long long s = t % p.S; const int cnt = (int)(s + 1 < WIN ? s + 1 : WIN); const float inv = 1.0f / (float)cnt;
        bf16x8_t xb[2];
#pragma unroll
        for (int ks = 0; ks < 2; ++ks) { const bf16_t* src = P + t * PW + C_POOL + g * 64 + 32 * ks + 8 * q; float f0[8], dv[8]; ld8(src, f0);
#pragma unroll
            for (int j = 0; j < 8; ++j) dv[j] = f0[j];
            for (int k = 1; k < WIN; ++k) if (k < cnt) { float f[8]; ld8(src - (long long)k * PW, f);
#pragma unroll
                for (int j = 0; j < 8; ++j) dv[j] += f[j]; }
            uint4 pk; pk.x = pk2bf(dv[0] * inv - f0[0], dv[1] * inv - f0[1]); pk.y = pk2bf(dv[2] * inv - f0[2], dv[3] * inv - f0[3]); pk.z = pk2bf(dv[4] * inv - f0[4], dv[5] * inv - f0[5]); pk.w = pk2bf(dv[6] * inv - f0[6], dv[7] * inv - f0[7]);
            xb[ks] = __builtin_bit_cast(bf16x8_t, pk); }
#pragma unroll
        for (int db = 0; db < 4; ++db) { f32x4_t acc = (f32x4_t){0.f, 0.f, 0.f, 0.f};
            acc = __builtin_amdgcn_mfma_f32_16x16x32_bf16(wa[db][0], xb[0], acc, 0, 0, 0); acc = __builtin_amdgcn_mfma_f32_16x16x32_bf16(wa[db][1], xb[1], acc, 0, 0, 0);
            uint2 w; w.x = pk2bf(acc[0] * ps[db][0], acc[1] * ps[db][1]); w.y = pk2bf(acc[2] * ps[db][2], acc[3] * ps[db][3]);
            *(uint2*)(O + t * 1024 + 256 + g * 64 + 16 * db + 4 * q) = w; } }
    __syncthreads();
}
__device__ __forceinline__ void compress2_gpu(const Params& p, int l, int wv, LAS unsigned char* lds, int gC, int gG) {
    int tid = wv * 64 + mk_lane(); asm volatile("" : "+v"(tid)); const int lane = tid & 63;
    const bf16_t* UV = WSP(bf16_t, p.oUV); const float* CB = WSP(float, p.oCB) + l * 256; const float* w2 = p.in[I_CMP_W2] + (long long)l * 2 * 128 * 64; const float* R = WSP(float, p.oROPE);
    bf16_t* KC = WSP(bf16_t, p.oKCMP); bf16_t* VC = WSP(bf16_t, p.oVCMP);
    const long long hb = p.S / 16, gtid = (long long)gC * 512 + tid, gsz = (long long)gG * 512;
    LAS float* WL = (LAS float*)lds;
    __syncthreads();
    for (int i = tid; i < 2 * 128 * 64; i += 512) WL[i] = w2[i];
    for (long long i = gtid; i < p.B * 2 * (128 - p.NC) * 64; i += gsz) { const long long bgi = i / ((128 - p.NC) * 64), rem = i % ((128 - p.NC) * 64); KC[(bgi * 128 + p.NC) * 64 + rem] = 0; VC[(bgi * 128 + p.NC) * 64 + rem] = 0; }
    __syncthreads();
    const long long rows = p.B * p.NC * 4;
    for (long long row = (long long)gC * 8 + wv; row < rows; row += (long long)gG * 8) { const int j = (int)(row & 1), g = (int)((row >> 1) & 1); const long long bn = row >> 2, n = bn % p.NC, b = bn / p.NC;
        const bf16_t* u = UV + ((b * hb + n) * 4 + (2 * j + g)) * 256; const bf16_t* vv = u + 4 * 256 + 128; const float* cb = CB + j * 128;
        const float hv0 = gelu_tanhf_(bf2f(u[lane]) + bf2f(vv[lane]) + cb[lane]), hv1 = gelu_tanhf_(bf2f(u[64 + lane]) + bf2f(vv[64 + lane]) + cb[64 + lane]);
        const LAS float* w = WL + j * 8192 + lane; float a = 0.f;
#pragma unroll 16
        for (int f = 0; f < 64; ++f) a += __builtin_bit_cast(float, __builtin_amdgcn_readlane(__builtin_bit_cast(int, hv0), f)) * w[f * 64];
#pragma unroll 16
        for (int f = 0; f < 64; ++f) a += __builtin_bit_cast(float, __builtin_amdgcn_readlane(__builtin_bit_cast(int, hv1), f)) * w[(64 + f) * 64];
        if (j == 0) { const float pa = dpp_mov<0x128>(a);
            if (lane < 16) { const float* r = R + (b * p.S + n * 16 + 31) * 16; const float cs = r[lane & 7], sn = r[8 + (lane & 7)]; a = lane < 8 ? a * cs - pa * sn : a * cs + pa * sn; } }
        bf16_t* dst = (j == 0 ? KC : VC) + (((b * 2 + g) * 128) + n) * 64;
        dst[lane] = f2bf(a); }
}
__device__ __forceinline__ float sum16d(float x) { x += dpp_mov<0xB1>(x); x += dpp_mov<0x4E>(x); x += dpp_mov<0x141>(x); x += dpp_mov<0x140>(x); return x; }
__device__ __forceinline__ void norm_router_256(const Params& p, int l, long long r0, int wv, LAS unsigned char* lds) {
    int tid = wv * 64 + mk_lane(); asm volatile("" : "+v"(tid)); const int lane = tid & 63;
    const float* router = p.in[I_MOE_R]; const float* gain = p.in[I_NORM_FFN] + l * 1024;
    const bf16_t* X = WSP(bf16_t, p.oH) + r0 * 1024; bf16_t* D = (bf16_t*)p.out + r0 * 1024; int* TE = WSP(int, p.oTOKE) + r0 * 2; float* TW = WSP(float, p.oTOKW) + r0 * 2;
    LAS float* WL = (LAS float*)lds;
    __syncthreads();
    for (int i = tid; i < 8192; i += 512) WL[(i & 7) * 1024 + (i >> 3)] = router[i];
    __syncthreads();
    uint2 raw[4][4];
#pragma unroll
    for (int r = 0; r < 4; ++r)
#pragma unroll
        for (int j = 0; j < 4; ++j) raw[r][j] = *(const uint2*)(X + (long long)(wv * 32 + r) * 1024 + j * 256 + lane * 4);
#pragma nounroll
    for (int it = 0; it < 8; ++it) { const int rb = wv * 32 + it * 4;
        float v[4][16];
#pragma unroll
        for (int r = 0; r < 4; ++r)
#pragma unroll
            for (int j = 0; j < 4; ++j) { const uint2 w = raw[r][j];
                v[r][4 * j] = u2f(w.x << 16); v[r][4 * j + 1] = u2f(w.x & 0xffff0000u); v[r][4 * j + 2] = u2f(w.y << 16); v[r][4 * j + 3] = u2f(w.y & 0xffff0000u); }
        { const int rn = it < 7 ? rb + 4 : rb;
#pragma unroll
          for (int r = 0; r < 4; ++r)
#pragma unroll
              for (int j = 0; j < 4; ++j) raw[r][j] = *(const uint2*)(X + (long long)(rn + r) * 1024 + j * 256 + lane * 4); }
#pragma unroll
        for (int r = 0; r < 4; ++r) { float ss = v[r][0] * v[r][0];
#pragma unroll
            for (int j = 1; j < 16; ++j) ss += v[r][j] * v[r][j];
            ss = wave_sum(ss); const float rs = rsqrtf(ss * (1.0f / 1024.0f) + 1e-6f);
#pragma unroll
            for (int j = 0; j < 4; ++j) { const float4 f = *(const float4*)(gain + j * 256 + lane * 4);
                v[r][4 * j] *= rs * f.x; v[r][4 * j + 1] *= rs * f.y; v[r][4 * j + 2] *= rs * f.z; v[r][4 * j + 3] *= rs * f.w;
                uint2 w; w.x = pk2bf(v[r][4 * j], v[r][4 * j + 1]); w.y = pk2bf(v[r][4 * j + 2], v[r][4 * j + 3]); *(uint2*)(D + (long long)(rb + r) * 1024 + j * 256 + lane * 4) = w; } }
        float acc[32];
#pragma unroll
        for (int j = 0; j < 4; ++j)
#pragma unroll
            for (int e = 0; e < 8; ++e) { const f32x4_t w = *(const LAS f32x4_t*)(WL + e * 1024 + j * 256 + lane * 4);
#pragma unroll
                for (int r = 0; r < 4; ++r) { const float t = (v[r][4 * j] * w[0] + v[r][4 * j + 1] * w[1]) + (v[r][4 * j + 2] * w[2] + v[r][4 * j + 3] * w[3]); acc[r * 8 + e] = j == 0 ? t : acc[r * 8 + e] + t; } }
        float x16[16];
#pragma unroll
        for (int i = 0; i < 16; ++i) { float a = acc[i], b = acc[i + 16]; asm("s_nop 1\n\tv_permlane32_swap_b32 %0, %1" : "+v"(a), "+v"(b)); x16[i] = a + b; }
        const bool hi16 = (lane & 16) != 0; float lg[8];
#pragma unroll
        for (int i = 0; i < 8; ++i) { const float send = hi16 ? x16[i] : x16[i + 8], keep = hi16 ? x16[i + 8] : x16[i]; float a = send, b = send; asm("s_nop 1\n\tv_permlane16_swap_b32 %0, %1" : "+v"(a), "+v"(b));
            lg[i] = sum16d(keep + u2f(f2u(a) ^ f2u(b) ^ f2u(send))); }
        int i0 = 0; float v0 = lg[0];
#pragma unroll
        for (int e = 1; e < 8; ++e) if (lg[e] > v0) { v0 = lg[e]; i0 = e; }
        int i1 = -1; float v1 = -3e38f;
#pragma unroll
        for (int e = 0; e < 8; ++e) if (e != i0 && lg[e] > v1) { v1 = lg[e]; i1 = e; }
        const float w0 = 1.0f / (1.0f + expf(v1 - v0));
        if ((lane & 15) == 0) { const int rr = rb + (lane >> 4); TE[rr * 2] = i0; TE[rr * 2 + 1] = i1; TW[rr * 2] = w0; TW[rr * 2 + 1] = 1.0f - w0; } }
}
constexpr int PC_GL0 = 2 * RW_BUF + 8192, PC_OB = PC_GL0 + 2 * GL_BUF, PC_LDS = PC_OB + 8192;
__device__ __forceinline__ void pair_chain(const Params& p, int l, int ch, int wv, LAS unsigned char* lds) {
    int tid = wv * 64 + mk_lane(); asm volatile("" : "+v"(tid));
    const long long b = ch >> 2; const int h = ch & 3; const long long tb = b * p.S; const int nch = (int)(p.S / SC_CH);
    bf16_t* O = WSP(bf16_t, p.oO);
    if (wv < 4) {
        const int rp = tid >> 3, cg = tid & 7;
        const float* RWW = WSP(float, p.oRWW); const bf16_t* RWX = WSP(bf16_t, p.oRWX); const float* lng = p.in[I_RW_LN] + l * 256 + h * 64; const float* rkw = p.in[I_RW_RK] + l * 256 + h * 64;
        LAS float* YB = (LAS float*)(lds + 2 * RW_BUF);
        float4 gw0, gw1; uint4 gx0, gx1, gx2, gx3, gx4;
#define PR_GLOAD1(idx_, dst_) do { const int idx = (idx_); const int step = idx / 40, rem = idx % 40, vec = rem >> 3, c8 = rem & 7; dst_ = *(const uint4*)(RWX + (t0_ + step) * 1280 + vec * 256 + h * 64 + 8 * c8); } while (0)
#define PR_GLOAD(c_) do { const long long t0_ = tb + (long long)(c_) * SC_CH; gw0 = *(const float4*)(RWW + (t0_ + (tid >> 4)) * 256 + h * 64 + 4 * (tid & 15)); gw1 = *(const float4*)(RWW + (t0_ + 16 + (tid >> 4)) * 256 + h * 64 + 4 * (tid & 15)); \
            PR_GLOAD1(tid, gx0); PR_GLOAD1(tid + 256, gx1); PR_GLOAD1(tid + 512, gx2); PR_GLOAD1(tid + 768, gx3); PR_GLOAD1(tid + 1024, gx4); } while (0)
#define PR_SSTORE1(idx_, src_) do { const int idx = (idx_); const int step = idx / 40, rem = idx % 40, vec = rem >> 3, c8 = rem & 7; \
            const int slot = vec == 0 ? 4 : (vec == 1 ? 3 : (vec == 2 ? 5 : (vec == 3 ? 1 : 2))); float f[8]; cvt8(src_, f); LAS float* d = B_ + step * RW_STEP + slot * 64 + 8 * c8; \
            *(LAS f32x4_t*)d = (f32x4_t){f[0], f[1], f[2], f[3]}; *(LAS f32x4_t*)(d + 4) = (f32x4_t){f[4], f[5], f[6], f[7]}; } while (0)
#define PR_SSTORE(buf_) do { LAS float* B_ = (LAS float*)(lds + (buf_) * RW_BUF); *(LAS f32x4_t*)(B_ + (tid >> 4) * RW_STEP + 4 * (tid & 15)) = (f32x4_t){gw0.x, gw0.y, gw0.z, gw0.w}; \
            *(LAS f32x4_t*)(B_ + (16 + (tid >> 4)) * RW_STEP + 4 * (tid & 15)) = (f32x4_t){gw1.x, gw1.y, gw1.z, gw1.w}; \
            PR_SSTORE1(tid, gx0); PR_SSTORE1(tid + 256, gx1); PR_SSTORE1(tid + 512, gx2); PR_SSTORE1(tid + 768, gx3); PR_SSTORE1(tid + 1024, gx4); } while (0)
        f32x2_t s0[4], s1[4];
#pragma unroll
        for (int i = 0; i < 4; ++i) { s0[i] = (f32x2_t){0.f, 0.f}; s1[i] = (f32x2_t){0.f, 0.f}; }
        float lnw[8], rkv[8]; uint4 gpre;
        {   const float4 a0 = *(const float4*)(lng + 8 * (tid & 7)), a1 = *(const float4*)(lng + 8 * (tid & 7) + 4), b0 = *(const float4*)(rkw + 8 * (tid & 7)), b1 = *(const float4*)(rkw + 8 * (tid & 7) + 4);
            lnw[0] = a0.x; lnw[1] = a0.y; lnw[2] = a0.z; lnw[3] = a0.w; lnw[4] = a1.x; lnw[5] = a1.y; lnw[6] = a1.z; lnw[7] = a1.w; rkv[0] = b0.x; rkv[1] = b0.y; rkv[2] = b0.z; rkv[3] = b0.w; rkv[4] = b1.x; rkv[5] = b1.y; rkv[6] = b1.z; rkv[7] = b1.w; }
        PR_GLOAD(0); PR_SSTORE(0); __syncthreads();
        for (int c = 0; c < nch; ++c) {
            gpre = *(const uint4*)(O + (tb + (long long)c * SC_CH + (tid >> 3)) * 1024 + 512 + h * 64 + 8 * (tid & 7));
            if (c + 1 < nch) PR_GLOAD(c + 1);
            const LAS float* B = (const LAS float*)(lds + (c & 1) * RW_BUF);
#define PR_LD(R_, V_, s_) do { const LAS float* x = B + (s_) * RW_STEP + 8 * cg; \
                R_[0] = *(const LAS f32x4_t*)(x); R_[1] = *(const LAS f32x4_t*)(x + 64); R_[2] = *(const LAS f32x4_t*)(x + 128); R_[3] = *(const LAS f32x4_t*)(x + 192); R_[4] = *(const LAS f32x4_t*)(x + 256); \
                R_[5] = *(const LAS f32x4_t*)(x + 4); R_[6] = *(const LAS f32x4_t*)(x + 68); R_[7] = *(const LAS f32x4_t*)(x + 132); R_[8] = *(const LAS f32x4_t*)(x + 196); R_[9] = *(const LAS f32x4_t*)(x + 260); \
                V_ = *(const LAS f32x2_t*)(B + (s_) * RW_STEP + 320 + 2 * rp); } while (0)
#define PR_STEP(R_, V_, s_) do { f32x2_t w[4], kk[4], bb[4], k[4], r[4]; \
                _Pragma("unroll") for (int i = 0; i < 2; ++i) { const f32x4_t a0 = R_[5 * i], a1 = R_[5 * i + 1], a2 = R_[5 * i + 2], a3 = R_[5 * i + 3], a4 = R_[5 * i + 4]; \
                    w[2 * i] = (f32x2_t){a0[0], a0[1]}; w[2 * i + 1] = (f32x2_t){a0[2], a0[3]}; kk[2 * i] = (f32x2_t){a1[0], a1[1]}; kk[2 * i + 1] = (f32x2_t){a1[2], a1[3]}; \
                    bb[2 * i] = (f32x2_t){a2[0], a2[1]}; bb[2 * i + 1] = (f32x2_t){a2[2], a2[3]}; k[2 * i] = (f32x2_t){a3[0], a3[1]}; k[2 * i + 1] = (f32x2_t){a3[2], a3[3]}; \
                    r[2 * i] = (f32x2_t){a4[0], a4[1]}; r[2 * i + 1] = (f32x2_t){a4[2], a4[3]}; } \
                f32x2_t a = s0[0] * kk[0] + s0[1] * kk[1]; a += s0[2] * kk[2] + s0[3] * kk[3]; \
                f32x2_t c2 = s1[0] * kk[0] + s1[1] * kk[1]; c2 += s1[2] * kk[2] + s1[3] * kk[3]; \
                const float skk0 = sum8(a[0] + a[1]), skk1 = sum8(c2[0] + c2[1]); \
                f32x2_t y0 = (f32x2_t){0.f, 0.f}, y1 = (f32x2_t){0.f, 0.f}; \
                _Pragma("unroll") for (int i = 0; i < 4; ++i) { s0[i] = s0[i] * w[i] - bb[i] * skk0 + k[i] * V_[0]; y0 += s0[i] * r[i]; s1[i] = s1[i] * w[i] - bb[i] * skk1 + k[i] * V_[1]; y1 += s1[i] * r[i]; } \
                const float ya = sum8(y0[0] + y0[1]), yb = sum8(y1[0] + y1[1]); \
                if (cg == 0) *(LAS f32x2_t*)(YB + (s_) * 64 + 2 * rp) = (f32x2_t){ya, yb}; } while (0)
            {   f32x4_t RA[10], RB[10]; f32x2_t VA, VB;
                PR_LD(RA, VA, 0); __builtin_amdgcn_sched_barrier(0);
#pragma nounroll
                for (int s = 0; s < SC_CH; s += 2) {
                    PR_LD(RB, VB, s + 1); __builtin_amdgcn_sched_barrier(0);
                    PR_STEP(RA, VA, s); __builtin_amdgcn_sched_barrier(0);
                    { const int sn = s + 2 < SC_CH ? s + 2 : SC_CH - 1; PR_LD(RA, VA, sn); } __builtin_amdgcn_sched_barrier(0);
                    PR_STEP(RB, VB, s + 1); __builtin_amdgcn_sched_barrier(0); } }
#undef PR_LD
#undef PR_STEP
            __syncthreads();
            {
                const int s = tid >> 3, v0 = 8 * (tid & 7); const long long t = tb + (long long)c * SC_CH + s;
                float y[8], vv[8], rr[8], kq[8];
#pragma unroll
                for (int i = 0; i < 2; ++i) { const f32x4_t ty = *(const LAS f32x4_t*)(YB + s * 64 + v0 + 4 * i), tv = *(const LAS f32x4_t*)(B + s * RW_STEP + 320 + v0 + 4 * i), tr = *(const LAS f32x4_t*)(B + s * RW_STEP + 256 + v0 + 4 * i), tk = *(const LAS f32x4_t*)(B + s * RW_STEP + 192 + v0 + 4 * i);
#pragma unroll
                    for (int j = 0; j < 4; ++j) { y[4 * i + j] = ty[j]; vv[4 * i + j] = tv[j]; rr[4 * i + j] = tr[j]; kq[4 * i + j] = tk[j]; } }
                float sm = 0.f, rkp = 0.f;
#pragma unroll
                for (int j = 0; j < 8; ++j) { sm += y[j]; rkp += rr[j] * kq[j] * rkv[j]; }
                const float mean = sum8(sm) * (1.0f / 64.0f); float vs = 0.f;
#pragma unroll
                for (int j = 0; j < 8; ++j) { y[j] -= mean; vs += y[j] * y[j]; }
                const float rstd = rsqrtf(sum8(vs) * (1.0f / 64.0f) + 64e-5f), rk = sum8(rkp);
                bf16_t* o = O + t * 1024 + 512 + h * 64 + v0; float g[8], res[8]; cvt8(gpre, g);
#pragma unroll
                for (int j = 0; j < 8; ++j) res[j] = (y[j] * rstd * lnw[j] + rk * vv[j]) * g[j];
                st8(o, res); }
            if (c + 1 < nch) PR_SSTORE((c + 1) & 1);
            __syncthreads();
        }
#undef PR_GLOAD1
#undef PR_GLOAD
#undef PR_SSTORE1
#undef PR_SSTORE
    } else {
        const int t = tid - 256, vp = t >> 3, kg = t & 7;
        const bf16_t* P = WSP(bf16_t, p.oP); const float* GA = WSP(float, p.oGA); const float* ng = p.in[I_GLA_NORM] + l * 64;
        LAS float* OB = (LAS float*)(lds + PC_OB);
        float4 ga; uint4 g1, g2;
#define PG_GLOAD(c_) do { const long long t0_ = tb + (long long)(c_) * SC_CH; const int step = t >> 3; \
            ga = *(const float4*)(GA + (t0_ + step) * 128 + h * 32 + 4 * (t & 7)); g1 = *(const uint4*)(P + (t0_ + step) * PW + C_GLA + 256 + h * 64 + 8 * (t & 7)); \
            g2 = *(const uint4*)(P + (t0_ + step) * PW + C_GLA + ((t >> 2) & 1) * 128 + h * 32 + 8 * (t & 3)); } while (0)
#define PG_SSTORE(buf_) do { LAS float* B_ = (LAS float*)(lds + PC_GL0 + (buf_) * GL_BUF); float f[8]; const int step = t >> 3; \
            *(LAS f32x4_t*)(B_ + step * GL_STEP + 4 * (t & 7)) = (f32x4_t){ga.x, ga.y, ga.z, ga.w}; \
            cvt8(g1, f); { LAS float* d = B_ + step * GL_STEP + 96 + 8 * (t & 7); *(LAS f32x4_t*)d = (f32x4_t){f[0], f[1], f[2], f[3]}; *(LAS f32x4_t*)(d + 4) = (f32x4_t){f[4], f[5], f[6], f[7]}; } \
            cvt8(g2, f); { LAS float* d = B_ + step * GL_STEP + (((t >> 2) & 1) == 0 ? 64 : 32) + 8 * (t & 3); *(LAS f32x4_t*)d = (f32x4_t){f[0], f[1], f[2], f[3]}; *(LAS f32x4_t*)(d + 4) = (f32x4_t){f[4], f[5], f[6], f[7]}; } } while (0)
        f32x4_t q0 = (f32x4_t){0.f, 0.f, 0.f, 0.f}, q1 = q0;
        float ngw[8]; uint4 gpre;
        {   const float4 a0 = *(const float4*)(ng + 8 * (t & 7)), a1 = *(const float4*)(ng + 8 * (t & 7) + 4); ngw[0] = a0.x; ngw[1] = a0.y; ngw[2] = a0.z; ngw[3] = a0.w; ngw[4] = a1.x; ngw[5] = a1.y; ngw[6] = a1.z; ngw[7] = a1.w; }
        PG_GLOAD(0); PG_SSTORE(0); __syncthreads();
        for (int c = 0; c < nch; ++c) {
            gpre = *(const uint4*)(O + (tb + (long long)c * SC_CH + (t >> 3)) * 1024 + 768 + h * 64 + 8 * (t & 7));
            if (c + 1 < nch) PG_GLOAD(c + 1);
            const LAS float* B = (const LAS float*)(lds + PC_GL0 + (c & 1) * GL_BUF);
#define PG_LD(R_, V_, s_) do { const LAS float* x = B + (s_) * GL_STEP + 4 * kg; R_[0] = *(const LAS f32x4_t*)x; R_[1] = *(const LAS f32x4_t*)(x + 32); R_[2] = *(const LAS f32x4_t*)(x + 64); V_ = *(const LAS f32x2_t*)(B + (s_) * GL_STEP + 96 + 2 * vp); } while (0)
#define PG_STEP(R_, V_, s_) do { q0 = q0 * R_[0] + R_[1] * V_[0]; q1 = q1 * R_[0] + R_[1] * V_[1]; const f32x4_t p0 = q0 * R_[2], p1 = q1 * R_[2]; \
                const float o0 = sum8((p0[0] + p0[1]) + (p0[2] + p0[3])), o1 = sum8((p1[0] + p1[1]) + (p1[2] + p1[3])); \
                if (kg == 0) *(LAS f32x2_t*)(OB + (s_) * 64 + 2 * vp) = (f32x2_t){o0 * 0.17677669529663687f, o1 * 0.17677669529663687f}; } while (0)
            {   f32x4_t RA[3], RB[3]; f32x2_t VA, VB;
                PG_LD(RA, VA, 0); __builtin_amdgcn_sched_barrier(0);
#pragma nounroll
                for (int s = 0; s < SC_CH; s += 2) {
                    PG_LD(RB, VB, s + 1); __builtin_amdgcn_sched_barrier(0);
                    PG_STEP(RA, VA, s); __builtin_amdgcn_sched_barrier(0);
                    { const int sn = s + 2 < SC_CH ? s + 2 : SC_CH - 1; PG_LD(RA, VA, sn); } __builtin_amdgcn_sched_barrier(0);
                    PG_STEP(RB, VB, s + 1); __builtin_amdgcn_sched_barrier(0); } }
#undef PG_LD
#undef PG_STEP
            __syncthreads();
            {   const int s = t >> 3, v0 = 8 * (t & 7); const long long tt = tb + (long long)c * SC_CH + s; float o[8];
#pragma unroll
                for (int i = 0; i < 2; ++i) { const f32x4_t to = *(const LAS f32x4_t*)(OB + s * 64 + v0 + 4 * i);
#pragma unroll
                    for (int j = 0; j < 4; ++j) o[4 * i + j] = to[j]; }
                float ms = 0.f;
#pragma unroll
                for (int j = 0; j < 8; ++j) ms += o[j] * o[j];
                const float rs = rsqrtf(sum8(ms) * (1.0f / 64.0f) + 1e-6f);
                bf16_t* d = O + tt * 1024 + 768 + h * 64 + v0; float g[8], res[8]; cvt8(gpre, g);
#pragma unroll
                for (int j = 0; j < 8; ++j) res[j] = o[j] * rs * ngw[j] * g[j];
                st8(d, res); }
            if (c + 1 < nch) PG_SSTORE((c + 1) & 1);
            __syncthreads();
        }
#undef PG_GLOAD
#undef PG_SSTORE
    }
}
__device__ __forceinline__ void ph_scan_selwin(const Params& p, int l, int wv, LAS unsigned char* lds) {
    const int nchain = (int)(p.B * 4), nsel = (int)(p.B * 2) * (int)(p.S >> 6);
    unsigned* ctr = WSP(unsigned, p.oMOEC) + 64 + 2 * l; volatile LAS unsigned* slot = (volatile LAS unsigned*)(lds + DEAL_SLOT_OFF);
    const int tid = wv * 64 + mk_lane();
    for (;;) { const int u = next_unit(ctr, slot, tid); if (u >= nchain + nsel) break;
#ifdef PROBE_DEAL
#define PD_SPIN(bit, ...) do { const unsigned long long s0_ = wall_clock64(); __VA_ARGS__; if ((PROBE_DEAL >> (bit)) & 1) { __syncthreads(); const unsigned long long s1_ = wall_clock64(); while (wall_clock64() < s1_ + (s1_ - s0_)) __builtin_amdgcn_s_sleep(8); } } while (0)
#else
#define PD_SPIN(bit, ...) do { __VA_ARGS__; } while (0)
#endif
        if (u < nchain) PD_SPIN(2, pair_chain(p, l, u, wv, lds));
        else { const int v = u - nchain, nbg = (int)(p.B * 2), cur = (int)(p.S >> 6) - 1 - v / nbg, bg = v % nbg;
            PD_SPIN(0, cmp_unit(p, cur, bg, wv, lds));
            __syncthreads();
            PD_SPIN(1, selwin_unit(p, cur, bg, wv, lds)); } }
}
#endif
#ifdef CPU_EMU
struct Ctx { long long gtid, gsz, gw, nw; int lane, G, c; };
#define GEMM(A, lda, Bt, ldb, K, S, E) gemm_cpu(A, lda, Bt, ldb, K, S, E)
#define GEMMK(A, lda, Bt, ldb, K, S, E, ks) gemm_cpu(A, lda, Bt, ldb, K, S, E, ks)
#define GEMMG(A, lda, Bt, ldb, K, S, E, gi) gemm_cpu(A, lda, Bt, ldb, K, S, E, 64, gi)
#define GRID_BARRIER() do { } while (0)
#else
struct Ctx { LAS unsigned char* lds; int wv; };
#define GEMM(A, lda, Bt, ldb, K, S, E) gemm_phase(cx.wv, cx.lds, A, lda, Bt, ldb, K, S, E)
#define GEMMK(A, lda, Bt, ldb, K, S, E, ks) gemm_phase(cx.wv, cx.lds, A, lda, Bt, ldb, K, S, E, ks)
#define GEMMG(A, lda, Bt, ldb, K, S, E, gi) gemm_phase<decltype(E), decltype(S), true>(cx.wv, cx.lds, A, lda, Bt, ldb, K, S, E, 64, gi)
#define GRID_BARRIER() do { XcdBarrier b_; b_.bar = (unsigned*)(p.ws + p.oBAR); b_.x = xb_xcc_id(); b_.st = (volatile LAS unsigned*)(cx.lds + XBW_OFF); b_.wv = cx.wv; xcd_barrier(b_); } while (0)
#endif
constexpr int N_PHASES = 52;
#if !defined(CPU_EMU) && defined(PROBE_SUB)
#define SUBP(bit, ...) do { const unsigned long long s0_ = wall_clock64(); __VA_ARGS__; if ((PROBE_SUB >> (bit)) & 1) { const unsigned long long s1_ = wall_clock64(); while (wall_clock64() < s1_ + (s1_ - s0_)) __builtin_amdgcn_s_sleep(8); } } while (0)
#else
#define SUBP(bit, ...) do { __VA_ARGS__; } while (0)
#endif
#ifndef PROBE_CONV
#define PROBE_CONV 1
#endif
#ifndef PROBE_PREP
#define PROBE_PREP 1
#endif
#ifndef PROBE_GEMM
#define PROBE_GEMM 1
#endif
#ifndef PROBE_CMP
#define PROBE_CMP 1
#endif
#ifndef PROBE_CA
#define PROBE_CA 1
#endif
#ifndef PROBE_MOE
#define PROBE_MOE 1
#endif
#ifndef PROBE_RMS
#define PROBE_RMS 1
#endif
#ifndef PROBE_BAR
#define PROBE_BAR 0
#endif

template <int KIND> DEVI void run_program(const Params& p, const Ctx& cx, int pb, int pe) {
    int ph = 0;
#define T p.T
#define DFF p.DFF
#ifdef CPU_EMU
    const long long gsz = cx.gsz, nw = cx.nw; const int gG = cx.G, gC = cx.c;
#else
#define gsz ((long long)gridDim.x * 512)
#define nw ((long long)gridDim.x * 8)
#define gG ((int)gridDim.x)
#define gC ((int)blockIdx.x)
#endif
#define H WSP(bf16_t, p.oH)
#define HN ((bf16_t*)p.out)
#define P WSP(bf16_t, p.oP)
#define O WSP(bf16_t, p.oO)
#define BO WSP(bf16_t, p.oBO)
#define MG WSP(bf16_t, p.oMG)
#define CQ WSP(bf16_t, p.oCQ)
#define CAO WSP(bf16_t, p.oCAO)
#define MEMN WSP(bf16_t, p.oMEMN)
#define ACT WSP(bf16_t, p.oACT)
#define WFFN WSP(bf16_t, p.oWFFN)
#ifdef CPU_EMU
#define OPAQUE_V(x) do { } while (0)
#define PH_IDX long long gtid = cx.gtid, gw = cx.gw; int lane = cx.lane
#else
#define OPAQUE_V(x) asm volatile("" : "+v"(x))
#define PH_IDX unsigned tx_ = (unsigned)(cx.wv * 64 + mk_lane()); OPAQUE_V(tx_); long long gtid = (long long)blockIdx.x * 512 + tx_, gw = (long long)(tx_ >> 6) * gridDim.x + blockIdx.x; int lane = tx_ & 63
#endif
#if !defined(CPU_EMU) && defined(PROBE_MASK)
#define PH_T0(k) const int kind_ = (k); const unsigned long long t0_ = wall_clock64();
#else
#define PH_T0(k)
#endif
#define PH_BEGIN(k) if (ph >= pb && ph < pe) { if constexpr (KIND < 0 || KIND == (k)) { PH_T0(k) PH_IDX; OPAQUE_V(gtid); OPAQUE_V(gw); OPAQUE_V(lane); (void)gtid; (void)gw; (void)lane;
#if !defined(CPU_EMU) && defined(PROBE_MASK)
#define PH_END   if ((PROBE_MASK >> kind_) & 1) { const unsigned long long t1_ = wall_clock64(); while (wall_clock64() < t1_ + (t1_ - t0_)) __builtin_amdgcn_s_sleep(8); } } if (ph + 1 < pe) GRID_BARRIER(); } ++ph;
#else
#define PH_END   } if (ph + 1 < pe) GRID_BARRIER(); } ++ph;
#endif
    PH_BEGIN(0)
        { long long cvo_ = 0; ph_convert_layer(p, 0, gtid, gsz, cvo_); ph_convert_layer(p, 1, gtid, gsz, cvo_); ph_convert_ffn(p, gtid, gsz, cvo_); ph_convert_cmp(p, gtid, gsz); } ph_rope(p, gtid, gsz);
        ph_rmsnorm(p, p.in[I_MEM], p.B * 256, p.in[I_MEM_NORM], MEMN, 0, nullptr, gw, nw, lane);
        ph_rmsnorm(p, p.in[I_X], T, p.in[I_NORM_MIX], H, 0, nullptr, gw, nw, lane);
    PH_END
    ++ph;
    for (int l = 0; l < 2; ++l) {
#define W WSP(bf16_t, p.oWL[l])
        PH_BEGIN(1)
            if (l == 0) { SchedPlain S; S.init(p.B * 256, 1024, 1024, 1024, gG, gC); EpStore E{WSP(bf16_t, p.oKV), 1024, 1.0f, nullptr, nullptr, 0}; GEMM(MEMN, 1024, WSP(bf16_t, p.oWKV), 1024, 1024, S, E); }
            { SchedPlain S; S.init(T, 3072, 1024, 1024, gG, gC); EpStore E{P, 3072, 1.0f, l == 1 ? WSP(rs_t, p.oRSA) : nullptr, nullptr, 0}; GEMM(H, 1024, W + W_IN, 1024, 1024, S, E); } PH_END
        PH_BEGIN(2) if (l == 1) { rs_t* rs_ = WSP(rs_t, p.oRSB); for (long long i_ = gtid; i_ < T; i_ += gsz) rs_[i_] = 0ull; } SUBP(0, { const int nuv_ = (int)(T / 16 / 256) * 4;
                if (gG >= 2 * nuv_) { if (gC >= nuv_) ph_rope_apply(p, (long long)(gC - nuv_) * 512 + tx_, (long long)(gG - nuv_) * 512); } else ph_rope_apply(p, gtid, gsz); }); SUBP(1, { SchedCmp S; S.init(T / 16, gG, gC); EpUV E{WSP(bf16_t, p.oUV)}; GEMMK(P, 16LL * PW, WSP(bf16_t, p.oW1T) + (long long)l * 2 * 256 * 1024, 1024, 1024, S, E, (long long)PW); });
#ifdef CPU_EMU
            { static float pwl_[4 * 64 * 64]; pool_fill_w(p, l, pwl_, 0, 1); ph_pool(p, l, pwl_, gtid, gsz); } ph_gla_prep(p, l, gtid, gsz);
#else
            SUBP(2, pool_gpu(p, l, cx.wv, cx.lds, gC, gG)); SUBP(3, ph_gla_prep(p, l, gtid, gsz));
#endif
#ifdef CPU_EMU
            { static unsigned wl_[80 * 256]; static unsigned F_[32 * 80]; static float KN_[128]; rwkv_fill_wl(p, l, wl_, 0, 1);
              for (long long tile = 0; tile < T / 32; ++tile) { for (int q = 0; q < 512; ++q) rwkv_prep_step1(p, l, F_, KN_, tile, q); for (int q = 0; q < 512; ++q) rwkv_prep_step2(p, l, wl_, F_, KN_, tile, q); } }
#else
            SUBP(4, { LDSQ unsigned* wl_ = (LDSQ unsigned*)cx.lds; LDSQ unsigned* F_ = (LDSQ unsigned*)(cx.lds + 131072); LDSQ float* KN_ = (LDSQ float*)(F_ + 32 * 80); LDSQ float* PRM_ = KN_ + 128; LDSQ float* Z_ = (LDSQ float*)cx.lds;
                __syncthreads(); rwkv_fill_wl_gpu(p, l, wl_, (int)tx_); rwkv_fill_prm(p, l, PRM_, (int)tx_); __syncthreads(); RwFrags fr_; rwkv_load_frags(wl_, cx.wv, fr_);
                for (long long tile = gC; tile < T / 32; tile += gG) { __syncthreads(); rwkv_prep_step1_gpu(p, l, F_, KN_, tile, (int)tx_); __syncthreads(); rwkv_lowrank_mfma(l, fr_, F_, Z_, cx.wv); __syncthreads(); rwkv_prep_step2_gpu(p, l, PRM_, KN_, Z_, tile, (int)tx_); } });
#endif
#if PROBE_PREP == 2
            ph_pool(p, l, gtid, gsz);
#elif PROBE_PREP == 3
            ph_pool(p, l, gtid, gsz); ph_gla_prep(p, l, gtid, gsz);
#endif
 PH_END
#ifdef CPU_EMU
        PH_BEGIN(3) ph_compress2(p, l, gtid, gsz); PH_END
#else
        PH_BEGIN(3) compress2_gpu(p, l, cx.wv, cx.lds, gC, gG); PH_END
#endif
#ifdef CPU_EMU
        PH_BEGIN(4) ph_rwkv_scan(p, l, gw, nw, lane); ph_gla_scan(p, l, (gw + nw - (p.B * 4) % nw) % nw, nw, lane); ph_cmp_attn(p, gtid, gsz); PH_END
#else
        ++ph;
#endif
#ifdef CPU_EMU
        PH_BEGIN(5) ph_selwin(p, gtid, gsz); PH_END
#else
        PH_BEGIN(5) ph_scan_selwin(p, l, cx.wv, cx.lds); PH_END
#endif
        PH_BEGIN(6) { SchedBranch S; S.init(T, gG, gC); EpStore E{P, 4096, 1.0f, nullptr, BO, 3 * T / 4}; GEMM(O, 1024, W + W_B, 256, 256, S, E); } PH_END
        PH_BEGIN(7) { SchedPlain S; S.init(T, 4096, 1024, 1024, gG, gC); EpGate E{P, p.in[I_B_GATE] + l * 4096, MG, 0, l == 1 ? WSP(rs_t, p.oRSA) : nullptr, BO, 3 * T / 4}; GEMM(H, 1024, W + W_G, 1024, 1024, S, E); } PH_END
        ph += 6;
        PH_BEGIN(8) { SchedPlain S; S.init(T, 1024, 1024, 1024, gG, gC); EpResid E{l == 0 ? p.in[I_X] : nullptr, H, H, WSP(rs_t, l == 0 ? p.oRSA : p.oRSB)}; GEMM(MG, 1024, W + W_O, 1024, 1024, S, E); } PH_END
        ++ph;
        PH_BEGIN(1) { SchedPlain S; S.init(T, 256, 1024, 1024, gG, gC); EpStore E{CQ, 256, QSCALE, WSP(rs_t, l == 0 ? p.oRSA : p.oRSB), nullptr, 0}; GEMM(H, 1024, W + W_CQ, 1024, 1024, S, E); } PH_END
#ifdef CPU_EMU
        PH_BEGIN(10) if (l == 0) { rs_t* rs_ = WSP(rs_t, p.oRSA); for (long long i_ = gtid; i_ < T; i_ += gsz) rs_[i_] = 0ull; } ph_ca_attn(p, l, gtid, gsz); PH_END
#else
        PH_BEGIN(10) if (l == 0) { rs_t* rs_ = WSP(rs_t, p.oRSA); for (long long i_ = gtid; i_ < T; i_ += gsz) rs_[i_] = 0ull; } ph_ca_attn_mfma(p, l, cx.wv, cx.lds, gC, gG); PH_END
#endif
        PH_BEGIN(8) { SchedPlain S; S.init(T, 1024, 256, 256, gG, gC); EpResid E{nullptr, H, H, l == 0 ? WSP(rs_t, p.oRSB) : nullptr}; GEMM(CAO, 256, W + W_CO, 256, 256, S, E); } PH_END
        if (l == 1) { PH_BEGIN(9)
#ifdef CPU_EMU
            ph_rmsnorm(p, nullptr, T, p.in[I_NORM_FFN] + l * 1024, HN, 2, nullptr, gw, nw, lane, 0, H); moe_count_range(p, 0, T / 64, 0, 1);
#else
            for (long long r0_ = (long long)gC * 256; r0_ < T; r0_ += (long long)gG * 256) { const int wib_ = (int)(tx_ >> 6);
                (void)wib_; norm_router_256(p, l, r0_, cx.wv, cx.lds);
                asm volatile("s_waitcnt vmcnt(0)" ::: "memory"); __syncthreads(); __builtin_amdgcn_fence(__ATOMIC_ACQUIRE, "agent"); asm volatile("s_waitcnt vmcnt(0)" ::: "memory");
                moe_count_range(p, r0_ / 64, 4, (int)tx_, 512); }
#endif
            { int* R2T_ = WSP(int, p.oR2T); for (long long i_ = gtid; i_ < p.NR; i_ += gsz) R2T_[i_] = -1; }
            ph_convert_moe(p, gtid, gsz); PH_END }
        else ++ph;
        if (l == 0) {
            PH_BEGIN(11) { SchedPlain S; S.init(T, 2 * DFF, 1024, 1024, gG, gC); EpSwiglu E{ACT, DFF, 0, WSP(rs_t, p.oRSB)}; GEMM(H, 1024, WFFN, 1024, 1024, S, E); } PH_END
            PH_BEGIN(8) { SchedPlain S; S.init(T, 1024, DFF, DFF, gG, gC); EpResid E{nullptr, H, H, WSP(rs_t, p.oRSA)}; GEMM(ACT, DFF, WFFN + 2 * DFF * 1024, DFF, DFF, S, E); } PH_END
            ++ph;
        } else {
            PH_BEGIN(12) for (int rep_ = 0; rep_ < PROBE_MOE; ++rep_) ph_moe_offsets(p, gw, nw, lane); PH_END
            PH_BEGIN(12) for (int rep_ = 0; rep_ < PROBE_MOE; ++rep_) ph_moe_assign(p, gtid, gsz); PH_END
#define HS WSP(bf16_t, p.oHS)
#define ACTC WSP(bf16_t, p.oACTC)
#define MW WSP(bf16_t, p.oMOEW)
#define MC WSP(int, p.oMOEC)
            const int ct = (p.NR / 256) >= 512 ? 256 : (int)((p.NR / 256 + 2) / 3);
            for (int q = 0; q < 3; ++q) {
                PH_BEGIN(13) { SchedMoe S; const int nt_ = MC[16 + 8] / 256; S.t0 = q * ct; S.t1 = (q + 1) * ct < nt_ ? (q + 1) * ct : nt_; if (S.t1 < S.t0) S.t1 = S.t0; S.nN = (int)(2 * DFF / 256); S.G = gG; S.c = gC; S.lda = 1024; S.ldb = 1024; S.per_e = 3 * 1024 * DFF * 2;
                    S.base = MC + 16;
                    EpSwiglu E{ACTC, DFF, (long long)S.t0 * 256, nullptr}; GEMMG(HN, 1024, MW, 1024, 1024, S, E, WSP(int, p.oR2T)); } PH_END
                PH_BEGIN(14) { SchedMoe S; const int nt_ = MC[16 + 8] / 256; S.t0 = q * ct; S.t1 = (q + 1) * ct < nt_ ? (q + 1) * ct : nt_; if (S.t1 < S.t0) S.t1 = S.t0; S.nN = 4; S.G = gG; S.c = gC; S.lda = DFF; S.ldb = DFF; S.per_e = 3 * 1024 * DFF * 2;
                    S.base = MC + 16;
                    EpMoeDown E{WSP(bf16_t, p.oY), WSP(float, p.oROWW)}; GEMM(ACTC - (long long)S.t0 * 256 * DFF, DFF, MW + 2 * DFF * 1024, DFF, DFF, S, E); } PH_END }
            PH_BEGIN(15) ph_final(p, gw, nw, lane); PH_END
        }
    }
#undef PH_BEGIN
#undef PH_END
#undef H
#undef HN
#undef P
#undef O
#undef BO
#undef MG
#undef CQ
#undef CAO
#undef MEMN
#undef ACT
#undef WFFN
#undef T
#undef DFF
#undef W
#undef HS
#undef ACTC
#undef MW
#undef MC
#ifndef CPU_EMU
#undef gsz
#undef nw
#undef gG
#undef gC
#endif
}

#ifndef CPU_EMU
template <int KIND> __global__ __launch_bounds__(512, 2) void mk_fwd(Params p, int pb, int pe) {
    extern __shared__ __attribute__((aligned(16))) unsigned char shm[];
    Ctx cx; cx.lds = (LAS unsigned char*)shm;
    volatile LAS unsigned* xbw = (volatile LAS unsigned*)(cx.lds + XBW_OFF);
    if (threadIdx.x == 0) { xbw[0] = 0u; xbw[1] = 0u; xbw[2] = 0u; xbw[3] = 0u; }
    __syncthreads();
    cx.wv = __builtin_amdgcn_readfirstlane((int)(threadIdx.x >> 6));
    (void)xcd_barrier_post((unsigned*)(p.ws + p.oBAR), xbw, cx.wv);
    run_program<KIND>(p, cx, pb, pe);
}
#ifndef MK_ONE
#define MK_ONE 1
#endif
#if !MK_ONE
static const int kPhaseKind[N_PHASES] = { 0, 1,
    1, 2, 3, 4, 5, 6, 7, 6, 7, 6, 7, 6, 7, 8, 9, 1, 10, 8, 9, 11, 8, 9,
    1, 2, 3, 4, 5, 6, 7, 6, 7, 6, 7, 6, 7, 8, 9, 1, 10, 8, 9, 12, 12, 12, 12, 13, 14, 13, 14, 13, 14, 13, 14, 13, 14, 15 };
#endif
typedef void (*mk_fn)(Params, int, int);
extern "C" void kernel_launch(void* const* d_in, const int* in_sizes, int n_in, void* d_out, int out_size, void* d_ws, size_t ws_size, hipStream_t stream) {
    (void)in_sizes; (void)n_in; (void)out_size;
    Params p; memset(&p, 0, sizeof(p));
    for (int i = 0; i < N_INPUTS; ++i) p.in[i] = (const float*)d_in[i];
    p.out = (float*)d_out; p.ws = (unsigned char*)d_ws;
    make_layout(p, 32, 2048, 2816);
    for (int j = 0; j < 8; ++j) p.inv_freq[j] = (float)pow(500000.0, -(double)(2 * j) / 16.0);
    if ((size_t)p.wsNeed > ws_size) { fprintf(stderr, "workspace too small: need %lld have %zu\n", p.wsNeed, ws_size); return; }
    const size_t lds_bytes = LDS_TOTAL;
#if MK_ONE
    static const mk_fn fns[1] = { mk_fwd<-1> }; const int nf = 1;
#else
    static const mk_fn fns[16] = { mk_fwd<0>, mk_fwd<1>, mk_fwd<2>, mk_fwd<3>, mk_fwd<4>, mk_fwd<5>, mk_fwd<6>, mk_fwd<7>, mk_fwd<8>, mk_fwd<9>, mk_fwd<10>, mk_fwd<11>, mk_fwd<12>, mk_fwd<13>, mk_fwd<14>, mk_fwd<15> }; const int nf = 16;
#endif
    static int grid = 0;
    if (!grid) { int dev = 0, cus = 0; (void)hipGetDevice(&dev); (void)hipDeviceGetAttribute(&cus, hipDeviceAttributeMultiprocessorCount, dev);
        for (int k = 0; k < nf; ++k) (void)hipFuncSetAttribute((const void*)fns[k], hipFuncAttributeMaxDynamicSharedMemorySize, (int)lds_bytes);
        int per_cu = 0; (void)hipOccupancyMaxActiveBlocksPerMultiprocessor(&per_cu, (const void*)fns[0], 512, lds_bytes); (void)hipGetLastError();
        grid = cus > 0 ? cus : 256; }
    (void)hipMemsetAsync(p.ws + p.oBAR, 0, 16384 + 4096, stream);
    (void)hipMemsetAsync(p.ws + p.oRSA, 0, (size_t)p.T * 8, stream); (void)hipMemsetAsync(p.ws + p.oRSB, 0, (size_t)p.T * 8, stream);
#if MK_ONE
    hipLaunchKernelGGL(fns[0], dim3(grid), dim3(512), lds_bytes, stream, p, 0, N_PHASES);
#else
    for (int ph = 0; ph < N_PHASES; ++ph) hipLaunchKernelGGL(fns[kPhaseKind[ph]], dim3(grid), dim3(512), lds_bytes, stream, p, ph, ph + 1);
#endif
}
#endif
```
